# Optimizing an MI355X kernel written in HIP

```python
import jax, jax.numpy as jnp
from jax import lax
import numpy as np

D_MODEL = 1024
BATCH = 8
SEQ = 8192
DEPTH = 1
DEC_BATCH = 8
DEC_SEQ = 32
PAST_LEN = 1024

CHUNK = 64
Q_BLOCK = 128
MIX_WIDTH = D_MODEL
A_WIDTH = MIX_WIDTH // 2
B_WIDTH = MIX_WIDTH - A_WIDTH
A_HEADS = 4
A_DK = A_WIDTH // A_HEADS
A_DV = A_WIDTH // A_HEADS
B_HEADS = 8
B_DH = B_WIDTH // B_HEADS
D_FF = 4 * D_MODEL
EPS = 1e-6
SPLITS = [A_WIDTH, 2 * A_WIDTH, 3 * A_WIDTH, 4 * A_WIDTH,
          4 * A_WIDTH + B_WIDTH, 4 * A_WIDTH + 2 * B_WIDTH, 4 * A_WIDTH + 3 * B_WIDTH]
IN_COLS = 4 * A_WIDTH + 3 * B_WIDTH + B_HEADS

kernel_name = 'hymba_hgrn2_fox_streaming_step'


def rms_norm(x, g):
    xf = x.astype(jnp.float32)
    y = xf * lax.rsqrt(jnp.mean(xf * xf, axis=-1, keepdims=True) + EPS)
    return (y * g.astype(jnp.float32)).astype(x.dtype)


def mixer_inputs(x, norm1, w_in, b_fox_f, q_gain, k_gain, lb):
    B, T, _ = x.shape
    h = rms_norm(x, norm1)
    z = h @ w_in
    qa, fa, ia, ga, qb, kb, vb, fb = jnp.split(z, SPLITS, axis=-1)
    f = lb + (1.0 - lb) * jax.nn.sigmoid(fa.astype(jnp.float32))
    hq = qa.astype(jnp.float32).reshape(B, T, A_HEADS, A_DK)
    hk = (1.0 - f).reshape(B, T, A_HEADS, A_DK)
    hlogf = jnp.log(f).reshape(B, T, A_HEADS, A_DK)
    hv = ia.astype(jnp.float32).reshape(B, T, A_HEADS, A_DV)
    fq = rms_norm(qb.reshape(B, T, B_HEADS, B_DH), q_gain)
    fk = rms_norm(kb.reshape(B, T, B_HEADS, B_DH), k_gain)
    fv = vb.reshape(B, T, B_HEADS, B_DH)
    flogf = jax.nn.log_sigmoid(fb.astype(jnp.float32) + b_fox_f.astype(jnp.float32))
    return (hq, hk, hv, hlogf, ga), (fq, fk, fv, flogf)


def hgrn2_chunk(S0, q, k, v, logf):
    C = q.shape[1]
    b = jnp.cumsum(logf, axis=1)
    b_ref = b[:, C // 2:C // 2 + 1]
    inter = jnp.einsum('bchk,bhkv->bchv', q * jnp.exp(b), S0)
    qr = q * jnp.exp(b - b_ref)
    kr = k * jnp.exp(b_ref - b)
    A = jnp.einsum('bchk,bshk->bhcs', qr, kr)
    mask = jnp.tril(jnp.ones((C, C), dtype=bool))
    A = jnp.where(mask[None, None], A, 0.0)
    o = inter + jnp.einsum('bhcs,bshv->bchv', A, v)
    b_last = b[:, -1:]
    S_new = jnp.exp(b_last[:, 0])[..., None] * S0 + jnp.einsum('bshk,bshv->bhkv', k * jnp.exp(b_last - b), v)
    return S_new, o


def hgrn2_prompt(q, k, v, logf):
    B, T, H, _ = q.shape
    nc = T // CHUNK

    def to_chunks(t):
        return jnp.moveaxis(t.reshape(B, nc, CHUNK, H, t.shape[-1]), 1, 0)

    def step(S_c, xs):
        return hgrn2_chunk(S_c, *xs)

    S0 = jnp.zeros((B, H, A_DK, A_DV), jnp.float32)
    S_fin, o = lax.scan(step, S0, (to_chunks(q), to_chunks(k), to_chunks(v), to_chunks(logf)))
    return S_fin, jnp.moveaxis(o, 0, 1).reshape(B, T, H, A_DV)


def fox_prompt_attention(q, k, v, logf):
    B, T, H, Dh = q.shape
    nb = T // Q_BLOCK
    c = jnp.cumsum(logf, axis=1)
    cT = jnp.transpose(c, (0, 2, 1))
    pos = jnp.arange(T)
    qblk = jnp.moveaxis(q.reshape(B, nb, Q_BLOCK, H, Dh), 1, 0)
    cblk = jnp.moveaxis(c.reshape(B, nb, Q_BLOCK, H), 1, 0)
    pblk = pos.reshape(nb, Q_BLOCK)
    scale = Dh ** -0.5

    def block(args):
        qi, ci, pi = args
        s = jnp.einsum('bqhd,bkhd->bhqk', qi, k, preferred_element_type=jnp.float32) * scale
        s = s + jnp.transpose(ci, (0, 2, 1))[..., :, None] - cT[..., None, :]
        s = jnp.where(pi[:, None] >= pos[None, :], s, -jnp.inf)
        p = jax.nn.softmax(s, axis=-1)
        return jnp.einsum('bhqk,bkhd->bqhd', p.astype(v.dtype), v)

    o = lax.map(block, (qblk, cblk, pblk))
    return jnp.moveaxis(o, 0, 1).reshape(B, T, H * Dh)


def fox_sample_attention(q, k_new, v_new, logf_new, k_cache, v_cache, logf_cache):
    B, T, H, Dh = q.shape
    P = k_cache.shape[1]
    k = jnp.concatenate([k_cache.astype(k_new.dtype), k_new], axis=1)
    v = jnp.concatenate([v_cache.astype(v_new.dtype), v_new], axis=1)
    c = jnp.cumsum(jnp.concatenate([logf_cache.astype(jnp.float32), logf_new], axis=1), axis=1)
    cT = jnp.transpose(c, (0, 2, 1))
    s = jnp.einsum('bqhd,bkhd->bhqk', q, k, preferred_element_type=jnp.float32) * (Dh ** -0.5)
    s = s + cT[..., P:, None] - cT[..., None, :]
    qpos = P + jnp.arange(T)
    kpos = jnp.arange(P + T)
    s = jnp.where(qpos[:, None] >= kpos[None, :], s, -jnp.inf)
    p = jax.nn.softmax(s, axis=-1)
    o = jnp.einsum('bhqk,bkhd->bqhd', p.astype(v.dtype), v)
    return o.reshape(B, T, H * Dh)


def mixer_output_and_ffn(x, o_a, ga, o_b, hgrn_out_norm, w_out, norm2, w_up, w_down):
    B, T, _ = x.shape
    oa = rms_norm(o_a, hgrn_out_norm.reshape(A_HEADS, A_DV))
    oa = (oa.reshape(B, T, A_WIDTH) * jax.nn.silu(ga.astype(jnp.float32))).astype(x.dtype)
    mix = jnp.concatenate([oa, o_b.astype(x.dtype)], axis=-1)
    x = x + mix @ w_out
    h = rms_norm(x, norm2)
    return x + jnp.square(jax.nn.relu(h @ w_up)) @ w_down


def setup_inputs(seed: int = 0) -> dict:
    key = jax.random.key(seed)
    ks = jax.random.split(key, 20)
    nrm = jax.random.normal
    f32 = jnp.float32
    return {
        'x_prompt': nrm(ks[0], (BATCH, SEQ, D_MODEL), f32),
        'x_sample': nrm(ks[1], (DEC_BATCH, DEC_SEQ, D_MODEL), f32),
        'cache_fox_k': nrm(ks[2], (DEPTH, DEC_BATCH, PAST_LEN, B_HEADS, B_DH), f32),
        'cache_fox_v': nrm(ks[3], (DEPTH, DEC_BATCH, PAST_LEN, B_HEADS, B_DH), f32),
        'cache_fox_logf': jax.nn.log_sigmoid(2.0 + nrm(ks[4], (DEPTH, DEC_BATCH, PAST_LEN, B_HEADS), f32)),
        'state_hgrn': 0.5 * nrm(ks[5], (DEPTH, DEC_BATCH, A_HEADS, A_DK, A_DV), f32),
        'norm1': 1.0 + 0.05 * nrm(ks[6], (DEPTH, D_MODEL), f32),
        'w_in': nrm(ks[7], (DEPTH, D_MODEL, IN_COLS), f32) * D_MODEL ** -0.5,
        'b_fox_f': 2.0 + 0.1 * nrm(ks[8], (DEPTH, B_HEADS), f32),
        'q_norm_gain': 1.0 + 0.05 * nrm(ks[9], (DEPTH, B_DH), f32),
        'k_norm_gain': 1.0 + 0.05 * nrm(ks[10], (DEPTH, B_DH), f32),
        'hgrn_lb_logits': 0.1 * nrm(ks[11], (DEPTH + 1, A_WIDTH), f32),
        'hgrn_out_norm': 1.0 + 0.05 * nrm(ks[12], (DEPTH, A_WIDTH), f32),
        'w_out': nrm(ks[13], (DEPTH, MIX_WIDTH, D_MODEL), f32) * MIX_WIDTH ** -0.5,
        'norm2': 1.0 + 0.05 * nrm(ks[14], (DEPTH, D_MODEL), f32),
        'w_up': nrm(ks[15], (DEPTH, D_MODEL, D_FF), f32) * D_MODEL ** -0.5,
        'w_down': nrm(ks[16], (DEPTH, D_FF, D_MODEL), f32) * D_FF ** -0.5,
    }


def reference(x_prompt, x_sample, cache_fox_k, cache_fox_v, cache_fox_logf, state_hgrn,
              norm1, w_in, b_fox_f, q_norm_gain, k_norm_gain, hgrn_lb_logits, hgrn_out_norm,
              w_out, norm2, w_up, w_down):
    lb_all = jnp.cumsum(jax.nn.softmax(hgrn_lb_logits.astype(jnp.float32), axis=0), axis=0)
    xp, xs = x_prompt, x_sample
    kp, vp, lp, sp = [], [], [], []
    ksl, vsl, lsl, ssl = [], [], [], []
    for l in range(DEPTH):
        lb = lb_all[l]
        (hq, hk, hv, hlf, ga), (fq, fk, fv, flf) = mixer_inputs(
            xp, norm1[l], w_in[l], b_fox_f[l], q_norm_gain[l], k_norm_gain[l], lb)
        S_p, o_a = hgrn2_prompt(hq, hk, hv, hlf)
        o_b = fox_prompt_attention(fq, fk, fv, flf)
        xp = mixer_output_and_ffn(xp, o_a, ga, o_b, hgrn_out_norm[l], w_out[l], norm2[l], w_up[l], w_down[l])
        kp.append(fk); vp.append(fv); lp.append(flf); sp.append(S_p.astype(x_prompt.dtype))
        (hq, hk, hv, hlf, ga), (fq, fk, fv, flf) = mixer_inputs(
            xs, norm1[l], w_in[l], b_fox_f[l], q_norm_gain[l], k_norm_gain[l], lb)
        S_s, o_a = hgrn2_chunk(state_hgrn[l].astype(jnp.float32), hq, hk, hv, hlf)
        o_b = fox_sample_attention(fq, fk, fv, flf, cache_fox_k[l], cache_fox_v[l], cache_fox_logf[l])
        xs = mixer_output_and_ffn(xs, o_a, ga, o_b, hgrn_out_norm[l], w_out[l], norm2[l], w_up[l], w_down[l])
        ksl.append(fk); vsl.append(fv); lsl.append(flf); ssl.append(S_s.astype(state_hgrn.dtype))
    return (xp, xs, jnp.stack(kp), jnp.stack(vp), jnp.stack(lp), jnp.stack(sp),
            jnp.stack(ksl), jnp.stack(vsl), jnp.stack(lsl), jnp.stack(ssl))
```

```cpp
#include <hip/hip_runtime.h>
#include <cstdio>
#include <cstdint>
namespace pg8 {
#define PG8_LAS __attribute__((address_space(3)))
typedef unsigned short bf16_t;
typedef short bf16x8 __attribute__((ext_vector_type(8)));
typedef float f32x4 __attribute__((ext_vector_type(4)));
typedef unsigned u32x4 __attribute__((ext_vector_type(4)));
constexpr int BM = 256, BK = 64, HALF = 128, HTB = HALF * BK * 2  , STAGE_BYTES = 8 * HTB, NXCD = 8, WGM = 8;

__host__ __device__ __forceinline__ int lds_byte(int r, int c) { const int st = (r >> 4) * 2 + (c >> 5), rr = r & 15, cc = c & 31, ob = rr * 64 + cc * 2; return st * 1024 + (ob ^ (((ob >> 9) & 1) << 5)); }
__host__ __device__ __forceinline__ void stage_rc(int b, int& R, int& C) { const int st = b / 1024, sb = b % 1024, swz = sb ^ (((sb >> 9) & 1) << 5); R = (st >> 1) * 16 + swz / 64; C = (st & 1) * 32 + (swz % 64) / 2; }
__host__ __device__ __forceinline__ int perm32(int rho) { const int n = rho >> 4, i = rho & 15; return 8 * (i >> 2) + 4 * n + (i & 3); }

struct Unit { int pm, pn; };
struct Gemm { const bf16_t* A; const bf16_t* Bt; int M, N, K; };

struct StaticOrder {
    int nM, nN, nwg, G, c;
    __host__ __device__ void init(int M, int N, int G_, int c_) { nM = M / BM; nN = N / BM; nwg = nM * nN; G = G_; c = c_; }
    __host__ __device__ bool next(int i, Unit& u) const {
        const long L = (long)i * G + c; if (L >= nwg) return false;
        int wgid = (int)L; { const int q = nwg / NXCD, r = nwg % NXCD, xcd = wgid % NXCD, off = wgid / NXCD; wgid = (xcd < r ? xcd * (q + 1) : r * (q + 1) + (xcd - r) * q) + off; }
        const int nig = WGM * nN, gid = wgid / nig, fm = gid * WGM, gsz = (nM - fm) < WGM ? (nM - fm) : WGM;
        u.pm = fm + ((wgid % nig) % gsz); u.pn = (wgid % nig) / gsz; return true;
    }
    __device__ __forceinline__ void a_ready(const Unit&) const {}
    __device__ __forceinline__ void done(const Unit&) const {}
};

__device__ __forceinline__ unsigned cvt_pk_bf16(float lo, float hi) { unsigned r; asm volatile("v_cvt_pk_bf16_f32 %0, %1, %2" : "=v"(r) : "v"(lo), "v"(hi)); return r; }
typedef float f32x2 __attribute__((ext_vector_type(2)));
template <class Epi, class Sched, bool ALIGN_EPI = false, bool SP2 = false>
__device__ __forceinline__ void gemm_phase(PG8_LAS unsigned char* lds, const Gemm g, const Sched& S, const Epi& E) {
    const int tid = threadIdx.x, wid = __builtin_amdgcn_readfirstlane(tid >> 6), lane = tid & 63, wr = wid >> 2, wc = wid & 3, fr = lane & 15, fq = lane >> 4;
    const int K = g.K, nt = K / BK;
    unsigned voffA[2], voffB[2];
#pragma unroll
    for (int i = 0; i < 2; ++i) { int R, C; stage_rc(tid * 16 + i * 8192, R, C); const int Rb = Epi::PERM ? ((R & ~31) + perm32(R & 31)) : R;
        voffA[i] = (unsigned)(R * K + C) * 2u; voffB[i] = (unsigned)(Rb * K + C) * 2u; }
    const size_t kstep = (size_t)(BK * 2);
    const size_t hstep = (size_t)HALF * K * 2;
    const size_t tstep = 2 * hstep;
    const unsigned ldsw = (unsigned)wid * 1024u;
    const int aoff = lds_byte(wr * 64 + fr, fq * 8), boff = lds_byte(wc * 32 + fr, fq * 8);
#define PG8_SA(b, h) (((b) * 2 + (h)) * HTB)
#define PG8_SB(b, h) ((4 + (b) * 2 + (h)) * HTB)
#define PG8_STAGE(bufoff, gbase, voff) do { _Pragma("unroll") for (int _i = 0; _i < 2; ++_i) \
        __builtin_amdgcn_global_load_lds((const unsigned*)((const char*)(gbase) + (voff)[_i]), (PG8_LAS unsigned*)(lds + (bufoff) + ldsw + _i * 8192), 16, 0, 0); } while (0)
#define PG8_LDA(dst, b, h) do { _Pragma("unroll") for (int m = 0; m < 4; ++m) _Pragma("unroll") for (int k = 0; k < 2; ++k) dst[m][k] = *(const PG8_LAS bf16x8*)(lds + PG8_SA(b, h) + aoff + m * 2048 + k * 1024); } while (0)
#define PG8_LDB(dst, b, h) do { _Pragma("unroll") for (int n = 0; n < 2; ++n) _Pragma("unroll") for (int k = 0; k < 2; ++k) dst[n][k] = *(const PG8_LAS bf16x8*)(lds + PG8_SB(b, h) + boff + n * 2048 + k * 1024); } while (0)
#define PG8_MMA(ai, bj, At, Bt) do { __builtin_amdgcn_s_setprio(1); _Pragma("unroll") for (int m = 0; m < 4; ++m) _Pragma("unroll") for (int n = 0; n < 2; ++n) _Pragma("unroll") for (int k = 0; k < 2; ++k) \
        acc[ai][bj][m][n] = __builtin_amdgcn_mfma_f32_16x16x32_bf16(Bt[n][k], At[m][k], acc[ai][bj][m][n], 0, 0, 0); __builtin_amdgcn_s_setprio(0); } while (0)
#define PG8_WAIT_V(n) asm volatile("s_waitcnt vmcnt(" #n ")" ::: "memory")
#define PG8_WAIT_L(n) asm volatile("s_waitcnt lgkmcnt(" #n ")" ::: "memory")
#define PG8_BAR __builtin_amdgcn_s_barrier()
#define PG8_SCHED __builtin_amdgcn_sched_barrier(0)
    Unit cur, nxt; int ui = 0;
    if (!S.next(0, cur)) return;
    f32x4 acc[2][2][4][2];
#pragma unroll
    for (int a = 0; a < 2; ++a)
#pragma unroll
        for (int b = 0; b < 2; ++b)
#pragma unroll
            for (int m = 0; m < 4; ++m)
#pragma unroll
                for (int n = 0; n < 2; ++n) acc[a][b][m][n] = (f32x4){0.f, 0.f, 0.f, 0.f};
    bf16x8 At[4][2], B0[2][2], B1[2][2];
    const char* cA = (const char*)g.A + (size_t)cur.pm * tstep; const char* cB = (const char*)g.Bt + (size_t)cur.pn * tstep;
    S.a_ready(cur);
    if constexpr (SP2) {
        PG8_STAGE(PG8_SB(0, 0), cB, voffB); PG8_STAGE(PG8_SB(0, 1), cB + hstep, voffB); PG8_STAGE(PG8_SA(0, 0), cA, voffA); PG8_STAGE(PG8_SA(0, 1), cA + hstep, voffA);
        if (wr == 1) PG8_BAR;
        PG8_WAIT_V(2); PG8_BAR;
        PG8_STAGE(PG8_SB(1, 0), cB + kstep, voffB); PG8_STAGE(PG8_SA(1, 0), cA + kstep, voffA); PG8_STAGE(PG8_SB(1, 1), cB + hstep + kstep, voffB);
        PG8_WAIT_V(6); PG8_BAR;
    } else {
        PG8_STAGE(PG8_SB(0, 0), cB, voffB); PG8_STAGE(PG8_SA(0, 0), cA, voffA); PG8_STAGE(PG8_SB(0, 1), cB + hstep, voffB); PG8_STAGE(PG8_SA(0, 1), cA + hstep, voffA);
        if (wr == 1) PG8_BAR;
        PG8_WAIT_V(4); PG8_BAR;
        PG8_STAGE(PG8_SB(1, 0), cB + kstep, voffB); PG8_STAGE(PG8_SA(1, 0), cA + kstep, voffA); PG8_STAGE(PG8_SB(1, 1), cB + hstep + kstep, voffB);
        PG8_WAIT_V(6); PG8_BAR;
    }
    for (;;) {
        const bool has_next = S.next(ui + 1, nxt);
        const char* nA = has_next ? (const char*)g.A + (size_t)nxt.pm * tstep : cA; const char* nB = has_next ? (const char*)g.Bt + (size_t)nxt.pn * tstep : cB;
        for (int t = 0; t < nt; t += 2) {
            const bool last = (t == nt - 2);
            const char* a1 = cA + (size_t)(t + 1) * kstep;
            const char* a2 = last ? nA : cA + (size_t)(t + 2) * kstep; const char* b2 = last ? nB : cB + (size_t)(t + 2) * kstep;
            const char* a3 = a2 + kstep; const char* b3 = b2 + kstep;
            if (last && has_next) S.a_ready(nxt);
            if constexpr (SP2) {
            PG8_LDB(B0, 0, 0); PG8_LDB(B1, 0, 1); PG8_SCHED; PG8_LDA(At, 0, 0); PG8_STAGE(PG8_SA(1, 1), a1 + hstep, voffA);
            PG8_WAIT_V(8); PG8_WAIT_L(0); PG8_BAR; PG8_MMA(0, 0, At, B0); PG8_MMA(0, 1, At, B1); PG8_BAR; PG8_SCHED;
            PG8_LDA(At, 0, 1); PG8_STAGE(PG8_SB(0, 0), b2, voffB); PG8_STAGE(PG8_SB(0, 1), b2 + hstep, voffB); PG8_STAGE(PG8_SA(0, 0), a2, voffA);
            PG8_WAIT_V(8); PG8_WAIT_L(0); PG8_BAR; PG8_MMA(1, 0, At, B0); PG8_MMA(1, 1, At, B1); PG8_BAR; PG8_SCHED;
            PG8_LDB(B0, 1, 0); PG8_LDB(B1, 1, 1); PG8_SCHED; PG8_LDA(At, 1, 0); PG8_STAGE(PG8_SA(0, 1), a2 + hstep, voffA);
            PG8_WAIT_V(8); PG8_WAIT_L(0); PG8_BAR; PG8_MMA(0, 0, At, B0); PG8_MMA(0, 1, At, B1); PG8_BAR; PG8_SCHED;
            PG8_LDA(At, 1, 1); PG8_STAGE(PG8_SB(1, 0), b3, voffB); PG8_STAGE(PG8_SB(1, 1), b3 + hstep, voffB); PG8_STAGE(PG8_SA(1, 0), a3, voffA);
            PG8_WAIT_V(8); PG8_WAIT_L(0); PG8_BAR; PG8_MMA(1, 0, At, B0); PG8_MMA(1, 1, At, B1); PG8_BAR; PG8_SCHED;
            } else {
            PG8_LDB(B0, 0, 0); PG8_SCHED; PG8_LDA(At, 0, 0); PG8_STAGE(PG8_SA(1, 1), a1 + hstep, voffA);
            PG8_WAIT_L(8); PG8_BAR; PG8_WAIT_L(0); PG8_MMA(0, 0, At, B0); PG8_BAR; PG8_SCHED;
            PG8_LDB(B1, 0, 1); PG8_STAGE(PG8_SB(0, 0), b2, voffB);
            PG8_BAR; PG8_WAIT_L(0); PG8_MMA(0, 1, At, B1); PG8_BAR;
            PG8_LDA(At, 0, 1); PG8_STAGE(PG8_SA(0, 0), a2, voffA);
            PG8_BAR; PG8_WAIT_L(0); PG8_MMA(1, 0, At, B0); PG8_BAR; PG8_SCHED;
            PG8_STAGE(PG8_SB(0, 1), b2 + hstep, voffB);
            PG8_WAIT_V(6); PG8_BAR; PG8_MMA(1, 1, At, B1); PG8_BAR;
            PG8_LDB(B0, 1, 0); PG8_SCHED; PG8_LDA(At, 1, 0); PG8_STAGE(PG8_SA(0, 1), a2 + hstep, voffA);
            PG8_WAIT_L(8); PG8_BAR; PG8_WAIT_L(0); PG8_MMA(0, 0, At, B0); PG8_BAR; PG8_SCHED;
            PG8_LDB(B1, 1, 1); PG8_STAGE(PG8_SB(1, 0), b3, voffB);
            PG8_BAR; PG8_WAIT_L(0); PG8_MMA(0, 1, At, B1); PG8_BAR;
            PG8_LDA(At, 1, 1); PG8_STAGE(PG8_SA(1, 0), a3, voffA);
            PG8_BAR; PG8_WAIT_L(0); PG8_MMA(1, 0, At, B0); PG8_BAR; PG8_SCHED;
            PG8_STAGE(PG8_SB(1, 1), b3 + hstep, voffB);
            PG8_WAIT_V(6); PG8_BAR; PG8_MMA(1, 1, At, B1); PG8_BAR;
            }
        }
        if constexpr (ALIGN_EPI) { if (wr == 0) PG8_BAR; }
        if constexpr (!Epi::AFTER_DRAIN) { E(acc, cur, wr, wc, fr, fq); S.done(cur); }
        if (!has_next) break;
#pragma unroll
        for (int a = 0; a < 2; ++a)
#pragma unroll
            for (int b = 0; b < 2; ++b)
#pragma unroll
                for (int m = 0; m < 4; ++m)
#pragma unroll
                    for (int n = 0; n < 2; ++n) acc[a][b][m][n] = (f32x4){0.f, 0.f, 0.f, 0.f};
        cur = nxt; cA = nA; cB = nB; ++ui;
        if constexpr (ALIGN_EPI) { if (wr == 1) PG8_BAR; }
    }
    PG8_WAIT_V(0);
    if constexpr (!ALIGN_EPI) { if (wr == 0) PG8_BAR; }
    PG8_BAR;
    if constexpr (Epi::AFTER_DRAIN) { E.fused(acc, cur, wr, wc, fr, fq, lds, wid, lane); S.done(cur); }
#undef PG8_SA
#undef PG8_SB
#undef PG8_STAGE
#undef PG8_LDA
#undef PG8_LDB
#undef PG8_MMA
#undef PG8_WAIT_V
#undef PG8_WAIT_L
#undef PG8_BAR
#undef PG8_SCHED
}
}
#include <hip/hip_bf16.h>
#include <cmath>
namespace attn_body {
using bf16=__hip_bfloat16;
using bf16x8=__attribute__((ext_vector_type(8)))short;
using s16x4=__attribute__((ext_vector_type(4)))short;
using f32x16=__attribute__((ext_vector_type(16)))float;
using u32x4=__attribute__((ext_vector_type(4)))unsigned;
constexpr int NHEAD=8,D=64,DM=NHEAD*D,OPITCH=1024;
constexpr int NW=8,QBLK=32,QB=QBLK*NW,KVBLK=64;
constexpr int ATTN_PITCH=DM, ATTN_UNIT_ROWS=QB;
__device__ __forceinline__ int crow(int r,int hi){return (r&3)+8*(r>>2)+4*hi;}
#define SBAR() __builtin_amdgcn_sched_barrier(0)
__device__ __forceinline__ void cmask(f32x16&p0,f32x16&p1,int jb,int qrel,int hi){
  const float NEG=-INFINITY; int kb=64*jb+4*hi;
  #pragma unroll
  for(int r=0;r<16;++r){int kv=kb+(r&3)+8*(r>>2); if(kv>qrel)p0[r]=NEG; if(kv+32>qrel)p1[r]=NEG;}
}

constexpr int NSLOT=3, SLOTB=8192;
constexpr int LDS_K=0, LDS_V=NSLOT*SLOTB, LDS_WS=2*NSLOT*SLOTB, LDS_OST=LDS_WS+NW*64*4, LDS_CB=LDS_OST+NW*4096, LDS_BYTES=LDS_CB+32768;
constexpr float C2=0.125f*1.4426950408889634f;
__device__ __forceinline__ void glds16(const void*gsrc,unsigned lds_dst){unsigned keep;
  asm volatile("s_mov_b32 %0, m0\n\ts_mov_b32 m0, %2\n\ts_nop 0\n\tglobal_load_lds_dwordx4 %1, off\n\ts_mov_b32 m0, %0":"=&s"(keep):"v"(gsrc),"s"(lds_dst):"memory");}
__device__ __forceinline__ float max3f(float a,float b,float c){float r;asm("v_max3_f32 %0, %1, %2, %3":"=v"(r):"v"(a),"v"(b),"v"(c));return r;}
__device__ __forceinline__ float max2f(float a,float b){float r;asm("v_max_f32_e32 %0, %1, %2":"=v"(r):"v"(a),"v"(b));return r;}
__device__ __forceinline__ float fadd_s(float a,float b){float r;asm("v_add_f32_e32 %0, %1, %2":"=v"(r):"v"(a),"v"(b));return r;}
__device__ __forceinline__ float fsub_s(float a,float b){float r;asm("v_sub_f32_e32 %0, %1, %2":"=v"(r):"v"(a),"v"(b));return r;}
typedef float f32x2_t __attribute__((ext_vector_type(2))); typedef float f32x4_t __attribute__((ext_vector_type(4))); typedef __bf16 bf16x2_t __attribute__((ext_vector_type(2)));
__device__ __forceinline__ unsigned cvtpk_s(float lo,float hi){f32x2_t v={lo,hi};bf16x2_t b=__builtin_convertvector(v,bf16x2_t);return __builtin_bit_cast(unsigned,b);}
#define WAIT_BAR(N) asm volatile("s_waitcnt vmcnt(" #N ") lgkmcnt(0)\n\ts_barrier":::"memory")

__device__ __forceinline__ void qkt(f32x16&p0,f32x16&p1,const char*Kslot,const bf16x8*qr,int r32,int hi){
  const char*kb=Kslot+hi*1024+r32*16;
  #pragma unroll
  for(int d0=0;d0<4;++d0){
    const bf16x8 b0=*reinterpret_cast<const bf16x8*>(kb+d0*2048);
    const bf16x8 b1=*reinterpret_cast<const bf16x8*>(kb+d0*2048+512);
    p0=__builtin_amdgcn_mfma_f32_32x32x16_bf16(b0,qr[d0],p0,0,0,0);p1=__builtin_amdgcn_mfma_f32_32x32x16_bf16(b1,qr[d0],p1,0,0,0);}
}
typedef __attribute__((address_space(3))) const char* lds_cptr;
typedef short v4i16_t __attribute__((ext_vector_type(4)));
__device__ __forceinline__ void kload8(bf16x8*kf,lds_cptr kp){
  kf[0]=*(const __attribute__((address_space(3))) bf16x8*)(kp);      kf[1]=*(const __attribute__((address_space(3))) bf16x8*)(kp+512);
  kf[2]=*(const __attribute__((address_space(3))) bf16x8*)(kp+2048); kf[3]=*(const __attribute__((address_space(3))) bf16x8*)(kp+2560);
  kf[4]=*(const __attribute__((address_space(3))) bf16x8*)(kp+4096); kf[5]=*(const __attribute__((address_space(3))) bf16x8*)(kp+4608);
  kf[6]=*(const __attribute__((address_space(3))) bf16x8*)(kp+6144); kf[7]=*(const __attribute__((address_space(3))) bf16x8*)(kp+6656);
}
__device__ __forceinline__ void kload2(bf16x8*kf,lds_cptr kp,int j){ kf[2*j]=*(const __attribute__((address_space(3))) bf16x8*)(kp+j*2048); kf[2*j+1]=*(const __attribute__((address_space(3))) bf16x8*)(kp+j*2048+512); }
__device__ __forceinline__ s16x4 vtr(lds_cptr p){ return __builtin_bit_cast(s16x4,__builtin_amdgcn_ds_read_tr16_b64_v4i16((__attribute__((address_space(3))) v4i16_t*)p)); }
__device__ __forceinline__ float rowmax(const f32x16&p0,const f32x16&p1){
  float a=max3f(p0[0],p0[1],p1[0]),b=max3f(p0[2],p0[3],p1[1]);a=max3f(a,p1[2],p1[3]);
  #pragma unroll
  for(int r=4;r<16;r+=4){a=max3f(a,p0[r],p0[r+1]);b=max3f(b,p0[r+2],p0[r+3]);a=max3f(a,p1[r],p1[r+1]);b=max3f(b,p1[r+2],p1[r+3]);}
  const float m=max2f(a,b);
  auto rr=__builtin_amdgcn_permlane32_swap(__float_as_uint(m),__float_as_uint(m),false,false);
  return max2f(__uint_as_float(rr[0]),__uint_as_float(rr[1]));
}
__device__ __forceinline__ void pv(f32x16*o,int vb,bf16x8 pa0,bf16x8 pa1,bf16x8 pa2,bf16x8 pa3){
  #pragma unroll
  for(int d0=0;d0<2;++d0){s16x4 lo[4],hi[4];
    #pragma unroll
    for(int ks=0;ks<4;++ks){
      asm volatile("ds_read_b64_tr_b16 %0,%1 offset:%c2":"=&v"(lo[ks]):"v"(vb),"i"(d0*4096+ks*1024):"memory");
      asm volatile("ds_read_b64_tr_b16 %0,%1 offset:%c2":"=&v"(hi[ks]):"v"(vb),"i"(d0*4096+ks*1024+512):"memory");}
    asm volatile("s_waitcnt lgkmcnt(0)":::"memory");SBAR();
    #define PK(k) (bf16x8){lo[k][0],lo[k][1],lo[k][2],lo[k][3],hi[k][0],hi[k][1],hi[k][2],hi[k][3]}
    o[d0]=__builtin_amdgcn_mfma_f32_32x32x16_bf16(pa0,PK(0),o[d0],0,0,0);
    o[d0]=__builtin_amdgcn_mfma_f32_32x32x16_bf16(pa1,PK(1),o[d0],0,0,0);
    o[d0]=__builtin_amdgcn_mfma_f32_32x32x16_bf16(pa2,PK(2),o[d0],0,0,0);
    o[d0]=__builtin_amdgcn_mfma_f32_32x32x16_bf16(pa3,PK(3),o[d0],0,0,0);
    #undef PK
  }
}

#ifndef ATTN_STORE16
#define ATTN_STORE16(p,v) (*(u32x4*)(p)=(v))
#endif
template<int THRL> __device__ __forceinline__ void attn_unit(const bf16*Qb,const bf16*__restrict__ Kh,const bf16*__restrict__ Vh,bf16*Ob,int NT,int NTE,const float*cgp,int q0,int wlo,int whi,char*shm){
  int tid_=threadIdx.x; asm volatile("":"+v"(tid_)); const int tid=tid_,lane=tid&63,r32=lane&31,hi=lane>>5; const int wid=__builtin_amdgcn_readfirstlane(tid>>6);
  const bf16*Qw=Qb+(long)(wid*QBLK)*DM;
  const unsigned lds0=(unsigned)(uintptr_t)shm;
  float*wsf=(float*)(shm+LDS_WS)+wid*64;
  const bf16*ksrc=Kh+(long)((NT-1)*KVBLK+lane)*DM+wid*8;
  const bf16*vsrc=Vh+(long)((NT-1)*KVBLK+16*(wid&3)+(lane>>2))*DM+(wid>>2)*32+(lane&3)*8;
  const unsigned kdst=lds0+LDS_K+wid*1024, vdst=lds0+LDS_V+wid*1024;
  #define DMA_K(t,slot) glds16(ksrc-(long)(t)*KVBLK*DM,(unsigned)__builtin_amdgcn_readfirstlane(kdst+(slot)))
  #define DMA_V(t,slot) glds16(vsrc-(long)(t)*KVBLK*DM,(unsigned)__builtin_amdgcn_readfirstlane(vdst+(slot)))
  const int vb0=(int)(lds0+LDS_V)+((lane>>4)&1)*32+(lane&3)*8+(4*hi+((lane&15)>>2))*64;
  const char*Kbase=shm+LDS_K; bf16x8 kf[8];
  const lds_cptr shm3=(lds_cptr)shm; const lds_cptr kp0=shm3+LDS_K+hi*1024+r32*16; const lds_cptr vp0=shm3+LDS_V+((lane>>4)&1)*32+(lane&3)*8+(4*hi+((lane&15)>>2))*64;
  { typedef __attribute__((address_space(3))) float lf_t; lf_t* cbw=(lf_t*)((lds_cptr)shm+LDS_CB); const float c0=cgp[q0]; const int jlo=(NT-NTE)*KVBLK, jhi=NT*KVBLK;
    for(int j=jlo+tid;j<jhi;j+=NW*64) cbw[j]=c0-cgp[j]; }
  const __attribute__((address_space(3))) float* cbL=(const __attribute__((address_space(3))) float*)((lds_cptr)shm+LDS_CB)+4*hi;
  #define CBLOAD(C0,C1,t,MH) do{ const __attribute__((address_space(3))) float* cbp_=cbL+(NT-1-(t))*KVBLK; \
    _Pragma("unroll") for(int g_=0;g_<4;++g_){ const f32x4_t v0_=*(const __attribute__((address_space(3))) f32x4_t*)(cbp_+8*g_); const f32x4_t v1_=*(const __attribute__((address_space(3))) f32x4_t*)(cbp_+32+8*g_); \
      C0[4*g_]=v0_[0]-(MH);C0[4*g_+1]=v0_[1]-(MH);C0[4*g_+2]=v0_[2]-(MH);C0[4*g_+3]=v0_[3]-(MH); C1[4*g_]=v1_[0]-(MH);C1[4*g_+1]=v1_[1]-(MH);C1[4*g_+2]=v1_[2]-(MH);C1[4*g_+3]=v1_[3]-(MH);} }while(0)
  DMA_K(0,0);DMA_V(0,0);DMA_K(1,SLOTB);
  bf16x8 qr[4];
  #pragma unroll
  for(int d0=0;d0<4;++d0)qr[d0]=*reinterpret_cast<const bf16x8*>(&Qw[(long)r32*DM+d0*16+hi*8]);
  float mhat=0.f,l_reg=0.f;f32x16 o[2];o[0]=f32x16{};o[1]=f32x16{};
  const int qrel=wid*QBLK+r32;
  #define CMASK(P0,P1,t) do{int jb_=3-(t); if(jb_>=0)cmask(P0,P1,jb_,qrel,hi);}while(0)
  bool resc=false;
  #define START(P0,P1) do{ const float rm=rowmax(P0,P1); resc=false; \
    { const float dl=(rm>-1e30f)?rm:0.f; mhat=fadd_s(mhat,dl); \
      _Pragma("unroll") for(int r=0;r<16;++r){P0[r]=fsub_s(P0[r],dl);P1[r]=fsub_s(P1[r],dl);} } \
    _Pragma("unroll") for(int r=0;r<16;++r)P0[r]=__builtin_amdgcn_exp2f(P0[r]); }while(0)
  #define RESC() do{ if(resc){ asm volatile("s_waitcnt lgkmcnt(0)":::"memory"); \
      _Pragma("unroll") for(int d_=0;d_<2;++d_) _Pragma("unroll") for(int r=0;r<16;++r)o[d_][r]*=wsf[crow(r,hi)]; } }while(0)
  f32x16 pA0,pA1,pB0,pB1;
  int sl_prev=0,sl_cur=0,sl_next=SLOTB;
  #define ROT() do{sl_prev=sl_cur;sl_cur=sl_next;sl_next=(sl_next==(NSLOT-1)*SLOTB)?0:sl_next+SLOTB;}while(0)
  DMA_K(2,2*SLOTB);
  WAIT_BAR(3);
  CBLOAD(pA0,pA1,0,0.f); qkt(pA0,pA1,Kbase,qr,r32,hi);asm volatile("s_nop 15\n\ts_nop 7":"+v"(pA0),"+v"(pA1));CMASK(pA0,pA1,0);
  START(pA0,pA1);
  _Pragma("unroll") for(int r=0;r<16;++r)pA1[r]=__builtin_amdgcn_exp2f(pA1[r]);
  WAIT_BAR(0);
  DMA_K(3,0);DMA_V(1,SLOTB);
  ROT();
  kload8(kf,kp0+sl_cur);
  WAIT_BAR(2);
  s16x4 vlo[8],vhi[8]; u32x4 pw0,pw1,pw2,pw3;
  #define PKW(P,B) cvtpk_s(P[B],P[B+1])
  #define PAF(k) __builtin_bit_cast(bf16x8,pw##k)
  #define VFR(i) (bf16x8){vlo[i][0],vlo[i][1],vlo[i][2],vlo[i][3],vhi[i][0],vhi[i][1],vhi[i][2],vhi[i][3]}
  #define PIN(x) asm volatile("":"+v"(x))
  #define MX3(a,b,c) __builtin_fmaxf(__builtin_fmaxf((a),(b)),(c))
  #define GAPA(MF,A0,A1,A2,A3,W0,W1,PW) do{ MF; sacc+=A0; sacc+=A1; sacc+=A2; sacc+=A3; PIN(sacc); W0; W1; PIN(PW); SBAR(); }while(0)
  #define EX(v) __builtin_amdgcn_exp2f(v)
  #define GAPB(MF,X,B) do{ MF; X[B]=EX(X[B]); X[B+1]=EX(X[B+1]); X[B+2]=EX(X[B+2]); X[B+3]=EX(X[B+3]); PIN(X); SBAR(); }while(0)
  #define VRD(i) do{ vlo[i]=vtr(vp_+(((i)>>2)*4096+((i)&3)*1024)); vhi[i]=vtr(vp_+(((i)>>2)*4096+((i)&3)*1024+512)); }while(0)
  #define KRD(G,j) do{ if(G){ kload2(kf,kp0+sl_next,j); SBAR(); } }while(0)
  #define STEP(C0,C1,P0,P1,t,GK,GV,GL) do{ SBAR(); \
    const lds_cptr vp_=vp0+sl_prev; CBLOAD(C0,C1,t,mhat); SBAR(); \
    VRD(0); SBAR(); float sacc=(P0[0]+P0[1]); \
    GAPA(C0=__builtin_amdgcn_mfma_f32_32x32x16_bf16(kf[0],qr[0],C0,0,0,0), P0[2],P0[3],P0[4],P0[5],     pw0[0]=PKW(P0,0), pw0[1]=PKW(P0,2), pw0); \
    VRD(4); SBAR(); GAPA(C1=__builtin_amdgcn_mfma_f32_32x32x16_bf16(kf[1],qr[0],C1,0,0,0), P0[6],P0[7],P0[8],P0[9],     pw0[2]=PKW(P0,4), pw0[3]=PKW(P0,6), pw0); \
    VRD(1); SBAR(); GAPA(C0=__builtin_amdgcn_mfma_f32_32x32x16_bf16(kf[2],qr[1],C0,0,0,0),   P0[10],P0[11],P0[12],P0[13], pw1[0]=PKW(P0,8), pw1[1]=PKW(P0,10), pw1); \
    VRD(5); SBAR(); GAPA(C1=__builtin_amdgcn_mfma_f32_32x32x16_bf16(kf[3],qr[1],C1,0,0,0),   P0[14],P0[15],P1[0],P1[1],   pw1[2]=PKW(P0,12),pw1[3]=PKW(P0,14), pw1); \
    VRD(2); SBAR(); GAPA(C0=__builtin_amdgcn_mfma_f32_32x32x16_bf16(kf[4],qr[2],C0,0,0,0),   P1[2],P1[3],P1[4],P1[5],     pw2[0]=PKW(P1,0), pw2[1]=PKW(P1,2), pw2); \
    VRD(6); SBAR(); GAPA(C1=__builtin_amdgcn_mfma_f32_32x32x16_bf16(kf[5],qr[2],C1,0,0,0),   P1[6],P1[7],P1[8],P1[9],     pw2[2]=PKW(P1,4), pw2[3]=PKW(P1,6), pw2); \
    VRD(3); SBAR(); GAPA(C0=__builtin_amdgcn_mfma_f32_32x32x16_bf16(kf[6],qr[3],C0,0,0,0),   P1[10],P1[11],P1[12],P1[13], pw3[0]=PKW(P1,8), pw3[1]=PKW(P1,10), pw3); \
    VRD(7); SBAR(); GAPA(C1=__builtin_amdgcn_mfma_f32_32x32x16_bf16(kf[7],qr[3],C1,0,0,0),   P1[14],P1[15],0.f,0.f,       pw3[2]=PKW(P1,12),pw3[3]=PKW(P1,14), pw3); \
    l_reg+=sacc; \
    if(GK){DMA_K((t)+3,sl_cur);} if(GV){DMA_V((t)+1,sl_next);} \
    CMASK(C0,C1,t); \
    { float a=MX3(C0[0],C0[1],C1[0]),b=MX3(C0[2],C0[3],C1[1]); a=MX3(a,C1[2],C1[3]); \
      _Pragma("unroll") for(int r=4;r<16;r+=4){a=MX3(a,C0[r],C0[r+1]);b=MX3(b,C0[r+2],C0[r+3]);a=MX3(a,C1[r],C1[r+1]);b=MX3(b,C1[r+2],C1[r+3]);} \
      float rm=__builtin_fmaxf(a,b); { auto rr=__builtin_amdgcn_permlane32_swap(__float_as_uint(rm),__float_as_uint(rm),false,false); rm=__builtin_fmaxf(__uint_as_float(rr[0]),__uint_as_float(rr[1])); } \
      resc=false; \
      if(__builtin_expect(__any(rm>(float)THRL),0)){ const float dl=__builtin_fmaxf(rm,0.f); mhat+=dl; \
        _Pragma("unroll") for(int r=0;r<16;++r){C0[r]-=dl;C1[r]-=dl;} \
        const float f=__builtin_amdgcn_exp2f(-dl); l_reg*=f; if(hi==0)wsf[r32]=f; resc=true; } } \
    SBAR(); \
    GAPB(o[0]=__builtin_amdgcn_mfma_f32_32x32x16_bf16(PAF(0),VFR(0),o[0],0,0,0), C0,0); \
    GAPB(o[1]=__builtin_amdgcn_mfma_f32_32x32x16_bf16(PAF(0),VFR(4),o[1],0,0,0), C0,4); \
    KRD(GL,0); GAPB(o[0]=__builtin_amdgcn_mfma_f32_32x32x16_bf16(PAF(1),VFR(1),o[0],0,0,0), C0,8); \
    KRD(GL,1); GAPB(o[1]=__builtin_amdgcn_mfma_f32_32x32x16_bf16(PAF(1),VFR(5),o[1],0,0,0), C0,12); \
    KRD(GL,2); GAPB(o[0]=__builtin_amdgcn_mfma_f32_32x32x16_bf16(PAF(2),VFR(2),o[0],0,0,0), C1,0); \
    KRD(GL,3); GAPB(o[1]=__builtin_amdgcn_mfma_f32_32x32x16_bf16(PAF(2),VFR(6),o[1],0,0,0), C1,4); \
    GAPB(o[0]=__builtin_amdgcn_mfma_f32_32x32x16_bf16(PAF(3),VFR(3),o[0],0,0,0), C1,8); \
    GAPB(o[1]=__builtin_amdgcn_mfma_f32_32x32x16_bf16(PAF(3),VFR(7),o[1],0,0,0), C1,12); \
    }while(0)
  int t=1;
  for(;t<5&&t+5<NTE;t+=2){
    STEP(pB0,pB1,pA0,pA1,t,true,true,true);     WAIT_BAR(2); RESC(); ROT();
    STEP(pA0,pA1,pB0,pB1,t+1,true,true,true);   WAIT_BAR(2); RESC(); ROT();
  }
  #undef CMASK
  #define CMASK(P0,P1,t) do{}while(0)
  for(;t+5<NTE;t+=2){
    STEP(pB0,pB1,pA0,pA1,t,true,true,true);     WAIT_BAR(2); RESC(); ROT();
    STEP(pA0,pA1,pB0,pB1,t+1,true,true,true);   WAIT_BAR(2); RESC(); ROT();
  }
  #undef CMASK
  #define CMASK(P0,P1,t) do{int jb_=3-(t); if(jb_>=0)cmask(P0,P1,jb_,qrel,hi);}while(0)
  #define ENDW(tt) do{ if((tt)+3<NTE){WAIT_BAR(2);} else if((tt)+2<NTE){WAIT_BAR(1);} else {WAIT_BAR(0);} }while(0)
  for(;t+1<NTE;t+=2){
    STEP(pB0,pB1,pA0,pA1,t,(t+3<NTE),(t+1<NTE),(t+1<NTE));       ENDW(t);   RESC(); ROT();
    STEP(pA0,pA1,pB0,pB1,t+1,(t+4<NTE),(t+2<NTE),(t+2<NTE));     ENDW(t+1); RESC(); ROT();
  }
  STEP(pB0,pB1,pA0,pA1,NTE-1,false,false,false); RESC();
  { float sacc=pB0[0]+pB0[1]; _Pragma("unroll") for(int r=2;r<16;++r)sacc+=pB0[r]; _Pragma("unroll") for(int r=0;r<16;++r)sacc+=pB1[r]; l_reg+=sacc;
    pw0=(u32x4){PKW(pB0,0),PKW(pB0,2),PKW(pB0,4),PKW(pB0,6)};pw1=(u32x4){PKW(pB0,8),PKW(pB0,10),PKW(pB0,12),PKW(pB0,14)};pw2=(u32x4){PKW(pB1,0),PKW(pB1,2),PKW(pB1,4),PKW(pB1,6)};pw3=(u32x4){PKW(pB1,8),PKW(pB1,10),PKW(pB1,12),PKW(pB1,14)};
    SBAR(); pv(o,vb0+sl_cur,PAF(0),PAF(1),PAF(2),PAF(3)); }
  #undef PKW
  #undef PAF
  #undef VFR
  #undef PIN
  #undef MX3
  #undef GAPA
  #undef GAPB
  #undef EX
  #undef VRD
  #undef KRD
  #undef STEP
  #undef ENDW
  {auto rr=__builtin_amdgcn_permlane32_swap(__float_as_uint(l_reg),__float_as_uint(l_reg),false,false);l_reg=__uint_as_float(rr[0])+__uint_as_float(rr[1]);}
  if(hi==0)wsf[32+r32]=l_reg;asm volatile("s_waitcnt lgkmcnt(0)":::"memory");
  float rli[16];
  #pragma unroll
  for(int r=0;r<16;++r)rli[r]=__builtin_amdgcn_rcpf(wsf[32+crow(r,hi)]);
  bf16*Ow=Ob+(long)(wid*QBLK)*OPITCH;
  { bf16*stg=(bf16*)(shm+LDS_OST)+wid*2048;
    #pragma unroll
    for(int r=0;r<16;++r){const int orow=crow(r,hi);
      #pragma unroll
      for(int d0=0;d0<2;++d0)stg[orow*64+d0*32+r32]=__float2bfloat16(o[d0][r]*rli[r]);}
    asm volatile("s_waitcnt lgkmcnt(0)":::"memory");
    #pragma unroll
    for(int i=0;i<4;++i){const int row=i*8+(lane>>3),ch=lane&7; const u32x4 v=*(const u32x4*)(stg+row*64+ch*8); if(wid>=wlo&&wid<whi)ATTN_STORE16(Ow+(long)row*OPITCH+ch*8,v);} }
  asm volatile("s_waitcnt lgkmcnt(0)\n\ts_barrier":::"memory");
  #undef DMA_K
  #undef DMA_V
  #undef CMASK
  #undef START
  #undef RESC
  #undef ROT
  #undef CBLOAD
}
constexpr int ATTN_LDS_BYTES=LDS_BYTES;
#undef SBAR
#undef WAIT_BAR
}
#include <hip/hip_cooperative_groups.h>
namespace cg = cooperative_groups;
#ifndef MK_N_LAUNCHES
#define MK_N_LAUNCHES 6
#endif
#ifndef FOX_PRUNE
#define FOX_PRUNE 0
#endif
constexpr int NWAVES = 8, NTHR = 512;
constexpr int DMOD = 1024, TSEQ = 8192, NBATCH = 8, MP = NBATCH * TSEQ, MS = 512, MTOT = MP + MS;
constexpr int NIN = 3584, INC = 3592, FF = 4096, SSEQ = 1152, PAST = 1024, DSEQ = 32;
constexpr int NCHUNK = MTOT / 64;
constexpr float EPSN = 1e-6f, LOG2E = 1.4426950408889634f;
constexpr size_t MiB = 1u << 20;
constexpr size_t WS_CTL = 0, CTL_ZERO_BYTES = 4096;
constexpr size_t WS_WIN = 2 * MiB, WS_WO = 9 * MiB, WS_WUP = 11 * MiB, WS_WDN = 19 * MiB;
constexpr size_t WS_RSTD = 27 * MiB, WS_CGP = 28 * MiB, WS_CGS = 30 * MiB, WS_VEC = 31 * MiB, WS_SSQ = 38 * MiB;
constexpr size_t WS_X1B = 44 * MiB, WS_MIX = 174 * MiB, WS_H = 304 * MiB;
constexpr size_t WS_XB = 304 * MiB, WS_Q = 434 * MiB, WS_K = 498 * MiB, WS_V = 562 * MiB, WS_QS = 626 * MiB, WS_KS = 635 * MiB, WS_VS = 644 * MiB;
constexpr size_t WS_QR = 654 * MiB, WS_KR = 719 * MiB, WS_VH = 784 * MiB, WS_SG = 849 * MiB, WS_END = 914 * MiB;
constexpr size_t VECN = (size_t)NCHUNK * 512;
static_assert(WS_VEC + 3 * VECN * 4 <= WS_SSQ && WS_SSQ + (size_t)MTOT * 16 * 4 <= WS_X1B && WS_X1B + (size_t)MTOT * DMOD * 2 <= WS_MIX && WS_MIX + (size_t)MTOT * DMOD * 2 <= WS_H, "ws map");
static_assert(WS_H + (size_t)MTOT * FF * 2 <= WS_END && WS_XB + (size_t)MTOT * DMOD * 2 <= WS_Q && WS_SG + (size_t)MTOT * 512 * 2 <= WS_END, "ws map 2");
constexpr int CW_QUEUE = 64;
constexpr size_t O_YP = 0, O_YS = O_YP + (size_t)MP * DMOD, O_KP = O_YS + (size_t)256 * DMOD, O_VP = O_KP + (size_t)MP * 512, O_LP = O_VP + (size_t)MP * 512,
                 O_HP = O_LP + (size_t)MP * 8, O_KS = O_HP + 524288, O_VS = O_KS + 131072, O_LS = O_VS + 131072, O_HS = O_LS + 2048, O_END = O_HS + 524288;
constexpr int RING_BYTES = 131072, MISC_OFF = RING_BYTES, LDS_BYTES = 135168;
static_assert(attn_body::ATTN_LDS_BYTES <= RING_BYTES, "attention LDS");

#define LAS __attribute__((address_space(3)))
typedef unsigned short bf16;
typedef unsigned v4u __attribute__((ext_vector_type(4)));
typedef unsigned v2u __attribute__((ext_vector_type(2)));
typedef float f32x4 __attribute__((ext_vector_type(4)));
typedef short bf16x8 __attribute__((ext_vector_type(8)));
#define LDS_WAIT() asm volatile("s_waitcnt lgkmcnt(0)" ::: "memory")
__device__ __forceinline__ unsigned pk2(float lo, float hi) { return pg8::cvt_pk_bf16(lo, hi); }
__device__ __forceinline__ float bf2f(unsigned short b) { return __uint_as_float(((unsigned)b) << 16); }
__device__ __forceinline__ float wave_sum(float v) {
#pragma unroll
    for (int o = 1; o < 64; o <<= 1) v += __shfl_xor(v, o);
    return v;
}
__device__ __forceinline__ bool row_map(int row, int& idx) { if (row < MP) { idx = row; return true; } const int rs = row - MP; idx = (rs >> 6) * 32 + (rs & 63); return (rs & 63) < 32; }

namespace pg8 {
#define DPP_SHR(v, n) __int_as_float(__builtin_amdgcn_update_dpp(0, __float_as_int(v), 0x110 + (n), 0xf, 0xf, false))
struct EpiIn {
    static constexpr bool PERM = false, AFTER_DRAIN = false;
    const float* rstd1; const float* lbl; const float* qg; const float* kg; unsigned char* ws; float* out;
    __device__ __forceinline__ void operator()(const f32x4 (&acc)[2][2][4][2], const Unit& u, int wr, int wc, int fr, int fq) const {
        const int pn = u.pn, rowb = u.pm * BM + wr * 64 + fr; const bool samp = u.pm >= (MP / BM);
        bf16_t* const QR = (bf16_t*)(ws + WS_QR); bf16_t* const KR = (bf16_t*)(ws + WS_KR); bf16_t* const VH = (bf16_t*)(ws + WS_VH); bf16_t* const SG = (bf16_t*)(ws + WS_SG); float* const vec = (float*)(ws + WS_VEC);
        float rs[2][4];
#pragma unroll
        for (int ai = 0; ai < 2; ++ai)
#pragma unroll
            for (int m = 0; m < 4; ++m) rs[ai][m] = rstd1[rowb + ai * HALF + m * 16];
        if (pn < 4) {
            const int h = pn, ch0 = 128 * h + 32 * wc + 4 * fq; const int lane = threadIdx.x & 63; const int a15 = ((lane & 48) | 15) << 2, a0 = (lane & 48) << 2;
#pragma unroll
            for (int n = 0; n < 2; ++n) {
                const f32x4 l0 = *(const f32x4*)(lbl + ch0 + 16 * n), l1 = *(const f32x4*)(lbl + 512 + ch0 + 16 * n);
                f32x4 lb, omlb;
#pragma unroll
                for (int j = 0; j < 4; ++j) { lb[j] = 1.f / (1.f + __expf(l1[j] - l0[j])); omlb[j] = 1.f - lb[j]; }
#pragma unroll
                for (int ai = 0; ai < 2; ++ai) {
                    f32x4 bq[4], kk[4], bb[4]; f32x4 carry = {0.f, 0.f, 0.f, 0.f};
#pragma unroll
                    for (int m = 0; m < 4; ++m) {
#pragma unroll
                        for (int j = 0; j < 4; ++j) {
                            const float zq = acc[ai][0][m][n][j] * rs[ai][m], zf = acc[ai][1][m][n][j] * rs[ai][m];
                            const float sig = 1.f / (1.f + __expf(-zf)); const float f = lb[j] + omlb[j] * sig; float k = omlb[j] * (1.f - sig); float s = __logf(f);
                            if (samp && m >= 2) { s = 0.f; k = 0.f; }
                            s += DPP_SHR(s, 1); s += DPP_SHR(s, 2); s += DPP_SHR(s, 4); s += DPP_SHR(s, 8);
                            s += carry[j]; carry[j] = __int_as_float(__builtin_amdgcn_ds_bpermute(a15, __float_as_int(s)));
                            bq[m][j] = zq; kk[m][j] = k; bb[m][j] = s;
                        }
                    }
                    f32x4 bref;
#pragma unroll
                    for (int j = 0; j < 4; ++j) bref[j] = __int_as_float(__builtin_amdgcn_ds_bpermute(a0, __float_as_int(bb[2][j])));
#pragma unroll
                    for (int m = 0; m < 4; ++m) {
                        float qv[4], kv[4];
#pragma unroll
                        for (int j = 0; j < 4; ++j) { qv[j] = bq[m][j] * __expf(bb[m][j] - bref[j]); kv[j] = kk[m][j] * __expf(bref[j] - bb[m][j]); }
                        const size_t off = (size_t)(rowb + ai * HALF + m * 16) * 512 + ch0 + 16 * n;
                        v2u wq; wq.x = cvt_pk_bf16(qv[0], qv[1]); wq.y = cvt_pk_bf16(qv[2], qv[3]); *(v2u*)(QR + off) = wq;
                        v2u wk; wk.x = cvt_pk_bf16(kv[0], kv[1]); wk.y = cvt_pk_bf16(kv[2], kv[3]); *(v2u*)(KR + off) = wk;
                    }
                    if (fr == 0) {
                        const size_t voff = (size_t)((u.pm * BM + ai * HALF + wr * 64) >> 6) * 512 + ch0 + 16 * n;
                        f32x4 e, d, g;
#pragma unroll
                        for (int j = 0; j < 4; ++j) { e[j] = __expf(bref[j]); d[j] = __expf(carry[j]); g[j] = __expf(carry[j] - bref[j]); }
                        *(f32x4*)(vec + voff) = e; *(f32x4*)(vec + VECN + voff) = d; *(f32x4*)(vec + 2 * VECN + voff) = g;
                    }
                }
            }
        } else if (pn < 8) {
            const int h = pn - 4, c0 = 128 * h + 32 * wc + 4 * fq;
#pragma unroll
            for (int ai = 0; ai < 2; ++ai)
#pragma unroll
                for (int m = 0; m < 4; ++m) { const size_t off = (size_t)(rowb + ai * HALF + m * 16) * 512 + c0; const float r = rs[ai][m];
#pragma unroll
                    for (int n = 0; n < 2; ++n) { const f32x4 v = acc[ai][0][m][n] * r; f32x4 g = acc[ai][1][m][n] * r;
#pragma unroll
                        for (int j = 0; j < 4; ++j) g[j] = g[j] / (1.f + __expf(-g[j]));
                        v2u wv; wv.x = cvt_pk_bf16(v[0], v[1]); wv.y = cvt_pk_bf16(v[2], v[3]); *(v2u*)(VH + off + 16 * n) = wv;
                        v2u wg; wg.x = cvt_pk_bf16(g[0], g[1]); wg.y = cvt_pk_bf16(g[2], g[3]); *(v2u*)(SG + off + 16 * n) = wg; } }
        } else if (pn < 12) {
            const bool isK = pn >= 10; const int head = 4 * ((pn - 8) & 1) + wc; const float* gain = isK ? kg : qg; const float osc = isK ? 1.f : attn_body::C2;
            f32x4 gv[2][2];
#pragma unroll
            for (int bj = 0; bj < 2; ++bj)
#pragma unroll
                for (int n = 0; n < 2; ++n) gv[bj][n] = *(const f32x4*)(gain + 32 * bj + 16 * n + 4 * fq) * osc;
#pragma unroll
            for (int ai = 0; ai < 2; ++ai)
#pragma unroll
                for (int m = 0; m < 4; ++m) { const int row = rowb + ai * HALF + m * 16; const float r = rs[ai][m]; float ssq = 0.f;
#pragma unroll
                    for (int bj = 0; bj < 2; ++bj)
#pragma unroll
                        for (int n = 0; n < 2; ++n) { const f32x4 z = acc[ai][bj][m][n] * r; ssq += (z[0] * z[0] + z[1] * z[1]) + (z[2] * z[2] + z[3] * z[3]); }
                    ssq += __shfl_xor(ssq, 16); ssq += __shfl_xor(ssq, 32);
                    const float r2 = r / sqrtf(ssq * (1.f / 64.f) + EPSN);
                    int idx; const bool valid = row_map(row, idx);
                    float* ofp = out + (samp ? O_KS : O_KP) + (size_t)idx * 512;
                    const size_t boff = samp ? (isK ? WS_KS : WS_QS) : (isK ? WS_K : WS_Q); const size_t brow = samp ? (size_t)((idx >> 5) * SSEQ + PAST + (idx & 31)) : (size_t)row;
                    bf16_t* bfp = (bf16_t*)(ws + boff) + brow * 512;
                    if (valid) {
#pragma unroll
                        for (int bj = 0; bj < 2; ++bj)
#pragma unroll
                            for (int n = 0; n < 2; ++n) { const f32x4 v = acc[ai][bj][m][n] * r2 * gv[bj][n]; const int col = 64 * head + 32 * bj + 16 * n + 4 * fq;
                                if (isK) *(f32x4*)(ofp + col) = v;
                                v2u w; w.x = cvt_pk_bf16(v[0], v[1]); w.y = cvt_pk_bf16(v[2], v[3]); *(v2u*)(bfp + col) = w; } } }
        } else {
            const int c0 = 256 * (pn - 12) + 32 * wc + 4 * fq;
#pragma unroll
            for (int ai = 0; ai < 2; ++ai)
#pragma unroll
                for (int m = 0; m < 4; ++m) { const int row = rowb + ai * HALF + m * 16; const float r = rs[ai][m];
                    int idx; const bool valid = row_map(row, idx);
                    float* ofp = out + (samp ? O_VS : O_VP) + (size_t)idx * 512;
                    const size_t brow = samp ? (size_t)((idx >> 5) * SSEQ + PAST + (idx & 31)) : (size_t)row;
                    bf16_t* bfp = (bf16_t*)(ws + (samp ? WS_VS : WS_V)) + brow * 512;
                    if (valid) {
#pragma unroll
                        for (int bj = 0; bj < 2; ++bj)
#pragma unroll
                            for (int n = 0; n < 2; ++n) { const f32x4 v = acc[ai][bj][m][n] * r; const int col = c0 + 128 * bj + 16 * n;
                                *(f32x4*)(ofp + col) = v;
                                v2u w; w.x = cvt_pk_bf16(v[0], v[1]); w.y = cvt_pk_bf16(v[2], v[3]); *(v2u*)(bfp + col) = w; } } }
        }
    }
};
struct EpiWo {
    static constexpr bool PERM = false, AFTER_DRAIN = false;
    const float* xp; const float* xs; float* yp; float* ys; bf16_t* X1B; float* ssq;
    __device__ __forceinline__ void operator()(const f32x4 (&acc)[2][2][4][2], const Unit& u, int wr, int wc, int fr, int fq) const {
        const int rowb = u.pm * BM + wr * 64 + fr, c0 = u.pn * BM + wc * 32 + 4 * fq; const bool samp = u.pm >= (MP / BM);
#pragma unroll
        for (int ai = 0; ai < 2; ++ai)
#pragma unroll
            for (int m = 0; m < 4; ++m) { const int row = rowb + ai * HALF + m * 16; int idx; const bool valid = row_map(row, idx);
                const float* xr = (samp ? xs : xp) + (size_t)idx * DMOD; float* yr = yp + (samp ? (size_t)MP * DMOD : (size_t)0) + (size_t)idx * DMOD; float s = 0.f;
#pragma unroll
                for (int bj = 0; bj < 2; ++bj)
#pragma unroll
                    for (int n = 0; n < 2; ++n) { const int col = c0 + 128 * bj + 16 * n; f32x4 v = acc[ai][bj][m][n];
                        if (valid) { v += *(const f32x4*)(xr + col); *(f32x4*)(yr + col) = v; }
                        s += (v[0] * v[0] + v[1] * v[1]) + (v[2] * v[2] + v[3] * v[3]);
                        v2u w; w.x = cvt_pk_bf16(v[0], v[1]); w.y = cvt_pk_bf16(v[2], v[3]); *(v2u*)(X1B + (size_t)row * DMOD + col) = w; }
                s += __shfl_xor(s, 16); s += __shfl_xor(s, 32);
                if (fq == 0) ssq[(size_t)row * 16 + 4 * u.pn + wc] = s; }
    }
};
struct EpiUp {
    static constexpr bool PERM = true, AFTER_DRAIN = false;
    bf16_t* O; const float* ssq;
    __device__ __forceinline__ void operator()(const f32x4 (&acc)[2][2][4][2], const Unit& u, int wr, int wc, int fr, int fq) const {
        const int row0 = u.pm * BM + wr * 64 + fr, col0 = u.pn * BM + wc * 32 + 8 * fq;
#pragma unroll
        for (int ai = 0; ai < 2; ++ai)
#pragma unroll
            for (int m = 0; m < 4; ++m) { const int row = row0 + ai * HALF + m * 16; const f32x4* sp = (const f32x4*)(ssq + (size_t)row * 16);
                const f32x4 s0 = sp[0], s1 = sp[1], s2 = sp[2], s3 = sp[3]; const f32x4 st = (s0 + s1) + (s2 + s3);
                const float r = 1.f / sqrtf(((st[0] + st[1]) + (st[2] + st[3])) * (1.f / DMOD) + EPSN);
                bf16_t* rowp = O + (size_t)row * FF + col0;
#pragma unroll
                for (int bj = 0; bj < 2; ++bj) { f32x4 v0 = acc[ai][bj][m][0] * r, v1 = acc[ai][bj][m][1] * r;
#pragma unroll
                    for (int j = 0; j < 4; ++j) { v0[j] = fmaxf(v0[j], 0.f); v0[j] *= v0[j]; v1[j] = fmaxf(v1[j], 0.f); v1[j] *= v1[j]; }
                    u32x4 w; w.x = cvt_pk_bf16(v0[0], v0[1]); w.y = cvt_pk_bf16(v0[2], v0[3]); w.z = cvt_pk_bf16(v1[0], v1[1]); w.w = cvt_pk_bf16(v1[2], v1[3]);
                    *(u32x4*)(rowp + bj * HALF) = w; } }
    }
};
struct EpiDown {
    static constexpr bool PERM = false, AFTER_DRAIN = false;
    float* yp; float* ys;
    __device__ __forceinline__ void operator()(const f32x4 (&acc)[2][2][4][2], const Unit& u, int wr, int wc, int fr, int fq) const {
        const int rowb = u.pm * BM + wr * 64 + fr, c0 = u.pn * BM + wc * 32 + 4 * fq; const bool samp = u.pm >= (MP / BM);
#pragma unroll
        for (int ai = 0; ai < 2; ++ai)
#pragma unroll
            for (int m = 0; m < 4; ++m) { const int row = rowb + ai * HALF + m * 16; int idx; const bool valid = row_map(row, idx);
                float* yr = yp + (samp ? (size_t)MP * DMOD : (size_t)0) + (size_t)idx * DMOD;
                if (valid) {
#pragma unroll
                    for (int bj = 0; bj < 2; ++bj)
#pragma unroll
                        for (int n = 0; n < 2; ++n) { const int col = c0 + 128 * bj + 16 * n; *(f32x4*)(yr + col) = *(const f32x4*)(yr + col) + acc[ai][bj][m][n]; } } }
    }
};
}

struct Args { const float* in[17]; float* out; unsigned char* ws; int ph_lo, ph_hi; };
struct Frame {
    LAS unsigned char* lds; volatile LAS unsigned* MISC; unsigned* ctl; unsigned char* ws; float* out;
    int tid, lane, wave, vcu, G;
    const float *xp, *xs, *ck, *cv, *clf, *sh, *n1, *win, *bff, *qg, *kg, *lbl, *hon, *wout, *n2, *wup, *wdn;
};

__device__ __forceinline__ int win_src_col(int g) {
    const int j0 = 32 * g, tile = j0 >> 8, jl = j0 & 255;
    if (tile < 4) return (jl < 128) ? (128 * tile + jl) : (512 + 128 * tile + (jl - 128));
    if (tile < 8) { const int h = tile - 4; return (jl < 128) ? (1024 + 128 * h + jl) : (1536 + 128 * h + (jl - 128)); }
    if (tile < 12) { const int base = tile < 10 ? 2048 : 2560, tl = (tile - 8) & 1, bj = jl >> 7, wc = (jl >> 5) & 3; return base + 64 * (4 * tl + wc) + 32 * bj; }
    return 3072 + (j0 - 12 * 256);
}
__device__ __forceinline__ void p0_transpose_item(const float* W, int ldw, int K, const float* nrm, bf16* WT, int n0, int src0, int k0, LAS float* scr, int lane) {
#pragma unroll 8
    for (int i = 0; i < 32; ++i) { const int kk = 2 * i + (lane >> 5); float v = W[(size_t)(k0 + kk) * ldw + src0 + (lane & 31)]; if (nrm) v *= nrm[k0 + kk]; scr[kk * 33 + (lane & 31)] = v; }
    LDS_WAIT(); asm volatile("" ::: "memory");
    const int c = lane & 7;
#pragma unroll
    for (int j = 0; j < 4; ++j) { const int n = (lane >> 3) + 8 * j; const LAS float* s = scr + (8 * c) * 33 + n;
        v4u o; o.x = pk2(s[0 * 33], s[1 * 33]); o.y = pk2(s[2 * 33], s[3 * 33]); o.z = pk2(s[4 * 33], s[5 * 33]); o.w = pk2(s[6 * 33], s[7 * 33]);
        *(v4u*)(WT + (size_t)(n0 + n) * K + k0 + 8 * c) = o; }
    LDS_WAIT(); asm volatile("" ::: "memory");
}
__device__ __forceinline__ void p0_prologue(Frame& F) {
    LAS float* scr = (LAS float*)(F.lds + F.wave * 16384);
    const int gw = F.vcu * NWAVES + F.wave, NGW = F.G * NWAVES, lane = F.lane;
    bf16* Win_t = (bf16*)(F.ws + WS_WIN); bf16* Wo_t = (bf16*)(F.ws + WS_WO); bf16* Wup_t = (bf16*)(F.ws + WS_WUP); bf16* Wdn_t = (bf16*)(F.ws + WS_WDN);
    constexpr int I_IN = 16 * (NIN / 32), I_O = 16 * 32, I_UP = 16 * (FF / 32), I_DN = 64 * 32, NITEMS = I_IN + I_O + I_UP + I_DN;
    for (int it = gw; it < NITEMS; it += NGW) {
        int r = it;
        if (r < I_IN) { const int kb = r / (NIN / 32), g = r % (NIN / 32); p0_transpose_item(F.win, INC, DMOD, F.n1, Win_t, 32 * g, win_src_col(g), 64 * kb, scr, lane); continue; } r -= I_IN;
        if (r < I_O) { const int kb = r / 32, g = r % 32; p0_transpose_item(F.wout, DMOD, DMOD, nullptr, Wo_t, 32 * g, 32 * g, 64 * kb, scr, lane); continue; } r -= I_O;
        if (r < I_UP) { const int kb = r / (FF / 32), g = r % (FF / 32); p0_transpose_item(F.wup, FF, DMOD, F.n2, Wup_t, 32 * g, 32 * g, 64 * kb, scr, lane); continue; } r -= I_UP;
        { const int kb = r / 32, g = r % 32; p0_transpose_item(F.wdn, DMOD, FF, nullptr, Wdn_t, 32 * g, 32 * g, 64 * kb, scr, lane); }
    }
    { const int gt = F.vcu * NTHR + F.tid, NGT = F.G * NTHR;
      bf16* Qs = (bf16*)(F.ws + WS_QS); bf16* Ks = (bf16*)(F.ws + WS_KS); bf16* Vs = (bf16*)(F.ws + WS_VS);
      for (int i = gt; i < NBATCH * PAST * 64; i += NGT) { const int b = i / (PAST * 64), rem = i % (PAST * 64); const size_t so = (size_t)i * 8, dof = ((size_t)b * SSEQ * 64 + rem) * 8;
          const f32x4 a0 = *(const f32x4*)(F.ck + so), a1 = *(const f32x4*)(F.ck + so + 4), b0 = *(const f32x4*)(F.cv + so), b1 = *(const f32x4*)(F.cv + so + 4);
          v4u o; o.x = pk2(a0[0], a0[1]); o.y = pk2(a0[2], a0[3]); o.z = pk2(a1[0], a1[1]); o.w = pk2(a1[2], a1[3]); *(v4u*)(Ks + dof) = o;
          o.x = pk2(b0[0], b0[1]); o.y = pk2(b0[2], b0[3]); o.z = pk2(b1[0], b1[1]); o.w = pk2(b1[2], b1[3]); *(v4u*)(Vs + dof) = o; }
      const v4u z = {0u, 0u, 0u, 0u};
      for (int i = gt; i < NBATCH * SSEQ * 64; i += NGT) *(v4u*)(Qs + (size_t)i * 8) = z;
      for (int i = gt; i < NBATCH * (SSEQ - PAST) * 64; i += NGT) { const int b = i / ((SSEQ - PAST) * 64), rem = i % ((SSEQ - PAST) * 64); const size_t dof = ((size_t)(b * SSEQ + PAST) * 64 + rem) * 8; *(v4u*)(Ks + dof) = z; *(v4u*)(Vs + dof) = z; }
    }
    float wf[4][4][8];
#pragma unroll
    for (int j = 0; j < 4; ++j)
#pragma unroll
        for (int i = 0; i < 4; ++i) { const int k = 256 * j + 4 * lane + i; const float nk = F.n1[k]; const f32x4 a = *(const f32x4*)(F.win + (size_t)k * INC + NIN), b = *(const f32x4*)(F.win + (size_t)k * INC + NIN + 4);
            wf[j][i][0] = a[0] * nk; wf[j][i][1] = a[1] * nk; wf[j][i][2] = a[2] * nk; wf[j][i][3] = a[3] * nk; wf[j][i][4] = b[0] * nk; wf[j][i][5] = b[1] * nk; wf[j][i][6] = b[2] * nk; wf[j][i][7] = b[3] * nk; }
    const f32x4 bf0 = *(const f32x4*)(F.bff), bf1 = *(const f32x4*)(F.bff + 4);
    float* rstd1 = (float*)(F.ws + WS_RSTD); bf16* XB = (bf16*)(F.ws + WS_XB);
    for (int m = gw; m < MTOT; m += NGW) {
        int idx; const bool valid = row_map(m, idx); const float* xrow = (m < MP ? F.xp : F.xs) + (size_t)idx * DMOD;
        f32x4 v[4]; float s = 0.f;
#pragma unroll
        for (int j = 0; j < 4; ++j) { v[j] = valid ? *((const f32x4*)xrow + 64 * j + lane) : (f32x4){0.f, 0.f, 0.f, 0.f}; s += (v[j][0] * v[j][0] + v[j][1] * v[j][1]) + (v[j][2] * v[j][2] + v[j][3] * v[j][3]); }
        const float rstd = 1.f / sqrtf(wave_sum(s) * (1.f / DMOD) + EPSN);
        if (lane == 0) rstd1[m] = rstd;
        unsigned long long* o8 = (unsigned long long*)(XB + (size_t)m * DMOD) + lane;
#pragma unroll
        for (int j = 0; j < 4; ++j) o8[64 * j] = (unsigned long long)pk2(v[j][0], v[j][1]) | ((unsigned long long)pk2(v[j][2], v[j][3]) << 32);
        float fb[8];
#pragma unroll
        for (int h = 0; h < 8; ++h) { float a = 0.f;
#pragma unroll
            for (int j = 0; j < 4; ++j)
#pragma unroll
                for (int i = 0; i < 4; ++i) a += v[j][i] * wf[j][i][h];
            fb[h] = wave_sum(a); }
        if (valid && lane == 0) { f32x4 o0, o1;
#pragma unroll
            for (int h = 0; h < 8; ++h) { const float xx = fb[h] * rstd + (h < 4 ? bf0[h & 3] : bf1[h & 3]); const float ls = fminf(xx, 0.f) - log1pf(expf(-fabsf(xx))); if (h < 4) o0[h & 3] = ls; else o1[h & 3] = ls; }
            float* lp = (m < MP ? F.out + O_LP : F.out + O_LS) + (size_t)idx * 8; *(f32x4*)lp = o0; *(f32x4*)(lp + 4) = o1; }
    }
}
__device__ __forceinline__ void scan_chain(Frame& F, int ch) {
    LAS float* wsum = (LAS float*)F.lds;
    const bool samp = ch >= 64; const int c2 = samp ? ch - 64 : ch, b = c2 >> 3, h = c2 & 7; const int L = samp ? SSEQ : TSEQ, EPT = samp ? 3 : 16;
    float* dst = samp ? (float*)(F.ws + WS_CGS) + (size_t)c2 * SSEQ : (float*)(F.ws + WS_CGP) + (size_t)c2 * TSEQ;
    float vals[16]; float sum = 0.f;
#pragma unroll
    for (int i = 0; i < 16; ++i) { const int p = F.tid * EPT + i; float v = 0.f;
        if (i < EPT && p < L) { if (!samp) v = F.out[O_LP + ((size_t)b * TSEQ + p) * 8 + h]; else if (p < PAST) v = F.clf[((size_t)b * PAST + p) * 8 + h]; else if (p < PAST + DSEQ) v = F.out[O_LS + ((size_t)b * DSEQ + (p - PAST)) * 8 + h]; }
        sum += v; vals[i] = sum; }
    float incl = sum;
#pragma unroll
    for (int o = 1; o < 64; o <<= 1) { const float t = __shfl_up(incl, o); if (F.lane >= o) incl += t; }
    if (F.lane == 63) wsum[F.wave] = incl;
    __syncthreads();
    float base = 0.f;
    for (int w = 0; w < F.wave; ++w) base += wsum[w];
    const float excl = base + incl - sum;
#pragma unroll
    for (int i = 0; i < 16; ++i) { const int p = F.tid * EPT + i; if (i < EPT && p < L) dst[p] = (excl + vals[i]) * LOG2E; }
    __syncthreads();
}
constexpr int H_QR = 0, H_KR = 17408, H_KT = 34816, H_VT = 53248, H_VEC = 71680, H_AL = 73216, H_OL = 82432, H_END = 116224;
static_assert(H_END <= RING_BYTES, "hgrn LDS");
__device__ __forceinline__ f32x4 mfma16(bf16x8 a, bf16x8 b, f32x4 c) { return __builtin_amdgcn_mfma_f32_16x16x32_bf16(a, b, c, 0, 0, 0); }
#define LAUNDER(x) asm volatile("" : "+v"(x))
__device__ __forceinline__ void hgrn_chain(Frame& F, int row0, int chunk0, int nsteps, int h, const float* S0, float* Sout) {
    LAS unsigned char* L = F.lds; int tid_ = F.tid; LAUNDER(tid_); const int tid = tid_, lane = tid & 63, w = F.wave, l15 = lane & 15, fq = lane >> 4;
    const char* qb = (const char*)(F.ws + WS_QR) + ((size_t)row0 * 512 + 128 * h) * 2; const char* kb_ = (const char*)(F.ws + WS_KR) + ((size_t)row0 * 512 + 128 * h) * 2;
    const char* vb = (const char*)(F.ws + WS_VH) + ((size_t)row0 * 512 + 128 * h) * 2; const char* gb = (const char*)(F.ws + WS_SG) + ((size_t)row0 * 512 + 128 * h) * 2;
    const char* eb = (const char*)(F.ws + WS_VEC) + ((size_t)chunk0 * 512 + 128 * h) * 4; char* mb = (char*)(F.ws + WS_MIX) + ((size_t)row0 * DMOD + 128 * h) * 2;
    const int oc = tid >> 3, oseg = tid & 7;
    unsigned vo_rm = (unsigned)((tid >> 4) * 1024 + (tid & 15) * 16), vo_t = (unsigned)(lane * 1024 + w * 32), vo_sg = (unsigned)(oc * 1024 + oseg * 32), vo_mix = (unsigned)(oc * 2048 + oseg * 32);
    unsigned vo_vec = (unsigned)((tid >> 5) * (unsigned)(VECN * 4) + (tid & 31) * 16);
    unsigned l_rm = (unsigned)(H_QR + (tid >> 4) * 272 + (tid & 15) * 16);
    unsigned l_tw = (unsigned)(H_KT + (16 * w) * 144 + lane * 2);
    unsigned l_vw = (unsigned)(H_VEC + (tid >> 5) * 512 + (tid & 31) * 16);
    unsigned l_aq = (unsigned)(H_QR + (16 * (w >> 1) + l15) * 272 + fq * 16);
    unsigned l_ak = (unsigned)(H_KR + (32 * (w & 1) + l15) * 272 + fq * 16);
    unsigned l_aw = (unsigned)(H_AL + (16 * (w >> 1) + 4 * fq) * 144 + (32 * (w & 1) + l15) * 2);
    unsigned l_vt = (unsigned)(H_VT + (16 * w + l15) * 144 + fq * 16);
    unsigned l_q2 = (unsigned)(H_QR + l15 * 272 + fq * 8);
    unsigned l_al = (unsigned)(H_AL + l15 * 144 + fq * 16);
    unsigned l_kt = (unsigned)(H_KT + l15 * 144 + fq * 16);
    unsigned l_ve = (unsigned)(H_VEC + fq * 16);
    unsigned l_ow = (unsigned)(H_OL + (4 * fq) * 528 + (16 * w + l15) * 4);
    unsigned l_or = (unsigned)(H_OL + oc * 528 + oseg * 64);
    f32x4 S[8];
#pragma unroll
    for (int kb = 0; kb < 8; ++kb) S[kb] = (f32x4){0.f, 0.f, 0.f, 0.f};
    if (S0) { const float* sp = S0 + (4 * fq) * 128 + 16 * w + l15;
#pragma unroll
        for (int kb = 0; kb < 8; ++kb) { LAUNDER(sp);
#pragma unroll
            for (int r = 0; r < 4; ++r) S[kb][r] = sp[r * 128];
            sp += 16 * 128; } }
    v4u pq[2], pk[2], pkt[2], pvt[2], psgc[2], pvec;
#define HG_LOAD() do { \
        _Pragma("unroll") for (int it = 0; it < 2; ++it) { pq[it] = *(const v4u*)(qb + vo_rm + it * 32768); pk[it] = *(const v4u*)(kb_ + vo_rm + it * 32768); \
            pkt[it] = *(const v4u*)(kb_ + vo_t + it * 16); pvt[it] = *(const v4u*)(vb + vo_t + it * 16); } \
        if (tid < 96) pvec = *(const v4u*)(eb + vo_vec); } while (0)
#define HG_STORE() do { \
        _Pragma("unroll") for (int it = 0; it < 2; ++it) { *(LAS v4u*)(L + l_rm + it * 8704) = pq[it]; *(LAS v4u*)(L + l_rm + (H_KR - H_QR) + it * 8704) = pk[it]; \
            _Pragma("unroll") for (int e = 0; e < 4; ++e) { \
                *(LAS unsigned short*)(L + l_tw + (8 * it + 2 * e) * 144) = (unsigned short)(pkt[it][e] & 0xffffu); *(LAS unsigned short*)(L + l_tw + (8 * it + 2 * e + 1) * 144) = (unsigned short)(pkt[it][e] >> 16); \
                *(LAS unsigned short*)(L + l_tw + (H_VT - H_KT) + (8 * it + 2 * e) * 144) = (unsigned short)(pvt[it][e] & 0xffffu); *(LAS unsigned short*)(L + l_tw + (H_VT - H_KT) + (8 * it + 2 * e + 1) * 144) = (unsigned short)(pvt[it][e] >> 16); } } \
        if (tid < 96) *(LAS v4u*)(L + l_vw) = pvec; } while (0)
#define HG_ADV() do { qb += 65536; kb_ += 65536; vb += 65536; eb += 2048; } while (0)
    HG_LOAD(); HG_ADV(); HG_STORE();
    __syncthreads();
    for (int c = 0; c < nsteps; ++c) {
        LAUNDER(vo_rm); LAUNDER(vo_t); LAUNDER(vo_sg); LAUNDER(vo_mix); LAUNDER(vo_vec); LAUNDER(l_rm); LAUNDER(l_tw); LAUNDER(l_vw); LAUNDER(l_aq); LAUNDER(l_ak); LAUNDER(l_aw);
        LAUNDER(l_vt); LAUNDER(l_q2); LAUNDER(l_al); LAUNDER(l_kt); LAUNDER(l_ve); LAUNDER(l_ow); LAUNDER(l_or);
        psgc[0] = *(const v4u*)(gb + vo_sg); psgc[1] = *(const v4u*)(gb + vo_sg + 16); gb += 65536;
        if (c + 1 < nsteps) { HG_LOAD(); HG_ADV(); }
        { const int cblk = w >> 1;
#pragma unroll
          for (int jj = 0; jj < 2; ++jj) { const int sblk = 2 * (w & 1) + jj; f32x4 a = {0.f, 0.f, 0.f, 0.f};
              if (sblk <= cblk) {
#pragma unroll
                  for (int ks = 0; ks < 4; ++ks) { const bf16x8 af = *(const LAS bf16x8*)(L + l_aq + ks * 64); const bf16x8 bf = *(const LAS bf16x8*)(L + l_ak + jj * 16 * 272 + ks * 64); a = mfma16(af, bf, a); }
#pragma unroll
                  for (int r = 0; r < 4; ++r) if (16 * sblk + l15 > 16 * cblk + 4 * fq + r) a[r] = 0.f;
              }
#pragma unroll
              for (int r = 0; r < 4; ++r) *(LAS unsigned short*)(L + l_aw + r * 144 + jj * 32) = (unsigned short)(pk2(a[r], 0.f) & 0xffffu);
          } }
        __syncthreads();
        { bf16x8 bvt[2];
#pragma unroll
          for (int ks = 0; ks < 2; ++ks) bvt[ks] = *(const LAS bf16x8*)(L + l_vt + ks * 64);
#pragma unroll
          for (int cb = 0; cb < 4; ++cb) { f32x4 o = {0.f, 0.f, 0.f, 0.f};
#pragma unroll
              for (int ks = 0; ks < 2; ++ks) if (32 * ks <= 16 * cb + 15) { const bf16x8 af = *(const LAS bf16x8*)(L + l_al + cb * 16 * 144 + ks * 64); o = mfma16(af, bvt[ks], o); }
#pragma unroll
              for (int kb2 = 0; kb2 < 4; ++kb2) { const v2u lo = *(const LAS v2u*)(L + l_q2 + cb * 16 * 272 + kb2 * 64), hi = *(const LAS v2u*)(L + l_q2 + cb * 16 * 272 + kb2 * 64 + 32);
                  const f32x4 e0 = *(const LAS f32x4*)(L + l_ve + kb2 * 128), e1 = *(const LAS f32x4*)(L + l_ve + kb2 * 128 + 64);
                  v4u sbv; sbv.x = pk2(S[2 * kb2][0] * e0[0], S[2 * kb2][1] * e0[1]); sbv.y = pk2(S[2 * kb2][2] * e0[2], S[2 * kb2][3] * e0[3]); sbv.z = pk2(S[2 * kb2 + 1][0] * e1[0], S[2 * kb2 + 1][1] * e1[1]); sbv.w = pk2(S[2 * kb2 + 1][2] * e1[2], S[2 * kb2 + 1][3] * e1[3]);
                  v4u t; t.x = lo.x; t.y = lo.y; t.z = hi.x; t.w = hi.y; o = mfma16(__builtin_bit_cast(bf16x8, t), __builtin_bit_cast(bf16x8, sbv), o); }
#pragma unroll
              for (int r = 0; r < 4; ++r) *(LAS float*)(L + l_ow + (16 * cb + r) * 528) = o[r];
              __builtin_amdgcn_sched_barrier(0); }
#pragma unroll
          for (int kb = 0; kb < 8; ++kb) { f32x4 t = {0.f, 0.f, 0.f, 0.f};
#pragma unroll
              for (int ks = 0; ks < 2; ++ks) { const bf16x8 af = *(const LAS bf16x8*)(L + l_kt + kb * 16 * 144 + ks * 64); t = mfma16(af, bvt[ks], t); }
              const f32x4 dv = *(const LAS f32x4*)(L + l_ve + 512 + kb * 64), gv = *(const LAS f32x4*)(L + l_ve + 1024 + kb * 64);
#pragma unroll
              for (int r = 0; r < 4; ++r) S[kb][r] = dv[r] * S[kb][r] + gv[r] * t[r];
              __builtin_amdgcn_sched_barrier(0); } }
        __syncthreads();
        { f32x4 ov[4]; float ss = 0.f;
#pragma unroll
          for (int i = 0; i < 4; ++i) { ov[i] = *(const LAS f32x4*)(L + l_or + 16 * i); ss += (ov[i][0] * ov[i][0] + ov[i][1] * ov[i][1]) + (ov[i][2] * ov[i][2] + ov[i][3] * ov[i][3]); }
          ss += __shfl_xor(ss, 1); ss += __shfl_xor(ss, 2); ss += __shfl_xor(ss, 4);
          const float rn = 1.f / sqrtf(ss * (1.f / 128.f) + EPSN);
          float res[16]; f32x4 gn[4]; const float* hp = F.hon + 128 * h + 16 * oseg; LAUNDER(hp);
#pragma unroll
          for (int i = 0; i < 4; ++i) gn[i] = *(const f32x4*)(hp + 4 * i);
#pragma unroll
          for (int i = 0; i < 4; ++i)
#pragma unroll
              for (int j = 0; j < 4; ++j) { const int e = 4 * i + j; const unsigned wd = psgc[e >> 3][(e & 7) >> 1]; const float sg = bf2f((unsigned short)((e & 1) ? (wd >> 16) : (wd & 0xffffu))); res[e] = ov[i][j] * rn * gn[i][j] * sg; }
          v4u o0, o1; o0.x = pk2(res[0], res[1]); o0.y = pk2(res[2], res[3]); o0.z = pk2(res[4], res[5]); o0.w = pk2(res[6], res[7]); o1.x = pk2(res[8], res[9]); o1.y = pk2(res[10], res[11]); o1.z = pk2(res[12], res[13]); o1.w = pk2(res[14], res[15]);
          *(v4u*)(mb + vo_mix) = o0; *(v4u*)(mb + vo_mix + 16) = o1; mb += 131072; }
        if (c + 1 < nsteps) { HG_STORE(); }
        __syncthreads();
    }
    { int ln2 = lane; LAUNDER(ln2); float* sp = Sout + (4 * (ln2 >> 4)) * 128 + 16 * w + (ln2 & 15);
#pragma unroll
      for (int kb = 0; kb < 8; ++kb) { LAUNDER(sp);
#pragma unroll
          for (int r = 0; r < 4; ++r) sp[r * 128] = S[kb][r];
          sp += 16 * 128; } }
#undef HG_LOAD
#undef HG_STORE
#undef HG_ADV
}

__global__ void __launch_bounds__(NTHR, 2) skel_fwd(Args args) {
    extern __shared__ __attribute__((aligned(16))) unsigned char lds[];
    Frame F;
    F.lds = (LAS unsigned char*)lds; F.MISC = (volatile LAS unsigned*)(F.lds + MISC_OFF);
    F.tid = threadIdx.x; F.lane = F.tid & 63; F.wave = __builtin_amdgcn_readfirstlane(F.tid >> 6);
    F.G = gridDim.x; { const int bx = blockIdx.x; F.vcu = (F.G % 8 == 0) ? (bx % 8) * (F.G / 8) + bx / 8 : bx; }
    F.ws = args.ws; F.ctl = (unsigned*)(args.ws + WS_CTL); F.out = args.out;
    F.xp = args.in[0]; F.xs = args.in[1]; F.ck = args.in[2]; F.cv = args.in[3]; F.clf = args.in[4]; F.sh = args.in[5]; F.n1 = args.in[6]; F.win = args.in[7]; F.bff = args.in[8];
    F.qg = args.in[9]; F.kg = args.in[10]; F.lbl = args.in[11]; F.hon = args.in[12]; F.wout = args.in[13]; F.n2 = args.in[14]; F.wup = args.in[15]; F.wdn = args.in[16];
    const int lo = args.ph_lo, hi = args.ph_hi;
#ifndef PH_MASK
#define PH_MASK 63
#endif
#define IN(k) (((PH_MASK >> (k)) & 1) && lo <= (k) && (k) < hi)
#define SEAM(k) do { if (IN(k) && IN((k) + 1)) { cg::this_grid().sync(); } } while (0)
    bf16* XB = (bf16*)(F.ws + WS_XB); bf16* X1B = (bf16*)(F.ws + WS_X1B); bf16* MIX = (bf16*)(F.ws + WS_MIX); bf16* HB = (bf16*)(F.ws + WS_H);
    if (IN(0)) { p0_prologue(F); }
    SEAM(0);
    if (IN(1)) {
#ifndef NO_SCAN
        for (int ch = F.vcu; ch < 128; ch += F.G) scan_chain(F, ch);
#endif
        pg8::Gemm g{XB, (const bf16*)(F.ws + WS_WIN), MTOT, NIN, DMOD}; pg8::StaticOrder S; S.init(MTOT, NIN, F.G, (int)blockIdx.x);
        pg8::EpiIn E{(const float*)(F.ws + WS_RSTD), F.lbl, F.qg, F.kg, F.ws, F.out};
        pg8::gemm_phase<pg8::EpiIn, pg8::StaticOrder, true, true>(F.lds, g, S, E);
    }
    SEAM(1);
    if (IN(2)) {
#ifndef NO_HGRN
        for (int c = F.vcu; c < 64; c += F.G) {
            const bool smp = c >= 32; const int c2 = c & 31, bb = c2 >> 2;
            hgrn_chain(F, smp ? MP + 64 * bb : bb * TSEQ, smp ? MP / 64 + bb : bb * (TSEQ / 64), smp ? 1 : TSEQ / 64, c2 & 3, smp ? F.sh + (size_t)c2 * 16384 : nullptr, F.out + (smp ? O_HS : O_HP) + (size_t)c2 * 16384);
            __syncthreads();
        }
#endif
#ifndef NO_ATTN
        for (;;) {
            if (F.tid == 0) F.MISC[0] = atomicAdd(F.ctl + CW_QUEUE, 1u);
            __syncthreads();
            const int i = (int)F.MISC[0];
            __syncthreads();
            if (i >= 2048 + 64) break;
            typedef attn_body::bf16 abf;
            const bool smp = i >= 2048; const int j = smp ? i - 2048 : i;
            const int bh = j & 63, qb = 31 - (j >> 6), b = bh >> 3, h = bh & 7;
            const int q0 = smp ? SSEQ - 256 : 256 * qb, NT = (q0 + 256) / 64; int NTE = NT;
            const size_t rb = (size_t)b * (smp ? SSEQ : TSEQ);
            const float* cgp = (const float*)(F.ws + (smp ? WS_CGS : WS_CGP)) + (size_t)bh * (smp ? SSEQ : TSEQ);
            const size_t orow = smp ? (size_t)(MP + 64 * b) - (size_t)(PAST - q0) : rb + q0;
            attn_body::attn_unit<8>((const abf*)(F.ws + (smp ? WS_QS : WS_Q)) + (rb + q0) * 512 + 64 * h, (const abf*)(F.ws + (smp ? WS_KS : WS_K)) + rb * 512 + 64 * h, (const abf*)(F.ws + (smp ? WS_VS : WS_V)) + rb * 512 + 64 * h,
                                    (abf*)MIX + orow * DMOD + 512 + 64 * h, NT, NTE, cgp, q0, smp ? (PAST - q0) / 32 : 0, smp ? (PAST - q0) / 32 + 1 : 8, (char*)lds);
        }
#endif
    }
    SEAM(2);
    if (IN(3)) {
        pg8::Gemm g{MIX, (const bf16*)(F.ws + WS_WO), MTOT, DMOD, DMOD}; pg8::StaticOrder S; S.init(MTOT, DMOD, F.G, (int)blockIdx.x);
        pg8::EpiWo E{F.xp, F.xs, F.out + O_YP, F.out + O_YS, X1B, (float*)(F.ws + WS_SSQ)};
        pg8::gemm_phase<pg8::EpiWo, pg8::StaticOrder, true, true>(F.lds, g, S, E);
    }
    SEAM(3);
    if (IN(4)) {
        pg8::Gemm g{X1B, (const bf16*)(F.ws + WS_WUP), MTOT, FF, DMOD}; pg8::StaticOrder S; S.init(MTOT, FF, F.G, (int)blockIdx.x);
        pg8::EpiUp E{HB, (const float*)(F.ws + WS_SSQ)};
        pg8::gemm_phase<pg8::EpiUp, pg8::StaticOrder, true, true>(F.lds, g, S, E);
    }
    SEAM(4);
    if (IN(5)) {
        pg8::Gemm g{HB, (const bf16*)(F.ws + WS_WDN), MTOT, DMOD, FF}; pg8::StaticOrder S; S.init(MTOT, DMOD, F.G, (int)blockIdx.x);
        pg8::EpiDown E{F.out + O_YP, F.out + O_YS};
        pg8::gemm_phase<pg8::EpiDown, pg8::StaticOrder, true, true>(F.lds, g, S, E);
    }
#undef IN
#undef SEAM
}

extern "C" void kernel_launch(void* const* d_in, const int* in_sizes, int n_in, void* d_out, int out_size, void* d_ws, size_t ws_size, hipStream_t stream) {
    static int grid = 0;
    if (grid == 0) {
        if (n_in != 17 || (size_t)out_size != O_END || ws_size < WS_END) { fprintf(stderr, "kernel_launch: unexpected shapes (n_in %d out %d ws %zu)\n", n_in, out_size, ws_size); grid = -1; return; }
        int dev = 0, cus = 0, per_cu = 0;
        if (hipGetDevice(&dev) != hipSuccess || hipDeviceGetAttribute(&cus, hipDeviceAttributeMultiprocessorCount, dev) != hipSuccess) { grid = -1; return; }
        if (hipFuncSetAttribute((const void*)skel_fwd, hipFuncAttributeMaxDynamicSharedMemorySize, LDS_BYTES) != hipSuccess) { fprintf(stderr, "kernel_launch: hipFuncSetAttribute failed\n"); grid = -1; return; }
        if (hipOccupancyMaxActiveBlocksPerMultiprocessor(&per_cu, (const void*)skel_fwd, NTHR, LDS_BYTES) != hipSuccess || per_cu < 1) { fprintf(stderr, "kernel_launch: occupancy query says %d\n", per_cu); per_cu = 1; }
        (void)hipGetLastError();
        grid = cus;
    }
    if (grid < 0) return;
    if (hipMemsetAsync((char*)d_ws + WS_CTL, 0, CTL_ZERO_BYTES, stream) != hipSuccess) { fprintf(stderr, "kernel_launch: memset failed\n"); return; }
    Args a{};
    for (int i = 0; i < 17; ++i) a.in[i] = (const float*)d_in[i];
    a.out = (float*)d_out; a.ws = (unsigned char*)d_ws;
#if MK_N_LAUNCHES == 1
    a.ph_lo = 0; a.ph_hi = 6;
    void* kargs[] = {&a};
    hipError_t e = hipLaunchCooperativeKernel((const void*)skel_fwd, dim3(grid), dim3(NTHR), kargs, LDS_BYTES, stream);
    if (e != hipSuccess) fprintf(stderr, "kernel_launch: cooperative launch failed: %s (grid %d)\n", hipGetErrorString(e), grid);
#else
    for (int li = 0; li < 6; ++li) { a.ph_lo = li; a.ph_hi = li + 1; hipLaunchKernelGGL(skel_fwd, dim3(grid), dim3(NTHR), LDS_BYTES, stream, a); }
#endif
}
```

```cpp
#include <hip/hip_runtime.h>
#include <cstdio>
#include <cstdint>
namespace pg8 {
#define PG8_LAS __attribute__((address_space(3)))
typedef unsigned short bf16_t;
typedef short bf16x8 __attribute__((ext_vector_type(8)));
typedef float f32x4 __attribute__((ext_vector_type(4)));
typedef unsigned u32x4 __attribute__((ext_vector_type(4)));
constexpr int BM = 256, BK = 64, HALF = 128, HTB = HALF * BK * 2  , STAGE_BYTES = 8 * HTB, NXCD = 8, WGM = 8;

__host__ __device__ __forceinline__ int lds_byte(int r, int c) { const int st = (r >> 4) * 2 + (c >> 5), rr = r & 15, cc = c & 31, ob = rr * 64 + cc * 2; return st * 1024 + (ob ^ (((ob >> 9) & 1) << 5)); }
__host__ __device__ __forceinline__ void stage_rc(int b, int& R, int& C) { const int st = b / 1024, sb = b % 1024, swz = sb ^ (((sb >> 9) & 1) << 5); R = (st >> 1) * 16 + swz / 64; C = (st & 1) * 32 + (swz % 64) / 2; }
__host__ __device__ __forceinline__ int perm32(int rho) { const int n = rho >> 4, i = rho & 15; return 8 * (i >> 2) + 4 * n + (i & 3); }

struct Unit { int pm, pn; };
struct Gemm { const bf16_t* A; const bf16_t* Bt; int M, N, K; };

struct StaticOrder {
    int nM, nN, nwg, G, c;
    __host__ __device__ void init(int M, int N, int G_, int c_) { nM = M / BM; nN = N / BM; nwg = nM * nN; G = G_; c = c_; }
    __host__ __device__ bool next(int i, Unit& u) const {
        const long L = (long)i * G + c; if (L >= nwg) return false;
        int wgid = (int)L; { const int q = nwg / NXCD, r = nwg % NXCD, xcd = wgid % NXCD, off = wgid / NXCD; wgid = (xcd < r ? xcd * (q + 1) : r * (q + 1) + (xcd - r) * q) + off; }
        const int nig = WGM * nN, gid = wgid / nig, fm = gid * WGM, gsz = (nM - fm) < WGM ? (nM - fm) : WGM;
        u.pm = fm + ((wgid % nig) % gsz); u.pn = (wgid % nig) / gsz; return true;
    }
    __device__ __forceinline__ void a_ready(const Unit&) const {}
    __device__ __forceinline__ void done(const Unit&) const {}
};

__device__ __forceinline__ unsigned cvt_pk_bf16(float lo, float hi) { unsigned r; asm volatile("v_cvt_pk_bf16_f32 %0, %1, %2" : "=v"(r) : "v"(lo), "v"(hi)); return r; }
typedef float f32x2 __attribute__((ext_vector_type(2)));
template <class Epi, class Sched, bool ALIGN_EPI = false, bool SP2 = false>
__device__ __forceinline__ void gemm_phase(PG8_LAS unsigned char* lds, const Gemm g, const Sched& S, const Epi& E) {
    const int tid = threadIdx.x, wid = __builtin_amdgcn_readfirstlane(tid >> 6), lane = tid & 63, wr = wid >> 2, wc = wid & 3, fr = lane & 15, fq = lane >> 4;
    const int K = g.K, nt = K / BK;
    unsigned voffA[2], voffB[2];
#pragma unroll
    for (int i = 0; i < 2; ++i) { int R, C; stage_rc(tid * 16 + i * 8192, R, C); const int Rb = Epi::PERM ? ((R & ~31) + perm32(R & 31)) : R;
        voffA[i] = (unsigned)(R * K + C) * 2u; voffB[i] = (unsigned)(Rb * K + C) * 2u; }
    const size_t kstep = (size_t)(BK * 2);
    const size_t hstep = (size_t)HALF * K * 2;
    const size_t tstep = 2 * hstep;
    const unsigned ldsw = (unsigned)wid * 1024u;
    const int aoff = lds_byte(wr * 64 + fr, fq * 8), boff = lds_byte(wc * 32 + fr, fq * 8);
#define PG8_SA(b, h) (((b) * 2 + (h)) * HTB)
#define PG8_SB(b, h) ((4 + (b) * 2 + (h)) * HTB)
#define PG8_STAGE(bufoff, gbase, voff) do { _Pragma("unroll") for (int _i = 0; _i < 2; ++_i) \
        __builtin_amdgcn_global_load_lds((const unsigned*)((const char*)(gbase) + (voff)[_i]), (PG8_LAS unsigned*)(lds + (bufoff) + ldsw + _i * 8192), 16, 0, 0); } while (0)
#define PG8_LDA(dst, b, h) do { _Pragma("unroll") for (int m = 0; m < 4; ++m) _Pragma("unroll") for (int k = 0; k < 2; ++k) dst[m][k] = *(const PG8_LAS bf16x8*)(lds + PG8_SA(b, h) + aoff + m * 2048 + k * 1024); } while (0)
#define PG8_LDB(dst, b, h) do { _Pragma("unroll") for (int n = 0; n < 2; ++n) _Pragma("unroll") for (int k = 0; k < 2; ++k) dst[n][k] = *(const PG8_LAS bf16x8*)(lds + PG8_SB(b, h) + boff + n * 2048 + k * 1024); } while (0)
#define PG8_MMA(ai, bj, At, Bt) do { __builtin_amdgcn_s_setprio(1); _Pragma("unroll") for (int m = 0; m < 4; ++m) _Pragma("unroll") for (int n = 0; n < 2; ++n) _Pragma("unroll") for (int k = 0; k < 2; ++k) \
        acc[ai][bj][m][n] = __builtin_amdgcn_mfma_f32_16x16x32_bf16(Bt[n][k], At[m][k], acc[ai][bj][m][n], 0, 0, 0); __builtin_amdgcn_s_setprio(0); } while (0)
#define PG8_WAIT_V(n) asm volatile("s_waitcnt vmcnt(" #n ")" ::: "memory")
#define PG8_WAIT_L(n) asm volatile("s_waitcnt lgkmcnt(" #n ")" ::: "memory")
#define PG8_BAR __builtin_amdgcn_s_barrier()
#define PG8_SCHED __builtin_amdgcn_sched_barrier(0)
    Unit cur, nxt; int ui = 0;
    if (!S.next(0, cur)) return;
    f32x4 acc[2][2][4][2];
#pragma unroll
    for (int a = 0; a < 2; ++a)
#pragma unroll
        for (int b = 0; b < 2; ++b)
#pragma unroll
            for (int m = 0; m < 4; ++m)
#pragma unroll
                for (int n = 0; n < 2; ++n) acc[a][b][m][n] = (f32x4){0.f, 0.f, 0.f, 0.f};
    bf16x8 At[4][2], B0[2][2], B1[2][2];
    const char* cA = (const char*)g.A + (size_t)cur.pm * tstep; const char* cB = (const char*)g.Bt + (size_t)cur.pn * tstep;
    S.a_ready(cur);
    if constexpr (SP2) {
        PG8_STAGE(PG8_SB(0, 0), cB, voffB); PG8_STAGE(PG8_SB(0, 1), cB + hstep, voffB); PG8_STAGE(PG8_SA(0, 0), cA, voffA); PG8_STAGE(PG8_SA(0, 1), cA + hstep, voffA);
        if (wr == 1) PG8_BAR;
        PG8_WAIT_V(2); PG8_BAR;
        PG8_STAGE(PG8_SB(1, 0), cB + kstep, voffB); PG8_STAGE(PG8_SA(1, 0), cA + kstep, voffA); PG8_STAGE(PG8_SB(1, 1), cB + hstep + kstep, voffB);
        PG8_WAIT_V(6); PG8_BAR;
    } else {
        PG8_STAGE(PG8_SB(0, 0), cB, voffB); PG8_STAGE(PG8_SA(0, 0), cA, voffA); PG8_STAGE(PG8_SB(0, 1), cB + hstep, voffB); PG8_STAGE(PG8_SA(0, 1), cA + hstep, voffA);
        if (wr == 1) PG8_BAR;
        PG8_WAIT_V(4); PG8_BAR;
        PG8_STAGE(PG8_SB(1, 0), cB + kstep, voffB); PG8_STAGE(PG8_SA(1, 0), cA + kstep, voffA); PG8_STAGE(PG8_SB(1, 1), cB + hstep + kstep, voffB);
        PG8_WAIT_V(6); PG8_BAR;
    }
    for (;;) {
        const bool has_next = S.next(ui + 1, nxt);
        const char* nA = has_next ? (const char*)g.A + (size_t)nxt.pm * tstep : cA; const char* nB = has_next ? (const char*)g.Bt + (size_t)nxt.pn * tstep : cB;
        for (int t = 0; t < nt; t += 2) {
            const bool last = (t == nt - 2);
            const char* a1 = cA + (size_t)(t + 1) * kstep;
            const char* a2 = last ? nA : cA + (size_t)(t + 2) * kstep; const char* b2 = last ? nB : cB + (size_t)(t + 2) * kstep;
            const char* a3 = a2 + kstep; const char* b3 = b2 + kstep;
            if (last && has_next) S.a_ready(nxt);
            if constexpr (SP2) {
            PG8_LDB(B0, 0, 0); PG8_LDB(B1, 0, 1); PG8_SCHED; PG8_LDA(At, 0, 0); PG8_STAGE(PG8_SA(1, 1), a1 + hstep, voffA);
            PG8_WAIT_V(8); PG8_WAIT_L(0); PG8_BAR; PG8_MMA(0, 0, At, B0); PG8_MMA(0, 1, At, B1); PG8_BAR; PG8_SCHED;
            PG8_LDA(At, 0, 1); PG8_STAGE(PG8_SB(0, 0), b2, voffB); PG8_STAGE(PG8_SB(0, 1), b2 + hstep, voffB); PG8_STAGE(PG8_SA(0, 0), a2, voffA);
            PG8_WAIT_V(8); PG8_WAIT_L(0); PG8_BAR; PG8_MMA(1, 0, At, B0); PG8_MMA(1, 1, At, B1); PG8_BAR; PG8_SCHED;
            PG8_LDB(B0, 1, 0); PG8_LDB(B1, 1, 1); PG8_SCHED; PG8_LDA(At, 1, 0); PG8_STAGE(PG8_SA(0, 1), a2 + hstep, voffA);
            PG8_WAIT_V(8); PG8_WAIT_L(0); PG8_BAR; PG8_MMA(0, 0, At, B0); PG8_MMA(0, 1, At, B1); PG8_BAR; PG8_SCHED;
            PG8_LDA(At, 1, 1); PG8_STAGE(PG8_SB(1, 0), b3, voffB); PG8_STAGE(PG8_SB(1, 1), b3 + hstep, voffB); PG8_STAGE(PG8_SA(1, 0), a3, voffA);
            PG8_WAIT_V(8); PG8_WAIT_L(0); PG8_BAR; PG8_MMA(1, 0, At, B0); PG8_MMA(1, 1, At, B1); PG8_BAR; PG8_SCHED;
            } else {
            PG8_LDB(B0, 0, 0); PG8_SCHED; PG8_LDA(At, 0, 0); PG8_STAGE(PG8_SA(1, 1), a1 + hstep, voffA);
            PG8_WAIT_L(8); PG8_BAR; PG8_WAIT_L(0); PG8_MMA(0, 0, At, B0); PG8_BAR; PG8_SCHED;
            PG8_LDB(B1, 0, 1); PG8_STAGE(PG8_SB(0, 0), b2, voffB);
            PG8_BAR; PG8_WAIT_L(0); PG8_MMA(0, 1, At, B1); PG8_BAR;
            PG8_LDA(At, 0, 1); PG8_STAGE(PG8_SA(0, 0), a2, voffA);
            PG8_BAR; PG8_WAIT_L(0); PG8_MMA(1, 0, At, B0); PG8_BAR; PG8_SCHED;
            PG8_STAGE(PG8_SB(0, 1), b2 + hstep, voffB);
            PG8_WAIT_V(6); PG8_BAR; PG8_MMA(1, 1, At, B1); PG8_BAR;
            PG8_LDB(B0, 1, 0); PG8_SCHED; PG8_LDA(At, 1, 0); PG8_STAGE(PG8_SA(0, 1), a2 + hstep, voffA);
            PG8_WAIT_L(8); PG8_BAR; PG8_WAIT_L(0); PG8_MMA(0, 0, At, B0); PG8_BAR; PG8_SCHED;
            PG8_LDB(B1, 1, 1); PG8_STAGE(PG8_SB(1, 0), b3, voffB);
            PG8_BAR; PG8_WAIT_L(0); PG8_MMA(0, 1, At, B1); PG8_BAR;
            PG8_LDA(At, 1, 1); PG8_STAGE(PG8_SA(1, 0), a3, voffA);
            PG8_BAR; PG8_WAIT_L(0); PG8_MMA(1, 0, At, B0); PG8_BAR; PG8_SCHED;
            PG8_STAGE(PG8_SB(1, 1), b3 + hstep, voffB);
            PG8_WAIT_V(6); PG8_BAR; PG8_MMA(1, 1, At, B1); PG8_BAR;
            }
        }
        if constexpr (ALIGN_EPI) { if (wr == 0) PG8_BAR; }
        if constexpr (!Epi::AFTER_DRAIN) { E(acc, cur, wr, wc, fr, fq); S.done(cur); }
        if (!has_next) break;
#pragma unroll
        for (int a = 0; a < 2; ++a)
#pragma unroll
            for (int b = 0; b < 2; ++b)
#pragma unroll
                for (int m = 0; m < 4; ++m)
#pragma unroll
                    for (int n = 0; n < 2; ++n) acc[a][b][m][n] = (f32x4){0.f, 0.f, 0.f, 0.f};
        cur = nxt; cA = nA; cB = nB; ++ui;
        if constexpr (ALIGN_EPI) { if (wr == 1) PG8_BAR; }
    }
    PG8_WAIT_V(0);
    if constexpr (!ALIGN_EPI) { if (wr == 0) PG8_BAR; }
    PG8_BAR;
    if constexpr (Epi::AFTER_DRAIN) { E.fused(acc, cur, wr, wc, fr, fq, lds, wid, lane); S.done(cur); }
#undef PG8_SA
#undef PG8_SB
#undef PG8_STAGE
#undef PG8_LDA
#undef PG8_LDB
#undef PG8_MMA
#undef PG8_WAIT_V
#undef PG8_WAIT_L
#undef PG8_BAR
#undef PG8_SCHED
}
}
#include <hip/hip_bf16.h>
#include <cmath>
namespace attn_body {
using bf16=__hip_bfloat16;
using bf16x8=__attribute__((ext_vector_type(8)))short;
using s16x4=__attribute__((ext_vector_type(4)))short;
using f32x16=__attribute__((ext_vector_type(16)))float;
using u32x4=__attribute__((ext_vector_type(4)))unsigned;
constexpr int NHEAD=8,D=64,DM=NHEAD*D,OPITCH=1024;
constexpr int NW=8,QBLK=32,QB=QBLK*NW,KVBLK=64;
constexpr int ATTN_PITCH=DM, ATTN_UNIT_ROWS=QB;
__device__ __forceinline__ int crow(int r,int hi){return (r&3)+8*(r>>2)+4*hi;}
#define SBAR() __builtin_amdgcn_sched_barrier(0)
__device__ __forceinline__ void cmask(f32x16&p0,f32x16&p1,int jb,int qrel,int hi){
  const float NEG=-INFINITY; int kb=64*jb+4*hi;
  #pragma unroll
  for(int r=0;r<16;++r){int kv=kb+(r&3)+8*(r>>2); if(kv>qrel)p0[r]=NEG; if(kv+32>qrel)p1[r]=NEG;}
}

constexpr int NSLOT=3, SLOTB=8192;
constexpr int LDS_K=0, LDS_V=NSLOT*SLOTB, LDS_WS=2*NSLOT*SLOTB, LDS_OST=LDS_WS+NW*64*4, LDS_CB=LDS_OST+NW*4096, LDS_BYTES=LDS_CB+32768;
constexpr float C2=0.125f*1.4426950408889634f;
__device__ __forceinline__ void glds16(const void*gsrc,unsigned lds_dst){unsigned keep;
  asm volatile("s_mov_b32 %0, m0\n\ts_mov_b32 m0, %2\n\ts_nop 0\n\tglobal_load_lds_dwordx4 %1, off\n\ts_mov_b32 m0, %0":"=&s"(keep):"v"(gsrc),"s"(lds_dst):"memory");}
__device__ __forceinline__ float max3f(float a,float b,float c){float r;asm("v_max3_f32 %0, %1, %2, %3":"=v"(r):"v"(a),"v"(b),"v"(c));return r;}
__device__ __forceinline__ float max2f(float a,float b){float r;asm("v_max_f32_e32 %0, %1, %2":"=v"(r):"v"(a),"v"(b));return r;}
__device__ __forceinline__ float fadd_s(float a,float b){float r;asm("v_add_f32_e32 %0, %1, %2":"=v"(r):"v"(a),"v"(b));return r;}
__device__ __forceinline__ float fsub_s(float a,float b){float r;asm("v_sub_f32_e32 %0, %1, %2":"=v"(r):"v"(a),"v"(b));return r;}
typedef float f32x2_t __attribute__((ext_vector_type(2))); typedef float f32x4_t __attribute__((ext_vector_type(4))); typedef __bf16 bf16x2_t __attribute__((ext_vector_type(2)));
__device__ __forceinline__ unsigned cvtpk_s(float lo,float hi){f32x2_t v={lo,hi};bf16x2_t b=__builtin_convertvector(v,bf16x2_t);return __builtin_bit_cast(unsigned,b);}
#define WAIT_BAR(N) asm volatile("s_waitcnt vmcnt(" #N ") lgkmcnt(0)\n\ts_barrier":::"memory")

__device__ __forceinline__ void qkt(f32x16&p0,f32x16&p1,const char*Kslot,const bf16x8*qr,int r32,int hi){
  const char*kb=Kslot+hi*1024+r32*16;
  #pragma unroll
  for(int d0=0;d0<4;++d0){
    const bf16x8 b0=*reinterpret_cast<const bf16x8*>(kb+d0*2048);
    const bf16x8 b1=*reinterpret_cast<const bf16x8*>(kb+d0*2048+512);
    p0=__builtin_amdgcn_mfma_f32_32x32x16_bf16(b0,qr[d0],p0,0,0,0);p1=__builtin_amdgcn_mfma_f32_32x32x16_bf16(b1,qr[d0],p1,0,0,0);}
}
typedef __attribute__((address_space(3))) const char* lds_cptr;
typedef short v4i16_t __attribute__((ext_vector_type(4)));
__device__ __forceinline__ void kload8(bf16x8*kf,lds_cptr kp){
  kf[0]=*(const __attribute__((address_space(3))) bf16x8*)(kp);      kf[1]=*(const __attribute__((address_space(3))) bf16x8*)(kp+512);
  kf[2]=*(const __attribute__((address_space(3))) bf16x8*)(kp+2048); kf[3]=*(const __attribute__((address_space(3))) bf16x8*)(kp+2560);
  kf[4]=*(const __attribute__((address_space(3))) bf16x8*)(kp+4096); kf[5]=*(const __attribute__((address_space(3))) bf16x8*)(kp+4608);
  kf[6]=*(const __attribute__((address_space(3))) bf16x8*)(kp+6144); kf[7]=*(const __attribute__((address_space(3))) bf16x8*)(kp+6656);
}
__device__ __forceinline__ void kload2(bf16x8*kf,lds_cptr kp,int j){ kf[2*j]=*(const __attribute__((address_space(3))) bf16x8*)(kp+j*2048); kf[2*j+1]=*(const __attribute__((address_space(3))) bf16x8*)(kp+j*2048+512); }
__device__ __forceinline__ s16x4 vtr(lds_cptr p){ return __builtin_bit_cast(s16x4,__builtin_amdgcn_ds_read_tr16_b64_v4i16((__attribute__((address_space(3))) v4i16_t*)p)); }
__device__ __forceinline__ float rowmax(const f32x16&p0,const f32x16&p1){
  float a=max3f(p0[0],p0[1],p1[0]),b=max3f(p0[2],p0[3],p1[1]);a=max3f(a,p1[2],p1[3]);
  #pragma unroll
  for(int r=4;r<16;r+=4){a=max3f(a,p0[r],p0[r+1]);b=max3f(b,p0[r+2],p0[r+3]);a=max3f(a,p1[r],p1[r+1]);b=max3f(b,p1[r+2],p1[r+3]);}
  const float m=max2f(a,b);
  auto rr=__builtin_amdgcn_permlane32_swap(__float_as_uint(m),__float_as_uint(m),false,false);
  return max2f(__uint_as_float(rr[0]),__uint_as_float(rr[1]));
}
__device__ __forceinline__ void pv(f32x16*o,int vb,bf16x8 pa0,bf16x8 pa1,bf16x8 pa2,bf16x8 pa3){
  #pragma unroll
  for(int d0=0;d0<2;++d0){s16x4 lo[4],hi[4];
    #pragma unroll
    for(int ks=0;ks<4;++ks){
      asm volatile("ds_read_b64_tr_b16 %0,%1 offset:%c2":"=&v"(lo[ks]):"v"(vb),"i"(d0*4096+ks*1024):"memory");
      asm volatile("ds_read_b64_tr_b16 %0,%1 offset:%c2":"=&v"(hi[ks]):"v"(vb),"i"(d0*4096+ks*1024+512):"memory");}
    asm volatile("s_waitcnt lgkmcnt(0)":::"memory");SBAR();
    #define PK(k) (bf16x8){lo[k][0],lo[k][1],lo[k][2],lo[k][3],hi[k][0],hi[k][1],hi[k][2],hi[k][3]}
    o[d0]=__builtin_amdgcn_mfma_f32_32x32x16_bf16(pa0,PK(0),o[d0],0,0,0);
    o[d0]=__builtin_amdgcn_mfma_f32_32x32x16_bf16(pa1,PK(1),o[d0],0,0,0);
    o[d0]=__builtin_amdgcn_mfma_f32_32x32x16_bf16(pa2,PK(2),o[d0],0,0,0);
    o[d0]=__builtin_amdgcn_mfma_f32_32x32x16_bf16(pa3,PK(3),o[d0],0,0,0);
    #undef PK
  }
}

#ifndef ATTN_STORE16
#define ATTN_STORE16(p,v) (*(u32x4*)(p)=(v))
#endif
template<int THRL> __device__ __forceinline__ void attn_unit(const bf16*Qb,const bf16*__restrict__ Kh,const bf16*__restrict__ Vh,bf16*Ob,int NT,int NTE,const float*cgp,int q0,int wlo,int whi,char*shm){
  int tid_=threadIdx.x; asm volatile("":"+v"(tid_)); const int tid=tid_,lane=tid&63,r32=lane&31,hi=lane>>5; const int wid=__builtin_amdgcn_readfirstlane(tid>>6);
  const bf16*Qw=Qb+(long)(wid*QBLK)*DM;
  const unsigned lds0=(unsigned)(uintptr_t)shm;
  float*wsf=(float*)(shm+LDS_WS)+wid*64;
  const bf16*ksrc=Kh+(long)((NT-1)*KVBLK+lane)*DM+wid*8;
  const bf16*vsrc=Vh+(long)((NT-1)*KVBLK+16*(wid&3)+(lane>>2))*DM+(wid>>2)*32+(lane&3)*8;
  const unsigned kdst=lds0+LDS_K+wid*1024, vdst=lds0+LDS_V+wid*1024;
  #define DMA_K(t,slot) glds16(ksrc-(long)(t)*KVBLK*DM,(unsigned)__builtin_amdgcn_readfirstlane(kdst+(slot)))
  #define DMA_V(t,slot) glds16(vsrc-(long)(t)*KVBLK*DM,(unsigned)__builtin_amdgcn_readfirstlane(vdst+(slot)))
  const int vb0=(int)(lds0+LDS_V)+((lane>>4)&1)*32+(lane&3)*8+(4*hi+((lane&15)>>2))*64;
  const char*Kbase=shm+LDS_K; bf16x8 kf[8];
  const lds_cptr shm3=(lds_cptr)shm; const lds_cptr kp0=shm3+LDS_K+hi*1024+r32*16; const lds_cptr vp0=shm3+LDS_V+((lane>>4)&1)*32+(lane&3)*8+(4*hi+((lane&15)>>2))*64;
  { typedef __attribute__((address_space(3))) float lf_t; lf_t* cbw=(lf_t*)((lds_cptr)shm+LDS_CB); const float c0=cgp[q0]; const int jlo=(NT-NTE)*KVBLK, jhi=NT*KVBLK;
    for(int j=jlo+tid;j<jhi;j+=NW*64) cbw[j]=c0-cgp[j]; }
  const __attribute__((address_space(3))) float* cbL=(const __attribute__((address_space(3))) float*)((lds_cptr)shm+LDS_CB)+4*hi;
  #define CBLOAD(C0,C1,t,MH) do{ const __attribute__((address_space(3))) float* cbp_=cbL+(NT-1-(t))*KVBLK; \
    _Pragma("unroll") for(int g_=0;g_<4;++g_){ const f32x4_t v0_=*(const __attribute__((address_space(3))) f32x4_t*)(cbp_+8*g_); const f32x4_t v1_=*(const __attribute__((address_space(3))) f32x4_t*)(cbp_+32+8*g_); \
      C0[4*g_]=v0_[0]-(MH);C0[4*g_+1]=v0_[1]-(MH);C0[4*g_+2]=v0_[2]-(MH);C0[4*g_+3]=v0_[3]-(MH); C1[4*g_]=v1_[0]-(MH);C1[4*g_+1]=v1_[1]-(MH);C1[4*g_+2]=v1_[2]-(MH);C1[4*g_+3]=v1_[3]-(MH);} }while(0)
  DMA_K(0,0);DMA_V(0,0);DMA_K(1,SLOTB);
  bf16x8 qr[4];
  #pragma unroll
  for(int d0=0;d0<4;++d0)qr[d0]=*reinterpret_cast<const bf16x8*>(&Qw[(long)r32*DM+d0*16+hi*8]);
  float mhat=0.f,l_reg=0.f;f32x16 o[2];o[0]=f32x16{};o[1]=f32x16{};
  const int qrel=wid*QBLK+r32;
  #define CMASK(P0,P1,t) do{int jb_=3-(t); if(jb_>=0)cmask(P0,P1,jb_,qrel,hi);}while(0)
  bool resc=false;
  #define START(P0,P1) do{ const float rm=rowmax(P0,P1); resc=false; \
    { const float dl=(rm>-1e30f)?rm:0.f; mhat=fadd_s(mhat,dl); \
      _Pragma("unroll") for(int r=0;r<16;++r){P0[r]=fsub_s(P0[r],dl);P1[r]=fsub_s(P1[r],dl);} } \
    _Pragma("unroll") for(int r=0;r<16;++r)P0[r]=__builtin_amdgcn_exp2f(P0[r]); }while(0)
  #define RESC() do{ if(resc){ asm volatile("s_waitcnt lgkmcnt(0)":::"memory"); \
      _Pragma("unroll") for(int d_=0;d_<2;++d_) _Pragma("unroll") for(int r=0;r<16;++r)o[d_][r]*=wsf[crow(r,hi)]; } }while(0)
  f32x16 pA0,pA1,pB0,pB1;
  int sl_prev=0,sl_cur=0,sl_next=SLOTB;
  #define ROT() do{sl_prev=sl_cur;sl_cur=sl_next;sl_next=(sl_next==(NSLOT-1)*SLOTB)?0:sl_next+SLOTB;}while(0)
  DMA_K(2,2*SLOTB);
  WAIT_BAR(3);
  CBLOAD(pA0,pA1,0,0.f); qkt(pA0,pA1,Kbase,qr,r32,hi);asm volatile("s_nop 15\n\ts_nop 7":"+v"(pA0),"+v"(pA1));CMASK(pA0,pA1,0);
  START(pA0,pA1);
  _Pragma("unroll") for(int r=0;r<16;++r)pA1[r]=__builtin_amdgcn_exp2f(pA1[r]);
  WAIT_BAR(0);
  DMA_K(3,0);DMA_V(1,SLOTB);
  ROT();
  kload8(kf,kp0+sl_cur);
  WAIT_BAR(2);
  s16x4 vlo[8],vhi[8]; u32x4 pw0,pw1,pw2,pw3;
  #define PKW(P,B) cvtpk_s(P[B],P[B+1])
  #define PAF(k) __builtin_bit_cast(bf16x8,pw##k)
  #define VFR(i) (bf16x8){vlo[i][0],vlo[i][1],vlo[i][2],vlo[i][3],vhi[i][0],vhi[i][1],vhi[i][2],vhi[i][3]}
  #define PIN(x) asm volatile("":"+v"(x))
  #define MX3(a,b,c) __builtin_fmaxf(__builtin_fmaxf((a),(b)),(c))
  #define GAPA(MF,A0,A1,A2,A3,W0,W1,PW) do{ MF; sacc+=A0; sacc+=A1; sacc+=A2; sacc+=A3; PIN(sacc); W0; W1; PIN(PW); SBAR(); }while(0)
  #define EX(v) __builtin_amdgcn_exp2f(v)
  #define GAPB(MF,X,B) do{ MF; X[B]=EX(X[B]); X[B+1]=EX(X[B+1]); X[B+2]=EX(X[B+2]); X[B+3]=EX(X[B+3]); PIN(X); SBAR(); }while(0)
  #define VRD(i) do{ vlo[i]=vtr(vp_+(((i)>>2)*4096+((i)&3)*1024)); vhi[i]=vtr(vp_+(((i)>>2)*4096+((i)&3)*1024+512)); }while(0)
  #define KRD(G,j) do{ if(G){ kload2(kf,kp0+sl_next,j); SBAR(); } }while(0)
  #define STEP(C0,C1,P0,P1,t,GK,GV,GL) do{ SBAR(); \
    const lds_cptr vp_=vp0+sl_prev; CBLOAD(C0,C1,t,mhat); SBAR(); \
    VRD(0); SBAR(); float sacc=(P0[0]+P0[1]); \
    GAPA(C0=__builtin_amdgcn_mfma_f32_32x32x16_bf16(kf[0],qr[0],C0,0,0,0), P0[2],P0[3],P0[4],P0[5],     pw0[0]=PKW(P0,0), pw0[1]=PKW(P0,2), pw0); \
    VRD(4); SBAR(); GAPA(C1=__builtin_amdgcn_mfma_f32_32x32x16_bf16(kf[1],qr[0],C1,0,0,0), P0[6],P0[7],P0[8],P0[9],     pw0[2]=PKW(P0,4), pw0[3]=PKW(P0,6), pw0); \
    VRD(1); SBAR(); GAPA(C0=__builtin_amdgcn_mfma_f32_32x32x16_bf16(kf[2],qr[1],C0,0,0,0),   P0[10],P0[11],P0[12],P0[13], pw1[0]=PKW(P0,8), pw1[1]=PKW(P0,10), pw1); \
    VRD(5); SBAR(); GAPA(C1=__builtin_amdgcn_mfma_f32_32x32x16_bf16(kf[3],qr[1],C1,0,0,0),   P0[14],P0[15],P1[0],P1[1],   pw1[2]=PKW(P0,12),pw1[3]=PKW(P0,14), pw1); \
    VRD(2); SBAR(); GAPA(C0=__builtin_amdgcn_mfma_f32_32x32x16_bf16(kf[4],qr[2],C0,0,0,0),   P1[2],P1[3],P1[4],P1[5],     pw2[0]=PKW(P1,0), pw2[1]=PKW(P1,2), pw2); \
    VRD(6); SBAR(); GAPA(C1=__builtin_amdgcn_mfma_f32_32x32x16_bf16(kf[5],qr[2],C1,0,0,0),   P1[6],P1[7],P1[8],P1[9],     pw2[2]=PKW(P1,4), pw2[3]=PKW(P1,6), pw2); \
    VRD(3); SBAR(); GAPA(C0=__builtin_amdgcn_mfma_f32_32x32x16_bf16(kf[6],qr[3],C0,0,0,0),   P1[10],P1[11],P1[12],P1[13], pw3[0]=PKW(P1,8), pw3[1]=PKW(P1,10), pw3); \
    VRD(7); SBAR(); GAPA(C1=__builtin_amdgcn_mfma_f32_32x32x16_bf16(kf[7],qr[3],C1,0,0,0),   P1[14],P1[15],0.f,0.f,       pw3[2]=PKW(P1,12),pw3[3]=PKW(P1,14), pw3); \
    l_reg+=sacc; \
    if(GK){DMA_K((t)+3,sl_cur);} if(GV){DMA_V((t)+1,sl_next);} \
    CMASK(C0,C1,t); \
    { float a=MX3(C0[0],C0[1],C1[0]),b=MX3(C0[2],C0[3],C1[1]); a=MX3(a,C1[2],C1[3]); \
      _Pragma("unroll") for(int r=4;r<16;r+=4){a=MX3(a,C0[r],C0[r+1]);b=MX3(b,C0[r+2],C0[r+3]);a=MX3(a,C1[r],C1[r+1]);b=MX3(b,C1[r+2],C1[r+3]);} \
      float rm=__builtin_fmaxf(a,b); { auto rr=__builtin_amdgcn_permlane32_swap(__float_as_uint(rm),__float_as_uint(rm),false,false); rm=__builtin_fmaxf(__uint_as_float(rr[0]),__uint_as_float(rr[1])); } \
      resc=false; \
      if(__builtin_expect(__any(rm>(float)THRL),0)){ const float dl=__builtin_fmaxf(rm,0.f); mhat+=dl; \
        _Pragma("unroll") for(int r=0;r<16;++r){C0[r]-=dl;C1[r]-=dl;} \
        const float f=__builtin_amdgcn_exp2f(-dl); l_reg*=f; if(hi==0)wsf[r32]=f; resc=true; } } \
    SBAR(); \
    GAPB(o[0]=__builtin_amdgcn_mfma_f32_32x32x16_bf16(PAF(0),VFR(0),o[0],0,0,0), C0,0); \
    GAPB(o[1]=__builtin_amdgcn_mfma_f32_32x32x16_bf16(PAF(0),VFR(4),o[1],0,0,0), C0,4); \
    KRD(GL,0); GAPB(o[0]=__builtin_amdgcn_mfma_f32_32x32x16_bf16(PAF(1),VFR(1),o[0],0,0,0), C0,8); \
    KRD(GL,1); GAPB(o[1]=__builtin_amdgcn_mfma_f32_32x32x16_bf16(PAF(1),VFR(5),o[1],0,0,0), C0,12); \
    KRD(GL,2); GAPB(o[0]=__builtin_amdgcn_mfma_f32_32x32x16_bf16(PAF(2),VFR(2),o[0],0,0,0), C1,0); \
    KRD(GL,3); GAPB(o[1]=__builtin_amdgcn_mfma_f32_32x32x16_bf16(PAF(2),VFR(6),o[1],0,0,0), C1,4); \
    GAPB(o[0]=__builtin_amdgcn_mfma_f32_32x32x16_bf16(PAF(3),VFR(3),o[0],0,0,0), C1,8); \
    GAPB(o[1]=__builtin_amdgcn_mfma_f32_32x32x16_bf16(PAF(3),VFR(7),o[1],0,0,0), C1,12); \
    }while(0)
  int t=1;
  for(;t<5&&t+5<NTE;t+=2){
    STEP(pB0,pB1,pA0,pA1,t,true,true,true);     WAIT_BAR(2); RESC(); ROT();
    STEP(pA0,pA1,pB0,pB1,t+1,true,true,true);   WAIT_BAR(2); RESC(); ROT();
  }
  #undef CMASK
  #define CMASK(P0,P1,t) do{}while(0)
  for(;t+5<NTE;t+=2){
    STEP(pB0,pB1,pA0,pA1,t,true,true,true);     WAIT_BAR(2); RESC(); ROT();
    STEP(pA0,pA1,pB0,pB1,t+1,true,true,true);   WAIT_BAR(2); RESC(); ROT();
  }
  #undef CMASK
  #define CMASK(P0,P1,t) do{int jb_=3-(t); if(jb_>=0)cmask(P0,P1,jb_,qrel,hi);}while(0)
  #define ENDW(tt) do{ if((tt)+3<NTE){WAIT_BAR(2);} else if((tt)+2<NTE){WAIT_BAR(1);} else {WAIT_BAR(0);} }while(0)
  for(;t+1<NTE;t+=2){
    STEP(pB0,pB1,pA0,pA1,t,(t+3<NTE),(t+1<NTE),(t+1<NTE));       ENDW(t);   RESC(); ROT();
    STEP(pA0,pA1,pB0,pB1,t+1,(t+4<NTE),(t+2<NTE),(t+2<NTE));     ENDW(t+1); RESC(); ROT();
  }
  STEP(pB0,pB1,pA0,pA1,NTE-1,false,false,false); RESC();
  { float sacc=pB0[0]+pB0[1]; _Pragma("unroll") for(int r=2;r<16;++r)sacc+=pB0[r]; _Pragma("unroll") for(int r=0;r<16;++r)sacc+=pB1[r]; l_reg+=sacc;
    pw0=(u32x4){PKW(pB0,0),PKW(pB0,2),PKW(pB0,4),PKW(pB0,6)};pw1=(u32x4){PKW(pB0,8),PKW(pB0,10),PKW(pB0,12),PKW(pB0,14)};pw2=(u32x4){PKW(pB1,0),PKW(pB1,2),PKW(pB1,4),PKW(pB1,6)};pw3=(u32x4){PKW(pB1,8),PKW(pB1,10),PKW(pB1,12),PKW(pB1,14)};
    SBAR(); pv(o,vb0+sl_cur,PAF(0),PAF(1),PAF(2),PAF(3)); }
  #undef PKW
  #undef PAF
  #undef VFR
  #undef PIN
  #undef MX3
  #undef GAPA
  #undef GAPB
  #undef EX
  #undef VRD
  #undef KRD
  #undef STEP
  #undef ENDW
  {auto rr=__builtin_amdgcn_permlane32_swap(__float_as_uint(l_reg),__float_as_uint(l_reg),false,false);l_reg=__uint_as_float(rr[0])+__uint_as_float(rr[1]);}
  if(hi==0)wsf[32+r32]=l_reg;asm volatile("s_waitcnt lgkmcnt(0)":::"memory");
  float rli[16];
  #pragma unroll
  for(int r=0;r<16;++r)rli[r]=__builtin_amdgcn_rcpf(wsf[32+crow(r,hi)]);
  bf16*Ow=Ob+(long)(wid*QBLK)*OPITCH;
  { bf16*stg=(bf16*)(shm+LDS_OST)+wid*2048;
    #pragma unroll
    for(int r=0;r<16;++r){const int orow=crow(r,hi);
      #pragma unroll
      for(int d0=0;d0<2;++d0)stg[orow*64+d0*32+r32]=__float2bfloat16(o[d0][r]*rli[r]);}
    asm volatile("s_waitcnt lgkmcnt(0)":::"memory");
    #pragma unroll
    for(int i=0;i<4;++i){const int row=i*8+(lane>>3),ch=lane&7; const u32x4 v=*(const u32x4*)(stg+row*64+ch*8); if(wid>=wlo&&wid<whi)ATTN_STORE16(Ow+(long)row*OPITCH+ch*8,v);} }
  asm volatile("s_waitcnt lgkmcnt(0)\n\ts_barrier":::"memory");
  #undef DMA_K
  #undef DMA_V
  #undef CMASK
  #undef START
  #undef RESC
  #undef ROT
  #undef CBLOAD
}
constexpr int ATTN_LDS_BYTES=LDS_BYTES;
#undef SBAR
#undef WAIT_BAR
}
#include <hip/hip_cooperative_groups.h>
namespace cg = cooperative_groups;
#ifndef MK_N_LAUNCHES
#define MK_N_LAUNCHES 1
#endif
#ifndef FOX_PRUNE
#define FOX_PRUNE 0
#endif
constexpr int NWAVES = 8, NTHR = 512;
constexpr int DMOD = 1024, TSEQ = 8192, NBATCH = 8, MP = NBATCH * TSEQ, MS = 512, MTOT = MP + MS;
constexpr int NIN = 3584, INC = 3592, FF = 4096, SSEQ = 1152, PAST = 1024, DSEQ = 32;
constexpr int NCHUNK = MTOT / 64;
constexpr float EPSN = 1e-6f, LOG2E = 1.4426950408889634f;
constexpr size_t MiB = 1u << 20;
constexpr size_t WS_CTL = 0, CTL_ZERO_BYTES = 4096;
constexpr size_t WS_WIN = 2 * MiB, WS_WO = 9 * MiB, WS_WUP = 11 * MiB, WS_WDN = 19 * MiB;
constexpr size_t WS_RSTD = 27 * MiB, WS_CGP = 28 * MiB, WS_CGS = 30 * MiB, WS_VEC = 31 * MiB, WS_SSQ = 38 * MiB;
constexpr size_t WS_X1B = 44 * MiB, WS_MIX = 174 * MiB, WS_H = 304 * MiB;
constexpr size_t WS_XB = 304 * MiB, WS_Q = 434 * MiB, WS_K = 498 * MiB, WS_V = 562 * MiB, WS_QS = 626 * MiB, WS_KS = 635 * MiB, WS_VS = 644 * MiB;
constexpr size_t WS_QR = 654 * MiB, WS_KR = 719 * MiB, WS_VH = 784 * MiB, WS_SG = 849 * MiB, WS_END = 914 * MiB;
constexpr size_t VECN = (size_t)NCHUNK * 512;
static_assert(WS_VEC + 3 * VECN * 4 <= WS_SSQ && WS_SSQ + (size_t)MTOT * 16 * 4 <= WS_X1B && WS_X1B + (size_t)MTOT * DMOD * 2 <= WS_MIX && WS_MIX + (size_t)MTOT * DMOD * 2 <= WS_H, "ws map");
static_assert(WS_H + (size_t)MTOT * FF * 2 <= WS_END && WS_XB + (size_t)MTOT * DMOD * 2 <= WS_Q && WS_SG + (size_t)MTOT * 512 * 2 <= WS_END, "ws map 2");
constexpr int CW_QUEUE = 64;
constexpr size_t O_YP = 0, O_YS = O_YP + (size_t)MP * DMOD, O_KP = O_YS + (size_t)256 * DMOD, O_VP = O_KP + (size_t)MP * 512, O_LP = O_VP + (size_t)MP * 512,
                 O_HP = O_LP + (size_t)MP * 8, O_KS = O_HP + 524288, O_VS = O_KS + 131072, O_LS = O_VS + 131072, O_HS = O_LS + 2048, O_END = O_HS + 524288;
constexpr int RING_BYTES = 131072, MISC_OFF = RING_BYTES, LDS_BYTES = 135168;
static_assert(attn_body::ATTN_LDS_BYTES <= RING_BYTES, "attention LDS");

#define LAS __attribute__((address_space(3)))
typedef unsigned short bf16;
typedef unsigned v4u __attribute__((ext_vector_type(4)));
typedef unsigned v2u __attribute__((ext_vector_type(2)));
typedef float f32x4 __attribute__((ext_vector_type(4)));
typedef short bf16x8 __attribute__((ext_vector_type(8)));
#define LDS_WAIT() asm volatile("s_waitcnt lgkmcnt(0)" ::: "memory")
__device__ __forceinline__ unsigned pk2(float lo, float hi) { return pg8::cvt_pk_bf16(lo, hi); }
__device__ __forceinline__ float bf2f(unsigned short b) { return __uint_as_float(((unsigned)b) << 16); }
__device__ __forceinline__ float wave_sum(float v) {
#pragma unroll
    for (int o = 1; o < 64; o <<= 1) v += __shfl_xor(v, o);
    return v;
}
__device__ __forceinline__ bool row_map(int row, int& idx) { if (row < MP) { idx = row; return true; } const int rs = row - MP; idx = (rs >> 6) * 32 + (rs & 63); return (rs & 63) < 32; }

namespace pg8 {
#define DPP_SHR(v, n) __int_as_float(__builtin_amdgcn_update_dpp(0, __float_as_int(v), 0x110 + (n), 0xf, 0xf, false))
struct EpiIn {
    static constexpr bool PERM = false, AFTER_DRAIN = false;
    const float* rstd1; const float* lbl; const float* qg; const float* kg; unsigned char* ws; float* out;
    __device__ __forceinline__ void operator()(const f32x4 (&acc)[2][2][4][2], const Unit& u, int wr, int wc, int fr, int fq) const {
        const int pn = u.pn, rowb = u.pm * BM + wr * 64 + fr; const bool samp = u.pm >= (MP / BM);
        bf16_t* const QR = (bf16_t*)(ws + WS_QR); bf16_t* const KR = (bf16_t*)(ws + WS_KR); bf16_t* const VH = (bf16_t*)(ws + WS_VH); bf16_t* const SG = (bf16_t*)(ws + WS_SG); float* const vec = (float*)(ws + WS_VEC);
        float rs[2][4];
#pragma unroll
        for (int ai = 0; ai < 2; ++ai)
#pragma unroll
            for (int m = 0; m < 4; ++m) rs[ai][m] = rstd1[rowb + ai * HALF + m * 16];
        if (pn < 4) {
            const int h = pn, ch0 = 128 * h + 32 * wc + 4 * fq; const int lane = threadIdx.x & 63; const int a15 = ((lane & 48) | 15) << 2, a0 = (lane & 48) << 2;
#pragma unroll
            for (int n = 0; n < 2; ++n) {
                const f32x4 l0 = *(const f32x4*)(lbl + ch0 + 16 * n), l1 = *(const f32x4*)(lbl + 512 + ch0 + 16 * n);
                f32x4 lb, omlb;
#pragma unroll
                for (int j = 0; j < 4; ++j) { lb[j] = 1.f / (1.f + __expf(l1[j] - l0[j])); omlb[j] = 1.f - lb[j]; }
#pragma unroll
                for (int ai = 0; ai < 2; ++ai) {
                    f32x4 bq[4], kk[4], bb[4]; f32x4 carry = {0.f, 0.f, 0.f, 0.f};
#pragma unroll
                    for (int m = 0; m < 4; ++m) {
#pragma unroll
                        for (int j = 0; j < 4; ++j) {
                            const float zq = acc[ai][0][m][n][j] * rs[ai][m], zf = acc[ai][1][m][n][j] * rs[ai][m];
                            const float sig = 1.f / (1.f + __expf(-zf)); const float f = lb[j] + omlb[j] * sig; float k = omlb[j] * (1.f - sig); float s = __logf(f);
                            if (samp && m >= 2) { s = 0.f; k = 0.f; }
                            s += DPP_SHR(s, 1); s += DPP_SHR(s, 2); s += DPP_SHR(s, 4); s += DPP_SHR(s, 8);
                            s += carry[j]; carry[j] = __int_as_float(__builtin_amdgcn_ds_bpermute(a15, __float_as_int(s)));
                            bq[m][j] = zq; kk[m][j] = k; bb[m][j] = s;
                        }
                    }
                    f32x4 bref;
#pragma unroll
                    for (int j = 0; j < 4; ++j) bref[j] = __int_as_float(__builtin_amdgcn_ds_bpermute(a0, __float_as_int(bb[2][j])));
#pragma unroll
                    for (int m = 0; m < 4; ++m) {
                        float qv[4], kv[4];
#pragma unroll
                        for (int j = 0; j < 4; ++j) { qv[j] = bq[m][j] * __expf(bb[m][j] - bref[j]); kv[j] = kk[m][j] * __expf(bref[j] - bb[m][j]); }
                        const size_t off = (size_t)(rowb + ai * HALF + m * 16) * 512 + ch0 + 16 * n;
                        v2u wq; wq.x = cvt_pk_bf16(qv[0], qv[1]); wq.y = cvt_pk_bf16(qv[2], qv[3]); *(v2u*)(QR + off) = wq;
                        v2u wk; wk.x = cvt_pk_bf16(kv[0], kv[1]); wk.y = cvt_pk_bf16(kv[2], kv[3]); *(v2u*)(KR + off) = wk;
                    }
                    if (fr == 0) {
                        const size_t voff = (size_t)((u.pm * BM + ai * HALF + wr * 64) >> 6) * 512 + ch0 + 16 * n;
                        f32x4 e, d, g;
#pragma unroll
                        for (int j = 0; j < 4; ++j) { e[j] = __expf(bref[j]); d[j] = __expf(carry[j]); g[j] = __expf(carry[j] - bref[j]); }
                        *(f32x4*)(vec + voff) = e; *(f32x4*)(vec + VECN + voff) = d; *(f32x4*)(vec + 2 * VECN + voff) = g;
                    }
                }
            }
        } else if (pn < 8) {
            const int h = pn - 4, c0 = 128 * h + 32 * wc + 4 * fq;
#pragma unroll
            for (int ai = 0; ai < 2; ++ai)
#pragma unroll
                for (int m = 0; m < 4; ++m) { const size_t off = (size_t)(rowb + ai * HALF + m * 16) * 512 + c0; const float r = rs[ai][m];
#pragma unroll
                    for (int n = 0; n < 2; ++n) { const f32x4 v = acc[ai][0][m][n] * r; f32x4 g = acc[ai][1][m][n] * r;
#pragma unroll
                        for (int j = 0; j < 4; ++j) g[j] = g[j] / (1.f + __expf(-g[j]));
                        v2u wv; wv.x = cvt_pk_bf16(v[0], v[1]); wv.y = cvt_pk_bf16(v[2], v[3]); *(v2u*)(VH + off + 16 * n) = wv;
                        v2u wg; wg.x = cvt_pk_bf16(g[0], g[1]); wg.y = cvt_pk_bf16(g[2], g[3]); *(v2u*)(SG + off + 16 * n) = wg; } }
        } else if (pn < 12) {
            const bool isK = pn >= 10; const int head = 4 * ((pn - 8) & 1) + wc; const float* gain = isK ? kg : qg; const float osc = isK ? 1.f : attn_body::C2;
            f32x4 gv[2][2];
#pragma unroll
            for (int bj = 0; bj < 2; ++bj)
#pragma unroll
                for (int n = 0; n < 2; ++n) gv[bj][n] = *(const f32x4*)(gain + 32 * bj + 16 * n + 4 * fq) * osc;
#pragma unroll
            for (int ai = 0; ai < 2; ++ai)
#pragma unroll
                for (int m = 0; m < 4; ++m) { const int row = rowb + ai * HALF + m * 16; const float r = rs[ai][m]; float ssq = 0.f;
#pragma unroll
                    for (int bj = 0; bj < 2; ++bj)
#pragma unroll
                        for (int n = 0; n < 2; ++n) { const f32x4 z = acc[ai][bj][m][n] * r; ssq += (z[0] * z[0] + z[1] * z[1]) + (z[2] * z[2] + z[3] * z[3]); }
                    ssq += __shfl_xor(ssq, 16); ssq += __shfl_xor(ssq, 32);
                    const float r2 = r / sqrtf(ssq * (1.f / 64.f) + EPSN);
                    int idx; const bool valid = row_map(row, idx);
                    float* ofp = out + (samp ? O_KS : O_KP) + (size_t)idx * 512;
                    const size_t boff = samp ? (isK ? WS_KS : WS_QS) : (isK ? WS_K : WS_Q); const size_t brow = samp ? (size_t)((idx >> 5) * SSEQ + PAST + (idx & 31)) : (size_t)row;
                    bf16_t* bfp = (bf16_t*)(ws + boff) + brow * 512;
                    if (valid) {
#pragma unroll
                        for (int bj = 0; bj < 2; ++bj)
#pragma unroll
                            for (int n = 0; n < 2; ++n) { const f32x4 v = acc[ai][bj][m][n] * r2 * gv[bj][n]; const int col = 64 * head + 32 * bj + 16 * n + 4 * fq;
                                if (isK) *(f32x4*)(ofp + col) = v;
                                v2u w; w.x = cvt_pk_bf16(v[0], v[1]); w.y = cvt_pk_bf16(v[2], v[3]); *(v2u*)(bfp + col) = w; } } }
        } else {
            const int c0 = 256 * (pn - 12) + 32 * wc + 4 * fq;
#pragma unroll
            for (int ai = 0; ai < 2; ++ai)
#pragma unroll
                for (int m = 0; m < 4; ++m) { const int row = rowb + ai * HALF + m * 16; const float r = rs[ai][m];
                    int idx; const bool valid = row_map(row, idx);
                    float* ofp = out + (samp ? O_VS : O_VP) + (size_t)idx * 512;
                    const size_t brow = samp ? (size_t)((idx >> 5) * SSEQ + PAST + (idx & 31)) : (size_t)row;
                    bf16_t* bfp = (bf16_t*)(ws + (samp ? WS_VS : WS_V)) + brow * 512;
                    if (valid) {
#pragma unroll
                        for (int bj = 0; bj < 2; ++bj)
#pragma unroll
                            for (int n = 0; n < 2; ++n) { const f32x4 v = acc[ai][bj][m][n] * r; const int col = c0 + 128 * bj + 16 * n;
                                *(f32x4*)(ofp + col) = v;
                                v2u w; w.x = cvt_pk_bf16(v[0], v[1]); w.y = cvt_pk_bf16(v[2], v[3]); *(v2u*)(bfp + col) = w; } } }
        }
    }
};
struct EpiWo {
    static constexpr bool PERM = false, AFTER_DRAIN = false;
    const float* xp; const float* xs; float* yp; float* ys; bf16_t* X1B; float* ssq;
    __device__ __forceinline__ void operator()(const f32x4 (&acc)[2][2][4][2], const Unit& u, int wr, int wc, int fr, int fq) const {
        const int rowb = u.pm * BM + wr * 64 + fr, c0 = u.pn * BM + wc * 32 + 4 * fq; const bool samp = u.pm >= (MP / BM);
#pragma unroll
        for (int ai = 0; ai < 2; ++ai)
#pragma unroll
            for (int m = 0; m < 4; ++m) { const int row = rowb + ai * HALF + m * 16; int idx; const bool valid = row_map(row, idx);
                const float* xr = (samp ? xs : xp) + (size_t)idx * DMOD; float* yr = yp + (samp ? (size_t)MP * DMOD : (size_t)0) + (size_t)idx * DMOD; float s = 0.f;
#pragma unroll
                for (int bj = 0; bj < 2; ++bj)
#pragma unroll
                    for (int n = 0; n < 2; ++n) { const int col = c0 + 128 * bj + 16 * n; f32x4 v = acc[ai][bj][m][n];
                        if (valid) { v += *(const f32x4*)(xr + col); *(f32x4*)(yr + col) = v; }
                        s += (v[0] * v[0] + v[1] * v[1]) + (v[2] * v[2] + v[3] * v[3]);
                        v2u w; w.x = cvt_pk_bf16(v[0], v[1]); w.y = cvt_pk_bf16(v[2], v[3]); *(v2u*)(X1B + (size_t)row * DMOD + col) = w; }
                s += __shfl_xor(s, 16); s += __shfl_xor(s, 32);
                if (fq == 0) ssq[(size_t)row * 16 + 4 * u.pn + wc] = s; }
    }
};
struct EpiUp {
    static constexpr bool PERM = true, AFTER_DRAIN = false;
    bf16_t* O; const float* ssq;
    __device__ __forceinline__ void operator()(const f32x4 (&acc)[2][2][4][2], const Unit& u, int wr, int wc, int fr, int fq) const {
        const int row0 = u.pm * BM + wr * 64 + fr, col0 = u.pn * BM + wc * 32 + 8 * fq;
#pragma unroll
        for (int ai = 0; ai < 2; ++ai)
#pragma unroll
            for (int m = 0; m < 4; ++m) { const int row = row0 + ai * HALF + m * 16; const f32x4* sp = (const f32x4*)(ssq + (size_t)row * 16);
                const f32x4 s0 = sp[0], s1 = sp[1], s2 = sp[2], s3 = sp[3]; const f32x4 st = (s0 + s1) + (s2 + s3);
                const float r = 1.f / sqrtf(((st[0] + st[1]) + (st[2] + st[3])) * (1.f / DMOD) + EPSN);
                bf16_t* rowp = O + (size_t)row * FF + col0;
#pragma unroll
                for (int bj = 0; bj < 2; ++bj) { f32x4 v0 = acc[ai][bj][m][0] * r, v1 = acc[ai][bj][m][1] * r;
#pragma unroll
                    for (int j = 0; j < 4; ++j) { v0[j] = fmaxf(v0[j], 0.f); v0[j] *= v0[j]; v1[j] = fmaxf(v1[j], 0.f); v1[j] *= v1[j]; }
                    u32x4 w; w.x = cvt_pk_bf16(v0[0], v0[1]); w.y = cvt_pk_bf16(v0[2], v0[3]); w.z = cvt_pk_bf16(v1[0], v1[1]); w.w = cvt_pk_bf16(v1[2], v1[3]);
                    *(u32x4*)(rowp + bj * HALF) = w; } }
    }
};
struct EpiDown {
    static constexpr bool PERM = false, AFTER_DRAIN = false;
    float* yp; float* ys;
    __device__ __forceinline__ void operator()(const f32x4 (&acc)[2][2][4][2], const Unit& u, int wr, int wc, int fr, int fq) const {
        const int rowb = u.pm * BM + wr * 64 + fr, c0 = u.pn * BM + wc * 32 + 4 * fq; const bool samp = u.pm >= (MP / BM);
#pragma unroll
        for (int ai = 0; ai < 2; ++ai)
#pragma unroll
            for (int m = 0; m < 4; ++m) { const int row = rowb + ai * HALF + m * 16; int idx; const bool valid = row_map(row, idx);
                float* yr = yp + (samp ? (size_t)MP * DMOD : (size_t)0) + (size_t)idx * DMOD;
                if (valid) {
#pragma unroll
                    for (int bj = 0; bj < 2; ++bj)
#pragma unroll
                        for (int n = 0; n < 2; ++n) { const int col = c0 + 128 * bj + 16 * n; *(f32x4*)(yr + col) = *(const f32x4*)(yr + col) + acc[ai][bj][m][n]; } } }
    }
};
}

struct Args { const float* in[17]; float* out; unsigned char* ws; int ph_lo, ph_hi; };
struct Frame {
    LAS unsigned char* lds; volatile LAS unsigned* MISC; unsigned* ctl; unsigned char* ws; float* out;
    int tid, lane, wave, vcu, G;
    const float *xp, *xs, *ck, *cv, *clf, *sh, *n1, *win, *bff, *qg, *kg, *lbl, *hon, *wout, *n2, *wup, *wdn;
};

__device__ __forceinline__ int win_src_col(int g) {
    const int j0 = 32 * g, tile = j0 >> 8, jl = j0 & 255;
    if (tile < 4) return (jl < 128) ? (128 * tile + jl) : (512 + 128 * tile + (jl - 128));
    if (tile < 8) { const int h = tile - 4; return (jl < 128) ? (1024 + 128 * h + jl) : (1536 + 128 * h + (jl - 128)); }
    if (tile < 12) { const int base = tile < 10 ? 2048 : 2560, tl = (tile - 8) & 1, bj = jl >> 7, wc = (jl >> 5) & 3; return base + 64 * (4 * tl + wc) + 32 * bj; }
    return 3072 + (j0 - 12 * 256);
}
__device__ __forceinline__ void p0_transpose_item(const float* W, int ldw, int K, const float* nrm, bf16* WT, int n0, int src0, int k0, LAS float* scr, int lane) {
#pragma unroll 8
    for (int i = 0; i < 32; ++i) { const int kk = 2 * i + (lane >> 5); float v = W[(size_t)(k0 + kk) * ldw + src0 + (lane & 31)]; if (nrm) v *= nrm[k0 + kk]; scr[kk * 33 + (lane & 31)] = v; }
    LDS_WAIT(); asm volatile("" ::: "memory");
    const int c = lane & 7;
#pragma unroll
    for (int j = 0; j < 4; ++j) { const int n = (lane >> 3) + 8 * j; const LAS float* s = scr + (8 * c) * 33 + n;
        v4u o; o.x = pk2(s[0 * 33], s[1 * 33]); o.y = pk2(s[2 * 33], s[3 * 33]); o.z = pk2(s[4 * 33], s[5 * 33]); o.w = pk2(s[6 * 33], s[7 * 33]);
        *(v4u*)(WT + (size_t)(n0 + n) * K + k0 + 8 * c) = o; }
    LDS_WAIT(); asm volatile("" ::: "memory");
}
__device__ __forceinline__ void p0_prologue(Frame& F) {
    LAS float* scr = (LAS float*)(F.lds + F.wave * 16384);
    const int gw = F.vcu * NWAVES + F.wave, NGW = F.G * NWAVES, lane = F.lane;
    bf16* Win_t = (bf16*)(F.ws + WS_WIN); bf16* Wo_t = (bf16*)(F.ws + WS_WO); bf16* Wup_t = (bf16*)(F.ws + WS_WUP); bf16* Wdn_t = (bf16*)(F.ws + WS_WDN);
    constexpr int I_IN = 16 * (NIN / 32), I_O = 16 * 32, I_UP = 16 * (FF / 32), I_DN = 64 * 32, NITEMS = I_IN + I_O + I_UP + I_DN;
    for (int it = gw; it < NITEMS; it += NGW) {
        int r = it;
        if (r < I_IN) { const int kb = r / (NIN / 32), g = r % (NIN / 32); p0_transpose_item(F.win, INC, DMOD, F.n1, Win_t, 32 * g, win_src_col(g), 64 * kb, scr, lane); continue; } r -= I_IN;
        if (r < I_O) { const int kb = r / 32, g = r % 32; p0_transpose_item(F.wout, DMOD, DMOD, nullptr, Wo_t, 32 * g, 32 * g, 64 * kb, scr, lane); continue; } r -= I_O;
        if (r < I_UP) { const int kb = r / (FF / 32), g = r % (FF / 32); p0_transpose_item(F.wup, FF, DMOD, F.n2, Wup_t, 32 * g, 32 * g, 64 * kb, scr, lane); continue; } r -= I_UP;
        { const int kb = r / 32, g = r % 32; p0_transpose_item(F.wdn, DMOD, FF, nullptr, Wdn_t, 32 * g, 32 * g, 64 * kb, scr, lane); }
    }
    { const int gt = F.vcu * NTHR + F.tid, NGT = F.G * NTHR;
      bf16* Qs = (bf16*)(F.ws + WS_QS); bf16* Ks = (bf16*)(F.ws + WS_KS); bf16* Vs = (bf16*)(F.ws + WS_VS);
      for (int i = gt; i < NBATCH * PAST * 64; i += NGT) { const int b = i / (PAST * 64), rem = i % (PAST * 64); const size_t so = (size_t)i * 8, dof = ((size_t)b * SSEQ * 64 + rem) * 8;
          const f32x4 a0 = *(const f32x4*)(F.ck + so), a1 = *(const f32x4*)(F.ck + so + 4), b0 = *(const f32x4*)(F.cv + so), b1 = *(const f32x4*)(F.cv + so + 4);
          v4u o; o.x = pk2(a0[0], a0[1]); o.y = pk2(a0[2], a0[3]); o.z = pk2(a1[0], a1[1]); o.w = pk2(a1[2], a1[3]); *(v4u*)(Ks + dof) = o;
          o.x = pk2(b0[0], b0[1]); o.y = pk2(b0[2], b0[3]); o.z = pk2(b1[0], b1[1]); o.w = pk2(b1[2], b1[3]); *(v4u*)(Vs + dof) = o; }
      const v4u z = {0u, 0u, 0u, 0u};
      for (int i = gt; i < NBATCH * SSEQ * 64; i += NGT) *(v4u*)(Qs + (size_t)i * 8) = z;
      for (int i = gt; i < NBATCH * (SSEQ - PAST) * 64; i += NGT) { const int b = i / ((SSEQ - PAST) * 64), rem = i % ((SSEQ - PAST) * 64); const size_t dof = ((size_t)(b * SSEQ + PAST) * 64 + rem) * 8; *(v4u*)(Ks + dof) = z; *(v4u*)(Vs + dof) = z; }
    }
    float wf[4][4][8];
#pragma unroll
    for (int j = 0; j < 4; ++j)
#pragma unroll
        for (int i = 0; i < 4; ++i) { const int k = 256 * j + 4 * lane + i; const float nk = F.n1[k]; const f32x4 a = *(const f32x4*)(F.win + (size_t)k * INC + NIN), b = *(const f32x4*)(F.win + (size_t)k * INC + NIN + 4);
            wf[j][i][0] = a[0] * nk; wf[j][i][1] = a[1] * nk; wf[j][i][2] = a[2] * nk; wf[j][i][3] = a[3] * nk; wf[j][i][4] = b[0] * nk; wf[j][i][5] = b[1] * nk; wf[j][i][6] = b[2] * nk; wf[j][i][7] = b[3] * nk; }
    const f32x4 bf0 = *(const f32x4*)(F.bff), bf1 = *(const f32x4*)(F.bff + 4);
    float* rstd1 = (float*)(F.ws + WS_RSTD); bf16* XB = (bf16*)(F.ws + WS_XB);
    for (int m = gw; m < MTOT; m += NGW) {
        int idx; const bool valid = row_map(m, idx); const float* xrow = (m < MP ? F.xp : F.xs) + (size_t)idx * DMOD;
        f32x4 v[4]; float s = 0.f;
#pragma unroll
        for (int j = 0; j < 4; ++j) { v[j] = valid ? *((const f32x4*)xrow + 64 * j + lane) : (f32x4){0.f, 0.f, 0.f, 0.f}; s += (v[j][0] * v[j][0] + v[j][1] * v[j][1]) + (v[j][2] * v[j][2] + v[j][3] * v[j][3]); }
        const float rstd = 1.f / sqrtf(wave_sum(s) * (1.f / DMOD) + EPSN);
        if (lane == 0) rstd1[m] = rstd;
        unsigned long long* o8 = (unsigned long long*)(XB + (size_t)m * DMOD) + lane;
#pragma unroll
        for (int j = 0; j < 4; ++j) o8[64 * j] = (unsigned long long)pk2(v[j][0], v[j][1]) | ((unsigned long long)pk2(v[j][2], v[j][3]) << 32);
        float fb[8];
#pragma unroll
        for (int h = 0; h < 8; ++h) { float a = 0.f;
#pragma unroll
            for (int j = 0; j < 4; ++j)
#pragma unroll
                for (int i = 0; i < 4; ++i) a += v[j][i] * wf[j][i][h];
            fb[h] = wave_sum(a); }
        if (valid && lane == 0) { f32x4 o0, o1;
#pragma unroll
            for (int h = 0; h < 8; ++h) { const float xx = fb[h] * rstd + (h < 4 ? bf0[h & 3] : bf1[h & 3]); const float ls = fminf(xx, 0.f) - log1pf(expf(-fabsf(xx))); if (h < 4) o0[h & 3] = ls; else o1[h & 3] = ls; }
            float* lp = (m < MP ? F.out + O_LP : F.out + O_LS) + (size_t)idx * 8; *(f32x4*)lp = o0; *(f32x4*)(lp + 4) = o1; }
    }
}
__device__ __forceinline__ void scan_chain(Frame& F, int ch) {
    LAS float* wsum = (LAS float*)F.lds;
    const bool samp = ch >= 64; const int c2 = samp ? ch - 64 : ch, b = c2 >> 3, h = c2 & 7; const int L = samp ? SSEQ : TSEQ, EPT = samp ? 3 : 16;
    float* dst = samp ? (float*)(F.ws + WS_CGS) + (size_t)c2 * SSEQ : (float*)(F.ws + WS_CGP) + (size_t)c2 * TSEQ;
    float vals[16]; float sum = 0.f;
#pragma unroll
    for (int i = 0; i < 16; ++i) { const int p = F.tid * EPT + i; float v = 0.f;
        if (i < EPT && p < L) { if (!samp) v = F.out[O_LP + ((size_t)b * TSEQ + p) * 8 + h]; else if (p < PAST) v = F.clf[((size_t)b * PAST + p) * 8 + h]; else if (p < PAST + DSEQ) v = F.out[O_LS + ((size_t)b * DSEQ + (p - PAST)) * 8 + h]; }
        sum += v; vals[i] = sum; }
    float incl = sum;
#pragma unroll
    for (int o = 1; o < 64; o <<= 1) { const float t = __shfl_up(incl, o); if (F.lane >= o) incl += t; }
    if (F.lane == 63) wsum[F.wave] = incl;
    __syncthreads();
    float base = 0.f;
    for (int w = 0; w < F.wave; ++w) base += wsum[w];
    const float excl = base + incl - sum;
#pragma unroll
    for (int i = 0; i < 16; ++i) { const int p = F.tid * EPT + i; if (i < EPT && p < L) dst[p] = (excl + vals[i]) * LOG2E; }
    __syncthreads();
}
constexpr int H_QR = 0, H_KR = 17408, H_KT = 34816, H_VT = 53248, H_VEC = 71680, H_AL = 73216, H_OL = 82432, H_END = 116224;
static_assert(H_END <= RING_BYTES, "hgrn LDS");
__device__ __forceinline__ f32x4 mfma16(bf16x8 a, bf16x8 b, f32x4 c) { return __builtin_amdgcn_mfma_f32_16x16x32_bf16(a, b, c, 0, 0, 0); }
#define LAUNDER(x) asm volatile("" : "+v"(x))
__device__ __forceinline__ void hgrn_chain(Frame& F, int row0, int chunk0, int nsteps, int h, const float* S0, float* Sout) {
    LAS unsigned char* L = F.lds; int tid_ = F.tid; LAUNDER(tid_); const int tid = tid_, lane = tid & 63, w = F.wave, l15 = lane & 15, fq = lane >> 4;
    const char* qb = (const char*)(F.ws + WS_QR) + ((size_t)row0 * 512 + 128 * h) * 2; const char* kb_ = (const char*)(F.ws + WS_KR) + ((size_t)row0 * 512 + 128 * h) * 2;
    const char* vb = (const char*)(F.ws + WS_VH) + ((size_t)row0 * 512 + 128 * h) * 2; const char* gb = (const char*)(F.ws + WS_SG) + ((size_t)row0 * 512 + 128 * h) * 2;
    const char* eb = (const char*)(F.ws + WS_VEC) + ((size_t)chunk0 * 512 + 128 * h) * 4; char* mb = (char*)(F.ws + WS_MIX) + ((size_t)row0 * DMOD + 128 * h) * 2;
    const int oc = tid >> 3, oseg = tid & 7;
    unsigned vo_rm = (unsigned)((tid >> 4) * 1024 + (tid & 15) * 16), vo_t = (unsigned)(lane * 1024 + w * 32), vo_sg = (unsigned)(oc * 1024 + oseg * 32), vo_mix = (unsigned)(oc * 2048 + oseg * 32);
    unsigned vo_vec = (unsigned)((tid >> 5) * (unsigned)(VECN * 4) + (tid & 31) * 16);
    unsigned l_rm = (unsigned)(H_QR + (tid >> 4) * 272 + (tid & 15) * 16);
    unsigned l_tw = (unsigned)(H_KT + (16 * w) * 144 + lane * 2);
    unsigned l_vw = (unsigned)(H_VEC + (tid >> 5) * 512 + (tid & 31) * 16);
    unsigned l_aq = (unsigned)(H_QR + (16 * (w >> 1) + l15) * 272 + fq * 16);
    unsigned l_ak = (unsigned)(H_KR + (32 * (w & 1) + l15) * 272 + fq * 16);
    unsigned l_aw = (unsigned)(H_AL + (16 * (w >> 1) + 4 * fq) * 144 + (32 * (w & 1) + l15) * 2);
    unsigned l_vt = (unsigned)(H_VT + (16 * w + l15) * 144 + fq * 16);
    unsigned l_q2 = (unsigned)(H_QR + l15 * 272 + fq * 8);
    unsigned l_al = (unsigned)(H_AL + l15 * 144 + fq * 16);
    unsigned l_kt = (unsigned)(H_KT + l15 * 144 + fq * 16);
    unsigned l_ve = (unsigned)(H_VEC + fq * 16);
    unsigned l_ow = (unsigned)(H_OL + (4 * fq) * 528 + (16 * w + l15) * 4);
    unsigned l_or = (unsigned)(H_OL + oc * 528 + oseg * 64);
    f32x4 S[8];
#pragma unroll
    for (int kb = 0; kb < 8; ++kb) S[kb] = (f32x4){0.f, 0.f, 0.f, 0.f};
    if (S0) { const float* sp = S0 + (4 * fq) * 128 + 16 * w + l15;
#pragma unroll
        for (int kb = 0; kb < 8; ++kb) { LAUNDER(sp);
#pragma unroll
            for (int r = 0; r < 4; ++r) S[kb][r] = sp[r * 128];
            sp += 16 * 128; } }
    v4u pq[2], pk[2], pkt[2], pvt[2], psgc[2], pvec;
#define HG_LOAD() do { \
        _Pragma("unroll") for (int it = 0; it < 2; ++it) { pq[it] = *(const v4u*)(qb + vo_rm + it * 32768); pk[it] = *(const v4u*)(kb_ + vo_rm + it * 32768); \
            pkt[it] = *(const v4u*)(kb_ + vo_t + it * 16); pvt[it] = *(const v4u*)(vb + vo_t + it * 16); } \
        if (tid < 96) pvec = *(const v4u*)(eb + vo_vec); } while (0)
#define HG_STORE() do { \
        _Pragma("unroll") for (int it = 0; it < 2; ++it) { *(LAS v4u*)(L + l_rm + it * 8704) = pq[it]; *(LAS v4u*)(L + l_rm + (H_KR - H_QR) + it * 8704) = pk[it]; \
            _Pragma("unroll") for (int e = 0; e < 4; ++e) { \
                *(LAS unsigned short*)(L + l_tw + (8 * it + 2 * e) * 144) = (unsigned short)(pkt[it][e] & 0xffffu); *(LAS unsigned short*)(L + l_tw + (8 * it + 2 * e + 1) * 144) = (unsigned short)(pkt[it][e] >> 16); \
                *(LAS unsigned short*)(L + l_tw + (H_VT - H_KT) + (8 * it + 2 * e) * 144) = (unsigned short)(pvt[it][e] & 0xffffu); *(LAS unsigned short*)(L + l_tw + (H_VT - H_KT) + (8 * it + 2 * e + 1) * 144) = (unsigned short)(pvt[it][e] >> 16); } } \
        if (tid < 96) *(LAS v4u*)(L + l_vw) = pvec; } while (0)
#define HG_ADV() do { qb += 65536; kb_ += 65536; vb += 65536; eb += 2048; } while (0)
    HG_LOAD(); HG_ADV(); HG_STORE();
    __syncthreads();
    for (int c = 0; c < nsteps; ++c) {
        LAUNDER(vo_rm); LAUNDER(vo_t); LAUNDER(vo_sg); LAUNDER(vo_mix); LAUNDER(vo_vec); LAUNDER(l_rm); LAUNDER(l_tw); LAUNDER(l_vw); LAUNDER(l_aq); LAUNDER(l_ak); LAUNDER(l_aw);
        LAUNDER(l_vt); LAUNDER(l_q2); LAUNDER(l_al); LAUNDER(l_kt); LAUNDER(l_ve); LAUNDER(l_ow); LAUNDER(l_or);
        psgc[0] = *(const v4u*)(gb + vo_sg); psgc[1] = *(const v4u*)(gb + vo_sg + 16); gb += 65536;
        if (c + 1 < nsteps) { HG_LOAD(); HG_ADV(); }
        { const int cblk = w >> 1;
#pragma unroll
          for (int jj = 0; jj < 2; ++jj) { const int sblk = 2 * (w & 1) + jj; f32x4 a = {0.f, 0.f, 0.f, 0.f};
              if (sblk <= cblk) {
#pragma unroll
                  for (int ks = 0; ks < 4; ++ks) { const bf16x8 af = *(const LAS bf16x8*)(L + l_aq + ks * 64); const bf16x8 bf = *(const LAS bf16x8*)(L + l_ak + jj * 16 * 272 + ks * 64); a = mfma16(af, bf, a); }
#pragma unroll
                  for (int r = 0; r < 4; ++r) if (16 * sblk + l15 > 16 * cblk + 4 * fq + r) a[r] = 0.f;
              }
#pragma unroll
              for (int r = 0; r < 4; ++r) *(LAS unsigned short*)(L + l_aw + r * 144 + jj * 32) = (unsigned short)(pk2(a[r], 0.f) & 0xffffu);
          } }
        __syncthreads();
        { bf16x8 bvt[2];
#pragma unroll
          for (int ks = 0; ks < 2; ++ks) bvt[ks] = *(const LAS bf16x8*)(L + l_vt + ks * 64);
#pragma unroll
          for (int cb = 0; cb < 4; ++cb) { f32x4 o = {0.f, 0.f, 0.f, 0.f};
#pragma unroll
              for (int ks = 0; ks < 2; ++ks) if (32 * ks <= 16 * cb + 15) { const bf16x8 af = *(const LAS bf16x8*)(L + l_al + cb * 16 * 144 + ks * 64); o = mfma16(af, bvt[ks], o); }
#pragma unroll
              for (int kb2 = 0; kb2 < 4; ++kb2) { const v2u lo = *(const LAS v2u*)(L + l_q2 + cb * 16 * 272 + kb2 * 64), hi = *(const LAS v2u*)(L + l_q2 + cb * 16 * 272 + kb2 * 64 + 32);
                  const f32x4 e0 = *(const LAS f32x4*)(L + l_ve + kb2 * 128), e1 = *(const LAS f32x4*)(L + l_ve + kb2 * 128 + 64);
                  v4u sbv; sbv.x = pk2(S[2 * kb2][0] * e0[0], S[2 * kb2][1] * e0[1]); sbv.y = pk2(S[2 * kb2][2] * e0[2], S[2 * kb2][3] * e0[3]); sbv.z = pk2(S[2 * kb2 + 1][0] * e1[0], S[2 * kb2 + 1][1] * e1[1]); sbv.w = pk2(S[2 * kb2 + 1][2] * e1[2], S[2 * kb2 + 1][3] * e1[3]);
                  v4u t; t.x = lo.x; t.y = lo.y; t.z = hi.x; t.w = hi.y; o = mfma16(__builtin_bit_cast(bf16x8, t), __builtin_bit_cast(bf16x8, sbv), o); }
#pragma unroll
              for (int r = 0; r < 4; ++r) *(LAS float*)(L + l_ow + (16 * cb + r) * 528) = o[r];
              __builtin_amdgcn_sched_barrier(0); }
#pragma unroll
          for (int kb = 0; kb < 8; ++kb) { f32x4 t = {0.f, 0.f, 0.f, 0.f};
#pragma unroll
              for (int ks = 0; ks < 2; ++ks) { const bf16x8 af = *(const LAS bf16x8*)(L + l_kt + kb * 16 * 144 + ks * 64); t = mfma16(af, bvt[ks], t); }
              const f32x4 dv = *(const LAS f32x4*)(L + l_ve + 512 + kb * 64), gv = *(const LAS f32x4*)(L + l_ve + 1024 + kb * 64);
#pragma unroll
              for (int r = 0; r < 4; ++r) S[kb][r] = dv[r] * S[kb][r] + gv[r] * t[r];
              __builtin_amdgcn_sched_barrier(0); } }
        __syncthreads();
        { f32x4 ov[4]; float ss = 0.f;
#pragma unroll
          for (int i = 0; i < 4; ++i) { ov[i] = *(const LAS f32x4*)(L + l_or + 16 * i); ss += (ov[i][0] * ov[i][0] + ov[i][1] * ov[i][1]) + (ov[i][2] * ov[i][2] + ov[i][3] * ov[i][3]); }
          ss += __shfl_xor(ss, 1); ss += __shfl_xor(ss, 2); ss += __shfl_xor(ss, 4);
          const float rn = 1.f / sqrtf(ss * (1.f / 128.f) + EPSN);
          float res[16]; f32x4 gn[4]; const float* hp = F.hon + 128 * h + 16 * oseg; LAUNDER(hp);
#pragma unroll
          for (int i = 0; i < 4; ++i) gn[i] = *(const f32x4*)(hp + 4 * i);
#pragma unroll
          for (int i = 0; i < 4; ++i)
#pragma unroll
              for (int j = 0; j < 4; ++j) { const int e = 4 * i + j; const unsigned wd = psgc[e >> 3][(e & 7) >> 1]; const float sg = bf2f((unsigned short)((e & 1) ? (wd >> 16) : (wd & 0xffffu))); res[e] = ov[i][j] * rn * gn[i][j] * sg; }
          v4u o0, o1; o0.x = pk2(res[0], res[1]); o0.y = pk2(res[2], res[3]); o0.z = pk2(res[4], res[5]); o0.w = pk2(res[6], res[7]); o1.x = pk2(res[8], res[9]); o1.y = pk2(res[10], res[11]); o1.z = pk2(res[12], res[13]); o1.w = pk2(res[14], res[15]);
          *(v4u*)(mb + vo_mix) = o0; *(v4u*)(mb + vo_mix + 16) = o1; mb += 131072; }
        if (c + 1 < nsteps) { HG_STORE(); }
        __syncthreads();
    }
    { int ln2 = lane; LAUNDER(ln2); float* sp = Sout + (4 * (ln2 >> 4)) * 128 + 16 * w + (ln2 & 15);
#pragma unroll
      for (int kb = 0; kb < 8; ++kb) { LAUNDER(sp);
#pragma unroll
          for (int r = 0; r < 4; ++r) sp[r * 128] = S[kb][r];
          sp += 16 * 128; } }
#undef HG_LOAD
#undef HG_STORE
#undef HG_ADV
}

__global__ void __launch_bounds__(NTHR, 2) skel_fwd(Args args) {
    extern __shared__ __attribute__((aligned(16))) unsigned char lds[];
    Frame F;
    F.lds = (LAS unsigned char*)lds; F.MISC = (volatile LAS unsigned*)(F.lds + MISC_OFF);
    F.tid = threadIdx.x; F.lane = F.tid & 63; F.wave = __builtin_amdgcn_readfirstlane(F.tid >> 6);
    F.G = gridDim.x; { const int bx = blockIdx.x; F.vcu = (F.G % 8 == 0) ? (bx % 8) * (F.G / 8) + bx / 8 : bx; }
    F.ws = args.ws; F.ctl = (unsigned*)(args.ws + WS_CTL); F.out = args.out;
    F.xp = args.in[0]; F.xs = args.in[1]; F.ck = args.in[2]; F.cv = args.in[3]; F.clf = args.in[4]; F.sh = args.in[5]; F.n1 = args.in[6]; F.win = args.in[7]; F.bff = args.in[8];
    F.qg = args.in[9]; F.kg = args.in[10]; F.lbl = args.in[11]; F.hon = args.in[12]; F.wout = args.in[13]; F.n2 = args.in[14]; F.wup = args.in[15]; F.wdn = args.in[16];
    const int lo = args.ph_lo, hi = args.ph_hi;
#ifndef PH_MASK
#define PH_MASK 63
#endif
#define IN(k) (((PH_MASK >> (k)) & 1) && lo <= (k) && (k) < hi)
#define SEAM(k) do { if (IN(k) && IN((k) + 1)) { cg::this_grid().sync(); } } while (0)
    bf16* XB = (bf16*)(F.ws + WS_XB); bf16* X1B = (bf16*)(F.ws + WS_X1B); bf16* MIX = (bf16*)(F.ws + WS_MIX); bf16* HB = (bf16*)(F.ws + WS_H);
    if (IN(0)) { p0_prologue(F); }
    SEAM(0);
    if (IN(1)) {
#ifndef NO_SCAN
        for (int ch = F.vcu; ch < 128; ch += F.G) scan_chain(F, ch);
#endif
        pg8::Gemm g{XB, (const bf16*)(F.ws + WS_WIN), MTOT, NIN, DMOD}; pg8::StaticOrder S; S.init(MTOT, NIN, F.G, (int)blockIdx.x);
        pg8::EpiIn E{(const float*)(F.ws + WS_RSTD), F.lbl, F.qg, F.kg, F.ws, F.out};
        pg8::gemm_phase<pg8::EpiIn, pg8::StaticOrder, true, true>(F.lds, g, S, E);
    }
    SEAM(1);
    if (IN(2)) {
#ifndef NO_HGRN
        for (int c = F.vcu; c < 64; c += F.G) {
            const bool smp = c >= 32; const int c2 = c & 31, bb = c2 >> 2;
            hgrn_chain(F, smp ? MP + 64 * bb : bb * TSEQ, smp ? MP / 64 + bb : bb * (TSEQ / 64), smp ? 1 : TSEQ / 64, c2 & 3, smp ? F.sh + (size_t)c2 * 16384 : nullptr, F.out + (smp ? O_HS : O_HP) + (size_t)c2 * 16384);
            __syncthreads();
        }
#endif
#ifndef NO_ATTN
        for (;;) {
            if (F.tid == 0) F.MISC[0] = atomicAdd(F.ctl + CW_QUEUE, 1u);
            __syncthreads();
            const int i = (int)F.MISC[0];
            __syncthreads();
            if (i >= 2048 + 64) break;
            typedef attn_body::bf16 abf;
            const bool smp = i >= 2048; const int j = smp ? i - 2048 : i;
            const int bh = j & 63, qb = 31 - (j >> 6), b = bh >> 3, h = bh & 7;
            const int q0 = smp ? SSEQ - 256 : 256 * qb, NT = (q0 + 256) / 64; int NTE = NT;
            const size_t rb = (size_t)b * (smp ? SSEQ : TSEQ);
            const float* cgp = (const float*)(F.ws + (smp ? WS_CGS : WS_CGP)) + (size_t)bh * (smp ? SSEQ : TSEQ);
            const size_t orow = smp ? (size_t)(MP + 64 * b) - (size_t)(PAST - q0) : rb + q0;
            attn_body::attn_unit<8>((const abf*)(F.ws + (smp ? WS_QS : WS_Q)) + (rb + q0) * 512 + 64 * h, (const abf*)(F.ws + (smp ? WS_KS : WS_K)) + rb * 512 + 64 * h, (const abf*)(F.ws + (smp ? WS_VS : WS_V)) + rb * 512 + 64 * h,
                                    (abf*)MIX + orow * DMOD + 512 + 64 * h, NT, NTE, cgp, q0, smp ? (PAST - q0) / 32 : 0, smp ? (PAST - q0) / 32 + 1 : 8, (char*)lds);
        }
#endif
    }
    SEAM(2);
    if (IN(3)) {
        pg8::Gemm g{MIX, (const bf16*)(F.ws + WS_WO), MTOT, DMOD, DMOD}; pg8::StaticOrder S; S.init(MTOT, DMOD, F.G, (int)blockIdx.x);
        pg8::EpiWo E{F.xp, F.xs, F.out + O_YP, F.out + O_YS, X1B, (float*)(F.ws + WS_SSQ)};
        pg8::gemm_phase<pg8::EpiWo, pg8::StaticOrder, true, true>(F.lds, g, S, E);
    }
    SEAM(3);
    if (IN(4)) {
        pg8::Gemm g{X1B, (const bf16*)(F.ws + WS_WUP), MTOT, FF, DMOD}; pg8::StaticOrder S; S.init(MTOT, FF, F.G, (int)blockIdx.x);
        pg8::EpiUp E{HB, (const float*)(F.ws + WS_SSQ)};
        pg8::gemm_phase<pg8::EpiUp, pg8::StaticOrder, true, true>(F.lds, g, S, E);
    }
    SEAM(4);
    if (IN(5)) {
        pg8::Gemm g{HB, (const bf16*)(F.ws + WS_WDN), MTOT, DMOD, FF}; pg8::StaticOrder S; S.init(MTOT, DMOD, F.G, (int)blockIdx.x);
        pg8::EpiDown E{F.out + O_YP, F.out + O_YS};
        pg8::gemm_phase<pg8::EpiDown, pg8::StaticOrder, true, true>(F.lds, g, S, E);
    }
#undef IN
#undef SEAM
}

extern "C" void kernel_launch(void* const* d_in, const int* in_sizes, int n_in, void* d_out, int out_size, void* d_ws, size_t ws_size, hipStream_t stream) {
    static int grid = 0;
    if (grid == 0) {
        if (n_in != 17 || (size_t)out_size != O_END || ws_size < WS_END) { fprintf(stderr, "kernel_launch: unexpected shapes (n_in %d out %d ws %zu)\n", n_in, out_size, ws_size); grid = -1; return; }
        int dev = 0, cus = 0, per_cu = 0;
        if (hipGetDevice(&dev) != hipSuccess || hipDeviceGetAttribute(&cus, hipDeviceAttributeMultiprocessorCount, dev) != hipSuccess) { grid = -1; return; }
        if (hipFuncSetAttribute((const void*)skel_fwd, hipFuncAttributeMaxDynamicSharedMemorySize, LDS_BYTES) != hipSuccess) { fprintf(stderr, "kernel_launch: hipFuncSetAttribute failed\n"); grid = -1; return; }
        if (hipOccupancyMaxActiveBlocksPerMultiprocessor(&per_cu, (const void*)skel_fwd, NTHR, LDS_BYTES) != hipSuccess || per_cu < 1) { fprintf(stderr, "kernel_launch: occupancy query says %d\n", per_cu); per_cu = 1; }
        (void)hipGetLastError();
        grid = cus;
    }
    if (grid < 0) return;
    if (hipMemsetAsync((char*)d_ws + WS_CTL, 0, CTL_ZERO_BYTES, stream) != hipSuccess) { fprintf(stderr, "kernel_launch: memset failed\n"); return; }
    Args a{};
    for (int i = 0; i < 17; ++i) a.in[i] = (const float*)d_in[i];
    a.out = (float*)d_out; a.ws = (unsigned char*)d_ws;
#if MK_N_LAUNCHES == 1
    a.ph_lo = 0; a.ph_hi = 6;
    void* kargs[] = {&a};
    hipError_t e = hipLaunchCooperativeKernel((const void*)skel_fwd, dim3(grid), dim3(NTHR), kargs, LDS_BYTES, stream);
    if (e != hipSuccess) fprintf(stderr, "kernel_launch: cooperative launch failed: %s (grid %d)\n", hipGetErrorString(e), grid);
#else
    for (int li = 0; li < 6; ++li) { a.ph_lo = li; a.ph_hi = li + 1; hipLaunchKernelGGL(skel_fwd, dim3(grid), dim3(NTHR), LDS_BYTES, stream, a); }
#endif
}
```

```cpp
#include <hip/hip_runtime.h>
#include <cstdio>
#include <cstdint>
namespace pg8 {
#define PG8_LAS __attribute__((address_space(3)))
typedef unsigned short bf16_t;
typedef short bf16x8 __attribute__((ext_vector_type(8)));
typedef float f32x4 __attribute__((ext_vector_type(4)));
typedef unsigned u32x4 __attribute__((ext_vector_type(4)));
constexpr int BM = 256, BK = 64, HALF = 128, HTB = HALF * BK * 2  , STAGE_BYTES = 8 * HTB, NXCD = 8, WGM = 8;

__host__ __device__ __forceinline__ int lds_byte(int r, int c) { const int st = (r >> 4) * 2 + (c >> 5), rr = r & 15, cc = c & 31, ob = rr * 64 + cc * 2; return st * 1024 + (ob ^ (((ob >> 9) & 1) << 5)); }
__host__ __device__ __forceinline__ void stage_rc(int b, int& R, int& C) { const int st = b / 1024, sb = b % 1024, swz = sb ^ (((sb >> 9) & 1) << 5); R = (st >> 1) * 16 + swz / 64; C = (st & 1) * 32 + (swz % 64) / 2; }
__host__ __device__ __forceinline__ int perm32(int rho) { const int n = rho >> 4, i = rho & 15; return 8 * (i >> 2) + 4 * n + (i & 3); }

struct Unit { int pm, pn; };
struct Gemm { const bf16_t* A; const bf16_t* Bt; int M, N, K; };

struct StaticOrder {
    int nM, nN, nwg, G, c;
    __host__ __device__ void init(int M, int N, int G_, int c_) { nM = M / BM; nN = N / BM; nwg = nM * nN; G = G_; c = c_; }
    __host__ __device__ bool next(int i, Unit& u) const {
        const long L = (long)i * G + c; if (L >= nwg) return false;
        int wgid = (int)L; { const int q = nwg / NXCD, r = nwg % NXCD, xcd = wgid % NXCD, off = wgid / NXCD; wgid = (xcd < r ? xcd * (q + 1) : r * (q + 1) + (xcd - r) * q) + off; }
        const int nig = WGM * nN, gid = wgid / nig, fm = gid * WGM, gsz = (nM - fm) < WGM ? (nM - fm) : WGM;
        u.pm = fm + ((wgid % nig) % gsz); u.pn = (wgid % nig) / gsz; return true;
    }
    __device__ __forceinline__ void a_ready(const Unit&) const {}
    __device__ __forceinline__ void done(const Unit&) const {}
};

__device__ __forceinline__ unsigned cvt_pk_bf16(float lo, float hi) { unsigned r; asm volatile("v_cvt_pk_bf16_f32 %0, %1, %2" : "=v"(r) : "v"(lo), "v"(hi)); return r; }
typedef float f32x2 __attribute__((ext_vector_type(2)));
template <class Epi, class Sched, bool ALIGN_EPI = false, bool SP2 = false>
__device__ __forceinline__ void gemm_phase(PG8_LAS unsigned char* lds, const Gemm g, const Sched& S, const Epi& E) {
    const int tid = threadIdx.x, wid = __builtin_amdgcn_readfirstlane(tid >> 6), lane = tid & 63, wr = wid >> 2, wc = wid & 3, fr = lane & 15, fq = lane >> 4;
    const int K = g.K, nt = K / BK;
    unsigned voffA[2], voffB[2];
#pragma unroll
    for (int i = 0; i < 2; ++i) { int R, C; stage_rc(tid * 16 + i * 8192, R, C); const int Rb = Epi::PERM ? ((R & ~31) + perm32(R & 31)) : R;
        voffA[i] = (unsigned)(R * K + C) * 2u; voffB[i] = (unsigned)(Rb * K + C) * 2u; }
    const size_t kstep = (size_t)(BK * 2);
    const size_t hstep = (size_t)HALF * K * 2;
    const size_t tstep = 2 * hstep;
    const unsigned ldsw = (unsigned)wid * 1024u;
    const int aoff = lds_byte(wr * 64 + fr, fq * 8), boff = lds_byte(wc * 32 + fr, fq * 8);
#define PG8_SA(b, h) (((b) * 2 + (h)) * HTB)
#define PG8_SB(b, h) ((4 + (b) * 2 + (h)) * HTB)
#define PG8_STAGE(bufoff, gbase, voff) do { _Pragma("unroll") for (int _i = 0; _i < 2; ++_i) \
        __builtin_amdgcn_global_load_lds((const unsigned*)((const char*)(gbase) + (voff)[_i]), (PG8_LAS unsigned*)(lds + (bufoff) + ldsw + _i * 8192), 16, 0, 0); } while (0)
#define PG8_LDA(dst, b, h) do { _Pragma("unroll") for (int m = 0; m < 4; ++m) _Pragma("unroll") for (int k = 0; k < 2; ++k) dst[m][k] = *(const PG8_LAS bf16x8*)(lds + PG8_SA(b, h) + aoff + m * 2048 + k * 1024); } while (0)
#define PG8_LDB(dst, b, h) do { _Pragma("unroll") for (int n = 0; n < 2; ++n) _Pragma("unroll") for (int k = 0; k < 2; ++k) dst[n][k] = *(const PG8_LAS bf16x8*)(lds + PG8_SB(b, h) + boff + n * 2048 + k * 1024); } while (0)
#define PG8_MMA(ai, bj, At, Bt) do { __builtin_amdgcn_s_setprio(1); _Pragma("unroll") for (int m = 0; m < 4; ++m) _Pragma("unroll") for (int n = 0; n < 2; ++n) _Pragma("unroll") for (int k = 0; k < 2; ++k) \
        acc[ai][bj][m][n] = __builtin_amdgcn_mfma_f32_16x16x32_bf16(Bt[n][k], At[m][k], acc[ai][bj][m][n], 0, 0, 0); __builtin_amdgcn_s_setprio(0); } while (0)
#define PG8_WAIT_V(n) asm volatile("s_waitcnt vmcnt(" #n ")" ::: "memory")
#define PG8_WAIT_L(n) asm volatile("s_waitcnt lgkmcnt(" #n ")" ::: "memory")
#define PG8_BAR __builtin_amdgcn_s_barrier()
#define PG8_SCHED __builtin_amdgcn_sched_barrier(0)
    Unit cur, nxt; int ui = 0;
    if (!S.next(0, cur)) return;
    f32x4 acc[2][2][4][2];
#pragma unroll
    for (int a = 0; a < 2; ++a)
#pragma unroll
        for (int b = 0; b < 2; ++b)
#pragma unroll
            for (int m = 0; m < 4; ++m)
#pragma unroll
                for (int n = 0; n < 2; ++n) acc[a][b][m][n] = (f32x4){0.f, 0.f, 0.f, 0.f};
    bf16x8 At[4][2], B0[2][2], B1[2][2];
    const char* cA = (const char*)g.A + (size_t)cur.pm * tstep; const char* cB = (const char*)g.Bt + (size_t)cur.pn * tstep;
    S.a_ready(cur);
    if constexpr (SP2) {
        PG8_STAGE(PG8_SB(0, 0), cB, voffB); PG8_STAGE(PG8_SB(0, 1), cB + hstep, voffB); PG8_STAGE(PG8_SA(0, 0), cA, voffA); PG8_STAGE(PG8_SA(0, 1), cA + hstep, voffA);
        if (wr == 1) PG8_BAR;
        PG8_WAIT_V(2); PG8_BAR;
        PG8_STAGE(PG8_SB(1, 0), cB + kstep, voffB); PG8_STAGE(PG8_SA(1, 0), cA + kstep, voffA); PG8_STAGE(PG8_SB(1, 1), cB + hstep + kstep, voffB);
        PG8_WAIT_V(6); PG8_BAR;
    } else {
        PG8_STAGE(PG8_SB(0, 0), cB, voffB); PG8_STAGE(PG8_SA(0, 0), cA, voffA); PG8_STAGE(PG8_SB(0, 1), cB + hstep, voffB); PG8_STAGE(PG8_SA(0, 1), cA + hstep, voffA);
        if (wr == 1) PG8_BAR;
        PG8_WAIT_V(4); PG8_BAR;
        PG8_STAGE(PG8_SB(1, 0), cB + kstep, voffB); PG8_STAGE(PG8_SA(1, 0), cA + kstep, voffA); PG8_STAGE(PG8_SB(1, 1), cB + hstep + kstep, voffB);
        PG8_WAIT_V(6); PG8_BAR;
    }
    for (;;) {
        const bool has_next = S.next(ui + 1, nxt);
        const char* nA = has_next ? (const char*)g.A + (size_t)nxt.pm * tstep : cA; const char* nB = has_next ? (const char*)g.Bt + (size_t)nxt.pn * tstep : cB;
        for (int t = 0; t < nt; t += 2) {
            const bool last = (t == nt - 2);
            const char* a1 = cA + (size_t)(t + 1) * kstep;
            const char* a2 = last ? nA : cA + (size_t)(t + 2) * kstep; const char* b2 = last ? nB : cB + (size_t)(t + 2) * kstep;
            const char* a3 = a2 + kstep; const char* b3 = b2 + kstep;
            if (last && has_next) S.a_ready(nxt);
            if constexpr (SP2) {
            PG8_LDB(B0, 0, 0); PG8_LDB(B1, 0, 1); PG8_SCHED; PG8_LDA(At, 0, 0); PG8_STAGE(PG8_SA(1, 1), a1 + hstep, voffA);
            PG8_WAIT_V(8); PG8_WAIT_L(0); PG8_BAR; PG8_MMA(0, 0, At, B0); PG8_MMA(0, 1, At, B1); PG8_BAR; PG8_SCHED;
            PG8_LDA(At, 0, 1); PG8_STAGE(PG8_SB(0, 0), b2, voffB); PG8_STAGE(PG8_SB(0, 1), b2 + hstep, voffB); PG8_STAGE(PG8_SA(0, 0), a2, voffA);
            PG8_WAIT_V(8); PG8_WAIT_L(0); PG8_BAR; PG8_MMA(1, 0, At, B0); PG8_MMA(1, 1, At, B1); PG8_BAR; PG8_SCHED;
            PG8_LDB(B0, 1, 0); PG8_LDB(B1, 1, 1); PG8_SCHED; PG8_LDA(At, 1, 0); PG8_STAGE(PG8_SA(0, 1), a2 + hstep, voffA);
            PG8_WAIT_V(8); PG8_WAIT_L(0); PG8_BAR; PG8_MMA(0, 0, At, B0); PG8_MMA(0, 1, At, B1); PG8_BAR; PG8_SCHED;
            PG8_LDA(At, 1, 1); PG8_STAGE(PG8_SB(1, 0), b3, voffB); PG8_STAGE(PG8_SB(1, 1), b3 + hstep, voffB); PG8_STAGE(PG8_SA(1, 0), a3, voffA);
            PG8_WAIT_V(8); PG8_WAIT_L(0); PG8_BAR; PG8_MMA(1, 0, At, B0); PG8_MMA(1, 1, At, B1); PG8_BAR; PG8_SCHED;
            } else {
            PG8_LDB(B0, 0, 0); PG8_SCHED; PG8_LDA(At, 0, 0); PG8_STAGE(PG8_SA(1, 1), a1 + hstep, voffA);
            PG8_WAIT_L(8); PG8_BAR; PG8_WAIT_L(0); PG8_MMA(0, 0, At, B0); PG8_BAR; PG8_SCHED;
            PG8_LDB(B1, 0, 1); PG8_STAGE(PG8_SB(0, 0), b2, voffB);
            PG8_BAR; PG8_WAIT_L(0); PG8_MMA(0, 1, At, B1); PG8_BAR;
            PG8_LDA(At, 0, 1); PG8_STAGE(PG8_SA(0, 0), a2, voffA);
            PG8_BAR; PG8_WAIT_L(0); PG8_MMA(1, 0, At, B0); PG8_BAR; PG8_SCHED;
            PG8_STAGE(PG8_SB(0, 1), b2 + hstep, voffB);
            PG8_WAIT_V(6); PG8_BAR; PG8_MMA(1, 1, At, B1); PG8_BAR;
            PG8_LDB(B0, 1, 0); PG8_SCHED; PG8_LDA(At, 1, 0); PG8_STAGE(PG8_SA(0, 1), a2 + hstep, voffA);
            PG8_WAIT_L(8); PG8_BAR; PG8_WAIT_L(0); PG8_MMA(0, 0, At, B0); PG8_BAR; PG8_SCHED;
            PG8_LDB(B1, 1, 1); PG8_STAGE(PG8_SB(1, 0), b3, voffB);
            PG8_BAR; PG8_WAIT_L(0); PG8_MMA(0, 1, At, B1); PG8_BAR;
            PG8_LDA(At, 1, 1); PG8_STAGE(PG8_SA(1, 0), a3, voffA);
            PG8_BAR; PG8_WAIT_L(0); PG8_MMA(1, 0, At, B0); PG8_BAR; PG8_SCHED;
            PG8_STAGE(PG8_SB(1, 1), b3 + hstep, voffB);
            PG8_WAIT_V(6); PG8_BAR; PG8_MMA(1, 1, At, B1); PG8_BAR;
            }
        }
        if constexpr (ALIGN_EPI) { if (wr == 0) PG8_BAR; }
        if constexpr (!Epi::AFTER_DRAIN) { E(acc, cur, wr, wc, fr, fq); S.done(cur); }
        if (!has_next) break;
#pragma unroll
        for (int a = 0; a < 2; ++a)
#pragma unroll
            for (int b = 0; b < 2; ++b)
#pragma unroll
                for (int m = 0; m < 4; ++m)
#pragma unroll
                    for (int n = 0; n < 2; ++n) acc[a][b][m][n] = (f32x4){0.f, 0.f, 0.f, 0.f};
        cur = nxt; cA = nA; cB = nB; ++ui;
        if constexpr (ALIGN_EPI) { if (wr == 1) PG8_BAR; }
    }
    PG8_WAIT_V(0);
    if constexpr (!ALIGN_EPI) { if (wr == 0) PG8_BAR; }
    PG8_BAR;
    if constexpr (Epi::AFTER_DRAIN) { E.fused(acc, cur, wr, wc, fr, fq, lds, wid, lane); S.done(cur); }
#undef PG8_SA
#undef PG8_SB
#undef PG8_STAGE
#undef PG8_LDA
#undef PG8_LDB
#undef PG8_MMA
#undef PG8_WAIT_V
#undef PG8_WAIT_L
#undef PG8_BAR
#undef PG8_SCHED
}
}
#include <hip/hip_bf16.h>
#include <cmath>
namespace attn_body {
using bf16=__hip_bfloat16;
using bf16x8=__attribute__((ext_vector_type(8)))short;
using s16x4=__attribute__((ext_vector_type(4)))short;
using f32x16=__attribute__((ext_vector_type(16)))float;
using u32x4=__attribute__((ext_vector_type(4)))unsigned;
constexpr int NHEAD=8,D=64,DM=NHEAD*D,OPITCH=1024;
constexpr int NW=8,QBLK=32,QB=QBLK*NW,KVBLK=64;
constexpr int ATTN_PITCH=DM, ATTN_UNIT_ROWS=QB;
__device__ __forceinline__ int crow(int r,int hi){return (r&3)+8*(r>>2)+4*hi;}
#define SBAR() __builtin_amdgcn_sched_barrier(0)
__device__ __forceinline__ void cmask(f32x16&p0,f32x16&p1,int jb,int qrel,int hi){
  const float NEG=-INFINITY; int kb=64*jb+4*hi;
  #pragma unroll
  for(int r=0;r<16;++r){int kv=kb+(r&3)+8*(r>>2); if(kv>qrel)p0[r]=NEG; if(kv+32>qrel)p1[r]=NEG;}
}

constexpr int NSLOT=3, SLOTB=8192;
constexpr int LDS_K=0, LDS_V=NSLOT*SLOTB, LDS_WS=2*NSLOT*SLOTB, LDS_OST=LDS_WS+NW*64*4, LDS_CB=LDS_OST+NW*4096, LDS_BYTES=LDS_CB+32768;
constexpr float C2=0.125f*1.4426950408889634f;
__device__ __forceinline__ void glds16(const void*gsrc,unsigned lds_dst){unsigned keep;
  asm volatile("s_mov_b32 %0, m0\n\ts_mov_b32 m0, %2\n\ts_nop 0\n\tglobal_load_lds_dwordx4 %1, off\n\ts_mov_b32 m0, %0":"=&s"(keep):"v"(gsrc),"s"(lds_dst):"memory");}
__device__ __forceinline__ float max3f(float a,float b,float c){float r;asm("v_max3_f32 %0, %1, %2, %3":"=v"(r):"v"(a),"v"(b),"v"(c));return r;}
__device__ __forceinline__ float max2f(float a,float b){float r;asm("v_max_f32_e32 %0, %1, %2":"=v"(r):"v"(a),"v"(b));return r;}
__device__ __forceinline__ float fadd_s(float a,float b){float r;asm("v_add_f32_e32 %0, %1, %2":"=v"(r):"v"(a),"v"(b));return r;}
__device__ __forceinline__ float fsub_s(float a,float b){float r;asm("v_sub_f32_e32 %0, %1, %2":"=v"(r):"v"(a),"v"(b));return r;}
typedef float f32x2_t __attribute__((ext_vector_type(2))); typedef float f32x4_t __attribute__((ext_vector_type(4))); typedef __bf16 bf16x2_t __attribute__((ext_vector_type(2)));
__device__ __forceinline__ unsigned cvtpk_s(float lo,float hi){f32x2_t v={lo,hi};bf16x2_t b=__builtin_convertvector(v,bf16x2_t);return __builtin_bit_cast(unsigned,b);}
#define WAIT_BAR(N) asm volatile("s_waitcnt vmcnt(" #N ") lgkmcnt(0)\n\ts_barrier":::"memory")

__device__ __forceinline__ void qkt(f32x16&p0,f32x16&p1,const char*Kslot,const bf16x8*qr,int r32,int hi){
  const char*kb=Kslot+hi*1024+r32*16;
  #pragma unroll
  for(int d0=0;d0<4;++d0){
    const bf16x8 b0=*reinterpret_cast<const bf16x8*>(kb+d0*2048);
    const bf16x8 b1=*reinterpret_cast<const bf16x8*>(kb+d0*2048+512);
    p0=__builtin_amdgcn_mfma_f32_32x32x16_bf16(b0,qr[d0],p0,0,0,0);p1=__builtin_amdgcn_mfma_f32_32x32x16_bf16(b1,qr[d0],p1,0,0,0);}
}
typedef __attribute__((address_space(3))) const char* lds_cptr;
typedef short v4i16_t __attribute__((ext_vector_type(4)));
__device__ __forceinline__ void kload8(bf16x8*kf,lds_cptr kp){
  kf[0]=*(const __attribute__((address_space(3))) bf16x8*)(kp);      kf[1]=*(const __attribute__((address_space(3))) bf16x8*)(kp+512);
  kf[2]=*(const __attribute__((address_space(3))) bf16x8*)(kp+2048); kf[3]=*(const __attribute__((address_space(3))) bf16x8*)(kp+2560);
  kf[4]=*(const __attribute__((address_space(3))) bf16x8*)(kp+4096); kf[5]=*(const __attribute__((address_space(3))) bf16x8*)(kp+4608);
  kf[6]=*(const __attribute__((address_space(3))) bf16x8*)(kp+6144); kf[7]=*(const __attribute__((address_space(3))) bf16x8*)(kp+6656);
}
__device__ __forceinline__ void kload2(bf16x8*kf,lds_cptr kp,int j){ kf[2*j]=*(const __attribute__((address_space(3))) bf16x8*)(kp+j*2048); kf[2*j+1]=*(const __attribute__((address_space(3))) bf16x8*)(kp+j*2048+512); }
__device__ __forceinline__ s16x4 vtr(lds_cptr p){ return __builtin_bit_cast(s16x4,__builtin_amdgcn_ds_read_tr16_b64_v4i16((__attribute__((address_space(3))) v4i16_t*)p)); }
__device__ __forceinline__ float rowmax(const f32x16&p0,const f32x16&p1){
  float a=max3f(p0[0],p0[1],p1[0]),b=max3f(p0[2],p0[3],p1[1]);a=max3f(a,p1[2],p1[3]);
  #pragma unroll
  for(int r=4;r<16;r+=4){a=max3f(a,p0[r],p0[r+1]);b=max3f(b,p0[r+2],p0[r+3]);a=max3f(a,p1[r],p1[r+1]);b=max3f(b,p1[r+2],p1[r+3]);}
  const float m=max2f(a,b);
  auto rr=__builtin_amdgcn_permlane32_swap(__float_as_uint(m),__float_as_uint(m),false,false);
  return max2f(__uint_as_float(rr[0]),__uint_as_float(rr[1]));
}
__device__ __forceinline__ void pv(f32x16*o,int vb,bf16x8 pa0,bf16x8 pa1,bf16x8 pa2,bf16x8 pa3){
  #pragma unroll
  for(int d0=0;d0<2;++d0){s16x4 lo[4],hi[4];
    #pragma unroll
    for(int ks=0;ks<4;++ks){
      asm volatile("ds_read_b64_tr_b16 %0,%1 offset:%c2":"=&v"(lo[ks]):"v"(vb),"i"(d0*4096+ks*1024):"memory");
      asm volatile("ds_read_b64_tr_b16 %0,%1 offset:%c2":"=&v"(hi[ks]):"v"(vb),"i"(d0*4096+ks*1024+512):"memory");}
    asm volatile("s_waitcnt lgkmcnt(0)":::"memory");SBAR();
    #define PK(k) (bf16x8){lo[k][0],lo[k][1],lo[k][2],lo[k][3],hi[k][0],hi[k][1],hi[k][2],hi[k][3]}
    o[d0]=__builtin_amdgcn_mfma_f32_32x32x16_bf16(pa0,PK(0),o[d0],0,0,0);
    o[d0]=__builtin_amdgcn_mfma_f32_32x32x16_bf16(pa1,PK(1),o[d0],0,0,0);
    o[d0]=__builtin_amdgcn_mfma_f32_32x32x16_bf16(pa2,PK(2),o[d0],0,0,0);
    o[d0]=__builtin_amdgcn_mfma_f32_32x32x16_bf16(pa3,PK(3),o[d0],0,0,0);
    #undef PK
  }
}

#ifndef ATTN_STORE16
#define ATTN_STORE16(p,v) (*(u32x4*)(p)=(v))
#endif
template<int THRL> __device__ __forceinline__ void attn_unit(const bf16*Qb,const bf16*__restrict__ Kh,const bf16*__restrict__ Vh,bf16*Ob,int NT,int NTE,const float*cgp,int q0,int wlo,int whi,char*shm){
  int tid_=threadIdx.x; asm volatile("":"+v"(tid_)); const int tid=tid_,lane=tid&63,r32=lane&31,hi=lane>>5; const int wid=__builtin_amdgcn_readfirstlane(tid>>6);
  const bf16*Qw=Qb+(long)(wid*QBLK)*DM;
  const unsigned lds0=(unsigned)(uintptr_t)shm;
  float*wsf=(float*)(shm+LDS_WS)+wid*64;
  const bf16*ksrc=Kh+(long)((NT-1)*KVBLK+lane)*DM+wid*8;
  const bf16*vsrc=Vh+(long)((NT-1)*KVBLK+16*(wid&3)+(lane>>2))*DM+(wid>>2)*32+(lane&3)*8;
  const unsigned kdst=lds0+LDS_K+wid*1024, vdst=lds0+LDS_V+wid*1024;
  #define DMA_K(t,slot) glds16(ksrc-(long)(t)*KVBLK*DM,(unsigned)__builtin_amdgcn_readfirstlane(kdst+(slot)))
  #define DMA_V(t,slot) glds16(vsrc-(long)(t)*KVBLK*DM,(unsigned)__builtin_amdgcn_readfirstlane(vdst+(slot)))
  const int vb0=(int)(lds0+LDS_V)+((lane>>4)&1)*32+(lane&3)*8+(4*hi+((lane&15)>>2))*64;
  const char*Kbase=shm+LDS_K; bf16x8 kf[8];
  const lds_cptr shm3=(lds_cptr)shm; const lds_cptr kp0=shm3+LDS_K+hi*1024+r32*16; const lds_cptr vp0=shm3+LDS_V+((lane>>4)&1)*32+(lane&3)*8+(4*hi+((lane&15)>>2))*64;
  { typedef __attribute__((address_space(3))) float lf_t; lf_t* cbw=(lf_t*)((lds_cptr)shm+LDS_CB); const float c0=cgp[q0]; const int jlo=(NT-NTE)*KVBLK, jhi=NT*KVBLK;
    for(int j=jlo+tid;j<jhi;j+=NW*64) cbw[j]=c0-cgp[j]; }
  const __attribute__((address_space(3))) float* cbL=(const __attribute__((address_space(3))) float*)((lds_cptr)shm+LDS_CB)+4*hi;
  #define CBLOAD(C0,C1,t,MH) do{ const __attribute__((address_space(3))) float* cbp_=cbL+(NT-1-(t))*KVBLK; \
    _Pragma("unroll") for(int g_=0;g_<4;++g_){ const f32x4_t v0_=*(const __attribute__((address_space(3))) f32x4_t*)(cbp_+8*g_); const f32x4_t v1_=*(const __attribute__((address_space(3))) f32x4_t*)(cbp_+32+8*g_); \
      C0[4*g_]=v0_[0]-(MH);C0[4*g_+1]=v0_[1]-(MH);C0[4*g_+2]=v0_[2]-(MH);C0[4*g_+3]=v0_[3]-(MH); C1[4*g_]=v1_[0]-(MH);C1[4*g_+1]=v1_[1]-(MH);C1[4*g_+2]=v1_[2]-(MH);C1[4*g_+3]=v1_[3]-(MH);} }while(0)
  DMA_K(0,0);DMA_V(0,0);DMA_K(1,SLOTB);
  bf16x8 qr[4];
  #pragma unroll
  for(int d0=0;d0<4;++d0)qr[d0]=*reinterpret_cast<const bf16x8*>(&Qw[(long)r32*DM+d0*16+hi*8]);
  float mhat=0.f,l_reg=0.f;f32x16 o[2];o[0]=f32x16{};o[1]=f32x16{};
  const int qrel=wid*QBLK+r32;
  #define CMASK(P0,P1,t) do{int jb_=3-(t); if(jb_>=0)cmask(P0,P1,jb_,qrel,hi);}while(0)
  bool resc=false;
  #define START(P0,P1) do{ const float rm=rowmax(P0,P1); resc=false; \
    { const float dl=(rm>-1e30f)?rm:0.f; mhat=fadd_s(mhat,dl); \
      _Pragma("unroll") for(int r=0;r<16;++r){P0[r]=fsub_s(P0[r],dl);P1[r]=fsub_s(P1[r],dl);} } \
    _Pragma("unroll") for(int r=0;r<16;++r)P0[r]=__builtin_amdgcn_exp2f(P0[r]); }while(0)
  #define RESC() do{ if(resc){ asm volatile("s_waitcnt lgkmcnt(0)":::"memory"); \
      _Pragma("unroll") for(int d_=0;d_<2;++d_) _Pragma("unroll") for(int r=0;r<16;++r)o[d_][r]*=wsf[crow(r,hi)]; } }while(0)
  f32x16 pA0,pA1,pB0,pB1;
  int sl_prev=0,sl_cur=0,sl_next=SLOTB;
  #define ROT() do{sl_prev=sl_cur;sl_cur=sl_next;sl_next=(sl_next==(NSLOT-1)*SLOTB)?0:sl_next+SLOTB;}while(0)
  DMA_K(2,2*SLOTB);
  WAIT_BAR(3);
  CBLOAD(pA0,pA1,0,0.f); qkt(pA0,pA1,Kbase,qr,r32,hi);asm volatile("s_nop 15\n\ts_nop 7":"+v"(pA0),"+v"(pA1));CMASK(pA0,pA1,0);
  START(pA0,pA1);
  _Pragma("unroll") for(int r=0;r<16;++r)pA1[r]=__builtin_amdgcn_exp2f(pA1[r]);
  WAIT_BAR(0);
  DMA_K(3,0);DMA_V(1,SLOTB);
  ROT();
  kload8(kf,kp0+sl_cur);
  WAIT_BAR(2);
  s16x4 vlo[8],vhi[8]; u32x4 pw0,pw1,pw2,pw3;
  #define PKW(P,B) cvtpk_s(P[B],P[B+1])
  #define PAF(k) __builtin_bit_cast(bf16x8,pw##k)
  #define VFR(i) (bf16x8){vlo[i][0],vlo[i][1],vlo[i][2],vlo[i][3],vhi[i][0],vhi[i][1],vhi[i][2],vhi[i][3]}
  #define PIN(x) asm volatile("":"+v"(x))
  #define MX3(a,b,c) __builtin_fmaxf(__builtin_fmaxf((a),(b)),(c))
  #define GAPA(MF,A0,A1,A2,A3,W0,W1,PW) do{ MF; sacc+=A0; sacc+=A1; sacc+=A2; sacc+=A3; PIN(sacc); W0; W1; PIN(PW); SBAR(); }while(0)
  #define EX(v) __builtin_amdgcn_exp2f(v)
  #define GAPB(MF,X,B) do{ MF; X[B]=EX(X[B]); X[B+1]=EX(X[B+1]); X[B+2]=EX(X[B+2]); X[B+3]=EX(X[B+3]); PIN(X); SBAR(); }while(0)
  #define VRD(i) do{ vlo[i]=vtr(vp_+(((i)>>2)*4096+((i)&3)*1024)); vhi[i]=vtr(vp_+(((i)>>2)*4096+((i)&3)*1024+512)); }while(0)
  #define KRD(G,j) do{ if(G){ kload2(kf,kp0+sl_next,j); SBAR(); } }while(0)
  #define STEP(C0,C1,P0,P1,t,GK,GV,GL) do{ SBAR(); \
    const lds_cptr vp_=vp0+sl_prev; CBLOAD(C0,C1,t,mhat); SBAR(); \
    VRD(0); SBAR(); float sacc=(P0[0]+P0[1]); \
    GAPA(C0=__builtin_amdgcn_mfma_f32_32x32x16_bf16(kf[0],qr[0],C0,0,0,0), P0[2],P0[3],P0[4],P0[5],     pw0[0]=PKW(P0,0), pw0[1]=PKW(P0,2), pw0); \
    VRD(4); SBAR(); GAPA(C1=__builtin_amdgcn_mfma_f32_32x32x16_bf16(kf[1],qr[0],C1,0,0,0), P0[6],P0[7],P0[8],P0[9],     pw0[2]=PKW(P0,4), pw0[3]=PKW(P0,6), pw0); \
    VRD(1); SBAR(); GAPA(C0=__builtin_amdgcn_mfma_f32_32x32x16_bf16(kf[2],qr[1],C0,0,0,0),   P0[10],P0[11],P0[12],P0[13], pw1[0]=PKW(P0,8), pw1[1]=PKW(P0,10), pw1); \
    VRD(5); SBAR(); GAPA(C1=__builtin_amdgcn_mfma_f32_32x32x16_bf16(kf[3],qr[1],C1,0,0,0),   P0[14],P0[15],P1[0],P1[1],   pw1[2]=PKW(P0,12),pw1[3]=PKW(P0,14), pw1); \
    VRD(2); SBAR(); GAPA(C0=__builtin_amdgcn_mfma_f32_32x32x16_bf16(kf[4],qr[2],C0,0,0,0),   P1[2],P1[3],P1[4],P1[5],     pw2[0]=PKW(P1,0), pw2[1]=PKW(P1,2), pw2); \
    VRD(6); SBAR(); GAPA(C1=__builtin_amdgcn_mfma_f32_32x32x16_bf16(kf[5],qr[2],C1,0,0,0),   P1[6],P1[7],P1[8],P1[9],     pw2[2]=PKW(P1,4), pw2[3]=PKW(P1,6), pw2); \
    VRD(3); SBAR(); GAPA(C0=__builtin_amdgcn_mfma_f32_32x32x16_bf16(kf[6],qr[3],C0,0,0,0),   P1[10],P1[11],P1[12],P1[13], pw3[0]=PKW(P1,8), pw3[1]=PKW(P1,10), pw3); \
    VRD(7); SBAR(); GAPA(C1=__builtin_amdgcn_mfma_f32_32x32x16_bf16(kf[7],qr[3],C1,0,0,0),   P1[14],P1[15],0.f,0.f,       pw3[2]=PKW(P1,12),pw3[3]=PKW(P1,14), pw3); \
    l_reg+=sacc; \
    if(GK){DMA_K((t)+3,sl_cur);} if(GV){DMA_V((t)+1,sl_next);} \
    CMASK(C0,C1,t); \
    { float a=MX3(C0[0],C0[1],C1[0]),b=MX3(C0[2],C0[3],C1[1]); a=MX3(a,C1[2],C1[3]); \
      _Pragma("unroll") for(int r=4;r<16;r+=4){a=MX3(a,C0[r],C0[r+1]);b=MX3(b,C0[r+2],C0[r+3]);a=MX3(a,C1[r],C1[r+1]);b=MX3(b,C1[r+2],C1[r+3]);} \
      float rm=__builtin_fmaxf(a,b); { auto rr=__builtin_amdgcn_permlane32_swap(__float_as_uint(rm),__float_as_uint(rm),false,false); rm=__builtin_fmaxf(__uint_as_float(rr[0]),__uint_as_float(rr[1])); } \
      resc=false; \
      if(__builtin_expect(__any(rm>(float)THRL),0)){ const float dl=__builtin_fmaxf(rm,0.f); mhat+=dl; \
        _Pragma("unroll") for(int r=0;r<16;++r){C0[r]-=dl;C1[r]-=dl;} \
        const float f=__builtin_amdgcn_exp2f(-dl); l_reg*=f; if(hi==0)wsf[r32]=f; resc=true; } } \
    SBAR(); \
    GAPB(o[0]=__builtin_amdgcn_mfma_f32_32x32x16_bf16(PAF(0),VFR(0),o[0],0,0,0), C0,0); \
    GAPB(o[1]=__builtin_amdgcn_mfma_f32_32x32x16_bf16(PAF(0),VFR(4),o[1],0,0,0), C0,4); \
    KRD(GL,0); GAPB(o[0]=__builtin_amdgcn_mfma_f32_32x32x16_bf16(PAF(1),VFR(1),o[0],0,0,0), C0,8); \
    KRD(GL,1); GAPB(o[1]=__builtin_amdgcn_mfma_f32_32x32x16_bf16(PAF(1),VFR(5),o[1],0,0,0), C0,12); \
    KRD(GL,2); GAPB(o[0]=__builtin_amdgcn_mfma_f32_32x32x16_bf16(PAF(2),VFR(2),o[0],0,0,0), C1,0); \
    KRD(GL,3); GAPB(o[1]=__builtin_amdgcn_mfma_f32_32x32x16_bf16(PAF(2),VFR(6),o[1],0,0,0), C1,4); \
    GAPB(o[0]=__builtin_amdgcn_mfma_f32_32x32x16_bf16(PAF(3),VFR(3),o[0],0,0,0), C1,8); \
    GAPB(o[1]=__builtin_amdgcn_mfma_f32_32x32x16_bf16(PAF(3),VFR(7),o[1],0,0,0), C1,12); \
    }while(0)
  int t=1;
  for(;t<5&&t+5<NTE;t+=2){
    STEP(pB0,pB1,pA0,pA1,t,true,true,true);     WAIT_BAR(2); RESC(); ROT();
    STEP(pA0,pA1,pB0,pB1,t+1,true,true,true);   WAIT_BAR(2); RESC(); ROT();
  }
  #undef CMASK
  #define CMASK(P0,P1,t) do{}while(0)
  for(;t+5<NTE;t+=2){
    STEP(pB0,pB1,pA0,pA1,t,true,true,true);     WAIT_BAR(2); RESC(); ROT();
    STEP(pA0,pA1,pB0,pB1,t+1,true,true,true);   WAIT_BAR(2); RESC(); ROT();
  }
  #undef CMASK
  #define CMASK(P0,P1,t) do{int jb_=3-(t); if(jb_>=0)cmask(P0,P1,jb_,qrel,hi);}while(0)
  #define ENDW(tt) do{ if((tt)+3<NTE){WAIT_BAR(2);} else if((tt)+2<NTE){WAIT_BAR(1);} else {WAIT_BAR(0);} }while(0)
  for(;t+1<NTE;t+=2){
    STEP(pB0,pB1,pA0,pA1,t,(t+3<NTE),(t+1<NTE),(t+1<NTE));       ENDW(t);   RESC(); ROT();
    STEP(pA0,pA1,pB0,pB1,t+1,(t+4<NTE),(t+2<NTE),(t+2<NTE));     ENDW(t+1); RESC(); ROT();
  }
  STEP(pB0,pB1,pA0,pA1,NTE-1,false,false,false); RESC();
  { float sacc=pB0[0]+pB0[1]; _Pragma("unroll") for(int r=2;r<16;++r)sacc+=pB0[r]; _Pragma("unroll") for(int r=0;r<16;++r)sacc+=pB1[r]; l_reg+=sacc;
    pw0=(u32x4){PKW(pB0,0),PKW(pB0,2),PKW(pB0,4),PKW(pB0,6)};pw1=(u32x4){PKW(pB0,8),PKW(pB0,10),PKW(pB0,12),PKW(pB0,14)};pw2=(u32x4){PKW(pB1,0),PKW(pB1,2),PKW(pB1,4),PKW(pB1,6)};pw3=(u32x4){PKW(pB1,8),PKW(pB1,10),PKW(pB1,12),PKW(pB1,14)};
    SBAR(); pv(o,vb0+sl_cur,PAF(0),PAF(1),PAF(2),PAF(3)); }
  #undef PKW
  #undef PAF
  #undef VFR
  #undef PIN
  #undef MX3
  #undef GAPA
  #undef GAPB
  #undef EX
  #undef VRD
  #undef KRD
  #undef STEP
  #undef ENDW
  {auto rr=__builtin_amdgcn_permlane32_swap(__float_as_uint(l_reg),__float_as_uint(l_reg),false,false);l_reg=__uint_as_float(rr[0])+__uint_as_float(rr[1]);}
  if(hi==0)wsf[32+r32]=l_reg;asm volatile("s_waitcnt lgkmcnt(0)":::"memory");
  float rli[16];
  #pragma unroll
  for(int r=0;r<16;++r)rli[r]=__builtin_amdgcn_rcpf(wsf[32+crow(r,hi)]);
  bf16*Ow=Ob+(long)(wid*QBLK)*OPITCH;
  { bf16*stg=(bf16*)(shm+LDS_OST)+wid*2048;
    #pragma unroll
    for(int r=0;r<16;++r){const int orow=crow(r,hi);
      #pragma unroll
      for(int d0=0;d0<2;++d0)stg[orow*64+d0*32+r32]=__float2bfloat16(o[d0][r]*rli[r]);}
    asm volatile("s_waitcnt lgkmcnt(0)":::"memory");
    #pragma unroll
    for(int i=0;i<4;++i){const int row=i*8+(lane>>3),ch=lane&7; const u32x4 v=*(const u32x4*)(stg+row*64+ch*8); if(wid>=wlo&&wid<whi)ATTN_STORE16(Ow+(long)row*OPITCH+ch*8,v);} }
  asm volatile("s_waitcnt lgkmcnt(0)\n\ts_barrier":::"memory");
  #undef DMA_K
  #undef DMA_V
  #undef CMASK
  #undef START
  #undef RESC
  #undef ROT
  #undef CBLOAD
}
constexpr int ATTN_LDS_BYTES=LDS_BYTES;
#undef SBAR
#undef WAIT_BAR
}
#include <hip/hip_cooperative_groups.h>
namespace cg = cooperative_groups;
#ifndef MK_N_LAUNCHES
#define MK_N_LAUNCHES 1
#endif
#ifndef FOX_PRUNE
#define FOX_PRUNE 1
#endif
constexpr int NWAVES = 8, NTHR = 512;
constexpr int DMOD = 1024, TSEQ = 8192, NBATCH = 8, MP = NBATCH * TSEQ, MS = 512, MTOT = MP + MS;
constexpr int NIN = 3584, INC = 3592, FF = 4096, SSEQ = 1152, PAST = 1024, DSEQ = 32;
constexpr int NCHUNK = MTOT / 64;
constexpr float EPSN = 1e-6f, LOG2E = 1.4426950408889634f;
constexpr size_t MiB = 1u << 20;
constexpr size_t WS_CTL = 0, CTL_ZERO_BYTES = 4096;
constexpr size_t WS_WIN = 2 * MiB, WS_WO = 9 * MiB, WS_WUP = 11 * MiB, WS_WDN = 19 * MiB;
constexpr size_t WS_RSTD = 27 * MiB, WS_CGP = 28 * MiB, WS_CGS = 30 * MiB, WS_VEC = 31 * MiB, WS_SSQ = 38 * MiB;
constexpr size_t WS_X1B = 44 * MiB, WS_MIX = 174 * MiB, WS_H = 304 * MiB;
constexpr size_t WS_XB = 304 * MiB, WS_Q = 434 * MiB, WS_K = 498 * MiB, WS_V = 562 * MiB, WS_QS = 626 * MiB, WS_KS = 635 * MiB, WS_VS = 644 * MiB;
constexpr size_t WS_QR = 654 * MiB, WS_KR = 719 * MiB, WS_VH = 784 * MiB, WS_SG = 849 * MiB, WS_END = 914 * MiB;
constexpr size_t VECN = (size_t)NCHUNK * 512;
static_assert(WS_VEC + 3 * VECN * 4 <= WS_SSQ && WS_SSQ + (size_t)MTOT * 16 * 4 <= WS_X1B && WS_X1B + (size_t)MTOT * DMOD * 2 <= WS_MIX && WS_MIX + (size_t)MTOT * DMOD * 2 <= WS_H, "ws map");
static_assert(WS_H + (size_t)MTOT * FF * 2 <= WS_END && WS_XB + (size_t)MTOT * DMOD * 2 <= WS_Q && WS_SG + (size_t)MTOT * 512 * 2 <= WS_END, "ws map 2");
constexpr int CW_QUEUE = 64;
constexpr size_t O_YP = 0, O_YS = O_YP + (size_t)MP * DMOD, O_KP = O_YS + (size_t)256 * DMOD, O_VP = O_KP + (size_t)MP * 512, O_LP = O_VP + (size_t)MP * 512,
                 O_HP = O_LP + (size_t)MP * 8, O_KS = O_HP + 524288, O_VS = O_KS + 131072, O_LS = O_VS + 131072, O_HS = O_LS + 2048, O_END = O_HS + 524288;
constexpr int RING_BYTES = 131072, MISC_OFF = RING_BYTES, LDS_BYTES = 135168;
static_assert(attn_body::ATTN_LDS_BYTES <= RING_BYTES, "attention LDS");

#define LAS __attribute__((address_space(3)))
typedef unsigned short bf16;
typedef unsigned v4u __attribute__((ext_vector_type(4)));
typedef unsigned v2u __attribute__((ext_vector_type(2)));
typedef float f32x4 __attribute__((ext_vector_type(4)));
typedef short bf16x8 __attribute__((ext_vector_type(8)));
#define LDS_WAIT() asm volatile("s_waitcnt lgkmcnt(0)" ::: "memory")
__device__ __forceinline__ unsigned pk2(float lo, float hi) { return pg8::cvt_pk_bf16(lo, hi); }
__device__ __forceinline__ float bf2f(unsigned short b) { return __uint_as_float(((unsigned)b) << 16); }
__device__ __forceinline__ float wave_sum(float v) {
#pragma unroll
    for (int o = 1; o < 64; o <<= 1) v += __shfl_xor(v, o);
    return v;
}
__device__ __forceinline__ bool row_map(int row, int& idx) { if (row < MP) { idx = row; return true; } const int rs = row - MP; idx = (rs >> 6) * 32 + (rs & 63); return (rs & 63) < 32; }

namespace pg8 {
#define DPP_SHR(v, n) __int_as_float(__builtin_amdgcn_update_dpp(0, __float_as_int(v), 0x110 + (n), 0xf, 0xf, false))
struct EpiIn {
    static constexpr bool PERM = false, AFTER_DRAIN = false;
    const float* rstd1; const float* lbl; const float* qg; const float* kg; unsigned char* ws; float* out;
    __device__ __forceinline__ void operator()(const f32x4 (&acc)[2][2][4][2], const Unit& u, int wr, int wc, int fr, int fq) const {
        const int pn = u.pn, rowb = u.pm * BM + wr * 64 + fr; const bool samp = u.pm >= (MP / BM);
        bf16_t* const QR = (bf16_t*)(ws + WS_QR); bf16_t* const KR = (bf16_t*)(ws + WS_KR); bf16_t* const VH = (bf16_t*)(ws + WS_VH); bf16_t* const SG = (bf16_t*)(ws + WS_SG); float* const vec = (float*)(ws + WS_VEC);
        float rs[2][4];
#pragma unroll
        for (int ai = 0; ai < 2; ++ai)
#pragma unroll
            for (int m = 0; m < 4; ++m) rs[ai][m] = rstd1[rowb + ai * HALF + m * 16];
        if (pn < 4) {
            const int h = pn, ch0 = 128 * h + 32 * wc + 4 * fq; const int lane = threadIdx.x & 63; const int a15 = ((lane & 48) | 15) << 2, a0 = (lane & 48) << 2;
#pragma unroll
            for (int n = 0; n < 2; ++n) {
                const f32x4 l0 = *(const f32x4*)(lbl + ch0 + 16 * n), l1 = *(const f32x4*)(lbl + 512 + ch0 + 16 * n);
                f32x4 lb, omlb;
#pragma unroll
                for (int j = 0; j < 4; ++j) { lb[j] = 1.f / (1.f + __expf(l1[j] - l0[j])); omlb[j] = 1.f - lb[j]; }
#pragma unroll
                for (int ai = 0; ai < 2; ++ai) {
                    f32x4 bq[4], kk[4], bb[4]; f32x4 carry = {0.f, 0.f, 0.f, 0.f};
#pragma unroll
                    for (int m = 0; m < 4; ++m) {
#pragma unroll
                        for (int j = 0; j < 4; ++j) {
                            const float zq = acc[ai][0][m][n][j] * rs[ai][m], zf = acc[ai][1][m][n][j] * rs[ai][m];
                            const float sig = 1.f / (1.f + __expf(-zf)); const float f = lb[j] + omlb[j] * sig; float k = omlb[j] * (1.f - sig); float s = __logf(f);
                            if (samp && m >= 2) { s = 0.f; k = 0.f; }
                            s += DPP_SHR(s, 1); s += DPP_SHR(s, 2); s += DPP_SHR(s, 4); s += DPP_SHR(s, 8);
                            s += carry[j]; carry[j] = __int_as_float(__builtin_amdgcn_ds_bpermute(a15, __float_as_int(s)));
                            bq[m][j] = zq; kk[m][j] = k; bb[m][j] = s;
                        }
                    }
                    f32x4 bref;
#pragma unroll
                    for (int j = 0; j < 4; ++j) bref[j] = __int_as_float(__builtin_amdgcn_ds_bpermute(a0, __float_as_int(bb[2][j])));
#pragma unroll
                    for (int m = 0; m < 4; ++m) {
                        float qv[4], kv[4];
#pragma unroll
                        for (int j = 0; j < 4; ++j) { qv[j] = bq[m][j] * __expf(bb[m][j] - bref[j]); kv[j] = kk[m][j] * __expf(bref[j] - bb[m][j]); }
                        const size_t off = (size_t)(rowb + ai * HALF + m * 16) * 512 + ch0 + 16 * n;
                        v2u wq; wq.x = cvt_pk_bf16(qv[0], qv[1]); wq.y = cvt_pk_bf16(qv[2], qv[3]); *(v2u*)(QR + off) = wq;
                        v2u wk; wk.x = cvt_pk_bf16(kv[0], kv[1]); wk.y = cvt_pk_bf16(kv[2], kv[3]); *(v2u*)(KR + off) = wk;
                    }
                    if (fr == 0) {
                        const size_t voff = (size_t)((u.pm * BM + ai * HALF + wr * 64) >> 6) * 512 + ch0 + 16 * n;
                        f32x4 e, d, g;
#pragma unroll
                        for (int j = 0; j < 4; ++j) { e[j] = __expf(bref[j]); d[j] = __expf(carry[j]); g[j] = __expf(carry[j] - bref[j]); }
                        *(f32x4*)(vec + voff) = e; *(f32x4*)(vec + VECN + voff) = d; *(f32x4*)(vec + 2 * VECN + voff) = g;
                    }
                }
            }
        } else if (pn < 8) {
            const int h = pn - 4, c0 = 128 * h + 32 * wc + 4 * fq;
#pragma unroll
            for (int ai = 0; ai < 2; ++ai)
#pragma unroll
                for (int m = 0; m < 4; ++m) { const size_t off = (size_t)(rowb + ai * HALF + m * 16) * 512 + c0; const float r = rs[ai][m];
#pragma unroll
                    for (int n = 0; n < 2; ++n) { const f32x4 v = acc[ai][0][m][n] * r; f32x4 g = acc[ai][1][m][n] * r;
#pragma unroll
                        for (int j = 0; j < 4; ++j) g[j] = g[j] / (1.f + __expf(-g[j]));
                        v2u wv; wv.x = cvt_pk_bf16(v[0], v[1]); wv.y = cvt_pk_bf16(v[2], v[3]); *(v2u*)(VH + off + 16 * n) = wv;
                        v2u wg; wg.x = cvt_pk_bf16(g[0], g[1]); wg.y = cvt_pk_bf16(g[2], g[3]); *(v2u*)(SG + off + 16 * n) = wg; } }
        } else if (pn < 12) {
            const bool isK = pn >= 10; const int head = 4 * ((pn - 8) & 1) + wc; const float* gain = isK ? kg : qg; const float osc = isK ? 1.f : attn_body::C2;
            f32x4 gv[2][2];
#pragma unroll
            for (int bj = 0; bj < 2; ++bj)
#pragma unroll
                for (int n = 0; n < 2; ++n) gv[bj][n] = *(const f32x4*)(gain + 32 * bj + 16 * n + 4 * fq) * osc;
#pragma unroll
            for (int ai = 0; ai < 2; ++ai)
#pragma unroll
                for (int m = 0; m < 4; ++m) { const int row = rowb + ai * HALF + m * 16; const float r = rs[ai][m]; float ssq = 0.f;
#pragma unroll
                    for (int bj = 0; bj < 2; ++bj)
#pragma unroll
                        for (int n = 0; n < 2; ++n) { const f32x4 z = acc[ai][bj][m][n] * r; ssq += (z[0] * z[0] + z[1] * z[1]) + (z[2] * z[2] + z[3] * z[3]); }
                    ssq += __shfl_xor(ssq, 16); ssq += __shfl_xor(ssq, 32);
                    const float r2 = r / sqrtf(ssq * (1.f / 64.f) + EPSN);
                    int idx; const bool valid = row_map(row, idx);
                    float* ofp = out + (samp ? O_KS : O_KP) + (size_t)idx * 512;
                    const size_t boff = samp ? (isK ? WS_KS : WS_QS) : (isK ? WS_K : WS_Q); const size_t brow = samp ? (size_t)((idx >> 5) * SSEQ + PAST + (idx & 31)) : (size_t)row;
                    bf16_t* bfp = (bf16_t*)(ws + boff) + brow * 512;
                    if (valid) {
#pragma unroll
                        for (int bj = 0; bj < 2; ++bj)
#pragma unroll
                            for (int n = 0; n < 2; ++n) { const f32x4 v = acc[ai][bj][m][n] * r2 * gv[bj][n]; const int col = 64 * head + 32 * bj + 16 * n + 4 * fq;
                                if (isK) *(f32x4*)(ofp + col) = v;
                                v2u w; w.x = cvt_pk_bf16(v[0], v[1]); w.y = cvt_pk_bf16(v[2], v[3]); *(v2u*)(bfp + col) = w; } } }
        } else {
            const int c0 = 256 * (pn - 12) + 32 * wc + 4 * fq;
#pragma unroll
            for (int ai = 0; ai < 2; ++ai)
#pragma unroll
                for (int m = 0; m < 4; ++m) { const int row = rowb + ai * HALF + m * 16; const float r = rs[ai][m];
                    int idx; const bool valid = row_map(row, idx);
                    float* ofp = out + (samp ? O_VS : O_VP) + (size_t)idx * 512;
                    const size_t brow = samp ? (size_t)((idx >> 5) * SSEQ + PAST + (idx & 31)) : (size_t)row;
                    bf16_t* bfp = (bf16_t*)(ws + (samp ? WS_VS : WS_V)) + brow * 512;
                    if (valid) {
#pragma unroll
                        for (int bj = 0; bj < 2; ++bj)
#pragma unroll
                            for (int n = 0; n < 2; ++n) { const f32x4 v = acc[ai][bj][m][n] * r; const int col = c0 + 128 * bj + 16 * n;
                                *(f32x4*)(ofp + col) = v;
                                v2u w; w.x = cvt_pk_bf16(v[0], v[1]); w.y = cvt_pk_bf16(v[2], v[3]); *(v2u*)(bfp + col) = w; } } }
        }
    }
};
struct EpiWo {
    static constexpr bool PERM = false, AFTER_DRAIN = false;
    const float* xp; const float* xs; float* yp; float* ys; bf16_t* X1B; float* ssq;
    __device__ __forceinline__ void operator()(const f32x4 (&acc)[2][2][4][2], const Unit& u, int wr, int wc, int fr, int fq) const {
        const int rowb = u.pm * BM + wr * 64 + fr, c0 = u.pn * BM + wc * 32 + 4 * fq; const bool samp = u.pm >= (MP / BM);
#pragma unroll
        for (int ai = 0; ai < 2; ++ai)
#pragma unroll
            for (int m = 0; m < 4; ++m) { const int row = rowb + ai * HALF + m * 16; int idx; const bool valid = row_map(row, idx);
                const float* xr = (samp ? xs : xp) + (size_t)idx * DMOD; float* yr = yp + (samp ? (size_t)MP * DMOD : (size_t)0) + (size_t)idx * DMOD; float s = 0.f;
#pragma unroll
                for (int bj = 0; bj < 2; ++bj)
#pragma unroll
                    for (int n = 0; n < 2; ++n) { const int col = c0 + 128 * bj + 16 * n; f32x4 v = acc[ai][bj][m][n];
                        if (valid) { v += *(const f32x4*)(xr + col); *(f32x4*)(yr + col) = v; }
                        s += (v[0] * v[0] + v[1] * v[1]) + (v[2] * v[2] + v[3] * v[3]);
                        v2u w; w.x = cvt_pk_bf16(v[0], v[1]); w.y = cvt_pk_bf16(v[2], v[3]); *(v2u*)(X1B + (size_t)row * DMOD + col) = w; }
                s += __shfl_xor(s, 16); s += __shfl_xor(s, 32);
                if (fq == 0) ssq[(size_t)row * 16 + 4 * u.pn + wc] = s; }
    }
};
struct EpiUp {
    static constexpr bool PERM = true, AFTER_DRAIN = false;
    bf16_t* O; const float* ssq;
    __device__ __forceinline__ void operator()(const f32x4 (&acc)[2][2][4][2], const Unit& u, int wr, int wc, int fr, int fq) const {
        const int row0 = u.pm * BM + wr * 64 + fr, col0 = u.pn * BM + wc * 32 + 8 * fq;
#pragma unroll
        for (int ai = 0; ai < 2; ++ai)
#pragma unroll
            for (int m = 0; m < 4; ++m) { const int row = row0 + ai * HALF + m * 16; const f32x4* sp = (const f32x4*)(ssq + (size_t)row * 16);
                const f32x4 s0 = sp[0], s1 = sp[1], s2 = sp[2], s3 = sp[3]; const f32x4 st = (s0 + s1) + (s2 + s3);
                const float r = 1.f / sqrtf(((st[0] + st[1]) + (st[2] + st[3])) * (1.f / DMOD) + EPSN);
                bf16_t* rowp = O + (size_t)row * FF + col0;
#pragma unroll
                for (int bj = 0; bj < 2; ++bj) { f32x4 v0 = acc[ai][bj][m][0] * r, v1 = acc[ai][bj][m][1] * r;
#pragma unroll
                    for (int j = 0; j < 4; ++j) { v0[j] = fmaxf(v0[j], 0.f); v0[j] *= v0[j]; v1[j] = fmaxf(v1[j], 0.f); v1[j] *= v1[j]; }
                    u32x4 w; w.x = cvt_pk_bf16(v0[0], v0[1]); w.y = cvt_pk_bf16(v0[2], v0[3]); w.z = cvt_pk_bf16(v1[0], v1[1]); w.w = cvt_pk_bf16(v1[2], v1[3]);
                    *(u32x4*)(rowp + bj * HALF) = w; } }
    }
};
struct EpiDown {
    static constexpr bool PERM = false, AFTER_DRAIN = false;
    float* yp; float* ys;
    __device__ __forceinline__ void operator()(const f32x4 (&acc)[2][2][4][2], const Unit& u, int wr, int wc, int fr, int fq) const {
        const int rowb = u.pm * BM + wr * 64 + fr, c0 = u.pn * BM + wc * 32 + 4 * fq; const bool samp = u.pm >= (MP / BM);
#pragma unroll
        for (int ai = 0; ai < 2; ++ai)
#pragma unroll
            for (int m = 0; m < 4; ++m) { const int row = rowb + ai * HALF + m * 16; int idx; const bool valid = row_map(row, idx);
                float* yr = yp + (samp ? (size_t)MP * DMOD : (size_t)0) + (size_t)idx * DMOD;
                if (valid) {
#pragma unroll
                    for (int bj = 0; bj < 2; ++bj)
#pragma unroll
                        for (int n = 0; n < 2; ++n) { const int col = c0 + 128 * bj + 16 * n; *(f32x4*)(yr + col) = *(const f32x4*)(yr + col) + acc[ai][bj][m][n]; } } }
    }
};
}

struct Args { const float* in[17]; float* out; unsigned char* ws; int ph_lo, ph_hi; };
struct Frame {
    LAS unsigned char* lds; volatile LAS unsigned* MISC; unsigned* ctl; unsigned char* ws; float* out;
    int tid, lane, wave, vcu, G;
    const float *xp, *xs, *ck, *cv, *clf, *sh, *n1, *win, *bff, *qg, *kg, *lbl, *hon, *wout, *n2, *wup, *wdn;
};

__device__ __forceinline__ int win_src_col(int g) {
    const int j0 = 32 * g, tile = j0 >> 8, jl = j0 & 255;
    if (tile < 4) return (jl < 128) ? (128 * tile + jl) : (512 + 128 * tile + (jl - 128));
    if (tile < 8) { const int h = tile - 4; return (jl < 128) ? (1024 + 128 * h + jl) : (1536 + 128 * h + (jl - 128)); }
    if (tile < 12) { const int base = tile < 10 ? 2048 : 2560, tl = (tile - 8) & 1, bj = jl >> 7, wc = (jl >> 5) & 3; return base + 64 * (4 * tl + wc) + 32 * bj; }
    return 3072 + (j0 - 12 * 256);
}
__device__ __forceinline__ void p0_transpose_item(const float* W, int ldw, int K, const float* nrm, bf16* WT, int n0, int src0, int k0, LAS float* scr, int lane) {
#pragma unroll 8
    for (int i = 0; i < 32; ++i) { const int kk = 2 * i + (lane >> 5); float v = W[(size_t)(k0 + kk) * ldw + src0 + (lane & 31)]; if (nrm) v *= nrm[k0 + kk]; scr[kk * 33 + (lane & 31)] = v; }
    LDS_WAIT(); asm volatile("" ::: "memory");
    const int c = lane & 7;
#pragma unroll
    for (int j = 0; j < 4; ++j) { const int n = (lane >> 3) + 8 * j; const LAS float* s = scr + (8 * c) * 33 + n;
        v4u o; o.x = pk2(s[0 * 33], s[1 * 33]); o.y = pk2(s[2 * 33], s[3 * 33]); o.z = pk2(s[4 * 33], s[5 * 33]); o.w = pk2(s[6 * 33], s[7 * 33]);
        *(v4u*)(WT + (size_t)(n0 + n) * K + k0 + 8 * c) = o; }
    LDS_WAIT(); asm volatile("" ::: "memory");
}
__device__ __forceinline__ void p0_prologue(Frame& F) {
    LAS float* scr = (LAS float*)(F.lds + F.wave * 16384);
    const int gw = F.vcu * NWAVES + F.wave, NGW = F.G * NWAVES, lane = F.lane;
    bf16* Win_t = (bf16*)(F.ws + WS_WIN); bf16* Wo_t = (bf16*)(F.ws + WS_WO); bf16* Wup_t = (bf16*)(F.ws + WS_WUP); bf16* Wdn_t = (bf16*)(F.ws + WS_WDN);
    constexpr int I_IN = 16 * (NIN / 32), I_O = 16 * 32, I_UP = 16 * (FF / 32), I_DN = 64 * 32, NITEMS = I_IN + I_O + I_UP + I_DN;
    for (int it = gw; it < NITEMS; it += NGW) {
        int r = it;
        if (r < I_IN) { const int kb = r / (NIN / 32), g = r % (NIN / 32); p0_transpose_item(F.win, INC, DMOD, F.n1, Win_t, 32 * g, win_src_col(g), 64 * kb, scr, lane); continue; } r -= I_IN;
        if (r < I_O) { const int kb = r / 32, g = r % 32; p0_transpose_item(F.wout, DMOD, DMOD, nullptr, Wo_t, 32 * g, 32 * g, 64 * kb, scr, lane); continue; } r -= I_O;
        if (r < I_UP) { const int kb = r / (FF / 32), g = r % (FF / 32); p0_transpose_item(F.wup, FF, DMOD, F.n2, Wup_t, 32 * g, 32 * g, 64 * kb, scr, lane); continue; } r -= I_UP;
        { const int kb = r / 32, g = r % 32; p0_transpose_item(F.wdn, DMOD, FF, nullptr, Wdn_t, 32 * g, 32 * g, 64 * kb, scr, lane); }
    }
    { const int gt = F.vcu * NTHR + F.tid, NGT = F.G * NTHR;
      bf16* Qs = (bf16*)(F.ws + WS_QS); bf16* Ks = (bf16*)(F.ws + WS_KS); bf16* Vs = (bf16*)(F.ws + WS_VS);
      for (int i = gt; i < NBATCH * PAST * 64; i += NGT) { const int b = i / (PAST * 64), rem = i % (PAST * 64); const size_t so = (size_t)i * 8, dof = ((size_t)b * SSEQ * 64 + rem) * 8;
          const f32x4 a0 = *(const f32x4*)(F.ck + so), a1 = *(const f32x4*)(F.ck + so + 4), b0 = *(const f32x4*)(F.cv + so), b1 = *(const f32x4*)(F.cv + so + 4);
          v4u o; o.x = pk2(a0[0], a0[1]); o.y = pk2(a0[2], a0[3]); o.z = pk2(a1[0], a1[1]); o.w = pk2(a1[2], a1[3]); *(v4u*)(Ks + dof) = o;
          o.x = pk2(b0[0], b0[1]); o.y = pk2(b0[2], b0[3]); o.z = pk2(b1[0], b1[1]); o.w = pk2(b1[2], b1[3]); *(v4u*)(Vs + dof) = o; }
      const v4u z = {0u, 0u, 0u, 0u};
      for (int i = gt; i < NBATCH * SSEQ * 64; i += NGT) *(v4u*)(Qs + (size_t)i * 8) = z;
      for (int i = gt; i < NBATCH * (SSEQ - PAST) * 64; i += NGT) { const int b = i / ((SSEQ - PAST) * 64), rem = i % ((SSEQ - PAST) * 64); const size_t dof = ((size_t)(b * SSEQ + PAST) * 64 + rem) * 8; *(v4u*)(Ks + dof) = z; *(v4u*)(Vs + dof) = z; }
    }
    float wf[4][4][8];
#pragma unroll
    for (int j = 0; j < 4; ++j)
#pragma unroll
        for (int i = 0; i < 4; ++i) { const int k = 256 * j + 4 * lane + i; const float nk = F.n1[k]; const f32x4 a = *(const f32x4*)(F.win + (size_t)k * INC + NIN), b = *(const f32x4*)(F.win + (size_t)k * INC + NIN + 4);
            wf[j][i][0] = a[0] * nk; wf[j][i][1] = a[1] * nk; wf[j][i][2] = a[2] * nk; wf[j][i][3] = a[3] * nk; wf[j][i][4] = b[0] * nk; wf[j][i][5] = b[1] * nk; wf[j][i][6] = b[2] * nk; wf[j][i][7] = b[3] * nk; }
    const f32x4 bf0 = *(const f32x4*)(F.bff), bf1 = *(const f32x4*)(F.bff + 4);
    float* rstd1 = (float*)(F.ws + WS_RSTD); bf16* XB = (bf16*)(F.ws + WS_XB);
    for (int m = gw; m < MTOT; m += NGW) {
        int idx; const bool valid = row_map(m, idx); const float* xrow = (m < MP ? F.xp : F.xs) + (size_t)idx * DMOD;
        f32x4 v[4]; float s = 0.f;
#pragma unroll
        for (int j = 0; j < 4; ++j) { v[j] = valid ? *((const f32x4*)xrow + 64 * j + lane) : (f32x4){0.f, 0.f, 0.f, 0.f}; s += (v[j][0] * v[j][0] + v[j][1] * v[j][1]) + (v[j][2] * v[j][2] + v[j][3] * v[j][3]); }
        const float rstd = 1.f / sqrtf(wave_sum(s) * (1.f / DMOD) + EPSN);
        if (lane == 0) rstd1[m] = rstd;
        unsigned long long* o8 = (unsigned long long*)(XB + (size_t)m * DMOD) + lane;
#pragma unroll
        for (int j = 0; j < 4; ++j) o8[64 * j] = (unsigned long long)pk2(v[j][0], v[j][1]) | ((unsigned long long)pk2(v[j][2], v[j][3]) << 32);
        float fb[8];
#pragma unroll
        for (int h = 0; h < 8; ++h) { float a = 0.f;
#pragma unroll
            for (int j = 0; j < 4; ++j)
#pragma unroll
                for (int i = 0; i < 4; ++i) a += v[j][i] * wf[j][i][h];
            fb[h] = wave_sum(a); }
        if (valid && lane == 0) { f32x4 o0, o1;
#pragma unroll
            for (int h = 0; h < 8; ++h) { const float xx = fb[h] * rstd + (h < 4 ? bf0[h & 3] : bf1[h & 3]); const float ls = fminf(xx, 0.f) - log1pf(expf(-fabsf(xx))); if (h < 4) o0[h & 3] = ls; else o1[h & 3] = ls; }
            float* lp = (m < MP ? F.out + O_LP : F.out + O_LS) + (size_t)idx * 8; *(f32x4*)lp = o0; *(f32x4*)(lp + 4) = o1; }
    }
}
__device__ __forceinline__ void scan_chain(Frame& F, int ch) {
    LAS float* wsum = (LAS float*)F.lds;
    const bool samp = ch >= 64; const int c2 = samp ? ch - 64 : ch, b = c2 >> 3, h = c2 & 7; const int L = samp ? SSEQ : TSEQ, EPT = samp ? 3 : 16;
    float* dst = samp ? (float*)(F.ws + WS_CGS) + (size_t)c2 * SSEQ : (float*)(F.ws + WS_CGP) + (size_t)c2 * TSEQ;
    float vals[16]; float sum = 0.f;
#pragma unroll
    for (int i = 0; i < 16; ++i) { const int p = F.tid * EPT + i; float v = 0.f;
        if (i < EPT && p < L) { if (!samp) v = F.out[O_LP + ((size_t)b * TSEQ + p) * 8 + h]; else if (p < PAST) v = F.clf[((size_t)b * PAST + p) * 8 + h]; else if (p < PAST + DSEQ) v = F.out[O_LS + ((size_t)b * DSEQ + (p - PAST)) * 8 + h]; }
        sum += v; vals[i] = sum; }
    float incl = sum;
#pragma unroll
    for (int o = 1; o < 64; o <<= 1) { const float t = __shfl_up(incl, o); if (F.lane >= o) incl += t; }
    if (F.lane == 63) wsum[F.wave] = incl;
    __syncthreads();
    float base = 0.f;
    for (int w = 0; w < F.wave; ++w) base += wsum[w];
    const float excl = base + incl - sum;
#pragma unroll
    for (int i = 0; i < 16; ++i) { const int p = F.tid * EPT + i; if (i < EPT && p < L) dst[p] = (excl + vals[i]) * LOG2E; }
    __syncthreads();
}
constexpr int H_QR = 0, H_KR = 17408, H_KT = 34816, H_VT = 53248, H_VEC = 71680, H_AL = 73216, H_OL = 82432, H_END = 116224;
static_assert(H_END <= RING_BYTES, "hgrn LDS");
__device__ __forceinline__ f32x4 mfma16(bf16x8 a, bf16x8 b, f32x4 c) { return __builtin_amdgcn_mfma_f32_16x16x32_bf16(a, b, c, 0, 0, 0); }
#define LAUNDER(x) asm volatile("" : "+v"(x))
__device__ __forceinline__ void hgrn_chain(Frame& F, int row0, int chunk0, int nsteps, int h, const float* S0, float* Sout) {
    LAS unsigned char* L = F.lds; int tid_ = F.tid; LAUNDER(tid_); const int tid = tid_, lane = tid & 63, w = F.wave, l15 = lane & 15, fq = lane >> 4;
    const char* qb = (const char*)(F.ws + WS_QR) + ((size_t)row0 * 512 + 128 * h) * 2; const char* kb_ = (const char*)(F.ws + WS_KR) + ((size_t)row0 * 512 + 128 * h) * 2;
    const char* vb = (const char*)(F.ws + WS_VH) + ((size_t)row0 * 512 + 128 * h) * 2; const char* gb = (const char*)(F.ws + WS_SG) + ((size_t)row0 * 512 + 128 * h) * 2;
    const char* eb = (const char*)(F.ws + WS_VEC) + ((size_t)chunk0 * 512 + 128 * h) * 4; char* mb = (char*)(F.ws + WS_MIX) + ((size_t)row0 * DMOD + 128 * h) * 2;
    const int oc = tid >> 3, oseg = tid & 7;
    unsigned vo_rm = (unsigned)((tid >> 4) * 1024 + (tid & 15) * 16), vo_t = (unsigned)(lane * 1024 + w * 32), vo_sg = (unsigned)(oc * 1024 + oseg * 32), vo_mix = (unsigned)(oc * 2048 + oseg * 32);
    unsigned vo_vec = (unsigned)((tid >> 5) * (unsigned)(VECN * 4) + (tid & 31) * 16);
    unsigned l_rm = (unsigned)(H_QR + (tid >> 4) * 272 + (tid & 15) * 16);
    unsigned l_tw = (unsigned)(H_KT + (16 * w) * 144 + lane * 2);
    unsigned l_vw = (unsigned)(H_VEC + (tid >> 5) * 512 + (tid & 31) * 16);
    unsigned l_aq = (unsigned)(H_QR + (16 * (w >> 1) + l15) * 272 + fq * 16);
    unsigned l_ak = (unsigned)(H_KR + (32 * (w & 1) + l15) * 272 + fq * 16);
    unsigned l_aw = (unsigned)(H_AL + (16 * (w >> 1) + 4 * fq) * 144 + (32 * (w & 1) + l15) * 2);
    unsigned l_vt = (unsigned)(H_VT + (16 * w + l15) * 144 + fq * 16);
    unsigned l_q2 = (unsigned)(H_QR + l15 * 272 + fq * 8);
    unsigned l_al = (unsigned)(H_AL + l15 * 144 + fq * 16);
    unsigned l_kt = (unsigned)(H_KT + l15 * 144 + fq * 16);
    unsigned l_ve = (unsigned)(H_VEC + fq * 16);
    unsigned l_ow = (unsigned)(H_OL + (4 * fq) * 528 + (16 * w + l15) * 4);
    unsigned l_or = (unsigned)(H_OL + oc * 528 + oseg * 64);
    f32x4 S[8];
#pragma unroll
    for (int kb = 0; kb < 8; ++kb) S[kb] = (f32x4){0.f, 0.f, 0.f, 0.f};
    if (S0) { const float* sp = S0 + (4 * fq) * 128 + 16 * w + l15;
#pragma unroll
        for (int kb = 0; kb < 8; ++kb) { LAUNDER(sp);
#pragma unroll
            for (int r = 0; r < 4; ++r) S[kb][r] = sp[r * 128];
            sp += 16 * 128; } }
    v4u pq[2], pk[2], pkt[2], pvt[2], psgc[2], pvec;
#define HG_LOAD() do { \
        _Pragma("unroll") for (int it = 0; it < 2; ++it) { pq[it] = *(const v4u*)(qb + vo_rm + it * 32768); pk[it] = *(const v4u*)(kb_ + vo_rm + it * 32768); \
            pkt[it] = *(const v4u*)(kb_ + vo_t + it * 16); pvt[it] = *(const v4u*)(vb + vo_t + it * 16); } \
        if (tid < 96) pvec = *(const v4u*)(eb + vo_vec); } while (0)
#define HG_STORE() do { \
        _Pragma("unroll") for (int it = 0; it < 2; ++it) { *(LAS v4u*)(L + l_rm + it * 8704) = pq[it]; *(LAS v4u*)(L + l_rm + (H_KR - H_QR) + it * 8704) = pk[it]; \
            _Pragma("unroll") for (int e = 0; e < 4; ++e) { \
                *(LAS unsigned short*)(L + l_tw + (8 * it + 2 * e) * 144) = (unsigned short)(pkt[it][e] & 0xffffu); *(LAS unsigned short*)(L + l_tw + (8 * it + 2 * e + 1) * 144) = (unsigned short)(pkt[it][e] >> 16); \
                *(LAS unsigned short*)(L + l_tw + (H_VT - H_KT) + (8 * it + 2 * e) * 144) = (unsigned short)(pvt[it][e] & 0xffffu); *(LAS unsigned short*)(L + l_tw + (H_VT - H_KT) + (8 * it + 2 * e + 1) * 144) = (unsigned short)(pvt[it][e] >> 16); } } \
        if (tid < 96) *(LAS v4u*)(L + l_vw) = pvec; } while (0)
#define HG_ADV() do { qb += 65536; kb_ += 65536; vb += 65536; eb += 2048; } while (0)
    HG_LOAD(); HG_ADV(); HG_STORE();
    __syncthreads();
    for (int c = 0; c < nsteps; ++c) {
        LAUNDER(vo_rm); LAUNDER(vo_t); LAUNDER(vo_sg); LAUNDER(vo_mix); LAUNDER(vo_vec); LAUNDER(l_rm); LAUNDER(l_tw); LAUNDER(l_vw); LAUNDER(l_aq); LAUNDER(l_ak); LAUNDER(l_aw);
        LAUNDER(l_vt); LAUNDER(l_q2); LAUNDER(l_al); LAUNDER(l_kt); LAUNDER(l_ve); LAUNDER(l_ow); LAUNDER(l_or);
        psgc[0] = *(const v4u*)(gb + vo_sg); psgc[1] = *(const v4u*)(gb + vo_sg + 16); gb += 65536;
        if (c + 1 < nsteps) { HG_LOAD(); HG_ADV(); }
        { const int cblk = w >> 1;
#pragma unroll
          for (int jj = 0; jj < 2; ++jj) { const int sblk = 2 * (w & 1) + jj; f32x4 a = {0.f, 0.f, 0.f, 0.f};
              if (sblk <= cblk) {
#pragma unroll
                  for (int ks = 0; ks < 4; ++ks) { const bf16x8 af = *(const LAS bf16x8*)(L + l_aq + ks * 64); const bf16x8 bf = *(const LAS bf16x8*)(L + l_ak + jj * 16 * 272 + ks * 64); a = mfma16(af, bf, a); }
#pragma unroll
                  for (int r = 0; r < 4; ++r) if (16 * sblk + l15 > 16 * cblk + 4 * fq + r) a[r] = 0.f;
              }
#pragma unroll
              for (int r = 0; r < 4; ++r) *(LAS unsigned short*)(L + l_aw + r * 144 + jj * 32) = (unsigned short)(pk2(a[r], 0.f) & 0xffffu);
          } }
        __syncthreads();
        { bf16x8 bvt[2];
#pragma unroll
          for (int ks = 0; ks < 2; ++ks) bvt[ks] = *(const LAS bf16x8*)(L + l_vt + ks * 64);
#pragma unroll
          for (int cb = 0; cb < 4; ++cb) { f32x4 o = {0.f, 0.f, 0.f, 0.f};
#pragma unroll
              for (int ks = 0; ks < 2; ++ks) if (32 * ks <= 16 * cb + 15) { const bf16x8 af = *(const LAS bf16x8*)(L + l_al + cb * 16 * 144 + ks * 64); o = mfma16(af, bvt[ks], o); }
#pragma unroll
              for (int kb2 = 0; kb2 < 4; ++kb2) { const v2u lo = *(const LAS v2u*)(L + l_q2 + cb * 16 * 272 + kb2 * 64), hi = *(const LAS v2u*)(L + l_q2 + cb * 16 * 272 + kb2 * 64 + 32);
                  const f32x4 e0 = *(const LAS f32x4*)(L + l_ve + kb2 * 128), e1 = *(const LAS f32x4*)(L + l_ve + kb2 * 128 + 64);
                  v4u sbv; sbv.x = pk2(S[2 * kb2][0] * e0[0], S[2 * kb2][1] * e0[1]); sbv.y = pk2(S[2 * kb2][2] * e0[2], S[2 * kb2][3] * e0[3]); sbv.z = pk2(S[2 * kb2 + 1][0] * e1[0], S[2 * kb2 + 1][1] * e1[1]); sbv.w = pk2(S[2 * kb2 + 1][2] * e1[2], S[2 * kb2 + 1][3] * e1[3]);
                  v4u t; t.x = lo.x; t.y = lo.y; t.z = hi.x; t.w = hi.y; o = mfma16(__builtin_bit_cast(bf16x8, t), __builtin_bit_cast(bf16x8, sbv), o); }
#pragma unroll
              for (int r = 0; r < 4; ++r) *(LAS float*)(L + l_ow + (16 * cb + r) * 528) = o[r];
              __builtin_amdgcn_sched_barrier(0); }
#pragma unroll
          for (int kb = 0; kb < 8; ++kb) { f32x4 t = {0.f, 0.f, 0.f, 0.f};
#pragma unroll
              for (int ks = 0; ks < 2; ++ks) { const bf16x8 af = *(const LAS bf16x8*)(L + l_kt + kb * 16 * 144 + ks * 64); t = mfma16(af, bvt[ks], t); }
              const f32x4 dv = *(const LAS f32x4*)(L + l_ve + 512 + kb * 64), gv = *(const LAS f32x4*)(L + l_ve + 1024 + kb * 64);
#pragma unroll
              for (int r = 0; r < 4; ++r) S[kb][r] = dv[r] * S[kb][r] + gv[r] * t[r];
              __builtin_amdgcn_sched_barrier(0); } }
        __syncthreads();
        { f32x4 ov[4]; float ss = 0.f;
#pragma unroll
          for (int i = 0; i < 4; ++i) { ov[i] = *(const LAS f32x4*)(L + l_or + 16 * i); ss += (ov[i][0] * ov[i][0] + ov[i][1] * ov[i][1]) + (ov[i][2] * ov[i][2] + ov[i][3] * ov[i][3]); }
          ss += __shfl_xor(ss, 1); ss += __shfl_xor(ss, 2); ss += __shfl_xor(ss, 4);
          const float rn = 1.f / sqrtf(ss * (1.f / 128.f) + EPSN);
          float res[16]; f32x4 gn[4]; const float* hp = F.hon + 128 * h + 16 * oseg; LAUNDER(hp);
#pragma unroll
          for (int i = 0; i < 4; ++i) gn[i] = *(const f32x4*)(hp + 4 * i);
#pragma unroll
          for (int i = 0; i < 4; ++i)
#pragma unroll
              for (int j = 0; j < 4; ++j) { const int e = 4 * i + j; const unsigned wd = psgc[e >> 3][(e & 7) >> 1]; const float sg = bf2f((unsigned short)((e & 1) ? (wd >> 16) : (wd & 0xffffu))); res[e] = ov[i][j] * rn * gn[i][j] * sg; }
          v4u o0, o1; o0.x = pk2(res[0], res[1]); o0.y = pk2(res[2], res[3]); o0.z = pk2(res[4], res[5]); o0.w = pk2(res[6], res[7]); o1.x = pk2(res[8], res[9]); o1.y = pk2(res[10], res[11]); o1.z = pk2(res[12], res[13]); o1.w = pk2(res[14], res[15]);
          *(v4u*)(mb + vo_mix) = o0; *(v4u*)(mb + vo_mix + 16) = o1; mb += 131072; }
        if (c + 1 < nsteps) { HG_STORE(); }
        __syncthreads();
    }
    { int ln2 = lane; LAUNDER(ln2); float* sp = Sout + (4 * (ln2 >> 4)) * 128 + 16 * w + (ln2 & 15);
#pragma unroll
      for (int kb = 0; kb < 8; ++kb) { LAUNDER(sp);
#pragma unroll
          for (int r = 0; r < 4; ++r) sp[r * 128] = S[kb][r];
          sp += 16 * 128; } }
#undef HG_LOAD
#undef HG_STORE
#undef HG_ADV
}

__global__ void __launch_bounds__(NTHR, 2) skel_fwd(Args args) {
    extern __shared__ __attribute__((aligned(16))) unsigned char lds[];
    Frame F;
    F.lds = (LAS unsigned char*)lds; F.MISC = (volatile LAS unsigned*)(F.lds + MISC_OFF);
    F.tid = threadIdx.x; F.lane = F.tid & 63; F.wave = __builtin_amdgcn_readfirstlane(F.tid >> 6);
    F.G = gridDim.x; { const int bx = blockIdx.x; F.vcu = (F.G % 8 == 0) ? (bx % 8) * (F.G / 8) + bx / 8 : bx; }
    F.ws = args.ws; F.ctl = (unsigned*)(args.ws + WS_CTL); F.out = args.out;
    F.xp = args.in[0]; F.xs = args.in[1]; F.ck = args.in[2]; F.cv = args.in[3]; F.clf = args.in[4]; F.sh = args.in[5]; F.n1 = args.in[6]; F.win = args.in[7]; F.bff = args.in[8];
    F.qg = args.in[9]; F.kg = args.in[10]; F.lbl = args.in[11]; F.hon = args.in[12]; F.wout = args.in[13]; F.n2 = args.in[14]; F.wup = args.in[15]; F.wdn = args.in[16];
    const int lo = args.ph_lo, hi = args.ph_hi;
#if defined(PROBE_A)
    unsigned long long ts_[9]; const bool stamper_ = (blockIdx.x == 0 && F.tid == 0);
#define STAMP(k) do { if (stamper_) ts_[k] = __builtin_amdgcn_s_memrealtime(); } while (0)
    STAMP(0);
#else
#define STAMP(k) do {} while (0)
#endif
#ifndef PH_MASK
#define PH_MASK 63
#endif
#define IN(k) (((PH_MASK >> (k)) & 1) && lo <= (k) && (k) < hi)
#define SEAM(k) do { if (IN(k) && IN((k) + 1)) { cg::this_grid().sync(); } } while (0)
    bf16* XB = (bf16*)(F.ws + WS_XB); bf16* X1B = (bf16*)(F.ws + WS_X1B); bf16* MIX = (bf16*)(F.ws + WS_MIX); bf16* HB = (bf16*)(F.ws + WS_H);
    if (IN(0)) { p0_prologue(F); }
    SEAM(0); STAMP(1);
    if (IN(1)) {
#ifndef NO_SCAN
        for (int ch = F.vcu; ch < 128; ch += F.G) scan_chain(F, ch);
#endif
        pg8::Gemm g{XB, (const bf16*)(F.ws + WS_WIN), MTOT, NIN, DMOD}; pg8::StaticOrder S; S.init(MTOT, NIN, F.G, (int)blockIdx.x);
        pg8::EpiIn E{(const float*)(F.ws + WS_RSTD), F.lbl, F.qg, F.kg, F.ws, F.out};
        pg8::gemm_phase<pg8::EpiIn, pg8::StaticOrder, true, true>(F.lds, g, S, E);
    }
    SEAM(1); STAMP(2);
    if (IN(2)) {
#ifndef NO_HGRN
        STAMP(7);
        for (int c = F.vcu; c < 64; c += F.G) {
            const bool smp = c >= 32; const int c2 = c & 31, bb = c2 >> 2;
            hgrn_chain(F, smp ? MP + 64 * bb : bb * TSEQ, smp ? MP / 64 + bb : bb * (TSEQ / 64), smp ? 1 : TSEQ / 64, c2 & 3, smp ? F.sh + (size_t)c2 * 16384 : nullptr, F.out + (smp ? O_HS : O_HP) + (size_t)c2 * 16384);
            __syncthreads();
        }
        STAMP(8);
#endif
#ifndef NO_ATTN
        float prune_thr;
        { float mq = fabsf(F.qg[F.lane]), mk = fabsf(F.kg[F.lane]);
#pragma unroll
          for (int o = 1; o < 64; o <<= 1) { mq = fmaxf(mq, __shfl_xor(mq, o)); mk = fmaxf(mk, __shfl_xor(mk, o)); }
          prune_thr = 2.f * (8.f * mq * mk * LOG2E) + 150.f; }
        for (;;) {
            if (F.tid == 0) F.MISC[0] = atomicAdd(F.ctl + CW_QUEUE, 1u);
            __syncthreads();
            const int i = (int)F.MISC[0];
            __syncthreads();
            if (i >= 2048 + 64) break;
            typedef attn_body::bf16 abf;
            const bool smp = i >= 2048; const int j = smp ? i - 2048 : i;
            const int bh = j & 63, qb = 31 - (j >> 6), b = bh >> 3, h = bh & 7;
            const int q0 = smp ? SSEQ - 256 : 256 * qb, NT = (q0 + 256) / 64; int NTE = NT;
            const size_t rb = (size_t)b * (smp ? SSEQ : TSEQ);
            const float* cgp = (const float*)(F.ws + (smp ? WS_CGS : WS_CGP)) + (size_t)bh * (smp ? SSEQ : TSEQ);
#if FOX_PRUNE
            { const bool need = F.tid < NT && (cgp[q0] - cgp[64 * F.tid + 63] >= -prune_thr); const int needed = __syncthreads_count(need ? 1 : 0);
              NTE = (needed + 1) & ~1; NTE = NTE < 4 ? 4 : (NTE > NT ? NT : NTE); }
#endif
            const size_t orow = smp ? (size_t)(MP + 64 * b) - (size_t)(PAST - q0) : rb + q0;
            attn_body::attn_unit<8>((const abf*)(F.ws + (smp ? WS_QS : WS_Q)) + (rb + q0) * 512 + 64 * h, (const abf*)(F.ws + (smp ? WS_KS : WS_K)) + rb * 512 + 64 * h, (const abf*)(F.ws + (smp ? WS_VS : WS_V)) + rb * 512 + 64 * h,
                                    (abf*)MIX + orow * DMOD + 512 + 64 * h, NT, NTE, cgp, q0, smp ? (PAST - q0) / 32 : 0, smp ? (PAST - q0) / 32 + 1 : 8, (char*)lds);
        }
#endif
    }
    SEAM(2); STAMP(3);
    if (IN(3)) {
        pg8::Gemm g{MIX, (const bf16*)(F.ws + WS_WO), MTOT, DMOD, DMOD}; pg8::StaticOrder S; S.init(MTOT, DMOD, F.G, (int)blockIdx.x);
        pg8::EpiWo E{F.xp, F.xs, F.out + O_YP, F.out + O_YS, X1B, (float*)(F.ws + WS_SSQ)};
        pg8::gemm_phase<pg8::EpiWo, pg8::StaticOrder, true, true>(F.lds, g, S, E);
    }
    SEAM(3); STAMP(4);
    if (IN(4)) {
        pg8::Gemm g{X1B, (const bf16*)(F.ws + WS_WUP), MTOT, FF, DMOD}; pg8::StaticOrder S; S.init(MTOT, FF, F.G, (int)blockIdx.x);
        pg8::EpiUp E{HB, (const float*)(F.ws + WS_SSQ)};
        pg8::gemm_phase<pg8::EpiUp, pg8::StaticOrder, true, true>(F.lds, g, S, E);
#if defined(DOUBLE_P4)
        cg::this_grid().sync();
        pg8::gemm_phase<pg8::EpiUp, pg8::StaticOrder, true, true>(F.lds, g, S, E);
#endif
    }
    SEAM(4); STAMP(5);
    if (IN(5)) {
        pg8::Gemm g{HB, (const bf16*)(F.ws + WS_WDN), MTOT, DMOD, FF}; pg8::StaticOrder S; S.init(MTOT, DMOD, F.G, (int)blockIdx.x);
        pg8::EpiDown E{F.out + O_YP, F.out + O_YS};
        pg8::gemm_phase<pg8::EpiDown, pg8::StaticOrder, true, true>(F.lds, g, S, E);
    }
    STAMP(6);
#if defined(PROBE_A)
    cg::this_grid().sync();
    if (stamper_) {
        unsigned long long da = ts_[PROBE_A + 1] - ts_[PROBE_A], db = ts_[PROBE_B + 1] - ts_[PROBE_B];
        unsigned qa = (unsigned)((da + 1250) / 2500), qb = (unsigned)((db + 1250) / 2500); if (qa > 63) qa = 63; if (qb > 63) qb = 63;
#if defined(PROBE_CAL)
        qa = 1000; qb = 0;
#endif
        const unsigned long long t0 = __builtin_amdgcn_s_memrealtime(), wait = 2000ull * (qa + 64 * qb);
        while (__builtin_amdgcn_s_memrealtime() - t0 < wait) __builtin_amdgcn_s_sleep(16);
    }
#endif
#undef IN
#undef SEAM
}

extern "C" void kernel_launch(void* const* d_in, const int* in_sizes, int n_in, void* d_out, int out_size, void* d_ws, size_t ws_size, hipStream_t stream) {
    static int grid = 0;
    if (grid == 0) {
        if (n_in != 17 || (size_t)out_size != O_END || ws_size < WS_END) { fprintf(stderr, "kernel_launch: unexpected shapes (n_in %d out %d ws %zu)\n", n_in, out_size, ws_size); grid = -1; return; }
        int dev = 0, cus = 0, per_cu = 0;
        if (hipGetDevice(&dev) != hipSuccess || hipDeviceGetAttribute(&cus, hipDeviceAttributeMultiprocessorCount, dev) != hipSuccess) { grid = -1; return; }
        if (hipFuncSetAttribute((const void*)skel_fwd, hipFuncAttributeMaxDynamicSharedMemorySize, LDS_BYTES) != hipSuccess) { fprintf(stderr, "kernel_launch: hipFuncSetAttribute failed\n"); grid = -1; return; }
        if (hipOccupancyMaxActiveBlocksPerMultiprocessor(&per_cu, (const void*)skel_fwd, NTHR, LDS_BYTES) != hipSuccess || per_cu < 1) { fprintf(stderr, "kernel_launch: occupancy query says %d\n", per_cu); per_cu = 1; }
        (void)hipGetLastError();
        grid = cus;
    }
    if (grid < 0) return;
    if (hipMemsetAsync((char*)d_ws + WS_CTL, 0, CTL_ZERO_BYTES, stream) != hipSuccess) { fprintf(stderr, "kernel_launch: memset failed\n"); return; }
    Args a{};
    for (int i = 0; i < 17; ++i) a.in[i] = (const float*)d_in[i];
    a.out = (float*)d_out; a.ws = (unsigned char*)d_ws;
#if MK_N_LAUNCHES == 1
    a.ph_lo = 0; a.ph_hi = 6;
    void* kargs[] = {&a};
    hipError_t e = hipLaunchCooperativeKernel((const void*)skel_fwd, dim3(grid), dim3(NTHR), kargs, LDS_BYTES, stream);
    if (e != hipSuccess) fprintf(stderr, "kernel_launch: cooperative launch failed: %s (grid %d)\n", hipGetErrorString(e), grid);
#else
    for (int li = 0; li < 6; ++li) { a.ph_lo = li; a.ph_hi = li + 1; hipLaunchKernelGGL(skel_fwd, dim3(grid), dim3(NTHR), LDS_BYTES, stream, a); }
#endif
}
```

```cpp
#include <hip/hip_runtime.h>
#include <cstdio>
#include <cstdint>
namespace pg8 {
#define PG8_LAS __attribute__((address_space(3)))
typedef unsigned short bf16_t;
typedef short bf16x8 __attribute__((ext_vector_type(8)));
typedef float f32x4 __attribute__((ext_vector_type(4)));
typedef unsigned u32x4 __attribute__((ext_vector_type(4)));
constexpr int BM = 256, BK = 64, HALF = 128, HTB = HALF * BK * 2  , STAGE_BYTES = 8 * HTB, NXCD = 8, WGM = 8;

__host__ __device__ __forceinline__ int lds_byte(int r, int c) { const int st = (r >> 4) * 2 + (c >> 5), rr = r & 15, cc = c & 31, ob = rr * 64 + cc * 2; return st * 1024 + (ob ^ (((ob >> 9) & 1) << 5)); }
__host__ __device__ __forceinline__ void stage_rc(int b, int& R, int& C) { const int st = b / 1024, sb = b % 1024, swz = sb ^ (((sb >> 9) & 1) << 5); R = (st >> 1) * 16 + swz / 64; C = (st & 1) * 32 + (swz % 64) / 2; }
__host__ __device__ __forceinline__ int perm32(int rho) { const int n = rho >> 4, i = rho & 15; return 8 * (i >> 2) + 4 * n + (i & 3); }

struct Unit { int pm, pn; };
struct Gemm { const bf16_t* A; const bf16_t* Bt; int M, N, K; };

struct StaticOrder {
    int nM, nN, nwg, G, c;
    __host__ __device__ void init(int M, int N, int G_, int c_) { nM = M / BM; nN = N / BM; nwg = nM * nN; G = G_; c = c_; }
    __host__ __device__ bool next(int i, Unit& u) const {
        const long L = (long)i * G + c; if (L >= nwg) return false;
        int wgid = (int)L; { const int q = nwg / NXCD, r = nwg % NXCD, xcd = wgid % NXCD, off = wgid / NXCD; wgid = (xcd < r ? xcd * (q + 1) : r * (q + 1) + (xcd - r) * q) + off; }
        const int nig = WGM * nN, gid = wgid / nig, fm = gid * WGM, gsz = (nM - fm) < WGM ? (nM - fm) : WGM;
        u.pm = fm + ((wgid % nig) % gsz); u.pn = (wgid % nig) / gsz; return true;
    }
    __device__ __forceinline__ void a_ready(const Unit&) const {}
    __device__ __forceinline__ void done(const Unit&) const {}
};

__device__ __forceinline__ unsigned cvt_pk_bf16(float lo, float hi) { unsigned r; asm volatile("v_cvt_pk_bf16_f32 %0, %1, %2" : "=v"(r) : "v"(lo), "v"(hi)); return r; }
typedef float f32x2 __attribute__((ext_vector_type(2)));
template <class Epi, class Sched, bool ALIGN_EPI = false, bool SP2 = false>
__device__ __forceinline__ void gemm_phase(PG8_LAS unsigned char* lds, const Gemm g, const Sched& S, const Epi& E) {
    const int tid = threadIdx.x, wid = __builtin_amdgcn_readfirstlane(tid >> 6), lane = tid & 63, wr = wid >> 2, wc = wid & 3, fr = lane & 15, fq = lane >> 4;
    const int K = g.K, nt = K / BK;
    unsigned voffA[2], voffB[2];
#pragma unroll
    for (int i = 0; i < 2; ++i) { int R, C; stage_rc(tid * 16 + i * 8192, R, C); const int Rb = Epi::PERM ? ((R & ~31) + perm32(R & 31)) : R;
        voffA[i] = (unsigned)(R * K + C) * 2u; voffB[i] = (unsigned)(Rb * K + C) * 2u; }
    const size_t kstep = (size_t)(BK * 2);
    const size_t hstep = (size_t)HALF * K * 2;
    const size_t tstep = 2 * hstep;
    const unsigned ldsw = (unsigned)wid * 1024u;
    const int aoff = lds_byte(wr * 64 + fr, fq * 8), boff = lds_byte(wc * 32 + fr, fq * 8);
#define PG8_SA(b, h) (((b) * 2 + (h)) * HTB)
#define PG8_SB(b, h) ((4 + (b) * 2 + (h)) * HTB)
#define PG8_STAGE(bufoff, gbase, voff) do { _Pragma("unroll") for (int _i = 0; _i < 2; ++_i) \
        __builtin_amdgcn_global_load_lds((const unsigned*)((const char*)(gbase) + (voff)[_i]), (PG8_LAS unsigned*)(lds + (bufoff) + ldsw + _i * 8192), 16, 0, 0); } while (0)
#define PG8_LDA(dst, b, h) do { _Pragma("unroll") for (int m = 0; m < 4; ++m) _Pragma("unroll") for (int k = 0; k < 2; ++k) dst[m][k] = *(const PG8_LAS bf16x8*)(lds + PG8_SA(b, h) + aoff + m * 2048 + k * 1024); } while (0)
#define PG8_LDB(dst, b, h) do { _Pragma("unroll") for (int n = 0; n < 2; ++n) _Pragma("unroll") for (int k = 0; k < 2; ++k) dst[n][k] = *(const PG8_LAS bf16x8*)(lds + PG8_SB(b, h) + boff + n * 2048 + k * 1024); } while (0)
#define PG8_MMA(ai, bj, At, Bt) do { __builtin_amdgcn_s_setprio(1); _Pragma("unroll") for (int m = 0; m < 4; ++m) _Pragma("unroll") for (int n = 0; n < 2; ++n) _Pragma("unroll") for (int k = 0; k < 2; ++k) \
        acc[ai][bj][m][n] = __builtin_amdgcn_mfma_f32_16x16x32_bf16(Bt[n][k], At[m][k], acc[ai][bj][m][n], 0, 0, 0); __builtin_amdgcn_s_setprio(0); } while (0)
#define PG8_WAIT_V(n) asm volatile("s_waitcnt vmcnt(" #n ")" ::: "memory")
#define PG8_WAIT_L(n) asm volatile("s_waitcnt lgkmcnt(" #n ")" ::: "memory")
#define PG8_BAR __builtin_amdgcn_s_barrier()
#define PG8_SCHED __builtin_amdgcn_sched_barrier(0)
    Unit cur, nxt; int ui = 0;
    if (!S.next(0, cur)) return;
    f32x4 acc[2][2][4][2];
#pragma unroll
    for (int a = 0; a < 2; ++a)
#pragma unroll
        for (int b = 0; b < 2; ++b)
#pragma unroll
            for (int m = 0; m < 4; ++m)
#pragma unroll
                for (int n = 0; n < 2; ++n) acc[a][b][m][n] = (f32x4){0.f, 0.f, 0.f, 0.f};
    bf16x8 At[4][2], B0[2][2], B1[2][2];
    const char* cA = (const char*)g.A + (size_t)cur.pm * tstep; const char* cB = (const char*)g.Bt + (size_t)cur.pn * tstep;
    S.a_ready(cur);
    if constexpr (SP2) {
        PG8_STAGE(PG8_SB(0, 0), cB, voffB); PG8_STAGE(PG8_SB(0, 1), cB + hstep, voffB); PG8_STAGE(PG8_SA(0, 0), cA, voffA); PG8_STAGE(PG8_SA(0, 1), cA + hstep, voffA);
        if (wr == 1) PG8_BAR;
        PG8_WAIT_V(2); PG8_BAR;
        PG8_STAGE(PG8_SB(1, 0), cB + kstep, voffB); PG8_STAGE(PG8_SA(1, 0), cA + kstep, voffA); PG8_STAGE(PG8_SB(1, 1), cB + hstep + kstep, voffB);
        PG8_WAIT_V(6); PG8_BAR;
    } else {
        PG8_STAGE(PG8_SB(0, 0), cB, voffB); PG8_STAGE(PG8_SA(0, 0), cA, voffA); PG8_STAGE(PG8_SB(0, 1), cB + hstep, voffB); PG8_STAGE(PG8_SA(0, 1), cA + hstep, voffA);
        if (wr == 1) PG8_BAR;
        PG8_WAIT_V(4); PG8_BAR;
        PG8_STAGE(PG8_SB(1, 0), cB + kstep, voffB); PG8_STAGE(PG8_SA(1, 0), cA + kstep, voffA); PG8_STAGE(PG8_SB(1, 1), cB + hstep + kstep, voffB);
        PG8_WAIT_V(6); PG8_BAR;
    }
    for (;;) {
        const bool has_next = S.next(ui + 1, nxt);
        const char* nA = has_next ? (const char*)g.A + (size_t)nxt.pm * tstep : cA; const char* nB = has_next ? (const char*)g.Bt + (size_t)nxt.pn * tstep : cB;
        for (int t = 0; t < nt; t += 2) {
            const bool last = (t == nt - 2);
            const char* a1 = cA + (size_t)(t + 1) * kstep;
            const char* a2 = last ? nA : cA + (size_t)(t + 2) * kstep; const char* b2 = last ? nB : cB + (size_t)(t + 2) * kstep;
            const char* a3 = a2 + kstep; const char* b3 = b2 + kstep;
            if (last && has_next) S.a_ready(nxt);
            if constexpr (SP2) {
            PG8_LDB(B0, 0, 0); PG8_LDB(B1, 0, 1); PG8_SCHED; PG8_LDA(At, 0, 0); PG8_STAGE(PG8_SA(1, 1), a1 + hstep, voffA);
            PG8_WAIT_V(8); PG8_WAIT_L(0); PG8_BAR; PG8_MMA(0, 0, At, B0); PG8_MMA(0, 1, At, B1); PG8_BAR; PG8_SCHED;
            PG8_LDA(At, 0, 1); PG8_STAGE(PG8_SB(0, 0), b2, voffB); PG8_STAGE(PG8_SB(0, 1), b2 + hstep, voffB); PG8_STAGE(PG8_SA(0, 0), a2, voffA);
            PG8_WAIT_V(8); PG8_WAIT_L(0); PG8_BAR; PG8_MMA(1, 0, At, B0); PG8_MMA(1, 1, At, B1); PG8_BAR; PG8_SCHED;
            PG8_LDB(B0, 1, 0); PG8_LDB(B1, 1, 1); PG8_SCHED; PG8_LDA(At, 1, 0); PG8_STAGE(PG8_SA(0, 1), a2 + hstep, voffA);
            PG8_WAIT_V(8); PG8_WAIT_L(0); PG8_BAR; PG8_MMA(0, 0, At, B0); PG8_MMA(0, 1, At, B1); PG8_BAR; PG8_SCHED;
            PG8_LDA(At, 1, 1); PG8_STAGE(PG8_SB(1, 0), b3, voffB); PG8_STAGE(PG8_SB(1, 1), b3 + hstep, voffB); PG8_STAGE(PG8_SA(1, 0), a3, voffA);
            PG8_WAIT_V(8); PG8_WAIT_L(0); PG8_BAR; PG8_MMA(1, 0, At, B0); PG8_MMA(1, 1, At, B1); PG8_BAR; PG8_SCHED;
            } else {
            PG8_LDB(B0, 0, 0); PG8_SCHED; PG8_LDA(At, 0, 0); PG8_STAGE(PG8_SA(1, 1), a1 + hstep, voffA);
            PG8_WAIT_L(8); PG8_BAR; PG8_WAIT_L(0); PG8_MMA(0, 0, At, B0); PG8_BAR; PG8_SCHED;
            PG8_LDB(B1, 0, 1); PG8_STAGE(PG8_SB(0, 0), b2, voffB);
            PG8_BAR; PG8_WAIT_L(0); PG8_MMA(0, 1, At, B1); PG8_BAR;
            PG8_LDA(At, 0, 1); PG8_STAGE(PG8_SA(0, 0), a2, voffA);
            PG8_BAR; PG8_WAIT_L(0); PG8_MMA(1, 0, At, B0); PG8_BAR; PG8_SCHED;
            PG8_STAGE(PG8_SB(0, 1), b2 + hstep, voffB);
            PG8_WAIT_V(6); PG8_BAR; PG8_MMA(1, 1, At, B1); PG8_BAR;
            PG8_LDB(B0, 1, 0); PG8_SCHED; PG8_LDA(At, 1, 0); PG8_STAGE(PG8_SA(0, 1), a2 + hstep, voffA);
            PG8_WAIT_L(8); PG8_BAR; PG8_WAIT_L(0); PG8_MMA(0, 0, At, B0); PG8_BAR; PG8_SCHED;
            PG8_LDB(B1, 1, 1); PG8_STAGE(PG8_SB(1, 0), b3, voffB);
            PG8_BAR; PG8_WAIT_L(0); PG8_MMA(0, 1, At, B1); PG8_BAR;
            PG8_LDA(At, 1, 1); PG8_STAGE(PG8_SA(1, 0), a3, voffA);
            PG8_BAR; PG8_WAIT_L(0); PG8_MMA(1, 0, At, B0); PG8_BAR; PG8_SCHED;
            PG8_STAGE(PG8_SB(1, 1), b3 + hstep, voffB);
            PG8_WAIT_V(6); PG8_BAR; PG8_MMA(1, 1, At, B1); PG8_BAR;
            }
        }
        if constexpr (ALIGN_EPI) { if (wr == 0) PG8_BAR; }
        if constexpr (!Epi::AFTER_DRAIN) { E(acc, cur, wr, wc, fr, fq); S.done(cur); }
        if (!has_next) break;
#pragma unroll
        for (int a = 0; a < 2; ++a)
#pragma unroll
            for (int b = 0; b < 2; ++b)
#pragma unroll
                for (int m = 0; m < 4; ++m)
#pragma unroll
                    for (int n = 0; n < 2; ++n) acc[a][b][m][n] = (f32x4){0.f, 0.f, 0.f, 0.f};
        cur = nxt; cA = nA; cB = nB; ++ui;
        if constexpr (ALIGN_EPI) { if (wr == 1) PG8_BAR; }
    }
    PG8_WAIT_V(0);
    if constexpr (!ALIGN_EPI) { if (wr == 0) PG8_BAR; }
    PG8_BAR;
    if constexpr (Epi::AFTER_DRAIN) { E.fused(acc, cur, wr, wc, fr, fq, lds, wid, lane); S.done(cur); }
#undef PG8_SA
#undef PG8_SB
#undef PG8_STAGE
#undef PG8_LDA
#undef PG8_LDB
#undef PG8_MMA
#undef PG8_WAIT_V
#undef PG8_WAIT_L
#undef PG8_BAR
#undef PG8_SCHED
}
}
#include <hip/hip_bf16.h>
#include <cmath>
namespace attn_body {
using bf16=__hip_bfloat16;
using bf16x8=__attribute__((ext_vector_type(8)))short;
using s16x4=__attribute__((ext_vector_type(4)))short;
using f32x16=__attribute__((ext_vector_type(16)))float;
using u32x4=__attribute__((ext_vector_type(4)))unsigned;
constexpr int NHEAD=8,D=64,DM=NHEAD*D,OPITCH=1024;
constexpr int NW=8,QBLK=32,QB=QBLK*NW,KVBLK=64;
constexpr int ATTN_PITCH=DM, ATTN_UNIT_ROWS=QB;
__device__ __forceinline__ int crow(int r,int hi){return (r&3)+8*(r>>2)+4*hi;}
#define SBAR() __builtin_amdgcn_sched_barrier(0)
__device__ __forceinline__ void cmask(f32x16&p0,f32x16&p1,int jb,int qrel,int hi){
  const float NEG=-INFINITY; int kb=64*jb+4*hi;
  #pragma unroll
  for(int r=0;r<16;++r){int kv=kb+(r&3)+8*(r>>2); if(kv>qrel)p0[r]=NEG; if(kv+32>qrel)p1[r]=NEG;}
}

constexpr int NSLOT=3, SLOTB=8192;
constexpr int LDS_K=0, LDS_V=NSLOT*SLOTB, LDS_WS=2*NSLOT*SLOTB, LDS_OST=LDS_WS+NW*64*4, LDS_CB=LDS_OST+NW*4096, LDS_BYTES=LDS_CB+32768;
constexpr float C2=0.125f*1.4426950408889634f;
__device__ __forceinline__ void glds16(const void*gsrc,unsigned lds_dst){unsigned keep;
  asm volatile("s_mov_b32 %0, m0\n\ts_mov_b32 m0, %2\n\ts_nop 0\n\tglobal_load_lds_dwordx4 %1, off\n\ts_mov_b32 m0, %0":"=&s"(keep):"v"(gsrc),"s"(lds_dst):"memory");}
__device__ __forceinline__ float max3f(float a,float b,float c){float r;asm("v_max3_f32 %0, %1, %2, %3":"=v"(r):"v"(a),"v"(b),"v"(c));return r;}
__device__ __forceinline__ float max2f(float a,float b){float r;asm("v_max_f32_e32 %0, %1, %2":"=v"(r):"v"(a),"v"(b));return r;}
__device__ __forceinline__ float fadd_s(float a,float b){float r;asm("v_add_f32_e32 %0, %1, %2":"=v"(r):"v"(a),"v"(b));return r;}
__device__ __forceinline__ float fsub_s(float a,float b){float r;asm("v_sub_f32_e32 %0, %1, %2":"=v"(r):"v"(a),"v"(b));return r;}
typedef float f32x2_t __attribute__((ext_vector_type(2))); typedef float f32x4_t __attribute__((ext_vector_type(4))); typedef __bf16 bf16x2_t __attribute__((ext_vector_type(2)));
__device__ __forceinline__ unsigned cvtpk_s(float lo,float hi){f32x2_t v={lo,hi};bf16x2_t b=__builtin_convertvector(v,bf16x2_t);return __builtin_bit_cast(unsigned,b);}
#define WAIT_BAR(N) asm volatile("s_waitcnt vmcnt(" #N ") lgkmcnt(0)\n\ts_barrier":::"memory")

__device__ __forceinline__ void qkt(f32x16&p0,f32x16&p1,const char*Kslot,const bf16x8*qr,int r32,int hi){
  const char*kb=Kslot+hi*1024+r32*16;
  #pragma unroll
  for(int d0=0;d0<4;++d0){
    const bf16x8 b0=*reinterpret_cast<const bf16x8*>(kb+d0*2048);
    const bf16x8 b1=*reinterpret_cast<const bf16x8*>(kb+d0*2048+512);
    p0=__builtin_amdgcn_mfma_f32_32x32x16_bf16(b0,qr[d0],p0,0,0,0);p1=__builtin_amdgcn_mfma_f32_32x32x16_bf16(b1,qr[d0],p1,0,0,0);}
}
typedef __attribute__((address_space(3))) const char* lds_cptr;
typedef short v4i16_t __attribute__((ext_vector_type(4)));
__device__ __forceinline__ void kload8(bf16x8*kf,lds_cptr kp){
  kf[0]=*(const __attribute__((address_space(3))) bf16x8*)(kp);      kf[1]=*(const __attribute__((address_space(3))) bf16x8*)(kp+512);
  kf[2]=*(const __attribute__((address_space(3))) bf16x8*)(kp+2048); kf[3]=*(const __attribute__((address_space(3))) bf16x8*)(kp+2560);
  kf[4]=*(const __attribute__((address_space(3))) bf16x8*)(kp+4096); kf[5]=*(const __attribute__((address_space(3))) bf16x8*)(kp+4608);
  kf[6]=*(const __attribute__((address_space(3))) bf16x8*)(kp+6144); kf[7]=*(const __attribute__((address_space(3))) bf16x8*)(kp+6656);
}
__device__ __forceinline__ void kload2(bf16x8*kf,lds_cptr kp,int j){ kf[2*j]=*(const __attribute__((address_space(3))) bf16x8*)(kp+j*2048); kf[2*j+1]=*(const __attribute__((address_space(3))) bf16x8*)(kp+j*2048+512); }
__device__ __forceinline__ s16x4 vtr(lds_cptr p){ return __builtin_bit_cast(s16x4,__builtin_amdgcn_ds_read_tr16_b64_v4i16((__attribute__((address_space(3))) v4i16_t*)p)); }
__device__ __forceinline__ float rowmax(const f32x16&p0,const f32x16&p1){
  float a=max3f(p0[0],p0[1],p1[0]),b=max3f(p0[2],p0[3],p1[1]);a=max3f(a,p1[2],p1[3]);
  #pragma unroll
  for(int r=4;r<16;r+=4){a=max3f(a,p0[r],p0[r+1]);b=max3f(b,p0[r+2],p0[r+3]);a=max3f(a,p1[r],p1[r+1]);b=max3f(b,p1[r+2],p1[r+3]);}
  const float m=max2f(a,b);
  auto rr=__builtin_amdgcn_permlane32_swap(__float_as_uint(m),__float_as_uint(m),false,false);
  return max2f(__uint_as_float(rr[0]),__uint_as_float(rr[1]));
}
__device__ __forceinline__ void pv(f32x16*o,int vb,bf16x8 pa0,bf16x8 pa1,bf16x8 pa2,bf16x8 pa3){
  #pragma unroll
  for(int d0=0;d0<2;++d0){s16x4 lo[4],hi[4];
    #pragma unroll
    for(int ks=0;ks<4;++ks){
      asm volatile("ds_read_b64_tr_b16 %0,%1 offset:%c2":"=&v"(lo[ks]):"v"(vb),"i"(d0*4096+ks*1024):"memory");
      asm volatile("ds_read_b64_tr_b16 %0,%1 offset:%c2":"=&v"(hi[ks]):"v"(vb),"i"(d0*4096+ks*1024+512):"memory");}
    asm volatile("s_waitcnt lgkmcnt(0)":::"memory");SBAR();
    #define PK(k) (bf16x8){lo[k][0],lo[k][1],lo[k][2],lo[k][3],hi[k][0],hi[k][1],hi[k][2],hi[k][3]}
    o[d0]=__builtin_amdgcn_mfma_f32_32x32x16_bf16(pa0,PK(0),o[d0],0,0,0);
    o[d0]=__builtin_amdgcn_mfma_f32_32x32x16_bf16(pa1,PK(1),o[d0],0,0,0);
    o[d0]=__builtin_amdgcn_mfma_f32_32x32x16_bf16(pa2,PK(2),o[d0],0,0,0);
    o[d0]=__builtin_amdgcn_mfma_f32_32x32x16_bf16(pa3,PK(3),o[d0],0,0,0);
    #undef PK
  }
}

#ifndef ATTN_STORE16
#define ATTN_STORE16(p,v) (*(u32x4*)(p)=(v))
#endif
template<int THRL> __device__ __forceinline__ void attn_unit(const bf16*Qb,const bf16*__restrict__ Kh,const bf16*__restrict__ Vh,bf16*Ob,int NT,int NTE,const float*cgp,int q0,int wlo,int whi,char*shm){
  int tid_=threadIdx.x; asm volatile("":"+v"(tid_)); const int tid=tid_,lane=tid&63,r32=lane&31,hi=lane>>5; const int wid=__builtin_amdgcn_readfirstlane(tid>>6);
  const bf16*Qw=Qb+(long)(wid*QBLK)*DM;
  const unsigned lds0=(unsigned)(uintptr_t)shm;
  float*wsf=(float*)(shm+LDS_WS)+wid*64;
  const bf16*ksrc=Kh+(long)((NT-1)*KVBLK+lane)*DM+wid*8;
  const bf16*vsrc=Vh+(long)((NT-1)*KVBLK+16*(wid&3)+(lane>>2))*DM+(wid>>2)*32+(lane&3)*8;
  const unsigned kdst=lds0+LDS_K+wid*1024, vdst=lds0+LDS_V+wid*1024;
  #define DMA_K(t,slot) glds16(ksrc-(long)(t)*KVBLK*DM,(unsigned)__builtin_amdgcn_readfirstlane(kdst+(slot)))
  #define DMA_V(t,slot) glds16(vsrc-(long)(t)*KVBLK*DM,(unsigned)__builtin_amdgcn_readfirstlane(vdst+(slot)))
  const int vb0=(int)(lds0+LDS_V)+((lane>>4)&1)*32+(lane&3)*8+(4*hi+((lane&15)>>2))*64;
  const char*Kbase=shm+LDS_K; bf16x8 kf[8];
  const lds_cptr shm3=(lds_cptr)shm; const lds_cptr kp0=shm3+LDS_K+hi*1024+r32*16; const lds_cptr vp0=shm3+LDS_V+((lane>>4)&1)*32+(lane&3)*8+(4*hi+((lane&15)>>2))*64;
  { typedef __attribute__((address_space(3))) float lf_t; lf_t* cbw=(lf_t*)((lds_cptr)shm+LDS_CB); const float c0=cgp[q0]; const int jlo=(NT-NTE)*KVBLK, jhi=NT*KVBLK;
    for(int j=jlo+tid;j<jhi;j+=NW*64) cbw[j]=c0-cgp[j]; }
  const __attribute__((address_space(3))) float* cbL=(const __attribute__((address_space(3))) float*)((lds_cptr)shm+LDS_CB)+4*hi;
  #define CBLOAD(C0,C1,t,MH) do{ const __attribute__((address_space(3))) float* cbp_=cbL+(NT-1-(t))*KVBLK; \
    _Pragma("unroll") for(int g_=0;g_<4;++g_){ const f32x4_t v0_=*(const __attribute__((address_space(3))) f32x4_t*)(cbp_+8*g_); const f32x4_t v1_=*(const __attribute__((address_space(3))) f32x4_t*)(cbp_+32+8*g_); \
      C0[4*g_]=v0_[0]-(MH);C0[4*g_+1]=v0_[1]-(MH);C0[4*g_+2]=v0_[2]-(MH);C0[4*g_+3]=v0_[3]-(MH); C1[4*g_]=v1_[0]-(MH);C1[4*g_+1]=v1_[1]-(MH);C1[4*g_+2]=v1_[2]-(MH);C1[4*g_+3]=v1_[3]-(MH);} }while(0)
  DMA_K(0,0);DMA_V(0,0);DMA_K(1,SLOTB);
  bf16x8 qr[4];
  #pragma unroll
  for(int d0=0;d0<4;++d0)qr[d0]=*reinterpret_cast<const bf16x8*>(&Qw[(long)r32*DM+d0*16+hi*8]);
  float mhat=0.f,l_reg=0.f;f32x16 o[2];o[0]=f32x16{};o[1]=f32x16{};
  const int qrel=wid*QBLK+r32;
  #define CMASK(P0,P1,t) do{int jb_=3-(t); if(jb_>=0)cmask(P0,P1,jb_,qrel,hi);}while(0)
  bool resc=false;
  #define START(P0,P1) do{ const float rm=rowmax(P0,P1); resc=false; \
    { const float dl=(rm>-1e30f)?rm:0.f; mhat=fadd_s(mhat,dl); \
      _Pragma("unroll") for(int r=0;r<16;++r){P0[r]=fsub_s(P0[r],dl);P1[r]=fsub_s(P1[r],dl);} } \
    _Pragma("unroll") for(int r=0;r<16;++r)P0[r]=__builtin_amdgcn_exp2f(P0[r]); }while(0)
  #define RESC() do{ if(resc){ asm volatile("s_waitcnt lgkmcnt(0)":::"memory"); \
      _Pragma("unroll") for(int d_=0;d_<2;++d_) _Pragma("unroll") for(int r=0;r<16;++r)o[d_][r]*=wsf[crow(r,hi)]; } }while(0)
  f32x16 pA0,pA1,pB0,pB1;
  int sl_prev=0,sl_cur=0,sl_next=SLOTB;
  #define ROT() do{sl_prev=sl_cur;sl_cur=sl_next;sl_next=(sl_next==(NSLOT-1)*SLOTB)?0:sl_next+SLOTB;}while(0)
  DMA_K(2,2*SLOTB);
  WAIT_BAR(3);
  CBLOAD(pA0,pA1,0,0.f); qkt(pA0,pA1,Kbase,qr,r32,hi);asm volatile("s_nop 15\n\ts_nop 7":"+v"(pA0),"+v"(pA1));CMASK(pA0,pA1,0);
  START(pA0,pA1);
  _Pragma("unroll") for(int r=0;r<16;++r)pA1[r]=__builtin_amdgcn_exp2f(pA1[r]);
  WAIT_BAR(0);
  DMA_K(3,0);DMA_V(1,SLOTB);
  ROT();
  kload8(kf,kp0+sl_cur);
  WAIT_BAR(2);
  s16x4 vlo[8],vhi[8]; u32x4 pw0,pw1,pw2,pw3;
  #define PKW(P,B) cvtpk_s(P[B],P[B+1])
  #define PAF(k) __builtin_bit_cast(bf16x8,pw##k)
  #define VFR(i) (bf16x8){vlo[i][0],vlo[i][1],vlo[i][2],vlo[i][3],vhi[i][0],vhi[i][1],vhi[i][2],vhi[i][3]}
  #define PIN(x) asm volatile("":"+v"(x))
  #define MX3(a,b,c) __builtin_fmaxf(__builtin_fmaxf((a),(b)),(c))
  #define GAPA(MF,A0,A1,A2,A3,W0,W1,PW) do{ MF; sacc+=A0; sacc+=A1; sacc+=A2; sacc+=A3; PIN(sacc); W0; W1; PIN(PW); SBAR(); }while(0)
  #define EX(v) __builtin_amdgcn_exp2f(v)
  #define GAPB(MF,X,B) do{ MF; X[B]=EX(X[B]); X[B+1]=EX(X[B+1]); X[B+2]=EX(X[B+2]); X[B+3]=EX(X[B+3]); PIN(X); SBAR(); }while(0)
  #define VRD(i) do{ vlo[i]=vtr(vp_+(((i)>>2)*4096+((i)&3)*1024)); vhi[i]=vtr(vp_+(((i)>>2)*4096+((i)&3)*1024+512)); }while(0)
  #define KRD(G,j) do{ if(G){ kload2(kf,kp0+sl_next,j); SBAR(); } }while(0)
  #define STEP(C0,C1,P0,P1,t,GK,GV,GL) do{ SBAR(); \
    const lds_cptr vp_=vp0+sl_prev; CBLOAD(C0,C1,t,mhat); SBAR(); \
    VRD(0); SBAR(); float sacc=(P0[0]+P0[1]); \
    GAPA(C0=__builtin_amdgcn_mfma_f32_32x32x16_bf16(kf[0],qr[0],C0,0,0,0), P0[2],P0[3],P0[4],P0[5],     pw0[0]=PKW(P0,0), pw0[1]=PKW(P0,2), pw0); \
    VRD(4); SBAR(); GAPA(C1=__builtin_amdgcn_mfma_f32_32x32x16_bf16(kf[1],qr[0],C1,0,0,0), P0[6],P0[7],P0[8],P0[9],     pw0[2]=PKW(P0,4), pw0[3]=PKW(P0,6), pw0); \
    VRD(1); SBAR(); GAPA(C0=__builtin_amdgcn_mfma_f32_32x32x16_bf16(kf[2],qr[1],C0,0,0,0),   P0[10],P0[11],P0[12],P0[13], pw1[0]=PKW(P0,8), pw1[1]=PKW(P0,10), pw1); \
    VRD(5); SBAR(); GAPA(C1=__builtin_amdgcn_mfma_f32_32x32x16_bf16(kf[3],qr[1],C1,0,0,0),   P0[14],P0[15],P1[0],P1[1],   pw1[2]=PKW(P0,12),pw1[3]=PKW(P0,14), pw1); \
    VRD(2); SBAR(); GAPA(C0=__builtin_amdgcn_mfma_f32_32x32x16_bf16(kf[4],qr[2],C0,0,0,0),   P1[2],P1[3],P1[4],P1[5],     pw2[0]=PKW(P1,0), pw2[1]=PKW(P1,2), pw2); \
    VRD(6); SBAR(); GAPA(C1=__builtin_amdgcn_mfma_f32_32x32x16_bf16(kf[5],qr[2],C1,0,0,0),   P1[6],P1[7],P1[8],P1[9],     pw2[2]=PKW(P1,4), pw2[3]=PKW(P1,6), pw2); \
    VRD(3); SBAR(); GAPA(C0=__builtin_amdgcn_mfma_f32_32x32x16_bf16(kf[6],qr[3],C0,0,0,0),   P1[10],P1[11],P1[12],P1[13], pw3[0]=PKW(P1,8), pw3[1]=PKW(P1,10), pw3); \
    VRD(7); SBAR(); GAPA(C1=__builtin_amdgcn_mfma_f32_32x32x16_bf16(kf[7],qr[3],C1,0,0,0),   P1[14],P1[15],0.f,0.f,       pw3[2]=PKW(P1,12),pw3[3]=PKW(P1,14), pw3); \
    l_reg+=sacc; \
    if(GK){DMA_K((t)+3,sl_cur);} if(GV){DMA_V((t)+1,sl_next);} \
    CMASK(C0,C1,t); \
    { float a=MX3(C0[0],C0[1],C1[0]),b=MX3(C0[2],C0[3],C1[1]); a=MX3(a,C1[2],C1[3]); \
      _Pragma("unroll") for(int r=4;r<16;r+=4){a=MX3(a,C0[r],C0[r+1]);b=MX3(b,C0[r+2],C0[r+3]);a=MX3(a,C1[r],C1[r+1]);b=MX3(b,C1[r+2],C1[r+3]);} \
      float rm=__builtin_fmaxf(a,b); { auto rr=__builtin_amdgcn_permlane32_swap(__float_as_uint(rm),__float_as_uint(rm),false,false); rm=__builtin_fmaxf(__uint_as_float(rr[0]),__uint_as_float(rr[1])); } \
      resc=false; \
      if(__builtin_expect(__any(rm>(float)THRL),0)){ const float dl=__builtin_fmaxf(rm,0.f); mhat+=dl; \
        _Pragma("unroll") for(int r=0;r<16;++r){C0[r]-=dl;C1[r]-=dl;} \
        const float f=__builtin_amdgcn_exp2f(-dl); l_reg*=f; if(hi==0)wsf[r32]=f; resc=true; } } \
    SBAR(); \
    GAPB(o[0]=__builtin_amdgcn_mfma_f32_32x32x16_bf16(PAF(0),VFR(0),o[0],0,0,0), C0,0); \
    GAPB(o[1]=__builtin_amdgcn_mfma_f32_32x32x16_bf16(PAF(0),VFR(4),o[1],0,0,0), C0,4); \
    KRD(GL,0); GAPB(o[0]=__builtin_amdgcn_mfma_f32_32x32x16_bf16(PAF(1),VFR(1),o[0],0,0,0), C0,8); \
    KRD(GL,1); GAPB(o[1]=__builtin_amdgcn_mfma_f32_32x32x16_bf16(PAF(1),VFR(5),o[1],0,0,0), C0,12); \
    KRD(GL,2); GAPB(o[0]=__builtin_amdgcn_mfma_f32_32x32x16_bf16(PAF(2),VFR(2),o[0],0,0,0), C1,0); \
    KRD(GL,3); GAPB(o[1]=__builtin_amdgcn_mfma_f32_32x32x16_bf16(PAF(2),VFR(6),o[1],0,0,0), C1,4); \
    GAPB(o[0]=__builtin_amdgcn_mfma_f32_32x32x16_bf16(PAF(3),VFR(3),o[0],0,0,0), C1,8); \
    GAPB(o[1]=__builtin_amdgcn_mfma_f32_32x32x16_bf16(PAF(3),VFR(7),o[1],0,0,0), C1,12); \
    }while(0)
  int t=1;
  for(;t<5&&t+5<NTE;t+=2){
    STEP(pB0,pB1,pA0,pA1,t,true,true,true);     WAIT_BAR(2); RESC(); ROT();
    STEP(pA0,pA1,pB0,pB1,t+1,true,true,true);   WAIT_BAR(2); RESC(); ROT();
  }
  #undef CMASK
  #define CMASK(P0,P1,t) do{}while(0)
  for(;t+5<NTE;t+=2){
    STEP(pB0,pB1,pA0,pA1,t,true,true,true);     WAIT_BAR(2); RESC(); ROT();
    STEP(pA0,pA1,pB0,pB1,t+1,true,true,true);   WAIT_BAR(2); RESC(); ROT();
  }
  #undef CMASK
  #define CMASK(P0,P1,t) do{int jb_=3-(t); if(jb_>=0)cmask(P0,P1,jb_,qrel,hi);}while(0)
  #define ENDW(tt) do{ if((tt)+3<NTE){WAIT_BAR(2);} else if((tt)+2<NTE){WAIT_BAR(1);} else {WAIT_BAR(0);} }while(0)
  for(;t+1<NTE;t+=2){
    STEP(pB0,pB1,pA0,pA1,t,(t+3<NTE),(t+1<NTE),(t+1<NTE));       ENDW(t);   RESC(); ROT();
    STEP(pA0,pA1,pB0,pB1,t+1,(t+4<NTE),(t+2<NTE),(t+2<NTE));     ENDW(t+1); RESC(); ROT();
  }
  STEP(pB0,pB1,pA0,pA1,NTE-1,false,false,false); RESC();
  { float sacc=pB0[0]+pB0[1]; _Pragma("unroll") for(int r=2;r<16;++r)sacc+=pB0[r]; _Pragma("unroll") for(int r=0;r<16;++r)sacc+=pB1[r]; l_reg+=sacc;
    pw0=(u32x4){PKW(pB0,0),PKW(pB0,2),PKW(pB0,4),PKW(pB0,6)};pw1=(u32x4){PKW(pB0,8),PKW(pB0,10),PKW(pB0,12),PKW(pB0,14)};pw2=(u32x4){PKW(pB1,0),PKW(pB1,2),PKW(pB1,4),PKW(pB1,6)};pw3=(u32x4){PKW(pB1,8),PKW(pB1,10),PKW(pB1,12),PKW(pB1,14)};
    SBAR(); pv(o,vb0+sl_cur,PAF(0),PAF(1),PAF(2),PAF(3)); }
  #undef PKW
  #undef PAF
  #undef VFR
  #undef PIN
  #undef MX3
  #undef GAPA
  #undef GAPB
  #undef EX
  #undef VRD
  #undef KRD
  #undef STEP
  #undef ENDW
  {auto rr=__builtin_amdgcn_permlane32_swap(__float_as_uint(l_reg),__float_as_uint(l_reg),false,false);l_reg=__uint_as_float(rr[0])+__uint_as_float(rr[1]);}
  if(hi==0)wsf[32+r32]=l_reg;asm volatile("s_waitcnt lgkmcnt(0)":::"memory");
  float rli[16];
  #pragma unroll
  for(int r=0;r<16;++r)rli[r]=__builtin_amdgcn_rcpf(wsf[32+crow(r,hi)]);
  bf16*Ow=Ob+(long)(wid*QBLK)*OPITCH;
  { bf16*stg=(bf16*)(shm+LDS_OST)+wid*2048;
    #pragma unroll
    for(int r=0;r<16;++r){const int orow=crow(r,hi);
      #pragma unroll
      for(int d0=0;d0<2;++d0)stg[orow*64+d0*32+r32]=__float2bfloat16(o[d0][r]*rli[r]);}
    asm volatile("s_waitcnt lgkmcnt(0)":::"memory");
    #pragma unroll
    for(int i=0;i<4;++i){const int row=i*8+(lane>>3),ch=lane&7; const u32x4 v=*(const u32x4*)(stg+row*64+ch*8); if(wid>=wlo&&wid<whi)ATTN_STORE16(Ow+(long)row*OPITCH+ch*8,v);} }
  asm volatile("s_waitcnt lgkmcnt(0)\n\ts_barrier":::"memory");
  #undef DMA_K
  #undef DMA_V
  #undef CMASK
  #undef START
  #undef RESC
  #undef ROT
  #undef CBLOAD
}
constexpr int ATTN_LDS_BYTES=LDS_BYTES;
#undef SBAR
#undef WAIT_BAR
}
#include <hip/hip_cooperative_groups.h>
namespace cg = cooperative_groups;
#ifndef MK_N_LAUNCHES
#define MK_N_LAUNCHES 1
#endif
#ifndef FOX_PRUNE
#define FOX_PRUNE 1
#endif
constexpr int NWAVES = 8, NTHR = 512;
constexpr int DMOD = 1024, TSEQ = 8192, NBATCH = 8, MP = NBATCH * TSEQ, MS = 512, MTOT = MP + MS;
constexpr int NIN = 3584, INC = 3592, FF = 4096, SSEQ = 1152, PAST = 1024, DSEQ = 32;
constexpr int NCHUNK = MTOT / 64;
constexpr float EPSN = 1e-6f, LOG2E = 1.4426950408889634f;
constexpr size_t MiB = 1u << 20;
constexpr size_t WS_CTL = 0, CTL_ZERO_BYTES = 4096;
constexpr size_t WS_WIN = 2 * MiB, WS_WO = 9 * MiB, WS_WUP = 11 * MiB, WS_WDN = 19 * MiB;
constexpr size_t WS_RSTD = 27 * MiB, WS_CGP = 28 * MiB, WS_CGS = 30 * MiB, WS_VEC = 31 * MiB, WS_SSQ = 38 * MiB;
constexpr size_t WS_X1B = 44 * MiB, WS_MIX = 174 * MiB, WS_H = 304 * MiB;
constexpr size_t WS_XB = 304 * MiB, WS_Q = 434 * MiB, WS_K = 498 * MiB, WS_V = 562 * MiB, WS_QS = 626 * MiB, WS_KS = 635 * MiB, WS_VS = 644 * MiB;
constexpr size_t WS_QR = 654 * MiB, WS_KR = 719 * MiB, WS_VH = 784 * MiB, WS_SG = 849 * MiB, WS_END = 914 * MiB;
constexpr size_t VECN = (size_t)NCHUNK * 512;
static_assert(WS_VEC + 3 * VECN * 4 <= WS_SSQ && WS_SSQ + (size_t)MTOT * 16 * 4 <= WS_X1B && WS_X1B + (size_t)MTOT * DMOD * 2 <= WS_MIX && WS_MIX + (size_t)MTOT * DMOD * 2 <= WS_H, "ws map");
static_assert(WS_H + (size_t)MTOT * FF * 2 <= WS_END && WS_XB + (size_t)MTOT * DMOD * 2 <= WS_Q && WS_SG + (size_t)MTOT * 512 * 2 <= WS_END, "ws map 2");
constexpr int CW_QUEUE = 64;
constexpr size_t O_YP = 0, O_YS = O_YP + (size_t)MP * DMOD, O_KP = O_YS + (size_t)256 * DMOD, O_VP = O_KP + (size_t)MP * 512, O_LP = O_VP + (size_t)MP * 512,
                 O_HP = O_LP + (size_t)MP * 8, O_KS = O_HP + 524288, O_VS = O_KS + 131072, O_LS = O_VS + 131072, O_HS = O_LS + 2048, O_END = O_HS + 524288;
constexpr int RING_BYTES = 131072, MISC_OFF = RING_BYTES, LDS_BYTES = 135168;
static_assert(attn_body::ATTN_LDS_BYTES <= RING_BYTES, "attention LDS");

#define LAS __attribute__((address_space(3)))
typedef unsigned short bf16;
typedef unsigned v4u __attribute__((ext_vector_type(4)));
typedef unsigned v2u __attribute__((ext_vector_type(2)));
typedef float f32x4 __attribute__((ext_vector_type(4)));
typedef short bf16x8 __attribute__((ext_vector_type(8)));
#define LDS_WAIT() asm volatile("s_waitcnt lgkmcnt(0)" ::: "memory")
__device__ __forceinline__ unsigned pk2(float lo, float hi) { return pg8::cvt_pk_bf16(lo, hi); }
__device__ __forceinline__ float bf2f(unsigned short b) { return __uint_as_float(((unsigned)b) << 16); }
__device__ __forceinline__ float wave_sum(float v) {
#pragma unroll
    for (int o = 1; o < 64; o <<= 1) v += __shfl_xor(v, o);
    return v;
}
__device__ __forceinline__ bool row_map(int row, int& idx) { if (row < MP) { idx = row; return true; } const int rs = row - MP; idx = (rs >> 6) * 32 + (rs & 63); return (rs & 63) < 32; }

namespace pg8 {
#define DPP_SHR(v, n) __int_as_float(__builtin_amdgcn_update_dpp(0, __float_as_int(v), 0x110 + (n), 0xf, 0xf, false))
struct EpiIn {
    static constexpr bool PERM = false, AFTER_DRAIN = false;
    const float* rstd1; const float* lbl; const float* qg; const float* kg; unsigned char* ws; float* out;
    __device__ __forceinline__ void operator()(const f32x4 (&acc)[2][2][4][2], const Unit& u, int wr, int wc, int fr, int fq) const {
        const int pn = u.pn, rowb = u.pm * BM + wr * 64 + fr; const bool samp = u.pm >= (MP / BM);
        bf16_t* const QR = (bf16_t*)(ws + WS_QR); bf16_t* const KR = (bf16_t*)(ws + WS_KR); bf16_t* const VH = (bf16_t*)(ws + WS_VH); bf16_t* const SG = (bf16_t*)(ws + WS_SG); float* const vec = (float*)(ws + WS_VEC);
        float rs[2][4];
#pragma unroll
        for (int ai = 0; ai < 2; ++ai)
#pragma unroll
            for (int m = 0; m < 4; ++m) rs[ai][m] = rstd1[rowb + ai * HALF + m * 16];
        if (pn < 4) {
            const int h = pn, ch0 = 128 * h + 32 * wc + 4 * fq; const int lane = threadIdx.x & 63; const int a15 = ((lane & 48) | 15) << 2;
#pragma unroll
            for (int n = 0; n < 2; ++n) {
                const f32x4 l0 = *(const f32x4*)(lbl + ch0 + 16 * n), l1 = *(const f32x4*)(lbl + 512 + ch0 + 16 * n);
                f32x4 lb, omlb;
#pragma unroll
                for (int j = 0; j < 4; ++j) { lb[j] = 1.f / (1.f + __expf(l1[j] - l0[j])); omlb[j] = 1.f - lb[j]; }
#pragma unroll
                for (int ai = 0; ai < 2; ++ai) {
                    f32x4 bq[4], kk[4], bb[4]; f32x4 carry = {0.f, 0.f, 0.f, 0.f};
#pragma unroll
                    for (int m = 0; m < 4; ++m) {
#pragma unroll
                        for (int j = 0; j < 4; ++j) {
                            const float zq = acc[ai][0][m][n][j] * rs[ai][m], zf = acc[ai][1][m][n][j] * rs[ai][m];
                            const float sig = 1.f / (1.f + __expf(-zf)); const float f = lb[j] + omlb[j] * sig; float k = omlb[j] * (1.f - sig); float s = __logf(f);
                            if (samp && m >= 2) { s = 0.f; k = 0.f; }
                            s += DPP_SHR(s, 1); s += DPP_SHR(s, 2); s += DPP_SHR(s, 4); s += DPP_SHR(s, 8);
                            s += carry[j]; carry[j] = __int_as_float(__builtin_amdgcn_ds_bpermute(a15, __float_as_int(s)));
                            bq[m][j] = zq; kk[m][j] = k; bb[m][j] = s;
                        }
                    }
#pragma unroll
                    for (int m = 0; m < 4; ++m) {
                        float qv[4], kv[4];
#pragma unroll
                        for (int j = 0; j < 4; ++j) { qv[j] = bq[m][j] * __expf(bb[m][j]); kv[j] = kk[m][j] * __expf(-bb[m][j]); }
                        const size_t off = (size_t)(rowb + ai * HALF + m * 16) * 512 + ch0 + 16 * n;
                        v2u wq; wq.x = cvt_pk_bf16(qv[0], qv[1]); wq.y = cvt_pk_bf16(qv[2], qv[3]); *(v2u*)(QR + off) = wq;
                        v2u wk; wk.x = cvt_pk_bf16(kv[0], kv[1]); wk.y = cvt_pk_bf16(kv[2], kv[3]); *(v2u*)(KR + off) = wk;
                    }
                    if (fr == 0) {
                        const size_t voff = (size_t)((u.pm * BM + ai * HALF + wr * 64) >> 6) * 512 + ch0 + 16 * n;
                        f32x4 d;
#pragma unroll
                        for (int j = 0; j < 4; ++j) d[j] = __expf(carry[j]);
                        *(f32x4*)(vec + voff) = d;
                    }
                }
            }
        } else if (pn < 8) {
            const int h = pn - 4, c0 = 128 * h + 32 * wc + 4 * fq;
#pragma unroll
            for (int ai = 0; ai < 2; ++ai)
#pragma unroll
                for (int m = 0; m < 4; ++m) { const size_t off = (size_t)(rowb + ai * HALF + m * 16) * 512 + c0; const float r = rs[ai][m];
#pragma unroll
                    for (int n = 0; n < 2; ++n) { const f32x4 v = acc[ai][0][m][n] * r; f32x4 g = acc[ai][1][m][n] * r;
#pragma unroll
                        for (int j = 0; j < 4; ++j) g[j] = g[j] / (1.f + __expf(-g[j]));
                        v2u wv; wv.x = cvt_pk_bf16(v[0], v[1]); wv.y = cvt_pk_bf16(v[2], v[3]); *(v2u*)(VH + off + 16 * n) = wv;
                        v2u wg; wg.x = cvt_pk_bf16(g[0], g[1]); wg.y = cvt_pk_bf16(g[2], g[3]); *(v2u*)(SG + off + 16 * n) = wg; } }
        } else if (pn < 12) {
            const bool isK = pn >= 10; const int head = 4 * ((pn - 8) & 1) + wc; const float* gain = isK ? kg : qg; const float osc = isK ? 1.f : attn_body::C2;
            f32x4 gv[2][2];
#pragma unroll
            for (int bj = 0; bj < 2; ++bj)
#pragma unroll
                for (int n = 0; n < 2; ++n) gv[bj][n] = *(const f32x4*)(gain + 32 * bj + 16 * n + 4 * fq) * osc;
#pragma unroll
            for (int ai = 0; ai < 2; ++ai)
#pragma unroll
                for (int m = 0; m < 4; ++m) { const int row = rowb + ai * HALF + m * 16; const float r = rs[ai][m]; float ssq = 0.f;
#pragma unroll
                    for (int bj = 0; bj < 2; ++bj)
#pragma unroll
                        for (int n = 0; n < 2; ++n) { const f32x4 z = acc[ai][bj][m][n] * r; ssq += (z[0] * z[0] + z[1] * z[1]) + (z[2] * z[2] + z[3] * z[3]); }
                    ssq += __shfl_xor(ssq, 16); ssq += __shfl_xor(ssq, 32);
                    const float r2 = r / sqrtf(ssq * (1.f / 64.f) + EPSN);
                    int idx; const bool valid = row_map(row, idx);
                    float* ofp = out + (samp ? O_KS : O_KP) + (size_t)idx * 512;
                    const size_t boff = samp ? (isK ? WS_KS : WS_QS) : (isK ? WS_K : WS_Q); const size_t brow = samp ? (size_t)((idx >> 5) * SSEQ + PAST + (idx & 31)) : (size_t)row;
                    bf16_t* bfp = (bf16_t*)(ws + boff) + brow * 512;
                    if (valid) {
#pragma unroll
                        for (int bj = 0; bj < 2; ++bj)
#pragma unroll
                            for (int n = 0; n < 2; ++n) { const f32x4 v = acc[ai][bj][m][n] * r2 * gv[bj][n]; const int col = 64 * head + 32 * bj + 16 * n + 4 * fq;
                                if (isK) *(f32x4*)(ofp + col) = v;
                                v2u w; w.x = cvt_pk_bf16(v[0], v[1]); w.y = cvt_pk_bf16(v[2], v[3]); *(v2u*)(bfp + col) = w; } } }
        } else {
            const int c0 = 256 * (pn - 12) + 32 * wc + 4 * fq;
#pragma unroll
            for (int ai = 0; ai < 2; ++ai)
#pragma unroll
                for (int m = 0; m < 4; ++m) { const int row = rowb + ai * HALF + m * 16; const float r = rs[ai][m];
                    int idx; const bool valid = row_map(row, idx);
                    float* ofp = out + (samp ? O_VS : O_VP) + (size_t)idx * 512;
                    const size_t brow = samp ? (size_t)((idx >> 5) * SSEQ + PAST + (idx & 31)) : (size_t)row;
                    bf16_t* bfp = (bf16_t*)(ws + (samp ? WS_VS : WS_V)) + brow * 512;
                    if (valid) {
#pragma unroll
                        for (int bj = 0; bj < 2; ++bj)
#pragma unroll
                            for (int n = 0; n < 2; ++n) { const f32x4 v = acc[ai][bj][m][n] * r; const int col = c0 + 128 * bj + 16 * n;
                                *(f32x4*)(ofp + col) = v;
                                v2u w; w.x = cvt_pk_bf16(v[0], v[1]); w.y = cvt_pk_bf16(v[2], v[3]); *(v2u*)(bfp + col) = w; } } }
        }
    }
};
struct EpiWo {
    static constexpr bool PERM = false, AFTER_DRAIN = false;
    const float* xp; const float* xs; float* yp; float* ys; bf16_t* X1B; float* ssq;
    __device__ __forceinline__ void operator()(const f32x4 (&acc)[2][2][4][2], const Unit& u, int wr, int wc, int fr, int fq) const {
        const int rowb = u.pm * BM + wr * 64 + fr, c0 = u.pn * BM + wc * 32 + 4 * fq; const bool samp = u.pm >= (MP / BM);
#pragma unroll
        for (int ai = 0; ai < 2; ++ai)
#pragma unroll
            for (int m = 0; m < 4; ++m) { const int row = rowb + ai * HALF + m * 16; int idx; const bool valid = row_map(row, idx);
                const float* xr = (samp ? xs : xp) + (size_t)idx * DMOD; float* yr = yp + (samp ? (size_t)MP * DMOD : (size_t)0) + (size_t)idx * DMOD; float s = 0.f;
#pragma unroll
                for (int bj = 0; bj < 2; ++bj)
#pragma unroll
                    for (int n = 0; n < 2; ++n) { const int col = c0 + 128 * bj + 16 * n; f32x4 v = acc[ai][bj][m][n];
                        if (valid) { v += *(const f32x4*)(xr + col); *(f32x4*)(yr + col) = v; }
                        s += (v[0] * v[0] + v[1] * v[1]) + (v[2] * v[2] + v[3] * v[3]);
                        v2u w; w.x = cvt_pk_bf16(v[0], v[1]); w.y = cvt_pk_bf16(v[2], v[3]); *(v2u*)(X1B + (size_t)row * DMOD + col) = w; }
                s += __shfl_xor(s, 16); s += __shfl_xor(s, 32);
                if (fq == 0) ssq[(size_t)row * 16 + 4 * u.pn + wc] = s; }
    }
};
struct EpiUp {
    static constexpr bool PERM = true, AFTER_DRAIN = false;
    bf16_t* O; const float* ssq;
    __device__ __forceinline__ void operator()(const f32x4 (&acc)[2][2][4][2], const Unit& u, int wr, int wc, int fr, int fq) const {
        const int row0 = u.pm * BM + wr * 64 + fr, col0 = u.pn * BM + wc * 32 + 8 * fq;
#pragma unroll
        for (int ai = 0; ai < 2; ++ai)
#pragma unroll
            for (int m = 0; m < 4; ++m) { const int row = row0 + ai * HALF + m * 16; const f32x4* sp = (const f32x4*)(ssq + (size_t)row * 16);
                const f32x4 s0 = sp[0], s1 = sp[1], s2 = sp[2], s3 = sp[3]; const f32x4 st = (s0 + s1) + (s2 + s3);
                const float r = 1.f / sqrtf(((st[0] + st[1]) + (st[2] + st[3])) * (1.f / DMOD) + EPSN);
                bf16_t* rowp = O + (size_t)row * FF + col0;
#pragma unroll
                for (int bj = 0; bj < 2; ++bj) { f32x4 v0 = acc[ai][bj][m][0] * r, v1 = acc[ai][bj][m][1] * r;
#pragma unroll
                    for (int j = 0; j < 4; ++j) { v0[j] = fmaxf(v0[j], 0.f); v0[j] *= v0[j]; v1[j] = fmaxf(v1[j], 0.f); v1[j] *= v1[j]; }
                    u32x4 w; w.x = cvt_pk_bf16(v0[0], v0[1]); w.y = cvt_pk_bf16(v0[2], v0[3]); w.z = cvt_pk_bf16(v1[0], v1[1]); w.w = cvt_pk_bf16(v1[2], v1[3]);
                    *(u32x4*)(rowp + bj * HALF) = w; } }
    }
};
struct EpiDown {
    static constexpr bool PERM = false, AFTER_DRAIN = false;
    float* yp; float* ys;
    __device__ __forceinline__ void operator()(const f32x4 (&acc)[2][2][4][2], const Unit& u, int wr, int wc, int fr, int fq) const {
        const int rowb = u.pm * BM + wr * 64 + fr, c0 = u.pn * BM + wc * 32 + 4 * fq; const bool samp = u.pm >= (MP / BM);
#pragma unroll
        for (int ai = 0; ai < 2; ++ai)
#pragma unroll
            for (int m = 0; m < 4; ++m) { const int row = rowb + ai * HALF + m * 16; int idx; const bool valid = row_map(row, idx);
                float* yr = yp + (samp ? (size_t)MP * DMOD : (size_t)0) + (size_t)idx * DMOD;
                if (valid) {
#pragma unroll
                    for (int bj = 0; bj < 2; ++bj)
#pragma unroll
                        for (int n = 0; n < 2; ++n) { const int col = c0 + 128 * bj + 16 * n; *(f32x4*)(yr + col) = *(const f32x4*)(yr + col) + acc[ai][bj][m][n]; } } }
    }
};
}

struct Args { const float* in[17]; float* out; unsigned char* ws; int ph_lo, ph_hi; };
struct Frame {
    LAS unsigned char* lds; volatile LAS unsigned* MISC; unsigned* ctl; unsigned char* ws; float* out;
    int tid, lane, wave, vcu, G;
    const float *xp, *xs, *ck, *cv, *clf, *sh, *n1, *win, *bff, *qg, *kg, *lbl, *hon, *wout, *n2, *wup, *wdn;
};

__device__ __forceinline__ int win_src_col(int g) {
    const int j0 = 32 * g, tile = j0 >> 8, jl = j0 & 255;
    if (tile < 4) return (jl < 128) ? (128 * tile + jl) : (512 + 128 * tile + (jl - 128));
    if (tile < 8) { const int h = tile - 4; return (jl < 128) ? (1024 + 128 * h + jl) : (1536 + 128 * h + (jl - 128)); }
    if (tile < 12) { const int base = tile < 10 ? 2048 : 2560, tl = (tile - 8) & 1, bj = jl >> 7, wc = (jl >> 5) & 3; return base + 64 * (4 * tl + wc) + 32 * bj; }
    return 3072 + (j0 - 12 * 256);
}
__device__ __forceinline__ void p0_transpose_item(const float* W, int ldw, int K, const float* nrm, bf16* WT, int n0, int src0, int k0, LAS float* scr, int lane) {
#pragma unroll 8
    for (int i = 0; i < 32; ++i) { const int kk = 2 * i + (lane >> 5); float v = W[(size_t)(k0 + kk) * ldw + src0 + (lane & 31)]; if (nrm) v *= nrm[k0 + kk]; scr[kk * 33 + (lane & 31)] = v; }
    LDS_WAIT(); asm volatile("" ::: "memory");
    const int c = lane & 7;
#pragma unroll
    for (int j = 0; j < 4; ++j) { const int n = (lane >> 3) + 8 * j; const LAS float* s = scr + (8 * c) * 33 + n;
        v4u o; o.x = pk2(s[0 * 33], s[1 * 33]); o.y = pk2(s[2 * 33], s[3 * 33]); o.z = pk2(s[4 * 33], s[5 * 33]); o.w = pk2(s[6 * 33], s[7 * 33]);
        *(v4u*)(WT + (size_t)(n0 + n) * K + k0 + 8 * c) = o; }
    LDS_WAIT(); asm volatile("" ::: "memory");
}
__device__ __forceinline__ void p0_prologue(Frame& F) {
    LAS float* scr = (LAS float*)(F.lds + F.wave * 16384);
    const int gw = F.vcu * NWAVES + F.wave, NGW = F.G * NWAVES, lane = F.lane;
    bf16* Win_t = (bf16*)(F.ws + WS_WIN); bf16* Wo_t = (bf16*)(F.ws + WS_WO); bf16* Wup_t = (bf16*)(F.ws + WS_WUP); bf16* Wdn_t = (bf16*)(F.ws + WS_WDN);
    constexpr int I_IN = 16 * (NIN / 32), I_O = 16 * 32, I_UP = 16 * (FF / 32), I_DN = 64 * 32, NITEMS = I_IN + I_O + I_UP + I_DN;
    for (int it = gw; it < NITEMS; it += NGW) {
        int r = it;
        if (r < I_IN) { const int kb = r / (NIN / 32), g = r % (NIN / 32); p0_transpose_item(F.win, INC, DMOD, F.n1, Win_t, 32 * g, win_src_col(g), 64 * kb, scr, lane); continue; } r -= I_IN;
        if (r < I_O) { const int kb = r / 32, g = r % 32; p0_transpose_item(F.wout, DMOD, DMOD, nullptr, Wo_t, 32 * g, 32 * g, 64 * kb, scr, lane); continue; } r -= I_O;
        if (r < I_UP) { const int kb = r / (FF / 32), g = r % (FF / 32); p0_transpose_item(F.wup, FF, DMOD, F.n2, Wup_t, 32 * g, 32 * g, 64 * kb, scr, lane); continue; } r -= I_UP;
        { const int kb = r / 32, g = r % 32; p0_transpose_item(F.wdn, DMOD, FF, nullptr, Wdn_t, 32 * g, 32 * g, 64 * kb, scr, lane); }
    }
    { const int gt = F.vcu * NTHR + F.tid, NGT = F.G * NTHR;
      bf16* Qs = (bf16*)(F.ws + WS_QS); bf16* Ks = (bf16*)(F.ws + WS_KS); bf16* Vs = (bf16*)(F.ws + WS_VS);
      for (int i = gt; i < NBATCH * PAST * 64; i += NGT) { const int b = i / (PAST * 64), rem = i % (PAST * 64); const size_t so = (size_t)i * 8, dof = ((size_t)b * SSEQ * 64 + rem) * 8;
          const f32x4 a0 = *(const f32x4*)(F.ck + so), a1 = *(const f32x4*)(F.ck + so + 4), b0 = *(const f32x4*)(F.cv + so), b1 = *(const f32x4*)(F.cv + so + 4);
          v4u o; o.x = pk2(a0[0], a0[1]); o.y = pk2(a0[2], a0[3]); o.z = pk2(a1[0], a1[1]); o.w = pk2(a1[2], a1[3]); *(v4u*)(Ks + dof) = o;
          o.x = pk2(b0[0], b0[1]); o.y = pk2(b0[2], b0[3]); o.z = pk2(b1[0], b1[1]); o.w = pk2(b1[2], b1[3]); *(v4u*)(Vs + dof) = o; }
      const v4u z = {0u, 0u, 0u, 0u};
      for (int i = gt; i < NBATCH * SSEQ * 64; i += NGT) *(v4u*)(Qs + (size_t)i * 8) = z;
      for (int i = gt; i < NBATCH * (SSEQ - PAST) * 64; i += NGT) { const int b = i / ((SSEQ - PAST) * 64), rem = i % ((SSEQ - PAST) * 64); const size_t dof = ((size_t)(b * SSEQ + PAST) * 64 + rem) * 8; *(v4u*)(Ks + dof) = z; *(v4u*)(Vs + dof) = z; }
    }
    float wf[4][4][8];
#pragma unroll
    for (int j = 0; j < 4; ++j)
#pragma unroll
        for (int i = 0; i < 4; ++i) { const int k = 256 * j + 4 * lane + i; const float nk = F.n1[k]; const f32x4 a = *(const f32x4*)(F.win + (size_t)k * INC + NIN), b = *(const f32x4*)(F.win + (size_t)k * INC + NIN + 4);
            wf[j][i][0] = a[0] * nk; wf[j][i][1] = a[1] * nk; wf[j][i][2] = a[2] * nk; wf[j][i][3] = a[3] * nk; wf[j][i][4] = b[0] * nk; wf[j][i][5] = b[1] * nk; wf[j][i][6] = b[2] * nk; wf[j][i][7] = b[3] * nk; }
    const f32x4 bf0 = *(const f32x4*)(F.bff), bf1 = *(const f32x4*)(F.bff + 4);
    float* rstd1 = (float*)(F.ws + WS_RSTD); bf16* XB = (bf16*)(F.ws + WS_XB);
    for (int m = gw; m < MTOT; m += NGW) {
        int idx; const bool valid = row_map(m, idx); const float* xrow = (m < MP ? F.xp : F.xs) + (size_t)idx * DMOD;
        f32x4 v[4]; float s = 0.f;
#pragma unroll
        for (int j = 0; j < 4; ++j) { v[j] = valid ? *((const f32x4*)xrow + 64 * j + lane) : (f32x4){0.f, 0.f, 0.f, 0.f}; s += (v[j][0] * v[j][0] + v[j][1] * v[j][1]) + (v[j][2] * v[j][2] + v[j][3] * v[j][3]); }
        const float rstd = 1.f / sqrtf(wave_sum(s) * (1.f / DMOD) + EPSN);
        if (lane == 0) rstd1[m] = rstd;
        unsigned long long* o8 = (unsigned long long*)(XB + (size_t)m * DMOD) + lane;
#pragma unroll
        for (int j = 0; j < 4; ++j) o8[64 * j] = (unsigned long long)pk2(v[j][0], v[j][1]) | ((unsigned long long)pk2(v[j][2], v[j][3]) << 32);
        float fb[8];
#pragma unroll
        for (int h = 0; h < 8; ++h) { float a = 0.f;
#pragma unroll
            for (int j = 0; j < 4; ++j)
#pragma unroll
                for (int i = 0; i < 4; ++i) a += v[j][i] * wf[j][i][h];
            fb[h] = wave_sum(a); }
        if (valid && lane == 0) { f32x4 o0, o1;
#pragma unroll
            for (int h = 0; h < 8; ++h) { const float xx = fb[h] * rstd + (h < 4 ? bf0[h & 3] : bf1[h & 3]); const float ls = fminf(xx, 0.f) - log1pf(expf(-fabsf(xx))); if (h < 4) o0[h & 3] = ls; else o1[h & 3] = ls; }
            float* lp = (m < MP ? F.out + O_LP : F.out + O_LS) + (size_t)idx * 8; *(f32x4*)lp = o0; *(f32x4*)(lp + 4) = o1; }
    }
}
__device__ __forceinline__ void scan_chain(Frame& F, int ch) {
    LAS float* wsum = (LAS float*)F.lds;
    const bool samp = ch >= 64; const int c2 = samp ? ch - 64 : ch, b = c2 >> 3, h = c2 & 7; const int L = samp ? SSEQ : TSEQ, EPT = samp ? 3 : 16;
    float* dst = samp ? (float*)(F.ws + WS_CGS) + (size_t)c2 * SSEQ : (float*)(F.ws + WS_CGP) + (size_t)c2 * TSEQ;
    float vals[16]; float sum = 0.f;
#pragma unroll
    for (int i = 0; i < 16; ++i) { const int p = F.tid * EPT + i; float v = 0.f;
        if (i < EPT && p < L) { if (!samp) v = F.out[O_LP + ((size_t)b * TSEQ + p) * 8 + h]; else if (p < PAST) v = F.clf[((size_t)b * PAST + p) * 8 + h]; else if (p < PAST + DSEQ) v = F.out[O_LS + ((size_t)b * DSEQ + (p - PAST)) * 8 + h]; }
        sum += v; vals[i] = sum; }
    float incl = sum;
#pragma unroll
    for (int o = 1; o < 64; o <<= 1) { const float t = __shfl_up(incl, o); if (F.lane >= o) incl += t; }
    if (F.lane == 63) wsum[F.wave] = incl;
    __syncthreads();
    float base = 0.f;
    for (int w = 0; w < F.wave; ++w) base += wsum[w];
    const float excl = base + incl - sum;
#pragma unroll
    for (int i = 0; i < 16; ++i) { const int p = F.tid * EPT + i; if (i < EPT && p < L) dst[p] = (excl + vals[i]) * LOG2E; }
    __syncthreads();
}
constexpr int H_QR = 0, H_KR = 17408, H_KT = 34816, H_VT = 53248, H_VEC = 71680, H_AL = 73216, H_OL = 82432, H_END = 116224;
static_assert(H_END <= RING_BYTES, "hgrn LDS");
typedef short v4i16_t __attribute__((ext_vector_type(4)));
__device__ __forceinline__ bf16x8 tr_frag(LAS unsigned char* p) {
    const v4i16_t lo = __builtin_amdgcn_ds_read_tr16_b64_v4i16((LAS v4i16_t*)p), hi = __builtin_amdgcn_ds_read_tr16_b64_v4i16((LAS v4i16_t*)(p + 4 * 272));
    return (bf16x8){lo[0], lo[1], lo[2], lo[3], hi[0], hi[1], hi[2], hi[3]};
}
__device__ __forceinline__ f32x4 mfma16(bf16x8 a, bf16x8 b, f32x4 c) { return __builtin_amdgcn_mfma_f32_16x16x32_bf16(a, b, c, 0, 0, 0); }
#define LAUNDER(x) asm volatile("" : "+v"(x))
#define HG_BAR() do { asm volatile("s_waitcnt lgkmcnt(0)" ::: "memory"); __builtin_amdgcn_s_barrier(); asm volatile("" ::: "memory"); } while (0)
__device__ __forceinline__ void hgrn_chain(Frame& F, int row0, int chunk0, int nsteps, int h, const float* S0, float* Sout) {
    LAS unsigned char* L = F.lds; int tid_ = F.tid; LAUNDER(tid_); const int tid = tid_, lane = tid & 63, w = F.wave, l15 = lane & 15, fq = lane >> 4;
    const char* qb = (const char*)(F.ws + WS_QR) + ((size_t)row0 * 512 + 128 * h) * 2; const char* kb_ = (const char*)(F.ws + WS_KR) + ((size_t)row0 * 512 + 128 * h) * 2;
    const char* vb = (const char*)(F.ws + WS_VH) + ((size_t)row0 * 512 + 128 * h) * 2; const char* gb = (const char*)(F.ws + WS_SG) + ((size_t)row0 * 512 + 128 * h) * 2;
    const char* eb = (const char*)(F.ws + WS_VEC) + ((size_t)chunk0 * 512 + 128 * h) * 4; char* mb = (char*)(F.ws + WS_MIX) + ((size_t)row0 * DMOD + 128 * h) * 2;
    const int oc = tid >> 3, oseg = tid & 7;
    unsigned vo_rm = (unsigned)((tid >> 4) * 1024 + (tid & 15) * 16), vo_sg = (unsigned)(oc * 1024 + oseg * 32), vo_mix = (unsigned)(oc * 2048 + oseg * 32);
    unsigned vo_vec = (unsigned)((tid & 31) * 16);
    unsigned l_rm = (unsigned)(H_QR + (tid >> 4) * 272 + (tid & 15) * 16);
    unsigned l_vw = (unsigned)(H_VEC + (tid & 31) * 16);
    unsigned l_aq = (unsigned)(H_QR + (16 * (w >> 1) + l15) * 272 + fq * 16);
    unsigned l_ak = (unsigned)(H_KR + (32 * (w & 1) + l15) * 272 + fq * 16);
    unsigned l_aw = (unsigned)(H_AL + (16 * (w >> 1) + 4 * fq) * 144 + (32 * (w & 1) + l15) * 2);
    unsigned l_vt = (unsigned)(H_KT + (8 * fq + (l15 >> 2)) * 272 + (16 * w + 4 * (l15 & 3)) * 2);
    unsigned l_q2 = (unsigned)(H_QR + l15 * 272 + fq * 16);
    unsigned l_al = (unsigned)(H_AL + l15 * 144 + fq * 16);
    unsigned l_kt = (unsigned)(H_KR + (8 * fq + (l15 >> 2)) * 272 + (8 * (l15 & 3)) * 2);
    unsigned l_ve = (unsigned)(H_VEC + fq * 32);
    unsigned l_ow = (unsigned)(H_OL + (4 * fq) * 528 + (16 * w + l15) * 4);
    unsigned l_or = (unsigned)(H_OL + oc * 528 + oseg * 64);
    f32x4 S[8];
#pragma unroll
    for (int kb = 0; kb < 8; ++kb) S[kb] = (f32x4){0.f, 0.f, 0.f, 0.f};
    if (S0) { const float* sp = S0 + (8 * fq) * 128 + 16 * w + l15;
#pragma unroll
        for (int kb = 0; kb < 8; ++kb) { LAUNDER(sp);
#pragma unroll
            for (int r = 0; r < 4; ++r) S[kb][r] = sp[r * 128];
            sp += (kb & 1) ? 28 * 128 : 4 * 128; } }
    v4u pq[2], pk[2], pv[2], psgc[2], pvec;
#define HG_LOAD() do { \
        _Pragma("unroll") for (int it = 0; it < 2; ++it) { pq[it] = *(const v4u*)(qb + vo_rm + it * 32768); pk[it] = *(const v4u*)(kb_ + vo_rm + it * 32768); pv[it] = *(const v4u*)(vb + vo_rm + it * 32768); } \
        if (tid < 32) pvec = *(const v4u*)(eb + vo_vec); } while (0)
#define HG_STORE() do { \
        _Pragma("unroll") for (int it = 0; it < 2; ++it) { *(LAS v4u*)(L + l_rm + it * 8704) = pq[it]; *(LAS v4u*)(L + l_rm + (H_KR - H_QR) + it * 8704) = pk[it]; *(LAS v4u*)(L + l_rm + (H_KT - H_QR) + it * 8704) = pv[it]; } \
        if (tid < 32) *(LAS v4u*)(L + l_vw) = pvec; } while (0)
#define HG_ADV() do { qb += 65536; kb_ += 65536; vb += 65536; eb += 2048; } while (0)
    HG_LOAD(); HG_ADV(); HG_STORE();
    HG_BAR();
    for (int c = 0; c < nsteps; ++c) {
        LAUNDER(vo_rm); LAUNDER(vo_sg); LAUNDER(vo_mix); LAUNDER(vo_vec); LAUNDER(l_rm); LAUNDER(l_vw); LAUNDER(l_aq); LAUNDER(l_ak); LAUNDER(l_aw);
        LAUNDER(l_vt); LAUNDER(l_q2); LAUNDER(l_al); LAUNDER(l_kt); LAUNDER(l_ve); LAUNDER(l_ow); LAUNDER(l_or);
        psgc[0] = *(const v4u*)(gb + vo_sg); psgc[1] = *(const v4u*)(gb + vo_sg + 16); gb += 65536;
        if (c + 1 < nsteps) { HG_LOAD(); HG_ADV(); }
        { const int cblk = w >> 1;
#pragma unroll
          for (int jj = 0; jj < 2; ++jj) { const int sblk = 2 * (w & 1) + jj; f32x4 a = {0.f, 0.f, 0.f, 0.f};
              if (sblk <= cblk) {
#pragma unroll
                  for (int ks = 0; ks < 4; ++ks) { const bf16x8 af = *(const LAS bf16x8*)(L + l_aq + ks * 64); const bf16x8 bf = *(const LAS bf16x8*)(L + l_ak + jj * 16 * 272 + ks * 64); a = mfma16(af, bf, a); }
#pragma unroll
                  for (int r = 0; r < 4; ++r) if (16 * sblk + l15 > 16 * cblk + 4 * fq + r) a[r] = 0.f;
              }
#pragma unroll
              for (int r = 0; r < 4; ++r) *(LAS unsigned short*)(L + l_aw + r * 144 + jj * 32) = (unsigned short)(pk2(a[r], 0.f) & 0xffffu);
          } }
        HG_BAR();
        { bf16x8 bvt[2];
#pragma unroll
          for (int ks = 0; ks < 2; ++ks) bvt[ks] = tr_frag(L + l_vt + ks * 32 * 272);
          bf16x8 sb[4];
#pragma unroll
          for (int kb2 = 0; kb2 < 4; ++kb2) { v4u t; t.x = pk2(S[2 * kb2][0], S[2 * kb2][1]); t.y = pk2(S[2 * kb2][2], S[2 * kb2][3]); t.z = pk2(S[2 * kb2 + 1][0], S[2 * kb2 + 1][1]); t.w = pk2(S[2 * kb2 + 1][2], S[2 * kb2 + 1][3]); sb[kb2] = __builtin_bit_cast(bf16x8, t); }
#pragma unroll
          for (int cb = 0; cb < 4; ++cb) { f32x4 o = {0.f, 0.f, 0.f, 0.f};
#pragma unroll
              for (int ks = 0; ks < 2; ++ks) if (32 * ks <= 16 * cb + 15) { const bf16x8 af = *(const LAS bf16x8*)(L + l_al + cb * 16 * 144 + ks * 64); o = mfma16(af, bvt[ks], o); }
#pragma unroll
              for (int kb2 = 0; kb2 < 4; ++kb2) { const bf16x8 af = *(const LAS bf16x8*)(L + l_q2 + cb * 16 * 272 + kb2 * 64); o = mfma16(af, sb[kb2], o); }
#pragma unroll
              for (int r = 0; r < 4; ++r) *(LAS float*)(L + l_ow + (16 * cb + r) * 528) = o[r];
              __builtin_amdgcn_sched_barrier(0); }
#pragma unroll
          for (int kb = 0; kb < 8; ++kb) {
#pragma unroll
              for (int ks = 0; ks < 2; ++ks) { const bf16x8 af = tr_frag(L + l_kt + (32 * (kb >> 1) + 4 * (kb & 1)) * 2 + ks * 32 * 272); S[kb] = mfma16(af, bvt[ks], S[kb]); }
              const f32x4 dv = *(const LAS f32x4*)(L + l_ve + (32 * (kb >> 1) + 4 * (kb & 1)) * 4);
              S[kb] = S[kb] * dv;
              if (kb & 1) __builtin_amdgcn_sched_barrier(0); } }
        HG_BAR();
        { f32x4 ov[4]; float ss = 0.f;
#pragma unroll
          for (int i = 0; i < 4; ++i) { ov[i] = *(const LAS f32x4*)(L + l_or + 16 * i); ss += (ov[i][0] * ov[i][0] + ov[i][1] * ov[i][1]) + (ov[i][2] * ov[i][2] + ov[i][3] * ov[i][3]); }
          ss += __shfl_xor(ss, 1); ss += __shfl_xor(ss, 2); ss += __shfl_xor(ss, 4);
          const float rn = 1.f / sqrtf(ss * (1.f / 128.f) + EPSN);
          float res[16]; f32x4 gn[4]; const float* hp = F.hon + 128 * h + 16 * oseg; LAUNDER(hp);
#pragma unroll
          for (int i = 0; i < 4; ++i) gn[i] = *(const f32x4*)(hp + 4 * i);
#pragma unroll
          for (int i = 0; i < 4; ++i)
#pragma unroll
              for (int j = 0; j < 4; ++j) { const int e = 4 * i + j; const unsigned wd = psgc[e >> 3][(e & 7) >> 1]; const float sg = bf2f((unsigned short)((e & 1) ? (wd >> 16) : (wd & 0xffffu))); res[e] = ov[i][j] * rn * gn[i][j] * sg; }
          v4u o0, o1; o0.x = pk2(res[0], res[1]); o0.y = pk2(res[2], res[3]); o0.z = pk2(res[4], res[5]); o0.w = pk2(res[6], res[7]); o1.x = pk2(res[8], res[9]); o1.y = pk2(res[10], res[11]); o1.z = pk2(res[12], res[13]); o1.w = pk2(res[14], res[15]);
          *(v4u*)(mb + vo_mix) = o0; *(v4u*)(mb + vo_mix + 16) = o1; mb += 131072; }
        if (c + 1 < nsteps) { HG_STORE(); }
        HG_BAR();
    }
    { int ln2 = lane; LAUNDER(ln2); float* sp = Sout + (8 * (ln2 >> 4)) * 128 + 16 * w + (ln2 & 15);
#pragma unroll
      for (int kb = 0; kb < 8; ++kb) { LAUNDER(sp);
#pragma unroll
          for (int r = 0; r < 4; ++r) sp[r * 128] = S[kb][r];
          sp += (kb & 1) ? 28 * 128 : 4 * 128; } }
#undef HG_LOAD
#undef HG_STORE
#undef HG_ADV
}

__global__ void __launch_bounds__(NTHR, 2) skel_fwd(Args args) {
    extern __shared__ __attribute__((aligned(16))) unsigned char lds[];
    Frame F;
    F.lds = (LAS unsigned char*)lds; F.MISC = (volatile LAS unsigned*)(F.lds + MISC_OFF);
    F.tid = threadIdx.x; F.lane = F.tid & 63; F.wave = __builtin_amdgcn_readfirstlane(F.tid >> 6);
    F.G = gridDim.x; { const int bx = blockIdx.x; F.vcu = (F.G % 8 == 0) ? (bx % 8) * (F.G / 8) + bx / 8 : bx; }
    F.ws = args.ws; F.ctl = (unsigned*)(args.ws + WS_CTL); F.out = args.out;
    F.xp = args.in[0]; F.xs = args.in[1]; F.ck = args.in[2]; F.cv = args.in[3]; F.clf = args.in[4]; F.sh = args.in[5]; F.n1 = args.in[6]; F.win = args.in[7]; F.bff = args.in[8];
    F.qg = args.in[9]; F.kg = args.in[10]; F.lbl = args.in[11]; F.hon = args.in[12]; F.wout = args.in[13]; F.n2 = args.in[14]; F.wup = args.in[15]; F.wdn = args.in[16];
    const int lo = args.ph_lo, hi = args.ph_hi;
#if defined(PROBE_A)
    unsigned long long ts_[9]; const bool stamper_ = (blockIdx.x == 0 && F.tid == 0);
#define STAMP(k) do { if (stamper_) ts_[k] = __builtin_amdgcn_s_memrealtime(); } while (0)
    STAMP(0);
#else
#define STAMP(k) do {} while (0)
#endif
#ifndef PH_MASK
#define PH_MASK 63
#endif
#define IN(k) (((PH_MASK >> (k)) & 1) && lo <= (k) && (k) < hi)
#define SEAM(k) do { if (IN(k) && IN((k) + 1)) { cg::this_grid().sync(); } } while (0)
    bf16* XB = (bf16*)(F.ws + WS_XB); bf16* X1B = (bf16*)(F.ws + WS_X1B); bf16* MIX = (bf16*)(F.ws + WS_MIX); bf16* HB = (bf16*)(F.ws + WS_H);
    if (IN(0)) { p0_prologue(F); }
    SEAM(0); STAMP(1);
    if (IN(1)) {
#ifndef NO_SCAN
        for (int ch = F.vcu; ch < 128; ch += F.G) scan_chain(F, ch);
#endif
        pg8::Gemm g{XB, (const bf16*)(F.ws + WS_WIN), MTOT, NIN, DMOD}; pg8::StaticOrder S; S.init(MTOT, NIN, F.G, (int)blockIdx.x);
        pg8::EpiIn E{(const float*)(F.ws + WS_RSTD), F.lbl, F.qg, F.kg, F.ws, F.out};
        pg8::gemm_phase<pg8::EpiIn, pg8::StaticOrder, true, true>(F.lds, g, S, E);
    }
    SEAM(1); STAMP(2);
    if (IN(2)) {
#ifndef NO_HGRN
        STAMP(7);
#if defined(DOUBLE_HGRN)
        for (int rep_ = 0; rep_ < 2; ++rep_)
#endif
        for (int c = F.vcu; c < 64; c += F.G) {
            const bool smp = c >= 32; const int c2 = c & 31, bb = c2 >> 2;
            hgrn_chain(F, smp ? MP + 64 * bb : bb * TSEQ, smp ? MP / 64 + bb : bb * (TSEQ / 64), smp ? 1 : TSEQ / 64, c2 & 3, smp ? F.sh + (size_t)c2 * 16384 : nullptr, F.out + (smp ? O_HS : O_HP) + (size_t)c2 * 16384);
            __syncthreads();
        }
        STAMP(8);
#endif
#ifndef NO_ATTN
        float prune_thr;
        { float mq = fabsf(F.qg[F.lane]), mk = fabsf(F.kg[F.lane]);
#pragma unroll
          for (int o = 1; o < 64; o <<= 1) { mq = fmaxf(mq, __shfl_xor(mq, o)); mk = fmaxf(mk, __shfl_xor(mk, o)); }
          prune_thr = 2.f * (8.f * mq * mk * LOG2E) + 150.f; }
        for (;;) {
            if (F.tid == 0) F.MISC[0] = atomicAdd(F.ctl + CW_QUEUE, 1u);
            __syncthreads();
            const int i = (int)F.MISC[0];
            __syncthreads();
            if (i >= 2048 + 64) break;
            typedef attn_body::bf16 abf;
            const bool smp = i >= 2048; const int j = smp ? i - 2048 : i;
            const int bh = j & 63, qb = 31 - (j >> 6), b = bh >> 3, h = bh & 7;
            const int q0 = smp ? SSEQ - 256 : 256 * qb, NT = (q0 + 256) / 64; int NTE = NT;
            const size_t rb = (size_t)b * (smp ? SSEQ : TSEQ);
            const float* cgp = (const float*)(F.ws + (smp ? WS_CGS : WS_CGP)) + (size_t)bh * (smp ? SSEQ : TSEQ);
#if FOX_PRUNE
            { const bool need = F.tid < NT && (cgp[q0] - cgp[64 * F.tid + 63] >= -prune_thr); const int needed = __syncthreads_count(need ? 1 : 0);
              NTE = (needed + 1) & ~1; NTE = NTE < 4 ? 4 : (NTE > NT ? NT : NTE); }
#endif
            const size_t orow = smp ? (size_t)(MP + 64 * b) - (size_t)(PAST - q0) : rb + q0;
            attn_body::attn_unit<8>((const abf*)(F.ws + (smp ? WS_QS : WS_Q)) + (rb + q0) * 512 + 64 * h, (const abf*)(F.ws + (smp ? WS_KS : WS_K)) + rb * 512 + 64 * h, (const abf*)(F.ws + (smp ? WS_VS : WS_V)) + rb * 512 + 64 * h,
                                    (abf*)MIX + orow * DMOD + 512 + 64 * h, NT, NTE, cgp, q0, smp ? (PAST - q0) / 32 : 0, smp ? (PAST - q0) / 32 + 1 : 8, (char*)lds);
        }
#endif
    }
    SEAM(2); STAMP(3);
    if (IN(3)) {
        pg8::Gemm g{MIX, (const bf16*)(F.ws + WS_WO), MTOT, DMOD, DMOD}; pg8::StaticOrder S; S.init(MTOT, DMOD, F.G, (int)blockIdx.x);
        pg8::EpiWo E{F.xp, F.xs, F.out + O_YP, F.out + O_YS, X1B, (float*)(F.ws + WS_SSQ)};
        pg8::gemm_phase<pg8::EpiWo, pg8::StaticOrder, true, true>(F.lds, g, S, E);
    }
    SEAM(3); STAMP(4);
    if (IN(4)) {
        pg8::Gemm g{X1B, (const bf16*)(F.ws + WS_WUP), MTOT, FF, DMOD}; pg8::StaticOrder S; S.init(MTOT, FF, F.G, (int)blockIdx.x);
        pg8::EpiUp E{HB, (const float*)(F.ws + WS_SSQ)};
        pg8::gemm_phase<pg8::EpiUp, pg8::StaticOrder, true, true>(F.lds, g, S, E);
#if defined(DOUBLE_P4)
        cg::this_grid().sync();
        pg8::gemm_phase<pg8::EpiUp, pg8::StaticOrder, true, true>(F.lds, g, S, E);
#endif
    }
    SEAM(4); STAMP(5);
    if (IN(5)) {
        pg8::Gemm g{HB, (const bf16*)(F.ws + WS_WDN), MTOT, DMOD, FF}; pg8::StaticOrder S; S.init(MTOT, DMOD, F.G, (int)blockIdx.x);
        pg8::EpiDown E{F.out + O_YP, F.out + O_YS};
        pg8::gemm_phase<pg8::EpiDown, pg8::StaticOrder, true, true>(F.lds, g, S, E);
    }
    STAMP(6);
#if defined(PROBE_A)
    cg::this_grid().sync();
    if (stamper_) {
        unsigned long long da = ts_[PROBE_A + 1] - ts_[PROBE_A], db = ts_[PROBE_B + 1] - ts_[PROBE_B];
        unsigned qa = (unsigned)((da + 1250) / 2500), qb = (unsigned)((db + 1250) / 2500); if (qa > 63) qa = 63; if (qb > 63) qb = 63;
#if defined(PROBE_CAL)
        qa = 1000; qb = 0;
#endif
        const unsigned long long t0 = __builtin_amdgcn_s_memrealtime(), wait = 2000ull * (qa + 64 * qb);
        while (__builtin_amdgcn_s_memrealtime() - t0 < wait) __builtin_amdgcn_s_sleep(16);
    }
#endif
#undef IN
#undef SEAM
}

extern "C" void kernel_launch(void* const* d_in, const int* in_sizes, int n_in, void* d_out, int out_size, void* d_ws, size_t ws_size, hipStream_t stream) {
    static int grid = 0;
    if (grid == 0) {
        if (n_in != 17 || (size_t)out_size != O_END || ws_size < WS_END) { fprintf(stderr, "kernel_launch: unexpected shapes (n_in %d out %d ws %zu)\n", n_in, out_size, ws_size); grid = -1; return; }
        int dev = 0, cus = 0, per_cu = 0;
        if (hipGetDevice(&dev) != hipSuccess || hipDeviceGetAttribute(&cus, hipDeviceAttributeMultiprocessorCount, dev) != hipSuccess) { grid = -1; return; }
        if (hipFuncSetAttribute((const void*)skel_fwd, hipFuncAttributeMaxDynamicSharedMemorySize, LDS_BYTES) != hipSuccess) { fprintf(stderr, "kernel_launch: hipFuncSetAttribute failed\n"); grid = -1; return; }
        if (hipOccupancyMaxActiveBlocksPerMultiprocessor(&per_cu, (const void*)skel_fwd, NTHR, LDS_BYTES) != hipSuccess || per_cu < 1) { fprintf(stderr, "kernel_launch: occupancy query says %d\n", per_cu); per_cu = 1; }
        (void)hipGetLastError();
        grid = cus;
    }
    if (grid < 0) return;
    if (hipMemsetAsync((char*)d_ws + WS_CTL, 0, CTL_ZERO_BYTES, stream) != hipSuccess) { fprintf(stderr, "kernel_launch: memset failed\n"); return; }
    Args a{};
    for (int i = 0; i < 17; ++i) a.in[i] = (const float*)d_in[i];
    a.out = (float*)d_out; a.ws = (unsigned char*)d_ws;
#if MK_N_LAUNCHES == 1
    a.ph_lo = 0; a.ph_hi = 6;
    void* kargs[] = {&a};
    hipError_t e = hipLaunchCooperativeKernel((const void*)skel_fwd, dim3(grid), dim3(NTHR), kargs, LDS_BYTES, stream);
    if (e != hipSuccess) fprintf(stderr, "kernel_launch: cooperative launch failed: %s (grid %d)\n", hipGetErrorString(e), grid);
#else
    for (int li = 0; li < 6; ++li) { a.ph_lo = li; a.ph_hi = li + 1; hipLaunchKernelGGL(skel_fwd, dim3(grid), dim3(NTHR), LDS_BYTES, stream, a); }
#endif
}
```

```cpp
#include <hip/hip_runtime.h>
#include <cstdio>
#include <cstdint>
namespace pg8 {
#define PG8_LAS __attribute__((address_space(3)))
typedef unsigned short bf16_t;
typedef short bf16x8 __attribute__((ext_vector_type(8)));
typedef float f32x4 __attribute__((ext_vector_type(4)));
typedef unsigned u32x4 __attribute__((ext_vector_type(4)));
constexpr int BM = 256, BK = 64, HALF = 128, HTB = HALF * BK * 2  , STAGE_BYTES = 8 * HTB, NXCD = 8, WGM = 8;

__host__ __device__ __forceinline__ int lds_byte(int r, int c) { const int st = (r >> 4) * 2 + (c >> 5), rr = r & 15, cc = c & 31, ob = rr * 64 + cc * 2; return st * 1024 + (ob ^ (((ob >> 9) & 1) << 5)); }
__host__ __device__ __forceinline__ void stage_rc(int b, int& R, int& C) { const int st = b / 1024, sb = b % 1024, swz = sb ^ (((sb >> 9) & 1) << 5); R = (st >> 1) * 16 + swz / 64; C = (st & 1) * 32 + (swz % 64) / 2; }
__host__ __device__ __forceinline__ int perm32(int rho) { const int n = rho >> 4, i = rho & 15; return 8 * (i >> 2) + 4 * n + (i & 3); }

struct Unit { int pm, pn; };
struct Gemm { const bf16_t* A; const bf16_t* Bt; int M, N, K; };

struct StaticOrder {
    int nM, nN, nwg, G, c;
    __host__ __device__ void init(int M, int N, int G_, int c_) { nM = M / BM; nN = N / BM; nwg = nM * nN; G = G_; c = c_; }
    __host__ __device__ bool next(int i, Unit& u) const {
        const long L = (long)i * G + c; if (L >= nwg) return false;
        int wgid = (int)L; { const int q = nwg / NXCD, r = nwg % NXCD, xcd = wgid % NXCD, off = wgid / NXCD; wgid = (xcd < r ? xcd * (q + 1) : r * (q + 1) + (xcd - r) * q) + off; }
        const int nig = WGM * nN, gid = wgid / nig, fm = gid * WGM, gsz = (nM - fm) < WGM ? (nM - fm) : WGM;
        u.pm = fm + ((wgid % nig) % gsz); u.pn = (wgid % nig) / gsz; return true;
    }
    __device__ __forceinline__ void a_ready(const Unit&) const {}
    __device__ __forceinline__ void done(const Unit&) const {}
};

__device__ __forceinline__ unsigned cvt_pk_bf16(float lo, float hi) { unsigned r; asm volatile("v_cvt_pk_bf16_f32 %0, %1, %2" : "=v"(r) : "v"(lo), "v"(hi)); return r; }
typedef float f32x2 __attribute__((ext_vector_type(2)));
template <class Epi, class Sched, bool ALIGN_EPI = false, bool SP2 = false>
__device__ __forceinline__ void gemm_phase(PG8_LAS unsigned char* lds, const Gemm g, const Sched& S, const Epi& E) {
    const int tid = threadIdx.x, wid = __builtin_amdgcn_readfirstlane(tid >> 6), lane = tid & 63, wr = wid >> 2, wc = wid & 3, fr = lane & 15, fq = lane >> 4;
    const int K = g.K, nt = K / BK;
    unsigned voffA[2], voffB[2];
#pragma unroll
    for (int i = 0; i < 2; ++i) { int R, C; stage_rc(tid * 16 + i * 8192, R, C); const int Rb = Epi::PERM ? ((R & ~31) + perm32(R & 31)) : R;
        voffA[i] = (unsigned)(R * K + C) * 2u; voffB[i] = (unsigned)(Rb * K + C) * 2u; }
    const size_t kstep = (size_t)(BK * 2);
    const size_t hstep = (size_t)HALF * K * 2;
    const size_t tstep = 2 * hstep;
    const unsigned ldsw = (unsigned)wid * 1024u;
    const int aoff = lds_byte(wr * 64 + fr, fq * 8), boff = lds_byte(wc * 32 + fr, fq * 8);
#define PG8_SA(b, h) (((b) * 2 + (h)) * HTB)
#define PG8_SB(b, h) ((4 + (b) * 2 + (h)) * HTB)
#define PG8_STAGE(bufoff, gbase, voff) do { _Pragma("unroll") for (int _i = 0; _i < 2; ++_i) \
        __builtin_amdgcn_global_load_lds((const unsigned*)((const char*)(gbase) + (voff)[_i]), (PG8_LAS unsigned*)(lds + (bufoff) + ldsw + _i * 8192), 16, 0, 0); } while (0)
#define PG8_LDA(dst, b, h) do { _Pragma("unroll") for (int m = 0; m < 4; ++m) _Pragma("unroll") for (int k = 0; k < 2; ++k) dst[m][k] = *(const PG8_LAS bf16x8*)(lds + PG8_SA(b, h) + aoff + m * 2048 + k * 1024); } while (0)
#define PG8_LDB(dst, b, h) do { _Pragma("unroll") for (int n = 0; n < 2; ++n) _Pragma("unroll") for (int k = 0; k < 2; ++k) dst[n][k] = *(const PG8_LAS bf16x8*)(lds + PG8_SB(b, h) + boff + n * 2048 + k * 1024); } while (0)
#define PG8_MMA(ai, bj, At, Bt) do { __builtin_amdgcn_s_setprio(1); _Pragma("unroll") for (int m = 0; m < 4; ++m) _Pragma("unroll") for (int n = 0; n < 2; ++n) _Pragma("unroll") for (int k = 0; k < 2; ++k) \
        acc[ai][bj][m][n] = __builtin_amdgcn_mfma_f32_16x16x32_bf16(Bt[n][k], At[m][k], acc[ai][bj][m][n], 0, 0, 0); __builtin_amdgcn_s_setprio(0); } while (0)
#define PG8_WAIT_V(n) asm volatile("s_waitcnt vmcnt(" #n ")" ::: "memory")
#define PG8_WAIT_L(n) asm volatile("s_waitcnt lgkmcnt(" #n ")" ::: "memory")
#define PG8_BAR __builtin_amdgcn_s_barrier()
#define PG8_SCHED __builtin_amdgcn_sched_barrier(0)
    Unit cur, nxt; int ui = 0;
    if (!S.next(0, cur)) return;
    f32x4 acc[2][2][4][2];
#pragma unroll
    for (int a = 0; a < 2; ++a)
#pragma unroll
        for (int b = 0; b < 2; ++b)
#pragma unroll
            for (int m = 0; m < 4; ++m)
#pragma unroll
                for (int n = 0; n < 2; ++n) acc[a][b][m][n] = (f32x4){0.f, 0.f, 0.f, 0.f};
    bf16x8 At[4][2], B0[2][2], B1[2][2];
    const char* cA = (const char*)g.A + (size_t)cur.pm * tstep; const char* cB = (const char*)g.Bt + (size_t)cur.pn * tstep;
    S.a_ready(cur);
    if constexpr (SP2) {
        PG8_STAGE(PG8_SB(0, 0), cB, voffB); PG8_STAGE(PG8_SB(0, 1), cB + hstep, voffB); PG8_STAGE(PG8_SA(0, 0), cA, voffA); PG8_STAGE(PG8_SA(0, 1), cA + hstep, voffA);
        if (wr == 1) PG8_BAR;
        PG8_WAIT_V(2); PG8_BAR;
        PG8_STAGE(PG8_SB(1, 0), cB + kstep, voffB); PG8_STAGE(PG8_SA(1, 0), cA + kstep, voffA); PG8_STAGE(PG8_SB(1, 1), cB + hstep + kstep, voffB);
        PG8_WAIT_V(6); PG8_BAR;
    } else {
        PG8_STAGE(PG8_SB(0, 0), cB, voffB); PG8_STAGE(PG8_SA(0, 0), cA, voffA); PG8_STAGE(PG8_SB(0, 1), cB + hstep, voffB); PG8_STAGE(PG8_SA(0, 1), cA + hstep, voffA);
        if (wr == 1) PG8_BAR;
        PG8_WAIT_V(4); PG8_BAR;
        PG8_STAGE(PG8_SB(1, 0), cB + kstep, voffB); PG8_STAGE(PG8_SA(1, 0), cA + kstep, voffA); PG8_STAGE(PG8_SB(1, 1), cB + hstep + kstep, voffB);
        PG8_WAIT_V(6); PG8_BAR;
    }
    for (;;) {
        const bool has_next = S.next(ui + 1, nxt);
        const char* nA = has_next ? (const char*)g.A + (size_t)nxt.pm * tstep : cA; const char* nB = has_next ? (const char*)g.Bt + (size_t)nxt.pn * tstep : cB;
        for (int t = 0; t < nt; t += 2) {
            const bool last = (t == nt - 2);
            const char* a1 = cA + (size_t)(t + 1) * kstep;
            const char* a2 = last ? nA : cA + (size_t)(t + 2) * kstep; const char* b2 = last ? nB : cB + (size_t)(t + 2) * kstep;
            const char* a3 = a2 + kstep; const char* b3 = b2 + kstep;
            if (last && has_next) S.a_ready(nxt);
            if constexpr (SP2) {
            PG8_LDB(B0, 0, 0); PG8_LDB(B1, 0, 1); PG8_SCHED; PG8_LDA(At, 0, 0); PG8_STAGE(PG8_SA(1, 1), a1 + hstep, voffA);
            PG8_WAIT_V(8); PG8_WAIT_L(0); PG8_BAR; PG8_MMA(0, 0, At, B0); PG8_MMA(0, 1, At, B1); PG8_BAR; PG8_SCHED;
            PG8_LDA(At, 0, 1); PG8_STAGE(PG8_SB(0, 0), b2, voffB); PG8_STAGE(PG8_SB(0, 1), b2 + hstep, voffB); PG8_STAGE(PG8_SA(0, 0), a2, voffA);
            PG8_WAIT_V(8); PG8_WAIT_L(0); PG8_BAR; PG8_MMA(1, 0, At, B0); PG8_MMA(1, 1, At, B1); PG8_BAR; PG8_SCHED;
            PG8_LDB(B0, 1, 0); PG8_LDB(B1, 1, 1); PG8_SCHED; PG8_LDA(At, 1, 0); PG8_STAGE(PG8_SA(0, 1), a2 + hstep, voffA);
            PG8_WAIT_V(8); PG8_WAIT_L(0); PG8_BAR; PG8_MMA(0, 0, At, B0); PG8_MMA(0, 1, At, B1); PG8_BAR; PG8_SCHED;
            PG8_LDA(At, 1, 1); PG8_STAGE(PG8_SB(1, 0), b3, voffB); PG8_STAGE(PG8_SB(1, 1), b3 + hstep, voffB); PG8_STAGE(PG8_SA(1, 0), a3, voffA);
            PG8_WAIT_V(8); PG8_WAIT_L(0); PG8_BAR; PG8_MMA(1, 0, At, B0); PG8_MMA(1, 1, At, B1); PG8_BAR; PG8_SCHED;
            } else {
            PG8_LDB(B0, 0, 0); PG8_SCHED; PG8_LDA(At, 0, 0); PG8_STAGE(PG8_SA(1, 1), a1 + hstep, voffA);
            PG8_WAIT_L(8); PG8_BAR; PG8_WAIT_L(0); PG8_MMA(0, 0, At, B0); PG8_BAR; PG8_SCHED;
            PG8_LDB(B1, 0, 1); PG8_STAGE(PG8_SB(0, 0), b2, voffB);
            PG8_BAR; PG8_WAIT_L(0); PG8_MMA(0, 1, At, B1); PG8_BAR;
            PG8_LDA(At, 0, 1); PG8_STAGE(PG8_SA(0, 0), a2, voffA);
            PG8_BAR; PG8_WAIT_L(0); PG8_MMA(1, 0, At, B0); PG8_BAR; PG8_SCHED;
            PG8_STAGE(PG8_SB(0, 1), b2 + hstep, voffB);
            PG8_WAIT_V(6); PG8_BAR; PG8_MMA(1, 1, At, B1); PG8_BAR;
            PG8_LDB(B0, 1, 0); PG8_SCHED; PG8_LDA(At, 1, 0); PG8_STAGE(PG8_SA(0, 1), a2 + hstep, voffA);
            PG8_WAIT_L(8); PG8_BAR; PG8_WAIT_L(0); PG8_MMA(0, 0, At, B0); PG8_BAR; PG8_SCHED;
            PG8_LDB(B1, 1, 1); PG8_STAGE(PG8_SB(1, 0), b3, voffB);
            PG8_BAR; PG8_WAIT_L(0); PG8_MMA(0, 1, At, B1); PG8_BAR;
            PG8_LDA(At, 1, 1); PG8_STAGE(PG8_SA(1, 0), a3, voffA);
            PG8_BAR; PG8_WAIT_L(0); PG8_MMA(1, 0, At, B0); PG8_BAR; PG8_SCHED;
            PG8_STAGE(PG8_SB(1, 1), b3 + hstep, voffB);
            PG8_WAIT_V(6); PG8_BAR; PG8_MMA(1, 1, At, B1); PG8_BAR;
            }
        }
        if constexpr (ALIGN_EPI) { if (wr == 0) PG8_BAR; }
        if constexpr (!Epi::AFTER_DRAIN) { E(acc, cur, wr, wc, fr, fq); S.done(cur); }
        if (!has_next) break;
#pragma unroll
        for (int a = 0; a < 2; ++a)
#pragma unroll
            for (int b = 0; b < 2; ++b)
#pragma unroll
                for (int m = 0; m < 4; ++m)
#pragma unroll
                    for (int n = 0; n < 2; ++n) acc[a][b][m][n] = (f32x4){0.f, 0.f, 0.f, 0.f};
        cur = nxt; cA = nA; cB = nB; ++ui;
        if constexpr (ALIGN_EPI) { if (wr == 1) PG8_BAR; }
    }
    PG8_WAIT_V(0);
    if constexpr (!ALIGN_EPI) { if (wr == 0) PG8_BAR; }
    PG8_BAR;
    if constexpr (Epi::AFTER_DRAIN) { E.fused(acc, cur, wr, wc, fr, fq, lds, wid, lane); S.done(cur); }
#undef PG8_SA
#undef PG8_SB
#undef PG8_STAGE
#undef PG8_LDA
#undef PG8_LDB
#undef PG8_MMA
#undef PG8_WAIT_V
#undef PG8_WAIT_L
#undef PG8_BAR
#undef PG8_SCHED
}
}
#include <hip/hip_bf16.h>
#include <cmath>
namespace attn_body {
using bf16=__hip_bfloat16;
using bf16x8=__attribute__((ext_vector_type(8)))short;
using s16x4=__attribute__((ext_vector_type(4)))short;
using f32x16=__attribute__((ext_vector_type(16)))float;
using u32x4=__attribute__((ext_vector_type(4)))unsigned;
constexpr int NHEAD=8,D=64,DM=NHEAD*D,OPITCH=1024;
constexpr int NW=8,QBLK=32,QB=QBLK*NW,KVBLK=64;
constexpr int ATTN_PITCH=DM, ATTN_UNIT_ROWS=QB;
__device__ __forceinline__ int crow(int r,int hi){return (r&3)+8*(r>>2)+4*hi;}
#define SBAR() __builtin_amdgcn_sched_barrier(0)
__device__ __forceinline__ void cmask(f32x16&p0,f32x16&p1,int jb,int qrel,int hi){
  const float NEG=-INFINITY; int kb=64*jb+4*hi;
  #pragma unroll
  for(int r=0;r<16;++r){int kv=kb+(r&3)+8*(r>>2); if(kv>qrel)p0[r]=NEG; if(kv+32>qrel)p1[r]=NEG;}
}

constexpr int NSLOT=3, SLOTB=8192;
constexpr int LDS_K=0, LDS_V=NSLOT*SLOTB, LDS_WS=2*NSLOT*SLOTB, LDS_OST=LDS_WS+NW*64*4, LDS_CB=LDS_OST+NW*4096, LDS_BYTES=LDS_CB+32768;
constexpr float C2=0.125f*1.4426950408889634f;
__device__ __forceinline__ void glds16(const void*gsrc,unsigned lds_dst){unsigned keep;
  asm volatile("s_mov_b32 %0, m0\n\ts_mov_b32 m0, %2\n\ts_nop 0\n\tglobal_load_lds_dwordx4 %1, off\n\ts_mov_b32 m0, %0":"=&s"(keep):"v"(gsrc),"s"(lds_dst):"memory");}
__device__ __forceinline__ float max3f(float a,float b,float c){float r;asm("v_max3_f32 %0, %1, %2, %3":"=v"(r):"v"(a),"v"(b),"v"(c));return r;}
__device__ __forceinline__ float max2f(float a,float b){float r;asm("v_max_f32_e32 %0, %1, %2":"=v"(r):"v"(a),"v"(b));return r;}
__device__ __forceinline__ float fadd_s(float a,float b){float r;asm("v_add_f32_e32 %0, %1, %2":"=v"(r):"v"(a),"v"(b));return r;}
__device__ __forceinline__ float fsub_s(float a,float b){float r;asm("v_sub_f32_e32 %0, %1, %2":"=v"(r):"v"(a),"v"(b));return r;}
typedef float f32x2_t __attribute__((ext_vector_type(2))); typedef float f32x4_t __attribute__((ext_vector_type(4))); typedef __bf16 bf16x2_t __attribute__((ext_vector_type(2)));
__device__ __forceinline__ unsigned cvtpk_s(float lo,float hi){f32x2_t v={lo,hi};bf16x2_t b=__builtin_convertvector(v,bf16x2_t);return __builtin_bit_cast(unsigned,b);}
#define WAIT_BAR(N) asm volatile("s_waitcnt vmcnt(" #N ") lgkmcnt(0)\n\ts_barrier":::"memory")

__device__ __forceinline__ void qkt(f32x16&p0,f32x16&p1,const char*Kslot,const bf16x8*qr,int r32,int hi){
  const char*kb=Kslot+hi*1024+r32*16;
  #pragma unroll
  for(int d0=0;d0<4;++d0){
    const bf16x8 b0=*reinterpret_cast<const bf16x8*>(kb+d0*2048);
    const bf16x8 b1=*reinterpret_cast<const bf16x8*>(kb+d0*2048+512);
    p0=__builtin_amdgcn_mfma_f32_32x32x16_bf16(b0,qr[d0],p0,0,0,0);p1=__builtin_amdgcn_mfma_f32_32x32x16_bf16(b1,qr[d0],p1,0,0,0);}
}
typedef __attribute__((address_space(3))) const char* lds_cptr;
typedef short v4i16_t __attribute__((ext_vector_type(4)));
__device__ __forceinline__ void kload8(bf16x8*kf,lds_cptr kp){
  kf[0]=*(const __attribute__((address_space(3))) bf16x8*)(kp);      kf[1]=*(const __attribute__((address_space(3))) bf16x8*)(kp+512);
  kf[2]=*(const __attribute__((address_space(3))) bf16x8*)(kp+2048); kf[3]=*(const __attribute__((address_space(3))) bf16x8*)(kp+2560);
  kf[4]=*(const __attribute__((address_space(3))) bf16x8*)(kp+4096); kf[5]=*(const __attribute__((address_space(3))) bf16x8*)(kp+4608);
  kf[6]=*(const __attribute__((address_space(3))) bf16x8*)(kp+6144); kf[7]=*(const __attribute__((address_space(3))) bf16x8*)(kp+6656);
}
__device__ __forceinline__ void kload2(bf16x8*kf,lds_cptr kp,int j){ kf[2*j]=*(const __attribute__((address_space(3))) bf16x8*)(kp+j*2048); kf[2*j+1]=*(const __attribute__((address_space(3))) bf16x8*)(kp+j*2048+512); }
__device__ __forceinline__ s16x4 vtr(lds_cptr p){ return __builtin_bit_cast(s16x4,__builtin_amdgcn_ds_read_tr16_b64_v4i16((__attribute__((address_space(3))) v4i16_t*)p)); }
__device__ __forceinline__ float rowmax(const f32x16&p0,const f32x16&p1){
  float a=max3f(p0[0],p0[1],p1[0]),b=max3f(p0[2],p0[3],p1[1]);a=max3f(a,p1[2],p1[3]);
  #pragma unroll
  for(int r=4;r<16;r+=4){a=max3f(a,p0[r],p0[r+1]);b=max3f(b,p0[r+2],p0[r+3]);a=max3f(a,p1[r],p1[r+1]);b=max3f(b,p1[r+2],p1[r+3]);}
  const float m=max2f(a,b);
  auto rr=__builtin_amdgcn_permlane32_swap(__float_as_uint(m),__float_as_uint(m),false,false);
  return max2f(__uint_as_float(rr[0]),__uint_as_float(rr[1]));
}
__device__ __forceinline__ void pv(f32x16*o,int vb,bf16x8 pa0,bf16x8 pa1,bf16x8 pa2,bf16x8 pa3){
  #pragma unroll
  for(int d0=0;d0<2;++d0){s16x4 lo[4],hi[4];
    #pragma unroll
    for(int ks=0;ks<4;++ks){
      asm volatile("ds_read_b64_tr_b16 %0,%1 offset:%c2":"=&v"(lo[ks]):"v"(vb),"i"(d0*4096+ks*1024):"memory");
      asm volatile("ds_read_b64_tr_b16 %0,%1 offset:%c2":"=&v"(hi[ks]):"v"(vb),"i"(d0*4096+ks*1024+512):"memory");}
    asm volatile("s_waitcnt lgkmcnt(0)":::"memory");SBAR();
    #define PK(k) (bf16x8){lo[k][0],lo[k][1],lo[k][2],lo[k][3],hi[k][0],hi[k][1],hi[k][2],hi[k][3]}
    o[d0]=__builtin_amdgcn_mfma_f32_32x32x16_bf16(pa0,PK(0),o[d0],0,0,0);
    o[d0]=__builtin_amdgcn_mfma_f32_32x32x16_bf16(pa1,PK(1),o[d0],0,0,0);
    o[d0]=__builtin_amdgcn_mfma_f32_32x32x16_bf16(pa2,PK(2),o[d0],0,0,0);
    o[d0]=__builtin_amdgcn_mfma_f32_32x32x16_bf16(pa3,PK(3),o[d0],0,0,0);
    #undef PK
  }
}

#ifndef ATTN_STORE16
#define ATTN_STORE16(p,v) (*(u32x4*)(p)=(v))
#endif
template<int THRL> __device__ __forceinline__ void attn_unit(const bf16*Qb,const bf16*__restrict__ Kh,const bf16*__restrict__ Vh,bf16*Ob,int NT,int NTE,const float*cgp,int q0,int wlo,int whi,char*shm){
  int tid_=threadIdx.x; asm volatile("":"+v"(tid_)); const int tid=tid_,lane=tid&63,r32=lane&31,hi=lane>>5; const int wid=__builtin_amdgcn_readfirstlane(tid>>6);
  const bf16*Qw=Qb+(long)(wid*QBLK)*DM;
  const unsigned lds0=(unsigned)(uintptr_t)shm;
  float*wsf=(float*)(shm+LDS_WS)+wid*64;
  const bf16*ksrc=Kh+(long)((NT-1)*KVBLK+lane)*DM+wid*8;
  const bf16*vsrc=Vh+(long)((NT-1)*KVBLK+16*(wid&3)+(lane>>2))*DM+(wid>>2)*32+(lane&3)*8;
  const unsigned kdst=lds0+LDS_K+wid*1024, vdst=lds0+LDS_V+wid*1024;
  #define DMA_K(t,slot) glds16(ksrc-(long)(t)*KVBLK*DM,(unsigned)__builtin_amdgcn_readfirstlane(kdst+(slot)))
  #define DMA_V(t,slot) glds16(vsrc-(long)(t)*KVBLK*DM,(unsigned)__builtin_amdgcn_readfirstlane(vdst+(slot)))
  const int vb0=(int)(lds0+LDS_V)+((lane>>4)&1)*32+(lane&3)*8+(4*hi+((lane&15)>>2))*64;
  const char*Kbase=shm+LDS_K; bf16x8 kf[8];
  const lds_cptr shm3=(lds_cptr)shm; const lds_cptr kp0=shm3+LDS_K+hi*1024+r32*16; const lds_cptr vp0=shm3+LDS_V+((lane>>4)&1)*32+(lane&3)*8+(4*hi+((lane&15)>>2))*64;
  { typedef __attribute__((address_space(3))) float lf_t; lf_t* cbw=(lf_t*)((lds_cptr)shm+LDS_CB); const float c0=cgp[q0]; const int jlo=(NT-NTE)*KVBLK, jhi=NT*KVBLK;
    for(int j=jlo+tid;j<jhi;j+=NW*64) cbw[j]=c0-cgp[j]; }
  const __attribute__((address_space(3))) float* cbL=(const __attribute__((address_space(3))) float*)((lds_cptr)shm+LDS_CB)+4*hi;
  #define CBLOAD(C0,C1,t,MH) do{ const __attribute__((address_space(3))) float* cbp_=cbL+(NT-1-(t))*KVBLK; \
    _Pragma("unroll") for(int g_=0;g_<4;++g_){ const f32x4_t v0_=*(const __attribute__((address_space(3))) f32x4_t*)(cbp_+8*g_); const f32x4_t v1_=*(const __attribute__((address_space(3))) f32x4_t*)(cbp_+32+8*g_); \
      C0[4*g_]=v0_[0]-(MH);C0[4*g_+1]=v0_[1]-(MH);C0[4*g_+2]=v0_[2]-(MH);C0[4*g_+3]=v0_[3]-(MH); C1[4*g_]=v1_[0]-(MH);C1[4*g_+1]=v1_[1]-(MH);C1[4*g_+2]=v1_[2]-(MH);C1[4*g_+3]=v1_[3]-(MH);} }while(0)
  DMA_K(0,0);DMA_V(0,0);DMA_K(1,SLOTB);
  bf16x8 qr[4];
  #pragma unroll
  for(int d0=0;d0<4;++d0)qr[d0]=*reinterpret_cast<const bf16x8*>(&Qw[(long)r32*DM+d0*16+hi*8]);
  float mhat=0.f,l_reg=0.f;f32x16 o[2];o[0]=f32x16{};o[1]=f32x16{};
  const int qrel=wid*QBLK+r32;
  #define CMASK(P0,P1,t) do{int jb_=3-(t); if(jb_>=0)cmask(P0,P1,jb_,qrel,hi);}while(0)
  bool resc=false;
  #define START(P0,P1) do{ const float rm=rowmax(P0,P1); resc=false; \
    { const float dl=(rm>-1e30f)?rm:0.f; mhat=fadd_s(mhat,dl); \
      _Pragma("unroll") for(int r=0;r<16;++r){P0[r]=fsub_s(P0[r],dl);P1[r]=fsub_s(P1[r],dl);} } \
    _Pragma("unroll") for(int r=0;r<16;++r)P0[r]=__builtin_amdgcn_exp2f(P0[r]); }while(0)
  #define RESC() do{ if(resc){ asm volatile("s_waitcnt lgkmcnt(0)":::"memory"); \
      _Pragma("unroll") for(int d_=0;d_<2;++d_) _Pragma("unroll") for(int r=0;r<16;++r)o[d_][r]*=wsf[crow(r,hi)]; } }while(0)
  f32x16 pA0,pA1,pB0,pB1;
  int sl_prev=0,sl_cur=0,sl_next=SLOTB;
  #define ROT() do{sl_prev=sl_cur;sl_cur=sl_next;sl_next=(sl_next==(NSLOT-1)*SLOTB)?0:sl_next+SLOTB;}while(0)
  DMA_K(2,2*SLOTB);
  WAIT_BAR(3);
  CBLOAD(pA0,pA1,0,0.f); qkt(pA0,pA1,Kbase,qr,r32,hi);asm volatile("s_nop 15\n\ts_nop 7":"+v"(pA0),"+v"(pA1));CMASK(pA0,pA1,0);
  START(pA0,pA1);
  _Pragma("unroll") for(int r=0;r<16;++r)pA1[r]=__builtin_amdgcn_exp2f(pA1[r]);
  WAIT_BAR(0);
  DMA_K(3,0);DMA_V(1,SLOTB);
  ROT();
  kload8(kf,kp0+sl_cur);
  WAIT_BAR(2);
  s16x4 vlo[8],vhi[8]; u32x4 pw0,pw1,pw2,pw3;
  #define PKW(P,B) cvtpk_s(P[B],P[B+1])
  #define PAF(k) __builtin_bit_cast(bf16x8,pw##k)
  #define VFR(i) (bf16x8){vlo[i][0],vlo[i][1],vlo[i][2],vlo[i][3],vhi[i][0],vhi[i][1],vhi[i][2],vhi[i][3]}
  #define PIN(x) asm volatile("":"+v"(x))
  #define MX3(a,b,c) __builtin_fmaxf(__builtin_fmaxf((a),(b)),(c))
  #define GAPA(MF,A0,A1,A2,A3,W0,W1,PW) do{ MF; sacc+=A0; sacc+=A1; sacc+=A2; sacc+=A3; PIN(sacc); W0; W1; PIN(PW); SBAR(); }while(0)
  #define EX(v) __builtin_amdgcn_exp2f(v)
  #define GAPB(MF,X,B) do{ MF; X[B]=EX(X[B]); X[B+1]=EX(X[B+1]); X[B+2]=EX(X[B+2]); X[B+3]=EX(X[B+3]); PIN(X); SBAR(); }while(0)
  #define VRD(i) do{ vlo[i]=vtr(vp_+(((i)>>2)*4096+((i)&3)*1024)); vhi[i]=vtr(vp_+(((i)>>2)*4096+((i)&3)*1024+512)); }while(0)
  #define KRD(G,j) do{ if(G){ kload2(kf,kp0+sl_next,j); SBAR(); } }while(0)
  #define STEP(C0,C1,P0,P1,t,GK,GV,GL) do{ SBAR(); \
    const lds_cptr vp_=vp0+sl_prev; CBLOAD(C0,C1,t,mhat); SBAR(); \
    VRD(0); SBAR(); float sacc=(P0[0]+P0[1]); \
    GAPA(C0=__builtin_amdgcn_mfma_f32_32x32x16_bf16(kf[0],qr[0],C0,0,0,0), P0[2],P0[3],P0[4],P0[5],     pw0[0]=PKW(P0,0), pw0[1]=PKW(P0,2), pw0); \
    VRD(4); SBAR(); GAPA(C1=__builtin_amdgcn_mfma_f32_32x32x16_bf16(kf[1],qr[0],C1,0,0,0), P0[6],P0[7],P0[8],P0[9],     pw0[2]=PKW(P0,4), pw0[3]=PKW(P0,6), pw0); \
    VRD(1); SBAR(); GAPA(C0=__builtin_amdgcn_mfma_f32_32x32x16_bf16(kf[2],qr[1],C0,0,0,0),   P0[10],P0[11],P0[12],P0[13], pw1[0]=PKW(P0,8), pw1[1]=PKW(P0,10), pw1); \
    VRD(5); SBAR(); GAPA(C1=__builtin_amdgcn_mfma_f32_32x32x16_bf16(kf[3],qr[1],C1,0,0,0),   P0[14],P0[15],P1[0],P1[1],   pw1[2]=PKW(P0,12),pw1[3]=PKW(P0,14), pw1); \
    VRD(2); SBAR(); GAPA(C0=__builtin_amdgcn_mfma_f32_32x32x16_bf16(kf[4],qr[2],C0,0,0,0),   P1[2],P1[3],P1[4],P1[5],     pw2[0]=PKW(P1,0), pw2[1]=PKW(P1,2), pw2); \
    VRD(6); SBAR(); GAPA(C1=__builtin_amdgcn_mfma_f32_32x32x16_bf16(kf[5],qr[2],C1,0,0,0),   P1[6],P1[7],P1[8],P1[9],     pw2[2]=PKW(P1,4), pw2[3]=PKW(P1,6), pw2); \
    VRD(3); SBAR(); GAPA(C0=__builtin_amdgcn_mfma_f32_32x32x16_bf16(kf[6],qr[3],C0,0,0,0),   P1[10],P1[11],P1[12],P1[13], pw3[0]=PKW(P1,8), pw3[1]=PKW(P1,10), pw3); \
    VRD(7); SBAR(); GAPA(C1=__builtin_amdgcn_mfma_f32_32x32x16_bf16(kf[7],qr[3],C1,0,0,0),   P1[14],P1[15],0.f,0.f,       pw3[2]=PKW(P1,12),pw3[3]=PKW(P1,14), pw3); \
    l_reg+=sacc; \
    if(GK){DMA_K((t)+3,sl_cur);} if(GV){DMA_V((t)+1,sl_next);} \
    CMASK(C0,C1,t); \
    { float a=MX3(C0[0],C0[1],C1[0]),b=MX3(C0[2],C0[3],C1[1]); a=MX3(a,C1[2],C1[3]); \
      _Pragma("unroll") for(int r=4;r<16;r+=4){a=MX3(a,C0[r],C0[r+1]);b=MX3(b,C0[r+2],C0[r+3]);a=MX3(a,C1[r],C1[r+1]);b=MX3(b,C1[r+2],C1[r+3]);} \
      float rm=__builtin_fmaxf(a,b); { auto rr=__builtin_amdgcn_permlane32_swap(__float_as_uint(rm),__float_as_uint(rm),false,false); rm=__builtin_fmaxf(__uint_as_float(rr[0]),__uint_as_float(rr[1])); } \
      resc=false; \
      if(__builtin_expect(__any(rm>(float)THRL),0)){ const float dl=__builtin_fmaxf(rm,0.f); mhat+=dl; \
        _Pragma("unroll") for(int r=0;r<16;++r){C0[r]-=dl;C1[r]-=dl;} \
        const float f=__builtin_amdgcn_exp2f(-dl); l_reg*=f; if(hi==0)wsf[r32]=f; resc=true; } } \
    SBAR(); \
    GAPB(o[0]=__builtin_amdgcn_mfma_f32_32x32x16_bf16(PAF(0),VFR(0),o[0],0,0,0), C0,0); \
    GAPB(o[1]=__builtin_amdgcn_mfma_f32_32x32x16_bf16(PAF(0),VFR(4),o[1],0,0,0), C0,4); \
    KRD(GL,0); GAPB(o[0]=__builtin_amdgcn_mfma_f32_32x32x16_bf16(PAF(1),VFR(1),o[0],0,0,0), C0,8); \
    KRD(GL,1); GAPB(o[1]=__builtin_amdgcn_mfma_f32_32x32x16_bf16(PAF(1),VFR(5),o[1],0,0,0), C0,12); \
    KRD(GL,2); GAPB(o[0]=__builtin_amdgcn_mfma_f32_32x32x16_bf16(PAF(2),VFR(2),o[0],0,0,0), C1,0); \
    KRD(GL,3); GAPB(o[1]=__builtin_amdgcn_mfma_f32_32x32x16_bf16(PAF(2),VFR(6),o[1],0,0,0), C1,4); \
    GAPB(o[0]=__builtin_amdgcn_mfma_f32_32x32x16_bf16(PAF(3),VFR(3),o[0],0,0,0), C1,8); \
    GAPB(o[1]=__builtin_amdgcn_mfma_f32_32x32x16_bf16(PAF(3),VFR(7),o[1],0,0,0), C1,12); \
    }while(0)
  int t=1;
  for(;t<5&&t+5<NTE;t+=2){
    STEP(pB0,pB1,pA0,pA1,t,true,true,true);     WAIT_BAR(2); RESC(); ROT();
    STEP(pA0,pA1,pB0,pB1,t+1,true,true,true);   WAIT_BAR(2); RESC(); ROT();
  }
  #undef CMASK
  #define CMASK(P0,P1,t) do{}while(0)
  for(;t+5<NTE;t+=2){
    STEP(pB0,pB1,pA0,pA1,t,true,true,true);     WAIT_BAR(2); RESC(); ROT();
    STEP(pA0,pA1,pB0,pB1,t+1,true,true,true);   WAIT_BAR(2); RESC(); ROT();
  }
  #undef CMASK
  #define CMASK(P0,P1,t) do{int jb_=3-(t); if(jb_>=0)cmask(P0,P1,jb_,qrel,hi);}while(0)
  #define ENDW(tt) do{ if((tt)+3<NTE){WAIT_BAR(2);} else if((tt)+2<NTE){WAIT_BAR(1);} else {WAIT_BAR(0);} }while(0)
  for(;t+1<NTE;t+=2){
    STEP(pB0,pB1,pA0,pA1,t,(t+3<NTE),(t+1<NTE),(t+1<NTE));       ENDW(t);   RESC(); ROT();
    STEP(pA0,pA1,pB0,pB1,t+1,(t+4<NTE),(t+2<NTE),(t+2<NTE));     ENDW(t+1); RESC(); ROT();
  }
  STEP(pB0,pB1,pA0,pA1,NTE-1,false,false,false); RESC();
  { float sacc=pB0[0]+pB0[1]; _Pragma("unroll") for(int r=2;r<16;++r)sacc+=pB0[r]; _Pragma("unroll") for(int r=0;r<16;++r)sacc+=pB1[r]; l_reg+=sacc;
    pw0=(u32x4){PKW(pB0,0),PKW(pB0,2),PKW(pB0,4),PKW(pB0,6)};pw1=(u32x4){PKW(pB0,8),PKW(pB0,10),PKW(pB0,12),PKW(pB0,14)};pw2=(u32x4){PKW(pB1,0),PKW(pB1,2),PKW(pB1,4),PKW(pB1,6)};pw3=(u32x4){PKW(pB1,8),PKW(pB1,10),PKW(pB1,12),PKW(pB1,14)};
    SBAR(); pv(o,vb0+sl_cur,PAF(0),PAF(1),PAF(2),PAF(3)); }
  #undef PKW
  #undef PAF
  #undef VFR
  #undef PIN
  #undef MX3
  #undef GAPA
  #undef GAPB
  #undef EX
  #undef VRD
  #undef KRD
  #undef STEP
  #undef ENDW
  {auto rr=__builtin_amdgcn_permlane32_swap(__float_as_uint(l_reg),__float_as_uint(l_reg),false,false);l_reg=__uint_as_float(rr[0])+__uint_as_float(rr[1]);}
  if(hi==0)wsf[32+r32]=l_reg;asm volatile("s_waitcnt lgkmcnt(0)":::"memory");
  float rli[16];
  #pragma unroll
  for(int r=0;r<16;++r)rli[r]=__builtin_amdgcn_rcpf(wsf[32+crow(r,hi)]);
  bf16*Ow=Ob+(long)(wid*QBLK)*OPITCH;
  { bf16*stg=(bf16*)(shm+LDS_OST)+wid*2048;
    #pragma unroll
    for(int r=0;r<16;++r){const int orow=crow(r,hi);
      #pragma unroll
      for(int d0=0;d0<2;++d0)stg[orow*64+d0*32+r32]=__float2bfloat16(o[d0][r]*rli[r]);}
    asm volatile("s_waitcnt lgkmcnt(0)":::"memory");
    #pragma unroll
    for(int i=0;i<4;++i){const int row=i*8+(lane>>3),ch=lane&7; const u32x4 v=*(const u32x4*)(stg+row*64+ch*8); if(wid>=wlo&&wid<whi)ATTN_STORE16(Ow+(long)row*OPITCH+ch*8,v);} }
  asm volatile("s_waitcnt lgkmcnt(0)\n\ts_barrier":::"memory");
  #undef DMA_K
  #undef DMA_V
  #undef CMASK
  #undef START
  #undef RESC
  #undef ROT
  #undef CBLOAD
}
constexpr int ATTN_LDS_BYTES=LDS_BYTES;
#undef SBAR
#undef WAIT_BAR
}
#include <hip/hip_cooperative_groups.h>
namespace cg = cooperative_groups;
#ifndef MK_N_LAUNCHES
#define MK_N_LAUNCHES 1
#endif
#ifndef FOX_PRUNE
#define FOX_PRUNE 1
#endif
constexpr int NWAVES = 8, NTHR = 512;
constexpr int DMOD = 1024, TSEQ = 8192, NBATCH = 8, MP = NBATCH * TSEQ, MS = 512, MTOT = MP + MS;
constexpr int NIN = 3584, INC = 3592, FF = 4096, SSEQ = 1152, PAST = 1024, DSEQ = 32;
constexpr int NCHUNK = MTOT / 64;
constexpr float EPSN = 1e-6f, LOG2E = 1.4426950408889634f;
constexpr size_t MiB = 1u << 20;
constexpr size_t WS_CTL = 0, CTL_ZERO_BYTES = 4096;
constexpr size_t WS_WIN = 2 * MiB, WS_WO = 9 * MiB, WS_WUP = 11 * MiB, WS_WDN = 19 * MiB;
constexpr size_t WS_RSTD = 27 * MiB, WS_CGP = 28 * MiB, WS_CGS = 30 * MiB, WS_VEC = 31 * MiB, WS_SSQ = 38 * MiB;
constexpr size_t WS_X1B = 44 * MiB, WS_MIX = 174 * MiB, WS_H = 304 * MiB;
constexpr size_t WS_XB = 304 * MiB, WS_Q = 434 * MiB, WS_K = 498 * MiB, WS_V = 562 * MiB, WS_QS = 626 * MiB, WS_KS = 635 * MiB, WS_VS = 644 * MiB;
constexpr size_t WS_QR = 654 * MiB, WS_KR = 719 * MiB, WS_VH = 784 * MiB, WS_SG = 849 * MiB, WS_END = 914 * MiB;
constexpr size_t VECN = (size_t)NCHUNK * 512;
static_assert(WS_VEC + 3 * VECN * 4 <= WS_SSQ && WS_SSQ + (size_t)MTOT * 16 * 4 <= WS_X1B && WS_X1B + (size_t)MTOT * DMOD * 2 <= WS_MIX && WS_MIX + (size_t)MTOT * DMOD * 2 <= WS_H, "ws map");
static_assert(WS_H + (size_t)MTOT * FF * 2 <= WS_END && WS_XB + (size_t)MTOT * DMOD * 2 <= WS_Q && WS_SG + (size_t)MTOT * 512 * 2 <= WS_END, "ws map 2");
constexpr int CW_QUEUE = 64, CW_SUB = 128, NCHAINWG = 32;
constexpr size_t O_YP = 0, O_YS = O_YP + (size_t)MP * DMOD, O_KP = O_YS + (size_t)256 * DMOD, O_VP = O_KP + (size_t)MP * 512, O_LP = O_VP + (size_t)MP * 512,
                 O_HP = O_LP + (size_t)MP * 8, O_KS = O_HP + 524288, O_VS = O_KS + 131072, O_LS = O_VS + 131072, O_HS = O_LS + 2048, O_END = O_HS + 524288;
constexpr int RING_BYTES = 131072, MISC_OFF = RING_BYTES, LDS_BYTES = 135168;
static_assert(attn_body::ATTN_LDS_BYTES <= RING_BYTES, "attention LDS");

#define LAS __attribute__((address_space(3)))
typedef unsigned short bf16;
typedef unsigned v4u __attribute__((ext_vector_type(4)));
typedef unsigned v2u __attribute__((ext_vector_type(2)));
typedef float f32x4 __attribute__((ext_vector_type(4)));
typedef short bf16x8 __attribute__((ext_vector_type(8)));
#define LDS_WAIT() asm volatile("s_waitcnt lgkmcnt(0)" ::: "memory")
__device__ __forceinline__ unsigned pk2(float lo, float hi) { return pg8::cvt_pk_bf16(lo, hi); }
__device__ __forceinline__ float bf2f(unsigned short b) { return __uint_as_float(((unsigned)b) << 16); }
__device__ __forceinline__ float wave_sum(float v) {
#pragma unroll
    for (int o = 1; o < 64; o <<= 1) v += __shfl_xor(v, o);
    return v;
}
__device__ __forceinline__ bool row_map(int row, int& idx) { if (row < MP) { idx = row; return true; } const int rs = row - MP; idx = (rs >> 6) * 32 + (rs & 63); return (rs & 63) < 32; }

namespace pg8 {
struct OrderIn {
    StaticOrder so; int pn_off, extra, extra_pm0;
    __device__ bool next(int i, Unit& u) const {
        const long L = (long)i * so.G + so.c;
        if (L < so.nwg) { so.next(i, u); u.pn += pn_off; return true; }
        const long e = L - so.nwg; if (e >= extra) return false;
        u.pm = extra_pm0 + (int)(e >> 3); u.pn = (int)(e & 7); return true;
    }
    __device__ __forceinline__ void a_ready(const Unit&) const {}
    __device__ __forceinline__ void done(const Unit&) const {}
};
#define DPP_SHR(v, n) __int_as_float(__builtin_amdgcn_update_dpp(0, __float_as_int(v), 0x110 + (n), 0xf, 0xf, false))
struct EpiIn {
    static constexpr bool PERM = false, AFTER_DRAIN = false;
    const float* rstd1; const float* lbl; const float* qg; const float* kg; unsigned char* ws; float* out;
    __device__ __forceinline__ void operator()(const f32x4 (&acc)[2][2][4][2], const Unit& u, int wr, int wc, int fr, int fq) const {
        const int pn = u.pn, rowb = u.pm * BM + wr * 64 + fr; const bool samp = u.pm >= (MP / BM);
        bf16_t* const QR = (bf16_t*)(ws + WS_QR); bf16_t* const KR = (bf16_t*)(ws + WS_KR); bf16_t* const VH = (bf16_t*)(ws + WS_VH); bf16_t* const SG = (bf16_t*)(ws + WS_SG); float* const vec = (float*)(ws + WS_VEC);
        float rs[2][4];
#pragma unroll
        for (int ai = 0; ai < 2; ++ai)
#pragma unroll
            for (int m = 0; m < 4; ++m) rs[ai][m] = rstd1[rowb + ai * HALF + m * 16];
        if (pn < 4) {
            const int h = pn, ch0 = 128 * h + 32 * wc + 4 * fq; const int lane = threadIdx.x & 63; const int a15 = ((lane & 48) | 15) << 2;
#pragma unroll
            for (int n = 0; n < 2; ++n) {
                const f32x4 l0 = *(const f32x4*)(lbl + ch0 + 16 * n), l1 = *(const f32x4*)(lbl + 512 + ch0 + 16 * n);
                f32x4 lb, omlb;
#pragma unroll
                for (int j = 0; j < 4; ++j) { lb[j] = 1.f / (1.f + __expf(l1[j] - l0[j])); omlb[j] = 1.f - lb[j]; }
#pragma unroll
                for (int ai = 0; ai < 2; ++ai) {
                    f32x4 bq[4], kk[4], bb[4]; f32x4 carry = {0.f, 0.f, 0.f, 0.f};
#pragma unroll
                    for (int m = 0; m < 4; ++m) {
#pragma unroll
                        for (int j = 0; j < 4; ++j) {
                            const float zq = acc[ai][0][m][n][j] * rs[ai][m], zf = acc[ai][1][m][n][j] * rs[ai][m];
                            const float sig = 1.f / (1.f + __expf(-zf)); const float f = lb[j] + omlb[j] * sig; float k = omlb[j] * (1.f - sig); float s = __logf(f);
                            if (samp && m >= 2) { s = 0.f; k = 0.f; }
                            s += DPP_SHR(s, 1); s += DPP_SHR(s, 2); s += DPP_SHR(s, 4); s += DPP_SHR(s, 8);
                            s += carry[j]; carry[j] = __int_as_float(__builtin_amdgcn_ds_bpermute(a15, __float_as_int(s)));
                            bq[m][j] = zq; kk[m][j] = k; bb[m][j] = s;
                        }
                    }
#pragma unroll
                    for (int m = 0; m < 4; ++m) {
                        float qv[4], kv[4];
#pragma unroll
                        for (int j = 0; j < 4; ++j) { qv[j] = bq[m][j] * __expf(bb[m][j]); kv[j] = kk[m][j] * __expf(-bb[m][j]); }
                        const size_t off = (size_t)(rowb + ai * HALF + m * 16) * 512 + ch0 + 16 * n;
                        v2u wq; wq.x = cvt_pk_bf16(qv[0], qv[1]); wq.y = cvt_pk_bf16(qv[2], qv[3]); *(v2u*)(QR + off) = wq;
                        v2u wk; wk.x = cvt_pk_bf16(kv[0], kv[1]); wk.y = cvt_pk_bf16(kv[2], kv[3]); *(v2u*)(KR + off) = wk;
                    }
                    if (fr == 0) {
                        const size_t voff = (size_t)((u.pm * BM + ai * HALF + wr * 64) >> 6) * 512 + ch0 + 16 * n;
                        f32x4 d;
#pragma unroll
                        for (int j = 0; j < 4; ++j) d[j] = __expf(carry[j]);
                        *(f32x4*)(vec + voff) = d;
                    }
                }
            }
        } else if (pn < 8) {
            const int h = pn - 4, c0 = 128 * h + 32 * wc + 4 * fq;
#pragma unroll
            for (int ai = 0; ai < 2; ++ai)
#pragma unroll
                for (int m = 0; m < 4; ++m) { const size_t off = (size_t)(rowb + ai * HALF + m * 16) * 512 + c0; const float r = rs[ai][m];
#pragma unroll
                    for (int n = 0; n < 2; ++n) { const f32x4 v = acc[ai][0][m][n] * r; f32x4 g = acc[ai][1][m][n] * r;
#pragma unroll
                        for (int j = 0; j < 4; ++j) g[j] = g[j] / (1.f + __expf(-g[j]));
                        v2u wv; wv.x = cvt_pk_bf16(v[0], v[1]); wv.y = cvt_pk_bf16(v[2], v[3]); *(v2u*)(VH + off + 16 * n) = wv;
                        v2u wg; wg.x = cvt_pk_bf16(g[0], g[1]); wg.y = cvt_pk_bf16(g[2], g[3]); *(v2u*)(SG + off + 16 * n) = wg; } }
        } else if (pn < 12) {
            const bool isK = pn >= 10; const int head = 4 * ((pn - 8) & 1) + wc; const float* gain = isK ? kg : qg; const float osc = isK ? 1.f : attn_body::C2;
            f32x4 gv[2][2];
#pragma unroll
            for (int bj = 0; bj < 2; ++bj)
#pragma unroll
                for (int n = 0; n < 2; ++n) gv[bj][n] = *(const f32x4*)(gain + 32 * bj + 16 * n + 4 * fq) * osc;
#pragma unroll
            for (int ai = 0; ai < 2; ++ai)
#pragma unroll
                for (int m = 0; m < 4; ++m) { const int row = rowb + ai * HALF + m * 16; const float r = rs[ai][m]; float ssq = 0.f;
#pragma unroll
                    for (int bj = 0; bj < 2; ++bj)
#pragma unroll
                        for (int n = 0; n < 2; ++n) { const f32x4 z = acc[ai][bj][m][n] * r; ssq += (z[0] * z[0] + z[1] * z[1]) + (z[2] * z[2] + z[3] * z[3]); }
                    ssq += __shfl_xor(ssq, 16); ssq += __shfl_xor(ssq, 32);
                    const float r2 = r / sqrtf(ssq * (1.f / 64.f) + EPSN);
                    int idx; const bool valid = row_map(row, idx);
                    float* ofp = out + (samp ? O_KS : O_KP) + (size_t)idx * 512;
                    const size_t boff = samp ? (isK ? WS_KS : WS_QS) : (isK ? WS_K : WS_Q); const size_t brow = samp ? (size_t)((idx >> 5) * SSEQ + PAST + (idx & 31)) : (size_t)row;
                    bf16_t* bfp = (bf16_t*)(ws + boff) + brow * 512;
                    if (valid) {
#pragma unroll
                        for (int bj = 0; bj < 2; ++bj)
#pragma unroll
                            for (int n = 0; n < 2; ++n) { const f32x4 v = acc[ai][bj][m][n] * r2 * gv[bj][n]; const int col = 64 * head + 32 * bj + 16 * n + 4 * fq;
                                if (isK) *(f32x4*)(ofp + col) = v;
                                v2u w; w.x = cvt_pk_bf16(v[0], v[1]); w.y = cvt_pk_bf16(v[2], v[3]); *(v2u*)(bfp + col) = w; } } }
        } else {
            const int c0 = 256 * (pn - 12) + 32 * wc + 4 * fq;
#pragma unroll
            for (int ai = 0; ai < 2; ++ai)
#pragma unroll
                for (int m = 0; m < 4; ++m) { const int row = rowb + ai * HALF + m * 16; const float r = rs[ai][m];
                    int idx; const bool valid = row_map(row, idx);
                    float* ofp = out + (samp ? O_VS : O_VP) + (size_t)idx * 512;
                    const size_t brow = samp ? (size_t)((idx >> 5) * SSEQ + PAST + (idx & 31)) : (size_t)row;
                    bf16_t* bfp = (bf16_t*)(ws + (samp ? WS_VS : WS_V)) + brow * 512;
                    if (valid) {
#pragma unroll
                        for (int bj = 0; bj < 2; ++bj)
#pragma unroll
                            for (int n = 0; n < 2; ++n) { const f32x4 v = acc[ai][bj][m][n] * r; const int col = c0 + 128 * bj + 16 * n;
                                *(f32x4*)(ofp + col) = v;
                                v2u w; w.x = cvt_pk_bf16(v[0], v[1]); w.y = cvt_pk_bf16(v[2], v[3]); *(v2u*)(bfp + col) = w; } } }
        }
    }
};
struct EpiWo {
    static constexpr bool PERM = false, AFTER_DRAIN = false;
    const float* xp; const float* xs; float* yp; float* ys; bf16_t* X1B; float* ssq;
    __device__ __forceinline__ void operator()(const f32x4 (&acc)[2][2][4][2], const Unit& u, int wr, int wc, int fr, int fq) const {
        const int rowb = u.pm * BM + wr * 64 + fr, c0 = u.pn * BM + wc * 32 + 4 * fq; const bool samp = u.pm >= (MP / BM);
#pragma unroll
        for (int ai = 0; ai < 2; ++ai)
#pragma unroll
            for (int m = 0; m < 4; ++m) { const int row = rowb + ai * HALF + m * 16; int idx; const bool valid = row_map(row, idx);
                const float* xr = (samp ? xs : xp) + (size_t)idx * DMOD; float* yr = yp + (samp ? (size_t)MP * DMOD : (size_t)0) + (size_t)idx * DMOD; float s = 0.f;
#pragma unroll
                for (int bj = 0; bj < 2; ++bj)
#pragma unroll
                    for (int n = 0; n < 2; ++n) { const int col = c0 + 128 * bj + 16 * n; f32x4 v = acc[ai][bj][m][n];
                        if (valid) { v += *(const f32x4*)(xr + col); *(f32x4*)(yr + col) = v; }
                        s += (v[0] * v[0] + v[1] * v[1]) + (v[2] * v[2] + v[3] * v[3]);
                        v2u w; w.x = cvt_pk_bf16(v[0], v[1]); w.y = cvt_pk_bf16(v[2], v[3]); *(v2u*)(X1B + (size_t)row * DMOD + col) = w; }
                s += __shfl_xor(s, 16); s += __shfl_xor(s, 32);
                if (fq == 0) ssq[(size_t)row * 16 + 4 * u.pn + wc] = s; }
    }
};
struct EpiUp {
    static constexpr bool PERM = true, AFTER_DRAIN = false;
    bf16_t* O; const float* ssq;
    __device__ __forceinline__ void operator()(const f32x4 (&acc)[2][2][4][2], const Unit& u, int wr, int wc, int fr, int fq) const {
        const int row0 = u.pm * BM + wr * 64 + fr, col0 = u.pn * BM + wc * 32 + 8 * fq;
#pragma unroll
        for (int ai = 0; ai < 2; ++ai)
#pragma unroll
            for (int m = 0; m < 4; ++m) { const int row = row0 + ai * HALF + m * 16; const f32x4* sp = (const f32x4*)(ssq + (size_t)row * 16);
                const f32x4 s0 = sp[0], s1 = sp[1], s2 = sp[2], s3 = sp[3]; const f32x4 st = (s0 + s1) + (s2 + s3);
                const float r = 1.f / sqrtf(((st[0] + st[1]) + (st[2] + st[3])) * (1.f / DMOD) + EPSN);
                bf16_t* rowp = O + (size_t)row * FF + col0;
#pragma unroll
                for (int bj = 0; bj < 2; ++bj) { f32x4 v0 = acc[ai][bj][m][0] * r, v1 = acc[ai][bj][m][1] * r;
#pragma unroll
                    for (int j = 0; j < 4; ++j) { v0[j] = fmaxf(v0[j], 0.f); v0[j] *= v0[j]; v1[j] = fmaxf(v1[j], 0.f); v1[j] *= v1[j]; }
                    u32x4 w; w.x = cvt_pk_bf16(v0[0], v0[1]); w.y = cvt_pk_bf16(v0[2], v0[3]); w.z = cvt_pk_bf16(v1[0], v1[1]); w.w = cvt_pk_bf16(v1[2], v1[3]);
                    *(u32x4*)(rowp + bj * HALF) = w; } }
    }
};
struct EpiDown {
    static constexpr bool PERM = false, AFTER_DRAIN = false;
    float* yp; float* ys;
    __device__ __forceinline__ void operator()(const f32x4 (&acc)[2][2][4][2], const Unit& u, int wr, int wc, int fr, int fq) const {
        const int rowb = u.pm * BM + wr * 64 + fr, c0 = u.pn * BM + wc * 32 + 4 * fq; const bool samp = u.pm >= (MP / BM);
#pragma unroll
        for (int ai = 0; ai < 2; ++ai)
#pragma unroll
            for (int m = 0; m < 4; ++m) { const int row = rowb + ai * HALF + m * 16; int idx; const bool valid = row_map(row, idx);
                float* yr = yp + (samp ? (size_t)MP * DMOD : (size_t)0) + (size_t)idx * DMOD;
                if (valid) {
#pragma unroll
                    for (int bj = 0; bj < 2; ++bj)
#pragma unroll
                        for (int n = 0; n < 2; ++n) { const int col = c0 + 128 * bj + 16 * n; *(f32x4*)(yr + col) = *(const f32x4*)(yr + col) + acc[ai][bj][m][n]; } } }
    }
};
}

struct Args { const float* in[17]; float* out; unsigned char* ws; int ph_lo, ph_hi; };
struct Frame {
    LAS unsigned char* lds; volatile LAS unsigned* MISC; unsigned* ctl; unsigned char* ws; float* out;
    int tid, lane, wave, vcu, G;
    const float *xp, *xs, *ck, *cv, *clf, *sh, *n1, *win, *bff, *qg, *kg, *lbl, *hon, *wout, *n2, *wup, *wdn;
};

__device__ __forceinline__ int win_src_col(int g) {
    const int j0 = 32 * g, tile = j0 >> 8, jl = j0 & 255;
    if (tile < 4) return (jl < 128) ? (128 * tile + jl) : (512 + 128 * tile + (jl - 128));
    if (tile < 8) { const int h = tile - 4; return (jl < 128) ? (1024 + 128 * h + jl) : (1536 + 128 * h + (jl - 128)); }
    if (tile < 12) { const int base = tile < 10 ? 2048 : 2560, tl = (tile - 8) & 1, bj = jl >> 7, wc = (jl >> 5) & 3; return base + 64 * (4 * tl + wc) + 32 * bj; }
    return 3072 + (j0 - 12 * 256);
}
__device__ __forceinline__ void p0_transpose_item(const float* W, int ldw, int K, const float* nrm, bf16* WT, int n0, int src0, int k0, LAS float* scr, int lane) {
#pragma unroll 8
    for (int i = 0; i < 32; ++i) { const int kk = 2 * i + (lane >> 5); float v = W[(size_t)(k0 + kk) * ldw + src0 + (lane & 31)]; if (nrm) v *= nrm[k0 + kk]; scr[kk * 33 + (lane & 31)] = v; }
    LDS_WAIT(); asm volatile("" ::: "memory");
    const int c = lane & 7;
#pragma unroll
    for (int j = 0; j < 4; ++j) { const int n = (lane >> 3) + 8 * j; const LAS float* s = scr + (8 * c) * 33 + n;
        v4u o; o.x = pk2(s[0 * 33], s[1 * 33]); o.y = pk2(s[2 * 33], s[3 * 33]); o.z = pk2(s[4 * 33], s[5 * 33]); o.w = pk2(s[6 * 33], s[7 * 33]);
        *(v4u*)(WT + (size_t)(n0 + n) * K + k0 + 8 * c) = o; }
    LDS_WAIT(); asm volatile("" ::: "memory");
}
__device__ __forceinline__ void p0_prologue(Frame& F) {
    LAS float* scr = (LAS float*)(F.lds + F.wave * 16384);
    const int gw = F.vcu * NWAVES + F.wave, NGW = F.G * NWAVES, lane = F.lane;
    bf16* Win_t = (bf16*)(F.ws + WS_WIN); bf16* Wo_t = (bf16*)(F.ws + WS_WO); bf16* Wup_t = (bf16*)(F.ws + WS_WUP); bf16* Wdn_t = (bf16*)(F.ws + WS_WDN);
    constexpr int I_IN = 16 * (NIN / 32), I_O = 16 * 32, I_UP = 16 * (FF / 32), I_DN = 64 * 32, NITEMS = I_IN + I_O + I_UP + I_DN;
    for (int it = gw; it < NITEMS; it += NGW) {
        int r = it;
        if (r < I_IN) { const int kb = r / (NIN / 32), g = r % (NIN / 32); p0_transpose_item(F.win, INC, DMOD, F.n1, Win_t, 32 * g, win_src_col(g), 64 * kb, scr, lane); continue; } r -= I_IN;
        if (r < I_O) { const int kb = r / 32, g = r % 32; p0_transpose_item(F.wout, DMOD, DMOD, nullptr, Wo_t, 32 * g, 32 * g, 64 * kb, scr, lane); continue; } r -= I_O;
        if (r < I_UP) { const int kb = r / (FF / 32), g = r % (FF / 32); p0_transpose_item(F.wup, FF, DMOD, F.n2, Wup_t, 32 * g, 32 * g, 64 * kb, scr, lane); continue; } r -= I_UP;
        { const int kb = r / 32, g = r % 32; p0_transpose_item(F.wdn, DMOD, FF, nullptr, Wdn_t, 32 * g, 32 * g, 64 * kb, scr, lane); }
    }
    { const int gt = F.vcu * NTHR + F.tid, NGT = F.G * NTHR;
      bf16* Qs = (bf16*)(F.ws + WS_QS); bf16* Ks = (bf16*)(F.ws + WS_KS); bf16* Vs = (bf16*)(F.ws + WS_VS);
      for (int i = gt; i < NBATCH * PAST * 64; i += NGT) { const int b = i / (PAST * 64), rem = i % (PAST * 64); const size_t so = (size_t)i * 8, dof = ((size_t)b * SSEQ * 64 + rem) * 8;
          const f32x4 a0 = *(const f32x4*)(F.ck + so), a1 = *(const f32x4*)(F.ck + so + 4), b0 = *(const f32x4*)(F.cv + so), b1 = *(const f32x4*)(F.cv + so + 4);
          v4u o; o.x = pk2(a0[0], a0[1]); o.y = pk2(a0[2], a0[3]); o.z = pk2(a1[0], a1[1]); o.w = pk2(a1[2], a1[3]); *(v4u*)(Ks + dof) = o;
          o.x = pk2(b0[0], b0[1]); o.y = pk2(b0[2], b0[3]); o.z = pk2(b1[0], b1[1]); o.w = pk2(b1[2], b1[3]); *(v4u*)(Vs + dof) = o; }
      const v4u z = {0u, 0u, 0u, 0u};
      for (int i = gt; i < NBATCH * SSEQ * 64; i += NGT) *(v4u*)(Qs + (size_t)i * 8) = z;
      for (int i = gt; i < NBATCH * (SSEQ - PAST) * 64; i += NGT) { const int b = i / ((SSEQ - PAST) * 64), rem = i % ((SSEQ - PAST) * 64); const size_t dof = ((size_t)(b * SSEQ + PAST) * 64 + rem) * 8; *(v4u*)(Ks + dof) = z; *(v4u*)(Vs + dof) = z; }
    }
    float wf[4][4][8];
#pragma unroll
    for (int j = 0; j < 4; ++j)
#pragma unroll
        for (int i = 0; i < 4; ++i) { const int k = 256 * j + 4 * lane + i; const float nk = F.n1[k]; const f32x4 a = *(const f32x4*)(F.win + (size_t)k * INC + NIN), b = *(const f32x4*)(F.win + (size_t)k * INC + NIN + 4);
            wf[j][i][0] = a[0] * nk; wf[j][i][1] = a[1] * nk; wf[j][i][2] = a[2] * nk; wf[j][i][3] = a[3] * nk; wf[j][i][4] = b[0] * nk; wf[j][i][5] = b[1] * nk; wf[j][i][6] = b[2] * nk; wf[j][i][7] = b[3] * nk; }
    const f32x4 bf0 = *(const f32x4*)(F.bff), bf1 = *(const f32x4*)(F.bff + 4);
    float* rstd1 = (float*)(F.ws + WS_RSTD); bf16* XB = (bf16*)(F.ws + WS_XB);
    for (int m = gw; m < MTOT; m += NGW) {
        int idx; const bool valid = row_map(m, idx); const float* xrow = (m < MP ? F.xp : F.xs) + (size_t)idx * DMOD;
        f32x4 v[4]; float s = 0.f;
#pragma unroll
        for (int j = 0; j < 4; ++j) { v[j] = valid ? *((const f32x4*)xrow + 64 * j + lane) : (f32x4){0.f, 0.f, 0.f, 0.f}; s += (v[j][0] * v[j][0] + v[j][1] * v[j][1]) + (v[j][2] * v[j][2] + v[j][3] * v[j][3]); }
        const float rstd = 1.f / sqrtf(wave_sum(s) * (1.f / DMOD) + EPSN);
        if (lane == 0) rstd1[m] = rstd;
        unsigned long long* o8 = (unsigned long long*)(XB + (size_t)m * DMOD) + lane;
#pragma unroll
        for (int j = 0; j < 4; ++j) o8[64 * j] = (unsigned long long)pk2(v[j][0], v[j][1]) | ((unsigned long long)pk2(v[j][2], v[j][3]) << 32);
        float fb[8];
#pragma unroll
        for (int h = 0; h < 8; ++h) { float a = 0.f;
#pragma unroll
            for (int j = 0; j < 4; ++j)
#pragma unroll
                for (int i = 0; i < 4; ++i) a += v[j][i] * wf[j][i][h];
            fb[h] = wave_sum(a); }
        if (valid && lane == 0) { f32x4 o0, o1;
#pragma unroll
            for (int h = 0; h < 8; ++h) { const float xx = fb[h] * rstd + (h < 4 ? bf0[h & 3] : bf1[h & 3]); const float ls = fminf(xx, 0.f) - log1pf(expf(-fabsf(xx))); if (h < 4) o0[h & 3] = ls; else o1[h & 3] = ls; }
            float* lp = (m < MP ? F.out + O_LP : F.out + O_LS) + (size_t)idx * 8; *(f32x4*)lp = o0; *(f32x4*)(lp + 4) = o1; }
    }
}
__device__ __forceinline__ void scan_chain(Frame& F, int ch) {
    LAS float* wsum = (LAS float*)F.lds;
    const bool samp = ch >= 64; const int c2 = samp ? ch - 64 : ch, b = c2 >> 3, h = c2 & 7; const int L = samp ? SSEQ : TSEQ, EPT = samp ? 3 : 16;
    float* dst = samp ? (float*)(F.ws + WS_CGS) + (size_t)c2 * SSEQ : (float*)(F.ws + WS_CGP) + (size_t)c2 * TSEQ;
    float vals[16]; float sum = 0.f;
#pragma unroll
    for (int i = 0; i < 16; ++i) { const int p = F.tid * EPT + i; float v = 0.f;
        if (i < EPT && p < L) { if (!samp) v = F.out[O_LP + ((size_t)b * TSEQ + p) * 8 + h]; else if (p < PAST) v = F.clf[((size_t)b * PAST + p) * 8 + h]; else if (p < PAST + DSEQ) v = F.out[O_LS + ((size_t)b * DSEQ + (p - PAST)) * 8 + h]; }
        sum += v; vals[i] = sum; }
    float incl = sum;
#pragma unroll
    for (int o = 1; o < 64; o <<= 1) { const float t = __shfl_up(incl, o); if (F.lane >= o) incl += t; }
    if (F.lane == 63) wsum[F.wave] = incl;
    __syncthreads();
    float base = 0.f;
    for (int w = 0; w < F.wave; ++w) base += wsum[w];
    const float excl = base + incl - sum;
#pragma unroll
    for (int i = 0; i < 16; ++i) { const int p = F.tid * EPT + i; if (i < EPT && p < L) dst[p] = (excl + vals[i]) * LOG2E; }
    __syncthreads();
}
constexpr int H_QR = 0, H_KR = 17408, H_KT = 34816, H_VT = 53248, H_VEC = 71680, H_AL = 73216, H_OL = 82432, H_END = 116224;
static_assert(H_END <= RING_BYTES, "hgrn LDS");
typedef short v4i16_t __attribute__((ext_vector_type(4)));
__device__ __forceinline__ bf16x8 tr_frag(LAS unsigned char* p) {
    const v4i16_t lo = __builtin_amdgcn_ds_read_tr16_b64_v4i16((LAS v4i16_t*)p), hi = __builtin_amdgcn_ds_read_tr16_b64_v4i16((LAS v4i16_t*)(p + 4 * 272));
    return (bf16x8){lo[0], lo[1], lo[2], lo[3], hi[0], hi[1], hi[2], hi[3]};
}
__device__ __forceinline__ f32x4 mfma16(bf16x8 a, bf16x8 b, f32x4 c) { return __builtin_amdgcn_mfma_f32_16x16x32_bf16(a, b, c, 0, 0, 0); }
#define LAUNDER(x) asm volatile("" : "+v"(x))
#define HG_BAR() do { asm volatile("s_waitcnt lgkmcnt(0)" ::: "memory"); __builtin_amdgcn_s_barrier(); asm volatile("" ::: "memory"); } while (0)
__device__ __forceinline__ void hgrn_chain(Frame& F, int row0, int chunk0, int nsteps, int h, const float* S0, float* Sout) {
    LAS unsigned char* L = F.lds; int tid_ = F.tid; LAUNDER(tid_); const int tid = tid_, lane = tid & 63, w = F.wave, l15 = lane & 15, fq = lane >> 4;
    const char* qb = (const char*)(F.ws + WS_QR) + ((size_t)row0 * 512 + 128 * h) * 2; const char* kb_ = (const char*)(F.ws + WS_KR) + ((size_t)row0 * 512 + 128 * h) * 2;
    const char* vb = (const char*)(F.ws + WS_VH) + ((size_t)row0 * 512 + 128 * h) * 2; const char* gb = (const char*)(F.ws + WS_SG) + ((size_t)row0 * 512 + 128 * h) * 2;
    const char* eb = (const char*)(F.ws + WS_VEC) + ((size_t)chunk0 * 512 + 128 * h) * 4; char* mb = (char*)(F.ws + WS_MIX) + ((size_t)row0 * DMOD + 128 * h) * 2;
    const int oc = tid >> 3, oseg = tid & 7;
    unsigned vo_rm = (unsigned)((tid >> 4) * 1024 + (tid & 15) * 16), vo_sg = (unsigned)(oc * 1024 + oseg * 32), vo_mix = (unsigned)(oc * 2048 + oseg * 32);
    unsigned vo_vec = (unsigned)((tid & 31) * 16);
    unsigned l_rm = (unsigned)(H_QR + (tid >> 4) * 272 + (tid & 15) * 16);
    unsigned l_vw = (unsigned)(H_VEC + (tid & 31) * 16);
    unsigned l_aq = (unsigned)(H_QR + (16 * (w >> 1) + l15) * 272 + fq * 16);
    unsigned l_ak = (unsigned)(H_KR + (32 * (w & 1) + l15) * 272 + fq * 16);
    unsigned l_aw = (unsigned)(H_AL + (16 * (w >> 1) + 4 * fq) * 144 + (32 * (w & 1) + l15) * 2);
    unsigned l_vt = (unsigned)(H_KT + (8 * fq + (l15 >> 2)) * 272 + (16 * w + 4 * (l15 & 3)) * 2);
    unsigned l_q2 = (unsigned)(H_QR + l15 * 272 + fq * 16);
    unsigned l_al = (unsigned)(H_AL + l15 * 144 + fq * 16);
    unsigned l_kt = (unsigned)(H_KR + (8 * fq + (l15 >> 2)) * 272 + (8 * (l15 & 3)) * 2);
    unsigned l_ve = (unsigned)(H_VEC + fq * 32);
    unsigned l_ow = (unsigned)(H_OL + (4 * fq) * 528 + (16 * w + l15) * 4);
    unsigned l_or = (unsigned)(H_OL + oc * 528 + oseg * 64);
    f32x4 S[8];
#pragma unroll
    for (int kb = 0; kb < 8; ++kb) S[kb] = (f32x4){0.f, 0.f, 0.f, 0.f};
    if (S0) { const float* sp = S0 + (8 * fq) * 128 + 16 * w + l15;
#pragma unroll
        for (int kb = 0; kb < 8; ++kb) { LAUNDER(sp);
#pragma unroll
            for (int r = 0; r < 4; ++r) S[kb][r] = sp[r * 128];
            sp += (kb & 1) ? 28 * 128 : 4 * 128; } }
    v4u pq[2], pk[2], pv[2], psgc[2], pvec;
#define HG_LOAD() do { \
        _Pragma("unroll") for (int it = 0; it < 2; ++it) { pq[it] = *(const v4u*)(qb + vo_rm + it * 32768); pk[it] = *(const v4u*)(kb_ + vo_rm + it * 32768); pv[it] = *(const v4u*)(vb + vo_rm + it * 32768); } \
        if (tid < 32) pvec = *(const v4u*)(eb + vo_vec); } while (0)
#define HG_STORE() do { \
        _Pragma("unroll") for (int it = 0; it < 2; ++it) { *(LAS v4u*)(L + l_rm + it * 8704) = pq[it]; *(LAS v4u*)(L + l_rm + (H_KR - H_QR) + it * 8704) = pk[it]; *(LAS v4u*)(L + l_rm + (H_KT - H_QR) + it * 8704) = pv[it]; } \
        if (tid < 32) *(LAS v4u*)(L + l_vw) = pvec; } while (0)
#define HG_ADV() do { qb += 65536; kb_ += 65536; vb += 65536; eb += 2048; } while (0)
    HG_LOAD(); HG_ADV(); HG_STORE();
    HG_BAR();
    for (int c = 0; c < nsteps; ++c) {
        LAUNDER(vo_rm); LAUNDER(vo_sg); LAUNDER(vo_mix); LAUNDER(vo_vec); LAUNDER(l_rm); LAUNDER(l_vw); LAUNDER(l_aq); LAUNDER(l_ak); LAUNDER(l_aw);
        LAUNDER(l_vt); LAUNDER(l_q2); LAUNDER(l_al); LAUNDER(l_kt); LAUNDER(l_ve); LAUNDER(l_ow); LAUNDER(l_or);
        psgc[0] = *(const v4u*)(gb + vo_sg); psgc[1] = *(const v4u*)(gb + vo_sg + 16); gb += 65536;
        if (c + 1 < nsteps) { HG_LOAD(); HG_ADV(); }
        { const int cblk = w >> 1;
#pragma unroll
          for (int jj = 0; jj < 2; ++jj) { const int sblk = 2 * (w & 1) + jj; f32x4 a = {0.f, 0.f, 0.f, 0.f};
              if (sblk <= cblk) {
#pragma unroll
                  for (int ks = 0; ks < 4; ++ks) { const bf16x8 af = *(const LAS bf16x8*)(L + l_aq + ks * 64); const bf16x8 bf = *(const LAS bf16x8*)(L + l_ak + jj * 16 * 272 + ks * 64); a = mfma16(af, bf, a); }
#pragma unroll
                  for (int r = 0; r < 4; ++r) if (16 * sblk + l15 > 16 * cblk + 4 * fq + r) a[r] = 0.f;
              }
#pragma unroll
              for (int r = 0; r < 4; ++r) *(LAS unsigned short*)(L + l_aw + r * 144 + jj * 32) = (unsigned short)(pk2(a[r], 0.f) & 0xffffu);
          } }
        HG_BAR();
        { bf16x8 bvt[2];
#pragma unroll
          for (int ks = 0; ks < 2; ++ks) bvt[ks] = tr_frag(L + l_vt + ks * 32 * 272);
          bf16x8 sb[4];
#pragma unroll
          for (int kb2 = 0; kb2 < 4; ++kb2) { v4u t; t.x = pk2(S[2 * kb2][0], S[2 * kb2][1]); t.y = pk2(S[2 * kb2][2], S[2 * kb2][3]); t.z = pk2(S[2 * kb2 + 1][0], S[2 * kb2 + 1][1]); t.w = pk2(S[2 * kb2 + 1][2], S[2 * kb2 + 1][3]); sb[kb2] = __builtin_bit_cast(bf16x8, t); }
#pragma unroll
          for (int cb = 0; cb < 4; ++cb) { f32x4 o = {0.f, 0.f, 0.f, 0.f};
#pragma unroll
              for (int ks = 0; ks < 2; ++ks) if (32 * ks <= 16 * cb + 15) { const bf16x8 af = *(const LAS bf16x8*)(L + l_al + cb * 16 * 144 + ks * 64); o = mfma16(af, bvt[ks], o); }
#pragma unroll
              for (int kb2 = 0; kb2 < 4; ++kb2) { const bf16x8 af = *(const LAS bf16x8*)(L + l_q2 + cb * 16 * 272 + kb2 * 64); o = mfma16(af, sb[kb2], o); }
#pragma unroll
              for (int r = 0; r < 4; ++r) *(LAS float*)(L + l_ow + (16 * cb + r) * 528) = o[r];
              __builtin_amdgcn_sched_barrier(0); }
#pragma unroll
          for (int kb = 0; kb < 8; ++kb) {
#pragma unroll
              for (int ks = 0; ks < 2; ++ks) { const bf16x8 af = tr_frag(L + l_kt + (32 * (kb >> 1) + 4 * (kb & 1)) * 2 + ks * 32 * 272); S[kb] = mfma16(af, bvt[ks], S[kb]); }
              const f32x4 dv = *(const LAS f32x4*)(L + l_ve + (32 * (kb >> 1) + 4 * (kb & 1)) * 4);
              S[kb] = S[kb] * dv;
              if (kb & 1) __builtin_amdgcn_sched_barrier(0); } }
        HG_BAR();
        { f32x4 ov[4]; float ss = 0.f;
#pragma unroll
          for (int i = 0; i < 4; ++i) { ov[i] = *(const LAS f32x4*)(L + l_or + 16 * i); ss += (ov[i][0] * ov[i][0] + ov[i][1] * ov[i][1]) + (ov[i][2] * ov[i][2] + ov[i][3] * ov[i][3]); }
          ss += __shfl_xor(ss, 1); ss += __shfl_xor(ss, 2); ss += __shfl_xor(ss, 4);
          const float rn = 1.f / sqrtf(ss * (1.f / 128.f) + EPSN);
          float res[16]; f32x4 gn[4]; const float* hp = F.hon + 128 * h + 16 * oseg; LAUNDER(hp);
#pragma unroll
          for (int i = 0; i < 4; ++i) gn[i] = *(const f32x4*)(hp + 4 * i);
#pragma unroll
          for (int i = 0; i < 4; ++i)
#pragma unroll
              for (int j = 0; j < 4; ++j) { const int e = 4 * i + j; const unsigned wd = psgc[e >> 3][(e & 7) >> 1]; const float sg = bf2f((unsigned short)((e & 1) ? (wd >> 16) : (wd & 0xffffu))); res[e] = ov[i][j] * rn * gn[i][j] * sg; }
          v4u o0, o1; o0.x = pk2(res[0], res[1]); o0.y = pk2(res[2], res[3]); o0.z = pk2(res[4], res[5]); o0.w = pk2(res[6], res[7]); o1.x = pk2(res[8], res[9]); o1.y = pk2(res[10], res[11]); o1.z = pk2(res[12], res[13]); o1.w = pk2(res[14], res[15]);
          *(v4u*)(mb + vo_mix) = o0; *(v4u*)(mb + vo_mix + 16) = o1; mb += 131072; }
        if (c + 1 < nsteps) { HG_STORE(); }
        HG_BAR();
    }
    { int ln2 = lane; LAUNDER(ln2); float* sp = Sout + (8 * (ln2 >> 4)) * 128 + 16 * w + (ln2 & 15);
#pragma unroll
      for (int kb = 0; kb < 8; ++kb) { LAUNDER(sp);
#pragma unroll
          for (int r = 0; r < 4; ++r) sp[r * 128] = S[kb][r];
          sp += (kb & 1) ? 28 * 128 : 4 * 128; } }
#undef HG_LOAD
#undef HG_STORE
#undef HG_ADV
}

__global__ void __launch_bounds__(NTHR, 2) skel_fwd(Args args) {
    extern __shared__ __attribute__((aligned(16))) unsigned char lds[];
    Frame F;
    F.lds = (LAS unsigned char*)lds; F.MISC = (volatile LAS unsigned*)(F.lds + MISC_OFF);
    F.tid = threadIdx.x; F.lane = F.tid & 63; F.wave = __builtin_amdgcn_readfirstlane(F.tid >> 6);
    F.G = gridDim.x; { const int bx = blockIdx.x; F.vcu = (F.G % 8 == 0) ? (bx % 8) * (F.G / 8) + bx / 8 : bx; }
    F.ws = args.ws; F.ctl = (unsigned*)(args.ws + WS_CTL); F.out = args.out;
    F.xp = args.in[0]; F.xs = args.in[1]; F.ck = args.in[2]; F.cv = args.in[3]; F.clf = args.in[4]; F.sh = args.in[5]; F.n1 = args.in[6]; F.win = args.in[7]; F.bff = args.in[8];
    F.qg = args.in[9]; F.kg = args.in[10]; F.lbl = args.in[11]; F.hon = args.in[12]; F.wout = args.in[13]; F.n2 = args.in[14]; F.wup = args.in[15]; F.wdn = args.in[16];
    const int lo = args.ph_lo, hi = args.ph_hi;
#if defined(PROBE_A)
    unsigned long long ts_[9]; const bool stamper_ = (blockIdx.x == 0 && F.tid == 0);
#define STAMP(k) do { if (stamper_) ts_[k] = __builtin_amdgcn_s_memrealtime(); } while (0)
    STAMP(0);
#else
#define STAMP(k) do {} while (0)
#endif
#ifndef PH_MASK
#define PH_MASK 63
#endif
#define IN(k) (((PH_MASK >> (k)) & 1) && lo <= (k) && (k) < hi)
#define SEAM(k) do { if (IN(k) && IN((k) + 1)) { cg::this_grid().sync(); } } while (0)
    bf16* XB = (bf16*)(F.ws + WS_XB); bf16* X1B = (bf16*)(F.ws + WS_X1B); bf16* MIX = (bf16*)(F.ws + WS_MIX); bf16* HB = (bf16*)(F.ws + WS_H);
    if (IN(0)) { p0_prologue(F); }
    SEAM(0); STAMP(1);
    const int bx = (int)blockIdx.x; const bool chainwg = bx < NCHAINWG; const int NWORK = F.G - NCHAINWG;
    if (IN(1)) {
#ifndef NO_SCAN
        for (int ch = F.vcu; ch < 128; ch += F.G) scan_chain(F, ch);
#endif
        pg8::Gemm g{XB, (const bf16*)(F.ws + WS_WIN), MTOT, NIN, DMOD};
        pg8::EpiIn E{(const float*)(F.ws + WS_RSTD), F.lbl, F.qg, F.kg, F.ws, F.out};
#pragma nounroll
        for (int sub = 0; sub < 2; ++sub) {
            pg8::OrderIn S;
            if (sub == 0) { S.so.init(MP, 2048, F.G, bx); S.pn_off = 0; S.extra = 0; S.extra_pm0 = 0; }
            else { S.so.init(MTOT, NIN - 2048, NWORK, bx - NCHAINWG); S.pn_off = 8; S.extra = 8 * (MS / 256); S.extra_pm0 = MP / 256; }
            if (sub == 0 || !chainwg) pg8::gemm_phase<pg8::EpiIn, pg8::OrderIn, true, true>(F.lds, g, S, E);
            if (sub == 0) {
                cg::this_grid().sync(); STAMP(2);
                if (chainwg) { const int bb = bx >> 2; hgrn_chain(F, bb * TSEQ, bb * (TSEQ / 64), TSEQ / 64, bx & 3, nullptr, F.out + O_HP + (size_t)bx * 16384); }
            }
        }
        asm volatile("s_waitcnt vmcnt(0)" ::: "memory"); __syncthreads();
        if (F.tid == 0) { unsigned* sc = F.ctl + CW_SUB;
            if (!chainwg) { __threadfence(); __hip_atomic_fetch_add(sc, 1u, __ATOMIC_RELAXED, __HIP_MEMORY_SCOPE_AGENT); }
            while (__hip_atomic_load(sc, __ATOMIC_RELAXED, __HIP_MEMORY_SCOPE_AGENT) < (unsigned)NWORK) __builtin_amdgcn_s_sleep(8);
            __threadfence(); }
        __syncthreads();
        if (chainwg) { const int bb = bx >> 2; hgrn_chain(F, MP + 64 * bb, MP / 64 + bb, 1, bx & 3, F.sh + (size_t)bx * 16384, F.out + O_HS + (size_t)bx * 16384); __syncthreads(); }
    }
    if (IN(2)) {
#ifndef NO_ATTN
        float prune_thr;
        { float mq = fabsf(F.qg[F.lane]), mk = fabsf(F.kg[F.lane]);
#pragma unroll
          for (int o = 1; o < 64; o <<= 1) { mq = fmaxf(mq, __shfl_xor(mq, o)); mk = fmaxf(mk, __shfl_xor(mk, o)); }
          prune_thr = 2.f * (8.f * mq * mk * LOG2E) + 150.f; }
        for (;;) {
            if (F.tid == 0) F.MISC[0] = atomicAdd(F.ctl + CW_QUEUE, 1u);
            __syncthreads();
            const int i = (int)F.MISC[0];
            __syncthreads();
            if (i >= 2048 + 64) break;
            typedef attn_body::bf16 abf;
            const bool smp = i >= 2048; const int j = smp ? i - 2048 : i;
            const int bh = j & 63, qb = 31 - (j >> 6), b = bh >> 3, h = bh & 7;
            const int q0 = smp ? SSEQ - 256 : 256 * qb, NT = (q0 + 256) / 64; int NTE = NT;
            const size_t rb = (size_t)b * (smp ? SSEQ : TSEQ);
            const float* cgp = (const float*)(F.ws + (smp ? WS_CGS : WS_CGP)) + (size_t)bh * (smp ? SSEQ : TSEQ);
#if FOX_PRUNE
            { const bool need = F.tid < NT && (cgp[q0] - cgp[64 * F.tid + 63] >= -prune_thr); const int needed = __syncthreads_count(need ? 1 : 0);
              NTE = (needed + 1) & ~1; NTE = NTE < 4 ? 4 : (NTE > NT ? NT : NTE); }
#endif
            const size_t orow = smp ? (size_t)(MP + 64 * b) - (size_t)(PAST - q0) : rb + q0;
            attn_body::attn_unit<8>((const abf*)(F.ws + (smp ? WS_QS : WS_Q)) + (rb + q0) * 512 + 64 * h, (const abf*)(F.ws + (smp ? WS_KS : WS_K)) + rb * 512 + 64 * h, (const abf*)(F.ws + (smp ? WS_VS : WS_V)) + rb * 512 + 64 * h,
                                    (abf*)MIX + orow * DMOD + 512 + 64 * h, NT, NTE, cgp, q0, smp ? (PAST - q0) / 32 : 0, smp ? (PAST - q0) / 32 + 1 : 8, (char*)lds);
        }
#endif
    }
    SEAM(2); STAMP(3);
    if (IN(3)) {
        pg8::Gemm g{MIX, (const bf16*)(F.ws + WS_WO), MTOT, DMOD, DMOD}; pg8::StaticOrder S; S.init(MTOT, DMOD, F.G, (int)blockIdx.x);
        pg8::EpiWo E{F.xp, F.xs, F.out + O_YP, F.out + O_YS, X1B, (float*)(F.ws + WS_SSQ)};
        pg8::gemm_phase<pg8::EpiWo, pg8::StaticOrder, true, true>(F.lds, g, S, E);
    }
    SEAM(3); STAMP(4);
    if (IN(4)) {
        pg8::Gemm g{X1B, (const bf16*)(F.ws + WS_WUP), MTOT, FF, DMOD}; pg8::StaticOrder S; S.init(MTOT, FF, F.G, (int)blockIdx.x);
        pg8::EpiUp E{HB, (const float*)(F.ws + WS_SSQ)};
        pg8::gemm_phase<pg8::EpiUp, pg8::StaticOrder, true, true>(F.lds, g, S, E);
#if defined(DOUBLE_P4)
        cg::this_grid().sync();
        pg8::gemm_phase<pg8::EpiUp, pg8::StaticOrder, true, true>(F.lds, g, S, E);
#endif
    }
    SEAM(4); STAMP(5);
    if (IN(5)) {
        pg8::Gemm g{HB, (const bf16*)(F.ws + WS_WDN), MTOT, DMOD, FF}; pg8::StaticOrder S; S.init(MTOT, DMOD, F.G, (int)blockIdx.x);
        pg8::EpiDown E{F.out + O_YP, F.out + O_YS};
        pg8::gemm_phase<pg8::EpiDown, pg8::StaticOrder, true, true>(F.lds, g, S, E);
    }
    STAMP(6);
#if defined(PROBE_A)
    cg::this_grid().sync();
    if (stamper_) {
        unsigned long long da = ts_[PROBE_A + 1] - ts_[PROBE_A], db = ts_[PROBE_B + 1] - ts_[PROBE_B];
        unsigned qa = (unsigned)((da + 1250) / 2500), qb = (unsigned)((db + 1250) / 2500); if (qa > 63) qa = 63; if (qb > 63) qb = 63;
#if defined(PROBE_CAL)
        qa = 1000; qb = 0;
#endif
        const unsigned long long t0 = __builtin_amdgcn_s_memrealtime(), wait = 2000ull * (qa + 64 * qb);
        while (__builtin_amdgcn_s_memrealtime() - t0 < wait) __builtin_amdgcn_s_sleep(16);
    }
#endif
#undef IN
#undef SEAM
}

extern "C" void kernel_launch(void* const* d_in, const int* in_sizes, int n_in, void* d_out, int out_size, void* d_ws, size_t ws_size, hipStream_t stream) {
    static int grid = 0;
    if (grid == 0) {
        if (n_in != 17 || (size_t)out_size != O_END || ws_size < WS_END) { fprintf(stderr, "kernel_launch: unexpected shapes (n_in %d out %d ws %zu)\n", n_in, out_size, ws_size); grid = -1; return; }
        int dev = 0, cus = 0, per_cu = 0;
        if (hipGetDevice(&dev) != hipSuccess || hipDeviceGetAttribute(&cus, hipDeviceAttributeMultiprocessorCount, dev) != hipSuccess) { grid = -1; return; }
        if (hipFuncSetAttribute((const void*)skel_fwd, hipFuncAttributeMaxDynamicSharedMemorySize, LDS_BYTES) != hipSuccess) { fprintf(stderr, "kernel_launch: hipFuncSetAttribute failed\n"); grid = -1; return; }
        if (hipOccupancyMaxActiveBlocksPerMultiprocessor(&per_cu, (const void*)skel_fwd, NTHR, LDS_BYTES) != hipSuccess || per_cu < 1) { fprintf(stderr, "kernel_launch: occupancy query says %d\n", per_cu); per_cu = 1; }
        (void)hipGetLastError();
        grid = cus;
    }
    if (grid < 0) return;
    if (hipMemsetAsync((char*)d_ws + WS_CTL, 0, CTL_ZERO_BYTES, stream) != hipSuccess) { fprintf(stderr, "kernel_launch: memset failed\n"); return; }
    Args a{};
    for (int i = 0; i < 17; ++i) a.in[i] = (const float*)d_in[i];
    a.out = (float*)d_out; a.ws = (unsigned char*)d_ws;
#if MK_N_LAUNCHES == 1
    a.ph_lo = 0; a.ph_hi = 6;
    void* kargs[] = {&a};
    hipError_t e = hipLaunchCooperativeKernel((const void*)skel_fwd, dim3(grid), dim3(NTHR), kargs, LDS_BYTES, stream);
    if (e != hipSuccess) fprintf(stderr, "kernel_launch: cooperative launch failed: %s (grid %d)\n", hipGetErrorString(e), grid);
#else
    for (int li = 0; li < 6; ++li) { a.ph_lo = li; a.ph_hi = li + 1; hipLaunchKernelGGL(skel_fwd, dim3(grid), dim3(NTHR), LDS_BYTES, stream, a); }
#endif
}
```

```cpp
#include <hip/hip_runtime.h>
#include <cstdio>
#include <cstdint>
namespace pg8 {
#define PG8_LAS __attribute__((address_space(3)))
typedef unsigned short bf16_t;
typedef short bf16x8 __attribute__((ext_vector_type(8)));
typedef float f32x4 __attribute__((ext_vector_type(4)));
typedef unsigned u32x4 __attribute__((ext_vector_type(4)));
constexpr int BM = 256, BK = 64, HALF = 128, HTB = HALF * BK * 2  , STAGE_BYTES = 8 * HTB, NXCD = 8, WGM = 8;

__host__ __device__ __forceinline__ int lds_byte(int r, int c) { const int st = (r >> 4) * 2 + (c >> 5), rr = r & 15, cc = c & 31, ob = rr * 64 + cc * 2; return st * 1024 + (ob ^ (((ob >> 9) & 1) << 5)); }
__host__ __device__ __forceinline__ void stage_rc(int b, int& R, int& C) { const int st = b / 1024, sb = b % 1024, swz = sb ^ (((sb >> 9) & 1) << 5); R = (st >> 1) * 16 + swz / 64; C = (st & 1) * 32 + (swz % 64) / 2; }
__host__ __device__ __forceinline__ int perm32(int rho) { const int n = rho >> 4, i = rho & 15; return 8 * (i >> 2) + 4 * n + (i & 3); }

struct Unit { int pm, pn; };
struct Gemm { const bf16_t* A; const bf16_t* Bt; int M, N, K; };

struct StaticOrder {
    int nM, nN, nwg, G, c;
    __host__ __device__ void init(int M, int N, int G_, int c_) { nM = M / BM; nN = N / BM; nwg = nM * nN; G = G_; c = c_; }
    __host__ __device__ bool next(int i, Unit& u) const {
        const long L = (long)i * G + c; if (L >= nwg) return false;
        int wgid = (int)L; { const int q = nwg / NXCD, r = nwg % NXCD, xcd = wgid % NXCD, off = wgid / NXCD; wgid = (xcd < r ? xcd * (q + 1) : r * (q + 1) + (xcd - r) * q) + off; }
        const int nig = WGM * nN, gid = wgid / nig, fm = gid * WGM, gsz = (nM - fm) < WGM ? (nM - fm) : WGM;
        u.pm = fm + ((wgid % nig) % gsz); u.pn = (wgid % nig) / gsz; return true;
    }
    __device__ __forceinline__ void a_ready(const Unit&) const {}
    __device__ __forceinline__ void done(const Unit&) const {}
};

__device__ __forceinline__ unsigned cvt_pk_bf16(float lo, float hi) { unsigned r; asm volatile("v_cvt_pk_bf16_f32 %0, %1, %2" : "=v"(r) : "v"(lo), "v"(hi)); return r; }
typedef float f32x2 __attribute__((ext_vector_type(2)));
template <class Epi, class Sched, bool ALIGN_EPI = false, bool SP2 = false>
__device__ __forceinline__ void gemm_phase(PG8_LAS unsigned char* lds, const Gemm g, const Sched& S, const Epi& E) {
    const int tid = threadIdx.x, wid = __builtin_amdgcn_readfirstlane(tid >> 6), lane = tid & 63, wr = wid >> 2, wc = wid & 3, fr = lane & 15, fq = lane >> 4;
    const int K = g.K, nt = K / BK;
    unsigned voffA[2], voffB[2];
#pragma unroll
    for (int i = 0; i < 2; ++i) { int R, C; stage_rc(tid * 16 + i * 8192, R, C); const int Rb = Epi::PERM ? ((R & ~31) + perm32(R & 31)) : R;
        voffA[i] = (unsigned)(R * K + C) * 2u; voffB[i] = (unsigned)(Rb * K + C) * 2u; }
    const size_t kstep = (size_t)(BK * 2);
    const size_t hstep = (size_t)HALF * K * 2;
    const size_t tstep = 2 * hstep;
    const unsigned ldsw = (unsigned)wid * 1024u;
    const int aoff = lds_byte(wr * 64 + fr, fq * 8), boff = lds_byte(wc * 32 + fr, fq * 8);
#define PG8_SA(b, h) (((b) * 2 + (h)) * HTB)
#define PG8_SB(b, h) ((4 + (b) * 2 + (h)) * HTB)
#define PG8_STAGE(bufoff, gbase, voff) do { _Pragma("unroll") for (int _i = 0; _i < 2; ++_i) \
        __builtin_amdgcn_global_load_lds((const unsigned*)((const char*)(gbase) + (voff)[_i]), (PG8_LAS unsigned*)(lds + (bufoff) + ldsw + _i * 8192), 16, 0, 0); } while (0)
#define PG8_LDA(dst, b, h) do { _Pragma("unroll") for (int m = 0; m < 4; ++m) _Pragma("unroll") for (int k = 0; k < 2; ++k) dst[m][k] = *(const PG8_LAS bf16x8*)(lds + PG8_SA(b, h) + aoff + m * 2048 + k * 1024); } while (0)
#define PG8_LDB(dst, b, h) do { _Pragma("unroll") for (int n = 0; n < 2; ++n) _Pragma("unroll") for (int k = 0; k < 2; ++k) dst[n][k] = *(const PG8_LAS bf16x8*)(lds + PG8_SB(b, h) + boff + n * 2048 + k * 1024); } while (0)
#define PG8_MMA(ai, bj, At, Bt) do { __builtin_amdgcn_s_setprio(1); _Pragma("unroll") for (int m = 0; m < 4; ++m) _Pragma("unroll") for (int n = 0; n < 2; ++n) _Pragma("unroll") for (int k = 0; k < 2; ++k) \
        acc[ai][bj][m][n] = __builtin_amdgcn_mfma_f32_16x16x32_bf16(Bt[n][k], At[m][k], acc[ai][bj][m][n], 0, 0, 0); __builtin_amdgcn_s_setprio(0); } while (0)
#define PG8_WAIT_V(n) asm volatile("s_waitcnt vmcnt(" #n ")" ::: "memory")
#define PG8_WAIT_L(n) asm volatile("s_waitcnt lgkmcnt(" #n ")" ::: "memory")
#define PG8_BAR __builtin_amdgcn_s_barrier()
#define PG8_SCHED __builtin_amdgcn_sched_barrier(0)
    Unit cur, nxt; int ui = 0;
    if (!S.next(0, cur)) return;
    f32x4 acc[2][2][4][2];
#pragma unroll
    for (int a = 0; a < 2; ++a)
#pragma unroll
        for (int b = 0; b < 2; ++b)
#pragma unroll
            for (int m = 0; m < 4; ++m)
#pragma unroll
                for (int n = 0; n < 2; ++n) acc[a][b][m][n] = (f32x4){0.f, 0.f, 0.f, 0.f};
    bf16x8 At[4][2], B0[2][2], B1[2][2];
    const char* cA = (const char*)g.A + (size_t)cur.pm * tstep; const char* cB = (const char*)g.Bt + (size_t)cur.pn * tstep;
    S.a_ready(cur);
    if constexpr (SP2) {
        PG8_STAGE(PG8_SB(0, 0), cB, voffB); PG8_STAGE(PG8_SB(0, 1), cB + hstep, voffB); PG8_STAGE(PG8_SA(0, 0), cA, voffA); PG8_STAGE(PG8_SA(0, 1), cA + hstep, voffA);
        if (wr == 1) PG8_BAR;
        PG8_WAIT_V(2); PG8_BAR;
        PG8_STAGE(PG8_SB(1, 0), cB + kstep, voffB); PG8_STAGE(PG8_SA(1, 0), cA + kstep, voffA); PG8_STAGE(PG8_SB(1, 1), cB + hstep + kstep, voffB);
        PG8_WAIT_V(6); PG8_BAR;
    } else {
        PG8_STAGE(PG8_SB(0, 0), cB, voffB); PG8_STAGE(PG8_SA(0, 0), cA, voffA); PG8_STAGE(PG8_SB(0, 1), cB + hstep, voffB); PG8_STAGE(PG8_SA(0, 1), cA + hstep, voffA);
        if (wr == 1) PG8_BAR;
        PG8_WAIT_V(4); PG8_BAR;
        PG8_STAGE(PG8_SB(1, 0), cB + kstep, voffB); PG8_STAGE(PG8_SA(1, 0), cA + kstep, voffA); PG8_STAGE(PG8_SB(1, 1), cB + hstep + kstep, voffB);
        PG8_WAIT_V(6); PG8_BAR;
    }
    for (;;) {
        const bool has_next = S.next(ui + 1, nxt);
        const char* nA = has_next ? (const char*)g.A + (size_t)nxt.pm * tstep : cA; const char* nB = has_next ? (const char*)g.Bt + (size_t)nxt.pn * tstep : cB;
        for (int t = 0; t < nt; t += 2) {
            const bool last = (t == nt - 2);
            const char* a1 = cA + (size_t)(t + 1) * kstep;
            const char* a2 = last ? nA : cA + (size_t)(t + 2) * kstep; const char* b2 = last ? nB : cB + (size_t)(t + 2) * kstep;
            const char* a3 = a2 + kstep; const char* b3 = b2 + kstep;
            if (last && has_next) S.a_ready(nxt);
            if constexpr (SP2) {
            PG8_LDB(B0, 0, 0); PG8_LDB(B1, 0, 1); PG8_SCHED; PG8_LDA(At, 0, 0); PG8_STAGE(PG8_SA(1, 1), a1 + hstep, voffA);
            PG8_WAIT_V(8); PG8_WAIT_L(0); PG8_BAR; PG8_MMA(0, 0, At, B0); PG8_MMA(0, 1, At, B1); PG8_BAR; PG8_SCHED;
            PG8_LDA(At, 0, 1); PG8_STAGE(PG8_SB(0, 0), b2, voffB); PG8_STAGE(PG8_SB(0, 1), b2 + hstep, voffB); PG8_STAGE(PG8_SA(0, 0), a2, voffA);
            PG8_WAIT_V(8); PG8_WAIT_L(0); PG8_BAR; PG8_MMA(1, 0, At, B0); PG8_MMA(1, 1, At, B1); PG8_BAR; PG8_SCHED;
            PG8_LDB(B0, 1, 0); PG8_LDB(B1, 1, 1); PG8_SCHED; PG8_LDA(At, 1, 0); PG8_STAGE(PG8_SA(0, 1), a2 + hstep, voffA);
            PG8_WAIT_V(8); PG8_WAIT_L(0); PG8_BAR; PG8_MMA(0, 0, At, B0); PG8_MMA(0, 1, At, B1); PG8_BAR; PG8_SCHED;
            PG8_LDA(At, 1, 1); PG8_STAGE(PG8_SB(1, 0), b3, voffB); PG8_STAGE(PG8_SB(1, 1), b3 + hstep, voffB); PG8_STAGE(PG8_SA(1, 0), a3, voffA);
            PG8_WAIT_V(8); PG8_WAIT_L(0); PG8_BAR; PG8_MMA(1, 0, At, B0); PG8_MMA(1, 1, At, B1); PG8_BAR; PG8_SCHED;
            } else {
            PG8_LDB(B0, 0, 0); PG8_SCHED; PG8_LDA(At, 0, 0); PG8_STAGE(PG8_SA(1, 1), a1 + hstep, voffA);
            PG8_WAIT_L(8); PG8_BAR; PG8_WAIT_L(0); PG8_MMA(0, 0, At, B0); PG8_BAR; PG8_SCHED;
            PG8_LDB(B1, 0, 1); PG8_STAGE(PG8_SB(0, 0), b2, voffB);
            PG8_BAR; PG8_WAIT_L(0); PG8_MMA(0, 1, At, B1); PG8_BAR;
            PG8_LDA(At, 0, 1); PG8_STAGE(PG8_SA(0, 0), a2, voffA);
            PG8_BAR; PG8_WAIT_L(0); PG8_MMA(1, 0, At, B0); PG8_BAR; PG8_SCHED;
            PG8_STAGE(PG8_SB(0, 1), b2 + hstep, voffB);
            PG8_WAIT_V(6); PG8_BAR; PG8_MMA(1, 1, At, B1); PG8_BAR;
            PG8_LDB(B0, 1, 0); PG8_SCHED; PG8_LDA(At, 1, 0); PG8_STAGE(PG8_SA(0, 1), a2 + hstep, voffA);
            PG8_WAIT_L(8); PG8_BAR; PG8_WAIT_L(0); PG8_MMA(0, 0, At, B0); PG8_BAR; PG8_SCHED;
            PG8_LDB(B1, 1, 1); PG8_STAGE(PG8_SB(1, 0), b3, voffB);
            PG8_BAR; PG8_WAIT_L(0); PG8_MMA(0, 1, At, B1); PG8_BAR;
            PG8_LDA(At, 1, 1); PG8_STAGE(PG8_SA(1, 0), a3, voffA);
            PG8_BAR; PG8_WAIT_L(0); PG8_MMA(1, 0, At, B0); PG8_BAR; PG8_SCHED;
            PG8_STAGE(PG8_SB(1, 1), b3 + hstep, voffB);
            PG8_WAIT_V(6); PG8_BAR; PG8_MMA(1, 1, At, B1); PG8_BAR;
            }
        }
        if constexpr (ALIGN_EPI) { if (wr == 0) PG8_BAR; }
        if constexpr (!Epi::AFTER_DRAIN) { E(acc, cur, wr, wc, fr, fq); S.done(cur); }
        if (!has_next) break;
#pragma unroll
        for (int a = 0; a < 2; ++a)
#pragma unroll
            for (int b = 0; b < 2; ++b)
#pragma unroll
                for (int m = 0; m < 4; ++m)
#pragma unroll
                    for (int n = 0; n < 2; ++n) acc[a][b][m][n] = (f32x4){0.f, 0.f, 0.f, 0.f};
        cur = nxt; cA = nA; cB = nB; ++ui;
        if constexpr (ALIGN_EPI) { if (wr == 1) PG8_BAR; }
    }
    PG8_WAIT_V(0);
    if constexpr (!ALIGN_EPI) { if (wr == 0) PG8_BAR; }
    PG8_BAR;
    if constexpr (Epi::AFTER_DRAIN) { E.fused(acc, cur, wr, wc, fr, fq, lds, wid, lane); S.done(cur); }
#undef PG8_SA
#undef PG8_SB
#undef PG8_STAGE
#undef PG8_LDA
#undef PG8_LDB
#undef PG8_MMA
#undef PG8_WAIT_V
#undef PG8_WAIT_L
#undef PG8_BAR
#undef PG8_SCHED
}
}
#include <hip/hip_bf16.h>
#include <cmath>
namespace attn_body {
using bf16=__hip_bfloat16;
using bf16x8=__attribute__((ext_vector_type(8)))short;
using s16x4=__attribute__((ext_vector_type(4)))short;
using f32x16=__attribute__((ext_vector_type(16)))float;
using u32x4=__attribute__((ext_vector_type(4)))unsigned;
constexpr int NHEAD=8,D=64,DM=NHEAD*D,OPITCH=1024;
constexpr int NW=8,QBLK=32,QB=QBLK*NW,KVBLK=64;
constexpr int ATTN_PITCH=DM, ATTN_UNIT_ROWS=QB;
__device__ __forceinline__ int crow(int r,int hi){return (r&3)+8*(r>>2)+4*hi;}
#define SBAR() __builtin_amdgcn_sched_barrier(0)
__device__ __forceinline__ void cmask(f32x16&p0,f32x16&p1,int jb,int qrel,int hi){
  const float NEG=-INFINITY; int kb=64*jb+4*hi;
  #pragma unroll
  for(int r=0;r<16;++r){int kv=kb+(r&3)+8*(r>>2); if(kv>qrel)p0[r]=NEG; if(kv+32>qrel)p1[r]=NEG;}
}

constexpr int NSLOT=3, SLOTB=8192;
constexpr int LDS_K=0, LDS_V=NSLOT*SLOTB, LDS_WS=2*NSLOT*SLOTB, LDS_OST=LDS_WS+NW*64*4, LDS_CB=LDS_OST+NW*4096, LDS_BYTES=LDS_CB+32768;
constexpr float C2=0.125f*1.4426950408889634f;
__device__ __forceinline__ void glds16(const void*gsrc,unsigned lds_dst){unsigned keep;
  asm volatile("s_mov_b32 %0, m0\n\ts_mov_b32 m0, %2\n\ts_nop 0\n\tglobal_load_lds_dwordx4 %1, off\n\ts_mov_b32 m0, %0":"=&s"(keep):"v"(gsrc),"s"(lds_dst):"memory");}
__device__ __forceinline__ float max3f(float a,float b,float c){float r;asm("v_max3_f32 %0, %1, %2, %3":"=v"(r):"v"(a),"v"(b),"v"(c));return r;}
__device__ __forceinline__ float max2f(float a,float b){float r;asm("v_max_f32_e32 %0, %1, %2":"=v"(r):"v"(a),"v"(b));return r;}
__device__ __forceinline__ float fadd_s(float a,float b){float r;asm("v_add_f32_e32 %0, %1, %2":"=v"(r):"v"(a),"v"(b));return r;}
__device__ __forceinline__ float fsub_s(float a,float b){float r;asm("v_sub_f32_e32 %0, %1, %2":"=v"(r):"v"(a),"v"(b));return r;}
typedef float f32x2_t __attribute__((ext_vector_type(2))); typedef float f32x4_t __attribute__((ext_vector_type(4))); typedef __bf16 bf16x2_t __attribute__((ext_vector_type(2)));
__device__ __forceinline__ unsigned cvtpk_s(float lo,float hi){f32x2_t v={lo,hi};bf16x2_t b=__builtin_convertvector(v,bf16x2_t);return __builtin_bit_cast(unsigned,b);}
#define WAIT_BAR(N) asm volatile("s_waitcnt vmcnt(" #N ") lgkmcnt(0)\n\ts_barrier":::"memory")

__device__ __forceinline__ void qkt(f32x16&p0,f32x16&p1,const char*Kslot,const bf16x8*qr,int r32,int hi){
  const char*kb=Kslot+hi*1024+r32*16;
  #pragma unroll
  for(int d0=0;d0<4;++d0){
    const bf16x8 b0=*reinterpret_cast<const bf16x8*>(kb+d0*2048);
    const bf16x8 b1=*reinterpret_cast<const bf16x8*>(kb+d0*2048+512);
    p0=__builtin_amdgcn_mfma_f32_32x32x16_bf16(b0,qr[d0],p0,0,0,0);p1=__builtin_amdgcn_mfma_f32_32x32x16_bf16(b1,qr[d0],p1,0,0,0);}
}
typedef __attribute__((address_space(3))) const char* lds_cptr;
typedef short v4i16_t __attribute__((ext_vector_type(4)));
__device__ __forceinline__ void kload8(bf16x8*kf,lds_cptr kp){
  kf[0]=*(const __attribute__((address_space(3))) bf16x8*)(kp);      kf[1]=*(const __attribute__((address_space(3))) bf16x8*)(kp+512);
  kf[2]=*(const __attribute__((address_space(3))) bf16x8*)(kp+2048); kf[3]=*(const __attribute__((address_space(3))) bf16x8*)(kp+2560);
  kf[4]=*(const __attribute__((address_space(3))) bf16x8*)(kp+4096); kf[5]=*(const __attribute__((address_space(3))) bf16x8*)(kp+4608);
  kf[6]=*(const __attribute__((address_space(3))) bf16x8*)(kp+6144); kf[7]=*(const __attribute__((address_space(3))) bf16x8*)(kp+6656);
}
__device__ __forceinline__ void kload2(bf16x8*kf,lds_cptr kp,int j){ kf[2*j]=*(const __attribute__((address_space(3))) bf16x8*)(kp+j*2048); kf[2*j+1]=*(const __attribute__((address_space(3))) bf16x8*)(kp+j*2048+512); }
__device__ __forceinline__ s16x4 vtr(lds_cptr p){ return __builtin_bit_cast(s16x4,__builtin_amdgcn_ds_read_tr16_b64_v4i16((__attribute__((address_space(3))) v4i16_t*)p)); }
__device__ __forceinline__ float rowmax(const f32x16&p0,const f32x16&p1){
  float a=max3f(p0[0],p0[1],p1[0]),b=max3f(p0[2],p0[3],p1[1]);a=max3f(a,p1[2],p1[3]);
  #pragma unroll
  for(int r=4;r<16;r+=4){a=max3f(a,p0[r],p0[r+1]);b=max3f(b,p0[r+2],p0[r+3]);a=max3f(a,p1[r],p1[r+1]);b=max3f(b,p1[r+2],p1[r+3]);}
  const float m=max2f(a,b);
  auto rr=__builtin_amdgcn_permlane32_swap(__float_as_uint(m),__float_as_uint(m),false,false);
  return max2f(__uint_as_float(rr[0]),__uint_as_float(rr[1]));
}
__device__ __forceinline__ void pv(f32x16*o,int vb,bf16x8 pa0,bf16x8 pa1,bf16x8 pa2,bf16x8 pa3){
  #pragma unroll
  for(int d0=0;d0<2;++d0){s16x4 lo[4],hi[4];
    #pragma unroll
    for(int ks=0;ks<4;++ks){
      asm volatile("ds_read_b64_tr_b16 %0,%1 offset:%c2":"=&v"(lo[ks]):"v"(vb),"i"(d0*4096+ks*1024):"memory");
      asm volatile("ds_read_b64_tr_b16 %0,%1 offset:%c2":"=&v"(hi[ks]):"v"(vb),"i"(d0*4096+ks*1024+512):"memory");}
    asm volatile("s_waitcnt lgkmcnt(0)":::"memory");SBAR();
    #define PK(k) (bf16x8){lo[k][0],lo[k][1],lo[k][2],lo[k][3],hi[k][0],hi[k][1],hi[k][2],hi[k][3]}
    o[d0]=__builtin_amdgcn_mfma_f32_32x32x16_bf16(pa0,PK(0),o[d0],0,0,0);
    o[d0]=__builtin_amdgcn_mfma_f32_32x32x16_bf16(pa1,PK(1),o[d0],0,0,0);
    o[d0]=__builtin_amdgcn_mfma_f32_32x32x16_bf16(pa2,PK(2),o[d0],0,0,0);
    o[d0]=__builtin_amdgcn_mfma_f32_32x32x16_bf16(pa3,PK(3),o[d0],0,0,0);
    #undef PK
  }
}

#ifndef ATTN_STORE16
#define ATTN_STORE16(p,v) (*(u32x4*)(p)=(v))
#endif
template<int THRL> __device__ __forceinline__ void attn_unit(const bf16*Qb,const bf16*__restrict__ Kh,const bf16*__restrict__ Vh,bf16*Ob,int NT,int NTE,const float*cgp,int q0,int wlo,int whi,char*shm){
  int tid_=threadIdx.x; asm volatile("":"+v"(tid_)); const int tid=tid_,lane=tid&63,r32=lane&31,hi=lane>>5; const int wid=__builtin_amdgcn_readfirstlane(tid>>6);
  const bf16*Qw=Qb+(long)(wid*QBLK)*DM;
  const unsigned lds0=(unsigned)(uintptr_t)shm;
  float*wsf=(float*)(shm+LDS_WS)+wid*64;
  const bf16*ksrc=Kh+(long)((NT-1)*KVBLK+lane)*DM+wid*8;
  const bf16*vsrc=Vh+(long)((NT-1)*KVBLK+16*(wid&3)+(lane>>2))*DM+(wid>>2)*32+(lane&3)*8;
  const unsigned kdst=lds0+LDS_K+wid*1024, vdst=lds0+LDS_V+wid*1024;
  #define DMA_K(t,slot) glds16(ksrc-(long)(t)*KVBLK*DM,(unsigned)__builtin_amdgcn_readfirstlane(kdst+(slot)))
  #define DMA_V(t,slot) glds16(vsrc-(long)(t)*KVBLK*DM,(unsigned)__builtin_amdgcn_readfirstlane(vdst+(slot)))
  const int vb0=(int)(lds0+LDS_V)+((lane>>4)&1)*32+(lane&3)*8+(4*hi+((lane&15)>>2))*64;
  const char*Kbase=shm+LDS_K; bf16x8 kf[8];
  const lds_cptr shm3=(lds_cptr)shm; const lds_cptr kp0=shm3+LDS_K+hi*1024+r32*16; const lds_cptr vp0=shm3+LDS_V+((lane>>4)&1)*32+(lane&3)*8+(4*hi+((lane&15)>>2))*64;
  { typedef __attribute__((address_space(3))) float lf_t; lf_t* cbw=(lf_t*)((lds_cptr)shm+LDS_CB); const float c0=cgp[q0]; const int jlo=(NT-NTE)*KVBLK, jhi=NT*KVBLK;
    for(int j=jlo+tid;j<jhi;j+=NW*64) cbw[j]=c0-cgp[j]; }
  const __attribute__((address_space(3))) float* cbL=(const __attribute__((address_space(3))) float*)((lds_cptr)shm+LDS_CB)+4*hi;
  #define CBLOAD(C0,C1,t,MH) do{ const __attribute__((address_space(3))) float* cbp_=cbL+(NT-1-(t))*KVBLK; \
    _Pragma("unroll") for(int g_=0;g_<4;++g_){ const f32x4_t v0_=*(const __attribute__((address_space(3))) f32x4_t*)(cbp_+8*g_); const f32x4_t v1_=*(const __attribute__((address_space(3))) f32x4_t*)(cbp_+32+8*g_); \
      C0[4*g_]=v0_[0]-(MH);C0[4*g_+1]=v0_[1]-(MH);C0[4*g_+2]=v0_[2]-(MH);C0[4*g_+3]=v0_[3]-(MH); C1[4*g_]=v1_[0]-(MH);C1[4*g_+1]=v1_[1]-(MH);C1[4*g_+2]=v1_[2]-(MH);C1[4*g_+3]=v1_[3]-(MH);} }while(0)
  DMA_K(0,0);DMA_V(0,0);DMA_K(1,SLOTB);
  bf16x8 qr[4];
  #pragma unroll
  for(int d0=0;d0<4;++d0)qr[d0]=*reinterpret_cast<const bf16x8*>(&Qw[(long)r32*DM+d0*16+hi*8]);
  float mhat=0.f,l_reg=0.f;f32x16 o[2];o[0]=f32x16{};o[1]=f32x16{};
  const int qrel=wid*QBLK+r32;
  #define CMASK(P0,P1,t) do{int jb_=3-(t); if(jb_>=0)cmask(P0,P1,jb_,qrel,hi);}while(0)
  bool resc=false;
  #define START(P0,P1) do{ const float rm=rowmax(P0,P1); resc=false; \
    { const float dl=(rm>-1e30f)?rm:0.f; mhat=fadd_s(mhat,dl); \
      _Pragma("unroll") for(int r=0;r<16;++r){P0[r]=fsub_s(P0[r],dl);P1[r]=fsub_s(P1[r],dl);} } \
    _Pragma("unroll") for(int r=0;r<16;++r)P0[r]=__builtin_amdgcn_exp2f(P0[r]); }while(0)
  #define RESC() do{ if(resc){ asm volatile("s_waitcnt lgkmcnt(0)":::"memory"); \
      _Pragma("unroll") for(int d_=0;d_<2;++d_) _Pragma("unroll") for(int r=0;r<16;++r)o[d_][r]*=wsf[crow(r,hi)]; } }while(0)
  f32x16 pA0,pA1,pB0,pB1;
  int sl_prev=0,sl_cur=0,sl_next=SLOTB;
  #define ROT() do{sl_prev=sl_cur;sl_cur=sl_next;sl_next=(sl_next==(NSLOT-1)*SLOTB)?0:sl_next+SLOTB;}while(0)
  DMA_K(2,2*SLOTB);
  WAIT_BAR(3);
  CBLOAD(pA0,pA1,0,0.f); qkt(pA0,pA1,Kbase,qr,r32,hi);asm volatile("s_nop 15\n\ts_nop 7":"+v"(pA0),"+v"(pA1));CMASK(pA0,pA1,0);
  START(pA0,pA1);
  _Pragma("unroll") for(int r=0;r<16;++r)pA1[r]=__builtin_amdgcn_exp2f(pA1[r]);
  WAIT_BAR(0);
  DMA_K(3,0);DMA_V(1,SLOTB);
  ROT();
  kload8(kf,kp0+sl_cur);
  WAIT_BAR(2);
  s16x4 vlo[8],vhi[8]; u32x4 pw0,pw1,pw2,pw3;
  #define PKW(P,B) cvtpk_s(P[B],P[B+1])
  #define PAF(k) __builtin_bit_cast(bf16x8,pw##k)
  #define VFR(i) (bf16x8){vlo[i][0],vlo[i][1],vlo[i][2],vlo[i][3],vhi[i][0],vhi[i][1],vhi[i][2],vhi[i][3]}
  #define PIN(x) asm volatile("":"+v"(x))
  #define MX3(a,b,c) __builtin_fmaxf(__builtin_fmaxf((a),(b)),(c))
  #define GAPA(MF,A0,A1,A2,A3,W0,W1,PW) do{ MF; sacc+=A0; sacc+=A1; sacc+=A2; sacc+=A3; PIN(sacc); W0; W1; PIN(PW); SBAR(); }while(0)
  #define EX(v) __builtin_amdgcn_exp2f(v)
  #define GAPB(MF,X,B) do{ MF; X[B]=EX(X[B]); X[B+1]=EX(X[B+1]); X[B+2]=EX(X[B+2]); X[B+3]=EX(X[B+3]); PIN(X); SBAR(); }while(0)
  #define VRD(i) do{ vlo[i]=vtr(vp_+(((i)>>2)*4096+((i)&3)*1024)); vhi[i]=vtr(vp_+(((i)>>2)*4096+((i)&3)*1024+512)); }while(0)
  #define KRD(G,j) do{ if(G){ kload2(kf,kp0+sl_next,j); SBAR(); } }while(0)
  #define STEP(C0,C1,P0,P1,t,GK,GV,GL) do{ SBAR(); \
    const lds_cptr vp_=vp0+sl_prev; CBLOAD(C0,C1,t,mhat); SBAR(); \
    VRD(0); SBAR(); float sacc=(P0[0]+P0[1]); \
    GAPA(C0=__builtin_amdgcn_mfma_f32_32x32x16_bf16(kf[0],qr[0],C0,0,0,0), P0[2],P0[3],P0[4],P0[5],     pw0[0]=PKW(P0,0), pw0[1]=PKW(P0,2), pw0); \
    VRD(4); SBAR(); GAPA(C1=__builtin_amdgcn_mfma_f32_32x32x16_bf16(kf[1],qr[0],C1,0,0,0), P0[6],P0[7],P0[8],P0[9],     pw0[2]=PKW(P0,4), pw0[3]=PKW(P0,6), pw0); \
    VRD(1); SBAR(); GAPA(C0=__builtin_amdgcn_mfma_f32_32x32x16_bf16(kf[2],qr[1],C0,0,0,0),   P0[10],P0[11],P0[12],P0[13], pw1[0]=PKW(P0,8), pw1[1]=PKW(P0,10), pw1); \
    VRD(5); SBAR(); GAPA(C1=__builtin_amdgcn_mfma_f32_32x32x16_bf16(kf[3],qr[1],C1,0,0,0),   P0[14],P0[15],P1[0],P1[1],   pw1[2]=PKW(P0,12),pw1[3]=PKW(P0,14), pw1); \
    VRD(2); SBAR(); GAPA(C0=__builtin_amdgcn_mfma_f32_32x32x16_bf16(kf[4],qr[2],C0,0,0,0),   P1[2],P1[3],P1[4],P1[5],     pw2[0]=PKW(P1,0), pw2[1]=PKW(P1,2), pw2); \
    VRD(6); SBAR(); GAPA(C1=__builtin_amdgcn_mfma_f32_32x32x16_bf16(kf[5],qr[2],C1,0,0,0),   P1[6],P1[7],P1[8],P1[9],     pw2[2]=PKW(P1,4), pw2[3]=PKW(P1,6), pw2); \
    VRD(3); SBAR(); GAPA(C0=__builtin_amdgcn_mfma_f32_32x32x16_bf16(kf[6],qr[3],C0,0,0,0),   P1[10],P1[11],P1[12],P1[13], pw3[0]=PKW(P1,8), pw3[1]=PKW(P1,10), pw3); \
    VRD(7); SBAR(); GAPA(C1=__builtin_amdgcn_mfma_f32_32x32x16_bf16(kf[7],qr[3],C1,0,0,0),   P1[14],P1[15],0.f,0.f,       pw3[2]=PKW(P1,12),pw3[3]=PKW(P1,14), pw3); \
    l_reg+=sacc; \
    if(GK){DMA_K((t)+3,sl_cur);} if(GV){DMA_V((t)+1,sl_next);} \
    CMASK(C0,C1,t); \
    { float a=MX3(C0[0],C0[1],C1[0]),b=MX3(C0[2],C0[3],C1[1]); a=MX3(a,C1[2],C1[3]); \
      _Pragma("unroll") for(int r=4;r<16;r+=4){a=MX3(a,C0[r],C0[r+1]);b=MX3(b,C0[r+2],C0[r+3]);a=MX3(a,C1[r],C1[r+1]);b=MX3(b,C1[r+2],C1[r+3]);} \
      float rm=__builtin_fmaxf(a,b); { auto rr=__builtin_amdgcn_permlane32_swap(__float_as_uint(rm),__float_as_uint(rm),false,false); rm=__builtin_fmaxf(__uint_as_float(rr[0]),__uint_as_float(rr[1])); } \
      resc=false; \
      if(__builtin_expect(__any(rm>(float)THRL),0)){ const float dl=__builtin_fmaxf(rm,0.f); mhat+=dl; \
        _Pragma("unroll") for(int r=0;r<16;++r){C0[r]-=dl;C1[r]-=dl;} \
        const float f=__builtin_amdgcn_exp2f(-dl); l_reg*=f; if(hi==0)wsf[r32]=f; resc=true; } } \
    SBAR(); \
    GAPB(o[0]=__builtin_amdgcn_mfma_f32_32x32x16_bf16(PAF(0),VFR(0),o[0],0,0,0), C0,0); \
    GAPB(o[1]=__builtin_amdgcn_mfma_f32_32x32x16_bf16(PAF(0),VFR(4),o[1],0,0,0), C0,4); \
    KRD(GL,0); GAPB(o[0]=__builtin_amdgcn_mfma_f32_32x32x16_bf16(PAF(1),VFR(1),o[0],0,0,0), C0,8); \
    KRD(GL,1); GAPB(o[1]=__builtin_amdgcn_mfma_f32_32x32x16_bf16(PAF(1),VFR(5),o[1],0,0,0), C0,12); \
    KRD(GL,2); GAPB(o[0]=__builtin_amdgcn_mfma_f32_32x32x16_bf16(PAF(2),VFR(2),o[0],0,0,0), C1,0); \
    KRD(GL,3); GAPB(o[1]=__builtin_amdgcn_mfma_f32_32x32x16_bf16(PAF(2),VFR(6),o[1],0,0,0), C1,4); \
    GAPB(o[0]=__builtin_amdgcn_mfma_f32_32x32x16_bf16(PAF(3),VFR(3),o[0],0,0,0), C1,8); \
    GAPB(o[1]=__builtin_amdgcn_mfma_f32_32x32x16_bf16(PAF(3),VFR(7),o[1],0,0,0), C1,12); \
    }while(0)
  int t=1;
  for(;t<5&&t+5<NTE;t+=2){
    STEP(pB0,pB1,pA0,pA1,t,true,true,true);     WAIT_BAR(2); RESC(); ROT();
    STEP(pA0,pA1,pB0,pB1,t+1,true,true,true);   WAIT_BAR(2); RESC(); ROT();
  }
  #undef CMASK
  #define CMASK(P0,P1,t) do{}while(0)
  for(;t+5<NTE;t+=2){
    STEP(pB0,pB1,pA0,pA1,t,true,true,true);     WAIT_BAR(2); RESC(); ROT();
    STEP(pA0,pA1,pB0,pB1,t+1,true,true,true);   WAIT_BAR(2); RESC(); ROT();
  }
  #undef CMASK
  #define CMASK(P0,P1,t) do{int jb_=3-(t); if(jb_>=0)cmask(P0,P1,jb_,qrel,hi);}while(0)
  #define ENDW(tt) do{ if((tt)+3<NTE){WAIT_BAR(2);} else if((tt)+2<NTE){WAIT_BAR(1);} else {WAIT_BAR(0);} }while(0)
  for(;t+1<NTE;t+=2){
    STEP(pB0,pB1,pA0,pA1,t,(t+3<NTE),(t+1<NTE),(t+1<NTE));       ENDW(t);   RESC(); ROT();
    STEP(pA0,pA1,pB0,pB1,t+1,(t+4<NTE),(t+2<NTE),(t+2<NTE));     ENDW(t+1); RESC(); ROT();
  }
  STEP(pB0,pB1,pA0,pA1,NTE-1,false,false,false); RESC();
  { float sacc=pB0[0]+pB0[1]; _Pragma("unroll") for(int r=2;r<16;++r)sacc+=pB0[r]; _Pragma("unroll") for(int r=0;r<16;++r)sacc+=pB1[r]; l_reg+=sacc;
    pw0=(u32x4){PKW(pB0,0),PKW(pB0,2),PKW(pB0,4),PKW(pB0,6)};pw1=(u32x4){PKW(pB0,8),PKW(pB0,10),PKW(pB0,12),PKW(pB0,14)};pw2=(u32x4){PKW(pB1,0),PKW(pB1,2),PKW(pB1,4),PKW(pB1,6)};pw3=(u32x4){PKW(pB1,8),PKW(pB1,10),PKW(pB1,12),PKW(pB1,14)};
    SBAR(); pv(o,vb0+sl_cur,PAF(0),PAF(1),PAF(2),PAF(3)); }
  #undef PKW
  #undef PAF
  #undef VFR
  #undef PIN
  #undef MX3
  #undef GAPA
  #undef GAPB
  #undef EX
  #undef VRD
  #undef KRD
  #undef STEP
  #undef ENDW
  {auto rr=__builtin_amdgcn_permlane32_swap(__float_as_uint(l_reg),__float_as_uint(l_reg),false,false);l_reg=__uint_as_float(rr[0])+__uint_as_float(rr[1]);}
  if(hi==0)wsf[32+r32]=l_reg;asm volatile("s_waitcnt lgkmcnt(0)":::"memory");
  float rli[16];
  #pragma unroll
  for(int r=0;r<16;++r)rli[r]=__builtin_amdgcn_rcpf(wsf[32+crow(r,hi)]);
  bf16*Ow=Ob+(long)(wid*QBLK)*OPITCH;
  { bf16*stg=(bf16*)(shm+LDS_OST)+wid*2048;
    #pragma unroll
    for(int r=0;r<16;++r){const int orow=crow(r,hi);
      #pragma unroll
      for(int d0=0;d0<2;++d0)stg[orow*64+d0*32+r32]=__float2bfloat16(o[d0][r]*rli[r]);}
    asm volatile("s_waitcnt lgkmcnt(0)":::"memory");
    #pragma unroll
    for(int i=0;i<4;++i){const int row=i*8+(lane>>3),ch=lane&7; const u32x4 v=*(const u32x4*)(stg+row*64+ch*8); if(wid>=wlo&&wid<whi)ATTN_STORE16(Ow+(long)row*OPITCH+ch*8,v);} }
  asm volatile("s_waitcnt lgkmcnt(0)\n\ts_barrier":::"memory");
  #undef DMA_K
  #undef DMA_V
  #undef CMASK
  #undef START
  #undef RESC
  #undef ROT
  #undef CBLOAD
}
constexpr int ATTN_LDS_BYTES=LDS_BYTES;
#undef SBAR
#undef WAIT_BAR
}
#include <hip/hip_cooperative_groups.h>
namespace cg = cooperative_groups;
#ifndef MK_N_LAUNCHES
#define MK_N_LAUNCHES 1
#endif
#ifndef FOX_PRUNE
#define FOX_PRUNE 1
#endif
constexpr int NWAVES = 8, NTHR = 512;
constexpr int DMOD = 1024, TSEQ = 8192, NBATCH = 8, MP = NBATCH * TSEQ, MS = 512, MTOT = MP + MS;
constexpr int NIN = 3584, INC = 3592, FF = 4096, SSEQ = 1152, PAST = 1024, DSEQ = 32;
constexpr int NCHUNK = MTOT / 64;
constexpr float EPSN = 1e-6f, LOG2E = 1.4426950408889634f;
constexpr size_t MiB = 1u << 20;
constexpr size_t WS_CTL = 0, CTL_ZERO_BYTES = 4096;
constexpr size_t WS_WIN = 2 * MiB, WS_WO = 9 * MiB, WS_WUP = 11 * MiB, WS_WDN = 19 * MiB;
constexpr size_t WS_RSTD = 27 * MiB, WS_CGP = 28 * MiB, WS_CGS = 30 * MiB, WS_VEC = 31 * MiB, WS_SSQ = 38 * MiB;
constexpr size_t WS_X1B = 44 * MiB, WS_MIX = 174 * MiB, WS_H = 304 * MiB;
constexpr size_t WS_XB = 304 * MiB, WS_Q = 434 * MiB, WS_K = 498 * MiB, WS_V = 562 * MiB, WS_QS = 626 * MiB, WS_KS = 635 * MiB, WS_VS = 644 * MiB;
constexpr size_t WS_QR = 654 * MiB, WS_KR = 719 * MiB, WS_VH = 784 * MiB, WS_SG = 849 * MiB, WS_END = 914 * MiB;
constexpr size_t VECN = (size_t)NCHUNK * 512;
static_assert(WS_VEC + 3 * VECN * 4 <= WS_SSQ && WS_SSQ + (size_t)MTOT * 16 * 4 <= WS_X1B && WS_X1B + (size_t)MTOT * DMOD * 2 <= WS_MIX && WS_MIX + (size_t)MTOT * DMOD * 2 <= WS_H, "ws map");
static_assert(WS_H + (size_t)MTOT * FF * 2 <= WS_END && WS_XB + (size_t)MTOT * DMOD * 2 <= WS_Q && WS_SG + (size_t)MTOT * 512 * 2 <= WS_END, "ws map 2");
constexpr int CW_QUEUE = 64, CW_SUB = 128, NCHAINWG = 32;
constexpr size_t O_YP = 0, O_YS = O_YP + (size_t)MP * DMOD, O_KP = O_YS + (size_t)256 * DMOD, O_VP = O_KP + (size_t)MP * 512, O_LP = O_VP + (size_t)MP * 512,
                 O_HP = O_LP + (size_t)MP * 8, O_KS = O_HP + 524288, O_VS = O_KS + 131072, O_LS = O_VS + 131072, O_HS = O_LS + 2048, O_END = O_HS + 524288;
constexpr int RING_BYTES = 131072, MISC_OFF = RING_BYTES, LDS_BYTES = 135168;
static_assert(attn_body::ATTN_LDS_BYTES <= RING_BYTES, "attention LDS");

#define LAS __attribute__((address_space(3)))
typedef unsigned short bf16;
typedef unsigned v4u __attribute__((ext_vector_type(4)));
typedef unsigned v2u __attribute__((ext_vector_type(2)));
typedef float f32x4 __attribute__((ext_vector_type(4)));
typedef short bf16x8 __attribute__((ext_vector_type(8)));
#define LDS_WAIT() asm volatile("s_waitcnt lgkmcnt(0)" ::: "memory")
__device__ __forceinline__ unsigned pk2(float lo, float hi) { return pg8::cvt_pk_bf16(lo, hi); }
__device__ __forceinline__ float bf2f(unsigned short b) { return __uint_as_float(((unsigned)b) << 16); }
__device__ __forceinline__ float wave_sum(float v) {
#pragma unroll
    for (int o = 1; o < 64; o <<= 1) v += __shfl_xor(v, o);
    return v;
}
__device__ __forceinline__ bool row_map(int row, int& idx) { if (row < MP) { idx = row; return true; } const int rs = row - MP; idx = (rs >> 6) * 32 + (rs & 63); return (rs & 63) < 32; }

namespace pg8 {
struct OrderIn {
    StaticOrder so; int pn_off, extra, extra_pm0;
    __device__ bool next(int i, Unit& u) const {
        const long L = (long)i * so.G + so.c;
        if (L < so.nwg) { so.next(i, u); u.pn += pn_off; return true; }
        const long e = L - so.nwg; if (e >= extra) return false;
        u.pm = extra_pm0 + (int)(e >> 3); u.pn = (int)(e & 7); return true;
    }
    __device__ __forceinline__ void a_ready(const Unit&) const {}
    __device__ __forceinline__ void done(const Unit&) const {}
};
#define DPP_SHR(v, n) __int_as_float(__builtin_amdgcn_update_dpp(0, __float_as_int(v), 0x110 + (n), 0xf, 0xf, false))
struct EpiIn {
    static constexpr bool PERM = false, AFTER_DRAIN = false;
    const float* rstd1; const float* lbl; const float* qg; const float* kg; unsigned char* ws; float* out;
    __device__ __forceinline__ void operator()(const f32x4 (&acc)[2][2][4][2], const Unit& u, int wr, int wc, int fr, int fq) const {
        const int pn = u.pn, rowb = u.pm * BM + wr * 64 + fr; const bool samp = u.pm >= (MP / BM);
        bf16_t* const QR = (bf16_t*)(ws + WS_QR); bf16_t* const KR = (bf16_t*)(ws + WS_KR); bf16_t* const VH = (bf16_t*)(ws + WS_VH); bf16_t* const SG = (bf16_t*)(ws + WS_SG); float* const vec = (float*)(ws + WS_VEC);
        float rs[2][4];
#pragma unroll
        for (int ai = 0; ai < 2; ++ai)
#pragma unroll
            for (int m = 0; m < 4; ++m) rs[ai][m] = rstd1[rowb + ai * HALF + m * 16];
        if (pn < 4) {
            const int h = pn, ch0 = 128 * h + 32 * wc + 4 * fq; const int lane = threadIdx.x & 63; const int a15 = ((lane & 48) | 15) << 2;
#pragma unroll
            for (int n = 0; n < 2; ++n) {
                const f32x4 l0 = *(const f32x4*)(lbl + ch0 + 16 * n), l1 = *(const f32x4*)(lbl + 512 + ch0 + 16 * n);
                f32x4 lb, omlb;
#pragma unroll
                for (int j = 0; j < 4; ++j) { lb[j] = 1.f / (1.f + __expf(l1[j] - l0[j])); omlb[j] = 1.f - lb[j]; }
#pragma unroll
                for (int ai = 0; ai < 2; ++ai) {
                    f32x4 bq[4], kk[4], bb[4]; f32x4 carry = {0.f, 0.f, 0.f, 0.f};
#pragma unroll
                    for (int m = 0; m < 4; ++m) {
#pragma unroll
                        for (int j = 0; j < 4; ++j) {
                            const float zq = acc[ai][0][m][n][j] * rs[ai][m], zf = acc[ai][1][m][n][j] * rs[ai][m];
                            const float sig = 1.f / (1.f + __expf(-zf)); const float f = lb[j] + omlb[j] * sig; float k = omlb[j] * (1.f - sig); float s = __logf(f);
                            if (samp && m >= 2) { s = 0.f; k = 0.f; }
                            s += DPP_SHR(s, 1); s += DPP_SHR(s, 2); s += DPP_SHR(s, 4); s += DPP_SHR(s, 8);
                            s += carry[j]; carry[j] = __int_as_float(__builtin_amdgcn_ds_bpermute(a15, __float_as_int(s)));
                            bq[m][j] = zq; kk[m][j] = k; bb[m][j] = s;
                        }
                    }
#pragma unroll
                    for (int m = 0; m < 4; ++m) {
                        float qv[4], kv[4];
#pragma unroll
                        for (int j = 0; j < 4; ++j) { qv[j] = bq[m][j] * __expf(bb[m][j]); kv[j] = kk[m][j] * __expf(-bb[m][j]); }
                        const size_t off = (size_t)(rowb + ai * HALF + m * 16) * 512 + ch0 + 16 * n;
                        v2u wq; wq.x = cvt_pk_bf16(qv[0], qv[1]); wq.y = cvt_pk_bf16(qv[2], qv[3]); *(v2u*)(QR + off) = wq;
                        v2u wk; wk.x = cvt_pk_bf16(kv[0], kv[1]); wk.y = cvt_pk_bf16(kv[2], kv[3]); *(v2u*)(KR + off) = wk;
                    }
                    if (fr == 0) {
                        const size_t voff = (size_t)((u.pm * BM + ai * HALF + wr * 64) >> 6) * 512 + ch0 + 16 * n;
                        f32x4 d;
#pragma unroll
                        for (int j = 0; j < 4; ++j) d[j] = __expf(carry[j]);
                        *(f32x4*)(vec + voff) = d;
                    }
                }
            }
        } else if (pn < 8) {
            const int h = pn - 4, c0 = 128 * h + 32 * wc + 4 * fq;
#pragma unroll
            for (int ai = 0; ai < 2; ++ai)
#pragma unroll
                for (int m = 0; m < 4; ++m) { const size_t off = (size_t)(rowb + ai * HALF + m * 16) * 512 + c0; const float r = rs[ai][m];
#pragma unroll
                    for (int n = 0; n < 2; ++n) { const f32x4 v = acc[ai][0][m][n] * r; f32x4 g = acc[ai][1][m][n] * r;
#pragma unroll
                        for (int j = 0; j < 4; ++j) g[j] = g[j] / (1.f + __expf(-g[j]));
                        v2u wv; wv.x = cvt_pk_bf16(v[0], v[1]); wv.y = cvt_pk_bf16(v[2], v[3]); *(v2u*)(VH + off + 16 * n) = wv;
                        v2u wg; wg.x = cvt_pk_bf16(g[0], g[1]); wg.y = cvt_pk_bf16(g[2], g[3]); *(v2u*)(SG + off + 16 * n) = wg; } }
        } else if (pn < 12) {
            const bool isK = pn >= 10; const int head = 4 * ((pn - 8) & 1) + wc; const float* gain = isK ? kg : qg; const float osc = isK ? 1.f : attn_body::C2;
            f32x4 gv[2][2];
#pragma unroll
            for (int bj = 0; bj < 2; ++bj)
#pragma unroll
                for (int n = 0; n < 2; ++n) gv[bj][n] = *(const f32x4*)(gain + 32 * bj + 16 * n + 4 * fq) * osc;
#pragma unroll
            for (int ai = 0; ai < 2; ++ai)
#pragma unroll
                for (int m = 0; m < 4; ++m) { const int row = rowb + ai * HALF + m * 16; const float r = rs[ai][m]; float ssq = 0.f;
#pragma unroll
                    for (int bj = 0; bj < 2; ++bj)
#pragma unroll
                        for (int n = 0; n < 2; ++n) { const f32x4 z = acc[ai][bj][m][n] * r; ssq += (z[0] * z[0] + z[1] * z[1]) + (z[2] * z[2] + z[3] * z[3]); }
                    ssq += __shfl_xor(ssq, 16); ssq += __shfl_xor(ssq, 32);
                    const float r2 = r / sqrtf(ssq * (1.f / 64.f) + EPSN);
                    int idx; const bool valid = row_map(row, idx);
                    float* ofp = out + (samp ? O_KS : O_KP) + (size_t)idx * 512;
                    const size_t boff = samp ? (isK ? WS_KS : WS_QS) : (isK ? WS_K : WS_Q); const size_t brow = samp ? (size_t)((idx >> 5) * SSEQ + PAST + (idx & 31)) : (size_t)row;
                    bf16_t* bfp = (bf16_t*)(ws + boff) + brow * 512;
                    if (valid) {
#pragma unroll
                        for (int bj = 0; bj < 2; ++bj)
#pragma unroll
                            for (int n = 0; n < 2; ++n) { const f32x4 v = acc[ai][bj][m][n] * r2 * gv[bj][n]; const int col = 64 * head + 32 * bj + 16 * n + 4 * fq;
                                if (isK) *(f32x4*)(ofp + col) = v;
                                v2u w; w.x = cvt_pk_bf16(v[0], v[1]); w.y = cvt_pk_bf16(v[2], v[3]); *(v2u*)(bfp + col) = w; } } }
        } else {
            const int c0 = 256 * (pn - 12) + 32 * wc + 4 * fq;
#pragma unroll
            for (int ai = 0; ai < 2; ++ai)
#pragma unroll
                for (int m = 0; m < 4; ++m) { const int row = rowb + ai * HALF + m * 16; const float r = rs[ai][m];
                    int idx; const bool valid = row_map(row, idx);
                    float* ofp = out + (samp ? O_VS : O_VP) + (size_t)idx * 512;
                    const size_t brow = samp ? (size_t)((idx >> 5) * SSEQ + PAST + (idx & 31)) : (size_t)row;
                    bf16_t* bfp = (bf16_t*)(ws + (samp ? WS_VS : WS_V)) + brow * 512;
                    if (valid) {
#pragma unroll
                        for (int bj = 0; bj < 2; ++bj)
#pragma unroll
                            for (int n = 0; n < 2; ++n) { const f32x4 v = acc[ai][bj][m][n] * r; const int col = c0 + 128 * bj + 16 * n;
                                *(f32x4*)(ofp + col) = v;
                                v2u w; w.x = cvt_pk_bf16(v[0], v[1]); w.y = cvt_pk_bf16(v[2], v[3]); *(v2u*)(bfp + col) = w; } } }
        }
    }
};
struct EpiWo {
    static constexpr bool PERM = false, AFTER_DRAIN = false;
    const float* xp; const float* xs; float* yp; float* ys; bf16_t* X1B; float* ssq;
    __device__ __forceinline__ void operator()(const f32x4 (&acc)[2][2][4][2], const Unit& u, int wr, int wc, int fr, int fq) const {
        const int rowb = u.pm * BM + wr * 64 + fr, c0 = u.pn * BM + wc * 32 + 4 * fq; const bool samp = u.pm >= (MP / BM);
#pragma unroll
        for (int ai = 0; ai < 2; ++ai)
#pragma unroll
            for (int m = 0; m < 4; ++m) { const int row = rowb + ai * HALF + m * 16; int idx; const bool valid = row_map(row, idx);
                const float* xr = (samp ? xs : xp) + (size_t)idx * DMOD; float* yr = yp + (samp ? (size_t)MP * DMOD : (size_t)0) + (size_t)idx * DMOD; float s = 0.f;
#pragma unroll
                for (int bj = 0; bj < 2; ++bj)
#pragma unroll
                    for (int n = 0; n < 2; ++n) { const int col = c0 + 128 * bj + 16 * n; f32x4 v = acc[ai][bj][m][n];
                        if (valid) { v += *(const f32x4*)(xr + col); *(f32x4*)(yr + col) = v; }
                        s += (v[0] * v[0] + v[1] * v[1]) + (v[2] * v[2] + v[3] * v[3]);
                        v2u w; w.x = cvt_pk_bf16(v[0], v[1]); w.y = cvt_pk_bf16(v[2], v[3]); *(v2u*)(X1B + (size_t)row * DMOD + col) = w; }
                s += __shfl_xor(s, 16); s += __shfl_xor(s, 32);
                if (fq == 0) ssq[(size_t)row * 16 + 4 * u.pn + wc] = s; }
    }
};
struct EpiUp {
    static constexpr bool PERM = true, AFTER_DRAIN = false;
    bf16_t* O; const float* ssq;
    __device__ __forceinline__ void operator()(const f32x4 (&acc)[2][2][4][2], const Unit& u, int wr, int wc, int fr, int fq) const {
        const int row0 = u.pm * BM + wr * 64 + fr, col0 = u.pn * BM + wc * 32 + 8 * fq;
#pragma unroll
        for (int ai = 0; ai < 2; ++ai)
#pragma unroll
            for (int m = 0; m < 4; ++m) { const int row = row0 + ai * HALF + m * 16; const f32x4* sp = (const f32x4*)(ssq + (size_t)row * 16);
                const f32x4 s0 = sp[0], s1 = sp[1], s2 = sp[2], s3 = sp[3]; const f32x4 st = (s0 + s1) + (s2 + s3);
                const float r = 1.f / sqrtf(((st[0] + st[1]) + (st[2] + st[3])) * (1.f / DMOD) + EPSN);
                bf16_t* rowp = O + (size_t)row * FF + col0;
#pragma unroll
                for (int bj = 0; bj < 2; ++bj) { f32x4 v0 = acc[ai][bj][m][0] * r, v1 = acc[ai][bj][m][1] * r;
#pragma unroll
                    for (int j = 0; j < 4; ++j) { v0[j] = fmaxf(v0[j], 0.f); v0[j] *= v0[j]; v1[j] = fmaxf(v1[j], 0.f); v1[j] *= v1[j]; }
                    u32x4 w; w.x = cvt_pk_bf16(v0[0], v0[1]); w.y = cvt_pk_bf16(v0[2], v0[3]); w.z = cvt_pk_bf16(v1[0], v1[1]); w.w = cvt_pk_bf16(v1[2], v1[3]);
                    *(u32x4*)(rowp + bj * HALF) = w; } }
    }
};
struct EpiDown {
    static constexpr bool PERM = false, AFTER_DRAIN = false;
    float* yp; float* ys;
    __device__ __forceinline__ void operator()(const f32x4 (&acc)[2][2][4][2], const Unit& u, int wr, int wc, int fr, int fq) const {
        const int rowb = u.pm * BM + wr * 64 + fr, c0 = u.pn * BM + wc * 32 + 4 * fq; const bool samp = u.pm >= (MP / BM);
#pragma unroll
        for (int ai = 0; ai < 2; ++ai)
#pragma unroll
            for (int m = 0; m < 4; ++m) { const int row = rowb + ai * HALF + m * 16; int idx; const bool valid = row_map(row, idx);
                float* yr = yp + (samp ? (size_t)MP * DMOD : (size_t)0) + (size_t)idx * DMOD;
                if (valid) {
#pragma unroll
                    for (int bj = 0; bj < 2; ++bj)
#pragma unroll
                        for (int n = 0; n < 2; ++n) { const int col = c0 + 128 * bj + 16 * n; *(f32x4*)(yr + col) = *(const f32x4*)(yr + col) + acc[ai][bj][m][n]; } } }
    }
};
}

struct Args { const float* in[17]; float* out; unsigned char* ws; int ph_lo, ph_hi; };
struct Frame {
    LAS unsigned char* lds; volatile LAS unsigned* MISC; unsigned* ctl; unsigned char* ws; float* out;
    int tid, lane, wave, vcu, G;
    const float *xp, *xs, *ck, *cv, *clf, *sh, *n1, *win, *bff, *qg, *kg, *lbl, *hon, *wout, *n2, *wup, *wdn;
};

__device__ __forceinline__ int win_src_col(int g) {
    const int j0 = 32 * g, tile = j0 >> 8, jl = j0 & 255;
    if (tile < 4) return (jl < 128) ? (128 * tile + jl) : (512 + 128 * tile + (jl - 128));
    if (tile < 8) { const int h = tile - 4; return (jl < 128) ? (1024 + 128 * h + jl) : (1536 + 128 * h + (jl - 128)); }
    if (tile < 12) { const int base = tile < 10 ? 2048 : 2560, tl = (tile - 8) & 1, bj = jl >> 7, wc = (jl >> 5) & 3; return base + 64 * (4 * tl + wc) + 32 * bj; }
    return 3072 + (j0 - 12 * 256);
}
__device__ __forceinline__ void p0_transpose_item(const float* W, int ldw, int K, const float* nrm, bf16* WT, int n0, int src0, int k0, LAS float* scr, int lane) {
#pragma unroll 8
    for (int i = 0; i < 32; ++i) { const int kk = 2 * i + (lane >> 5); float v = W[(size_t)(k0 + kk) * ldw + src0 + (lane & 31)]; if (nrm) v *= nrm[k0 + kk]; scr[kk * 33 + (lane & 31)] = v; }
    LDS_WAIT(); asm volatile("" ::: "memory");
    const int c = lane & 7;
#pragma unroll
    for (int j = 0; j < 4; ++j) { const int n = (lane >> 3) + 8 * j; const LAS float* s = scr + (8 * c) * 33 + n;
        v4u o; o.x = pk2(s[0 * 33], s[1 * 33]); o.y = pk2(s[2 * 33], s[3 * 33]); o.z = pk2(s[4 * 33], s[5 * 33]); o.w = pk2(s[6 * 33], s[7 * 33]);
        *(v4u*)(WT + (size_t)(n0 + n) * K + k0 + 8 * c) = o; }
    LDS_WAIT(); asm volatile("" ::: "memory");
}
__device__ __forceinline__ void p0_prologue(Frame& F) {
    LAS float* scr = (LAS float*)(F.lds + F.wave * 16384);
    const int gw = F.vcu * NWAVES + F.wave, NGW = F.G * NWAVES, lane = F.lane;
    bf16* Win_t = (bf16*)(F.ws + WS_WIN); bf16* Wo_t = (bf16*)(F.ws + WS_WO); bf16* Wup_t = (bf16*)(F.ws + WS_WUP); bf16* Wdn_t = (bf16*)(F.ws + WS_WDN);
    constexpr int I_IN = 16 * (NIN / 32), I_O = 16 * 32, I_UP = 16 * (FF / 32), I_DN = 64 * 32, NITEMS = I_IN + I_O + I_UP + I_DN;
    for (int it = gw; it < NITEMS; it += NGW) {
        int r = it;
        if (r < I_IN) { const int kb = r / (NIN / 32), g = r % (NIN / 32); p0_transpose_item(F.win, INC, DMOD, F.n1, Win_t, 32 * g, win_src_col(g), 64 * kb, scr, lane); continue; } r -= I_IN;
        if (r < I_O) { const int kb = r / 32, g = r % 32; p0_transpose_item(F.wout, DMOD, DMOD, nullptr, Wo_t, 32 * g, 32 * g, 64 * kb, scr, lane); continue; } r -= I_O;
        if (r < I_UP) { const int kb = r / (FF / 32), g = r % (FF / 32); p0_transpose_item(F.wup, FF, DMOD, F.n2, Wup_t, 32 * g, 32 * g, 64 * kb, scr, lane); continue; } r -= I_UP;
        { const int kb = r / 32, g = r % 32; p0_transpose_item(F.wdn, DMOD, FF, nullptr, Wdn_t, 32 * g, 32 * g, 64 * kb, scr, lane); }
    }
    { const int gt = F.vcu * NTHR + F.tid, NGT = F.G * NTHR;
      bf16* Qs = (bf16*)(F.ws + WS_QS); bf16* Ks = (bf16*)(F.ws + WS_KS); bf16* Vs = (bf16*)(F.ws + WS_VS);
      for (int i = gt; i < NBATCH * PAST * 64; i += NGT) { const int b = i / (PAST * 64), rem = i % (PAST * 64); const size_t so = (size_t)i * 8, dof = ((size_t)b * SSEQ * 64 + rem) * 8;
          const f32x4 a0 = *(const f32x4*)(F.ck + so), a1 = *(const f32x4*)(F.ck + so + 4), b0 = *(const f32x4*)(F.cv + so), b1 = *(const f32x4*)(F.cv + so + 4);
          v4u o; o.x = pk2(a0[0], a0[1]); o.y = pk2(a0[2], a0[3]); o.z = pk2(a1[0], a1[1]); o.w = pk2(a1[2], a1[3]); *(v4u*)(Ks + dof) = o;
          o.x = pk2(b0[0], b0[1]); o.y = pk2(b0[2], b0[3]); o.z = pk2(b1[0], b1[1]); o.w = pk2(b1[2], b1[3]); *(v4u*)(Vs + dof) = o; }
      const v4u z = {0u, 0u, 0u, 0u};
      for (int i = gt; i < NBATCH * SSEQ * 64; i += NGT) *(v4u*)(Qs + (size_t)i * 8) = z;
      for (int i = gt; i < NBATCH * (SSEQ - PAST) * 64; i += NGT) { const int b = i / ((SSEQ - PAST) * 64), rem = i % ((SSEQ - PAST) * 64); const size_t dof = ((size_t)(b * SSEQ + PAST) * 64 + rem) * 8; *(v4u*)(Ks + dof) = z; *(v4u*)(Vs + dof) = z; }
    }
    float wf[4][4][8];
#pragma unroll
    for (int j = 0; j < 4; ++j)
#pragma unroll
        for (int i = 0; i < 4; ++i) { const int k = 256 * j + 4 * lane + i; const float nk = F.n1[k]; const f32x4 a = *(const f32x4*)(F.win + (size_t)k * INC + NIN), b = *(const f32x4*)(F.win + (size_t)k * INC + NIN + 4);
            wf[j][i][0] = a[0] * nk; wf[j][i][1] = a[1] * nk; wf[j][i][2] = a[2] * nk; wf[j][i][3] = a[3] * nk; wf[j][i][4] = b[0] * nk; wf[j][i][5] = b[1] * nk; wf[j][i][6] = b[2] * nk; wf[j][i][7] = b[3] * nk; }
    const f32x4 bf0 = *(const f32x4*)(F.bff), bf1 = *(const f32x4*)(F.bff + 4);
    float* rstd1 = (float*)(F.ws + WS_RSTD); bf16* XB = (bf16*)(F.ws + WS_XB);
    for (int m = gw; m < MTOT; m += NGW) {
        int idx; const bool valid = row_map(m, idx); const float* xrow = (m < MP ? F.xp : F.xs) + (size_t)idx * DMOD;
        f32x4 v[4]; float s = 0.f;
#pragma unroll
        for (int j = 0; j < 4; ++j) { v[j] = valid ? *((const f32x4*)xrow + 64 * j + lane) : (f32x4){0.f, 0.f, 0.f, 0.f}; s += (v[j][0] * v[j][0] + v[j][1] * v[j][1]) + (v[j][2] * v[j][2] + v[j][3] * v[j][3]); }
        const float rstd = 1.f / sqrtf(wave_sum(s) * (1.f / DMOD) + EPSN);
        if (lane == 0) rstd1[m] = rstd;
        unsigned long long* o8 = (unsigned long long*)(XB + (size_t)m * DMOD) + lane;
#pragma unroll
        for (int j = 0; j < 4; ++j) o8[64 * j] = (unsigned long long)pk2(v[j][0], v[j][1]) | ((unsigned long long)pk2(v[j][2], v[j][3]) << 32);
        float fb[8];
#pragma unroll
        for (int h = 0; h < 8; ++h) { float a = 0.f;
#pragma unroll
            for (int j = 0; j < 4; ++j)
#pragma unroll
                for (int i = 0; i < 4; ++i) a += v[j][i] * wf[j][i][h];
            fb[h] = wave_sum(a); }
        if (valid && lane == 0) { f32x4 o0, o1;
#pragma unroll
            for (int h = 0; h < 8; ++h) { const float xx = fb[h] * rstd + (h < 4 ? bf0[h & 3] : bf1[h & 3]); const float ls = fminf(xx, 0.f) - log1pf(expf(-fabsf(xx))); if (h < 4) o0[h & 3] = ls; else o1[h & 3] = ls; }
            float* lp = (m < MP ? F.out + O_LP : F.out + O_LS) + (size_t)idx * 8; *(f32x4*)lp = o0; *(f32x4*)(lp + 4) = o1; }
    }
}
__device__ __forceinline__ void scan_chain(Frame& F, int ch) {
    LAS float* wsum = (LAS float*)F.lds;
    const bool samp = ch >= 64; const int c2 = samp ? ch - 64 : ch, b = c2 >> 3, h = c2 & 7; const int L = samp ? SSEQ : TSEQ, EPT = samp ? 3 : 16;
    float* dst = samp ? (float*)(F.ws + WS_CGS) + (size_t)c2 * SSEQ : (float*)(F.ws + WS_CGP) + (size_t)c2 * TSEQ;
    float vals[16]; float sum = 0.f;
#pragma unroll
    for (int i = 0; i < 16; ++i) { const int p = F.tid * EPT + i; float v = 0.f;
        if (i < EPT && p < L) { if (!samp) v = F.out[O_LP + ((size_t)b * TSEQ + p) * 8 + h]; else if (p < PAST) v = F.clf[((size_t)b * PAST + p) * 8 + h]; else if (p < PAST + DSEQ) v = F.out[O_LS + ((size_t)b * DSEQ + (p - PAST)) * 8 + h]; }
        sum += v; vals[i] = sum; }
    float incl = sum;
#pragma unroll
    for (int o = 1; o < 64; o <<= 1) { const float t = __shfl_up(incl, o); if (F.lane >= o) incl += t; }
    if (F.lane == 63) wsum[F.wave] = incl;
    __syncthreads();
    float base = 0.f;
    for (int w = 0; w < F.wave; ++w) base += wsum[w];
    const float excl = base + incl - sum;
#pragma unroll
    for (int i = 0; i < 16; ++i) { const int p = F.tid * EPT + i; if (i < EPT && p < L) dst[p] = (excl + vals[i]) * LOG2E; }
    __syncthreads();
}
constexpr int KP = 320  , H_QR = 0, H_KR = 17408, H_KT = 37888, H_VT = 58368, H_VEC = 71680, H_AL = 73216, H_OL = 82432, H_END = 116224;
static_assert(H_END <= RING_BYTES, "hgrn LDS");
typedef short v4i16_t __attribute__((ext_vector_type(4)));
__device__ __forceinline__ bf16x8 tr_frag(LAS unsigned char* p) {
    const v4i16_t lo = __builtin_amdgcn_ds_read_tr16_b64_v4i16((LAS v4i16_t*)p), hi = __builtin_amdgcn_ds_read_tr16_b64_v4i16((LAS v4i16_t*)(p + 4 * KP));
    return (bf16x8){lo[0], lo[1], lo[2], lo[3], hi[0], hi[1], hi[2], hi[3]};
}
__device__ __forceinline__ f32x4 mfma16(bf16x8 a, bf16x8 b, f32x4 c) { return __builtin_amdgcn_mfma_f32_16x16x32_bf16(a, b, c, 0, 0, 0); }
#define LAUNDER(x) asm volatile("" : "+v"(x))
#ifndef PR_A
#define PR_A 1
#endif
#ifndef PR_O
#define PR_O 1
#endif
#ifndef PR_OUT
#define PR_OUT 1
#endif
#define HG_BAR() do { asm volatile("s_waitcnt lgkmcnt(0)" ::: "memory"); __builtin_amdgcn_s_barrier(); asm volatile("" ::: "memory"); } while (0)
__device__ __forceinline__ void hgrn_chain(Frame& F, int row0, int chunk0, int nsteps, int h, const float* S0, float* Sout) {
    LAS unsigned char* L = F.lds; int tid_ = F.tid; LAUNDER(tid_); const int tid = tid_, lane = tid & 63, w = F.wave, l15 = lane & 15, fq = lane >> 4;
    const char* qb = (const char*)(F.ws + WS_QR) + ((size_t)row0 * 512 + 128 * h) * 2; const char* kb_ = (const char*)(F.ws + WS_KR) + ((size_t)row0 * 512 + 128 * h) * 2;
    const char* vb = (const char*)(F.ws + WS_VH) + ((size_t)row0 * 512 + 128 * h) * 2; const char* gb = (const char*)(F.ws + WS_SG) + ((size_t)row0 * 512 + 128 * h) * 2;
    const char* eb = (const char*)(F.ws + WS_VEC) + ((size_t)chunk0 * 512 + 128 * h) * 4; char* mb = (char*)(F.ws + WS_MIX) + ((size_t)row0 * DMOD + 128 * h) * 2;
    const int oc = tid >> 3, oseg = tid & 7;
    unsigned vo_rm = (unsigned)((tid >> 4) * 1024 + (tid & 15) * 16), vo_sg = (unsigned)(oc * 1024 + oseg * 32), vo_mix = (unsigned)(oc * 2048 + oseg * 32);
    unsigned vo_vec = (unsigned)((tid & 31) * 16);
    unsigned l_rm = (unsigned)(H_QR + (tid >> 4) * 272 + (tid & 15) * 16), l_rk = (unsigned)(H_KR + (tid >> 4) * KP + (tid & 15) * 16);
    unsigned l_vw = (unsigned)(H_VEC + (tid & 31) * 16);
    unsigned l_aq = (unsigned)(H_QR + (16 * (w >> 1) + l15) * 272 + fq * 16);
    unsigned l_ak = (unsigned)(H_KR + (32 * (w & 1) + l15) * KP + fq * 16);
    unsigned l_aw = (unsigned)(H_AL + (16 * (w >> 1) + 4 * fq) * 144 + (32 * (w & 1) + l15) * 2);
    unsigned l_vt = (unsigned)(H_KT + (8 * fq + (l15 >> 2)) * KP + (16 * w + 4 * (l15 & 3)) * 2);
    unsigned l_q2 = (unsigned)(H_QR + l15 * 272 + fq * 16);
    unsigned l_al = (unsigned)(H_AL + l15 * 144 + fq * 16);
    unsigned l_kt = (unsigned)(H_KR + (8 * fq + (l15 >> 2)) * KP + (8 * (l15 & 3)) * 2);
    unsigned l_ve = (unsigned)(H_VEC + fq * 32);
    unsigned l_ow = (unsigned)(H_OL + (4 * fq) * 528 + (16 * w + l15) * 4);
    unsigned l_or = (unsigned)(H_OL + oc * 528 + oseg * 64);
    f32x4 S[8];
#pragma unroll
    for (int kb = 0; kb < 8; ++kb) S[kb] = (f32x4){0.f, 0.f, 0.f, 0.f};
    if (S0) { const float* sp = S0 + (8 * fq) * 128 + 16 * w + l15;
#pragma unroll
        for (int kb = 0; kb < 8; ++kb) { LAUNDER(sp);
#pragma unroll
            for (int r = 0; r < 4; ++r) S[kb][r] = sp[r * 128];
            sp += (kb & 1) ? 28 * 128 : 4 * 128; } }
    f32x4 gn[4];
#pragma unroll
    for (int i = 0; i < 4; ++i) gn[i] = *(const f32x4*)(F.hon + 128 * h + 16 * oseg + 4 * i);
    v4u pq[2][2], pk[2][2], pv[2][2], psg[2][2], pvec[2]; int cl = 0, gl = 0;
#define HG_LOADS(SET) do { \
        _Pragma("unroll") for (int it = 0; it < 2; ++it) { pq[SET][it] = *(const v4u*)(qb + vo_rm + it * 32768); pk[SET][it] = *(const v4u*)(kb_ + vo_rm + it * 32768); pv[SET][it] = *(const v4u*)(vb + vo_rm + it * 32768); } \
        pvec[SET] = *(const v4u*)(eb + vo_vec); } while (0)
#define HG_STORE(SET) do { \
        _Pragma("unroll") for (int it = 0; it < 2; ++it) { *(LAS v4u*)(L + l_rm + it * 8704) = pq[SET][it]; *(LAS v4u*)(L + l_rk + it * 32 * KP) = pk[SET][it]; *(LAS v4u*)(L + l_rk + (H_KT - H_KR) + it * 32 * KP) = pv[SET][it]; } \
        if (tid < 32) *(LAS v4u*)(L + l_vw) = pvec[SET]; } while (0)
#define HG_ADV() do { const int a_ = (cl + 1 < nsteps) ? 1 : 0; qb += a_ * 65536; kb_ += a_ * 65536; vb += a_ * 65536; eb += a_ * 2048; cl += a_; } while (0)
    HG_LOADS(0); HG_ADV(); HG_STORE(0); HG_LOADS(1); HG_ADV();
    psg[0][0] = *(const v4u*)(gb + vo_sg); psg[0][1] = *(const v4u*)(gb + vo_sg + 16); { const int a_ = (gl + 1 < nsteps) ? 1 : 0; gb += a_ * 65536; gl += a_; }
    HG_BAR();
#define HG_BODY(CUR, NXT, CC) do { \
        LAUNDER(vo_rm); LAUNDER(vo_sg); LAUNDER(vo_mix); LAUNDER(vo_vec); LAUNDER(l_rm); LAUNDER(l_rk); LAUNDER(l_vw); LAUNDER(l_aq); LAUNDER(l_ak); LAUNDER(l_aw); \
        LAUNDER(l_vt); LAUNDER(l_q2); LAUNDER(l_al); LAUNDER(l_kt); LAUNDER(l_ve); LAUNDER(l_ow); LAUNDER(l_or); \
        psg[NXT][0] = *(const v4u*)(gb + vo_sg); psg[NXT][1] = *(const v4u*)(gb + vo_sg + 16); { const int a_ = (gl + 1 < nsteps) ? 1 : 0; gb += a_ * 65536; gl += a_; } \
        HG_LOADS(CUR); HG_ADV(); \
        for (int ra_ = 0; ra_ < PR_A; ++ra_) { const int cblk = w >> 1; \
        _Pragma("unroll") \
          for (int jj = 0; jj < 2; ++jj) { const int sblk = 2 * (w & 1) + jj; f32x4 a = {0.f, 0.f, 0.f, 0.f}; \
              if (sblk <= cblk) { \
                  bf16x8 af[4], bf[4]; \
        _Pragma("unroll") \
                  for (int ks = 0; ks < 4; ++ks) { af[ks] = *(const LAS bf16x8*)(L + l_aq + ks * 64); bf[ks] = *(const LAS bf16x8*)(L + l_ak + jj * 16 * KP + ks * 64); } \
                  asm volatile("" : "+v"(af[0]), "+v"(af[1]), "+v"(af[2]), "+v"(af[3]), "+v"(bf[0]), "+v"(bf[1]), "+v"(bf[2]), "+v"(bf[3])); \
        _Pragma("unroll") \
                  for (int ks = 0; ks < 4; ++ks) a = mfma16(af[ks], bf[ks], a); \
        _Pragma("unroll") \
                  for (int r = 0; r < 4; ++r) if (16 * sblk + l15 > 16 * cblk + 4 * fq + r) a[r] = 0.f; \
              } \
        _Pragma("unroll") \
              for (int r = 0; r < 4; ++r) *(LAS unsigned short*)(L + l_aw + r * 144 + jj * 32) = (unsigned short)(pk2(a[r], 0.f) & 0xffffu); \
          } HG_BAR(); } \
        { bf16x8 bvt[2]; \
        _Pragma("unroll") \
          for (int ks = 0; ks < 2; ++ks) bvt[ks] = tr_frag(L + l_vt + ks * 32 * KP); \
          bf16x8 sb[4]; \
        _Pragma("unroll") \
          for (int kb2 = 0; kb2 < 4; ++kb2) { v4u t; t.x = pk2(S[2 * kb2][0], S[2 * kb2][1]); t.y = pk2(S[2 * kb2][2], S[2 * kb2][3]); t.z = pk2(S[2 * kb2 + 1][0], S[2 * kb2 + 1][1]); t.w = pk2(S[2 * kb2 + 1][2], S[2 * kb2 + 1][3]); sb[kb2] = __builtin_bit_cast(bf16x8, t); } \
          for (int ro_ = 0; ro_ < PR_O; ++ro_) \
          _Pragma("unroll") \
          for (int cb = 0; cb < 4; ++cb) { f32x4 o = {0.f, 0.f, 0.f, 0.f}; bf16x8 fa[2], fq_[4]; \
        _Pragma("unroll") \
              for (int ks = 0; ks < 2; ++ks) fa[ks] = *(const LAS bf16x8*)(L + l_al + cb * 16 * 144 + ks * 64); \
        _Pragma("unroll") \
              for (int kb2 = 0; kb2 < 4; ++kb2) fq_[kb2] = *(const LAS bf16x8*)(L + l_q2 + cb * 16 * 272 + kb2 * 64); \
              asm volatile("" : "+v"(fa[0]), "+v"(fa[1]), "+v"(fq_[0]), "+v"(fq_[1]), "+v"(fq_[2]), "+v"(fq_[3])); \
        _Pragma("unroll") \
              for (int ks = 0; ks < 2; ++ks) if (32 * ks <= 16 * cb + 15) o = mfma16(fa[ks], bvt[ks], o); \
        _Pragma("unroll") \
              for (int kb2 = 0; kb2 < 4; ++kb2) o = mfma16(fq_[kb2], sb[kb2], o); \
        _Pragma("unroll") \
              for (int r = 0; r < 4; ++r) *(LAS float*)(L + l_ow + (16 * cb + r) * 528) = o[r]; \
              __builtin_amdgcn_sched_barrier(0); } \
        _Pragma("unroll") \
          for (int kp = 0; kp < 4; ++kp) { bf16x8 fk[2][2]; f32x4 dv[2]; \
        _Pragma("unroll") \
              for (int e = 0; e < 2; ++e) { const int kb = 2 * kp + e; \
        _Pragma("unroll") \
                  for (int ks = 0; ks < 2; ++ks) fk[e][ks] = tr_frag(L + l_kt + (32 * (kb >> 1) + 4 * (kb & 1)) * 2 + ks * 32 * KP); \
                  dv[e] = *(const LAS f32x4*)(L + l_ve + (32 * (kb >> 1) + 4 * (kb & 1)) * 4); } \
              asm volatile("" : "+v"(fk[0][0]), "+v"(fk[0][1]), "+v"(fk[1][0]), "+v"(fk[1][1]), "+v"(dv[0]), "+v"(dv[1])); \
        _Pragma("unroll") \
              for (int e = 0; e < 2; ++e) { const int kb = 2 * kp + e; \
        _Pragma("unroll") \
                  for (int ks = 0; ks < 2; ++ks) S[kb] = mfma16(fk[e][ks], bvt[ks], S[kb]); \
                  S[kb] = S[kb] * dv[e]; } \
              __builtin_amdgcn_sched_barrier(0); } } \
        HG_BAR(); \
        for (int rt_ = 0; rt_ < PR_OUT; ++rt_) { f32x4 ov[4]; float ss = 0.f; \
        _Pragma("unroll") \
          for (int i = 0; i < 4; ++i) { ov[i] = *(const LAS f32x4*)(L + l_or + 16 * i); ss += (ov[i][0] * ov[i][0] + ov[i][1] * ov[i][1]) + (ov[i][2] * ov[i][2] + ov[i][3] * ov[i][3]); } \
          ss += __shfl_xor(ss, 1); ss += __shfl_xor(ss, 2); ss += __shfl_xor(ss, 4); \
          const float rn = __builtin_amdgcn_rsqf(ss * (1.f / 128.f) + EPSN); \
          float res[16]; \
        _Pragma("unroll") \
          for (int i = 0; i < 4; ++i) \
        _Pragma("unroll") \
              for (int j = 0; j < 4; ++j) { const int e = 4 * i + j; const unsigned wd = psg[CUR][e >> 3][(e & 7) >> 1]; const float sg = bf2f((unsigned short)((e & 1) ? (wd >> 16) : (wd & 0xffffu))); res[e] = ov[i][j] * rn * gn[i][j] * sg; } \
          v4u o0, o1; o0.x = pk2(res[0], res[1]); o0.y = pk2(res[2], res[3]); o0.z = pk2(res[4], res[5]); o0.w = pk2(res[6], res[7]); o1.x = pk2(res[8], res[9]); o1.y = pk2(res[10], res[11]); o1.z = pk2(res[12], res[13]); o1.w = pk2(res[14], res[15]); \
          *(v4u*)(mb + vo_mix) = o0; *(v4u*)(mb + vo_mix + 16) = o1; } mb += 131072; \
        if ((CC) + 1 < nsteps) { HG_STORE(NXT); } \
        HG_BAR(); \
    } while (0)
    for (int c = 0; c < nsteps; c += 2) { HG_BODY(0, 1, c); if (c + 1 < nsteps) HG_BODY(1, 0, c + 1); }
    { int ln2 = lane; LAUNDER(ln2); float* sp = Sout + (8 * (ln2 >> 4)) * 128 + 16 * w + (ln2 & 15);
#pragma unroll
      for (int kb = 0; kb < 8; ++kb) { LAUNDER(sp);
#pragma unroll
          for (int r = 0; r < 4; ++r) sp[r * 128] = S[kb][r];
          sp += (kb & 1) ? 28 * 128 : 4 * 128; } }
#undef HG_LOADS
#undef HG_STORE
#undef HG_ADV
#undef HG_BODY
}

__global__ void __launch_bounds__(NTHR, 2) skel_fwd(Args args) {
    extern __shared__ __attribute__((aligned(16))) unsigned char lds[];
    Frame F;
    F.lds = (LAS unsigned char*)lds; F.MISC = (volatile LAS unsigned*)(F.lds + MISC_OFF);
    F.tid = threadIdx.x; F.lane = F.tid & 63; F.wave = __builtin_amdgcn_readfirstlane(F.tid >> 6);
    F.G = gridDim.x; { const int bx = blockIdx.x; F.vcu = (F.G % 8 == 0) ? (bx % 8) * (F.G / 8) + bx / 8 : bx; }
    F.ws = args.ws; F.ctl = (unsigned*)(args.ws + WS_CTL); F.out = args.out;
    F.xp = args.in[0]; F.xs = args.in[1]; F.ck = args.in[2]; F.cv = args.in[3]; F.clf = args.in[4]; F.sh = args.in[5]; F.n1 = args.in[6]; F.win = args.in[7]; F.bff = args.in[8];
    F.qg = args.in[9]; F.kg = args.in[10]; F.lbl = args.in[11]; F.hon = args.in[12]; F.wout = args.in[13]; F.n2 = args.in[14]; F.wup = args.in[15]; F.wdn = args.in[16];
    const int lo = args.ph_lo, hi = args.ph_hi;
#if defined(PROBE_A)
    unsigned long long ts_[9]; const bool stamper_ = (blockIdx.x == 0 && F.tid == 0);
#define STAMP(k) do { if (stamper_) ts_[k] = __builtin_amdgcn_s_memrealtime(); } while (0)
    STAMP(0);
#else
#define STAMP(k) do {} while (0)
#endif
#ifndef PH_MASK
#define PH_MASK 63
#endif
#define IN(k) (((PH_MASK >> (k)) & 1) && lo <= (k) && (k) < hi)
#define SEAM(k) do { if (IN(k) && IN((k) + 1)) { cg::this_grid().sync(); } } while (0)
    bf16* XB = (bf16*)(F.ws + WS_XB); bf16* X1B = (bf16*)(F.ws + WS_X1B); bf16* MIX = (bf16*)(F.ws + WS_MIX); bf16* HB = (bf16*)(F.ws + WS_H);
    if (IN(0)) { p0_prologue(F); }
    SEAM(0); STAMP(1);
    const int bx = (int)blockIdx.x; const bool chainwg = bx < NCHAINWG; const int NWORK = F.G - NCHAINWG;
    if (IN(1)) {
#ifndef NO_SCAN
        for (int ch = F.vcu; ch < 128; ch += F.G) scan_chain(F, ch);
#endif
        pg8::Gemm g{XB, (const bf16*)(F.ws + WS_WIN), MTOT, NIN, DMOD};
        pg8::EpiIn E{(const float*)(F.ws + WS_RSTD), F.lbl, F.qg, F.kg, F.ws, F.out};
#pragma nounroll
        for (int sub = 0; sub < 2; ++sub) {
            pg8::OrderIn S;
            if (sub == 0) { S.so.init(MP, 2048, F.G, bx); S.pn_off = 0; S.extra = 0; S.extra_pm0 = 0; }
            else { S.so.init(MTOT, NIN - 2048, NWORK, bx - NCHAINWG); S.pn_off = 8; S.extra = 8 * (MS / 256); S.extra_pm0 = MP / 256; }
            if (sub == 0 || !chainwg) pg8::gemm_phase<pg8::EpiIn, pg8::OrderIn, true, true>(F.lds, g, S, E);
            if (sub == 0) {
                cg::this_grid().sync(); STAMP(2);
                if (chainwg)
#if defined(DOUBLE_HGRN)
                for (int rep_ = 0; rep_ < 2; ++rep_)
#endif
                { const int bb = bx >> 2; hgrn_chain(F, bb * TSEQ, bb * (TSEQ / 64), TSEQ / 64, bx & 3, nullptr, F.out + O_HP + (size_t)bx * 16384); }
            }
        }
        asm volatile("s_waitcnt vmcnt(0)" ::: "memory"); __syncthreads();
        if (F.tid == 0) { unsigned* sc = F.ctl + CW_SUB;
            if (!chainwg) { __threadfence(); __hip_atomic_fetch_add(sc, 1u, __ATOMIC_RELAXED, __HIP_MEMORY_SCOPE_AGENT); }
            while (__hip_atomic_load(sc, __ATOMIC_RELAXED, __HIP_MEMORY_SCOPE_AGENT) < (unsigned)NWORK) __builtin_amdgcn_s_sleep(8);
            __threadfence(); }
        __syncthreads();
        if (chainwg) { const int bb = bx >> 2; hgrn_chain(F, MP + 64 * bb, MP / 64 + bb, 1, bx & 3, F.sh + (size_t)bx * 16384, F.out + O_HS + (size_t)bx * 16384); __syncthreads(); }
    }
    if (IN(2)) {
#ifndef NO_ATTN
        float prune_thr;
        { float mq = fabsf(F.qg[F.lane]), mk = fabsf(F.kg[F.lane]);
#pragma unroll
          for (int o = 1; o < 64; o <<= 1) { mq = fmaxf(mq, __shfl_xor(mq, o)); mk = fmaxf(mk, __shfl_xor(mk, o)); }
          prune_thr = 2.f * (8.f * mq * mk * LOG2E) + 150.f; }
        for (;;) {
            if (F.tid == 0) F.MISC[0] = atomicAdd(F.ctl + CW_QUEUE, 1u);
            __syncthreads();
            const int i = (int)F.MISC[0];
            __syncthreads();
            if (i >= 2048 + 64) break;
            typedef attn_body::bf16 abf;
            const bool smp = i >= 2048; const int j = smp ? i - 2048 : i;
            const int bh = j & 63, qb = 31 - (j >> 6), b = bh >> 3, h = bh & 7;
            const int q0 = smp ? SSEQ - 256 : 256 * qb, NT = (q0 + 256) / 64; int NTE = NT;
            const size_t rb = (size_t)b * (smp ? SSEQ : TSEQ);
            const float* cgp = (const float*)(F.ws + (smp ? WS_CGS : WS_CGP)) + (size_t)bh * (smp ? SSEQ : TSEQ);
#if FOX_PRUNE
            { const bool need = F.tid < NT && (cgp[q0] - cgp[64 * F.tid + 63] >= -prune_thr); const int needed = __syncthreads_count(need ? 1 : 0);
              NTE = (needed + 1) & ~1; NTE = NTE < 4 ? 4 : (NTE > NT ? NT : NTE); }
#endif
            const size_t orow = smp ? (size_t)(MP + 64 * b) - (size_t)(PAST - q0) : rb + q0;
            attn_body::attn_unit<8>((const abf*)(F.ws + (smp ? WS_QS : WS_Q)) + (rb + q0) * 512 + 64 * h, (const abf*)(F.ws + (smp ? WS_KS : WS_K)) + rb * 512 + 64 * h, (const abf*)(F.ws + (smp ? WS_VS : WS_V)) + rb * 512 + 64 * h,
                                    (abf*)MIX + orow * DMOD + 512 + 64 * h, NT, NTE, cgp, q0, smp ? (PAST - q0) / 32 : 0, smp ? (PAST - q0) / 32 + 1 : 8, (char*)lds);
        }
#endif
    }
    SEAM(2); STAMP(3);
    if (IN(3)) {
        pg8::Gemm g{MIX, (const bf16*)(F.ws + WS_WO), MTOT, DMOD, DMOD}; pg8::StaticOrder S; S.init(MTOT, DMOD, F.G, (int)blockIdx.x);
        pg8::EpiWo E{F.xp, F.xs, F.out + O_YP, F.out + O_YS, X1B, (float*)(F.ws + WS_SSQ)};
        pg8::gemm_phase<pg8::EpiWo, pg8::StaticOrder, true, true>(F.lds, g, S, E);
    }
    SEAM(3); STAMP(4);
    if (IN(4)) {
        pg8::Gemm g{X1B, (const bf16*)(F.ws + WS_WUP), MTOT, FF, DMOD}; pg8::StaticOrder S; S.init(MTOT, FF, F.G, (int)blockIdx.x);
        pg8::EpiUp E{HB, (const float*)(F.ws + WS_SSQ)};
        pg8::gemm_phase<pg8::EpiUp, pg8::StaticOrder, true, true>(F.lds, g, S, E);
#if defined(DOUBLE_P4)
        cg::this_grid().sync();
        pg8::gemm_phase<pg8::EpiUp, pg8::StaticOrder, true, true>(F.lds, g, S, E);
#endif
    }
    SEAM(4); STAMP(5);
    if (IN(5)) {
        pg8::Gemm g{HB, (const bf16*)(F.ws + WS_WDN), MTOT, DMOD, FF}; pg8::StaticOrder S; S.init(MTOT, DMOD, F.G, (int)blockIdx.x);
        pg8::EpiDown E{F.out + O_YP, F.out + O_YS};
        pg8::gemm_phase<pg8::EpiDown, pg8::StaticOrder, true, true>(F.lds, g, S, E);
    }
    STAMP(6);
#if defined(PROBE_A)
    cg::this_grid().sync();
    if (stamper_) {
        unsigned long long da = ts_[PROBE_A + 1] - ts_[PROBE_A], db = ts_[PROBE_B + 1] - ts_[PROBE_B];
        unsigned qa = (unsigned)((da + 1250) / 2500), qb = (unsigned)((db + 1250) / 2500); if (qa > 63) qa = 63; if (qb > 63) qb = 63;
#if defined(PROBE_CAL)
        qa = 1000; qb = 0;
#endif
        const unsigned long long t0 = __builtin_amdgcn_s_memrealtime(), wait = 2000ull * (qa + 64 * qb);
        while (__builtin_amdgcn_s_memrealtime() - t0 < wait) __builtin_amdgcn_s_sleep(16);
    }
#endif
#undef IN
#undef SEAM
}

extern "C" void kernel_launch(void* const* d_in, const int* in_sizes, int n_in, void* d_out, int out_size, void* d_ws, size_t ws_size, hipStream_t stream) {
    static int grid = 0;
    if (grid == 0) {
        if (n_in != 17 || (size_t)out_size != O_END || ws_size < WS_END) { fprintf(stderr, "kernel_launch: unexpected shapes (n_in %d out %d ws %zu)\n", n_in, out_size, ws_size); grid = -1; return; }
        int dev = 0, cus = 0, per_cu = 0;
        if (hipGetDevice(&dev) != hipSuccess || hipDeviceGetAttribute(&cus, hipDeviceAttributeMultiprocessorCount, dev) != hipSuccess) { grid = -1; return; }
        if (hipFuncSetAttribute((const void*)skel_fwd, hipFuncAttributeMaxDynamicSharedMemorySize, LDS_BYTES) != hipSuccess) { fprintf(stderr, "kernel_launch: hipFuncSetAttribute failed\n"); grid = -1; return; }
        if (hipOccupancyMaxActiveBlocksPerMultiprocessor(&per_cu, (const void*)skel_fwd, NTHR, LDS_BYTES) != hipSuccess || per_cu < 1) { fprintf(stderr, "kernel_launch: occupancy query says %d\n", per_cu); per_cu = 1; }
        (void)hipGetLastError();
        grid = cus;
    }
    if (grid < 0) return;
    if (hipMemsetAsync((char*)d_ws + WS_CTL, 0, CTL_ZERO_BYTES, stream) != hipSuccess) { fprintf(stderr, "kernel_launch: memset failed\n"); return; }
    Args a{};
    for (int i = 0; i < 17; ++i) a.in[i] = (const float*)d_in[i];
    a.out = (float*)d_out; a.ws = (unsigned char*)d_ws;
#if MK_N_LAUNCHES == 1
    a.ph_lo = 0; a.ph_hi = 6;
    void* kargs[] = {&a};
    hipError_t e = hipLaunchCooperativeKernel((const void*)skel_fwd, dim3(grid), dim3(NTHR), kargs, LDS_BYTES, stream);
    if (e != hipSuccess) fprintf(stderr, "kernel_launch: cooperative launch failed: %s (grid %d)\n", hipGetErrorString(e), grid);
#else
    for (int li = 0; li < 6; ++li) { a.ph_lo = li; a.ph_hi = li + 1; hipLaunchKernelGGL(skel_fwd, dim3(grid), dim3(NTHR), LDS_BYTES, stream, a); }
#endif
}
```

```cpp
#include <hip/hip_runtime.h>
#include <cstdio>
#include <cstdint>
namespace pg8 {
#define PG8_LAS __attribute__((address_space(3)))
typedef unsigned short bf16_t;
typedef short bf16x8 __attribute__((ext_vector_type(8)));
typedef float f32x4 __attribute__((ext_vector_type(4)));
typedef unsigned u32x4 __attribute__((ext_vector_type(4)));
constexpr int BM = 256, BK = 64, HALF = 128, HTB = HALF * BK * 2  , STAGE_BYTES = 8 * HTB, NXCD = 8, WGM = 8;

__host__ __device__ __forceinline__ int lds_byte(int r, int c) { const int st = (r >> 4) * 2 + (c >> 5), rr = r & 15, cc = c & 31, ob = rr * 64 + cc * 2; return st * 1024 + (ob ^ (((ob >> 9) & 1) << 5)); }
__host__ __device__ __forceinline__ void stage_rc(int b, int& R, int& C) { const int st = b / 1024, sb = b % 1024, swz = sb ^ (((sb >> 9) & 1) << 5); R = (st >> 1) * 16 + swz / 64; C = (st & 1) * 32 + (swz % 64) / 2; }
__host__ __device__ __forceinline__ int perm32(int rho) { const int n = rho >> 4, i = rho & 15; return 8 * (i >> 2) + 4 * n + (i & 3); }

struct Unit { int pm, pn, kofs; };
struct Gemm { const bf16_t* A; const bf16_t* Bt; int M, N, K, ld; };

struct StaticOrder {
    int nM, nN, nwg, G, c;
    __host__ __device__ void init(int M, int N, int G_, int c_) { nM = M / BM; nN = N / BM; nwg = nM * nN; G = G_; c = c_; }
    __host__ __device__ bool next(int i, Unit& u) const {
        const long L = (long)i * G + c; if (L >= nwg) return false;
        int wgid = (int)L; { const int q = nwg / NXCD, r = nwg % NXCD, xcd = wgid % NXCD, off = wgid / NXCD; wgid = (xcd < r ? xcd * (q + 1) : r * (q + 1) + (xcd - r) * q) + off; }
        const int nig = WGM * nN, gid = wgid / nig, fm = gid * WGM, gsz = (nM - fm) < WGM ? (nM - fm) : WGM;
        u.pm = fm + ((wgid % nig) % gsz); u.pn = (wgid % nig) / gsz; u.kofs = 0; return true;
    }
    __device__ __forceinline__ void a_ready(const Unit&) const {}
    __device__ __forceinline__ void done(const Unit&) const {}
};

__device__ __forceinline__ unsigned cvt_pk_bf16(float lo, float hi) { unsigned r; asm volatile("v_cvt_pk_bf16_f32 %0, %1, %2" : "=v"(r) : "v"(lo), "v"(hi)); return r; }
typedef float f32x2 __attribute__((ext_vector_type(2)));
template <class Epi, class Sched, bool ALIGN_EPI = false, bool SP2 = false>
__device__ __forceinline__ void gemm_phase(PG8_LAS unsigned char* lds, const Gemm g, const Sched& S, const Epi& E) {
    const int tid = threadIdx.x, wid = __builtin_amdgcn_readfirstlane(tid >> 6), lane = tid & 63, wr = wid >> 2, wc = wid & 3, fr = lane & 15, fq = lane >> 4;
    const int K = g.ld, nt = g.K / BK;
    unsigned voffA[2], voffB[2];
#pragma unroll
    for (int i = 0; i < 2; ++i) { int R, C; stage_rc(tid * 16 + i * 8192, R, C); const int Rb = Epi::PERM ? ((R & ~31) + perm32(R & 31)) : R;
        voffA[i] = (unsigned)(R * K + C) * 2u; voffB[i] = (unsigned)(Rb * K + C) * 2u; }
    const size_t kstep = (size_t)(BK * 2);
    const size_t hstep = (size_t)HALF * K * 2;
    const size_t tstep = 2 * hstep;
    const unsigned ldsw = (unsigned)wid * 1024u;
    const int aoff = lds_byte(wr * 64 + fr, fq * 8), boff = lds_byte(wc * 32 + fr, fq * 8);
#define PG8_SA(b, h) (((b) * 2 + (h)) * HTB)
#define PG8_SB(b, h) ((4 + (b) * 2 + (h)) * HTB)
#define PG8_STAGE(bufoff, gbase, voff) do { _Pragma("unroll") for (int _i = 0; _i < 2; ++_i) \
        __builtin_amdgcn_global_load_lds((const unsigned*)((const char*)(gbase) + (voff)[_i]), (PG8_LAS unsigned*)(lds + (bufoff) + ldsw + _i * 8192), 16, 0, 0); } while (0)
#define PG8_LDA(dst, b, h) do { _Pragma("unroll") for (int m = 0; m < 4; ++m) _Pragma("unroll") for (int k = 0; k < 2; ++k) dst[m][k] = *(const PG8_LAS bf16x8*)(lds + PG8_SA(b, h) + aoff + m * 2048 + k * 1024); } while (0)
#define PG8_LDB(dst, b, h) do { _Pragma("unroll") for (int n = 0; n < 2; ++n) _Pragma("unroll") for (int k = 0; k < 2; ++k) dst[n][k] = *(const PG8_LAS bf16x8*)(lds + PG8_SB(b, h) + boff + n * 2048 + k * 1024); } while (0)
#define PG8_MMA(ai, bj, At, Bt) do { __builtin_amdgcn_s_setprio(1); _Pragma("unroll") for (int m = 0; m < 4; ++m) _Pragma("unroll") for (int n = 0; n < 2; ++n) _Pragma("unroll") for (int k = 0; k < 2; ++k) \
        acc[ai][bj][m][n] = __builtin_amdgcn_mfma_f32_16x16x32_bf16(Bt[n][k], At[m][k], acc[ai][bj][m][n], 0, 0, 0); __builtin_amdgcn_s_setprio(0); } while (0)
#define PG8_WAIT_V(n) asm volatile("s_waitcnt vmcnt(" #n ")" ::: "memory")
#define PG8_WAIT_L(n) asm volatile("s_waitcnt lgkmcnt(" #n ")" ::: "memory")
#define PG8_BAR __builtin_amdgcn_s_barrier()
#define PG8_SCHED __builtin_amdgcn_sched_barrier(0)
    Unit cur, nxt; int ui = 0;
    if (!S.next(0, cur)) return;
    f32x4 acc[2][2][4][2];
#pragma unroll
    for (int a = 0; a < 2; ++a)
#pragma unroll
        for (int b = 0; b < 2; ++b)
#pragma unroll
            for (int m = 0; m < 4; ++m)
#pragma unroll
                for (int n = 0; n < 2; ++n) acc[a][b][m][n] = (f32x4){0.f, 0.f, 0.f, 0.f};
    bf16x8 At[4][2], B0[2][2], B1[2][2];
    const char* cA = (const char*)g.A + (size_t)cur.pm * tstep + (size_t)cur.kofs * 2; const char* cB = (const char*)g.Bt + (size_t)cur.pn * tstep + (size_t)cur.kofs * 2;
    S.a_ready(cur);
    if constexpr (SP2) {
        PG8_STAGE(PG8_SB(0, 0), cB, voffB); PG8_STAGE(PG8_SB(0, 1), cB + hstep, voffB); PG8_STAGE(PG8_SA(0, 0), cA, voffA); PG8_STAGE(PG8_SA(0, 1), cA + hstep, voffA);
        if (wr == 1) PG8_BAR;
        PG8_WAIT_V(2); PG8_BAR;
        PG8_STAGE(PG8_SB(1, 0), cB + kstep, voffB); PG8_STAGE(PG8_SA(1, 0), cA + kstep, voffA); PG8_STAGE(PG8_SB(1, 1), cB + hstep + kstep, voffB);
        PG8_WAIT_V(6); PG8_BAR;
    } else {
        PG8_STAGE(PG8_SB(0, 0), cB, voffB); PG8_STAGE(PG8_SA(0, 0), cA, voffA); PG8_STAGE(PG8_SB(0, 1), cB + hstep, voffB); PG8_STAGE(PG8_SA(0, 1), cA + hstep, voffA);
        if (wr == 1) PG8_BAR;
        PG8_WAIT_V(4); PG8_BAR;
        PG8_STAGE(PG8_SB(1, 0), cB + kstep, voffB); PG8_STAGE(PG8_SA(1, 0), cA + kstep, voffA); PG8_STAGE(PG8_SB(1, 1), cB + hstep + kstep, voffB);
        PG8_WAIT_V(6); PG8_BAR;
    }
    for (;;) {
        const bool has_next = S.next(ui + 1, nxt);
        const char* nA = has_next ? (const char*)g.A + (size_t)nxt.pm * tstep + (size_t)nxt.kofs * 2 : cA; const char* nB = has_next ? (const char*)g.Bt + (size_t)nxt.pn * tstep + (size_t)nxt.kofs * 2 : cB;
        for (int t = 0; t < nt; t += 2) {
            const bool last = (t == nt - 2);
            const char* a1 = cA + (size_t)(t + 1) * kstep;
            const char* a2 = last ? nA : cA + (size_t)(t + 2) * kstep; const char* b2 = last ? nB : cB + (size_t)(t + 2) * kstep;
            const char* a3 = a2 + kstep; const char* b3 = b2 + kstep;
            if (last && has_next) S.a_ready(nxt);
            if constexpr (SP2) {
            PG8_LDB(B0, 0, 0); PG8_LDB(B1, 0, 1); PG8_SCHED; PG8_LDA(At, 0, 0); PG8_STAGE(PG8_SA(1, 1), a1 + hstep, voffA);
            PG8_WAIT_V(8); PG8_WAIT_L(0); PG8_BAR; PG8_MMA(0, 0, At, B0); PG8_MMA(0, 1, At, B1); PG8_BAR; PG8_SCHED;
            PG8_LDA(At, 0, 1); PG8_STAGE(PG8_SB(0, 0), b2, voffB); PG8_STAGE(PG8_SB(0, 1), b2 + hstep, voffB); PG8_STAGE(PG8_SA(0, 0), a2, voffA);
            PG8_WAIT_V(8); PG8_WAIT_L(0); PG8_BAR; PG8_MMA(1, 0, At, B0); PG8_MMA(1, 1, At, B1); PG8_BAR; PG8_SCHED;
            PG8_LDB(B0, 1, 0); PG8_LDB(B1, 1, 1); PG8_SCHED; PG8_LDA(At, 1, 0); PG8_STAGE(PG8_SA(0, 1), a2 + hstep, voffA);
            PG8_WAIT_V(8); PG8_WAIT_L(0); PG8_BAR; PG8_MMA(0, 0, At, B0); PG8_MMA(0, 1, At, B1); PG8_BAR; PG8_SCHED;
            PG8_LDA(At, 1, 1); PG8_STAGE(PG8_SB(1, 0), b3, voffB); PG8_STAGE(PG8_SB(1, 1), b3 + hstep, voffB); PG8_STAGE(PG8_SA(1, 0), a3, voffA);
            PG8_WAIT_V(8); PG8_WAIT_L(0); PG8_BAR; PG8_MMA(1, 0, At, B0); PG8_MMA(1, 1, At, B1); PG8_BAR; PG8_SCHED;
            } else {
            PG8_LDB(B0, 0, 0); PG8_SCHED; PG8_LDA(At, 0, 0); PG8_STAGE(PG8_SA(1, 1), a1 + hstep, voffA);
            PG8_WAIT_L(8); PG8_BAR; PG8_WAIT_L(0); PG8_MMA(0, 0, At, B0); PG8_BAR; PG8_SCHED;
            PG8_LDB(B1, 0, 1); PG8_STAGE(PG8_SB(0, 0), b2, voffB);
            PG8_BAR; PG8_WAIT_L(0); PG8_MMA(0, 1, At, B1); PG8_BAR;
            PG8_LDA(At, 0, 1); PG8_STAGE(PG8_SA(0, 0), a2, voffA);
            PG8_BAR; PG8_WAIT_L(0); PG8_MMA(1, 0, At, B0); PG8_BAR; PG8_SCHED;
            PG8_STAGE(PG8_SB(0, 1), b2 + hstep, voffB);
            PG8_WAIT_V(6); PG8_BAR; PG8_MMA(1, 1, At, B1); PG8_BAR;
            PG8_LDB(B0, 1, 0); PG8_SCHED; PG8_LDA(At, 1, 0); PG8_STAGE(PG8_SA(0, 1), a2 + hstep, voffA);
            PG8_WAIT_L(8); PG8_BAR; PG8_WAIT_L(0); PG8_MMA(0, 0, At, B0); PG8_BAR; PG8_SCHED;
            PG8_LDB(B1, 1, 1); PG8_STAGE(PG8_SB(1, 0), b3, voffB);
            PG8_BAR; PG8_WAIT_L(0); PG8_MMA(0, 1, At, B1); PG8_BAR;
            PG8_LDA(At, 1, 1); PG8_STAGE(PG8_SA(1, 0), a3, voffA);
            PG8_BAR; PG8_WAIT_L(0); PG8_MMA(1, 0, At, B0); PG8_BAR; PG8_SCHED;
            PG8_STAGE(PG8_SB(1, 1), b3 + hstep, voffB);
            PG8_WAIT_V(6); PG8_BAR; PG8_MMA(1, 1, At, B1); PG8_BAR;
            }
        }
        if constexpr (ALIGN_EPI) { if (wr == 0) PG8_BAR; }
        if constexpr (!Epi::AFTER_DRAIN) { E(acc, cur, wr, wc, fr, fq); S.done(cur); }
        if (!has_next) break;
#pragma unroll
        for (int a = 0; a < 2; ++a)
#pragma unroll
            for (int b = 0; b < 2; ++b)
#pragma unroll
                for (int m = 0; m < 4; ++m)
#pragma unroll
                    for (int n = 0; n < 2; ++n) acc[a][b][m][n] = (f32x4){0.f, 0.f, 0.f, 0.f};
        cur = nxt; cA = nA; cB = nB; ++ui;
        if constexpr (ALIGN_EPI) { if (wr == 1) PG8_BAR; }
    }
    PG8_WAIT_V(0);
    if constexpr (!ALIGN_EPI) { if (wr == 0) PG8_BAR; }
    PG8_BAR;
    if constexpr (Epi::AFTER_DRAIN) { E.fused(acc, cur, wr, wc, fr, fq, lds, wid, lane); S.done(cur); }
#undef PG8_SA
#undef PG8_SB
#undef PG8_STAGE
#undef PG8_LDA
#undef PG8_LDB
#undef PG8_MMA
#undef PG8_WAIT_V
#undef PG8_WAIT_L
#undef PG8_BAR
#undef PG8_SCHED
}
}
#include <hip/hip_bf16.h>
#include <cmath>
namespace attn_body {
using bf16=__hip_bfloat16;
using bf16x8=__attribute__((ext_vector_type(8)))short;
using s16x4=__attribute__((ext_vector_type(4)))short;
using f32x16=__attribute__((ext_vector_type(16)))float;
using u32x4=__attribute__((ext_vector_type(4)))unsigned;
constexpr int NHEAD=8,D=64,DM=NHEAD*D,OPITCH=1024;
constexpr int NW=8,QBLK=32,QB=QBLK*NW,KVBLK=64;
constexpr int ATTN_PITCH=DM, ATTN_UNIT_ROWS=QB;
__device__ __forceinline__ int crow(int r,int hi){return (r&3)+8*(r>>2)+4*hi;}
#define SBAR() __builtin_amdgcn_sched_barrier(0)
__device__ __forceinline__ void cmask(f32x16&p0,f32x16&p1,int jb,int qrel,int hi){
  const float NEG=-INFINITY; int kb=64*jb+4*hi;
  #pragma unroll
  for(int r=0;r<16;++r){int kv=kb+(r&3)+8*(r>>2); if(kv>qrel)p0[r]=NEG; if(kv+32>qrel)p1[r]=NEG;}
}

constexpr int NSLOT=3, SLOTB=8192;
constexpr int LDS_K=0, LDS_V=NSLOT*SLOTB, LDS_WS=2*NSLOT*SLOTB, LDS_OST=LDS_WS+NW*64*4, LDS_CB=LDS_OST+NW*4096, LDS_BYTES=LDS_CB+32768;
constexpr float C2=0.125f*1.4426950408889634f;
__device__ __forceinline__ void glds16(const void*gsrc,unsigned lds_dst){unsigned keep;
  asm volatile("s_mov_b32 %0, m0\n\ts_mov_b32 m0, %2\n\ts_nop 0\n\tglobal_load_lds_dwordx4 %1, off\n\ts_mov_b32 m0, %0":"=&s"(keep):"v"(gsrc),"s"(lds_dst):"memory");}
__device__ __forceinline__ float max3f(float a,float b,float c){float r;asm("v_max3_f32 %0, %1, %2, %3":"=v"(r):"v"(a),"v"(b),"v"(c));return r;}
__device__ __forceinline__ float max2f(float a,float b){float r;asm("v_max_f32_e32 %0, %1, %2":"=v"(r):"v"(a),"v"(b));return r;}
__device__ __forceinline__ float fadd_s(float a,float b){float r;asm("v_add_f32_e32 %0, %1, %2":"=v"(r):"v"(a),"v"(b));return r;}
__device__ __forceinline__ float fsub_s(float a,float b){float r;asm("v_sub_f32_e32 %0, %1, %2":"=v"(r):"v"(a),"v"(b));return r;}
typedef float f32x2_t __attribute__((ext_vector_type(2))); typedef float f32x4_t __attribute__((ext_vector_type(4))); typedef __bf16 bf16x2_t __attribute__((ext_vector_type(2)));
__device__ __forceinline__ unsigned cvtpk_s(float lo,float hi){f32x2_t v={lo,hi};bf16x2_t b=__builtin_convertvector(v,bf16x2_t);return __builtin_bit_cast(unsigned,b);}
#define WAIT_BAR(N) asm volatile("s_waitcnt vmcnt(" #N ") lgkmcnt(0)\n\ts_barrier":::"memory")

__device__ __forceinline__ void qkt(f32x16&p0,f32x16&p1,const char*Kslot,const bf16x8*qr,int r32,int hi){
  const char*kb=Kslot+hi*1024+r32*16;
  #pragma unroll
  for(int d0=0;d0<4;++d0){
    const bf16x8 b0=*reinterpret_cast<const bf16x8*>(kb+d0*2048);
    const bf16x8 b1=*reinterpret_cast<const bf16x8*>(kb+d0*2048+512);
    p0=__builtin_amdgcn_mfma_f32_32x32x16_bf16(b0,qr[d0],p0,0,0,0);p1=__builtin_amdgcn_mfma_f32_32x32x16_bf16(b1,qr[d0],p1,0,0,0);}
}
typedef __attribute__((address_space(3))) const char* lds_cptr;
typedef short v4i16_t __attribute__((ext_vector_type(4)));
__device__ __forceinline__ void kload8(bf16x8*kf,lds_cptr kp){
  kf[0]=*(const __attribute__((address_space(3))) bf16x8*)(kp);      kf[1]=*(const __attribute__((address_space(3))) bf16x8*)(kp+512);
  kf[2]=*(const __attribute__((address_space(3))) bf16x8*)(kp+2048); kf[3]=*(const __attribute__((address_space(3))) bf16x8*)(kp+2560);
  kf[4]=*(const __attribute__((address_space(3))) bf16x8*)(kp+4096); kf[5]=*(const __attribute__((address_space(3))) bf16x8*)(kp+4608);
  kf[6]=*(const __attribute__((address_space(3))) bf16x8*)(kp+6144); kf[7]=*(const __attribute__((address_space(3))) bf16x8*)(kp+6656);
}
__device__ __forceinline__ void kload2(bf16x8*kf,lds_cptr kp,int j){ kf[2*j]=*(const __attribute__((address_space(3))) bf16x8*)(kp+j*2048); kf[2*j+1]=*(const __attribute__((address_space(3))) bf16x8*)(kp+j*2048+512); }
__device__ __forceinline__ s16x4 vtr(lds_cptr p){ return __builtin_bit_cast(s16x4,__builtin_amdgcn_ds_read_tr16_b64_v4i16((__attribute__((address_space(3))) v4i16_t*)p)); }
__device__ __forceinline__ float rowmax(const f32x16&p0,const f32x16&p1){
  float a=max3f(p0[0],p0[1],p1[0]),b=max3f(p0[2],p0[3],p1[1]);a=max3f(a,p1[2],p1[3]);
  #pragma unroll
  for(int r=4;r<16;r+=4){a=max3f(a,p0[r],p0[r+1]);b=max3f(b,p0[r+2],p0[r+3]);a=max3f(a,p1[r],p1[r+1]);b=max3f(b,p1[r+2],p1[r+3]);}
  const float m=max2f(a,b);
  auto rr=__builtin_amdgcn_permlane32_swap(__float_as_uint(m),__float_as_uint(m),false,false);
  return max2f(__uint_as_float(rr[0]),__uint_as_float(rr[1]));
}
__device__ __forceinline__ void pv(f32x16*o,int vb,bf16x8 pa0,bf16x8 pa1,bf16x8 pa2,bf16x8 pa3){
  #pragma unroll
  for(int d0=0;d0<2;++d0){s16x4 lo[4],hi[4];
    #pragma unroll
    for(int ks=0;ks<4;++ks){
      asm volatile("ds_read_b64_tr_b16 %0,%1 offset:%c2":"=&v"(lo[ks]):"v"(vb),"i"(d0*4096+ks*1024):"memory");
      asm volatile("ds_read_b64_tr_b16 %0,%1 offset:%c2":"=&v"(hi[ks]):"v"(vb),"i"(d0*4096+ks*1024+512):"memory");}
    asm volatile("s_waitcnt lgkmcnt(0)":::"memory");SBAR();
    #define PK(k) (bf16x8){lo[k][0],lo[k][1],lo[k][2],lo[k][3],hi[k][0],hi[k][1],hi[k][2],hi[k][3]}
    o[d0]=__builtin_amdgcn_mfma_f32_32x32x16_bf16(pa0,PK(0),o[d0],0,0,0);
    o[d0]=__builtin_amdgcn_mfma_f32_32x32x16_bf16(pa1,PK(1),o[d0],0,0,0);
    o[d0]=__builtin_amdgcn_mfma_f32_32x32x16_bf16(pa2,PK(2),o[d0],0,0,0);
    o[d0]=__builtin_amdgcn_mfma_f32_32x32x16_bf16(pa3,PK(3),o[d0],0,0,0);
    #undef PK
  }
}

#ifndef ATTN_STORE16
#define ATTN_STORE16(p,v) (*(u32x4*)(p)=(v))
#endif
template<int THRL> __device__ __forceinline__ void attn_unit(const bf16*Qb,const bf16*__restrict__ Kh,const bf16*__restrict__ Vh,bf16*Ob,int NT,int NTE,const float*cgp,int q0,int wlo,int whi,char*shm){
  int tid_=threadIdx.x; asm volatile("":"+v"(tid_)); const int tid=tid_,lane=tid&63,r32=lane&31,hi=lane>>5; const int wid=__builtin_amdgcn_readfirstlane(tid>>6);
  const bf16*Qw=Qb+(long)(wid*QBLK)*DM;
  const unsigned lds0=(unsigned)(uintptr_t)shm;
  float*wsf=(float*)(shm+LDS_WS)+wid*64;
  const bf16*ksrc=Kh+(long)((NT-1)*KVBLK+lane)*DM+wid*8;
  const bf16*vsrc=Vh+(long)((NT-1)*KVBLK+16*(wid&3)+(lane>>2))*DM+(wid>>2)*32+(lane&3)*8;
  const unsigned kdst=lds0+LDS_K+wid*1024, vdst=lds0+LDS_V+wid*1024;
  #define DMA_K(t,slot) glds16(ksrc-(long)(t)*KVBLK*DM,(unsigned)__builtin_amdgcn_readfirstlane(kdst+(slot)))
  #define DMA_V(t,slot) glds16(vsrc-(long)(t)*KVBLK*DM,(unsigned)__builtin_amdgcn_readfirstlane(vdst+(slot)))
  const int vb0=(int)(lds0+LDS_V)+((lane>>4)&1)*32+(lane&3)*8+(4*hi+((lane&15)>>2))*64;
  const char*Kbase=shm+LDS_K; bf16x8 kf[8];
  const lds_cptr shm3=(lds_cptr)shm; const lds_cptr kp0=shm3+LDS_K+hi*1024+r32*16; const lds_cptr vp0=shm3+LDS_V+((lane>>4)&1)*32+(lane&3)*8+(4*hi+((lane&15)>>2))*64;
  { typedef __attribute__((address_space(3))) float lf_t; lf_t* cbw=(lf_t*)((lds_cptr)shm+LDS_CB); const float c0=cgp[q0]; const int jlo=(NT-NTE)*KVBLK, jhi=NT*KVBLK;
    for(int j=jlo+tid;j<jhi;j+=NW*64) cbw[j]=c0-cgp[j]; }
  const __attribute__((address_space(3))) float* cbL=(const __attribute__((address_space(3))) float*)((lds_cptr)shm+LDS_CB)+4*hi;
  #define CBLOAD(C0,C1,t,MH) do{ const __attribute__((address_space(3))) float* cbp_=cbL+(NT-1-(t))*KVBLK; \
    _Pragma("unroll") for(int g_=0;g_<4;++g_){ const f32x4_t v0_=*(const __attribute__((address_space(3))) f32x4_t*)(cbp_+8*g_); const f32x4_t v1_=*(const __attribute__((address_space(3))) f32x4_t*)(cbp_+32+8*g_); \
      C0[4*g_]=v0_[0]-(MH);C0[4*g_+1]=v0_[1]-(MH);C0[4*g_+2]=v0_[2]-(MH);C0[4*g_+3]=v0_[3]-(MH); C1[4*g_]=v1_[0]-(MH);C1[4*g_+1]=v1_[1]-(MH);C1[4*g_+2]=v1_[2]-(MH);C1[4*g_+3]=v1_[3]-(MH);} }while(0)
  DMA_K(0,0);DMA_V(0,0);DMA_K(1,SLOTB);
  bf16x8 qr[4];
  #pragma unroll
  for(int d0=0;d0<4;++d0)qr[d0]=*reinterpret_cast<const bf16x8*>(&Qw[(long)r32*DM+d0*16+hi*8]);
  float mhat=0.f,l_reg=0.f;f32x16 o[2];o[0]=f32x16{};o[1]=f32x16{};
  const int qrel=wid*QBLK+r32;
  #define CMASK(P0,P1,t) do{int jb_=3-(t); if(jb_>=0)cmask(P0,P1,jb_,qrel,hi);}while(0)
  bool resc=false;
  #define START(P0,P1) do{ const float rm=rowmax(P0,P1); resc=false; \
    { const float dl=(rm>-1e30f)?rm:0.f; mhat=fadd_s(mhat,dl); \
      _Pragma("unroll") for(int r=0;r<16;++r){P0[r]=fsub_s(P0[r],dl);P1[r]=fsub_s(P1[r],dl);} } \
    _Pragma("unroll") for(int r=0;r<16;++r)P0[r]=__builtin_amdgcn_exp2f(P0[r]); }while(0)
  #define RESC() do{ if(resc){ asm volatile("s_waitcnt lgkmcnt(0)":::"memory"); \
      _Pragma("unroll") for(int d_=0;d_<2;++d_) _Pragma("unroll") for(int r=0;r<16;++r)o[d_][r]*=wsf[crow(r,hi)]; } }while(0)
  f32x16 pA0,pA1,pB0,pB1;
  int sl_prev=0,sl_cur=0,sl_next=SLOTB;
  #define ROT() do{sl_prev=sl_cur;sl_cur=sl_next;sl_next=(sl_next==(NSLOT-1)*SLOTB)?0:sl_next+SLOTB;}while(0)
  DMA_K(2,2*SLOTB);
  WAIT_BAR(3);
  CBLOAD(pA0,pA1,0,0.f); qkt(pA0,pA1,Kbase,qr,r32,hi);asm volatile("s_nop 15\n\ts_nop 7":"+v"(pA0),"+v"(pA1));CMASK(pA0,pA1,0);
  START(pA0,pA1);
  _Pragma("unroll") for(int r=0;r<16;++r)pA1[r]=__builtin_amdgcn_exp2f(pA1[r]);
  WAIT_BAR(0);
  DMA_K(3,0);DMA_V(1,SLOTB);
  ROT();
  kload8(kf,kp0+sl_cur);
  WAIT_BAR(2);
  s16x4 vlo[8],vhi[8]; u32x4 pw0,pw1,pw2,pw3;
  #define PKW(P,B) cvtpk_s(P[B],P[B+1])
  #define PAF(k) __builtin_bit_cast(bf16x8,pw##k)
  #define VFR(i) (bf16x8){vlo[i][0],vlo[i][1],vlo[i][2],vlo[i][3],vhi[i][0],vhi[i][1],vhi[i][2],vhi[i][3]}
  #define PIN(x) asm volatile("":"+v"(x))
  #define MX3(a,b,c) __builtin_fmaxf(__builtin_fmaxf((a),(b)),(c))
  #define GAPA(MF,A0,A1,A2,A3,W0,W1,PW) do{ MF; sacc+=A0; sacc+=A1; sacc+=A2; sacc+=A3; PIN(sacc); W0; W1; PIN(PW); SBAR(); }while(0)
  #define EX(v) __builtin_amdgcn_exp2f(v)
  #define GAPB(MF,X,B) do{ MF; X[B]=EX(X[B]); X[B+1]=EX(X[B+1]); X[B+2]=EX(X[B+2]); X[B+3]=EX(X[B+3]); PIN(X); SBAR(); }while(0)
  #define VRD(i) do{ vlo[i]=vtr(vp_+(((i)>>2)*4096+((i)&3)*1024)); vhi[i]=vtr(vp_+(((i)>>2)*4096+((i)&3)*1024+512)); }while(0)
  #define KRD(G,j) do{ if(G){ kload2(kf,kp0+sl_next,j); SBAR(); } }while(0)
  #define STEP(C0,C1,P0,P1,t,GK,GV,GL) do{ SBAR(); \
    const lds_cptr vp_=vp0+sl_prev; CBLOAD(C0,C1,t,mhat); SBAR(); \
    VRD(0); SBAR(); float sacc=(P0[0]+P0[1]); \
    GAPA(C0=__builtin_amdgcn_mfma_f32_32x32x16_bf16(kf[0],qr[0],C0,0,0,0), P0[2],P0[3],P0[4],P0[5],     pw0[0]=PKW(P0,0), pw0[1]=PKW(P0,2), pw0); \
    VRD(4); SBAR(); GAPA(C1=__builtin_amdgcn_mfma_f32_32x32x16_bf16(kf[1],qr[0],C1,0,0,0), P0[6],P0[7],P0[8],P0[9],     pw0[2]=PKW(P0,4), pw0[3]=PKW(P0,6), pw0); \
    VRD(1); SBAR(); GAPA(C0=__builtin_amdgcn_mfma_f32_32x32x16_bf16(kf[2],qr[1],C0,0,0,0),   P0[10],P0[11],P0[12],P0[13], pw1[0]=PKW(P0,8), pw1[1]=PKW(P0,10), pw1); \
    VRD(5); SBAR(); GAPA(C1=__builtin_amdgcn_mfma_f32_32x32x16_bf16(kf[3],qr[1],C1,0,0,0),   P0[14],P0[15],P1[0],P1[1],   pw1[2]=PKW(P0,12),pw1[3]=PKW(P0,14), pw1); \
    VRD(2); SBAR(); GAPA(C0=__builtin_amdgcn_mfma_f32_32x32x16_bf16(kf[4],qr[2],C0,0,0,0),   P1[2],P1[3],P1[4],P1[5],     pw2[0]=PKW(P1,0), pw2[1]=PKW(P1,2), pw2); \
    VRD(6); SBAR(); GAPA(C1=__builtin_amdgcn_mfma_f32_32x32x16_bf16(kf[5],qr[2],C1,0,0,0),   P1[6],P1[7],P1[8],P1[9],     pw2[2]=PKW(P1,4), pw2[3]=PKW(P1,6), pw2); \
    VRD(3); SBAR(); GAPA(C0=__builtin_amdgcn_mfma_f32_32x32x16_bf16(kf[6],qr[3],C0,0,0,0),   P1[10],P1[11],P1[12],P1[13], pw3[0]=PKW(P1,8), pw3[1]=PKW(P1,10), pw3); \
    VRD(7); SBAR(); GAPA(C1=__builtin_amdgcn_mfma_f32_32x32x16_bf16(kf[7],qr[3],C1,0,0,0),   P1[14],P1[15],0.f,0.f,       pw3[2]=PKW(P1,12),pw3[3]=PKW(P1,14), pw3); \
    l_reg+=sacc; \
    if(GK){DMA_K((t)+3,sl_cur);} if(GV){DMA_V((t)+1,sl_next);} \
    CMASK(C0,C1,t); \
    { float a=MX3(C0[0],C0[1],C1[0]),b=MX3(C0[2],C0[3],C1[1]); a=MX3(a,C1[2],C1[3]); \
      _Pragma("unroll") for(int r=4;r<16;r+=4){a=MX3(a,C0[r],C0[r+1]);b=MX3(b,C0[r+2],C0[r+3]);a=MX3(a,C1[r],C1[r+1]);b=MX3(b,C1[r+2],C1[r+3]);} \
      float rm=__builtin_fmaxf(a,b); { auto rr=__builtin_amdgcn_permlane32_swap(__float_as_uint(rm),__float_as_uint(rm),false,false); rm=__builtin_fmaxf(__uint_as_float(rr[0]),__uint_as_float(rr[1])); } \
      resc=false; \
      if(__builtin_expect(__any(rm>(float)THRL),0)){ const float dl=__builtin_fmaxf(rm,0.f); mhat+=dl; \
        _Pragma("unroll") for(int r=0;r<16;++r){C0[r]-=dl;C1[r]-=dl;} \
        const float f=__builtin_amdgcn_exp2f(-dl); l_reg*=f; if(hi==0)wsf[r32]=f; resc=true; } } \
    SBAR(); \
    GAPB(o[0]=__builtin_amdgcn_mfma_f32_32x32x16_bf16(PAF(0),VFR(0),o[0],0,0,0), C0,0); \
    GAPB(o[1]=__builtin_amdgcn_mfma_f32_32x32x16_bf16(PAF(0),VFR(4),o[1],0,0,0), C0,4); \
    KRD(GL,0); GAPB(o[0]=__builtin_amdgcn_mfma_f32_32x32x16_bf16(PAF(1),VFR(1),o[0],0,0,0), C0,8); \
    KRD(GL,1); GAPB(o[1]=__builtin_amdgcn_mfma_f32_32x32x16_bf16(PAF(1),VFR(5),o[1],0,0,0), C0,12); \
    KRD(GL,2); GAPB(o[0]=__builtin_amdgcn_mfma_f32_32x32x16_bf16(PAF(2),VFR(2),o[0],0,0,0), C1,0); \
    KRD(GL,3); GAPB(o[1]=__builtin_amdgcn_mfma_f32_32x32x16_bf16(PAF(2),VFR(6),o[1],0,0,0), C1,4); \
    GAPB(o[0]=__builtin_amdgcn_mfma_f32_32x32x16_bf16(PAF(3),VFR(3),o[0],0,0,0), C1,8); \
    GAPB(o[1]=__builtin_amdgcn_mfma_f32_32x32x16_bf16(PAF(3),VFR(7),o[1],0,0,0), C1,12); \
    }while(0)
  int t=1;
  for(;t<5&&t+5<NTE;t+=2){
    STEP(pB0,pB1,pA0,pA1,t,true,true,true);     WAIT_BAR(2); RESC(); ROT();
    STEP(pA0,pA1,pB0,pB1,t+1,true,true,true);   WAIT_BAR(2); RESC(); ROT();
  }
  #undef CMASK
  #define CMASK(P0,P1,t) do{}while(0)
  for(;t+5<NTE;t+=2){
    STEP(pB0,pB1,pA0,pA1,t,true,true,true);     WAIT_BAR(2); RESC(); ROT();
    STEP(pA0,pA1,pB0,pB1,t+1,true,true,true);   WAIT_BAR(2); RESC(); ROT();
  }
  #undef CMASK
  #define CMASK(P0,P1,t) do{int jb_=3-(t); if(jb_>=0)cmask(P0,P1,jb_,qrel,hi);}while(0)
  #define ENDW(tt) do{ if((tt)+3<NTE){WAIT_BAR(2);} else if((tt)+2<NTE){WAIT_BAR(1);} else {WAIT_BAR(0);} }while(0)
  for(;t+1<NTE;t+=2){
    STEP(pB0,pB1,pA0,pA1,t,(t+3<NTE),(t+1<NTE),(t+1<NTE));       ENDW(t);   RESC(); ROT();
    STEP(pA0,pA1,pB0,pB1,t+1,(t+4<NTE),(t+2<NTE),(t+2<NTE));     ENDW(t+1); RESC(); ROT();
  }
  STEP(pB0,pB1,pA0,pA1,NTE-1,false,false,false); RESC();
  { float sacc=pB0[0]+pB0[1]; _Pragma("unroll") for(int r=2;r<16;++r)sacc+=pB0[r]; _Pragma("unroll") for(int r=0;r<16;++r)sacc+=pB1[r]; l_reg+=sacc;
    pw0=(u32x4){PKW(pB0,0),PKW(pB0,2),PKW(pB0,4),PKW(pB0,6)};pw1=(u32x4){PKW(pB0,8),PKW(pB0,10),PKW(pB0,12),PKW(pB0,14)};pw2=(u32x4){PKW(pB1,0),PKW(pB1,2),PKW(pB1,4),PKW(pB1,6)};pw3=(u32x4){PKW(pB1,8),PKW(pB1,10),PKW(pB1,12),PKW(pB1,14)};
    SBAR(); pv(o,vb0+sl_cur,PAF(0),PAF(1),PAF(2),PAF(3)); }
  #undef PKW
  #undef PAF
  #undef VFR
  #undef PIN
  #undef MX3
  #undef GAPA
  #undef GAPB
  #undef EX
  #undef VRD
  #undef KRD
  #undef STEP
  #undef ENDW
  {auto rr=__builtin_amdgcn_permlane32_swap(__float_as_uint(l_reg),__float_as_uint(l_reg),false,false);l_reg=__uint_as_float(rr[0])+__uint_as_float(rr[1]);}
  if(hi==0)wsf[32+r32]=l_reg;asm volatile("s_waitcnt lgkmcnt(0)":::"memory");
  float rli[16];
  #pragma unroll
  for(int r=0;r<16;++r)rli[r]=__builtin_amdgcn_rcpf(wsf[32+crow(r,hi)]);
  bf16*Ow=Ob+(long)(wid*QBLK)*OPITCH;
  { bf16*stg=(bf16*)(shm+LDS_OST)+wid*2048;
    #pragma unroll
    for(int r=0;r<16;++r){const int orow=crow(r,hi);
      #pragma unroll
      for(int d0=0;d0<2;++d0)stg[orow*64+d0*32+r32]=__float2bfloat16(o[d0][r]*rli[r]);}
    asm volatile("s_waitcnt lgkmcnt(0)":::"memory");
    #pragma unroll
    for(int i=0;i<4;++i){const int row=i*8+(lane>>3),ch=lane&7; const u32x4 v=*(const u32x4*)(stg+row*64+ch*8); if(wid>=wlo&&wid<whi)ATTN_STORE16(Ow+(long)row*OPITCH+ch*8,v);} }
  asm volatile("s_waitcnt lgkmcnt(0)\n\ts_barrier":::"memory");
  #undef DMA_K
  #undef DMA_V
  #undef CMASK
  #undef START
  #undef RESC
  #undef ROT
  #undef CBLOAD
}
constexpr int ATTN_LDS_BYTES=LDS_BYTES;
#undef SBAR
#undef WAIT_BAR
}
#include <hip/hip_cooperative_groups.h>
namespace cg = cooperative_groups;
#ifndef MK_N_LAUNCHES
#define MK_N_LAUNCHES 1
#endif
#ifndef FOX_PRUNE
#define FOX_PRUNE 1
#endif
constexpr int NWAVES = 8, NTHR = 512;
constexpr int DMOD = 1024, TSEQ = 8192, NBATCH = 8, MP = NBATCH * TSEQ, MS = 512, MTOT = MP + MS;
constexpr int NIN = 3584, INC = 3592, FF = 4096, SSEQ = 1152, PAST = 1024, DSEQ = 32;
constexpr int NCHUNK = MTOT / 64;
constexpr float EPSN = 1e-6f, LOG2E = 1.4426950408889634f;
constexpr size_t MiB = 1u << 20;
constexpr size_t WS_CTL = 0, CTL_ZERO_BYTES = 4096;
constexpr size_t WS_WIN = 2 * MiB, WS_WO = 9 * MiB, WS_WUP = 11 * MiB, WS_WDN = 19 * MiB;
constexpr size_t WS_RSTD = 27 * MiB, WS_CGP = 28 * MiB, WS_CGS = 30 * MiB, WS_VEC = 31 * MiB, WS_SSQ = 38 * MiB;
constexpr size_t WS_X1B = 44 * MiB, WS_MIX = 174 * MiB, WS_H = 304 * MiB;
constexpr size_t WS_XB = 304 * MiB, WS_Q = 434 * MiB, WS_K = 498 * MiB, WS_V = 562 * MiB, WS_QS = 626 * MiB, WS_KS = 635 * MiB, WS_VS = 644 * MiB;
constexpr size_t WS_QR = 654 * MiB, WS_KR = 719 * MiB, WS_VH = 784 * MiB, WS_SG = 849 * MiB, WS_END = 914 * MiB;
constexpr size_t VECN = (size_t)NCHUNK * 512;
static_assert(WS_VEC + 3 * VECN * 4 <= WS_SSQ && WS_SSQ + (size_t)MTOT * 16 * 4 <= WS_X1B && WS_X1B + (size_t)MTOT * DMOD * 2 <= WS_MIX && WS_MIX + (size_t)MTOT * DMOD * 2 <= WS_H, "ws map");
static_assert(WS_H + (size_t)MTOT * FF * 2 <= WS_END && WS_XB + (size_t)MTOT * DMOD * 2 <= WS_Q && WS_SG + (size_t)MTOT * 512 * 2 <= WS_END, "ws map 2");
constexpr int CW_QUEUE = 64, CW_SUB = 128, NCHAINWG = 32;
constexpr size_t O_YP = 0, O_YS = O_YP + (size_t)MP * DMOD, O_KP = O_YS + (size_t)256 * DMOD, O_VP = O_KP + (size_t)MP * 512, O_LP = O_VP + (size_t)MP * 512,
                 O_HP = O_LP + (size_t)MP * 8, O_KS = O_HP + 524288, O_VS = O_KS + 131072, O_LS = O_VS + 131072, O_HS = O_LS + 2048, O_END = O_HS + 524288;
constexpr int RING_BYTES = 131072, MISC_OFF = RING_BYTES, LDS_BYTES = 135168;
static_assert(attn_body::ATTN_LDS_BYTES <= RING_BYTES, "attention LDS");

#define LAS __attribute__((address_space(3)))
typedef unsigned short bf16;
typedef unsigned v4u __attribute__((ext_vector_type(4)));
typedef unsigned v2u __attribute__((ext_vector_type(2)));
typedef float f32x4 __attribute__((ext_vector_type(4)));
typedef short bf16x8 __attribute__((ext_vector_type(8)));
#define LDS_WAIT() asm volatile("s_waitcnt lgkmcnt(0)" ::: "memory")
__device__ __forceinline__ unsigned pk2(float lo, float hi) { return pg8::cvt_pk_bf16(lo, hi); }
__device__ __forceinline__ float bf2f(unsigned short b) { return __uint_as_float(((unsigned)b) << 16); }
__device__ __forceinline__ float wave_sum(float v) {
#pragma unroll
    for (int o = 1; o < 64; o <<= 1) v += __shfl_xor(v, o);
    return v;
}
__device__ __forceinline__ bool row_map(int row, int& idx) { if (row < MP) { idx = row; return true; } const int rs = row - MP; idx = (rs >> 6) * 32 + (rs & 63); return (rs & 63) < 32; }

namespace pg8 {
struct OrderIn {
    StaticOrder so; int pn_off, extra, extra_pm0;
    __device__ bool next(int i, Unit& u) const {
        const long L = (long)i * so.G + so.c;
        if (L < so.nwg) { so.next(i, u); u.pn += pn_off; return true; }
        const long e = L - so.nwg; if (e >= extra) return false;
        u.pm = extra_pm0 + (int)(e >> 3); u.pn = (int)(e & 7); u.kofs = 0; return true;
    }
    __device__ __forceinline__ void a_ready(const Unit&) const {}
    __device__ __forceinline__ void done(const Unit&) const {}
};
#define DPP_SHR(v, n) __int_as_float(__builtin_amdgcn_update_dpp(0, __float_as_int(v), 0x110 + (n), 0xf, 0xf, false))
struct EpiIn {
    static constexpr bool PERM = false, AFTER_DRAIN = false;
    const float* rstd1; const float* lbl; const float* qg; const float* kg; unsigned char* ws; float* out;
    __device__ __forceinline__ void operator()(const f32x4 (&acc)[2][2][4][2], const Unit& u, int wr, int wc, int fr, int fq) const {
        const int pn = u.pn, rowb = u.pm * BM + wr * 64 + fr; const bool samp = u.pm >= (MP / BM);
        bf16_t* const QR = (bf16_t*)(ws + WS_QR); bf16_t* const KR = (bf16_t*)(ws + WS_KR); bf16_t* const VH = (bf16_t*)(ws + WS_VH); bf16_t* const SG = (bf16_t*)(ws + WS_SG); float* const vec = (float*)(ws + WS_VEC);
        float rs[2][4];
#pragma unroll
        for (int ai = 0; ai < 2; ++ai)
#pragma unroll
            for (int m = 0; m < 4; ++m) rs[ai][m] = rstd1[rowb + ai * HALF + m * 16];
        if (pn < 4) {
            const int h = pn, ch0 = 128 * h + 32 * wc + 4 * fq; const int lane = threadIdx.x & 63; const int a15 = ((lane & 48) | 15) << 2;
#pragma unroll
            for (int n = 0; n < 2; ++n) {
                const f32x4 l0 = *(const f32x4*)(lbl + ch0 + 16 * n), l1 = *(const f32x4*)(lbl + 512 + ch0 + 16 * n);
                f32x4 lb, omlb;
#pragma unroll
                for (int j = 0; j < 4; ++j) { lb[j] = 1.f / (1.f + __expf(l1[j] - l0[j])); omlb[j] = 1.f - lb[j]; }
#pragma unroll
                for (int ai = 0; ai < 2; ++ai) {
                    f32x4 bq[4], kk[4], bb[4]; f32x4 carry = {0.f, 0.f, 0.f, 0.f};
#pragma unroll
                    for (int m = 0; m < 4; ++m) {
#pragma unroll
                        for (int j = 0; j < 4; ++j) {
                            const float zq = acc[ai][0][m][n][j] * rs[ai][m], zf = acc[ai][1][m][n][j] * rs[ai][m];
                            const float sig = 1.f / (1.f + __expf(-zf)); const float f = lb[j] + omlb[j] * sig; float k = omlb[j] * (1.f - sig); float s = __logf(f);
                            if (samp && m >= 2) { s = 0.f; k = 0.f; }
                            s += DPP_SHR(s, 1); s += DPP_SHR(s, 2); s += DPP_SHR(s, 4); s += DPP_SHR(s, 8);
                            s += carry[j]; carry[j] = __int_as_float(__builtin_amdgcn_ds_bpermute(a15, __float_as_int(s)));
                            bq[m][j] = zq; kk[m][j] = k; bb[m][j] = s;
                        }
                    }
#pragma unroll
                    for (int m = 0; m < 4; ++m) {
                        float qv[4], kv[4];
#pragma unroll
                        for (int j = 0; j < 4; ++j) { qv[j] = bq[m][j] * __expf(bb[m][j]); kv[j] = kk[m][j] * __expf(-bb[m][j]); }
                        const size_t off = (size_t)(rowb + ai * HALF + m * 16) * 512 + ch0 + 16 * n;
                        v2u wq; wq.x = cvt_pk_bf16(qv[0], qv[1]); wq.y = cvt_pk_bf16(qv[2], qv[3]); *(v2u*)(QR + off) = wq;
                        v2u wk; wk.x = cvt_pk_bf16(kv[0], kv[1]); wk.y = cvt_pk_bf16(kv[2], kv[3]); *(v2u*)(KR + off) = wk;
                    }
                    if (fr == 0) {
                        const size_t voff = (size_t)((u.pm * BM + ai * HALF + wr * 64) >> 6) * 512 + ch0 + 16 * n;
                        f32x4 d;
#pragma unroll
                        for (int j = 0; j < 4; ++j) d[j] = __expf(carry[j]);
                        *(f32x4*)(vec + voff) = d;
                    }
                }
            }
        } else if (pn < 8) {
            const int h = pn - 4, c0 = 128 * h + 32 * wc + 4 * fq;
#pragma unroll
            for (int ai = 0; ai < 2; ++ai)
#pragma unroll
                for (int m = 0; m < 4; ++m) { const size_t off = (size_t)(rowb + ai * HALF + m * 16) * 512 + c0; const float r = rs[ai][m];
#pragma unroll
                    for (int n = 0; n < 2; ++n) { const f32x4 v = acc[ai][0][m][n] * r; f32x4 g = acc[ai][1][m][n] * r;
#pragma unroll
                        for (int j = 0; j < 4; ++j) g[j] = g[j] / (1.f + __expf(-g[j]));
                        v2u wv; wv.x = cvt_pk_bf16(v[0], v[1]); wv.y = cvt_pk_bf16(v[2], v[3]); *(v2u*)(VH + off + 16 * n) = wv;
                        v2u wg; wg.x = cvt_pk_bf16(g[0], g[1]); wg.y = cvt_pk_bf16(g[2], g[3]); *(v2u*)(SG + off + 16 * n) = wg; } }
        } else if (pn < 12) {
            const bool isK = pn >= 10; const int head = 4 * ((pn - 8) & 1) + wc; const float* gain = isK ? kg : qg; const float osc = isK ? 1.f : attn_body::C2;
            f32x4 gv[2][2];
#pragma unroll
            for (int bj = 0; bj < 2; ++bj)
#pragma unroll
                for (int n = 0; n < 2; ++n) gv[bj][n] = *(const f32x4*)(gain + 32 * bj + 16 * n + 4 * fq) * osc;
#pragma unroll
            for (int ai = 0; ai < 2; ++ai)
#pragma unroll
                for (int m = 0; m < 4; ++m) { const int row = rowb + ai * HALF + m * 16; const float r = rs[ai][m]; float ssq = 0.f;
#pragma unroll
                    for (int bj = 0; bj < 2; ++bj)
#pragma unroll
                        for (int n = 0; n < 2; ++n) { const f32x4 z = acc[ai][bj][m][n] * r; ssq += (z[0] * z[0] + z[1] * z[1]) + (z[2] * z[2] + z[3] * z[3]); }
                    ssq += __shfl_xor(ssq, 16); ssq += __shfl_xor(ssq, 32);
                    const float r2 = r / sqrtf(ssq * (1.f / 64.f) + EPSN);
                    int idx; const bool valid = row_map(row, idx);
                    float* ofp = out + (samp ? O_KS : O_KP) + (size_t)idx * 512;
                    const size_t boff = samp ? (isK ? WS_KS : WS_QS) : (isK ? WS_K : WS_Q); const size_t brow = samp ? (size_t)((idx >> 5) * SSEQ + PAST + (idx & 31)) : (size_t)row;
                    bf16_t* bfp = (bf16_t*)(ws + boff) + brow * 512;
                    if (valid) {
#pragma unroll
                        for (int bj = 0; bj < 2; ++bj)
#pragma unroll
                            for (int n = 0; n < 2; ++n) { const f32x4 v = acc[ai][bj][m][n] * r2 * gv[bj][n]; const int col = 64 * head + 32 * bj + 16 * n + 4 * fq;
                                if (isK) *(f32x4*)(ofp + col) = v;
                                v2u w; w.x = cvt_pk_bf16(v[0], v[1]); w.y = cvt_pk_bf16(v[2], v[3]); *(v2u*)(bfp + col) = w; } } }
        } else {
            const int c0 = 256 * (pn - 12) + 32 * wc + 4 * fq;
#pragma unroll
            for (int ai = 0; ai < 2; ++ai)
#pragma unroll
                for (int m = 0; m < 4; ++m) { const int row = rowb + ai * HALF + m * 16; const float r = rs[ai][m];
                    int idx; const bool valid = row_map(row, idx);
                    float* ofp = out + (samp ? O_VS : O_VP) + (size_t)idx * 512;
                    const size_t brow = samp ? (size_t)((idx >> 5) * SSEQ + PAST + (idx & 31)) : (size_t)row;
                    bf16_t* bfp = (bf16_t*)(ws + (samp ? WS_VS : WS_V)) + brow * 512;
                    if (valid) {
#pragma unroll
                        for (int bj = 0; bj < 2; ++bj)
#pragma unroll
                            for (int n = 0; n < 2; ++n) { const f32x4 v = acc[ai][bj][m][n] * r; const int col = c0 + 128 * bj + 16 * n;
                                *(f32x4*)(ofp + col) = v;
                                v2u w; w.x = cvt_pk_bf16(v[0], v[1]); w.y = cvt_pk_bf16(v[2], v[3]); *(v2u*)(bfp + col) = w; } } }
        }
    }
};
struct EpiWo {
    static constexpr bool PERM = false, AFTER_DRAIN = false;
    const float* xp; const float* xs; float* yp; float* ys; bf16_t* X1B; float* ssq;
    __device__ __forceinline__ void operator()(const f32x4 (&acc)[2][2][4][2], const Unit& u, int wr, int wc, int fr, int fq) const {
        const int rowb = u.pm * BM + wr * 64 + fr, c0 = u.pn * BM + wc * 32 + 4 * fq; const bool samp = u.pm >= (MP / BM);
#pragma unroll
        for (int ai = 0; ai < 2; ++ai)
#pragma unroll
            for (int m = 0; m < 4; ++m) { const int row = rowb + ai * HALF + m * 16; int idx; const bool valid = row_map(row, idx);
                const float* xr = (samp ? xs : xp) + (size_t)idx * DMOD; float* yr = yp + (samp ? (size_t)MP * DMOD : (size_t)0) + (size_t)idx * DMOD; float s = 0.f;
#pragma unroll
                for (int bj = 0; bj < 2; ++bj)
#pragma unroll
                    for (int n = 0; n < 2; ++n) { const int col = c0 + 128 * bj + 16 * n; f32x4 v = acc[ai][bj][m][n];
                        if (valid) { v += *(const f32x4*)(xr + col); *(f32x4*)(yr + col) = v; }
                        s += (v[0] * v[0] + v[1] * v[1]) + (v[2] * v[2] + v[3] * v[3]);
                        v2u w; w.x = cvt_pk_bf16(v[0], v[1]); w.y = cvt_pk_bf16(v[2], v[3]); *(v2u*)(X1B + (size_t)row * DMOD + col) = w; }
                s += __shfl_xor(s, 16); s += __shfl_xor(s, 32);
                if (fq == 0) ssq[(size_t)row * 16 + 4 * u.pn + wc] = s; }
    }
};
struct EpiUp {
    static constexpr bool PERM = true, AFTER_DRAIN = false;
    bf16_t* O; const float* ssq;
    __device__ __forceinline__ void operator()(const f32x4 (&acc)[2][2][4][2], const Unit& u, int wr, int wc, int fr, int fq) const {
        const int row0 = u.pm * BM + wr * 64 + fr, col0 = u.pn * BM + wc * 32 + 8 * fq;
#pragma unroll
        for (int ai = 0; ai < 2; ++ai)
#pragma unroll
            for (int m = 0; m < 4; ++m) { const int row = row0 + ai * HALF + m * 16; const f32x4* sp = (const f32x4*)(ssq + (size_t)row * 16);
                const f32x4 s0 = sp[0], s1 = sp[1], s2 = sp[2], s3 = sp[3]; const f32x4 st = (s0 + s1) + (s2 + s3);
                const float r = 1.f / sqrtf(((st[0] + st[1]) + (st[2] + st[3])) * (1.f / DMOD) + EPSN);
                bf16_t* rowp = O + (size_t)row * FF + col0;
#pragma unroll
                for (int bj = 0; bj < 2; ++bj) { f32x4 v0 = acc[ai][bj][m][0] * r, v1 = acc[ai][bj][m][1] * r;
#pragma unroll
                    for (int j = 0; j < 4; ++j) { v0[j] = fmaxf(v0[j], 0.f); v0[j] *= v0[j]; v1[j] = fmaxf(v1[j], 0.f); v1[j] *= v1[j]; }
                    u32x4 w; w.x = cvt_pk_bf16(v0[0], v0[1]); w.y = cvt_pk_bf16(v0[2], v0[3]); w.z = cvt_pk_bf16(v1[0], v1[1]); w.w = cvt_pk_bf16(v1[2], v1[3]);
                    *(u32x4*)(rowp + bj * HALF) = w; } }
    }
};
struct OrderDown {
    StaticOrder so; int mode;
    static constexpr int KSPLIT = 4;
    __device__ bool next(int i, Unit& u) const {
        if (mode) return so.next(i, u);
        const long L = (long)i * so.G + so.c; if (L >= 8 * KSPLIT) return false;
        const int t = (int)L / KSPLIT, ks = (int)L % KSPLIT; u.pm = MP / BM + (t >> 2); u.pn = t & 3; u.kofs = ks * (FF / KSPLIT); return true;
    }
    __device__ __forceinline__ void a_ready(const Unit&) const {}
    __device__ __forceinline__ void done(const Unit&) const {}
};
struct EpiDown {
    static constexpr bool PERM = false, AFTER_DRAIN = false;
    float* yp; float* ys; int atomic;
    __device__ __forceinline__ void operator()(const f32x4 (&acc)[2][2][4][2], const Unit& u, int wr, int wc, int fr, int fq) const {
        const int rowb = u.pm * BM + wr * 64 + fr, c0 = u.pn * BM + wc * 32 + 4 * fq; const bool samp = u.pm >= (MP / BM);
#pragma unroll
        for (int ai = 0; ai < 2; ++ai)
#pragma unroll
            for (int m = 0; m < 4; ++m) { const int row = rowb + ai * HALF + m * 16; int idx; const bool valid = row_map(row, idx);
                float* yr = yp + (samp ? (size_t)MP * DMOD : (size_t)0) + (size_t)idx * DMOD;
                if (valid) {
#pragma unroll
                    for (int bj = 0; bj < 2; ++bj)
#pragma unroll
                        for (int n = 0; n < 2; ++n) { const int col = c0 + 128 * bj + 16 * n;
                            if (atomic) {
#pragma unroll
                                for (int j = 0; j < 4; ++j) __hip_atomic_fetch_add(yr + col + j, acc[ai][bj][m][n][j], __ATOMIC_RELAXED, __HIP_MEMORY_SCOPE_AGENT);
                            } else *(f32x4*)(yr + col) = *(const f32x4*)(yr + col) + acc[ai][bj][m][n]; } } }
    }
};
}

struct Args { const float* in[17]; float* out; unsigned char* ws; int ph_lo, ph_hi; };
struct Frame {
    LAS unsigned char* lds; volatile LAS unsigned* MISC; unsigned* ctl; unsigned char* ws; float* out;
    int tid, lane, wave, vcu, G;
    const float *xp, *xs, *ck, *cv, *clf, *sh, *n1, *win, *bff, *qg, *kg, *lbl, *hon, *wout, *n2, *wup, *wdn;
};

__device__ __forceinline__ int win_src_col(int g) {
    const int j0 = 32 * g, tile = j0 >> 8, jl = j0 & 255;
    if (tile < 4) return (jl < 128) ? (128 * tile + jl) : (512 + 128 * tile + (jl - 128));
    if (tile < 8) { const int h = tile - 4; return (jl < 128) ? (1024 + 128 * h + jl) : (1536 + 128 * h + (jl - 128)); }
    if (tile < 12) { const int base = tile < 10 ? 2048 : 2560, tl = (tile - 8) & 1, bj = jl >> 7, wc = (jl >> 5) & 3; return base + 64 * (4 * tl + wc) + 32 * bj; }
    return 3072 + (j0 - 12 * 256);
}
__device__ __forceinline__ void p0_transpose_item(const float* W, int ldw, int K, const float* nrm, bf16* WT, int n0, int src0, int k0, LAS float* scr, int lane) {
    float vals[32]; const float* wp = W + (size_t)(k0 + (lane >> 5)) * ldw + src0 + (lane & 31);
#pragma unroll
    for (int i = 0; i < 32; ++i) vals[i] = wp[(size_t)(2 * i) * ldw];
    const int c = lane & 7;
    f32x4 n0v = {1.f, 1.f, 1.f, 1.f}, n1v = {1.f, 1.f, 1.f, 1.f};
    if (nrm) { n0v = *(const f32x4*)(nrm + k0 + 8 * c); n1v = *(const f32x4*)(nrm + k0 + 8 * c + 4); }
#pragma unroll
    for (int i = 0; i < 32; ++i) scr[(2 * i + (lane >> 5)) * 33 + (lane & 31)] = vals[i];
    LDS_WAIT(); asm volatile("" ::: "memory");
#pragma unroll
    for (int j = 0; j < 4; ++j) { const int n = (lane >> 3) + 8 * j; const LAS float* s = scr + (8 * c) * 33 + n;
        v4u o; o.x = pk2(s[0 * 33] * n0v[0], s[1 * 33] * n0v[1]); o.y = pk2(s[2 * 33] * n0v[2], s[3 * 33] * n0v[3]); o.z = pk2(s[4 * 33] * n1v[0], s[5 * 33] * n1v[1]); o.w = pk2(s[6 * 33] * n1v[2], s[7 * 33] * n1v[3]);
        *(v4u*)(WT + (size_t)(n0 + n) * K + k0 + 8 * c) = o; }
    LDS_WAIT(); asm volatile("" ::: "memory");
}
__device__ __forceinline__ void p0_prologue(Frame& F) {
    LAS float* scr = (LAS float*)(F.lds + F.wave * 16384);
    const int gw = F.vcu * NWAVES + F.wave, NGW = F.G * NWAVES, lane = F.lane;
    bf16* Win_t = (bf16*)(F.ws + WS_WIN); bf16* Wo_t = (bf16*)(F.ws + WS_WO); bf16* Wup_t = (bf16*)(F.ws + WS_WUP); bf16* Wdn_t = (bf16*)(F.ws + WS_WDN);
    constexpr int I_IN = 16 * (NIN / 32), I_O = 16 * 32, I_UP = 16 * (FF / 32), I_DN = 64 * 32, NITEMS = I_IN + I_O + I_UP + I_DN;
    for (int it = gw; it < NITEMS; it += NGW) {
        int r = it;
        if (r < I_IN) { const int kb = r / (NIN / 32), g = r % (NIN / 32); p0_transpose_item(F.win, INC, DMOD, F.n1, Win_t, 32 * g, win_src_col(g), 64 * kb, scr, lane); continue; } r -= I_IN;
        if (r < I_O) { const int kb = r / 32, g = r % 32; p0_transpose_item(F.wout, DMOD, DMOD, nullptr, Wo_t, 32 * g, 32 * g, 64 * kb, scr, lane); continue; } r -= I_O;
        if (r < I_UP) { const int kb = r / (FF / 32), g = r % (FF / 32); p0_transpose_item(F.wup, FF, DMOD, F.n2, Wup_t, 32 * g, 32 * g, 64 * kb, scr, lane); continue; } r -= I_UP;
        { const int kb = r / 32, g = r % 32; p0_transpose_item(F.wdn, DMOD, FF, nullptr, Wdn_t, 32 * g, 32 * g, 64 * kb, scr, lane); }
    }
    { const int gt = F.vcu * NTHR + F.tid, NGT = F.G * NTHR;
      bf16* Qs = (bf16*)(F.ws + WS_QS); bf16* Ks = (bf16*)(F.ws + WS_KS); bf16* Vs = (bf16*)(F.ws + WS_VS);
      for (int i = gt; i < NBATCH * PAST * 64; i += NGT) { const int b = i / (PAST * 64), rem = i % (PAST * 64); const size_t so = (size_t)i * 8, dof = ((size_t)b * SSEQ * 64 + rem) * 8;
          const f32x4 a0 = *(const f32x4*)(F.ck + so), a1 = *(const f32x4*)(F.ck + so + 4), b0 = *(const f32x4*)(F.cv + so), b1 = *(const f32x4*)(F.cv + so + 4);
          v4u o; o.x = pk2(a0[0], a0[1]); o.y = pk2(a0[2], a0[3]); o.z = pk2(a1[0], a1[1]); o.w = pk2(a1[2], a1[3]); *(v4u*)(Ks + dof) = o;
          o.x = pk2(b0[0], b0[1]); o.y = pk2(b0[2], b0[3]); o.z = pk2(b1[0], b1[1]); o.w = pk2(b1[2], b1[3]); *(v4u*)(Vs + dof) = o; }
      const v4u z = {0u, 0u, 0u, 0u};
      for (int i = gt; i < NBATCH * SSEQ * 64; i += NGT) *(v4u*)(Qs + (size_t)i * 8) = z;
      for (int i = gt; i < NBATCH * (SSEQ - PAST) * 64; i += NGT) { const int b = i / ((SSEQ - PAST) * 64), rem = i % ((SSEQ - PAST) * 64); const size_t dof = ((size_t)(b * SSEQ + PAST) * 64 + rem) * 8; *(v4u*)(Ks + dof) = z; *(v4u*)(Vs + dof) = z; }
    }
    float wf[4][4][8];
#pragma unroll
    for (int j = 0; j < 4; ++j)
#pragma unroll
        for (int i = 0; i < 4; ++i) { const int k = 256 * j + 4 * lane + i; const float nk = F.n1[k]; const f32x4 a = *(const f32x4*)(F.win + (size_t)k * INC + NIN), b = *(const f32x4*)(F.win + (size_t)k * INC + NIN + 4);
            wf[j][i][0] = a[0] * nk; wf[j][i][1] = a[1] * nk; wf[j][i][2] = a[2] * nk; wf[j][i][3] = a[3] * nk; wf[j][i][4] = b[0] * nk; wf[j][i][5] = b[1] * nk; wf[j][i][6] = b[2] * nk; wf[j][i][7] = b[3] * nk; }
    float* rstd1 = (float*)(F.ws + WS_RSTD); bf16* XB = (bf16*)(F.ws + WS_XB);
    f32x4 vn[4];
#define P0_LOADROW(mm) do { int idx_; const bool val_ = (mm) < MTOT && row_map((mm), idx_); const float* xr_ = ((mm) < MP ? F.xp : F.xs) + (size_t)idx_ * DMOD; \
        _Pragma("unroll") for (int j = 0; j < 4; ++j) vn[j] = val_ ? *((const f32x4*)xr_ + 64 * j + lane) : (f32x4){0.f, 0.f, 0.f, 0.f}; } while (0)
    P0_LOADROW(gw);
    for (int m = gw; m < MTOT; m += NGW) {
        int idx; const bool valid = row_map(m, idx);
        f32x4 v[4]; float s = 0.f;
#pragma unroll
        for (int j = 0; j < 4; ++j) v[j] = vn[j];
        P0_LOADROW(m + NGW);
#pragma unroll
        for (int j = 0; j < 4; ++j) s += (v[j][0] * v[j][0] + v[j][1] * v[j][1]) + (v[j][2] * v[j][2] + v[j][3] * v[j][3]);
        const float rstd = 1.f / sqrtf(wave_sum(s) * (1.f / DMOD) + EPSN);
        if (lane == 0) rstd1[m] = rstd;
        unsigned long long* o8 = (unsigned long long*)(XB + (size_t)m * DMOD) + lane;
#pragma unroll
        for (int j = 0; j < 4; ++j) o8[64 * j] = (unsigned long long)pk2(v[j][0], v[j][1]) | ((unsigned long long)pk2(v[j][2], v[j][3]) << 32);
        float a8[8];
#pragma unroll
        for (int h = 0; h < 8; ++h) { float a = 0.f;
#pragma unroll
            for (int j = 0; j < 4; ++j)
#pragma unroll
                for (int i = 0; i < 4; ++i) a += v[j][i] * wf[j][i][h];
            a8[h] = a; }
        float b4[4], c2[2], dsum;
#pragma unroll
        for (int i = 0; i < 4; ++i) { const bool hi_ = (lane & 32) != 0; const float send = hi_ ? a8[i] : a8[4 + i], keep = hi_ ? a8[4 + i] : a8[i]; b4[i] = keep + __shfl_xor(send, 32); }
#pragma unroll
        for (int i = 0; i < 2; ++i) { const bool hi_ = (lane & 16) != 0; const float send = hi_ ? b4[i] : b4[2 + i], keep = hi_ ? b4[2 + i] : b4[i]; c2[i] = keep + __shfl_xor(send, 16); }
        { const bool hi_ = (lane & 8) != 0; const float send = hi_ ? c2[0] : c2[1], keep = hi_ ? c2[1] : c2[0]; dsum = keep + __shfl_xor(send, 8); }
        dsum += __shfl_xor(dsum, 4); dsum += __shfl_xor(dsum, 2); dsum += __shfl_xor(dsum, 1);
        { const int hh = (lane >> 3) & 7; const float xx = dsum * rstd + F.bff[hh]; const float ls = fminf(xx, 0.f) - log1pf(expf(-fabsf(xx)));
          if (valid && (lane & 7) == 0) { float* lp = (m < MP ? F.out + O_LP : F.out + O_LS) + (size_t)idx * 8; lp[hh] = ls; } }
    }
}
__device__ __forceinline__ void scan_chain(Frame& F, int ch) {
    LAS float* wsum = (LAS float*)F.lds;
    const bool samp = ch >= 64; const int c2 = samp ? ch - 64 : ch, b = c2 >> 3, h = c2 & 7; const int L = samp ? SSEQ : TSEQ, EPT = samp ? 3 : 16;
    float* dst = samp ? (float*)(F.ws + WS_CGS) + (size_t)c2 * SSEQ : (float*)(F.ws + WS_CGP) + (size_t)c2 * TSEQ;
    float vals[16]; float sum = 0.f;
#pragma unroll
    for (int i = 0; i < 16; ++i) { const int p = F.tid * EPT + i; float v = 0.f;
        if (i < EPT && p < L) { if (!samp) v = F.out[O_LP + ((size_t)b * TSEQ + p) * 8 + h]; else if (p < PAST) v = F.clf[((size_t)b * PAST + p) * 8 + h]; else if (p < PAST + DSEQ) v = F.out[O_LS + ((size_t)b * DSEQ + (p - PAST)) * 8 + h]; }
        sum += v; vals[i] = sum; }
    float incl = sum;
#pragma unroll
    for (int o = 1; o < 64; o <<= 1) { const float t = __shfl_up(incl, o); if (F.lane >= o) incl += t; }
    if (F.lane == 63) wsum[F.wave] = incl;
    __syncthreads();
    float base = 0.f;
    for (int w = 0; w < F.wave; ++w) base += wsum[w];
    const float excl = base + incl - sum;
#pragma unroll
    for (int i = 0; i < 16; ++i) { const int p = F.tid * EPT + i; if (i < EPT && p < L) dst[p] = (excl + vals[i]) * LOG2E; }
    __syncthreads();
}
constexpr int KP = 320  , H_QR = 0, H_KR = 17408, H_KT = 37888, H_VT = 58368, H_VEC = 71680, H_AL = 73216, H_OL = 82432, H_END = 116224;
static_assert(H_END <= RING_BYTES, "hgrn LDS");
typedef short v4i16_t __attribute__((ext_vector_type(4)));
__device__ __forceinline__ bf16x8 tr_frag(LAS unsigned char* p) {
    const v4i16_t lo = __builtin_amdgcn_ds_read_tr16_b64_v4i16((LAS v4i16_t*)p), hi = __builtin_amdgcn_ds_read_tr16_b64_v4i16((LAS v4i16_t*)(p + 4 * KP));
    return (bf16x8){lo[0], lo[1], lo[2], lo[3], hi[0], hi[1], hi[2], hi[3]};
}
__device__ __forceinline__ f32x4 mfma16(bf16x8 a, bf16x8 b, f32x4 c) { return __builtin_amdgcn_mfma_f32_16x16x32_bf16(a, b, c, 0, 0, 0); }
#define LAUNDER(x) asm volatile("" : "+v"(x))
#ifndef PR_A
#define PR_A 1
#endif
#ifndef PR_O
#define PR_O 1
#endif
#ifndef PR_OUT
#define PR_OUT 1
#endif
#ifndef PR_U
#define PR_U 0
#endif
#ifndef PR_ST
#define PR_ST 1
#endif
#ifndef PR_BAR
#define PR_BAR 1
#endif
#define HG_BAR() do { for (int rb_ = 0; rb_ < PR_BAR; ++rb_) { asm volatile("s_waitcnt lgkmcnt(0)" ::: "memory"); __builtin_amdgcn_s_barrier(); asm volatile("" ::: "memory"); } } while (0)
__device__ __forceinline__ void hgrn_chain(Frame& F, int row0, int chunk0, int nsteps, int h, const float* S0, float* Sout) {
    LAS unsigned char* L = F.lds; int tid_ = F.tid; LAUNDER(tid_); const int tid = tid_, lane = tid & 63, w = F.wave, l15 = lane & 15, fq = lane >> 4;
    const char* qb = (const char*)(F.ws + WS_QR) + ((size_t)row0 * 512 + 128 * h) * 2; const char* kb_ = (const char*)(F.ws + WS_KR) + ((size_t)row0 * 512 + 128 * h) * 2;
    const char* vb = (const char*)(F.ws + WS_VH) + ((size_t)row0 * 512 + 128 * h) * 2; const char* gb = (const char*)(F.ws + WS_SG) + ((size_t)row0 * 512 + 128 * h) * 2;
    const char* eb = (const char*)(F.ws + WS_VEC) + ((size_t)chunk0 * 512 + 128 * h) * 4; char* mb = (char*)(F.ws + WS_MIX) + ((size_t)row0 * DMOD + 128 * h) * 2;
    const int oc = tid >> 3, oseg = tid & 7;
    unsigned vo_rm = (unsigned)((tid >> 4) * 1024 + (tid & 15) * 16), vo_sg = (unsigned)(oc * 1024 + oseg * 32), vo_mix = (unsigned)(oc * 2048 + oseg * 32);
    unsigned vo_vec = (unsigned)((tid & 31) * 16);
    unsigned l_rm = (unsigned)(H_QR + (tid >> 4) * 272 + (tid & 15) * 16), l_rk = (unsigned)(H_KR + (tid >> 4) * KP + (tid & 15) * 16);
    unsigned l_vw = (unsigned)(H_VEC + (tid & 31) * 16);
    unsigned l_aq = (unsigned)(H_QR + (16 * (w >> 1) + l15) * 272 + fq * 16);
    unsigned l_ak = (unsigned)(H_KR + (32 * (w & 1) + l15) * KP + fq * 16);
    unsigned l_aw = (unsigned)(H_AL + (16 * (w >> 1) + 4 * fq) * 144 + (32 * (w & 1) + l15) * 2);
    unsigned l_vt = (unsigned)(H_KT + (8 * fq + (l15 >> 2)) * KP + (16 * w + 4 * (l15 & 3)) * 2);
    unsigned l_q2 = (unsigned)(H_QR + l15 * 272 + fq * 16);
    unsigned l_al = (unsigned)(H_AL + l15 * 144 + fq * 16);
    unsigned l_kt = (unsigned)(H_KR + (8 * fq + (l15 >> 2)) * KP + (8 * (l15 & 3)) * 2);
    unsigned l_ve = (unsigned)(H_VEC + fq * 32);
    unsigned l_ow = (unsigned)(H_OL + (4 * fq) * 528 + (16 * w + l15) * 4);
    unsigned l_or = (unsigned)(H_OL + oc * 528 + oseg * 64);
    f32x4 S[8];
#pragma unroll
    for (int kb = 0; kb < 8; ++kb) S[kb] = (f32x4){0.f, 0.f, 0.f, 0.f};
    if (S0) { const float* sp = S0 + (8 * fq) * 128 + 16 * w + l15;
#pragma unroll
        for (int kb = 0; kb < 8; ++kb) { LAUNDER(sp);
#pragma unroll
            for (int r = 0; r < 4; ++r) S[kb][r] = sp[r * 128];
            sp += (kb & 1) ? 28 * 128 : 4 * 128; } }
    f32x4 gn[4];
#pragma unroll
    for (int i = 0; i < 4; ++i) gn[i] = *(const f32x4*)(F.hon + 128 * h + 16 * oseg + 4 * i);
    v4u pq[2][2], pk[2][2], pv[2][2], psg[2][2], pvec[2]; int cl = 0, gl = 0;
#define HG_LOADS(SET) do { \
        _Pragma("unroll") for (int it = 0; it < 2; ++it) { pq[SET][it] = *(const v4u*)(qb + vo_rm + it * 32768); pk[SET][it] = *(const v4u*)(kb_ + vo_rm + it * 32768); pv[SET][it] = *(const v4u*)(vb + vo_rm + it * 32768); } \
        pvec[SET] = *(const v4u*)(eb + vo_vec); } while (0)
#define HG_STORE(SET) do { \
        _Pragma("unroll") for (int it = 0; it < 2; ++it) { *(LAS v4u*)(L + l_rm + it * 8704) = pq[SET][it]; *(LAS v4u*)(L + l_rk + it * 32 * KP) = pk[SET][it]; *(LAS v4u*)(L + l_rk + (H_KT - H_KR) + it * 32 * KP) = pv[SET][it]; } \
        if (tid < 32) *(LAS v4u*)(L + l_vw) = pvec[SET]; } while (0)
#define HG_ADV() do { const int a_ = (cl + 1 < nsteps) ? 1 : 0; qb += a_ * 65536; kb_ += a_ * 65536; vb += a_ * 65536; eb += a_ * 2048; cl += a_; } while (0)
    HG_LOADS(0); HG_ADV(); HG_STORE(0); HG_LOADS(1); HG_ADV();
    psg[0][0] = *(const v4u*)(gb + vo_sg); psg[0][1] = *(const v4u*)(gb + vo_sg + 16); { const int a_ = (gl + 1 < nsteps) ? 1 : 0; gb += a_ * 65536; gl += a_; }
    HG_BAR();
#define HG_BODY(CUR, NXT, CC) do { \
        LAUNDER(vo_rm); LAUNDER(vo_sg); LAUNDER(vo_mix); LAUNDER(vo_vec); LAUNDER(l_rm); LAUNDER(l_rk); LAUNDER(l_vw); LAUNDER(l_aq); LAUNDER(l_ak); LAUNDER(l_aw); \
        LAUNDER(l_vt); LAUNDER(l_q2); LAUNDER(l_al); LAUNDER(l_kt); LAUNDER(l_ve); LAUNDER(l_ow); LAUNDER(l_or); \
        psg[NXT][0] = *(const v4u*)(gb + vo_sg); psg[NXT][1] = *(const v4u*)(gb + vo_sg + 16); { const int a_ = (gl + 1 < nsteps) ? 1 : 0; gb += a_ * 65536; gl += a_; } \
        HG_LOADS(CUR); HG_ADV(); \
        for (int ra_ = 0; ra_ < PR_A; ++ra_) { const int cblk = w >> 1; \
        _Pragma("unroll") \
          for (int jj = 0; jj < 2; ++jj) { const int sblk = 2 * (w & 1) + jj; f32x4 a = {0.f, 0.f, 0.f, 0.f}; \
              if (sblk <= cblk) { \
                  bf16x8 af[4], bf[4]; \
        _Pragma("unroll") \
                  for (int ks = 0; ks < 4; ++ks) { af[ks] = *(const LAS bf16x8*)(L + l_aq + ks * 64); bf[ks] = *(const LAS bf16x8*)(L + l_ak + jj * 16 * KP + ks * 64); } \
                  asm volatile("" : "+v"(af[0]), "+v"(af[1]), "+v"(af[2]), "+v"(af[3]), "+v"(bf[0]), "+v"(bf[1]), "+v"(bf[2]), "+v"(bf[3])); \
        _Pragma("unroll") \
                  for (int ks = 0; ks < 4; ++ks) a = mfma16(af[ks], bf[ks], a); \
        _Pragma("unroll") \
                  for (int r = 0; r < 4; ++r) if (16 * sblk + l15 > 16 * cblk + 4 * fq + r) a[r] = 0.f; \
              } \
        _Pragma("unroll") \
              for (int r = 0; r < 4; ++r) *(LAS unsigned short*)(L + l_aw + r * 144 + jj * 32) = (unsigned short)(pk2(a[r], 0.f) & 0xffffu); \
          } HG_BAR(); } \
        { bf16x8 bvt[2]; \
        _Pragma("unroll") \
          for (int ks = 0; ks < 2; ++ks) bvt[ks] = tr_frag(L + l_vt + ks * 32 * KP); \
          bf16x8 sb[4]; \
        _Pragma("unroll") \
          for (int kb2 = 0; kb2 < 4; ++kb2) { v4u t; t.x = pk2(S[2 * kb2][0], S[2 * kb2][1]); t.y = pk2(S[2 * kb2][2], S[2 * kb2][3]); t.z = pk2(S[2 * kb2 + 1][0], S[2 * kb2 + 1][1]); t.w = pk2(S[2 * kb2 + 1][2], S[2 * kb2 + 1][3]); sb[kb2] = __builtin_bit_cast(bf16x8, t); } \
          for (int ro_ = 0; ro_ < PR_O; ++ro_) \
          _Pragma("unroll") \
          for (int cb = 0; cb < 4; ++cb) { f32x4 o = {0.f, 0.f, 0.f, 0.f}; bf16x8 fa[2], fq_[4]; \
        _Pragma("unroll") \
              for (int ks = 0; ks < 2; ++ks) fa[ks] = *(const LAS bf16x8*)(L + l_al + cb * 16 * 144 + ks * 64); \
        _Pragma("unroll") \
              for (int kb2 = 0; kb2 < 4; ++kb2) fq_[kb2] = *(const LAS bf16x8*)(L + l_q2 + cb * 16 * 272 + kb2 * 64); \
              asm volatile("" : "+v"(fa[0]), "+v"(fa[1]), "+v"(fq_[0]), "+v"(fq_[1]), "+v"(fq_[2]), "+v"(fq_[3])); \
        _Pragma("unroll") \
              for (int ks = 0; ks < 2; ++ks) if (32 * ks <= 16 * cb + 15) o = mfma16(fa[ks], bvt[ks], o); \
        _Pragma("unroll") \
              for (int kb2 = 0; kb2 < 4; ++kb2) o = mfma16(fq_[kb2], sb[kb2], o); \
        _Pragma("unroll") \
              for (int r = 0; r < 4; ++r) *(LAS float*)(L + l_ow + (16 * cb + r) * 528) = o[r]; \
              __builtin_amdgcn_sched_barrier(0); } \
        _Pragma("unroll") \
          for (int kp = 0; kp < 4; ++kp) { bf16x8 fk[2][2]; f32x4 dv[2]; \
        _Pragma("unroll") \
              for (int e = 0; e < 2; ++e) { const int kb = 2 * kp + e; \
        _Pragma("unroll") \
                  for (int ks = 0; ks < 2; ++ks) fk[e][ks] = tr_frag(L + l_kt + (32 * (kb >> 1) + 4 * (kb & 1)) * 2 + ks * 32 * KP); \
                  dv[e] = *(const LAS f32x4*)(L + l_ve + (32 * (kb >> 1) + 4 * (kb & 1)) * 4); } \
              asm volatile("" : "+v"(fk[0][0]), "+v"(fk[0][1]), "+v"(fk[1][0]), "+v"(fk[1][1]), "+v"(dv[0]), "+v"(dv[1])); \
        _Pragma("unroll") \
              for (int e = 0; e < 2; ++e) { const int kb = 2 * kp + e; \
        _Pragma("unroll") \
                  for (int ks = 0; ks < 2; ++ks) S[kb] = mfma16(fk[e][ks], bvt[ks], S[kb]); \
                  S[kb] = S[kb] * dv[e]; } \
              __builtin_amdgcn_sched_barrier(0); } \
          for (int ru_ = 0; ru_ < PR_U; ++ru_) { f32x4 S2[8]; \
          _Pragma("unroll") for (int kb = 0; kb < 8; ++kb) S2[kb] = S[kb]; \
          _Pragma("unroll") \
          for (int kp = 0; kp < 4; ++kp) { bf16x8 fk[2][2]; f32x4 dv[2]; \
          _Pragma("unroll") \
              for (int e = 0; e < 2; ++e) { const int kb = 2 * kp + e; \
          _Pragma("unroll") \
                  for (int ks = 0; ks < 2; ++ks) fk[e][ks] = tr_frag(L + l_kt + (32 * (kb >> 1) + 4 * (kb & 1)) * 2 + ks * 32 * KP); \
                  dv[e] = *(const LAS f32x4*)(L + l_ve + (32 * (kb >> 1) + 4 * (kb & 1)) * 4); } \
              asm volatile("" : "+v"(fk[0][0]), "+v"(fk[0][1]), "+v"(fk[1][0]), "+v"(fk[1][1]), "+v"(dv[0]), "+v"(dv[1])); \
          _Pragma("unroll") \
              for (int e = 0; e < 2; ++e) { const int kb = 2 * kp + e; \
          _Pragma("unroll") \
                  for (int ks = 0; ks < 2; ++ks) S2[kb] = mfma16(fk[e][ks], bvt[ks], S2[kb]); \
                  S2[kb] = S2[kb] * dv[e]; } \
              __builtin_amdgcn_sched_barrier(0); } \
          asm volatile("" :: "v"(S2[0]), "v"(S2[1]), "v"(S2[2]), "v"(S2[3]), "v"(S2[4]), "v"(S2[5]), "v"(S2[6]), "v"(S2[7])); } } \
        HG_BAR(); \
        for (int rt_ = 0; rt_ < PR_OUT; ++rt_) { f32x4 ov[4]; float ss = 0.f; \
        _Pragma("unroll") \
          for (int i = 0; i < 4; ++i) { ov[i] = *(const LAS f32x4*)(L + l_or + 16 * i); ss += (ov[i][0] * ov[i][0] + ov[i][1] * ov[i][1]) + (ov[i][2] * ov[i][2] + ov[i][3] * ov[i][3]); } \
          ss += __shfl_xor(ss, 1); ss += __shfl_xor(ss, 2); ss += __shfl_xor(ss, 4); \
          const float rn = __builtin_amdgcn_rsqf(ss * (1.f / 128.f) + EPSN); \
          float res[16]; \
        _Pragma("unroll") \
          for (int i = 0; i < 4; ++i) \
        _Pragma("unroll") \
              for (int j = 0; j < 4; ++j) { const int e = 4 * i + j; const unsigned wd = psg[CUR][e >> 3][(e & 7) >> 1]; const float sg = bf2f((unsigned short)((e & 1) ? (wd >> 16) : (wd & 0xffffu))); res[e] = ov[i][j] * rn * gn[i][j] * sg; } \
          v4u o0, o1; o0.x = pk2(res[0], res[1]); o0.y = pk2(res[2], res[3]); o0.z = pk2(res[4], res[5]); o0.w = pk2(res[6], res[7]); o1.x = pk2(res[8], res[9]); o1.y = pk2(res[10], res[11]); o1.z = pk2(res[12], res[13]); o1.w = pk2(res[14], res[15]); \
          *(v4u*)(mb + vo_mix) = o0; *(v4u*)(mb + vo_mix + 16) = o1; } mb += 131072; \
        if ((CC) + 1 < nsteps) { for (int rs_ = 0; rs_ < PR_ST; ++rs_) { HG_STORE(NXT); } } \
        HG_BAR(); \
    } while (0)
    for (int c = 0; c < nsteps; c += 2) { HG_BODY(0, 1, c); if (c + 1 < nsteps) HG_BODY(1, 0, c + 1); }
    { int ln2 = lane; LAUNDER(ln2); float* sp = Sout + (8 * (ln2 >> 4)) * 128 + 16 * w + (ln2 & 15);
#pragma unroll
      for (int kb = 0; kb < 8; ++kb) { LAUNDER(sp);
#pragma unroll
          for (int r = 0; r < 4; ++r) sp[r * 128] = S[kb][r];
          sp += (kb & 1) ? 28 * 128 : 4 * 128; } }
#undef HG_LOADS
#undef HG_STORE
#undef HG_ADV
#undef HG_BODY
}

__global__ void __launch_bounds__(NTHR, 2) skel_fwd(Args args) {
    extern __shared__ __attribute__((aligned(16))) unsigned char lds[];
    Frame F;
    F.lds = (LAS unsigned char*)lds; F.MISC = (volatile LAS unsigned*)(F.lds + MISC_OFF);
    F.tid = threadIdx.x; F.lane = F.tid & 63; F.wave = __builtin_amdgcn_readfirstlane(F.tid >> 6);
    F.G = gridDim.x; { const int bx = blockIdx.x; F.vcu = (F.G % 8 == 0) ? (bx % 8) * (F.G / 8) + bx / 8 : bx; }
    F.ws = args.ws; F.ctl = (unsigned*)(args.ws + WS_CTL); F.out = args.out;
    F.xp = args.in[0]; F.xs = args.in[1]; F.ck = args.in[2]; F.cv = args.in[3]; F.clf = args.in[4]; F.sh = args.in[5]; F.n1 = args.in[6]; F.win = args.in[7]; F.bff = args.in[8];
    F.qg = args.in[9]; F.kg = args.in[10]; F.lbl = args.in[11]; F.hon = args.in[12]; F.wout = args.in[13]; F.n2 = args.in[14]; F.wup = args.in[15]; F.wdn = args.in[16];
    const int lo = args.ph_lo, hi = args.ph_hi;
#if defined(PROBE_A)
    unsigned long long ts_[9]; const bool stamper_ = (blockIdx.x == 0 && F.tid == 0);
#define STAMP(k) do { if (stamper_) ts_[k] = __builtin_amdgcn_s_memrealtime(); } while (0)
    STAMP(0);
#else
#define STAMP(k) do {} while (0)
#endif
#ifndef PH_MASK
#define PH_MASK 63
#endif
#define IN(k) (((PH_MASK >> (k)) & 1) && lo <= (k) && (k) < hi)
#define SEAM(k) do { if (IN(k) && IN((k) + 1)) { cg::this_grid().sync(); } } while (0)
    bf16* XB = (bf16*)(F.ws + WS_XB); bf16* X1B = (bf16*)(F.ws + WS_X1B); bf16* MIX = (bf16*)(F.ws + WS_MIX); bf16* HB = (bf16*)(F.ws + WS_H);
    if (IN(0)) { p0_prologue(F);
#if defined(DOUBLE_P0)
        cg::this_grid().sync(); p0_prologue(F);
#endif
    }
    SEAM(0); STAMP(1);
    const int bx = (int)blockIdx.x; const bool chainwg = bx < NCHAINWG; const int NWORK = F.G - NCHAINWG;
    if (IN(1)) {
#ifndef NO_SCAN
        for (int ch = F.vcu; ch < 128; ch += F.G) scan_chain(F, ch);
#endif
        pg8::Gemm g{XB, (const bf16*)(F.ws + WS_WIN), MTOT, NIN, DMOD, DMOD};
        pg8::EpiIn E{(const float*)(F.ws + WS_RSTD), F.lbl, F.qg, F.kg, F.ws, F.out};
#pragma nounroll
        for (int sub = 0; sub < 2; ++sub) {
            pg8::OrderIn S;
            if (sub == 0) { S.so.init(MP, 2048, F.G, bx); S.pn_off = 0; S.extra = 0; S.extra_pm0 = 0; }
            else { S.so.init(MTOT, NIN - 2048, NWORK, bx - NCHAINWG); S.pn_off = 8; S.extra = 8 * (MS / 256); S.extra_pm0 = MP / 256; }
            if (sub == 0 || !chainwg) pg8::gemm_phase<pg8::EpiIn, pg8::OrderIn, true, true>(F.lds, g, S, E);
            if (sub == 0) {
                cg::this_grid().sync(); STAMP(2);
                if (chainwg)
#if defined(DOUBLE_HGRN)
                for (int rep_ = 0; rep_ < 2; ++rep_)
#endif
                { const int bb = bx >> 2; hgrn_chain(F, bb * TSEQ, bb * (TSEQ / 64), TSEQ / 64, bx & 3, nullptr, F.out + O_HP + (size_t)bx * 16384); }
            }
        }
        asm volatile("s_waitcnt vmcnt(0)" ::: "memory"); __syncthreads();
        if (F.tid == 0) { unsigned* sc = F.ctl + CW_SUB;
            if (!chainwg) { __threadfence(); __hip_atomic_fetch_add(sc, 1u, __ATOMIC_RELAXED, __HIP_MEMORY_SCOPE_AGENT); }
            while (__hip_atomic_load(sc, __ATOMIC_RELAXED, __HIP_MEMORY_SCOPE_AGENT) < (unsigned)NWORK) __builtin_amdgcn_s_sleep(8);
            __threadfence(); }
        __syncthreads();
        if (chainwg) { const int bb = bx >> 2; hgrn_chain(F, MP + 64 * bb, MP / 64 + bb, 1, bx & 3, F.sh + (size_t)bx * 16384, F.out + O_HS + (size_t)bx * 16384); __syncthreads(); }
    }
    if (IN(2)) {
#ifndef NO_ATTN
        float prune_thr;
        { float mq = fabsf(F.qg[F.lane]), mk = fabsf(F.kg[F.lane]);
#pragma unroll
          for (int o = 1; o < 64; o <<= 1) { mq = fmaxf(mq, __shfl_xor(mq, o)); mk = fmaxf(mk, __shfl_xor(mk, o)); }
          prune_thr = 2.f * (8.f * mq * mk * LOG2E) + 150.f; }
        for (;;) {
            if (F.tid == 0) F.MISC[0] = atomicAdd(F.ctl + CW_QUEUE, 1u);
            __syncthreads();
            const int i = (int)F.MISC[0];
            __syncthreads();
            if (i >= 2048 + 64) break;
            typedef attn_body::bf16 abf;
            const bool smp = i >= 2048; const int j = smp ? i - 2048 : i;
            const int bh = j & 63, qb = 31 - (j >> 6), b = bh >> 3, h = bh & 7;
            const int q0 = smp ? SSEQ - 256 : 256 * qb, NT = (q0 + 256) / 64; int NTE = NT;
            const size_t rb = (size_t)b * (smp ? SSEQ : TSEQ);
            const float* cgp = (const float*)(F.ws + (smp ? WS_CGS : WS_CGP)) + (size_t)bh * (smp ? SSEQ : TSEQ);
#if FOX_PRUNE
            { const bool need = F.tid < NT && (cgp[q0] - cgp[64 * F.tid + 63] >= -prune_thr); const int needed = __syncthreads_count(need ? 1 : 0);
              NTE = (needed + 1) & ~1; NTE = NTE < 4 ? 4 : (NTE > NT ? NT : NTE); }
#endif
            const size_t orow = smp ? (size_t)(MP + 64 * b) - (size_t)(PAST - q0) : rb + q0;
            attn_body::attn_unit<8>((const abf*)(F.ws + (smp ? WS_QS : WS_Q)) + (rb + q0) * 512 + 64 * h, (const abf*)(F.ws + (smp ? WS_KS : WS_K)) + rb * 512 + 64 * h, (const abf*)(F.ws + (smp ? WS_VS : WS_V)) + rb * 512 + 64 * h,
                                    (abf*)MIX + orow * DMOD + 512 + 64 * h, NT, NTE, cgp, q0, smp ? (PAST - q0) / 32 : 0, smp ? (PAST - q0) / 32 + 1 : 8, (char*)lds);
        }
#endif
    }
    SEAM(2); STAMP(3);
    if (IN(3)) {
        pg8::Gemm g{MIX, (const bf16*)(F.ws + WS_WO), MTOT, DMOD, DMOD, DMOD}; pg8::StaticOrder S; S.init(MTOT, DMOD, F.G, (int)blockIdx.x);
        pg8::EpiWo E{F.xp, F.xs, F.out + O_YP, F.out + O_YS, X1B, (float*)(F.ws + WS_SSQ)};
        pg8::gemm_phase<pg8::EpiWo, pg8::StaticOrder, true, true>(F.lds, g, S, E);
    }
    SEAM(3); STAMP(4);
    if (IN(4)) {
        pg8::Gemm g{X1B, (const bf16*)(F.ws + WS_WUP), MTOT, FF, DMOD, DMOD}; pg8::StaticOrder S; S.init(MTOT, FF, F.G, (int)blockIdx.x);
        pg8::EpiUp E{HB, (const float*)(F.ws + WS_SSQ)};
        pg8::gemm_phase<pg8::EpiUp, pg8::StaticOrder, true, true>(F.lds, g, S, E);
#if defined(DOUBLE_P4)
        cg::this_grid().sync();
        pg8::gemm_phase<pg8::EpiUp, pg8::StaticOrder, true, true>(F.lds, g, S, E);
#endif
    }
    SEAM(4); STAMP(5);
    if (IN(5)) {
#pragma nounroll
        for (int pass = 0; pass < 2; ++pass) {
            pg8::Gemm g{HB, (const bf16*)(F.ws + WS_WDN), MTOT, DMOD, pass ? FF : FF / pg8::OrderDown::KSPLIT, FF};
            pg8::OrderDown S; S.mode = pass; S.so.init(MP, DMOD, F.G, (int)blockIdx.x);
            pg8::EpiDown E{F.out + O_YP, F.out + O_YS, pass ? 0 : 1};
            pg8::gemm_phase<pg8::EpiDown, pg8::OrderDown, true, true>(F.lds, g, S, E);
        }
    }
    STAMP(6);
#if defined(PROBE_A)
    cg::this_grid().sync();
    if (stamper_) {
        unsigned long long da = ts_[PROBE_A + 1] - ts_[PROBE_A], db = ts_[PROBE_B + 1] - ts_[PROBE_B];
        unsigned qa = (unsigned)((da + 1250) / 2500), qb = (unsigned)((db + 1250) / 2500); if (qa > 63) qa = 63; if (qb > 63) qb = 63;
#if defined(PROBE_CAL)
        qa = 1000; qb = 0;
#endif
        const unsigned long long t0 = __builtin_amdgcn_s_memrealtime(), wait = 2000ull * (qa + 64 * qb);
        while (__builtin_amdgcn_s_memrealtime() - t0 < wait) __builtin_amdgcn_s_sleep(16);
    }
#endif
#undef IN
#undef SEAM
}

extern "C" void kernel_launch(void* const* d_in, const int* in_sizes, int n_in, void* d_out, int out_size, void* d_ws, size_t ws_size, hipStream_t stream) {
    static int grid = 0;
    if (grid == 0) {
        if (n_in != 17 || (size_t)out_size != O_END || ws_size < WS_END) { fprintf(stderr, "kernel_launch: unexpected shapes (n_in %d out %d ws %zu)\n", n_in, out_size, ws_size); grid = -1; return; }
        int dev = 0, cus = 0, per_cu = 0;
        if (hipGetDevice(&dev) != hipSuccess || hipDeviceGetAttribute(&cus, hipDeviceAttributeMultiprocessorCount, dev) != hipSuccess) { grid = -1; return; }
        if (hipFuncSetAttribute((const void*)skel_fwd, hipFuncAttributeMaxDynamicSharedMemorySize, LDS_BYTES) != hipSuccess) { fprintf(stderr, "kernel_launch: hipFuncSetAttribute failed\n"); grid = -1; return; }
        if (hipOccupancyMaxActiveBlocksPerMultiprocessor(&per_cu, (const void*)skel_fwd, NTHR, LDS_BYTES) != hipSuccess || per_cu < 1) { fprintf(stderr, "kernel_launch: occupancy query says %d\n", per_cu); per_cu = 1; }
        (void)hipGetLastError();
        grid = cus;
    }
    if (grid < 0) return;
    if (hipMemsetAsync((char*)d_ws + WS_CTL, 0, CTL_ZERO_BYTES, stream) != hipSuccess) { fprintf(stderr, "kernel_launch: memset failed\n"); return; }
    Args a{};
    for (int i = 0; i < 17; ++i) a.in[i] = (const float*)d_in[i];
    a.out = (float*)d_out; a.ws = (unsigned char*)d_ws;
#if MK_N_LAUNCHES == 1
    a.ph_lo = 0; a.ph_hi = 6;
    void* kargs[] = {&a};
    hipError_t e = hipLaunchCooperativeKernel((const void*)skel_fwd, dim3(grid), dim3(NTHR), kargs, LDS_BYTES, stream);
    if (e != hipSuccess) fprintf(stderr, "kernel_launch: cooperative launch failed: %s (grid %d)\n", hipGetErrorString(e), grid);
#else
    for (int li = 0; li < 6; ++li) { a.ph_lo = li; a.ph_hi = li + 1; hipLaunchKernelGGL(skel_fwd, dim3(grid), dim3(NTHR), LDS_BYTES, stream, a); }
#endif
}
```

```cpp
#include <hip/hip_runtime.h>
#include <cstdio>
#include <cstdint>
namespace pg8 {
#define PG8_LAS __attribute__((address_space(3)))
typedef unsigned short bf16_t;
typedef short bf16x8 __attribute__((ext_vector_type(8)));
typedef float f32x4 __attribute__((ext_vector_type(4)));
typedef unsigned u32x4 __attribute__((ext_vector_type(4)));
constexpr int BM = 256, BK = 64, HALF = 128, HTB = HALF * BK * 2  , STAGE_BYTES = 8 * HTB, NXCD = 8, WGM = 8;

__host__ __device__ __forceinline__ int lds_byte(int r, int c) { const int st = (r >> 4) * 2 + (c >> 5), rr = r & 15, cc = c & 31, ob = rr * 64 + cc * 2; return st * 1024 + (ob ^ (((ob >> 9) & 1) << 5)); }
__host__ __device__ __forceinline__ void stage_rc(int b, int& R, int& C) { const int st = b / 1024, sb = b % 1024, swz = sb ^ (((sb >> 9) & 1) << 5); R = (st >> 1) * 16 + swz / 64; C = (st & 1) * 32 + (swz % 64) / 2; }
__host__ __device__ __forceinline__ int perm32(int rho) { const int n = rho >> 4, i = rho & 15; return 8 * (i >> 2) + 4 * n + (i & 3); }

struct Unit { int pm, pn, kofs; };
struct Gemm { const bf16_t* A; const bf16_t* Bt; int M, N, K, ld; };

struct StaticOrder {
    int nM, nN, nwg, G, c;
    __host__ __device__ void init(int M, int N, int G_, int c_) { nM = M / BM; nN = N / BM; nwg = nM * nN; G = G_; c = c_; }
    __host__ __device__ bool next(int i, Unit& u) const {
        const long L = (long)i * G + c; if (L >= nwg) return false;
        int wgid = (int)L; { const int q = nwg / NXCD, r = nwg % NXCD, xcd = wgid % NXCD, off = wgid / NXCD; wgid = (xcd < r ? xcd * (q + 1) : r * (q + 1) + (xcd - r) * q) + off; }
        const int nig = WGM * nN, gid = wgid / nig, fm = gid * WGM, gsz = (nM - fm) < WGM ? (nM - fm) : WGM;
        u.pm = fm + ((wgid % nig) % gsz); u.pn = (wgid % nig) / gsz; u.kofs = 0; return true;
    }
    __device__ __forceinline__ void a_ready(const Unit&) const {}
    __device__ __forceinline__ void done(const Unit&) const {}
};

__device__ __forceinline__ unsigned cvt_pk_bf16(float lo, float hi) { unsigned r; asm volatile("v_cvt_pk_bf16_f32 %0, %1, %2" : "=v"(r) : "v"(lo), "v"(hi)); return r; }
typedef float f32x2 __attribute__((ext_vector_type(2)));
template <class Epi, class Sched, bool ALIGN_EPI = false, bool SP2 = false>
__device__ __forceinline__ void gemm_phase(PG8_LAS unsigned char* lds, const Gemm g, const Sched& S, const Epi& E) {
    const int tid = threadIdx.x, wid = __builtin_amdgcn_readfirstlane(tid >> 6), lane = tid & 63, wr = wid >> 2, wc = wid & 3, fr = lane & 15, fq = lane >> 4;
    const int K = g.ld, nt = g.K / BK;
    unsigned voffA[2], voffB[2];
#pragma unroll
    for (int i = 0; i < 2; ++i) { int R, C; stage_rc(tid * 16 + i * 8192, R, C); const int Rb = Epi::PERM ? ((R & ~31) + perm32(R & 31)) : R;
        voffA[i] = (unsigned)(R * K + C) * 2u; voffB[i] = (unsigned)(Rb * K + C) * 2u; }
    const size_t kstep = (size_t)(BK * 2);
    const size_t hstep = (size_t)HALF * K * 2;
    const size_t tstep = 2 * hstep;
    const unsigned ldsw = (unsigned)wid * 1024u;
    const int aoff = lds_byte(wr * 64 + fr, fq * 8), boff = lds_byte(wc * 32 + fr, fq * 8);
#define PG8_SA(b, h) (((b) * 2 + (h)) * HTB)
#define PG8_SB(b, h) ((4 + (b) * 2 + (h)) * HTB)
#define PG8_STAGE(bufoff, gbase, voff) do { _Pragma("unroll") for (int _i = 0; _i < 2; ++_i) \
        __builtin_amdgcn_global_load_lds((const unsigned*)((const char*)(gbase) + (voff)[_i]), (PG8_LAS unsigned*)(lds + (bufoff) + ldsw + _i * 8192), 16, 0, 0); } while (0)
#define PG8_LDA(dst, b, h) do { _Pragma("unroll") for (int m = 0; m < 4; ++m) _Pragma("unroll") for (int k = 0; k < 2; ++k) dst[m][k] = *(const PG8_LAS bf16x8*)(lds + PG8_SA(b, h) + aoff + m * 2048 + k * 1024); } while (0)
#define PG8_LDB(dst, b, h) do { _Pragma("unroll") for (int n = 0; n < 2; ++n) _Pragma("unroll") for (int k = 0; k < 2; ++k) dst[n][k] = *(const PG8_LAS bf16x8*)(lds + PG8_SB(b, h) + boff + n * 2048 + k * 1024); } while (0)
#define PG8_MMA(ai, bj, At, Bt) do { __builtin_amdgcn_s_setprio(1); _Pragma("unroll") for (int m = 0; m < 4; ++m) _Pragma("unroll") for (int n = 0; n < 2; ++n) _Pragma("unroll") for (int k = 0; k < 2; ++k) \
        acc[ai][bj][m][n] = __builtin_amdgcn_mfma_f32_16x16x32_bf16(Bt[n][k], At[m][k], acc[ai][bj][m][n], 0, 0, 0); __builtin_amdgcn_s_setprio(0); } while (0)
#define PG8_WAIT_V(n) asm volatile("s_waitcnt vmcnt(" #n ")" ::: "memory")
#define PG8_WAIT_L(n) asm volatile("s_waitcnt lgkmcnt(" #n ")" ::: "memory")
#define PG8_BAR __builtin_amdgcn_s_barrier()
#define PG8_SCHED __builtin_amdgcn_sched_barrier(0)
    Unit cur, nxt; int ui = 0;
    if (!S.next(0, cur)) return;
    f32x4 acc[2][2][4][2];
#pragma unroll
    for (int a = 0; a < 2; ++a)
#pragma unroll
        for (int b = 0; b < 2; ++b)
#pragma unroll
            for (int m = 0; m < 4; ++m)
#pragma unroll
                for (int n = 0; n < 2; ++n) acc[a][b][m][n] = (f32x4){0.f, 0.f, 0.f, 0.f};
    bf16x8 At[4][2], B0[2][2], B1[2][2];
    const char* cA = (const char*)g.A + (size_t)cur.pm * tstep + (size_t)cur.kofs * 2; const char* cB = (const char*)g.Bt + (size_t)cur.pn * tstep + (size_t)cur.kofs * 2;
    S.a_ready(cur);
    if constexpr (SP2) {
        PG8_STAGE(PG8_SB(0, 0), cB, voffB); PG8_STAGE(PG8_SB(0, 1), cB + hstep, voffB); PG8_STAGE(PG8_SA(0, 0), cA, voffA); PG8_STAGE(PG8_SA(0, 1), cA + hstep, voffA);
        if (wr == 1) PG8_BAR;
        PG8_WAIT_V(2); PG8_BAR;
        PG8_STAGE(PG8_SB(1, 0), cB + kstep, voffB); PG8_STAGE(PG8_SA(1, 0), cA + kstep, voffA); PG8_STAGE(PG8_SB(1, 1), cB + hstep + kstep, voffB);
        PG8_WAIT_V(6); PG8_BAR;
    } else {
        PG8_STAGE(PG8_SB(0, 0), cB, voffB); PG8_STAGE(PG8_SA(0, 0), cA, voffA); PG8_STAGE(PG8_SB(0, 1), cB + hstep, voffB); PG8_STAGE(PG8_SA(0, 1), cA + hstep, voffA);
        if (wr == 1) PG8_BAR;
        PG8_WAIT_V(4); PG8_BAR;
        PG8_STAGE(PG8_SB(1, 0), cB + kstep, voffB); PG8_STAGE(PG8_SA(1, 0), cA + kstep, voffA); PG8_STAGE(PG8_SB(1, 1), cB + hstep + kstep, voffB);
        PG8_WAIT_V(6); PG8_BAR;
    }
    for (;;) {
        const bool has_next = S.next(ui + 1, nxt);
        const char* nA = has_next ? (const char*)g.A + (size_t)nxt.pm * tstep + (size_t)nxt.kofs * 2 : cA; const char* nB = has_next ? (const char*)g.Bt + (size_t)nxt.pn * tstep + (size_t)nxt.kofs * 2 : cB;
        for (int t = 0; t < nt; t += 2) {
            const bool last = (t == nt - 2);
            const char* a1 = cA + (size_t)(t + 1) * kstep;
            const char* a2 = last ? nA : cA + (size_t)(t + 2) * kstep; const char* b2 = last ? nB : cB + (size_t)(t + 2) * kstep;
            const char* a3 = a2 + kstep; const char* b3 = b2 + kstep;
            if (last && has_next) S.a_ready(nxt);
            if constexpr (SP2) {
            PG8_LDB(B0, 0, 0); PG8_LDB(B1, 0, 1); PG8_SCHED; PG8_LDA(At, 0, 0); PG8_STAGE(PG8_SA(1, 1), a1 + hstep, voffA);
            PG8_WAIT_V(8); PG8_WAIT_L(0); PG8_BAR; PG8_MMA(0, 0, At, B0); PG8_MMA(0, 1, At, B1); PG8_BAR; PG8_SCHED;
            PG8_LDA(At, 0, 1); PG8_STAGE(PG8_SB(0, 0), b2, voffB); PG8_STAGE(PG8_SB(0, 1), b2 + hstep, voffB); PG8_STAGE(PG8_SA(0, 0), a2, voffA);
            PG8_WAIT_V(8); PG8_WAIT_L(0); PG8_BAR; PG8_MMA(1, 0, At, B0); PG8_MMA(1, 1, At, B1); PG8_BAR; PG8_SCHED;
            PG8_LDB(B0, 1, 0); PG8_LDB(B1, 1, 1); PG8_SCHED; PG8_LDA(At, 1, 0); PG8_STAGE(PG8_SA(0, 1), a2 + hstep, voffA);
            PG8_WAIT_V(8); PG8_WAIT_L(0); PG8_BAR; PG8_MMA(0, 0, At, B0); PG8_MMA(0, 1, At, B1); PG8_BAR; PG8_SCHED;
            PG8_LDA(At, 1, 1); PG8_STAGE(PG8_SB(1, 0), b3, voffB); PG8_STAGE(PG8_SB(1, 1), b3 + hstep, voffB); PG8_STAGE(PG8_SA(1, 0), a3, voffA);
            PG8_WAIT_V(8); PG8_WAIT_L(0); PG8_BAR; PG8_MMA(1, 0, At, B0); PG8_MMA(1, 1, At, B1); PG8_BAR; PG8_SCHED;
            } else {
            PG8_LDB(B0, 0, 0); PG8_SCHED; PG8_LDA(At, 0, 0); PG8_STAGE(PG8_SA(1, 1), a1 + hstep, voffA);
            PG8_WAIT_L(8); PG8_BAR; PG8_WAIT_L(0); PG8_MMA(0, 0, At, B0); PG8_BAR; PG8_SCHED;
            PG8_LDB(B1, 0, 1); PG8_STAGE(PG8_SB(0, 0), b2, voffB);
            PG8_BAR; PG8_WAIT_L(0); PG8_MMA(0, 1, At, B1); PG8_BAR;
            PG8_LDA(At, 0, 1); PG8_STAGE(PG8_SA(0, 0), a2, voffA);
            PG8_BAR; PG8_WAIT_L(0); PG8_MMA(1, 0, At, B0); PG8_BAR; PG8_SCHED;
            PG8_STAGE(PG8_SB(0, 1), b2 + hstep, voffB);
            PG8_WAIT_V(6); PG8_BAR; PG8_MMA(1, 1, At, B1); PG8_BAR;
            PG8_LDB(B0, 1, 0); PG8_SCHED; PG8_LDA(At, 1, 0); PG8_STAGE(PG8_SA(0, 1), a2 + hstep, voffA);
            PG8_WAIT_L(8); PG8_BAR; PG8_WAIT_L(0); PG8_MMA(0, 0, At, B0); PG8_BAR; PG8_SCHED;
            PG8_LDB(B1, 1, 1); PG8_STAGE(PG8_SB(1, 0), b3, voffB);
            PG8_BAR; PG8_WAIT_L(0); PG8_MMA(0, 1, At, B1); PG8_BAR;
            PG8_LDA(At, 1, 1); PG8_STAGE(PG8_SA(1, 0), a3, voffA);
            PG8_BAR; PG8_WAIT_L(0); PG8_MMA(1, 0, At, B0); PG8_BAR; PG8_SCHED;
            PG8_STAGE(PG8_SB(1, 1), b3 + hstep, voffB);
            PG8_WAIT_V(6); PG8_BAR; PG8_MMA(1, 1, At, B1); PG8_BAR;
            }
        }
        if constexpr (ALIGN_EPI) { if (wr == 0) PG8_BAR; }
        if constexpr (!Epi::AFTER_DRAIN) { E(acc, cur, wr, wc, fr, fq); S.done(cur); }
        if (!has_next) break;
#pragma unroll
        for (int a = 0; a < 2; ++a)
#pragma unroll
            for (int b = 0; b < 2; ++b)
#pragma unroll
                for (int m = 0; m < 4; ++m)
#pragma unroll
                    for (int n = 0; n < 2; ++n) acc[a][b][m][n] = (f32x4){0.f, 0.f, 0.f, 0.f};
        cur = nxt; cA = nA; cB = nB; ++ui;
        if constexpr (ALIGN_EPI) { if (wr == 1) PG8_BAR; }
    }
    PG8_WAIT_V(0);
    if constexpr (!ALIGN_EPI) { if (wr == 0) PG8_BAR; }
    PG8_BAR;
    if constexpr (Epi::AFTER_DRAIN) { E.fused(acc, cur, wr, wc, fr, fq, lds, wid, lane); S.done(cur); }
#undef PG8_SA
#undef PG8_SB
#undef PG8_STAGE
#undef PG8_LDA
#undef PG8_LDB
#undef PG8_MMA
#undef PG8_WAIT_V
#undef PG8_WAIT_L
#undef PG8_BAR
#undef PG8_SCHED
}
}
#include <hip/hip_bf16.h>
#include <cmath>
namespace attn_body {
using bf16=__hip_bfloat16;
using bf16x8=__attribute__((ext_vector_type(8)))short;
using s16x4=__attribute__((ext_vector_type(4)))short;
using f32x16=__attribute__((ext_vector_type(16)))float;
using u32x4=__attribute__((ext_vector_type(4)))unsigned;
constexpr int NHEAD=8,D=64,DM=NHEAD*D,OPITCH=1024;
constexpr int NW=8,QBLK=32,QB=QBLK*NW,KVBLK=64;
constexpr int ATTN_PITCH=DM, ATTN_UNIT_ROWS=QB;
__device__ __forceinline__ int crow(int r,int hi){return (r&3)+8*(r>>2)+4*hi;}
#define SBAR() __builtin_amdgcn_sched_barrier(0)
__device__ __forceinline__ void cmask(f32x16&p0,f32x16&p1,int jb,int qrel,int hi){
  const float NEG=-INFINITY; int kb=64*jb+4*hi;
  #pragma unroll
  for(int r=0;r<16;++r){int kv=kb+(r&3)+8*(r>>2); if(kv>qrel)p0[r]=NEG; if(kv+32>qrel)p1[r]=NEG;}
}

constexpr int NSLOT=3, SLOTB=8192;
constexpr int LDS_K=0, LDS_V=NSLOT*SLOTB, LDS_WS=2*NSLOT*SLOTB, LDS_OST=LDS_WS+NW*64*4, LDS_CB=LDS_OST+NW*4096, LDS_BYTES=LDS_CB+32768;
constexpr float C2=0.125f*1.4426950408889634f;
__device__ __forceinline__ void glds16(const void*gsrc,unsigned lds_dst){unsigned keep;
  asm volatile("s_mov_b32 %0, m0\n\ts_mov_b32 m0, %2\n\ts_nop 0\n\tglobal_load_lds_dwordx4 %1, off\n\ts_mov_b32 m0, %0":"=&s"(keep):"v"(gsrc),"s"(lds_dst):"memory");}
__device__ __forceinline__ float max3f(float a,float b,float c){float r;asm("v_max3_f32 %0, %1, %2, %3":"=v"(r):"v"(a),"v"(b),"v"(c));return r;}
__device__ __forceinline__ float max2f(float a,float b){float r;asm("v_max_f32_e32 %0, %1, %2":"=v"(r):"v"(a),"v"(b));return r;}
__device__ __forceinline__ float fadd_s(float a,float b){float r;asm("v_add_f32_e32 %0, %1, %2":"=v"(r):"v"(a),"v"(b));return r;}
__device__ __forceinline__ float fsub_s(float a,float b){float r;asm("v_sub_f32_e32 %0, %1, %2":"=v"(r):"v"(a),"v"(b));return r;}
typedef float f32x2_t __attribute__((ext_vector_type(2))); typedef float f32x4_t __attribute__((ext_vector_type(4))); typedef __bf16 bf16x2_t __attribute__((ext_vector_type(2)));
__device__ __forceinline__ unsigned cvtpk_s(float lo,float hi){f32x2_t v={lo,hi};bf16x2_t b=__builtin_convertvector(v,bf16x2_t);return __builtin_bit_cast(unsigned,b);}
#define WAIT_BAR(N) asm volatile("s_waitcnt vmcnt(" #N ") lgkmcnt(0)\n\ts_barrier":::"memory")

__device__ __forceinline__ void qkt(f32x16&p0,f32x16&p1,const char*Kslot,const bf16x8*qr,int r32,int hi){
  const char*kb=Kslot+hi*1024+r32*16;
  #pragma unroll
  for(int d0=0;d0<4;++d0){
    const bf16x8 b0=*reinterpret_cast<const bf16x8*>(kb+d0*2048);
    const bf16x8 b1=*reinterpret_cast<const bf16x8*>(kb+d0*2048+512);
    p0=__builtin_amdgcn_mfma_f32_32x32x16_bf16(b0,qr[d0],p0,0,0,0);p1=__builtin_amdgcn_mfma_f32_32x32x16_bf16(b1,qr[d0],p1,0,0,0);}
}
typedef __attribute__((address_space(3))) const char* lds_cptr;
typedef short v4i16_t __attribute__((ext_vector_type(4)));
__device__ __forceinline__ void kload8(bf16x8*kf,lds_cptr kp){
  kf[0]=*(const __attribute__((address_space(3))) bf16x8*)(kp);      kf[1]=*(const __attribute__((address_space(3))) bf16x8*)(kp+512);
  kf[2]=*(const __attribute__((address_space(3))) bf16x8*)(kp+2048); kf[3]=*(const __attribute__((address_space(3))) bf16x8*)(kp+2560);
  kf[4]=*(const __attribute__((address_space(3))) bf16x8*)(kp+4096); kf[5]=*(const __attribute__((address_space(3))) bf16x8*)(kp+4608);
  kf[6]=*(const __attribute__((address_space(3))) bf16x8*)(kp+6144); kf[7]=*(const __attribute__((address_space(3))) bf16x8*)(kp+6656);
}
__device__ __forceinline__ void kload2(bf16x8*kf,lds_cptr kp,int j){ kf[2*j]=*(const __attribute__((address_space(3))) bf16x8*)(kp+j*2048); kf[2*j+1]=*(const __attribute__((address_space(3))) bf16x8*)(kp+j*2048+512); }
__device__ __forceinline__ s16x4 vtr(lds_cptr p){ return __builtin_bit_cast(s16x4,__builtin_amdgcn_ds_read_tr16_b64_v4i16((__attribute__((address_space(3))) v4i16_t*)p)); }
__device__ __forceinline__ float rowmax(const f32x16&p0,const f32x16&p1){
  float a=max3f(p0[0],p0[1],p1[0]),b=max3f(p0[2],p0[3],p1[1]);a=max3f(a,p1[2],p1[3]);
  #pragma unroll
  for(int r=4;r<16;r+=4){a=max3f(a,p0[r],p0[r+1]);b=max3f(b,p0[r+2],p0[r+3]);a=max3f(a,p1[r],p1[r+1]);b=max3f(b,p1[r+2],p1[r+3]);}
  const float m=max2f(a,b);
  auto rr=__builtin_amdgcn_permlane32_swap(__float_as_uint(m),__float_as_uint(m),false,false);
  return max2f(__uint_as_float(rr[0]),__uint_as_float(rr[1]));
}
__device__ __forceinline__ void pv(f32x16*o,int vb,bf16x8 pa0,bf16x8 pa1,bf16x8 pa2,bf16x8 pa3){
  #pragma unroll
  for(int d0=0;d0<2;++d0){s16x4 lo[4],hi[4];
    #pragma unroll
    for(int ks=0;ks<4;++ks){
      asm volatile("ds_read_b64_tr_b16 %0,%1 offset:%c2":"=&v"(lo[ks]):"v"(vb),"i"(d0*4096+ks*1024):"memory");
      asm volatile("ds_read_b64_tr_b16 %0,%1 offset:%c2":"=&v"(hi[ks]):"v"(vb),"i"(d0*4096+ks*1024+512):"memory");}
    asm volatile("s_waitcnt lgkmcnt(0)":::"memory");SBAR();
    #define PK(k) (bf16x8){lo[k][0],lo[k][1],lo[k][2],lo[k][3],hi[k][0],hi[k][1],hi[k][2],hi[k][3]}
    o[d0]=__builtin_amdgcn_mfma_f32_32x32x16_bf16(pa0,PK(0),o[d0],0,0,0);
    o[d0]=__builtin_amdgcn_mfma_f32_32x32x16_bf16(pa1,PK(1),o[d0],0,0,0);
    o[d0]=__builtin_amdgcn_mfma_f32_32x32x16_bf16(pa2,PK(2),o[d0],0,0,0);
    o[d0]=__builtin_amdgcn_mfma_f32_32x32x16_bf16(pa3,PK(3),o[d0],0,0,0);
    #undef PK
  }
}

#ifndef ATTN_STORE16
#define ATTN_STORE16(p,v) (*(u32x4*)(p)=(v))
#endif
template<int THRL> __device__ __forceinline__ void attn_unit(const bf16*Qb,const bf16*__restrict__ Kh,const bf16*__restrict__ Vh,bf16*Ob,int NT,int NTE,const float*cgp,int q0,int wlo,int whi,char*shm){
  int tid_=threadIdx.x; asm volatile("":"+v"(tid_)); const int tid=tid_,lane=tid&63,r32=lane&31,hi=lane>>5; const int wid=__builtin_amdgcn_readfirstlane(tid>>6);
  const bf16*Qw=Qb+(long)(wid*QBLK)*DM;
  const unsigned lds0=(unsigned)(uintptr_t)shm;
  float*wsf=(float*)(shm+LDS_WS)+wid*64;
  const bf16*ksrc=Kh+(long)((NT-1)*KVBLK+lane)*DM+wid*8;
  const bf16*vsrc=Vh+(long)((NT-1)*KVBLK+16*(wid&3)+(lane>>2))*DM+(wid>>2)*32+(lane&3)*8;
  const unsigned kdst=lds0+LDS_K+wid*1024, vdst=lds0+LDS_V+wid*1024;
  #define DMA_K(t,slot) glds16(ksrc-(long)(t)*KVBLK*DM,(unsigned)__builtin_amdgcn_readfirstlane(kdst+(slot)))
  #define DMA_V(t,slot) glds16(vsrc-(long)(t)*KVBLK*DM,(unsigned)__builtin_amdgcn_readfirstlane(vdst+(slot)))
  const int vb0=(int)(lds0+LDS_V)+((lane>>4)&1)*32+(lane&3)*8+(4*hi+((lane&15)>>2))*64;
  const char*Kbase=shm+LDS_K; bf16x8 kf[8];
  const lds_cptr shm3=(lds_cptr)shm; const lds_cptr kp0=shm3+LDS_K+hi*1024+r32*16; const lds_cptr vp0=shm3+LDS_V+((lane>>4)&1)*32+(lane&3)*8+(4*hi+((lane&15)>>2))*64;
  { typedef __attribute__((address_space(3))) float lf_t; lf_t* cbw=(lf_t*)((lds_cptr)shm+LDS_CB); const float c0=cgp[q0]; const int jlo=(NT-NTE)*KVBLK, jhi=NT*KVBLK;
    for(int j=jlo+tid;j<jhi;j+=NW*64) cbw[j]=c0-cgp[j]; }
  const __attribute__((address_space(3))) float* cbL=(const __attribute__((address_space(3))) float*)((lds_cptr)shm+LDS_CB)+4*hi;
  #define CBLOAD(C0,C1,t,MH) do{ const __attribute__((address_space(3))) float* cbp_=cbL+(NT-1-(t))*KVBLK; \
    _Pragma("unroll") for(int g_=0;g_<4;++g_){ const f32x4_t v0_=*(const __attribute__((address_space(3))) f32x4_t*)(cbp_+8*g_); const f32x4_t v1_=*(const __attribute__((address_space(3))) f32x4_t*)(cbp_+32+8*g_); \
      C0[4*g_]=v0_[0]-(MH);C0[4*g_+1]=v0_[1]-(MH);C0[4*g_+2]=v0_[2]-(MH);C0[4*g_+3]=v0_[3]-(MH); C1[4*g_]=v1_[0]-(MH);C1[4*g_+1]=v1_[1]-(MH);C1[4*g_+2]=v1_[2]-(MH);C1[4*g_+3]=v1_[3]-(MH);} }while(0)
  DMA_K(0,0);DMA_V(0,0);DMA_K(1,SLOTB);
  bf16x8 qr[4];
  #pragma unroll
  for(int d0=0;d0<4;++d0)qr[d0]=*reinterpret_cast<const bf16x8*>(&Qw[(long)r32*DM+d0*16+hi*8]);
  float mhat=0.f,l_reg=0.f;f32x16 o[2];o[0]=f32x16{};o[1]=f32x16{};
  const int qrel=wid*QBLK+r32;
  #define CMASK(P0,P1,t) do{int jb_=3-(t); if(jb_>=0)cmask(P0,P1,jb_,qrel,hi);}while(0)
  bool resc=false;
  #define START(P0,P1) do{ const float rm=rowmax(P0,P1); resc=false; \
    { const float dl=(rm>-1e30f)?rm:0.f; mhat=fadd_s(mhat,dl); \
      _Pragma("unroll") for(int r=0;r<16;++r){P0[r]=fsub_s(P0[r],dl);P1[r]=fsub_s(P1[r],dl);} } \
    _Pragma("unroll") for(int r=0;r<16;++r)P0[r]=__builtin_amdgcn_exp2f(P0[r]); }while(0)
  #define RESC() do{ if(resc){ asm volatile("s_waitcnt lgkmcnt(0)":::"memory"); \
      _Pragma("unroll") for(int d_=0;d_<2;++d_) _Pragma("unroll") for(int r=0;r<16;++r)o[d_][r]*=wsf[crow(r,hi)]; } }while(0)
  f32x16 pA0,pA1,pB0,pB1;
  int sl_prev=0,sl_cur=0,sl_next=SLOTB;
  #define ROT() do{sl_prev=sl_cur;sl_cur=sl_next;sl_next=(sl_next==(NSLOT-1)*SLOTB)?0:sl_next+SLOTB;}while(0)
  DMA_K(2,2*SLOTB);
  WAIT_BAR(3);
  CBLOAD(pA0,pA1,0,0.f); qkt(pA0,pA1,Kbase,qr,r32,hi);asm volatile("s_nop 15\n\ts_nop 7":"+v"(pA0),"+v"(pA1));CMASK(pA0,pA1,0);
  START(pA0,pA1);
  _Pragma("unroll") for(int r=0;r<16;++r)pA1[r]=__builtin_amdgcn_exp2f(pA1[r]);
  WAIT_BAR(0);
  DMA_K(3,0);DMA_V(1,SLOTB);
  ROT();
  kload8(kf,kp0+sl_cur);
  WAIT_BAR(2);
  s16x4 vlo[8],vhi[8]; u32x4 pw0,pw1,pw2,pw3;
  #define PKW(P,B) cvtpk_s(P[B],P[B+1])
  #define PAF(k) __builtin_bit_cast(bf16x8,pw##k)
  #define VFR(i) (bf16x8){vlo[i][0],vlo[i][1],vlo[i][2],vlo[i][3],vhi[i][0],vhi[i][1],vhi[i][2],vhi[i][3]}
  #define PIN(x) asm volatile("":"+v"(x))
  #define MX3(a,b,c) __builtin_fmaxf(__builtin_fmaxf((a),(b)),(c))
  #define GAPA(MF,A0,A1,A2,A3,W0,W1,PW) do{ MF; sacc+=A0; sacc+=A1; sacc+=A2; sacc+=A3; PIN(sacc); W0; W1; PIN(PW); SBAR(); }while(0)
  #define EX(v) __builtin_amdgcn_exp2f(v)
  #define GAPB(MF,X,B) do{ MF; X[B]=EX(X[B]); X[B+1]=EX(X[B+1]); X[B+2]=EX(X[B+2]); X[B+3]=EX(X[B+3]); PIN(X); SBAR(); }while(0)
  #define VRD(i) do{ vlo[i]=vtr(vp_+(((i)>>2)*4096+((i)&3)*1024)); vhi[i]=vtr(vp_+(((i)>>2)*4096+((i)&3)*1024+512)); }while(0)
  #define KRD(G,j) do{ if(G){ kload2(kf,kp0+sl_next,j); SBAR(); } }while(0)
  #define STEP(C0,C1,P0,P1,t,GK,GV,GL) do{ SBAR(); \
    const lds_cptr vp_=vp0+sl_prev; CBLOAD(C0,C1,t,mhat); SBAR(); \
    VRD(0); SBAR(); float sacc=(P0[0]+P0[1]); \
    GAPA(C0=__builtin_amdgcn_mfma_f32_32x32x16_bf16(kf[0],qr[0],C0,0,0,0), P0[2],P0[3],P0[4],P0[5],     pw0[0]=PKW(P0,0), pw0[1]=PKW(P0,2), pw0); \
    VRD(4); SBAR(); GAPA(C1=__builtin_amdgcn_mfma_f32_32x32x16_bf16(kf[1],qr[0],C1,0,0,0), P0[6],P0[7],P0[8],P0[9],     pw0[2]=PKW(P0,4), pw0[3]=PKW(P0,6), pw0); \
    VRD(1); SBAR(); GAPA(C0=__builtin_amdgcn_mfma_f32_32x32x16_bf16(kf[2],qr[1],C0,0,0,0),   P0[10],P0[11],P0[12],P0[13], pw1[0]=PKW(P0,8), pw1[1]=PKW(P0,10), pw1); \
    VRD(5); SBAR(); GAPA(C1=__builtin_amdgcn_mfma_f32_32x32x16_bf16(kf[3],qr[1],C1,0,0,0),   P0[14],P0[15],P1[0],P1[1],   pw1[2]=PKW(P0,12),pw1[3]=PKW(P0,14), pw1); \
    VRD(2); SBAR(); GAPA(C0=__builtin_amdgcn_mfma_f32_32x32x16_bf16(kf[4],qr[2],C0,0,0,0),   P1[2],P1[3],P1[4],P1[5],     pw2[0]=PKW(P1,0), pw2[1]=PKW(P1,2), pw2); \
    VRD(6); SBAR(); GAPA(C1=__builtin_amdgcn_mfma_f32_32x32x16_bf16(kf[5],qr[2],C1,0,0,0),   P1[6],P1[7],P1[8],P1[9],     pw2[2]=PKW(P1,4), pw2[3]=PKW(P1,6), pw2); \
    VRD(3); SBAR(); GAPA(C0=__builtin_amdgcn_mfma_f32_32x32x16_bf16(kf[6],qr[3],C0,0,0,0),   P1[10],P1[11],P1[12],P1[13], pw3[0]=PKW(P1,8), pw3[1]=PKW(P1,10), pw3); \
    VRD(7); SBAR(); GAPA(C1=__builtin_amdgcn_mfma_f32_32x32x16_bf16(kf[7],qr[3],C1,0,0,0),   P1[14],P1[15],0.f,0.f,       pw3[2]=PKW(P1,12),pw3[3]=PKW(P1,14), pw3); \
    l_reg+=sacc; \
    if(GK){DMA_K((t)+3,sl_cur);} if(GV){DMA_V((t)+1,sl_next);} \
    CMASK(C0,C1,t); \
    { float a=MX3(C0[0],C0[1],C1[0]),b=MX3(C0[2],C0[3],C1[1]); a=MX3(a,C1[2],C1[3]); \
      _Pragma("unroll") for(int r=4;r<16;r+=4){a=MX3(a,C0[r],C0[r+1]);b=MX3(b,C0[r+2],C0[r+3]);a=MX3(a,C1[r],C1[r+1]);b=MX3(b,C1[r+2],C1[r+3]);} \
      float rm=__builtin_fmaxf(a,b); { auto rr=__builtin_amdgcn_permlane32_swap(__float_as_uint(rm),__float_as_uint(rm),false,false); rm=__builtin_fmaxf(__uint_as_float(rr[0]),__uint_as_float(rr[1])); } \
      resc=false; \
      if(__builtin_expect(__any(rm>(float)THRL),0)){ const float dl=__builtin_fmaxf(rm,0.f); mhat+=dl; \
        _Pragma("unroll") for(int r=0;r<16;++r){C0[r]-=dl;C1[r]-=dl;} \
        const float f=__builtin_amdgcn_exp2f(-dl); l_reg*=f; if(hi==0)wsf[r32]=f; resc=true; } } \
    SBAR(); \
    GAPB(o[0]=__builtin_amdgcn_mfma_f32_32x32x16_bf16(PAF(0),VFR(0),o[0],0,0,0), C0,0); \
    GAPB(o[1]=__builtin_amdgcn_mfma_f32_32x32x16_bf16(PAF(0),VFR(4),o[1],0,0,0), C0,4); \
    KRD(GL,0); GAPB(o[0]=__builtin_amdgcn_mfma_f32_32x32x16_bf16(PAF(1),VFR(1),o[0],0,0,0), C0,8); \
    KRD(GL,1); GAPB(o[1]=__builtin_amdgcn_mfma_f32_32x32x16_bf16(PAF(1),VFR(5),o[1],0,0,0), C0,12); \
    KRD(GL,2); GAPB(o[0]=__builtin_amdgcn_mfma_f32_32x32x16_bf16(PAF(2),VFR(2),o[0],0,0,0), C1,0); \
    KRD(GL,3); GAPB(o[1]=__builtin_amdgcn_mfma_f32_32x32x16_bf16(PAF(2),VFR(6),o[1],0,0,0), C1,4); \
    GAPB(o[0]=__builtin_amdgcn_mfma_f32_32x32x16_bf16(PAF(3),VFR(3),o[0],0,0,0), C1,8); \
    GAPB(o[1]=__builtin_amdgcn_mfma_f32_32x32x16_bf16(PAF(3),VFR(7),o[1],0,0,0), C1,12); \
    }while(0)
  int t=1;
  for(;t<5&&t+5<NTE;t+=2){
    STEP(pB0,pB1,pA0,pA1,t,true,true,true);     WAIT_BAR(2); RESC(); ROT();
    STEP(pA0,pA1,pB0,pB1,t+1,true,true,true);   WAIT_BAR(2); RESC(); ROT();
  }
  #undef CMASK
  #define CMASK(P0,P1,t) do{}while(0)
  for(;t+5<NTE;t+=2){
    STEP(pB0,pB1,pA0,pA1,t,true,true,true);     WAIT_BAR(2); RESC(); ROT();
    STEP(pA0,pA1,pB0,pB1,t+1,true,true,true);   WAIT_BAR(2); RESC(); ROT();
  }
  #undef CMASK
  #define CMASK(P0,P1,t) do{int jb_=3-(t); if(jb_>=0)cmask(P0,P1,jb_,qrel,hi);}while(0)
  #define ENDW(tt) do{ if((tt)+3<NTE){WAIT_BAR(2);} else if((tt)+2<NTE){WAIT_BAR(1);} else {WAIT_BAR(0);} }while(0)
  for(;t+1<NTE;t+=2){
    STEP(pB0,pB1,pA0,pA1,t,(t+3<NTE),(t+1<NTE),(t+1<NTE));       ENDW(t);   RESC(); ROT();
    STEP(pA0,pA1,pB0,pB1,t+1,(t+4<NTE),(t+2<NTE),(t+2<NTE));     ENDW(t+1); RESC(); ROT();
  }
  STEP(pB0,pB1,pA0,pA1,NTE-1,false,false,false); RESC();
  { float sacc=pB0[0]+pB0[1]; _Pragma("unroll") for(int r=2;r<16;++r)sacc+=pB0[r]; _Pragma("unroll") for(int r=0;r<16;++r)sacc+=pB1[r]; l_reg+=sacc;
    pw0=(u32x4){PKW(pB0,0),PKW(pB0,2),PKW(pB0,4),PKW(pB0,6)};pw1=(u32x4){PKW(pB0,8),PKW(pB0,10),PKW(pB0,12),PKW(pB0,14)};pw2=(u32x4){PKW(pB1,0),PKW(pB1,2),PKW(pB1,4),PKW(pB1,6)};pw3=(u32x4){PKW(pB1,8),PKW(pB1,10),PKW(pB1,12),PKW(pB1,14)};
    SBAR(); pv(o,vb0+sl_cur,PAF(0),PAF(1),PAF(2),PAF(3)); }
  #undef PKW
  #undef PAF
  #undef VFR
  #undef PIN
  #undef MX3
  #undef GAPA
  #undef GAPB
  #undef EX
  #undef VRD
  #undef KRD
  #undef STEP
  #undef ENDW
  {auto rr=__builtin_amdgcn_permlane32_swap(__float_as_uint(l_reg),__float_as_uint(l_reg),false,false);l_reg=__uint_as_float(rr[0])+__uint_as_float(rr[1]);}
  if(hi==0)wsf[32+r32]=l_reg;asm volatile("s_waitcnt lgkmcnt(0)":::"memory");
  float rli[16];
  #pragma unroll
  for(int r=0;r<16;++r)rli[r]=__builtin_amdgcn_rcpf(wsf[32+crow(r,hi)]);
  bf16*Ow=Ob+(long)(wid*QBLK)*OPITCH;
  { bf16*stg=(bf16*)(shm+LDS_OST)+wid*2048;
    #pragma unroll
    for(int r=0;r<16;++r){const int orow=crow(r,hi);
      #pragma unroll
      for(int d0=0;d0<2;++d0)stg[orow*64+d0*32+r32]=__float2bfloat16(o[d0][r]*rli[r]);}
    asm volatile("s_waitcnt lgkmcnt(0)":::"memory");
    #pragma unroll
    for(int i=0;i<4;++i){const int row=i*8+(lane>>3),ch=lane&7; const u32x4 v=*(const u32x4*)(stg+row*64+ch*8); if(wid>=wlo&&wid<whi)ATTN_STORE16(Ow+(long)row*OPITCH+ch*8,v);} }
  asm volatile("s_waitcnt lgkmcnt(0)\n\ts_barrier":::"memory");
  #undef DMA_K
  #undef DMA_V
  #undef CMASK
  #undef START
  #undef RESC
  #undef ROT
  #undef CBLOAD
}
constexpr int ATTN_LDS_BYTES=LDS_BYTES;
#undef SBAR
#undef WAIT_BAR
}
#include <hip/hip_cooperative_groups.h>
namespace cg = cooperative_groups;
#ifndef MK_N_LAUNCHES
#define MK_N_LAUNCHES 1
#endif
#ifndef FOX_PRUNE
#define FOX_PRUNE 1
#endif
constexpr int NWAVES = 8, NTHR = 512;
constexpr int DMOD = 1024, TSEQ = 8192, NBATCH = 8, MP = NBATCH * TSEQ, MS = 512, MTOT = MP + MS;
constexpr int NIN = 3584, INC = 3592, FF = 4096, SSEQ = 1152, PAST = 1024, DSEQ = 32;
constexpr int NCHUNK = MTOT / 64;
constexpr float EPSN = 1e-6f, LOG2E = 1.4426950408889634f;
constexpr size_t MiB = 1u << 20;
constexpr size_t WS_CTL = 0, CTL_ZERO_BYTES = 4096;
constexpr size_t WS_WIN = 2 * MiB, WS_WO = 9 * MiB, WS_WUP = 11 * MiB, WS_WDN = 19 * MiB;
constexpr size_t WS_RSTD = 27 * MiB, WS_CGP = 28 * MiB, WS_CGS = 30 * MiB, WS_VEC = 31 * MiB, WS_SSQ = 38 * MiB;
constexpr size_t WS_X1B = 44 * MiB, WS_MIX = 174 * MiB, WS_H = 304 * MiB;
constexpr size_t WS_XB = 304 * MiB, WS_Q = 434 * MiB, WS_K = 498 * MiB, WS_V = 562 * MiB, WS_QS = 626 * MiB, WS_KS = 635 * MiB, WS_VS = 644 * MiB;
constexpr size_t WS_QR = 654 * MiB, WS_KR = 719 * MiB, WS_VH = 784 * MiB, WS_SG = 849 * MiB, WS_END = 914 * MiB;
constexpr size_t VECN = (size_t)NCHUNK * 512;
static_assert(WS_VEC + 3 * VECN * 4 <= WS_SSQ && WS_SSQ + (size_t)MTOT * 16 * 4 <= WS_X1B && WS_X1B + (size_t)MTOT * DMOD * 2 <= WS_MIX && WS_MIX + (size_t)MTOT * DMOD * 2 <= WS_H, "ws map");
static_assert(WS_H + (size_t)MTOT * FF * 2 <= WS_END && WS_XB + (size_t)MTOT * DMOD * 2 <= WS_Q && WS_SG + (size_t)MTOT * 512 * 2 <= WS_END, "ws map 2");
constexpr int CW_QUEUE = 64, CW_SUB = 128, NCHAINWG = 32;
constexpr size_t O_YP = 0, O_YS = O_YP + (size_t)MP * DMOD, O_KP = O_YS + (size_t)256 * DMOD, O_VP = O_KP + (size_t)MP * 512, O_LP = O_VP + (size_t)MP * 512,
                 O_HP = O_LP + (size_t)MP * 8, O_KS = O_HP + 524288, O_VS = O_KS + 131072, O_LS = O_VS + 131072, O_HS = O_LS + 2048, O_END = O_HS + 524288;
constexpr int RING_BYTES = 131072, MISC_OFF = RING_BYTES, LDS_BYTES = 135168;
static_assert(attn_body::ATTN_LDS_BYTES <= RING_BYTES, "attention LDS");

#define LAS __attribute__((address_space(3)))
typedef unsigned short bf16;
typedef unsigned v4u __attribute__((ext_vector_type(4)));
typedef unsigned v2u __attribute__((ext_vector_type(2)));
typedef float f32x4 __attribute__((ext_vector_type(4)));
typedef short bf16x8 __attribute__((ext_vector_type(8)));
#define LDS_WAIT() asm volatile("s_waitcnt lgkmcnt(0)" ::: "memory")
__device__ __forceinline__ unsigned pk2(float lo, float hi) { return pg8::cvt_pk_bf16(lo, hi); }
__device__ __forceinline__ float bf2f(unsigned short b) { return __uint_as_float(((unsigned)b) << 16); }
__device__ __forceinline__ float wave_sum(float v) {
#pragma unroll
    for (int o = 1; o < 64; o <<= 1) v += __shfl_xor(v, o);
    return v;
}
__device__ __forceinline__ bool row_map(int row, int& idx) { if (row < MP) { idx = row; return true; } const int rs = row - MP; idx = (rs >> 6) * 32 + (rs & 63); return (rs & 63) < 32; }

namespace pg8 {
struct OrderIn {
    StaticOrder so; int pn_off, extra, extra_pm0;
    __device__ bool next(int i, Unit& u) const {
        const long L = (long)i * so.G + so.c;
        if (L < so.nwg) { so.next(i, u); u.pn += pn_off; return true; }
        const long e = L - so.nwg; if (e >= extra) return false;
        u.pm = extra_pm0 + (int)(e >> 3); u.pn = (int)(e & 7); u.kofs = 0; return true;
    }
    __device__ __forceinline__ void a_ready(const Unit&) const {}
    __device__ __forceinline__ void done(const Unit&) const {}
};
#define DPP_SHR(v, n) __int_as_float(__builtin_amdgcn_update_dpp(0, __float_as_int(v), 0x110 + (n), 0xf, 0xf, false))
#define PERMA(lane) ((((lane) >> 2) + 16 * ((lane) & 3)) << 2)
__device__ __forceinline__ f32x4 lperm(const f32x4 v, int pa) { f32x4 r;
    r[0] = __int_as_float(__builtin_amdgcn_ds_bpermute(pa, __float_as_int(v[0]))); r[1] = __int_as_float(__builtin_amdgcn_ds_bpermute(pa, __float_as_int(v[1])));
    r[2] = __int_as_float(__builtin_amdgcn_ds_bpermute(pa, __float_as_int(v[2]))); r[3] = __int_as_float(__builtin_amdgcn_ds_bpermute(pa, __float_as_int(v[3]))); return r; }
struct EpiIn {
    static constexpr bool PERM = false, AFTER_DRAIN = false;
    const float* rstd1; const float* lbl; const float* qg; const float* kg; unsigned char* ws; float* out;
    __device__ __forceinline__ void operator()(const f32x4 (&acc)[2][2][4][2], const Unit& u, int wr, int wc, int fr, int fq) const {
        const int pn = u.pn, rowb = u.pm * BM + wr * 64 + fr; const bool samp = u.pm >= (MP / BM);
        bf16_t* const QR = (bf16_t*)(ws + WS_QR); bf16_t* const KR = (bf16_t*)(ws + WS_KR); bf16_t* const VH = (bf16_t*)(ws + WS_VH); bf16_t* const SG = (bf16_t*)(ws + WS_SG); float* const vec = (float*)(ws + WS_VEC);
        float rs[2][4];
#pragma unroll
        for (int ai = 0; ai < 2; ++ai)
#pragma unroll
            for (int m = 0; m < 4; ++m) rs[ai][m] = rstd1[rowb + ai * HALF + m * 16];
        if (pn < 4) {
            const int h = pn, ch0 = 128 * h + 32 * wc + 4 * fq; const int lane = threadIdx.x & 63; const int a15 = ((lane & 48) | 15) << 2;
#pragma unroll
            for (int n = 0; n < 2; ++n) {
                const f32x4 l0 = *(const f32x4*)(lbl + ch0 + 16 * n), l1 = *(const f32x4*)(lbl + 512 + ch0 + 16 * n);
                f32x4 lb, omlb;
#pragma unroll
                for (int j = 0; j < 4; ++j) { lb[j] = 1.f / (1.f + __expf(l1[j] - l0[j])); omlb[j] = 1.f - lb[j]; }
#pragma unroll
                for (int ai = 0; ai < 2; ++ai) {
                    f32x4 bq[4], kk[4], bb[4]; f32x4 carry = {0.f, 0.f, 0.f, 0.f};
#pragma unroll
                    for (int m = 0; m < 4; ++m) {
#pragma unroll
                        for (int j = 0; j < 4; ++j) {
                            const float zq = acc[ai][0][m][n][j] * rs[ai][m], zf = acc[ai][1][m][n][j] * rs[ai][m];
                            const float sig = 1.f / (1.f + __expf(-zf)); const float f = lb[j] + omlb[j] * sig; float k = omlb[j] * (1.f - sig); float s = __logf(f);
                            if (samp && m >= 2) { s = 0.f; k = 0.f; }
                            s += DPP_SHR(s, 1); s += DPP_SHR(s, 2); s += DPP_SHR(s, 4); s += DPP_SHR(s, 8);
                            s += carry[j]; carry[j] = __int_as_float(__builtin_amdgcn_ds_bpermute(a15, __float_as_int(s)));
                            bq[m][j] = zq; kk[m][j] = k; bb[m][j] = s;
                        }
                    }
#pragma unroll
                    for (int m = 0; m < 4; ++m) {
                        float qv[4], kv[4];
#pragma unroll
                        for (int j = 0; j < 4; ++j) { qv[j] = bq[m][j] * __expf(bb[m][j]); kv[j] = kk[m][j] * __expf(-bb[m][j]); }
                        const size_t off = (size_t)(rowb + ai * HALF + m * 16) * 512 + ch0 + 16 * n;
                        v2u wq; wq.x = cvt_pk_bf16(qv[0], qv[1]); wq.y = cvt_pk_bf16(qv[2], qv[3]); *(v2u*)(QR + off) = wq;
                        v2u wk; wk.x = cvt_pk_bf16(kv[0], kv[1]); wk.y = cvt_pk_bf16(kv[2], kv[3]); *(v2u*)(KR + off) = wk;
                    }
                    if (fr == 0) {
                        const size_t voff = (size_t)((u.pm * BM + ai * HALF + wr * 64) >> 6) * 512 + ch0 + 16 * n;
                        f32x4 d;
#pragma unroll
                        for (int j = 0; j < 4; ++j) d[j] = __expf(carry[j]);
                        *(f32x4*)(vec + voff) = d;
                    }
                }
            }
        } else if (pn < 8) {
            const int h = pn - 4, c0 = 128 * h + 32 * wc + 4 * fq;
#pragma unroll
            for (int ai = 0; ai < 2; ++ai)
#pragma unroll
                for (int m = 0; m < 4; ++m) { const size_t off = (size_t)(rowb + ai * HALF + m * 16) * 512 + c0; const float r = rs[ai][m];
#pragma unroll
                    for (int n = 0; n < 2; ++n) { const f32x4 v = acc[ai][0][m][n] * r; f32x4 g = acc[ai][1][m][n] * r;
#pragma unroll
                        for (int j = 0; j < 4; ++j) g[j] = g[j] / (1.f + __expf(-g[j]));
                        v2u wv; wv.x = cvt_pk_bf16(v[0], v[1]); wv.y = cvt_pk_bf16(v[2], v[3]); *(v2u*)(VH + off + 16 * n) = wv;
                        v2u wg; wg.x = cvt_pk_bf16(g[0], g[1]); wg.y = cvt_pk_bf16(g[2], g[3]); *(v2u*)(SG + off + 16 * n) = wg; } }
        } else if (pn < 12) {
            const bool isK = pn >= 10; const int head = 4 * ((pn - 8) & 1) + wc; const float* gain = isK ? kg : qg; const float osc = isK ? 1.f : attn_body::C2;
            f32x4 gv[2][2];
#pragma unroll
            for (int bj = 0; bj < 2; ++bj)
#pragma unroll
                for (int n = 0; n < 2; ++n) gv[bj][n] = *(const f32x4*)(gain + 32 * bj + 16 * n + 4 * fq) * osc;
#pragma unroll
            for (int ai = 0; ai < 2; ++ai)
#pragma unroll
                for (int m = 0; m < 4; ++m) { const int row = rowb + ai * HALF + m * 16; const float r = rs[ai][m]; float ssq = 0.f;
#pragma unroll
                    for (int bj = 0; bj < 2; ++bj)
#pragma unroll
                        for (int n = 0; n < 2; ++n) { const f32x4 z = acc[ai][bj][m][n] * r; ssq += (z[0] * z[0] + z[1] * z[1]) + (z[2] * z[2] + z[3] * z[3]); }
                    ssq += __shfl_xor(ssq, 16); ssq += __shfl_xor(ssq, 32);
                    const float r2 = r / sqrtf(ssq * (1.f / 64.f) + EPSN);
                    int idx; const bool valid = row_map(row, idx);
                    float* ofp = out + (samp ? O_KS : O_KP) + (size_t)idx * 512;
                    const size_t boff = samp ? (isK ? WS_KS : WS_QS) : (isK ? WS_K : WS_Q); const size_t brow = samp ? (size_t)((idx >> 5) * SSEQ + PAST + (idx & 31)) : (size_t)row;
                    bf16_t* bfp = (bf16_t*)(ws + boff) + brow * 512;
                    if (valid) {
#pragma unroll
                        for (int bj = 0; bj < 2; ++bj)
#pragma unroll
                            for (int n = 0; n < 2; ++n) { const f32x4 v = acc[ai][bj][m][n] * r2 * gv[bj][n]; const int col = 64 * head + 32 * bj + 16 * n + 4 * fq;
                                if (isK) *(f32x4*)(ofp + col) = v;
                                v2u w; w.x = cvt_pk_bf16(v[0], v[1]); w.y = cvt_pk_bf16(v[2], v[3]); *(v2u*)(bfp + col) = w; } } }
        } else {
            const int c0 = 256 * (pn - 12) + 32 * wc + 4 * fq;
#pragma unroll
            for (int ai = 0; ai < 2; ++ai)
#pragma unroll
                for (int m = 0; m < 4; ++m) { const int row = rowb + ai * HALF + m * 16; const float r = rs[ai][m];
                    int idx; const bool valid = row_map(row, idx);
                    float* ofp = out + (samp ? O_VS : O_VP) + (size_t)idx * 512;
                    const size_t brow = samp ? (size_t)((idx >> 5) * SSEQ + PAST + (idx & 31)) : (size_t)row;
                    bf16_t* bfp = (bf16_t*)(ws + (samp ? WS_VS : WS_V)) + brow * 512;
                    if (valid) {
#pragma unroll
                        for (int bj = 0; bj < 2; ++bj)
#pragma unroll
                            for (int n = 0; n < 2; ++n) { const f32x4 v = acc[ai][bj][m][n] * r; const int col = c0 + 128 * bj + 16 * n;
                                *(f32x4*)(ofp + col) = v;
                                v2u w; w.x = cvt_pk_bf16(v[0], v[1]); w.y = cvt_pk_bf16(v[2], v[3]); *(v2u*)(bfp + col) = w; } } }
        }
    }
};
struct EpiWo {
    static constexpr bool PERM = false, AFTER_DRAIN = false;
    const float* xp; const float* xs; float* yp; float* ys; bf16_t* X1B; float* ssq;
    __device__ __forceinline__ void operator()(const f32x4 (&acc)[2][2][4][2], const Unit& u, int wr, int wc, int fr, int fq) const {
        const int lane = threadIdx.x & 63, pa = PERMA(lane); fr = lane >> 2; fq = lane & 3;
        const int rowb = u.pm * BM + wr * 64 + fr, c0 = u.pn * BM + wc * 32 + 4 * fq; const bool samp = u.pm >= (MP / BM);
#pragma unroll
        for (int ai = 0; ai < 2; ++ai) {
            f32x4 xv[4][2][2];
#pragma unroll
            for (int m = 0; m < 4; ++m) { const int row = rowb + ai * HALF + m * 16; int idx; const bool valid = row_map(row, idx); const float* xr = (samp ? xs : xp) + (size_t)idx * DMOD;
#pragma unroll
                for (int bj = 0; bj < 2; ++bj)
#pragma unroll
                    for (int n = 0; n < 2; ++n) xv[m][bj][n] = valid ? *(const f32x4*)(xr + c0 + 128 * bj + 16 * n) : (f32x4){0.f, 0.f, 0.f, 0.f}; }
            __builtin_amdgcn_sched_barrier(0);
#pragma unroll
            for (int m = 0; m < 4; ++m) { const int row = rowb + ai * HALF + m * 16; int idx; const bool valid = row_map(row, idx);
                float* yr = yp + (samp ? (size_t)MP * DMOD : (size_t)0) + (size_t)idx * DMOD; float s = 0.f;
#pragma unroll
                for (int bj = 0; bj < 2; ++bj)
#pragma unroll
                    for (int n = 0; n < 2; ++n) { const int col = c0 + 128 * bj + 16 * n; f32x4 v = lperm(acc[ai][bj][m][n], pa) + xv[m][bj][n];
                        if (valid) *(f32x4*)(yr + col) = v;
                        s += (v[0] * v[0] + v[1] * v[1]) + (v[2] * v[2] + v[3] * v[3]);
                        v2u w; w.x = cvt_pk_bf16(v[0], v[1]); w.y = cvt_pk_bf16(v[2], v[3]); *(v2u*)(X1B + (size_t)row * DMOD + col) = w; }
                s += __shfl_xor(s, 1); s += __shfl_xor(s, 2);
                if (fq == 0) ssq[(size_t)row * 16 + 4 * u.pn + wc] = s; }
            __builtin_amdgcn_sched_barrier(0);
        }
    }
};
struct EpiUp {
    static constexpr bool PERM = true, AFTER_DRAIN = false;
    bf16_t* O; const float* ssq;
    __device__ __forceinline__ void operator()(const f32x4 (&acc)[2][2][4][2], const Unit& u, int wr, int wc, int fr, int fq) const {
        const int row0 = u.pm * BM + wr * 64 + fr, col0 = u.pn * BM + wc * 32 + 8 * fq;
        float rr[2][4];
#pragma unroll
        for (int ai = 0; ai < 2; ++ai) { f32x4 sv[4][4];
#pragma unroll
            for (int m = 0; m < 4; ++m) { const f32x4* sp = (const f32x4*)(ssq + (size_t)(row0 + ai * HALF + m * 16) * 16); sv[m][0] = sp[0]; sv[m][1] = sp[1]; sv[m][2] = sp[2]; sv[m][3] = sp[3]; }
            __builtin_amdgcn_sched_barrier(0);
#pragma unroll
            for (int m = 0; m < 4; ++m) { const f32x4 st = (sv[m][0] + sv[m][1]) + (sv[m][2] + sv[m][3]); rr[ai][m] = __builtin_amdgcn_rsqf(((st[0] + st[1]) + (st[2] + st[3])) * (1.f / DMOD) + EPSN); } }
#pragma unroll
        for (int ai = 0; ai < 2; ++ai)
#pragma unroll
            for (int m = 0; m < 4; ++m) { const int row = row0 + ai * HALF + m * 16;
                const float r = rr[ai][m];
                bf16_t* rowp = O + (size_t)row * FF + col0;
#pragma unroll
                for (int bj = 0; bj < 2; ++bj) { f32x4 v0 = acc[ai][bj][m][0] * r, v1 = acc[ai][bj][m][1] * r;
#pragma unroll
                    for (int j = 0; j < 4; ++j) { v0[j] = fmaxf(v0[j], 0.f); v0[j] *= v0[j]; v1[j] = fmaxf(v1[j], 0.f); v1[j] *= v1[j]; }
                    u32x4 w; w.x = cvt_pk_bf16(v0[0], v0[1]); w.y = cvt_pk_bf16(v0[2], v0[3]); w.z = cvt_pk_bf16(v1[0], v1[1]); w.w = cvt_pk_bf16(v1[2], v1[3]);
                    *(u32x4*)(rowp + bj * HALF) = w; } }
    }
};
struct OrderDown {
    StaticOrder so; int mode;
    static constexpr int KSPLIT = 4;
    __device__ bool next(int i, Unit& u) const {
        if (mode) return so.next(i, u);
        const long L = (long)i * so.G + so.c; if (L >= 8 * KSPLIT) return false;
        const int t = (int)L / KSPLIT, ks = (int)L % KSPLIT; u.pm = MP / BM + (t >> 2); u.pn = t & 3; u.kofs = ks * (FF / KSPLIT); return true;
    }
    __device__ __forceinline__ void a_ready(const Unit&) const {}
    __device__ __forceinline__ void done(const Unit&) const {}
};
struct EpiDown {
    static constexpr bool PERM = false, AFTER_DRAIN = false;
    float* yp; float* ys; int atomic;
    __device__ __forceinline__ void operator()(const f32x4 (&acc)[2][2][4][2], const Unit& u, int wr, int wc, int fr, int fq) const {
        const int lane = threadIdx.x & 63, pa = PERMA(lane); fr = lane >> 2; fq = lane & 3;
        const int rowb = u.pm * BM + wr * 64 + fr, c0 = u.pn * BM + wc * 32 + 4 * fq; const bool samp = u.pm >= (MP / BM);
#pragma unroll
        for (int ai = 0; ai < 2; ++ai) {
            f32x4 xv[4][2][2];
            if (!atomic) {
#pragma unroll
                for (int m = 0; m < 4; ++m) { const int row = rowb + ai * HALF + m * 16; int idx; const bool valid = row_map(row, idx); const float* yr = yp + (samp ? (size_t)MP * DMOD : (size_t)0) + (size_t)idx * DMOD;
#pragma unroll
                    for (int bj = 0; bj < 2; ++bj)
#pragma unroll
                        for (int n = 0; n < 2; ++n) xv[m][bj][n] = valid ? *(const f32x4*)(yr + c0 + 128 * bj + 16 * n) : (f32x4){0.f, 0.f, 0.f, 0.f}; }
            }
            __builtin_amdgcn_sched_barrier(0);
#pragma unroll
            for (int m = 0; m < 4; ++m) { const int row = rowb + ai * HALF + m * 16; int idx; const bool valid = row_map(row, idx);
                float* yr = yp + (samp ? (size_t)MP * DMOD : (size_t)0) + (size_t)idx * DMOD;
                if (valid) {
#pragma unroll
                    for (int bj = 0; bj < 2; ++bj)
#pragma unroll
                        for (int n = 0; n < 2; ++n) { const int col = c0 + 128 * bj + 16 * n; const f32x4 v = lperm(acc[ai][bj][m][n], pa);
                            if (atomic) {
#pragma unroll
                                for (int j = 0; j < 4; ++j) __hip_atomic_fetch_add(yr + col + j, v[j], __ATOMIC_RELAXED, __HIP_MEMORY_SCOPE_AGENT);
                            } else *(f32x4*)(yr + col) = xv[m][bj][n] + v; } } }
            __builtin_amdgcn_sched_barrier(0);
        }
    }
};
}

struct Args { const float* in[17]; float* out; unsigned char* ws; int ph_lo, ph_hi; };
struct Frame {
    LAS unsigned char* lds; volatile LAS unsigned* MISC; unsigned* ctl; unsigned char* ws; float* out;
    int tid, lane, wave, vcu, G;
    const float *xp, *xs, *ck, *cv, *clf, *sh, *n1, *win, *bff, *qg, *kg, *lbl, *hon, *wout, *n2, *wup, *wdn;
};

__device__ __forceinline__ int win_src_col(int g) {
    const int j0 = 32 * g, tile = j0 >> 8, jl = j0 & 255;
    if (tile < 4) return (jl < 128) ? (128 * tile + jl) : (512 + 128 * tile + (jl - 128));
    if (tile < 8) { const int h = tile - 4; return (jl < 128) ? (1024 + 128 * h + jl) : (1536 + 128 * h + (jl - 128)); }
    if (tile < 12) { const int base = tile < 10 ? 2048 : 2560, tl = (tile - 8) & 1, bj = jl >> 7, wc = (jl >> 5) & 3; return base + 64 * (4 * tl + wc) + 32 * bj; }
    return 3072 + (j0 - 12 * 256);
}
__device__ __forceinline__ void p0_transpose_item(const float* W, int ldw, int K, const float* nrm, bf16* WT, int n0, int src0, int k0, LAS float* scr, int lane) {
    float vals[32]; const float* wp = W + (size_t)(k0 + (lane >> 5)) * ldw + src0 + (lane & 31);
#pragma unroll
    for (int i = 0; i < 32; ++i) vals[i] = wp[(size_t)(2 * i) * ldw];
    const int c = lane & 7;
    f32x4 n0v = {1.f, 1.f, 1.f, 1.f}, n1v = {1.f, 1.f, 1.f, 1.f};
    if (nrm) { n0v = *(const f32x4*)(nrm + k0 + 8 * c); n1v = *(const f32x4*)(nrm + k0 + 8 * c + 4); }
#pragma unroll
    for (int i = 0; i < 32; ++i) scr[(2 * i + (lane >> 5)) * 33 + (lane & 31)] = vals[i];
    LDS_WAIT(); asm volatile("" ::: "memory");
#pragma unroll
    for (int j = 0; j < 4; ++j) { const int n = (lane >> 3) + 8 * j; const LAS float* s = scr + (8 * c) * 33 + n;
        v4u o; o.x = pk2(s[0 * 33] * n0v[0], s[1 * 33] * n0v[1]); o.y = pk2(s[2 * 33] * n0v[2], s[3 * 33] * n0v[3]); o.z = pk2(s[4 * 33] * n1v[0], s[5 * 33] * n1v[1]); o.w = pk2(s[6 * 33] * n1v[2], s[7 * 33] * n1v[3]);
        *(v4u*)(WT + (size_t)(n0 + n) * K + k0 + 8 * c) = o; }
    LDS_WAIT(); asm volatile("" ::: "memory");
}
__device__ __forceinline__ void p0_prologue(Frame& F) {
    LAS float* scr = (LAS float*)(F.lds + F.wave * 16384);
    const int gw = F.vcu * NWAVES + F.wave, NGW = F.G * NWAVES, lane = F.lane;
    bf16* Win_t = (bf16*)(F.ws + WS_WIN); bf16* Wo_t = (bf16*)(F.ws + WS_WO); bf16* Wup_t = (bf16*)(F.ws + WS_WUP); bf16* Wdn_t = (bf16*)(F.ws + WS_WDN);
    constexpr int I_IN = 16 * (NIN / 32), I_O = 16 * 32, I_UP = 16 * (FF / 32), I_DN = 64 * 32, NITEMS = I_IN + I_O + I_UP + I_DN;
    for (int it = gw; it < NITEMS; it += NGW) {
        int r = it;
        if (r < I_IN) { const int kb = r / (NIN / 32), g = r % (NIN / 32); p0_transpose_item(F.win, INC, DMOD, F.n1, Win_t, 32 * g, win_src_col(g), 64 * kb, scr, lane); continue; } r -= I_IN;
        if (r < I_O) { const int kb = r / 32, g = r % 32; p0_transpose_item(F.wout, DMOD, DMOD, nullptr, Wo_t, 32 * g, 32 * g, 64 * kb, scr, lane); continue; } r -= I_O;
        if (r < I_UP) { const int kb = r / (FF / 32), g = r % (FF / 32); p0_transpose_item(F.wup, FF, DMOD, F.n2, Wup_t, 32 * g, 32 * g, 64 * kb, scr, lane); continue; } r -= I_UP;
        { const int kb = r / 32, g = r % 32; p0_transpose_item(F.wdn, DMOD, FF, nullptr, Wdn_t, 32 * g, 32 * g, 64 * kb, scr, lane); }
    }
    { const int gt = F.vcu * NTHR + F.tid, NGT = F.G * NTHR;
      bf16* Qs = (bf16*)(F.ws + WS_QS); bf16* Ks = (bf16*)(F.ws + WS_KS); bf16* Vs = (bf16*)(F.ws + WS_VS);
      for (int i = gt; i < NBATCH * PAST * 64; i += NGT) { const int b = i / (PAST * 64), rem = i % (PAST * 64); const size_t so = (size_t)i * 8, dof = ((size_t)b * SSEQ * 64 + rem) * 8;
          const f32x4 a0 = *(const f32x4*)(F.ck + so), a1 = *(const f32x4*)(F.ck + so + 4), b0 = *(const f32x4*)(F.cv + so), b1 = *(const f32x4*)(F.cv + so + 4);
          v4u o; o.x = pk2(a0[0], a0[1]); o.y = pk2(a0[2], a0[3]); o.z = pk2(a1[0], a1[1]); o.w = pk2(a1[2], a1[3]); *(v4u*)(Ks + dof) = o;
          o.x = pk2(b0[0], b0[1]); o.y = pk2(b0[2], b0[3]); o.z = pk2(b1[0], b1[1]); o.w = pk2(b1[2], b1[3]); *(v4u*)(Vs + dof) = o; }
      const v4u z = {0u, 0u, 0u, 0u};
      for (int i = gt; i < NBATCH * SSEQ * 64; i += NGT) *(v4u*)(Qs + (size_t)i * 8) = z;
      for (int i = gt; i < NBATCH * (SSEQ - PAST) * 64; i += NGT) { const int b = i / ((SSEQ - PAST) * 64), rem = i % ((SSEQ - PAST) * 64); const size_t dof = ((size_t)(b * SSEQ + PAST) * 64 + rem) * 8; *(v4u*)(Ks + dof) = z; *(v4u*)(Vs + dof) = z; }
    }
    float wf[4][4][8];
#pragma unroll
    for (int j = 0; j < 4; ++j)
#pragma unroll
        for (int i = 0; i < 4; ++i) { const int k = 256 * j + 4 * lane + i; const float nk = F.n1[k]; const f32x4 a = *(const f32x4*)(F.win + (size_t)k * INC + NIN), b = *(const f32x4*)(F.win + (size_t)k * INC + NIN + 4);
            wf[j][i][0] = a[0] * nk; wf[j][i][1] = a[1] * nk; wf[j][i][2] = a[2] * nk; wf[j][i][3] = a[3] * nk; wf[j][i][4] = b[0] * nk; wf[j][i][5] = b[1] * nk; wf[j][i][6] = b[2] * nk; wf[j][i][7] = b[3] * nk; }
    float* rstd1 = (float*)(F.ws + WS_RSTD); bf16* XB = (bf16*)(F.ws + WS_XB);
    f32x4 vn[4];
#define P0_LOADROW(mm) do { int idx_; const bool val_ = (mm) < MTOT && row_map((mm), idx_); const float* xr_ = ((mm) < MP ? F.xp : F.xs) + (size_t)idx_ * DMOD; \
        _Pragma("unroll") for (int j = 0; j < 4; ++j) vn[j] = val_ ? *((const f32x4*)xr_ + 64 * j + lane) : (f32x4){0.f, 0.f, 0.f, 0.f}; } while (0)
    P0_LOADROW(gw);
    for (int m = gw; m < MTOT; m += NGW) {
        int idx; const bool valid = row_map(m, idx);
        f32x4 v[4]; float s = 0.f;
#pragma unroll
        for (int j = 0; j < 4; ++j) v[j] = vn[j];
        P0_LOADROW(m + NGW);
#pragma unroll
        for (int j = 0; j < 4; ++j) s += (v[j][0] * v[j][0] + v[j][1] * v[j][1]) + (v[j][2] * v[j][2] + v[j][3] * v[j][3]);
        const float rstd = 1.f / sqrtf(wave_sum(s) * (1.f / DMOD) + EPSN);
        if (lane == 0) rstd1[m] = rstd;
        unsigned long long* o8 = (unsigned long long*)(XB + (size_t)m * DMOD) + lane;
#pragma unroll
        for (int j = 0; j < 4; ++j) o8[64 * j] = (unsigned long long)pk2(v[j][0], v[j][1]) | ((unsigned long long)pk2(v[j][2], v[j][3]) << 32);
        float a8[8];
#pragma unroll
        for (int h = 0; h < 8; ++h) { float a = 0.f;
#pragma unroll
            for (int j = 0; j < 4; ++j)
#pragma unroll
                for (int i = 0; i < 4; ++i) a += v[j][i] * wf[j][i][h];
            a8[h] = a; }
        float b4[4], c2[2], dsum;
#pragma unroll
        for (int i = 0; i < 4; ++i) { const bool hi_ = (lane & 32) != 0; const float send = hi_ ? a8[i] : a8[4 + i], keep = hi_ ? a8[4 + i] : a8[i]; b4[i] = keep + __shfl_xor(send, 32); }
#pragma unroll
        for (int i = 0; i < 2; ++i) { const bool hi_ = (lane & 16) != 0; const float send = hi_ ? b4[i] : b4[2 + i], keep = hi_ ? b4[2 + i] : b4[i]; c2[i] = keep + __shfl_xor(send, 16); }
        { const bool hi_ = (lane & 8) != 0; const float send = hi_ ? c2[0] : c2[1], keep = hi_ ? c2[1] : c2[0]; dsum = keep + __shfl_xor(send, 8); }
        dsum += __shfl_xor(dsum, 4); dsum += __shfl_xor(dsum, 2); dsum += __shfl_xor(dsum, 1);
        { const int hh = (lane >> 3) & 7; const float xx = dsum * rstd + F.bff[hh]; const float ls = fminf(xx, 0.f) - log1pf(expf(-fabsf(xx)));
          if (valid && (lane & 7) == 0) { float* lp = (m < MP ? F.out + O_LP : F.out + O_LS) + (size_t)idx * 8; lp[hh] = ls; } }
    }
}
__device__ __forceinline__ void scan_chain(Frame& F, int ch) {
    LAS float* wsum = (LAS float*)F.lds;
    const bool samp = ch >= 64; const int c2 = samp ? ch - 64 : ch, b = c2 >> 3, h = c2 & 7; const int L = samp ? SSEQ : TSEQ, EPT = samp ? 3 : 16;
    float* dst = samp ? (float*)(F.ws + WS_CGS) + (size_t)c2 * SSEQ : (float*)(F.ws + WS_CGP) + (size_t)c2 * TSEQ;
    float vals[16]; float sum = 0.f;
#pragma unroll
    for (int i = 0; i < 16; ++i) { const int p = F.tid * EPT + i; float v = 0.f;
        if (i < EPT && p < L) { if (!samp) v = F.out[O_LP + ((size_t)b * TSEQ + p) * 8 + h]; else if (p < PAST) v = F.clf[((size_t)b * PAST + p) * 8 + h]; else if (p < PAST + DSEQ) v = F.out[O_LS + ((size_t)b * DSEQ + (p - PAST)) * 8 + h]; }
        sum += v; vals[i] = sum; }
    float incl = sum;
#pragma unroll
    for (int o = 1; o < 64; o <<= 1) { const float t = __shfl_up(incl, o); if (F.lane >= o) incl += t; }
    if (F.lane == 63) wsum[F.wave] = incl;
    __syncthreads();
    float base = 0.f;
    for (int w = 0; w < F.wave; ++w) base += wsum[w];
    const float excl = base + incl - sum;
#pragma unroll
    for (int i = 0; i < 16; ++i) { const int p = F.tid * EPT + i; if (i < EPT && p < L) dst[p] = (excl + vals[i]) * LOG2E; }
    __syncthreads();
}
constexpr int KP = 320  , H_QR = 0, H_KR = 17408, H_KT = 37888, H_VT = 58368, H_VEC = 71680, H_AL = 73216, H_OL = 82432, H_END = 116224;
static_assert(H_END <= RING_BYTES, "hgrn LDS");
typedef short v4i16_t __attribute__((ext_vector_type(4)));
__device__ __forceinline__ bf16x8 tr_frag(LAS unsigned char* p) {
    const v4i16_t lo = __builtin_amdgcn_ds_read_tr16_b64_v4i16((LAS v4i16_t*)p), hi = __builtin_amdgcn_ds_read_tr16_b64_v4i16((LAS v4i16_t*)(p + 4 * KP));
    return (bf16x8){lo[0], lo[1], lo[2], lo[3], hi[0], hi[1], hi[2], hi[3]};
}
__device__ __forceinline__ f32x4 mfma16(bf16x8 a, bf16x8 b, f32x4 c) { return __builtin_amdgcn_mfma_f32_16x16x32_bf16(a, b, c, 0, 0, 0); }
#define LAUNDER(x) asm volatile("" : "+v"(x))
#ifndef PR_A
#define PR_A 1
#endif
#ifndef PR_O
#define PR_O 1
#endif
#ifndef PR_OUT
#define PR_OUT 1
#endif
#ifndef PR_U
#define PR_U 0
#endif
#ifndef PR_ST
#define PR_ST 1
#endif
#ifndef PR_BAR
#define PR_BAR 1
#endif
#define HG_BAR() do { for (int rb_ = 0; rb_ < PR_BAR; ++rb_) { asm volatile("s_waitcnt lgkmcnt(0)" ::: "memory"); __builtin_amdgcn_s_barrier(); asm volatile("" ::: "memory"); } } while (0)
__device__ __forceinline__ void hgrn_chain(Frame& F, int row0, int chunk0, int nsteps, int h, const float* S0, float* Sout) {
    LAS unsigned char* L = F.lds; int tid_ = F.tid; LAUNDER(tid_); const int tid = tid_, lane = tid & 63, w = F.wave, l15 = lane & 15, fq = lane >> 4;
    const char* qb = (const char*)(F.ws + WS_QR) + ((size_t)row0 * 512 + 128 * h) * 2; const char* kb_ = (const char*)(F.ws + WS_KR) + ((size_t)row0 * 512 + 128 * h) * 2;
    const char* vb = (const char*)(F.ws + WS_VH) + ((size_t)row0 * 512 + 128 * h) * 2; const char* gb = (const char*)(F.ws + WS_SG) + ((size_t)row0 * 512 + 128 * h) * 2;
    const char* eb = (const char*)(F.ws + WS_VEC) + ((size_t)chunk0 * 512 + 128 * h) * 4; char* mb = (char*)(F.ws + WS_MIX) + ((size_t)row0 * DMOD + 128 * h) * 2;
    const int oc = tid >> 3, oseg = tid & 7;
    unsigned vo_rm = (unsigned)((tid >> 4) * 1024 + (tid & 15) * 16), vo_sg = (unsigned)(oc * 1024 + oseg * 32), vo_mix = (unsigned)(oc * 2048 + oseg * 32);
    unsigned vo_vec = (unsigned)((tid & 31) * 16);
    unsigned l_rm = (unsigned)(H_QR + (tid >> 4) * 272 + (tid & 15) * 16), l_rk = (unsigned)(H_KR + (tid >> 4) * KP + (tid & 15) * 16);
    unsigned l_vw = (unsigned)(H_VEC + (tid & 31) * 16);
    unsigned l_aq = (unsigned)(H_QR + (16 * (w >> 1) + l15) * 272 + fq * 16);
    unsigned l_ak = (unsigned)(H_KR + (32 * (w & 1) + l15) * KP + fq * 16);
    unsigned l_aw = (unsigned)(H_AL + (16 * (w >> 1) + 4 * fq) * 144 + (32 * (w & 1) + l15) * 2);
    unsigned l_vt = (unsigned)(H_KT + (8 * fq + (l15 >> 2)) * KP + (16 * w + 4 * (l15 & 3)) * 2);
    unsigned l_q2 = (unsigned)(H_QR + l15 * 272 + fq * 16);
    unsigned l_al = (unsigned)(H_AL + l15 * 144 + fq * 16);
    unsigned l_kt = (unsigned)(H_KR + (8 * fq + (l15 >> 2)) * KP + (8 * (l15 & 3)) * 2);
    unsigned l_ve = (unsigned)(H_VEC + fq * 32);
    unsigned l_ow = (unsigned)(H_OL + (4 * fq) * 528 + (16 * w + l15) * 4);
    unsigned l_or = (unsigned)(H_OL + oc * 528 + oseg * 64);
    f32x4 S[8];
#pragma unroll
    for (int kb = 0; kb < 8; ++kb) S[kb] = (f32x4){0.f, 0.f, 0.f, 0.f};
    if (S0) { const float* sp = S0 + (8 * fq) * 128 + 16 * w + l15;
#pragma unroll
        for (int kb = 0; kb < 8; ++kb) { LAUNDER(sp);
#pragma unroll
            for (int r = 0; r < 4; ++r) S[kb][r] = sp[r * 128];
            sp += (kb & 1) ? 28 * 128 : 4 * 128; } }
    f32x4 gn[4];
#pragma unroll
    for (int i = 0; i < 4; ++i) gn[i] = *(const f32x4*)(F.hon + 128 * h + 16 * oseg + 4 * i);
    v4u pq[2][2], pk[2][2], pv[2][2], psg[2][2], pvec[2]; int cl = 0, gl = 0;
#define HG_LOADS(SET) do { \
        _Pragma("unroll") for (int it = 0; it < 2; ++it) { pq[SET][it] = *(const v4u*)(qb + vo_rm + it * 32768); pk[SET][it] = *(const v4u*)(kb_ + vo_rm + it * 32768); pv[SET][it] = *(const v4u*)(vb + vo_rm + it * 32768); } \
        pvec[SET] = *(const v4u*)(eb + vo_vec); } while (0)
#define HG_STORE(SET) do { \
        _Pragma("unroll") for (int it = 0; it < 2; ++it) { *(LAS v4u*)(L + l_rm + it * 8704) = pq[SET][it]; *(LAS v4u*)(L + l_rk + it * 32 * KP) = pk[SET][it]; *(LAS v4u*)(L + l_rk + (H_KT - H_KR) + it * 32 * KP) = pv[SET][it]; } \
        if (tid < 32) *(LAS v4u*)(L + l_vw) = pvec[SET]; } while (0)
#define HG_ADV() do { const int a_ = (cl + 1 < nsteps) ? 1 : 0; qb += a_ * 65536; kb_ += a_ * 65536; vb += a_ * 65536; eb += a_ * 2048; cl += a_; } while (0)
    HG_LOADS(0); HG_ADV(); HG_STORE(0); HG_LOADS(1); HG_ADV();
    psg[0][0] = *(const v4u*)(gb + vo_sg); psg[0][1] = *(const v4u*)(gb + vo_sg + 16); { const int a_ = (gl + 1 < nsteps) ? 1 : 0; gb += a_ * 65536; gl += a_; }
    HG_BAR();
#define HG_BODY(CUR, NXT, CC) do { \
        LAUNDER(vo_rm); LAUNDER(vo_sg); LAUNDER(vo_mix); LAUNDER(vo_vec); LAUNDER(l_rm); LAUNDER(l_rk); LAUNDER(l_vw); LAUNDER(l_aq); LAUNDER(l_ak); LAUNDER(l_aw); \
        LAUNDER(l_vt); LAUNDER(l_q2); LAUNDER(l_al); LAUNDER(l_kt); LAUNDER(l_ve); LAUNDER(l_ow); LAUNDER(l_or); \
        psg[NXT][0] = *(const v4u*)(gb + vo_sg); psg[NXT][1] = *(const v4u*)(gb + vo_sg + 16); { const int a_ = (gl + 1 < nsteps) ? 1 : 0; gb += a_ * 65536; gl += a_; } \
        HG_LOADS(CUR); HG_ADV(); \
        for (int ra_ = 0; ra_ < PR_A; ++ra_) { const int cblk = w >> 1; \
        _Pragma("unroll") \
          for (int jj = 0; jj < 2; ++jj) { const int sblk = 2 * (w & 1) + jj; f32x4 a = {0.f, 0.f, 0.f, 0.f}; \
              if (sblk <= cblk) { \
                  bf16x8 af[4], bf[4]; \
        _Pragma("unroll") \
                  for (int ks = 0; ks < 4; ++ks) { af[ks] = *(const LAS bf16x8*)(L + l_aq + ks * 64); bf[ks] = *(const LAS bf16x8*)(L + l_ak + jj * 16 * KP + ks * 64); } \
                  asm volatile("" : "+v"(af[0]), "+v"(af[1]), "+v"(af[2]), "+v"(af[3]), "+v"(bf[0]), "+v"(bf[1]), "+v"(bf[2]), "+v"(bf[3])); \
        _Pragma("unroll") \
                  for (int ks = 0; ks < 4; ++ks) a = mfma16(af[ks], bf[ks], a); \
        _Pragma("unroll") \
                  for (int r = 0; r < 4; ++r) if (16 * sblk + l15 > 16 * cblk + 4 * fq + r) a[r] = 0.f; \
              } \
        _Pragma("unroll") \
              for (int r = 0; r < 4; ++r) *(LAS unsigned short*)(L + l_aw + r * 144 + jj * 32) = (unsigned short)(pk2(a[r], 0.f) & 0xffffu); \
          } HG_BAR(); } \
        { bf16x8 bvt[2]; \
        _Pragma("unroll") \
          for (int ks = 0; ks < 2; ++ks) bvt[ks] = tr_frag(L + l_vt + ks * 32 * KP); \
          bf16x8 sb[4]; \
        _Pragma("unroll") \
          for (int kb2 = 0; kb2 < 4; ++kb2) { v4u t; t.x = pk2(S[2 * kb2][0], S[2 * kb2][1]); t.y = pk2(S[2 * kb2][2], S[2 * kb2][3]); t.z = pk2(S[2 * kb2 + 1][0], S[2 * kb2 + 1][1]); t.w = pk2(S[2 * kb2 + 1][2], S[2 * kb2 + 1][3]); sb[kb2] = __builtin_bit_cast(bf16x8, t); } \
          for (int ro_ = 0; ro_ < PR_O; ++ro_) \
          _Pragma("unroll") \
          for (int cb = 0; cb < 4; ++cb) { f32x4 o = {0.f, 0.f, 0.f, 0.f}; bf16x8 fa[2], fq_[4]; \
        _Pragma("unroll") \
              for (int ks = 0; ks < 2; ++ks) fa[ks] = *(const LAS bf16x8*)(L + l_al + cb * 16 * 144 + ks * 64); \
        _Pragma("unroll") \
              for (int kb2 = 0; kb2 < 4; ++kb2) fq_[kb2] = *(const LAS bf16x8*)(L + l_q2 + cb * 16 * 272 + kb2 * 64); \
              asm volatile("" : "+v"(fa[0]), "+v"(fa[1]), "+v"(fq_[0]), "+v"(fq_[1]), "+v"(fq_[2]), "+v"(fq_[3])); \
        _Pragma("unroll") \
              for (int ks = 0; ks < 2; ++ks) if (32 * ks <= 16 * cb + 15) o = mfma16(fa[ks], bvt[ks], o); \
        _Pragma("unroll") \
              for (int kb2 = 0; kb2 < 4; ++kb2) o = mfma16(fq_[kb2], sb[kb2], o); \
        _Pragma("unroll") \
              for (int r = 0; r < 4; ++r) *(LAS float*)(L + l_ow + (16 * cb + r) * 528) = o[r]; \
              __builtin_amdgcn_sched_barrier(0); } \
        _Pragma("unroll") \
          for (int kp = 0; kp < 4; ++kp) { bf16x8 fk[2][2]; f32x4 dv[2]; \
        _Pragma("unroll") \
              for (int e = 0; e < 2; ++e) { const int kb = 2 * kp + e; \
        _Pragma("unroll") \
                  for (int ks = 0; ks < 2; ++ks) fk[e][ks] = tr_frag(L + l_kt + (32 * (kb >> 1) + 4 * (kb & 1)) * 2 + ks * 32 * KP); \
                  dv[e] = *(const LAS f32x4*)(L + l_ve + (32 * (kb >> 1) + 4 * (kb & 1)) * 4); } \
              asm volatile("" : "+v"(fk[0][0]), "+v"(fk[0][1]), "+v"(fk[1][0]), "+v"(fk[1][1]), "+v"(dv[0]), "+v"(dv[1])); \
        _Pragma("unroll") \
              for (int e = 0; e < 2; ++e) { const int kb = 2 * kp + e; \
        _Pragma("unroll") \
                  for (int ks = 0; ks < 2; ++ks) S[kb] = mfma16(fk[e][ks], bvt[ks], S[kb]); \
                  S[kb] = S[kb] * dv[e]; } \
              __builtin_amdgcn_sched_barrier(0); } \
          for (int ru_ = 0; ru_ < PR_U; ++ru_) { f32x4 S2[8]; \
          _Pragma("unroll") for (int kb = 0; kb < 8; ++kb) S2[kb] = S[kb]; \
          _Pragma("unroll") \
          for (int kp = 0; kp < 4; ++kp) { bf16x8 fk[2][2]; f32x4 dv[2]; \
          _Pragma("unroll") \
              for (int e = 0; e < 2; ++e) { const int kb = 2 * kp + e; \
          _Pragma("unroll") \
                  for (int ks = 0; ks < 2; ++ks) fk[e][ks] = tr_frag(L + l_kt + (32 * (kb >> 1) + 4 * (kb & 1)) * 2 + ks * 32 * KP); \
                  dv[e] = *(const LAS f32x4*)(L + l_ve + (32 * (kb >> 1) + 4 * (kb & 1)) * 4); } \
              asm volatile("" : "+v"(fk[0][0]), "+v"(fk[0][1]), "+v"(fk[1][0]), "+v"(fk[1][1]), "+v"(dv[0]), "+v"(dv[1])); \
          _Pragma("unroll") \
              for (int e = 0; e < 2; ++e) { const int kb = 2 * kp + e; \
          _Pragma("unroll") \
                  for (int ks = 0; ks < 2; ++ks) S2[kb] = mfma16(fk[e][ks], bvt[ks], S2[kb]); \
                  S2[kb] = S2[kb] * dv[e]; } \
              __builtin_amdgcn_sched_barrier(0); } \
          asm volatile("" :: "v"(S2[0]), "v"(S2[1]), "v"(S2[2]), "v"(S2[3]), "v"(S2[4]), "v"(S2[5]), "v"(S2[6]), "v"(S2[7])); } } \
        HG_BAR(); \
        for (int rt_ = 0; rt_ < PR_OUT; ++rt_) { f32x4 ov[4]; float ss = 0.f; \
        _Pragma("unroll") \
          for (int i = 0; i < 4; ++i) { ov[i] = *(const LAS f32x4*)(L + l_or + 16 * i); ss += (ov[i][0] * ov[i][0] + ov[i][1] * ov[i][1]) + (ov[i][2] * ov[i][2] + ov[i][3] * ov[i][3]); } \
          ss += __shfl_xor(ss, 1); ss += __shfl_xor(ss, 2); ss += __shfl_xor(ss, 4); \
          const float rn = __builtin_amdgcn_rsqf(ss * (1.f / 128.f) + EPSN); \
          float res[16]; \
        _Pragma("unroll") \
          for (int i = 0; i < 4; ++i) \
        _Pragma("unroll") \
              for (int j = 0; j < 4; ++j) { const int e = 4 * i + j; const unsigned wd = psg[CUR][e >> 3][(e & 7) >> 1]; const float sg = bf2f((unsigned short)((e & 1) ? (wd >> 16) : (wd & 0xffffu))); res[e] = ov[i][j] * rn * gn[i][j] * sg; } \
          v4u o0, o1; o0.x = pk2(res[0], res[1]); o0.y = pk2(res[2], res[3]); o0.z = pk2(res[4], res[5]); o0.w = pk2(res[6], res[7]); o1.x = pk2(res[8], res[9]); o1.y = pk2(res[10], res[11]); o1.z = pk2(res[12], res[13]); o1.w = pk2(res[14], res[15]); \
          *(v4u*)(mb + vo_mix) = o0; *(v4u*)(mb + vo_mix + 16) = o1; } mb += 131072; \
        if ((CC) + 1 < nsteps) { for (int rs_ = 0; rs_ < PR_ST; ++rs_) { HG_STORE(NXT); } } \
        HG_BAR(); \
    } while (0)
    for (int c = 0; c < nsteps; c += 2) { HG_BODY(0, 1, c); if (c + 1 < nsteps) HG_BODY(1, 0, c + 1); }
    { int ln2 = lane; LAUNDER(ln2); float* sp = Sout + (8 * (ln2 >> 4)) * 128 + 16 * w + (ln2 & 15);
#pragma unroll
      for (int kb = 0; kb < 8; ++kb) { LAUNDER(sp);
#pragma unroll
          for (int r = 0; r < 4; ++r) sp[r * 128] = S[kb][r];
          sp += (kb & 1) ? 28 * 128 : 4 * 128; } }
#undef HG_LOADS
#undef HG_STORE
#undef HG_ADV
#undef HG_BODY
}

__global__ void __launch_bounds__(NTHR, 2) skel_fwd(Args args) {
    extern __shared__ __attribute__((aligned(16))) unsigned char lds[];
    Frame F;
    F.lds = (LAS unsigned char*)lds; F.MISC = (volatile LAS unsigned*)(F.lds + MISC_OFF);
    F.tid = threadIdx.x; F.lane = F.tid & 63; F.wave = __builtin_amdgcn_readfirstlane(F.tid >> 6);
    F.G = gridDim.x; { const int bx = blockIdx.x; F.vcu = (F.G % 8 == 0) ? (bx % 8) * (F.G / 8) + bx / 8 : bx; }
    F.ws = args.ws; F.ctl = (unsigned*)(args.ws + WS_CTL); F.out = args.out;
    F.xp = args.in[0]; F.xs = args.in[1]; F.ck = args.in[2]; F.cv = args.in[3]; F.clf = args.in[4]; F.sh = args.in[5]; F.n1 = args.in[6]; F.win = args.in[7]; F.bff = args.in[8];
    F.qg = args.in[9]; F.kg = args.in[10]; F.lbl = args.in[11]; F.hon = args.in[12]; F.wout = args.in[13]; F.n2 = args.in[14]; F.wup = args.in[15]; F.wdn = args.in[16];
    const int lo = args.ph_lo, hi = args.ph_hi;
#if defined(PROBE_A)
    unsigned long long ts_[9]; const bool stamper_ = (blockIdx.x == 0 && F.tid == 0);
#define STAMP(k) do { if (stamper_) ts_[k] = __builtin_amdgcn_s_memrealtime(); } while (0)
    STAMP(0);
#else
#define STAMP(k) do {} while (0)
#endif
#ifndef PH_MASK
#define PH_MASK 63
#endif
#define IN(k) (((PH_MASK >> (k)) & 1) && lo <= (k) && (k) < hi)
#define SEAM(k) do { if (IN(k) && IN((k) + 1)) { cg::this_grid().sync(); } } while (0)
    bf16* XB = (bf16*)(F.ws + WS_XB); bf16* X1B = (bf16*)(F.ws + WS_X1B); bf16* MIX = (bf16*)(F.ws + WS_MIX); bf16* HB = (bf16*)(F.ws + WS_H);
    if (IN(0)) { p0_prologue(F);
#if defined(DOUBLE_P0)
        cg::this_grid().sync(); p0_prologue(F);
#endif
    }
    SEAM(0); STAMP(1);
    const int bx = (int)blockIdx.x; const bool chainwg = bx < NCHAINWG; const int NWORK = F.G - NCHAINWG;
    if (IN(1)) {
#ifndef NO_SCAN
        for (int ch = F.vcu; ch < 128; ch += F.G) scan_chain(F, ch);
#endif
        pg8::Gemm g{XB, (const bf16*)(F.ws + WS_WIN), MTOT, NIN, DMOD, DMOD};
        pg8::EpiIn E{(const float*)(F.ws + WS_RSTD), F.lbl, F.qg, F.kg, F.ws, F.out};
#pragma nounroll
        for (int sub = 0; sub < 2; ++sub) {
            pg8::OrderIn S;
            if (sub == 0) { S.so.init(MP, 2048, F.G, bx); S.pn_off = 0; S.extra = 0; S.extra_pm0 = 0; }
            else { S.so.init(MTOT, NIN - 2048, NWORK, bx - NCHAINWG); S.pn_off = 8; S.extra = 8 * (MS / 256); S.extra_pm0 = MP / 256; }
            if (sub == 0 || !chainwg) pg8::gemm_phase<pg8::EpiIn, pg8::OrderIn, true, true>(F.lds, g, S, E);
            if (sub == 0) {
                cg::this_grid().sync(); STAMP(2);
                if (chainwg)
#if defined(DOUBLE_HGRN)
                for (int rep_ = 0; rep_ < 2; ++rep_)
#endif
                { const int bb = bx >> 2; hgrn_chain(F, bb * TSEQ, bb * (TSEQ / 64), TSEQ / 64, bx & 3, nullptr, F.out + O_HP + (size_t)bx * 16384); }
            }
        }
        asm volatile("s_waitcnt vmcnt(0)" ::: "memory"); __syncthreads();
        if (F.tid == 0) { unsigned* sc = F.ctl + CW_SUB;
            if (!chainwg) { __threadfence(); __hip_atomic_fetch_add(sc, 1u, __ATOMIC_RELAXED, __HIP_MEMORY_SCOPE_AGENT); }
            while (__hip_atomic_load(sc, __ATOMIC_RELAXED, __HIP_MEMORY_SCOPE_AGENT) < (unsigned)NWORK) __builtin_amdgcn_s_sleep(8);
            __threadfence(); }
        __syncthreads();
        if (chainwg) { const int bb = bx >> 2; hgrn_chain(F, MP + 64 * bb, MP / 64 + bb, 1, bx & 3, F.sh + (size_t)bx * 16384, F.out + O_HS + (size_t)bx * 16384); __syncthreads(); }
    }
    if (IN(2)) {
#ifndef NO_ATTN
        float prune_thr;
        { float mq = fabsf(F.qg[F.lane]), mk = fabsf(F.kg[F.lane]);
#pragma unroll
          for (int o = 1; o < 64; o <<= 1) { mq = fmaxf(mq, __shfl_xor(mq, o)); mk = fmaxf(mk, __shfl_xor(mk, o)); }
          prune_thr = 2.f * (8.f * mq * mk * LOG2E) + 150.f; }
        for (;;) {
            if (F.tid == 0) F.MISC[0] = atomicAdd(F.ctl + CW_QUEUE, 1u);
            __syncthreads();
            const int i = (int)F.MISC[0];
            __syncthreads();
            if (i >= 2048 + 64) break;
            typedef attn_body::bf16 abf;
            const bool smp = i >= 2048; const int j = smp ? i - 2048 : i;
            const int bh = j & 63, qb = 31 - (j >> 6), b = bh >> 3, h = bh & 7;
            const int q0 = smp ? SSEQ - 256 : 256 * qb, NT = (q0 + 256) / 64; int NTE = NT;
            const size_t rb = (size_t)b * (smp ? SSEQ : TSEQ);
            const float* cgp = (const float*)(F.ws + (smp ? WS_CGS : WS_CGP)) + (size_t)bh * (smp ? SSEQ : TSEQ);
#if FOX_PRUNE
            { const bool need = F.tid < NT && (cgp[q0] - cgp[64 * F.tid + 63] >= -prune_thr); const int needed = __syncthreads_count(need ? 1 : 0);
              NTE = (needed + 1) & ~1; NTE = NTE < 4 ? 4 : (NTE > NT ? NT : NTE); }
#endif
            const size_t orow = smp ? (size_t)(MP + 64 * b) - (size_t)(PAST - q0) : rb + q0;
            attn_body::attn_unit<8>((const abf*)(F.ws + (smp ? WS_QS : WS_Q)) + (rb + q0) * 512 + 64 * h, (const abf*)(F.ws + (smp ? WS_KS : WS_K)) + rb * 512 + 64 * h, (const abf*)(F.ws + (smp ? WS_VS : WS_V)) + rb * 512 + 64 * h,
                                    (abf*)MIX + orow * DMOD + 512 + 64 * h, NT, NTE, cgp, q0, smp ? (PAST - q0) / 32 : 0, smp ? (PAST - q0) / 32 + 1 : 8, (char*)lds);
        }
#endif
    }
    SEAM(2); STAMP(3);
    if (IN(3)) {
        pg8::Gemm g{MIX, (const bf16*)(F.ws + WS_WO), MTOT, DMOD, DMOD, DMOD}; pg8::StaticOrder S; S.init(MTOT, DMOD, F.G, (int)blockIdx.x);
        pg8::EpiWo E{F.xp, F.xs, F.out + O_YP, F.out + O_YS, X1B, (float*)(F.ws + WS_SSQ)};
#ifndef P3_STAGGER
#define P3_STAGGER 0
#endif
        if (P3_STAGGER) {
            const unsigned long long t0 = __builtin_amdgcn_s_memrealtime(), wait = (unsigned long long)(blockIdx.x & 15) * P3_STAGGER;
            while (__builtin_amdgcn_s_memrealtime() - t0 < wait) __builtin_amdgcn_s_sleep(4);
        }
        pg8::gemm_phase<pg8::EpiWo, pg8::StaticOrder, true, true>(F.lds, g, S, E);
#if defined(DOUBLE_P3)
        cg::this_grid().sync();
        pg8::gemm_phase<pg8::EpiWo, pg8::StaticOrder, true, true>(F.lds, g, S, E);
#endif
    }
    SEAM(3); STAMP(4);
    if (IN(4)) {
        pg8::Gemm g{X1B, (const bf16*)(F.ws + WS_WUP), MTOT, FF, DMOD, DMOD}; pg8::StaticOrder S; S.init(MTOT, FF, F.G, (int)blockIdx.x);
        pg8::EpiUp E{HB, (const float*)(F.ws + WS_SSQ)};
        pg8::gemm_phase<pg8::EpiUp, pg8::StaticOrder, true, true>(F.lds, g, S, E);
#if defined(DOUBLE_P4)
        cg::this_grid().sync();
        pg8::gemm_phase<pg8::EpiUp, pg8::StaticOrder, true, true>(F.lds, g, S, E);
#endif
    }
    SEAM(4); STAMP(5);
    if (IN(5)) {
#pragma nounroll
        for (int pass = 0; pass < 2; ++pass) {
            pg8::Gemm g{HB, (const bf16*)(F.ws + WS_WDN), MTOT, DMOD, pass ? FF : FF / pg8::OrderDown::KSPLIT, FF};
            pg8::OrderDown S; S.mode = pass; S.so.init(MP, DMOD, F.G, (int)blockIdx.x);
            pg8::EpiDown E{F.out + O_YP, F.out + O_YS, pass ? 0 : 1};
            pg8::gemm_phase<pg8::EpiDown, pg8::OrderDown, true, true>(F.lds, g, S, E);
        }
    }
    STAMP(6);
#if defined(PROBE_A)
    cg::this_grid().sync();
    if (stamper_) {
        unsigned long long da = ts_[PROBE_A + 1] - ts_[PROBE_A], db = ts_[PROBE_B + 1] - ts_[PROBE_B];
        unsigned qa = (unsigned)((da + 1250) / 2500), qb = (unsigned)((db + 1250) / 2500); if (qa > 63) qa = 63; if (qb > 63) qb = 63;
#if defined(PROBE_CAL)
        qa = 1000; qb = 0;
#endif
        const unsigned long long t0 = __builtin_amdgcn_s_memrealtime(), wait = 2000ull * (qa + 64 * qb);
        while (__builtin_amdgcn_s_memrealtime() - t0 < wait) __builtin_amdgcn_s_sleep(16);
    }
#endif
#undef IN
#undef SEAM
}

extern "C" void kernel_launch(void* const* d_in, const int* in_sizes, int n_in, void* d_out, int out_size, void* d_ws, size_t ws_size, hipStream_t stream) {
    static int grid = 0;
    if (grid == 0) {
        if (n_in != 17 || (size_t)out_size != O_END || ws_size < WS_END) { fprintf(stderr, "kernel_launch: unexpected shapes (n_in %d out %d ws %zu)\n", n_in, out_size, ws_size); grid = -1; return; }
        int dev = 0, cus = 0, per_cu = 0;
        if (hipGetDevice(&dev) != hipSuccess || hipDeviceGetAttribute(&cus, hipDeviceAttributeMultiprocessorCount, dev) != hipSuccess) { grid = -1; return; }
        if (hipFuncSetAttribute((const void*)skel_fwd, hipFuncAttributeMaxDynamicSharedMemorySize, LDS_BYTES) != hipSuccess) { fprintf(stderr, "kernel_launch: hipFuncSetAttribute failed\n"); grid = -1; return; }
        if (hipOccupancyMaxActiveBlocksPerMultiprocessor(&per_cu, (const void*)skel_fwd, NTHR, LDS_BYTES) != hipSuccess || per_cu < 1) { fprintf(stderr, "kernel_launch: occupancy query says %d\n", per_cu); per_cu = 1; }
        (void)hipGetLastError();
        grid = cus;
    }
    if (grid < 0) return;
    if (hipMemsetAsync((char*)d_ws + WS_CTL, 0, CTL_ZERO_BYTES, stream) != hipSuccess) { fprintf(stderr, "kernel_launch: memset failed\n"); return; }
    Args a{};
    for (int i = 0; i < 17; ++i) a.in[i] = (const float*)d_in[i];
    a.out = (float*)d_out; a.ws = (unsigned char*)d_ws;
#if MK_N_LAUNCHES == 1
    a.ph_lo = 0; a.ph_hi = 6;
    void* kargs[] = {&a};
    hipError_t e = hipLaunchCooperativeKernel((const void*)skel_fwd, dim3(grid), dim3(NTHR), kargs, LDS_BYTES, stream);
    if (e != hipSuccess) fprintf(stderr, "kernel_launch: cooperative launch failed: %s (grid %d)\n", hipGetErrorString(e), grid);
#else
    for (int li = 0; li < 6; ++li) { a.ph_lo = li; a.ph_hi = li + 1; hipLaunchKernelGGL(skel_fwd, dim3(grid), dim3(NTHR), LDS_BYTES, stream, a); }
#endif
}
```

```cpp
#include <hip/hip_runtime.h>
#include <cstdio>
#include <cstdint>
namespace pg8 {
#define PG8_LAS __attribute__((address_space(3)))
typedef unsigned short bf16_t;
typedef short bf16x8 __attribute__((ext_vector_type(8)));
typedef float f32x4 __attribute__((ext_vector_type(4)));
typedef unsigned u32x4 __attribute__((ext_vector_type(4)));
constexpr int BM = 256, BK = 64, HALF = 128, HTB = HALF * BK * 2  , STAGE_BYTES = 8 * HTB, NXCD = 8, WGM = 8;

__host__ __device__ __forceinline__ int lds_byte(int r, int c) { const int st = (r >> 4) * 2 + (c >> 5), rr = r & 15, cc = c & 31, ob = rr * 64 + cc * 2; return st * 1024 + (ob ^ (((ob >> 9) & 1) << 5)); }
__host__ __device__ __forceinline__ void stage_rc(int b, int& R, int& C) { const int st = b / 1024, sb = b % 1024, swz = sb ^ (((sb >> 9) & 1) << 5); R = (st >> 1) * 16 + swz / 64; C = (st & 1) * 32 + (swz % 64) / 2; }
__host__ __device__ __forceinline__ int perm32(int rho) { const int n = rho >> 4, i = rho & 15; return 8 * (i >> 2) + 4 * n + (i & 3); }

struct Unit { int pm, pn, kofs; };
struct Gemm { const bf16_t* A; const bf16_t* Bt; int M, N, K, ld; };

struct StaticOrder {
    int nM, nN, nwg, G, c;
    __host__ __device__ void init(int M, int N, int G_, int c_) { nM = M / BM; nN = N / BM; nwg = nM * nN; G = G_; c = c_; }
    __host__ __device__ bool next(int i, Unit& u) const {
        const long L = (long)i * G + c; if (L >= nwg) return false;
        int wgid = (int)L; { const int q = nwg / NXCD, r = nwg % NXCD, xcd = wgid % NXCD, off = wgid / NXCD; wgid = (xcd < r ? xcd * (q + 1) : r * (q + 1) + (xcd - r) * q) + off; }
        const int nig = WGM * nN, gid = wgid / nig, fm = gid * WGM, gsz = (nM - fm) < WGM ? (nM - fm) : WGM;
        u.pm = fm + ((wgid % nig) % gsz); u.pn = (wgid % nig) / gsz; u.kofs = 0; return true;
    }
    __device__ __forceinline__ void a_ready(const Unit&) const {}
    __device__ __forceinline__ void done(const Unit&) const {}
};

__device__ __forceinline__ unsigned cvt_pk_bf16(float lo, float hi) { unsigned r; asm volatile("v_cvt_pk_bf16_f32 %0, %1, %2" : "=v"(r) : "v"(lo), "v"(hi)); return r; }
typedef float f32x2 __attribute__((ext_vector_type(2)));
template <class Epi, class Sched, bool ALIGN_EPI = false, bool SP2 = false>
__device__ __forceinline__ void gemm_phase(PG8_LAS unsigned char* lds, const Gemm g, const Sched& S, const Epi& E) {
    const int tid = threadIdx.x, wid = __builtin_amdgcn_readfirstlane(tid >> 6), lane = tid & 63, wr = wid >> 2, wc = wid & 3, fr = lane & 15, fq = lane >> 4;
    const int K = g.ld, nt = g.K / BK;
    unsigned voffA[2], voffB[2];
#pragma unroll
    for (int i = 0; i < 2; ++i) { int R, C; stage_rc(tid * 16 + i * 8192, R, C); const int Rb = Epi::PERM ? ((R & ~31) + perm32(R & 31)) : R;
        voffA[i] = (unsigned)(R * K + C) * 2u; voffB[i] = (unsigned)(Rb * K + C) * 2u; }
    const size_t kstep = (size_t)(BK * 2);
    const size_t hstep = (size_t)HALF * K * 2;
    const size_t tstep = 2 * hstep;
    const unsigned ldsw = (unsigned)wid * 1024u;
    const int aoff = lds_byte(wr * 64 + fr, fq * 8), boff = lds_byte(wc * 32 + fr, fq * 8);
#define PG8_SA(b, h) (((b) * 2 + (h)) * HTB)
#define PG8_SB(b, h) ((4 + (b) * 2 + (h)) * HTB)
#define PG8_STAGE(bufoff, gbase, voff) do { _Pragma("unroll") for (int _i = 0; _i < 2; ++_i) \
        __builtin_amdgcn_global_load_lds((const unsigned*)((const char*)(gbase) + (voff)[_i]), (PG8_LAS unsigned*)(lds + (bufoff) + ldsw + _i * 8192), 16, 0, 0); } while (0)
#define PG8_LDA(dst, b, h) do { _Pragma("unroll") for (int m = 0; m < 4; ++m) _Pragma("unroll") for (int k = 0; k < 2; ++k) dst[m][k] = *(const PG8_LAS bf16x8*)(lds + PG8_SA(b, h) + aoff + m * 2048 + k * 1024); } while (0)
#define PG8_LDB(dst, b, h) do { _Pragma("unroll") for (int n = 0; n < 2; ++n) _Pragma("unroll") for (int k = 0; k < 2; ++k) dst[n][k] = *(const PG8_LAS bf16x8*)(lds + PG8_SB(b, h) + boff + n * 2048 + k * 1024); } while (0)
#define PG8_MMA(ai, bj, At, Bt) do { __builtin_amdgcn_s_setprio(1); _Pragma("unroll") for (int m = 0; m < 4; ++m) _Pragma("unroll") for (int n = 0; n < 2; ++n) _Pragma("unroll") for (int k = 0; k < 2; ++k) \
        acc[ai][bj][m][n] = __builtin_amdgcn_mfma_f32_16x16x32_bf16(Bt[n][k], At[m][k], acc[ai][bj][m][n], 0, 0, 0); __builtin_amdgcn_s_setprio(0); } while (0)
#define PG8_WAIT_V(n) asm volatile("s_waitcnt vmcnt(" #n ")" ::: "memory")
#define PG8_WAIT_L(n) asm volatile("s_waitcnt lgkmcnt(" #n ")" ::: "memory")
#define PG8_BAR __builtin_amdgcn_s_barrier()
#define PG8_SCHED __builtin_amdgcn_sched_barrier(0)
    Unit cur, nxt; int ui = 0;
    if (!S.next(0, cur)) return;
    f32x4 acc[2][2][4][2];
#pragma unroll
    for (int a = 0; a < 2; ++a)
#pragma unroll
        for (int b = 0; b < 2; ++b)
#pragma unroll
            for (int m = 0; m < 4; ++m)
#pragma unroll
                for (int n = 0; n < 2; ++n) acc[a][b][m][n] = (f32x4){0.f, 0.f, 0.f, 0.f};
    bf16x8 At[4][2], B0[2][2], B1[2][2];
    const char* cA = (const char*)g.A + (size_t)cur.pm * tstep + (size_t)cur.kofs * 2; const char* cB = (const char*)g.Bt + (size_t)cur.pn * tstep + (size_t)cur.kofs * 2;
    S.a_ready(cur);
    if constexpr (SP2) {
        PG8_STAGE(PG8_SB(0, 0), cB, voffB); PG8_STAGE(PG8_SB(0, 1), cB + hstep, voffB); PG8_STAGE(PG8_SA(0, 0), cA, voffA); PG8_STAGE(PG8_SA(0, 1), cA + hstep, voffA);
        if (wr == 1) PG8_BAR;
        PG8_WAIT_V(2); PG8_BAR;
        PG8_STAGE(PG8_SB(1, 0), cB + kstep, voffB); PG8_STAGE(PG8_SA(1, 0), cA + kstep, voffA); PG8_STAGE(PG8_SB(1, 1), cB + hstep + kstep, voffB);
        PG8_WAIT_V(6); PG8_BAR;
    } else {
        PG8_STAGE(PG8_SB(0, 0), cB, voffB); PG8_STAGE(PG8_SA(0, 0), cA, voffA); PG8_STAGE(PG8_SB(0, 1), cB + hstep, voffB); PG8_STAGE(PG8_SA(0, 1), cA + hstep, voffA);
        if (wr == 1) PG8_BAR;
        PG8_WAIT_V(4); PG8_BAR;
        PG8_STAGE(PG8_SB(1, 0), cB + kstep, voffB); PG8_STAGE(PG8_SA(1, 0), cA + kstep, voffA); PG8_STAGE(PG8_SB(1, 1), cB + hstep + kstep, voffB);
        PG8_WAIT_V(6); PG8_BAR;
    }
    for (;;) {
        const bool has_next = S.next(ui + 1, nxt);
        const char* nA = has_next ? (const char*)g.A + (size_t)nxt.pm * tstep + (size_t)nxt.kofs * 2 : cA; const char* nB = has_next ? (const char*)g.Bt + (size_t)nxt.pn * tstep + (size_t)nxt.kofs * 2 : cB;
        for (int t = 0; t < nt; t += 2) {
            const bool last = (t == nt - 2);
            const char* a1 = cA + (size_t)(t + 1) * kstep;
            const char* a2 = last ? nA : cA + (size_t)(t + 2) * kstep; const char* b2 = last ? nB : cB + (size_t)(t + 2) * kstep;
            const char* a3 = a2 + kstep; const char* b3 = b2 + kstep;
            if (last && has_next) S.a_ready(nxt);
            if constexpr (SP2) {
            PG8_LDB(B0, 0, 0); PG8_LDB(B1, 0, 1); PG8_SCHED; PG8_LDA(At, 0, 0); PG8_STAGE(PG8_SA(1, 1), a1 + hstep, voffA);
            PG8_WAIT_V(8); PG8_WAIT_L(0); PG8_BAR; PG8_MMA(0, 0, At, B0); PG8_MMA(0, 1, At, B1); PG8_BAR; PG8_SCHED;
            PG8_LDA(At, 0, 1); PG8_STAGE(PG8_SB(0, 0), b2, voffB); PG8_STAGE(PG8_SB(0, 1), b2 + hstep, voffB); PG8_STAGE(PG8_SA(0, 0), a2, voffA);
            PG8_WAIT_V(8); PG8_WAIT_L(0); PG8_BAR; PG8_MMA(1, 0, At, B0); PG8_MMA(1, 1, At, B1); PG8_BAR; PG8_SCHED;
            PG8_LDB(B0, 1, 0); PG8_LDB(B1, 1, 1); PG8_SCHED; PG8_LDA(At, 1, 0); PG8_STAGE(PG8_SA(0, 1), a2 + hstep, voffA);
            PG8_WAIT_V(8); PG8_WAIT_L(0); PG8_BAR; PG8_MMA(0, 0, At, B0); PG8_MMA(0, 1, At, B1); PG8_BAR; PG8_SCHED;
            PG8_LDA(At, 1, 1); PG8_STAGE(PG8_SB(1, 0), b3, voffB); PG8_STAGE(PG8_SB(1, 1), b3 + hstep, voffB); PG8_STAGE(PG8_SA(1, 0), a3, voffA);
            PG8_WAIT_V(8); PG8_WAIT_L(0); PG8_BAR; PG8_MMA(1, 0, At, B0); PG8_MMA(1, 1, At, B1); PG8_BAR; PG8_SCHED;
            } else {
            PG8_LDB(B0, 0, 0); PG8_SCHED; PG8_LDA(At, 0, 0); PG8_STAGE(PG8_SA(1, 1), a1 + hstep, voffA);
            PG8_WAIT_L(8); PG8_BAR; PG8_WAIT_L(0); PG8_MMA(0, 0, At, B0); PG8_BAR; PG8_SCHED;
            PG8_LDB(B1, 0, 1); PG8_STAGE(PG8_SB(0, 0), b2, voffB);
            PG8_BAR; PG8_WAIT_L(0); PG8_MMA(0, 1, At, B1); PG8_BAR;
            PG8_LDA(At, 0, 1); PG8_STAGE(PG8_SA(0, 0), a2, voffA);
            PG8_BAR; PG8_WAIT_L(0); PG8_MMA(1, 0, At, B0); PG8_BAR; PG8_SCHED;
            PG8_STAGE(PG8_SB(0, 1), b2 + hstep, voffB);
            PG8_WAIT_V(6); PG8_BAR; PG8_MMA(1, 1, At, B1); PG8_BAR;
            PG8_LDB(B0, 1, 0); PG8_SCHED; PG8_LDA(At, 1, 0); PG8_STAGE(PG8_SA(0, 1), a2 + hstep, voffA);
            PG8_WAIT_L(8); PG8_BAR; PG8_WAIT_L(0); PG8_MMA(0, 0, At, B0); PG8_BAR; PG8_SCHED;
            PG8_LDB(B1, 1, 1); PG8_STAGE(PG8_SB(1, 0), b3, voffB);
            PG8_BAR; PG8_WAIT_L(0); PG8_MMA(0, 1, At, B1); PG8_BAR;
            PG8_LDA(At, 1, 1); PG8_STAGE(PG8_SA(1, 0), a3, voffA);
            PG8_BAR; PG8_WAIT_L(0); PG8_MMA(1, 0, At, B0); PG8_BAR; PG8_SCHED;
            PG8_STAGE(PG8_SB(1, 1), b3 + hstep, voffB);
            PG8_WAIT_V(6); PG8_BAR; PG8_MMA(1, 1, At, B1); PG8_BAR;
            }
        }
        if constexpr (ALIGN_EPI) { if (wr == 0) PG8_BAR; }
        if constexpr (!Epi::AFTER_DRAIN) { E(acc, cur, wr, wc, fr, fq); S.done(cur); }
        if (!has_next) break;
#pragma unroll
        for (int a = 0; a < 2; ++a)
#pragma unroll
            for (int b = 0; b < 2; ++b)
#pragma unroll
                for (int m = 0; m < 4; ++m)
#pragma unroll
                    for (int n = 0; n < 2; ++n) acc[a][b][m][n] = (f32x4){0.f, 0.f, 0.f, 0.f};
        cur = nxt; cA = nA; cB = nB; ++ui;
        if constexpr (ALIGN_EPI) { if (wr == 1) PG8_BAR; }
    }
    PG8_WAIT_V(0);
    if constexpr (!ALIGN_EPI) { if (wr == 0) PG8_BAR; }
    PG8_BAR;
    if constexpr (Epi::AFTER_DRAIN) { E.fused(acc, cur, wr, wc, fr, fq, lds, wid, lane); S.done(cur); }
#undef PG8_SA
#undef PG8_SB
#undef PG8_STAGE
#undef PG8_LDA
#undef PG8_LDB
#undef PG8_MMA
#undef PG8_WAIT_V
#undef PG8_WAIT_L
#undef PG8_BAR
#undef PG8_SCHED
}
}
#include <hip/hip_bf16.h>
#include <cmath>
namespace attn_body {
using bf16=__hip_bfloat16;
using bf16x8=__attribute__((ext_vector_type(8)))short;
using s16x4=__attribute__((ext_vector_type(4)))short;
using f32x16=__attribute__((ext_vector_type(16)))float;
using u32x4=__attribute__((ext_vector_type(4)))unsigned;
constexpr int NHEAD=8,D=64,DM=NHEAD*D,OPITCH=1024;
constexpr int NW=8,QBLK=32,QB=QBLK*NW,KVBLK=64;
constexpr int ATTN_PITCH=DM, ATTN_UNIT_ROWS=QB;
__device__ __forceinline__ int crow(int r,int hi){return (r&3)+8*(r>>2)+4*hi;}
#define SBAR() __builtin_amdgcn_sched_barrier(0)
__device__ __forceinline__ void cmask(f32x16&p0,f32x16&p1,int jb,int qrel,int hi){
  const float NEG=-INFINITY; int kb=64*jb+4*hi;
  #pragma unroll
  for(int r=0;r<16;++r){int kv=kb+(r&3)+8*(r>>2); if(kv>qrel)p0[r]=NEG; if(kv+32>qrel)p1[r]=NEG;}
}

constexpr int NSLOT=3, SLOTB=8192;
constexpr int LDS_K=0, LDS_V=NSLOT*SLOTB, LDS_WS=2*NSLOT*SLOTB, LDS_OST=LDS_WS+NW*64*4, LDS_CB=LDS_OST+NW*4096, LDS_BYTES=LDS_CB+32768;
constexpr float C2=0.125f*1.4426950408889634f;
__device__ __forceinline__ void glds16(const void*gsrc,unsigned lds_dst){unsigned keep;
  asm volatile("s_mov_b32 %0, m0\n\ts_mov_b32 m0, %2\n\ts_nop 0\n\tglobal_load_lds_dwordx4 %1, off\n\ts_mov_b32 m0, %0":"=&s"(keep):"v"(gsrc),"s"(lds_dst):"memory");}
__device__ __forceinline__ float max3f(float a,float b,float c){float r;asm("v_max3_f32 %0, %1, %2, %3":"=v"(r):"v"(a),"v"(b),"v"(c));return r;}
__device__ __forceinline__ float max2f(float a,float b){float r;asm("v_max_f32_e32 %0, %1, %2":"=v"(r):"v"(a),"v"(b));return r;}
__device__ __forceinline__ float fadd_s(float a,float b){float r;asm("v_add_f32_e32 %0, %1, %2":"=v"(r):"v"(a),"v"(b));return r;}
__device__ __forceinline__ float fsub_s(float a,float b){float r;asm("v_sub_f32_e32 %0, %1, %2":"=v"(r):"v"(a),"v"(b));return r;}
typedef float f32x2_t __attribute__((ext_vector_type(2))); typedef float f32x4_t __attribute__((ext_vector_type(4))); typedef __bf16 bf16x2_t __attribute__((ext_vector_type(2)));
__device__ __forceinline__ unsigned cvtpk_s(float lo,float hi){f32x2_t v={lo,hi};bf16x2_t b=__builtin_convertvector(v,bf16x2_t);return __builtin_bit_cast(unsigned,b);}
#define WAIT_BAR(N) asm volatile("s_waitcnt vmcnt(" #N ") lgkmcnt(0)\n\ts_barrier":::"memory")

__device__ __forceinline__ void qkt(f32x16&p0,f32x16&p1,const char*Kslot,const bf16x8*qr,int r32,int hi){
  const char*kb=Kslot+hi*1024+r32*16;
  #pragma unroll
  for(int d0=0;d0<4;++d0){
    const bf16x8 b0=*reinterpret_cast<const bf16x8*>(kb+d0*2048);
    const bf16x8 b1=*reinterpret_cast<const bf16x8*>(kb+d0*2048+512);
    p0=__builtin_amdgcn_mfma_f32_32x32x16_bf16(b0,qr[d0],p0,0,0,0);p1=__builtin_amdgcn_mfma_f32_32x32x16_bf16(b1,qr[d0],p1,0,0,0);}
}
typedef __attribute__((address_space(3))) const char* lds_cptr;
typedef short v4i16_t __attribute__((ext_vector_type(4)));
__device__ __forceinline__ void kload8(bf16x8*kf,lds_cptr kp){
  kf[0]=*(const __attribute__((address_space(3))) bf16x8*)(kp);      kf[1]=*(const __attribute__((address_space(3))) bf16x8*)(kp+512);
  kf[2]=*(const __attribute__((address_space(3))) bf16x8*)(kp+2048); kf[3]=*(const __attribute__((address_space(3))) bf16x8*)(kp+2560);
  kf[4]=*(const __attribute__((address_space(3))) bf16x8*)(kp+4096); kf[5]=*(const __attribute__((address_space(3))) bf16x8*)(kp+4608);
  kf[6]=*(const __attribute__((address_space(3))) bf16x8*)(kp+6144); kf[7]=*(const __attribute__((address_space(3))) bf16x8*)(kp+6656);
}
__device__ __forceinline__ void kload2(bf16x8*kf,lds_cptr kp,int j){ kf[2*j]=*(const __attribute__((address_space(3))) bf16x8*)(kp+j*2048); kf[2*j+1]=*(const __attribute__((address_space(3))) bf16x8*)(kp+j*2048+512); }
__device__ __forceinline__ s16x4 vtr(lds_cptr p){ return __builtin_bit_cast(s16x4,__builtin_amdgcn_ds_read_tr16_b64_v4i16((__attribute__((address_space(3))) v4i16_t*)p)); }
__device__ __forceinline__ float rowmax(const f32x16&p0,const f32x16&p1){
  float a=max3f(p0[0],p0[1],p1[0]),b=max3f(p0[2],p0[3],p1[1]);a=max3f(a,p1[2],p1[3]);
  #pragma unroll
  for(int r=4;r<16;r+=4){a=max3f(a,p0[r],p0[r+1]);b=max3f(b,p0[r+2],p0[r+3]);a=max3f(a,p1[r],p1[r+1]);b=max3f(b,p1[r+2],p1[r+3]);}
  const float m=max2f(a,b);
  auto rr=__builtin_amdgcn_permlane32_swap(__float_as_uint(m),__float_as_uint(m),false,false);
  return max2f(__uint_as_float(rr[0]),__uint_as_float(rr[1]));
}
__device__ __forceinline__ void pv(f32x16*o,int vb,bf16x8 pa0,bf16x8 pa1,bf16x8 pa2,bf16x8 pa3){
  #pragma unroll
  for(int d0=0;d0<2;++d0){s16x4 lo[4],hi[4];
    #pragma unroll
    for(int ks=0;ks<4;++ks){
      asm volatile("ds_read_b64_tr_b16 %0,%1 offset:%c2":"=&v"(lo[ks]):"v"(vb),"i"(d0*4096+ks*1024):"memory");
      asm volatile("ds_read_b64_tr_b16 %0,%1 offset:%c2":"=&v"(hi[ks]):"v"(vb),"i"(d0*4096+ks*1024+512):"memory");}
    asm volatile("s_waitcnt lgkmcnt(0)":::"memory");SBAR();
    #define PK(k) (bf16x8){lo[k][0],lo[k][1],lo[k][2],lo[k][3],hi[k][0],hi[k][1],hi[k][2],hi[k][3]}
    o[d0]=__builtin_amdgcn_mfma_f32_32x32x16_bf16(pa0,PK(0),o[d0],0,0,0);
    o[d0]=__builtin_amdgcn_mfma_f32_32x32x16_bf16(pa1,PK(1),o[d0],0,0,0);
    o[d0]=__builtin_amdgcn_mfma_f32_32x32x16_bf16(pa2,PK(2),o[d0],0,0,0);
    o[d0]=__builtin_amdgcn_mfma_f32_32x32x16_bf16(pa3,PK(3),o[d0],0,0,0);
    #undef PK
  }
}

#ifndef ATTN_STORE16
#define ATTN_STORE16(p,v) (*(u32x4*)(p)=(v))
#endif
template<int THRL> __device__ __forceinline__ void attn_unit(const bf16*Qb,const bf16*__restrict__ Kh,const bf16*__restrict__ Vh,bf16*Ob,int NT,int NTE,const float*cgp,int q0,int wlo,int whi,char*shm){
  int tid_=threadIdx.x; asm volatile("":"+v"(tid_)); const int tid=tid_,lane=tid&63,r32=lane&31,hi=lane>>5; const int wid=__builtin_amdgcn_readfirstlane(tid>>6);
  const bf16*Qw=Qb+(long)(wid*QBLK)*DM;
  const unsigned lds0=(unsigned)(uintptr_t)shm;
  float*wsf=(float*)(shm+LDS_WS)+wid*64;
  const bf16*ksrc=Kh+(long)((NT-1)*KVBLK+lane)*DM+wid*8;
  const bf16*vsrc=Vh+(long)((NT-1)*KVBLK+16*(wid&3)+(lane>>2))*DM+(wid>>2)*32+(lane&3)*8;
  const unsigned kdst=lds0+LDS_K+wid*1024, vdst=lds0+LDS_V+wid*1024;
  #define DMA_K(t,slot) glds16(ksrc-(long)(t)*KVBLK*DM,(unsigned)__builtin_amdgcn_readfirstlane(kdst+(slot)))
  #define DMA_V(t,slot) glds16(vsrc-(long)(t)*KVBLK*DM,(unsigned)__builtin_amdgcn_readfirstlane(vdst+(slot)))
  const int vb0=(int)(lds0+LDS_V)+((lane>>4)&1)*32+(lane&3)*8+(4*hi+((lane&15)>>2))*64;
  const char*Kbase=shm+LDS_K; bf16x8 kf[8];
  const lds_cptr shm3=(lds_cptr)shm; const lds_cptr kp0=shm3+LDS_K+hi*1024+r32*16; const lds_cptr vp0=shm3+LDS_V+((lane>>4)&1)*32+(lane&3)*8+(4*hi+((lane&15)>>2))*64;
  { typedef __attribute__((address_space(3))) float lf_t; lf_t* cbw=(lf_t*)((lds_cptr)shm+LDS_CB); const float c0=cgp[q0]; const int jlo=(NT-NTE)*KVBLK, jhi=NT*KVBLK;
    for(int j=jlo+tid;j<jhi;j+=NW*64) cbw[j]=c0-cgp[j]; }
  const __attribute__((address_space(3))) float* cbL=(const __attribute__((address_space(3))) float*)((lds_cptr)shm+LDS_CB)+4*hi;
  #define CBLOAD(C0,C1,t,MH) do{ const __attribute__((address_space(3))) float* cbp_=cbL+(NT-1-(t))*KVBLK; \
    _Pragma("unroll") for(int g_=0;g_<4;++g_){ const f32x4_t v0_=*(const __attribute__((address_space(3))) f32x4_t*)(cbp_+8*g_); const f32x4_t v1_=*(const __attribute__((address_space(3))) f32x4_t*)(cbp_+32+8*g_); \
      C0[4*g_]=v0_[0]-(MH);C0[4*g_+1]=v0_[1]-(MH);C0[4*g_+2]=v0_[2]-(MH);C0[4*g_+3]=v0_[3]-(MH); C1[4*g_]=v1_[0]-(MH);C1[4*g_+1]=v1_[1]-(MH);C1[4*g_+2]=v1_[2]-(MH);C1[4*g_+3]=v1_[3]-(MH);} }while(0)
  DMA_K(0,0);DMA_V(0,0);DMA_K(1,SLOTB);
  bf16x8 qr[4];
  #pragma unroll
  for(int d0=0;d0<4;++d0)qr[d0]=*reinterpret_cast<const bf16x8*>(&Qw[(long)r32*DM+d0*16+hi*8]);
  float mhat=0.f,l_reg=0.f;f32x16 o[2];o[0]=f32x16{};o[1]=f32x16{};
  const int qrel=wid*QBLK+r32;
  #define CMASK(P0,P1,t) do{int jb_=3-(t); if(jb_>=0)cmask(P0,P1,jb_,qrel,hi);}while(0)
  bool resc=false;
  #define START(P0,P1) do{ const float rm=rowmax(P0,P1); resc=false; \
    { const float dl=(rm>-1e30f)?rm:0.f; mhat=fadd_s(mhat,dl); \
      _Pragma("unroll") for(int r=0;r<16;++r){P0[r]=fsub_s(P0[r],dl);P1[r]=fsub_s(P1[r],dl);} } \
    _Pragma("unroll") for(int r=0;r<16;++r)P0[r]=__builtin_amdgcn_exp2f(P0[r]); }while(0)
  #define RESC() do{ if(resc){ asm volatile("s_waitcnt lgkmcnt(0)":::"memory"); \
      _Pragma("unroll") for(int d_=0;d_<2;++d_) _Pragma("unroll") for(int r=0;r<16;++r)o[d_][r]*=wsf[crow(r,hi)]; } }while(0)
  f32x16 pA0,pA1,pB0,pB1;
  int sl_prev=0,sl_cur=0,sl_next=SLOTB;
  #define ROT() do{sl_prev=sl_cur;sl_cur=sl_next;sl_next=(sl_next==(NSLOT-1)*SLOTB)?0:sl_next+SLOTB;}while(0)
  DMA_K(2,2*SLOTB);
  WAIT_BAR(3);
  CBLOAD(pA0,pA1,0,0.f); qkt(pA0,pA1,Kbase,qr,r32,hi);asm volatile("s_nop 15\n\ts_nop 7":"+v"(pA0),"+v"(pA1));CMASK(pA0,pA1,0);
  START(pA0,pA1);
  _Pragma("unroll") for(int r=0;r<16;++r)pA1[r]=__builtin_amdgcn_exp2f(pA1[r]);
  WAIT_BAR(0);
  DMA_K(3,0);DMA_V(1,SLOTB);
  ROT();
  kload8(kf,kp0+sl_cur);
  WAIT_BAR(2);
  s16x4 vlo[8],vhi[8]; u32x4 pw0,pw1,pw2,pw3;
  #define PKW(P,B) cvtpk_s(P[B],P[B+1])
  #define PAF(k) __builtin_bit_cast(bf16x8,pw##k)
  #define VFR(i) (bf16x8){vlo[i][0],vlo[i][1],vlo[i][2],vlo[i][3],vhi[i][0],vhi[i][1],vhi[i][2],vhi[i][3]}
  #define PIN(x) asm volatile("":"+v"(x))
  #define MX3(a,b,c) __builtin_fmaxf(__builtin_fmaxf((a),(b)),(c))
  #define GAPA(MF,A0,A1,A2,A3,W0,W1,PW) do{ MF; sacc+=A0; sacc+=A1; sacc+=A2; sacc+=A3; PIN(sacc); W0; W1; PIN(PW); SBAR(); }while(0)
  #define EX(v) __builtin_amdgcn_exp2f(v)
  #define GAPB(MF,X,B) do{ MF; X[B]=EX(X[B]); X[B+1]=EX(X[B+1]); X[B+2]=EX(X[B+2]); X[B+3]=EX(X[B+3]); PIN(X); SBAR(); }while(0)
  #define VRD(i) do{ vlo[i]=vtr(vp_+(((i)>>2)*4096+((i)&3)*1024)); vhi[i]=vtr(vp_+(((i)>>2)*4096+((i)&3)*1024+512)); }while(0)
  #define KRD(G,j) do{ if(G){ kload2(kf,kp0+sl_next,j); SBAR(); } }while(0)
  #define STEP(C0,C1,P0,P1,t,GK,GV,GL) do{ SBAR(); \
    const lds_cptr vp_=vp0+sl_prev; CBLOAD(C0,C1,t,mhat); SBAR(); \
    VRD(0); SBAR(); float sacc=(P0[0]+P0[1]); \
    GAPA(C0=__builtin_amdgcn_mfma_f32_32x32x16_bf16(kf[0],qr[0],C0,0,0,0), P0[2],P0[3],P0[4],P0[5],     pw0[0]=PKW(P0,0), pw0[1]=PKW(P0,2), pw0); \
    VRD(4); SBAR(); GAPA(C1=__builtin_amdgcn_mfma_f32_32x32x16_bf16(kf[1],qr[0],C1,0,0,0), P0[6],P0[7],P0[8],P0[9],     pw0[2]=PKW(P0,4), pw0[3]=PKW(P0,6), pw0); \
    VRD(1); SBAR(); GAPA(C0=__builtin_amdgcn_mfma_f32_32x32x16_bf16(kf[2],qr[1],C0,0,0,0),   P0[10],P0[11],P0[12],P0[13], pw1[0]=PKW(P0,8), pw1[1]=PKW(P0,10), pw1); \
    VRD(5); SBAR(); GAPA(C1=__builtin_amdgcn_mfma_f32_32x32x16_bf16(kf[3],qr[1],C1,0,0,0),   P0[14],P0[15],P1[0],P1[1],   pw1[2]=PKW(P0,12),pw1[3]=PKW(P0,14), pw1); \
    VRD(2); SBAR(); GAPA(C0=__builtin_amdgcn_mfma_f32_32x32x16_bf16(kf[4],qr[2],C0,0,0,0),   P1[2],P1[3],P1[4],P1[5],     pw2[0]=PKW(P1,0), pw2[1]=PKW(P1,2), pw2); \
    VRD(6); SBAR(); GAPA(C1=__builtin_amdgcn_mfma_f32_32x32x16_bf16(kf[5],qr[2],C1,0,0,0),   P1[6],P1[7],P1[8],P1[9],     pw2[2]=PKW(P1,4), pw2[3]=PKW(P1,6), pw2); \
    VRD(3); SBAR(); GAPA(C0=__builtin_amdgcn_mfma_f32_32x32x16_bf16(kf[6],qr[3],C0,0,0,0),   P1[10],P1[11],P1[12],P1[13], pw3[0]=PKW(P1,8), pw3[1]=PKW(P1,10), pw3); \
    VRD(7); SBAR(); GAPA(C1=__builtin_amdgcn_mfma_f32_32x32x16_bf16(kf[7],qr[3],C1,0,0,0),   P1[14],P1[15],0.f,0.f,       pw3[2]=PKW(P1,12),pw3[3]=PKW(P1,14), pw3); \
    l_reg+=sacc; \
    if(GK){DMA_K((t)+3,sl_cur);} if(GV){DMA_V((t)+1,sl_next);} \
    CMASK(C0,C1,t); \
    { float a=MX3(C0[0],C0[1],C1[0]),b=MX3(C0[2],C0[3],C1[1]); a=MX3(a,C1[2],C1[3]); \
      _Pragma("unroll") for(int r=4;r<16;r+=4){a=MX3(a,C0[r],C0[r+1]);b=MX3(b,C0[r+2],C0[r+3]);a=MX3(a,C1[r],C1[r+1]);b=MX3(b,C1[r+2],C1[r+3]);} \
      float rm=__builtin_fmaxf(a,b); { auto rr=__builtin_amdgcn_permlane32_swap(__float_as_uint(rm),__float_as_uint(rm),false,false); rm=__builtin_fmaxf(__uint_as_float(rr[0]),__uint_as_float(rr[1])); } \
      resc=false; \
      if(__builtin_expect(__any(rm>(float)THRL),0)){ const float dl=__builtin_fmaxf(rm,0.f); mhat+=dl; \
        _Pragma("unroll") for(int r=0;r<16;++r){C0[r]-=dl;C1[r]-=dl;} \
        const float f=__builtin_amdgcn_exp2f(-dl); l_reg*=f; if(hi==0)wsf[r32]=f; resc=true; } } \
    SBAR(); \
    GAPB(o[0]=__builtin_amdgcn_mfma_f32_32x32x16_bf16(PAF(0),VFR(0),o[0],0,0,0), C0,0); \
    GAPB(o[1]=__builtin_amdgcn_mfma_f32_32x32x16_bf16(PAF(0),VFR(4),o[1],0,0,0), C0,4); \
    KRD(GL,0); GAPB(o[0]=__builtin_amdgcn_mfma_f32_32x32x16_bf16(PAF(1),VFR(1),o[0],0,0,0), C0,8); \
    KRD(GL,1); GAPB(o[1]=__builtin_amdgcn_mfma_f32_32x32x16_bf16(PAF(1),VFR(5),o[1],0,0,0), C0,12); \
    KRD(GL,2); GAPB(o[0]=__builtin_amdgcn_mfma_f32_32x32x16_bf16(PAF(2),VFR(2),o[0],0,0,0), C1,0); \
    KRD(GL,3); GAPB(o[1]=__builtin_amdgcn_mfma_f32_32x32x16_bf16(PAF(2),VFR(6),o[1],0,0,0), C1,4); \
    GAPB(o[0]=__builtin_amdgcn_mfma_f32_32x32x16_bf16(PAF(3),VFR(3),o[0],0,0,0), C1,8); \
    GAPB(o[1]=__builtin_amdgcn_mfma_f32_32x32x16_bf16(PAF(3),VFR(7),o[1],0,0,0), C1,12); \
    }while(0)
  int t=1;
  for(;t<5&&t+5<NTE;t+=2){
    STEP(pB0,pB1,pA0,pA1,t,true,true,true);     WAIT_BAR(2); RESC(); ROT();
    STEP(pA0,pA1,pB0,pB1,t+1,true,true,true);   WAIT_BAR(2); RESC(); ROT();
  }
  #undef CMASK
  #define CMASK(P0,P1,t) do{}while(0)
  for(;t+5<NTE;t+=2){
    STEP(pB0,pB1,pA0,pA1,t,true,true,true);     WAIT_BAR(2); RESC(); ROT();
    STEP(pA0,pA1,pB0,pB1,t+1,true,true,true);   WAIT_BAR(2); RESC(); ROT();
  }
  #undef CMASK
  #define CMASK(P0,P1,t) do{int jb_=3-(t); if(jb_>=0)cmask(P0,P1,jb_,qrel,hi);}while(0)
  #define ENDW(tt) do{ if((tt)+3<NTE){WAIT_BAR(2);} else if((tt)+2<NTE){WAIT_BAR(1);} else {WAIT_BAR(0);} }while(0)
  for(;t+1<NTE;t+=2){
    STEP(pB0,pB1,pA0,pA1,t,(t+3<NTE),(t+1<NTE),(t+1<NTE));       ENDW(t);   RESC(); ROT();
    STEP(pA0,pA1,pB0,pB1,t+1,(t+4<NTE),(t+2<NTE),(t+2<NTE));     ENDW(t+1); RESC(); ROT();
  }
  STEP(pB0,pB1,pA0,pA1,NTE-1,false,false,false); RESC();
  { float sacc=pB0[0]+pB0[1]; _Pragma("unroll") for(int r=2;r<16;++r)sacc+=pB0[r]; _Pragma("unroll") for(int r=0;r<16;++r)sacc+=pB1[r]; l_reg+=sacc;
    pw0=(u32x4){PKW(pB0,0),PKW(pB0,2),PKW(pB0,4),PKW(pB0,6)};pw1=(u32x4){PKW(pB0,8),PKW(pB0,10),PKW(pB0,12),PKW(pB0,14)};pw2=(u32x4){PKW(pB1,0),PKW(pB1,2),PKW(pB1,4),PKW(pB1,6)};pw3=(u32x4){PKW(pB1,8),PKW(pB1,10),PKW(pB1,12),PKW(pB1,14)};
    SBAR(); pv(o,vb0+sl_cur,PAF(0),PAF(1),PAF(2),PAF(3)); }
  #undef PKW
  #undef PAF
  #undef VFR
  #undef PIN
  #undef MX3
  #undef GAPA
  #undef GAPB
  #undef EX
  #undef VRD
  #undef KRD
  #undef STEP
  #undef ENDW
  {auto rr=__builtin_amdgcn_permlane32_swap(__float_as_uint(l_reg),__float_as_uint(l_reg),false,false);l_reg=__uint_as_float(rr[0])+__uint_as_float(rr[1]);}
  if(hi==0)wsf[32+r32]=l_reg;asm volatile("s_waitcnt lgkmcnt(0)":::"memory");
  float rli[16];
  #pragma unroll
  for(int r=0;r<16;++r)rli[r]=__builtin_amdgcn_rcpf(wsf[32+crow(r,hi)]);
  bf16*Ow=Ob+(long)(wid*QBLK)*OPITCH;
  { bf16*stg=(bf16*)(shm+LDS_OST)+wid*2048;
    #pragma unroll
    for(int r=0;r<16;++r){const int orow=crow(r,hi);
      #pragma unroll
      for(int d0=0;d0<2;++d0)stg[orow*64+d0*32+r32]=__float2bfloat16(o[d0][r]*rli[r]);}
    asm volatile("s_waitcnt lgkmcnt(0)":::"memory");
    #pragma unroll
    for(int i=0;i<4;++i){const int row=i*8+(lane>>3),ch=lane&7; const u32x4 v=*(const u32x4*)(stg+row*64+ch*8); if(wid>=wlo&&wid<whi)ATTN_STORE16(Ow+(long)row*OPITCH+ch*8,v);} }
  asm volatile("s_waitcnt lgkmcnt(0)\n\ts_barrier":::"memory");
  #undef DMA_K
  #undef DMA_V
  #undef CMASK
  #undef START
  #undef RESC
  #undef ROT
  #undef CBLOAD
}
constexpr int ATTN_LDS_BYTES=LDS_BYTES;
#undef SBAR
#undef WAIT_BAR
}
#include <hip/hip_cooperative_groups.h>
namespace cg = cooperative_groups;
#ifndef MK_N_LAUNCHES
#define MK_N_LAUNCHES 1
#endif
#ifndef FOX_PRUNE
#define FOX_PRUNE 1
#endif
constexpr int NWAVES = 8, NTHR = 512;
constexpr int DMOD = 1024, TSEQ = 8192, NBATCH = 8, MP = NBATCH * TSEQ, MS = 512, MTOT = MP + MS;
constexpr int NIN = 3584, INC = 3592, FF = 4096, SSEQ = 1152, PAST = 1024, DSEQ = 32;
constexpr int NCHUNK = MTOT / 64;
constexpr float EPSN = 1e-6f, LOG2E = 1.4426950408889634f;
constexpr size_t MiB = 1u << 20;
constexpr size_t WS_CTL = 0, CTL_ZERO_BYTES = 4096;
constexpr size_t WS_WIN = 2 * MiB, WS_WO = 9 * MiB, WS_WUP = 11 * MiB, WS_WDN = 19 * MiB;
constexpr size_t WS_RSTD = 27 * MiB, WS_CGP = 28 * MiB, WS_CGS = 30 * MiB, WS_VEC = 31 * MiB, WS_SSQ = 38 * MiB;
constexpr size_t WS_X1B = 44 * MiB, WS_MIX = 174 * MiB, WS_H = 304 * MiB;
constexpr size_t WS_XB = 304 * MiB, WS_Q = 434 * MiB, WS_K = 498 * MiB, WS_V = 562 * MiB, WS_QS = 626 * MiB, WS_KS = 635 * MiB, WS_VS = 644 * MiB;
constexpr size_t WS_QR = 654 * MiB, WS_KR = 719 * MiB, WS_VH = 784 * MiB, WS_SG = 849 * MiB, WS_END = 914 * MiB;
constexpr size_t VECN = (size_t)NCHUNK * 512;
static_assert(WS_VEC + 3 * VECN * 4 <= WS_SSQ && WS_SSQ + (size_t)MTOT * 16 * 4 <= WS_X1B && WS_X1B + (size_t)MTOT * DMOD * 2 <= WS_MIX && WS_MIX + (size_t)MTOT * DMOD * 2 <= WS_H, "ws map");
static_assert(WS_H + (size_t)MTOT * FF * 2 <= WS_END && WS_XB + (size_t)MTOT * DMOD * 2 <= WS_Q && WS_SG + (size_t)MTOT * 512 * 2 <= WS_END, "ws map 2");
constexpr int CW_QUEUE = 64, CW_SUB = 128, NCHAINWG = 32;
constexpr size_t O_YP = 0, O_YS = O_YP + (size_t)MP * DMOD, O_KP = O_YS + (size_t)256 * DMOD, O_VP = O_KP + (size_t)MP * 512, O_LP = O_VP + (size_t)MP * 512,
                 O_HP = O_LP + (size_t)MP * 8, O_KS = O_HP + 524288, O_VS = O_KS + 131072, O_LS = O_VS + 131072, O_HS = O_LS + 2048, O_END = O_HS + 524288;
constexpr int RING_BYTES = 131072, MISC_OFF = RING_BYTES, LDS_BYTES = 135168;
static_assert(attn_body::ATTN_LDS_BYTES <= RING_BYTES, "attention LDS");

#define LAS __attribute__((address_space(3)))
typedef unsigned short bf16;
typedef unsigned v4u __attribute__((ext_vector_type(4)));
typedef unsigned v2u __attribute__((ext_vector_type(2)));
typedef float f32x4 __attribute__((ext_vector_type(4)));
typedef short bf16x8 __attribute__((ext_vector_type(8)));
#define LDS_WAIT() asm volatile("s_waitcnt lgkmcnt(0)" ::: "memory")
__device__ __forceinline__ unsigned pk2(float lo, float hi) { return pg8::cvt_pk_bf16(lo, hi); }
__device__ __forceinline__ float bf2f(unsigned short b) { return __uint_as_float(((unsigned)b) << 16); }
#define DPPF(v, ctrl) __int_as_float(__builtin_amdgcn_update_dpp(0, __float_as_int(v), (ctrl), 0xf, 0xf, false))
__device__ __forceinline__ float sum8(float v) { v += DPPF(v, 0xB1); v += DPPF(v, 0x4E); v += DPPF(v, 0x141); return v; }
__device__ __forceinline__ float swap16_sum(float a, float b) { auto r = __builtin_amdgcn_permlane16_swap(__float_as_uint(a), __float_as_uint(b), false, false); return __uint_as_float(r[0]) + __uint_as_float(r[1]); }
__device__ __forceinline__ float swap32_sum(float a, float b) { auto r = __builtin_amdgcn_permlane32_swap(__float_as_uint(a), __float_as_uint(b), false, false); return __uint_as_float(r[0]) + __uint_as_float(r[1]); }
__device__ __forceinline__ float wave_sum(float v) { v = sum8(v); v += DPPF(v, 0x140); v = swap16_sum(v, v); v = swap32_sum(v, v); return v; }
__device__ __forceinline__ bool row_map(int row, int& idx) { if (row < MP) { idx = row; return true; } const int rs = row - MP; idx = (rs >> 6) * 32 + (rs & 63); return (rs & 63) < 32; }

namespace pg8 {
struct OrderIn {
    StaticOrder so; int pn_off, extra, extra_pm0;
    __device__ bool next(int i, Unit& u) const {
        const long L = (long)i * so.G + so.c;
        if (L < so.nwg) { so.next(i, u); u.pn += pn_off; return true; }
        const long e = L - so.nwg; if (e >= extra) return false;
        u.pm = extra_pm0 + (int)(e >> 3); u.pn = (int)(e & 7); u.kofs = 0; return true;
    }
    __device__ __forceinline__ void a_ready(const Unit&) const {}
    __device__ __forceinline__ void done(const Unit&) const {}
};
#define DPP_SHR(v, n) __int_as_float(__builtin_amdgcn_update_dpp(0, __float_as_int(v), 0x110 + (n), 0xf, 0xf, false))
#define PERMA(lane) ((((lane) >> 2) + 16 * ((lane) & 3)) << 2)
__device__ __forceinline__ f32x4 lperm(const f32x4 v, int pa) { f32x4 r;
    r[0] = __int_as_float(__builtin_amdgcn_ds_bpermute(pa, __float_as_int(v[0]))); r[1] = __int_as_float(__builtin_amdgcn_ds_bpermute(pa, __float_as_int(v[1])));
    r[2] = __int_as_float(__builtin_amdgcn_ds_bpermute(pa, __float_as_int(v[2]))); r[3] = __int_as_float(__builtin_amdgcn_ds_bpermute(pa, __float_as_int(v[3]))); return r; }
struct EpiIn {
    static constexpr bool PERM = false, AFTER_DRAIN = false;
    const float* rstd1; const float* lbl; const float* qg; const float* kg; unsigned char* ws; float* out;
    __device__ __forceinline__ void operator()(const f32x4 (&acc)[2][2][4][2], const Unit& u, int wr, int wc, int fr, int fq) const {
        const int pn = u.pn, rowb = u.pm * BM + wr * 64 + fr; const bool samp = u.pm >= (MP / BM);
        bf16_t* const QR = (bf16_t*)(ws + WS_QR); bf16_t* const KR = (bf16_t*)(ws + WS_KR); bf16_t* const VH = (bf16_t*)(ws + WS_VH); bf16_t* const SG = (bf16_t*)(ws + WS_SG); float* const vec = (float*)(ws + WS_VEC);
        float rs[2][4];
#pragma unroll
        for (int ai = 0; ai < 2; ++ai)
#pragma unroll
            for (int m = 0; m < 4; ++m) rs[ai][m] = rstd1[rowb + ai * HALF + m * 16];
        if (pn < 4) {
            const int h = pn, ch0 = 128 * h + 32 * wc + 4 * fq; const int lane = threadIdx.x & 63; const int a15 = ((lane & 48) | 15) << 2;
#pragma unroll
            for (int n = 0; n < 2; ++n) {
                const f32x4 l0 = *(const f32x4*)(lbl + ch0 + 16 * n), l1 = *(const f32x4*)(lbl + 512 + ch0 + 16 * n);
                f32x4 lb, omlb;
#pragma unroll
                for (int j = 0; j < 4; ++j) { lb[j] = 1.f / (1.f + __expf(l1[j] - l0[j])); omlb[j] = 1.f - lb[j]; }
#pragma unroll
                for (int ai = 0; ai < 2; ++ai) {
                    f32x4 bq[4], kk[4], bb[4]; f32x4 carry = {0.f, 0.f, 0.f, 0.f};
#pragma unroll
                    for (int m = 0; m < 4; ++m) {
#pragma unroll
                        for (int j = 0; j < 4; ++j) {
                            const float zq = acc[ai][0][m][n][j] * rs[ai][m], zf = acc[ai][1][m][n][j] * rs[ai][m];
                            const float sig = 1.f / (1.f + __expf(-zf)); const float f = lb[j] + omlb[j] * sig; float k = omlb[j] * (1.f - sig); float s = __logf(f);
                            if (samp && m >= 2) { s = 0.f; k = 0.f; }
                            s += DPP_SHR(s, 1); s += DPP_SHR(s, 2); s += DPP_SHR(s, 4); s += DPP_SHR(s, 8);
                            s += carry[j]; carry[j] = __int_as_float(__builtin_amdgcn_ds_bpermute(a15, __float_as_int(s)));
                            bq[m][j] = zq; kk[m][j] = k; bb[m][j] = s;
                        }
                    }
#pragma unroll
                    for (int m = 0; m < 4; ++m) {
                        float qv[4], kv[4];
#pragma unroll
                        for (int j = 0; j < 4; ++j) { qv[j] = bq[m][j] * __expf(bb[m][j]); kv[j] = kk[m][j] * __expf(-bb[m][j]); }
                        const size_t off = (size_t)(rowb + ai * HALF + m * 16) * 512 + ch0 + 16 * n;
                        v2u wq; wq.x = cvt_pk_bf16(qv[0], qv[1]); wq.y = cvt_pk_bf16(qv[2], qv[3]); *(v2u*)(QR + off) = wq;
                        v2u wk; wk.x = cvt_pk_bf16(kv[0], kv[1]); wk.y = cvt_pk_bf16(kv[2], kv[3]); *(v2u*)(KR + off) = wk;
                    }
                    if (fr == 0) {
                        const size_t voff = (size_t)((u.pm * BM + ai * HALF + wr * 64) >> 6) * 512 + ch0 + 16 * n;
                        f32x4 d;
#pragma unroll
                        for (int j = 0; j < 4; ++j) d[j] = __expf(carry[j]);
                        *(f32x4*)(vec + voff) = d;
                    }
                }
            }
        } else if (pn < 8) {
            const int h = pn - 4, c0 = 128 * h + 32 * wc + 4 * fq;
#pragma unroll
            for (int ai = 0; ai < 2; ++ai)
#pragma unroll
                for (int m = 0; m < 4; ++m) { const size_t off = (size_t)(rowb + ai * HALF + m * 16) * 512 + c0; const float r = rs[ai][m];
#pragma unroll
                    for (int n = 0; n < 2; ++n) { const f32x4 v = acc[ai][0][m][n] * r; f32x4 g = acc[ai][1][m][n] * r;
#pragma unroll
                        for (int j = 0; j < 4; ++j) g[j] = g[j] / (1.f + __expf(-g[j]));
                        v2u wv; wv.x = cvt_pk_bf16(v[0], v[1]); wv.y = cvt_pk_bf16(v[2], v[3]); *(v2u*)(VH + off + 16 * n) = wv;
                        v2u wg; wg.x = cvt_pk_bf16(g[0], g[1]); wg.y = cvt_pk_bf16(g[2], g[3]); *(v2u*)(SG + off + 16 * n) = wg; } }
        } else if (pn < 12) {
            const bool isK = pn >= 10; const int head = 4 * ((pn - 8) & 1) + wc; const float* gain = isK ? kg : qg; const float osc = isK ? 1.f : attn_body::C2;
            f32x4 gv[2][2];
#pragma unroll
            for (int bj = 0; bj < 2; ++bj)
#pragma unroll
                for (int n = 0; n < 2; ++n) gv[bj][n] = *(const f32x4*)(gain + 32 * bj + 16 * n + 4 * fq) * osc;
#pragma unroll
            for (int ai = 0; ai < 2; ++ai)
#pragma unroll
                for (int m = 0; m < 4; ++m) { const int row = rowb + ai * HALF + m * 16; const float r = rs[ai][m]; float ssq = 0.f;
#pragma unroll
                    for (int bj = 0; bj < 2; ++bj)
#pragma unroll
                        for (int n = 0; n < 2; ++n) { const f32x4 z = acc[ai][bj][m][n] * r; ssq += (z[0] * z[0] + z[1] * z[1]) + (z[2] * z[2] + z[3] * z[3]); }
                    ssq += __shfl_xor(ssq, 16); ssq += __shfl_xor(ssq, 32);
                    const float r2 = r / sqrtf(ssq * (1.f / 64.f) + EPSN);
                    int idx; const bool valid = row_map(row, idx);
                    float* ofp = out + (samp ? O_KS : O_KP) + (size_t)idx * 512;
                    const size_t boff = samp ? (isK ? WS_KS : WS_QS) : (isK ? WS_K : WS_Q); const size_t brow = samp ? (size_t)((idx >> 5) * SSEQ + PAST + (idx & 31)) : (size_t)row;
                    bf16_t* bfp = (bf16_t*)(ws + boff) + brow * 512;
                    if (valid) {
#pragma unroll
                        for (int bj = 0; bj < 2; ++bj)
#pragma unroll
                            for (int n = 0; n < 2; ++n) { const f32x4 v = acc[ai][bj][m][n] * r2 * gv[bj][n]; const int col = 64 * head + 32 * bj + 16 * n + 4 * fq;
                                if (isK) *(f32x4*)(ofp + col) = v;
                                v2u w; w.x = cvt_pk_bf16(v[0], v[1]); w.y = cvt_pk_bf16(v[2], v[3]); *(v2u*)(bfp + col) = w; } } }
        } else {
            const int c0 = 256 * (pn - 12) + 32 * wc + 4 * fq;
#pragma unroll
            for (int ai = 0; ai < 2; ++ai)
#pragma unroll
                for (int m = 0; m < 4; ++m) { const int row = rowb + ai * HALF + m * 16; const float r = rs[ai][m];
                    int idx; const bool valid = row_map(row, idx);
                    float* ofp = out + (samp ? O_VS : O_VP) + (size_t)idx * 512;
                    const size_t brow = samp ? (size_t)((idx >> 5) * SSEQ + PAST + (idx & 31)) : (size_t)row;
                    bf16_t* bfp = (bf16_t*)(ws + (samp ? WS_VS : WS_V)) + brow * 512;
                    if (valid) {
#pragma unroll
                        for (int bj = 0; bj < 2; ++bj)
#pragma unroll
                            for (int n = 0; n < 2; ++n) { const f32x4 v = acc[ai][bj][m][n] * r; const int col = c0 + 128 * bj + 16 * n;
                                *(f32x4*)(ofp + col) = v;
                                v2u w; w.x = cvt_pk_bf16(v[0], v[1]); w.y = cvt_pk_bf16(v[2], v[3]); *(v2u*)(bfp + col) = w; } } }
        }
    }
};
struct EpiWo {
    static constexpr bool PERM = false, AFTER_DRAIN = false;
    const bf16_t* XBp; const float* xs; float* yp; float* ys; bf16_t* X1B; float* ssq;
    __device__ __forceinline__ void operator()(const f32x4 (&acc)[2][2][4][2], const Unit& u, int wr, int wc, int fr, int fq) const {
        const int lane = threadIdx.x & 63, pa = PERMA(lane); fr = lane >> 2; fq = lane & 3;
        const int rowb = u.pm * BM + wr * 64 + fr, c0 = u.pn * BM + wc * 32 + 4 * fq; const bool samp = u.pm >= (MP / BM);
#pragma unroll
        for (int ai = 0; ai < 2; ++ai) {
            f32x4 xv[4][2][2];
            if (samp) {
#pragma unroll
                for (int m = 0; m < 4; ++m) { const int row = rowb + ai * HALF + m * 16; int idx; const bool valid = row_map(row, idx); const float* xr = xs + (size_t)idx * DMOD;
#pragma unroll
                    for (int bj = 0; bj < 2; ++bj)
#pragma unroll
                        for (int n = 0; n < 2; ++n) xv[m][bj][n] = valid ? *(const f32x4*)(xr + c0 + 128 * bj + 16 * n) : (f32x4){0.f, 0.f, 0.f, 0.f}; }
            } else {
                v2u xb[4][2][2];
#pragma unroll
                for (int m = 0; m < 4; ++m) { const bf16_t* xr = XBp + (size_t)(rowb + ai * HALF + m * 16) * DMOD;
#pragma unroll
                    for (int bj = 0; bj < 2; ++bj)
#pragma unroll
                        for (int n = 0; n < 2; ++n) xb[m][bj][n] = *(const v2u*)(xr + c0 + 128 * bj + 16 * n); }
                __builtin_amdgcn_sched_barrier(0);
#pragma unroll
                for (int m = 0; m < 4; ++m)
#pragma unroll
                    for (int bj = 0; bj < 2; ++bj)
#pragma unroll
                        for (int n = 0; n < 2; ++n) { const v2u w = xb[m][bj][n]; xv[m][bj][n] = (f32x4){__uint_as_float(w.x << 16), __uint_as_float(w.x & 0xffff0000u), __uint_as_float(w.y << 16), __uint_as_float(w.y & 0xffff0000u)}; }
            }
            __builtin_amdgcn_sched_barrier(0);
#pragma unroll
            for (int m = 0; m < 4; ++m) { const int row = rowb + ai * HALF + m * 16; int idx; const bool valid = row_map(row, idx);
                float* yr = yp + (samp ? (size_t)MP * DMOD : (size_t)0) + (size_t)idx * DMOD; float s = 0.f;
#pragma unroll
                for (int bj = 0; bj < 2; ++bj)
#pragma unroll
                    for (int n = 0; n < 2; ++n) { const int col = c0 + 128 * bj + 16 * n; f32x4 v = lperm(acc[ai][bj][m][n], pa) + xv[m][bj][n];
                        if (samp && valid) *(f32x4*)(yr + col) = v;
                        s += (v[0] * v[0] + v[1] * v[1]) + (v[2] * v[2] + v[3] * v[3]);
                        v2u w; w.x = cvt_pk_bf16(v[0], v[1]); w.y = cvt_pk_bf16(v[2], v[3]); *(v2u*)(X1B + (size_t)row * DMOD + col) = w; }
                s += __shfl_xor(s, 1); s += __shfl_xor(s, 2);
                if (fq == 0) ssq[(size_t)row * 16 + 4 * u.pn + wc] = s; }
            __builtin_amdgcn_sched_barrier(0);
        }
    }
};
struct EpiUp {
    static constexpr bool PERM = true, AFTER_DRAIN = false;
    bf16_t* O; const float* ssq;
    __device__ __forceinline__ void operator()(const f32x4 (&acc)[2][2][4][2], const Unit& u, int wr, int wc, int fr, int fq) const {
        const int row0 = u.pm * BM + wr * 64 + fr, col0 = u.pn * BM + wc * 32 + 8 * fq;
        float rr[2][4];
#pragma unroll
        for (int ai = 0; ai < 2; ++ai) { f32x4 sv[4][4];
#pragma unroll
            for (int m = 0; m < 4; ++m) { const f32x4* sp = (const f32x4*)(ssq + (size_t)(row0 + ai * HALF + m * 16) * 16); sv[m][0] = sp[0]; sv[m][1] = sp[1]; sv[m][2] = sp[2]; sv[m][3] = sp[3]; }
            __builtin_amdgcn_sched_barrier(0);
#pragma unroll
            for (int m = 0; m < 4; ++m) { const f32x4 st = (sv[m][0] + sv[m][1]) + (sv[m][2] + sv[m][3]); rr[ai][m] = __builtin_amdgcn_rsqf(((st[0] + st[1]) + (st[2] + st[3])) * (1.f / DMOD) + EPSN); } }
#pragma unroll
        for (int ai = 0; ai < 2; ++ai)
#pragma unroll
            for (int m = 0; m < 4; ++m) { const int row = row0 + ai * HALF + m * 16;
                const float r = rr[ai][m];
                bf16_t* rowp = O + (size_t)row * FF + col0;
#pragma unroll
                for (int bj = 0; bj < 2; ++bj) { f32x4 v0 = acc[ai][bj][m][0] * r, v1 = acc[ai][bj][m][1] * r;
#pragma unroll
                    for (int j = 0; j < 4; ++j) { v0[j] = fmaxf(v0[j], 0.f); v0[j] *= v0[j]; v1[j] = fmaxf(v1[j], 0.f); v1[j] *= v1[j]; }
                    u32x4 w; w.x = cvt_pk_bf16(v0[0], v0[1]); w.y = cvt_pk_bf16(v0[2], v0[3]); w.z = cvt_pk_bf16(v1[0], v1[1]); w.w = cvt_pk_bf16(v1[2], v1[3]);
                    *(u32x4*)(rowp + bj * HALF) = w; } }
    }
};
struct OrderDown {
    StaticOrder so; int mode;
    static constexpr int KSPLIT = 4;
    __device__ bool next(int i, Unit& u) const {
        if (mode) return so.next(i, u);
        const long L = (long)i * so.G + so.c; if (L >= 8 * KSPLIT) return false;
        const int t = (int)L / KSPLIT, ks = (int)L % KSPLIT; u.pm = MP / BM + (t >> 2); u.pn = t & 3; u.kofs = ks * (FF / KSPLIT); return true;
    }
    __device__ __forceinline__ void a_ready(const Unit&) const {}
    __device__ __forceinline__ void done(const Unit&) const {}
};
struct EpiDown {
    static constexpr bool PERM = false, AFTER_DRAIN = false;
    float* yp; float* ys; const bf16_t* X1B; int atomic;
    __device__ __forceinline__ void operator()(const f32x4 (&acc)[2][2][4][2], const Unit& u, int wr, int wc, int fr, int fq) const {
        const int lane = threadIdx.x & 63, pa = PERMA(lane); fr = lane >> 2; fq = lane & 3;
        const int rowb = u.pm * BM + wr * 64 + fr, c0 = u.pn * BM + wc * 32 + 4 * fq; const bool samp = u.pm >= (MP / BM);
#pragma unroll
        for (int ai = 0; ai < 2; ++ai) {
            f32x4 xv[4][2][2];
            if (!atomic) {
                v2u xb[4][2][2];
#pragma unroll
                for (int m = 0; m < 4; ++m) { const bf16_t* xr = X1B + (size_t)(rowb + ai * HALF + m * 16) * DMOD;
#pragma unroll
                    for (int bj = 0; bj < 2; ++bj)
#pragma unroll
                        for (int n = 0; n < 2; ++n) xb[m][bj][n] = *(const v2u*)(xr + c0 + 128 * bj + 16 * n); }
                __builtin_amdgcn_sched_barrier(0);
#pragma unroll
                for (int m = 0; m < 4; ++m)
#pragma unroll
                    for (int bj = 0; bj < 2; ++bj)
#pragma unroll
                        for (int n = 0; n < 2; ++n) { const v2u w = xb[m][bj][n]; xv[m][bj][n] = (f32x4){__uint_as_float(w.x << 16), __uint_as_float(w.x & 0xffff0000u), __uint_as_float(w.y << 16), __uint_as_float(w.y & 0xffff0000u)}; }
            }
            __builtin_amdgcn_sched_barrier(0);
#pragma unroll
            for (int m = 0; m < 4; ++m) { const int row = rowb + ai * HALF + m * 16; int idx; const bool valid = row_map(row, idx);
                float* yr = yp + (samp ? (size_t)MP * DMOD : (size_t)0) + (size_t)idx * DMOD;
                if (valid) {
#pragma unroll
                    for (int bj = 0; bj < 2; ++bj)
#pragma unroll
                        for (int n = 0; n < 2; ++n) { const int col = c0 + 128 * bj + 16 * n; const f32x4 v = lperm(acc[ai][bj][m][n], pa);
                            if (atomic) {
#pragma unroll
                                for (int j = 0; j < 4; ++j) __hip_atomic_fetch_add(yr + col + j, v[j], __ATOMIC_RELAXED, __HIP_MEMORY_SCOPE_AGENT);
                            } else *(f32x4*)(yr + col) = xv[m][bj][n] + v; } } }
            __builtin_amdgcn_sched_barrier(0);
        }
    }
};
}

struct Args { const float* in[17]; float* out; unsigned char* ws; int ph_lo, ph_hi; };
struct Frame {
    LAS unsigned char* lds; volatile LAS unsigned* MISC; unsigned* ctl; unsigned char* ws; float* out;
    int tid, lane, wave, vcu, G;
    const float *xp, *xs, *ck, *cv, *clf, *sh, *n1, *win, *bff, *qg, *kg, *lbl, *hon, *wout, *n2, *wup, *wdn;
};

__device__ __forceinline__ int win_src_col(int g) {
    const int j0 = 32 * g, tile = j0 >> 8, jl = j0 & 255;
    if (tile < 4) return (jl < 128) ? (128 * tile + jl) : (512 + 128 * tile + (jl - 128));
    if (tile < 8) { const int h = tile - 4; return (jl < 128) ? (1024 + 128 * h + jl) : (1536 + 128 * h + (jl - 128)); }
    if (tile < 12) { const int base = tile < 10 ? 2048 : 2560, tl = (tile - 8) & 1, bj = jl >> 7, wc = (jl >> 5) & 3; return base + 64 * (4 * tl + wc) + 32 * bj; }
    return 3072 + (j0 - 12 * 256);
}
__device__ __forceinline__ void p0_transpose_item(const float* W, int ldw, int K, const float* nrm, bf16* WT, int n0, int src0, int k0, LAS float* scr, int lane) {
    float vals[32]; const float* wp = W + (size_t)(k0 + (lane >> 5)) * ldw + src0 + (lane & 31);
#pragma unroll
    for (int i = 0; i < 32; ++i) vals[i] = wp[(size_t)(2 * i) * ldw];
    const int c = lane & 7;
    f32x4 n0v = {1.f, 1.f, 1.f, 1.f}, n1v = {1.f, 1.f, 1.f, 1.f};
    if (nrm) { n0v = *(const f32x4*)(nrm + k0 + 8 * c); n1v = *(const f32x4*)(nrm + k0 + 8 * c + 4); }
#pragma unroll
    for (int i = 0; i < 32; ++i) scr[(2 * i + (lane >> 5)) * 33 + (lane & 31)] = vals[i];
    LDS_WAIT(); asm volatile("" ::: "memory");
#pragma unroll
    for (int j = 0; j < 4; ++j) { const int n = (lane >> 3) + 8 * j; const LAS float* s = scr + (8 * c) * 33 + n;
        v4u o; o.x = pk2(s[0 * 33] * n0v[0], s[1 * 33] * n0v[1]); o.y = pk2(s[2 * 33] * n0v[2], s[3 * 33] * n0v[3]); o.z = pk2(s[4 * 33] * n1v[0], s[5 * 33] * n1v[1]); o.w = pk2(s[6 * 33] * n1v[2], s[7 * 33] * n1v[3]);
        *(v4u*)(WT + (size_t)(n0 + n) * K + k0 + 8 * c) = o; }
    LDS_WAIT(); asm volatile("" ::: "memory");
}
__device__ __forceinline__ void p0_prologue(Frame& F) {
    LAS float* scr = (LAS float*)(F.lds + F.wave * 16384);
    const int gw = F.vcu * NWAVES + F.wave, NGW = F.G * NWAVES, lane = F.lane;
    bf16* Win_t = (bf16*)(F.ws + WS_WIN); bf16* Wo_t = (bf16*)(F.ws + WS_WO); bf16* Wup_t = (bf16*)(F.ws + WS_WUP); bf16* Wdn_t = (bf16*)(F.ws + WS_WDN);
    constexpr int I_IN = 16 * (NIN / 32), I_O = 16 * 32, I_UP = 16 * (FF / 32), I_DN = 64 * 32, NITEMS = I_IN + I_O + I_UP + I_DN;
    for (int it = gw; it < NITEMS; it += NGW) {
        int r = it;
        if (r < I_IN) { const int kb = r / (NIN / 32), g = r % (NIN / 32); p0_transpose_item(F.win, INC, DMOD, F.n1, Win_t, 32 * g, win_src_col(g), 64 * kb, scr, lane); continue; } r -= I_IN;
        if (r < I_O) { const int kb = r / 32, g = r % 32; p0_transpose_item(F.wout, DMOD, DMOD, nullptr, Wo_t, 32 * g, 32 * g, 64 * kb, scr, lane); continue; } r -= I_O;
        if (r < I_UP) { const int kb = r / (FF / 32), g = r % (FF / 32); p0_transpose_item(F.wup, FF, DMOD, F.n2, Wup_t, 32 * g, 32 * g, 64 * kb, scr, lane); continue; } r -= I_UP;
        { const int kb = r / 32, g = r % 32; p0_transpose_item(F.wdn, DMOD, FF, nullptr, Wdn_t, 32 * g, 32 * g, 64 * kb, scr, lane); }
    }
    { const int gt = F.vcu * NTHR + F.tid, NGT = F.G * NTHR;
      bf16* Qs = (bf16*)(F.ws + WS_QS); bf16* Ks = (bf16*)(F.ws + WS_KS); bf16* Vs = (bf16*)(F.ws + WS_VS);
      for (int i = gt; i < NBATCH * PAST * 64; i += NGT) { const int b = i / (PAST * 64), rem = i % (PAST * 64); const size_t so = (size_t)i * 8, dof = ((size_t)b * SSEQ * 64 + rem) * 8;
          const f32x4 a0 = *(const f32x4*)(F.ck + so), a1 = *(const f32x4*)(F.ck + so + 4), b0 = *(const f32x4*)(F.cv + so), b1 = *(const f32x4*)(F.cv + so + 4);
          v4u o; o.x = pk2(a0[0], a0[1]); o.y = pk2(a0[2], a0[3]); o.z = pk2(a1[0], a1[1]); o.w = pk2(a1[2], a1[3]); *(v4u*)(Ks + dof) = o;
          o.x = pk2(b0[0], b0[1]); o.y = pk2(b0[2], b0[3]); o.z = pk2(b1[0], b1[1]); o.w = pk2(b1[2], b1[3]); *(v4u*)(Vs + dof) = o; }
      const v4u z = {0u, 0u, 0u, 0u};
      for (int i = gt; i < NBATCH * SSEQ * 64; i += NGT) *(v4u*)(Qs + (size_t)i * 8) = z;
      for (int i = gt; i < NBATCH * (SSEQ - PAST) * 64; i += NGT) { const int b = i / ((SSEQ - PAST) * 64), rem = i % ((SSEQ - PAST) * 64); const size_t dof = ((size_t)(b * SSEQ + PAST) * 64 + rem) * 8; *(v4u*)(Ks + dof) = z; *(v4u*)(Vs + dof) = z; }
    }
    float wf[4][4][8];
#pragma unroll
    for (int j = 0; j < 4; ++j)
#pragma unroll
        for (int i = 0; i < 4; ++i) { const int k = 256 * j + 4 * lane + i; const float nk = F.n1[k]; const f32x4 a = *(const f32x4*)(F.win + (size_t)k * INC + NIN), b = *(const f32x4*)(F.win + (size_t)k * INC + NIN + 4);
            wf[j][i][0] = a[0] * nk; wf[j][i][1] = a[1] * nk; wf[j][i][2] = a[2] * nk; wf[j][i][3] = a[3] * nk; wf[j][i][4] = b[0] * nk; wf[j][i][5] = b[1] * nk; wf[j][i][6] = b[2] * nk; wf[j][i][7] = b[3] * nk; }
    float* rstd1 = (float*)(F.ws + WS_RSTD); bf16* XB = (bf16*)(F.ws + WS_XB);
    f32x4 vn[4];
#define P0_LOADROW(mm) do { int idx_; const bool val_ = (mm) < MTOT && row_map((mm), idx_); const float* xr_ = ((mm) < MP ? F.xp : F.xs) + (size_t)idx_ * DMOD; \
        _Pragma("unroll") for (int j = 0; j < 4; ++j) vn[j] = val_ ? *((const f32x4*)xr_ + 64 * j + lane) : (f32x4){0.f, 0.f, 0.f, 0.f}; } while (0)
    P0_LOADROW(gw);
    for (int m = gw; m < MTOT; m += NGW) {
        int idx; const bool valid = row_map(m, idx);
        f32x4 v[4]; float s = 0.f;
#pragma unroll
        for (int j = 0; j < 4; ++j) v[j] = vn[j];
        P0_LOADROW(m + NGW);
#pragma unroll
        for (int j = 0; j < 4; ++j) s += (v[j][0] * v[j][0] + v[j][1] * v[j][1]) + (v[j][2] * v[j][2] + v[j][3] * v[j][3]);
        const float rstd = 1.f / sqrtf(wave_sum(s) * (1.f / DMOD) + EPSN);
        if (lane == 0) rstd1[m] = rstd;
        unsigned long long* o8 = (unsigned long long*)(XB + (size_t)m * DMOD) + lane;
#pragma unroll
        for (int j = 0; j < 4; ++j) o8[64 * j] = (unsigned long long)pk2(v[j][0], v[j][1]) | ((unsigned long long)pk2(v[j][2], v[j][3]) << 32);
        float a8[8];
#pragma unroll
        for (int h = 0; h < 8; ++h) { float a = 0.f;
#pragma unroll
            for (int j = 0; j < 4; ++j)
#pragma unroll
                for (int i = 0; i < 4; ++i) a += v[j][i] * wf[j][i][h];
            a8[h] = a; }
        float b4[4], c2[2], dsum;
#pragma unroll
        for (int i = 0; i < 4; ++i) b4[i] = swap32_sum(a8[i], a8[4 + i]);
#pragma unroll
        for (int i = 0; i < 2; ++i) c2[i] = swap16_sum(b4[i], b4[2 + i]);
        { const bool hi_ = (lane & 8) != 0; const float send = hi_ ? c2[0] : c2[1], keep = hi_ ? c2[1] : c2[0]; dsum = keep + DPPF(send, 0x128); }
        dsum = sum8(dsum);
        { const int hh = (lane >> 3) & 7; const float xx = dsum * rstd + F.bff[hh]; const float ls = fminf(xx, 0.f) - log1pf(expf(-fabsf(xx)));
          if (valid && (lane & 7) == 0) { float* lp = (m < MP ? F.out + O_LP : F.out + O_LS) + (size_t)idx * 8; lp[hh] = ls; } }
    }
}
__device__ __forceinline__ void scan_chain(Frame& F, int ch) {
    LAS float* wsum = (LAS float*)F.lds;
    const bool samp = ch >= 64; const int c2 = samp ? ch - 64 : ch, b = c2 >> 3, h = c2 & 7; const int L = samp ? SSEQ : TSEQ, EPT = samp ? 3 : 16;
    float* dst = samp ? (float*)(F.ws + WS_CGS) + (size_t)c2 * SSEQ : (float*)(F.ws + WS_CGP) + (size_t)c2 * TSEQ;
    float vals[16]; float sum = 0.f;
#pragma unroll
    for (int i = 0; i < 16; ++i) { const int p = F.tid * EPT + i; float v = 0.f;
        if (i < EPT && p < L) { if (!samp) v = F.out[O_LP + ((size_t)b * TSEQ + p) * 8 + h]; else if (p < PAST) v = F.clf[((size_t)b * PAST + p) * 8 + h]; else if (p < PAST + DSEQ) v = F.out[O_LS + ((size_t)b * DSEQ + (p - PAST)) * 8 + h]; }
        sum += v; vals[i] = sum; }
    float incl = sum;
#pragma unroll
    for (int o = 1; o < 64; o <<= 1) { const float t = __shfl_up(incl, o); if (F.lane >= o) incl += t; }
    if (F.lane == 63) wsum[F.wave] = incl;
    __syncthreads();
    float base = 0.f;
    for (int w = 0; w < F.wave; ++w) base += wsum[w];
    const float excl = base + incl - sum;
#pragma unroll
    for (int i = 0; i < 16; ++i) { const int p = F.tid * EPT + i; if (i < EPT && p < L) dst[p] = (excl + vals[i]) * LOG2E; }
    __syncthreads();
}
constexpr int KP = 320  , H_QR = 0, H_KR = 17408, H_KT = 37888, H_VT = 58368, H_VEC = 71680, H_AL = 73216, H_OL = 82432, H_END = 116224;
static_assert(H_END <= RING_BYTES, "hgrn LDS");
typedef short v4i16_t __attribute__((ext_vector_type(4)));
__device__ __forceinline__ bf16x8 tr_frag(LAS unsigned char* p) {
    const v4i16_t lo = __builtin_amdgcn_ds_read_tr16_b64_v4i16((LAS v4i16_t*)p), hi = __builtin_amdgcn_ds_read_tr16_b64_v4i16((LAS v4i16_t*)(p + 4 * KP));
    return (bf16x8){lo[0], lo[1], lo[2], lo[3], hi[0], hi[1], hi[2], hi[3]};
}
__device__ __forceinline__ f32x4 mfma16(bf16x8 a, bf16x8 b, f32x4 c) { return __builtin_amdgcn_mfma_f32_16x16x32_bf16(a, b, c, 0, 0, 0); }
#define LAUNDER(x) asm volatile("" : "+v"(x))
#ifndef PR_A
#define PR_A 1
#endif
#ifndef PR_O
#define PR_O 1
#endif
#ifndef PR_OUT
#define PR_OUT 1
#endif
#ifndef PR_U
#define PR_U 0
#endif
#ifndef PR_ST
#define PR_ST 1
#endif
#ifndef PR_BAR
#define PR_BAR 1
#endif
#define HG_BAR() do { for (int rb_ = 0; rb_ < PR_BAR; ++rb_) { asm volatile("s_waitcnt lgkmcnt(0)" ::: "memory"); __builtin_amdgcn_s_barrier(); asm volatile("" ::: "memory"); } } while (0)
__device__ __forceinline__ void hgrn_chain(Frame& F, int row0, int chunk0, int nsteps, int h, const float* S0, float* Sout) {
    LAS unsigned char* L = F.lds; int tid_ = F.tid; LAUNDER(tid_); const int tid = tid_, lane = tid & 63, w = F.wave, l15 = lane & 15, fq = lane >> 4;
    const char* qb = (const char*)(F.ws + WS_QR) + ((size_t)row0 * 512 + 128 * h) * 2; const char* kb_ = (const char*)(F.ws + WS_KR) + ((size_t)row0 * 512 + 128 * h) * 2;
    const char* vb = (const char*)(F.ws + WS_VH) + ((size_t)row0 * 512 + 128 * h) * 2; const char* gb = (const char*)(F.ws + WS_SG) + ((size_t)row0 * 512 + 128 * h) * 2;
    const char* eb = (const char*)(F.ws + WS_VEC) + ((size_t)chunk0 * 512 + 128 * h) * 4; char* mb = (char*)(F.ws + WS_MIX) + ((size_t)row0 * DMOD + 128 * h) * 2;
    const int oc = tid >> 3, oseg = tid & 7;
    unsigned vo_rm = (unsigned)((tid >> 4) * 1024 + (tid & 15) * 16), vo_sg = (unsigned)(oc * 1024 + oseg * 32), vo_mix = (unsigned)(oc * 2048 + oseg * 32);
    unsigned vo_vec = (unsigned)((tid & 31) * 16);
    unsigned l_rm = (unsigned)(H_QR + (tid >> 4) * 272 + (tid & 15) * 16), l_rk = (unsigned)(H_KR + (tid >> 4) * KP + (tid & 15) * 16);
    unsigned l_vw = (unsigned)(H_VEC + (tid & 31) * 16);
    unsigned l_aq = (unsigned)(H_QR + (16 * (w >> 1) + l15) * 272 + fq * 16);
    unsigned l_ak = (unsigned)(H_KR + (32 * (w & 1) + l15) * KP + fq * 16);
    unsigned l_aw = (unsigned)(H_AL + (16 * (w >> 1) + 4 * fq) * 144 + (32 * (w & 1) + l15) * 2);
    unsigned l_vt = (unsigned)(H_KT + (8 * fq + (l15 >> 2)) * KP + (16 * w + 4 * (l15 & 3)) * 2);
    unsigned l_q2 = (unsigned)(H_QR + l15 * 272 + fq * 16);
    unsigned l_al = (unsigned)(H_AL + l15 * 144 + fq * 16);
    unsigned l_kt = (unsigned)(H_KR + (8 * fq + (l15 >> 2)) * KP + (8 * (l15 & 3)) * 2);
    unsigned l_ve = (unsigned)(H_VEC + fq * 32);
    unsigned l_ow = (unsigned)(H_OL + (4 * fq) * 528 + (16 * w + l15) * 4);
    unsigned l_or = (unsigned)(H_OL + oc * 528 + oseg * 64);
    f32x4 S[8];
#pragma unroll
    for (int kb = 0; kb < 8; ++kb) S[kb] = (f32x4){0.f, 0.f, 0.f, 0.f};
    if (S0) { const float* sp = S0 + (8 * fq) * 128 + 16 * w + l15;
#pragma unroll
        for (int kb = 0; kb < 8; ++kb) { LAUNDER(sp);
#pragma unroll
            for (int r = 0; r < 4; ++r) S[kb][r] = sp[r * 128];
            sp += (kb & 1) ? 28 * 128 : 4 * 128; } }
    f32x4 gn[4];
#pragma unroll
    for (int i = 0; i < 4; ++i) gn[i] = *(const f32x4*)(F.hon + 128 * h + 16 * oseg + 4 * i);
    v4u pq[2][2], pk[2][2], pv[2][2], psg[2][2], pvec[2]; int cl = 0, gl = 0;
#define HG_LOADS(SET) do { \
        _Pragma("unroll") for (int it = 0; it < 2; ++it) { pq[SET][it] = *(const v4u*)(qb + vo_rm + it * 32768); pk[SET][it] = *(const v4u*)(kb_ + vo_rm + it * 32768); pv[SET][it] = *(const v4u*)(vb + vo_rm + it * 32768); } \
        pvec[SET] = *(const v4u*)(eb + vo_vec); } while (0)
#define HG_STORE(SET) do { \
        _Pragma("unroll") for (int it = 0; it < 2; ++it) { *(LAS v4u*)(L + l_rm + it * 8704) = pq[SET][it]; *(LAS v4u*)(L + l_rk + it * 32 * KP) = pk[SET][it]; *(LAS v4u*)(L + l_rk + (H_KT - H_KR) + it * 32 * KP) = pv[SET][it]; } \
        if (tid < 32) *(LAS v4u*)(L + l_vw) = pvec[SET]; } while (0)
#define HG_ADV() do { const int a_ = (cl + 1 < nsteps) ? 1 : 0; qb += a_ * 65536; kb_ += a_ * 65536; vb += a_ * 65536; eb += a_ * 2048; cl += a_; } while (0)
    HG_LOADS(0); HG_ADV(); HG_STORE(0); HG_LOADS(1); HG_ADV();
    psg[0][0] = *(const v4u*)(gb + vo_sg); psg[0][1] = *(const v4u*)(gb + vo_sg + 16); { const int a_ = (gl + 1 < nsteps) ? 1 : 0; gb += a_ * 65536; gl += a_; }
    HG_BAR();
#define HG_BODY(CUR, NXT, CC) do { \
        LAUNDER(vo_rm); LAUNDER(vo_sg); LAUNDER(vo_mix); LAUNDER(vo_vec); LAUNDER(l_rm); LAUNDER(l_rk); LAUNDER(l_vw); LAUNDER(l_aq); LAUNDER(l_ak); LAUNDER(l_aw); \
        LAUNDER(l_vt); LAUNDER(l_q2); LAUNDER(l_al); LAUNDER(l_kt); LAUNDER(l_ve); LAUNDER(l_ow); LAUNDER(l_or); \
        psg[NXT][0] = *(const v4u*)(gb + vo_sg); psg[NXT][1] = *(const v4u*)(gb + vo_sg + 16); { const int a_ = (gl + 1 < nsteps) ? 1 : 0; gb += a_ * 65536; gl += a_; } \
        HG_LOADS(CUR); HG_ADV(); \
        for (int ra_ = 0; ra_ < PR_A; ++ra_) { const int cblk = w >> 1; \
        _Pragma("unroll") \
          for (int jj = 0; jj < 2; ++jj) { const int sblk = 2 * (w & 1) + jj; f32x4 a = {0.f, 0.f, 0.f, 0.f}; \
              if (sblk <= cblk) { \
                  bf16x8 af[4], bf[4]; \
        _Pragma("unroll") \
                  for (int ks = 0; ks < 4; ++ks) { af[ks] = *(const LAS bf16x8*)(L + l_aq + ks * 64); bf[ks] = *(const LAS bf16x8*)(L + l_ak + jj * 16 * KP + ks * 64); } \
                  asm volatile("" : "+v"(af[0]), "+v"(af[1]), "+v"(af[2]), "+v"(af[3]), "+v"(bf[0]), "+v"(bf[1]), "+v"(bf[2]), "+v"(bf[3])); \
        _Pragma("unroll") \
                  for (int ks = 0; ks < 4; ++ks) a = mfma16(af[ks], bf[ks], a); \
        _Pragma("unroll") \
                  for (int r = 0; r < 4; ++r) if (16 * sblk + l15 > 16 * cblk + 4 * fq + r) a[r] = 0.f; \
              } \
        _Pragma("unroll") \
              for (int r = 0; r < 4; ++r) *(LAS unsigned short*)(L + l_aw + r * 144 + jj * 32) = (unsigned short)(pk2(a[r], 0.f) & 0xffffu); \
          } HG_BAR(); } \
        { bf16x8 bvt[2]; \
        _Pragma("unroll") \
          for (int ks = 0; ks < 2; ++ks) bvt[ks] = tr_frag(L + l_vt + ks * 32 * KP); \
          bf16x8 sb[4]; \
        _Pragma("unroll") \
          for (int kb2 = 0; kb2 < 4; ++kb2) { v4u t; t.x = pk2(S[2 * kb2][0], S[2 * kb2][1]); t.y = pk2(S[2 * kb2][2], S[2 * kb2][3]); t.z = pk2(S[2 * kb2 + 1][0], S[2 * kb2 + 1][1]); t.w = pk2(S[2 * kb2 + 1][2], S[2 * kb2 + 1][3]); sb[kb2] = __builtin_bit_cast(bf16x8, t); } \
          for (int ro_ = 0; ro_ < PR_O; ++ro_) \
          _Pragma("unroll") \
          for (int cb = 0; cb < 4; ++cb) { f32x4 o = {0.f, 0.f, 0.f, 0.f}; bf16x8 fa[2], fq_[4]; \
        _Pragma("unroll") \
              for (int ks = 0; ks < 2; ++ks) fa[ks] = *(const LAS bf16x8*)(L + l_al + cb * 16 * 144 + ks * 64); \
        _Pragma("unroll") \
              for (int kb2 = 0; kb2 < 4; ++kb2) fq_[kb2] = *(const LAS bf16x8*)(L + l_q2 + cb * 16 * 272 + kb2 * 64); \
              asm volatile("" : "+v"(fa[0]), "+v"(fa[1]), "+v"(fq_[0]), "+v"(fq_[1]), "+v"(fq_[2]), "+v"(fq_[3])); \
        _Pragma("unroll") \
              for (int ks = 0; ks < 2; ++ks) if (32 * ks <= 16 * cb + 15) o = mfma16(fa[ks], bvt[ks], o); \
        _Pragma("unroll") \
              for (int kb2 = 0; kb2 < 4; ++kb2) o = mfma16(fq_[kb2], sb[kb2], o); \
        _Pragma("unroll") \
              for (int r = 0; r < 4; ++r) *(LAS float*)(L + l_ow + (16 * cb + r) * 528) = o[r]; \
              __builtin_amdgcn_sched_barrier(0); } \
        _Pragma("unroll") \
          for (int kp = 0; kp < 4; ++kp) { bf16x8 fk[2][2]; f32x4 dv[2]; \
        _Pragma("unroll") \
              for (int e = 0; e < 2; ++e) { const int kb = 2 * kp + e; \
        _Pragma("unroll") \
                  for (int ks = 0; ks < 2; ++ks) fk[e][ks] = tr_frag(L + l_kt + (32 * (kb >> 1) + 4 * (kb & 1)) * 2 + ks * 32 * KP); \
                  dv[e] = *(const LAS f32x4*)(L + l_ve + (32 * (kb >> 1) + 4 * (kb & 1)) * 4); } \
              asm volatile("" : "+v"(fk[0][0]), "+v"(fk[0][1]), "+v"(fk[1][0]), "+v"(fk[1][1]), "+v"(dv[0]), "+v"(dv[1])); \
        _Pragma("unroll") \
              for (int e = 0; e < 2; ++e) { const int kb = 2 * kp + e; \
        _Pragma("unroll") \
                  for (int ks = 0; ks < 2; ++ks) S[kb] = mfma16(fk[e][ks], bvt[ks], S[kb]); \
                  S[kb] = S[kb] * dv[e]; } \
              __builtin_amdgcn_sched_barrier(0); } \
          for (int ru_ = 0; ru_ < PR_U; ++ru_) { f32x4 S2[8]; \
          _Pragma("unroll") for (int kb = 0; kb < 8; ++kb) S2[kb] = S[kb]; \
          _Pragma("unroll") \
          for (int kp = 0; kp < 4; ++kp) { bf16x8 fk[2][2]; f32x4 dv[2]; \
          _Pragma("unroll") \
              for (int e = 0; e < 2; ++e) { const int kb = 2 * kp + e; \
          _Pragma("unroll") \
                  for (int ks = 0; ks < 2; ++ks) fk[e][ks] = tr_frag(L + l_kt + (32 * (kb >> 1) + 4 * (kb & 1)) * 2 + ks * 32 * KP); \
                  dv[e] = *(const LAS f32x4*)(L + l_ve + (32 * (kb >> 1) + 4 * (kb & 1)) * 4); } \
              asm volatile("" : "+v"(fk[0][0]), "+v"(fk[0][1]), "+v"(fk[1][0]), "+v"(fk[1][1]), "+v"(dv[0]), "+v"(dv[1])); \
          _Pragma("unroll") \
              for (int e = 0; e < 2; ++e) { const int kb = 2 * kp + e; \
          _Pragma("unroll") \
                  for (int ks = 0; ks < 2; ++ks) S2[kb] = mfma16(fk[e][ks], bvt[ks], S2[kb]); \
                  S2[kb] = S2[kb] * dv[e]; } \
              __builtin_amdgcn_sched_barrier(0); } \
          asm volatile("" :: "v"(S2[0]), "v"(S2[1]), "v"(S2[2]), "v"(S2[3]), "v"(S2[4]), "v"(S2[5]), "v"(S2[6]), "v"(S2[7])); } } \
        HG_BAR(); \
        for (int rt_ = 0; rt_ < PR_OUT; ++rt_) { f32x4 ov[4]; float ss = 0.f; \
        _Pragma("unroll") \
          for (int i = 0; i < 4; ++i) { ov[i] = *(const LAS f32x4*)(L + l_or + 16 * i); ss += (ov[i][0] * ov[i][0] + ov[i][1] * ov[i][1]) + (ov[i][2] * ov[i][2] + ov[i][3] * ov[i][3]); } \
          ss = sum8(ss); \
          const float rn = __builtin_amdgcn_rsqf(ss * (1.f / 128.f) + EPSN); \
          float res[16]; \
        _Pragma("unroll") \
          for (int i = 0; i < 4; ++i) \
        _Pragma("unroll") \
              for (int j = 0; j < 4; ++j) { const int e = 4 * i + j; const unsigned wd = psg[CUR][e >> 3][(e & 7) >> 1]; const float sg = bf2f((unsigned short)((e & 1) ? (wd >> 16) : (wd & 0xffffu))); res[e] = ov[i][j] * rn * gn[i][j] * sg; } \
          v4u o0, o1; o0.x = pk2(res[0], res[1]); o0.y = pk2(res[2], res[3]); o0.z = pk2(res[4], res[5]); o0.w = pk2(res[6], res[7]); o1.x = pk2(res[8], res[9]); o1.y = pk2(res[10], res[11]); o1.z = pk2(res[12], res[13]); o1.w = pk2(res[14], res[15]); \
          *(v4u*)(mb + vo_mix) = o0; *(v4u*)(mb + vo_mix + 16) = o1; } mb += 131072; \
        if ((CC) + 1 < nsteps) { for (int rs_ = 0; rs_ < PR_ST; ++rs_) { HG_STORE(NXT); } } \
        HG_BAR(); \
    } while (0)
    for (int c = 0; c < nsteps; c += 2) { HG_BODY(0, 1, c); if (c + 1 < nsteps) HG_BODY(1, 0, c + 1); }
    { int ln2 = lane; LAUNDER(ln2); float* sp = Sout + (8 * (ln2 >> 4)) * 128 + 16 * w + (ln2 & 15);
#pragma unroll
      for (int kb = 0; kb < 8; ++kb) { LAUNDER(sp);
#pragma unroll
          for (int r = 0; r < 4; ++r) sp[r * 128] = S[kb][r];
          sp += (kb & 1) ? 28 * 128 : 4 * 128; } }
#undef HG_LOADS
#undef HG_STORE
#undef HG_ADV
#undef HG_BODY
}

__global__ void __launch_bounds__(NTHR, 2) skel_fwd(Args args) {
    extern __shared__ __attribute__((aligned(16))) unsigned char lds[];
    Frame F;
    F.lds = (LAS unsigned char*)lds; F.MISC = (volatile LAS unsigned*)(F.lds + MISC_OFF);
    F.tid = threadIdx.x; F.lane = F.tid & 63; F.wave = __builtin_amdgcn_readfirstlane(F.tid >> 6);
    F.G = gridDim.x; { const int bx = blockIdx.x; F.vcu = (F.G % 8 == 0) ? (bx % 8) * (F.G / 8) + bx / 8 : bx; }
    F.ws = args.ws; F.ctl = (unsigned*)(args.ws + WS_CTL); F.out = args.out;
    F.xp = args.in[0]; F.xs = args.in[1]; F.ck = args.in[2]; F.cv = args.in[3]; F.clf = args.in[4]; F.sh = args.in[5]; F.n1 = args.in[6]; F.win = args.in[7]; F.bff = args.in[8];
    F.qg = args.in[9]; F.kg = args.in[10]; F.lbl = args.in[11]; F.hon = args.in[12]; F.wout = args.in[13]; F.n2 = args.in[14]; F.wup = args.in[15]; F.wdn = args.in[16];
    const int lo = args.ph_lo, hi = args.ph_hi;
#if defined(PROBE_A)
    unsigned long long ts_[9]; const bool stamper_ = (blockIdx.x == 0 && F.tid == 0);
#define STAMP(k) do { if (stamper_) ts_[k] = __builtin_amdgcn_s_memrealtime(); } while (0)
    STAMP(0);
#else
#define STAMP(k) do {} while (0)
#endif
#ifndef PH_MASK
#define PH_MASK 63
#endif
#define IN(k) (((PH_MASK >> (k)) & 1) && lo <= (k) && (k) < hi)
#define SEAM(k) do { if (IN(k) && IN((k) + 1)) { cg::this_grid().sync(); } } while (0)
    bf16* XB = (bf16*)(F.ws + WS_XB); bf16* X1B = (bf16*)(F.ws + WS_X1B); bf16* MIX = (bf16*)(F.ws + WS_MIX); bf16* HB = (bf16*)(F.ws + WS_H);
    if (IN(0)) { p0_prologue(F);
#if defined(DOUBLE_P0)
        cg::this_grid().sync(); p0_prologue(F);
#endif
    }
    SEAM(0); STAMP(1);
    const int bx = (int)blockIdx.x; const bool chainwg = bx < NCHAINWG; const int NWORK = F.G - NCHAINWG;
    if (IN(1)) {
#ifndef NO_SCAN
        for (int ch = F.vcu; ch < 128; ch += F.G) scan_chain(F, ch);
#endif
        pg8::Gemm g{XB, (const bf16*)(F.ws + WS_WIN), MTOT, NIN, DMOD, DMOD};
        pg8::EpiIn E{(const float*)(F.ws + WS_RSTD), F.lbl, F.qg, F.kg, F.ws, F.out};
#pragma nounroll
        for (int sub = 0; sub < 2; ++sub) {
            pg8::OrderIn S;
            if (sub == 0) { S.so.init(MP, 2048, F.G, bx); S.pn_off = 0; S.extra = 0; S.extra_pm0 = 0; }
            else { S.so.init(MTOT, NIN - 2048, NWORK, bx - NCHAINWG); S.pn_off = 8; S.extra = 8 * (MS / 256); S.extra_pm0 = MP / 256; }
            if (sub == 0 || !chainwg) pg8::gemm_phase<pg8::EpiIn, pg8::OrderIn, true, true>(F.lds, g, S, E);
            if (sub == 0) {
                cg::this_grid().sync(); STAMP(2);
                if (chainwg)
#if defined(DOUBLE_HGRN)
                for (int rep_ = 0; rep_ < 2; ++rep_)
#endif
                { const int bb = bx >> 2; hgrn_chain(F, bb * TSEQ, bb * (TSEQ / 64), TSEQ / 64, bx & 3, nullptr, F.out + O_HP + (size_t)bx * 16384); }
            }
        }
        asm volatile("s_waitcnt vmcnt(0)" ::: "memory"); __syncthreads();
        if (F.tid == 0) { unsigned* sc = F.ctl + CW_SUB;
            if (!chainwg) { __threadfence(); __hip_atomic_fetch_add(sc, 1u, __ATOMIC_RELAXED, __HIP_MEMORY_SCOPE_AGENT); }
            while (__hip_atomic_load(sc, __ATOMIC_RELAXED, __HIP_MEMORY_SCOPE_AGENT) < (unsigned)NWORK) __builtin_amdgcn_s_sleep(8);
            __threadfence(); }
        __syncthreads();
        if (chainwg) { const int bb = bx >> 2; hgrn_chain(F, MP + 64 * bb, MP / 64 + bb, 1, bx & 3, F.sh + (size_t)bx * 16384, F.out + O_HS + (size_t)bx * 16384); __syncthreads(); }
    }
    if (IN(2)) {
#ifndef NO_ATTN
        float prune_thr;
        { float mq = fabsf(F.qg[F.lane]), mk = fabsf(F.kg[F.lane]);
#pragma unroll
          for (int o = 1; o < 64; o <<= 1) { mq = fmaxf(mq, __shfl_xor(mq, o)); mk = fmaxf(mk, __shfl_xor(mk, o)); }
          prune_thr = 2.f * (8.f * mq * mk * LOG2E) + 150.f; }
        for (;;) {
            if (F.tid == 0) F.MISC[0] = atomicAdd(F.ctl + CW_QUEUE, 1u);
            __syncthreads();
            const int i = (int)F.MISC[0];
            __syncthreads();
            if (i >= 2048 + 64) break;
            typedef attn_body::bf16 abf;
            const bool smp = i >= 2048; const int j = smp ? i - 2048 : i;
            const int bh = j & 63, qb = 31 - (j >> 6), b = bh >> 3, h = bh & 7;
            const int q0 = smp ? SSEQ - 256 : 256 * qb, NT = (q0 + 256) / 64; int NTE = NT;
            const size_t rb = (size_t)b * (smp ? SSEQ : TSEQ);
            const float* cgp = (const float*)(F.ws + (smp ? WS_CGS : WS_CGP)) + (size_t)bh * (smp ? SSEQ : TSEQ);
#if FOX_PRUNE
            { const bool need = F.tid < NT && (cgp[q0] - cgp[64 * F.tid + 63] >= -prune_thr); const int needed = __syncthreads_count(need ? 1 : 0);
              NTE = (needed + 1) & ~1; NTE = NTE < 4 ? 4 : (NTE > NT ? NT : NTE); }
#endif
            const size_t orow = smp ? (size_t)(MP + 64 * b) - (size_t)(PAST - q0) : rb + q0;
            attn_body::attn_unit<8>((const abf*)(F.ws + (smp ? WS_QS : WS_Q)) + (rb + q0) * 512 + 64 * h, (const abf*)(F.ws + (smp ? WS_KS : WS_K)) + rb * 512 + 64 * h, (const abf*)(F.ws + (smp ? WS_VS : WS_V)) + rb * 512 + 64 * h,
                                    (abf*)MIX + orow * DMOD + 512 + 64 * h, NT, NTE, cgp, q0, smp ? (PAST - q0) / 32 : 0, smp ? (PAST - q0) / 32 + 1 : 8, (char*)lds);
        }
#endif
    }
    SEAM(2); STAMP(3);
    if (IN(3)) {
        pg8::Gemm g{MIX, (const bf16*)(F.ws + WS_WO), MTOT, DMOD, DMOD, DMOD}; pg8::StaticOrder S; S.init(MTOT, DMOD, F.G, (int)blockIdx.x);
        pg8::EpiWo E{XB, F.xs, F.out + O_YP, F.out + O_YS, X1B, (float*)(F.ws + WS_SSQ)};
#ifndef P3_STAGGER
#define P3_STAGGER 0
#endif
        if (P3_STAGGER) {
            const unsigned long long t0 = __builtin_amdgcn_s_memrealtime(), wait = (unsigned long long)(blockIdx.x & 15) * P3_STAGGER;
            while (__builtin_amdgcn_s_memrealtime() - t0 < wait) __builtin_amdgcn_s_sleep(4);
        }
        pg8::gemm_phase<pg8::EpiWo, pg8::StaticOrder, true, true>(F.lds, g, S, E);
#if defined(DOUBLE_P3)
        cg::this_grid().sync();
        pg8::gemm_phase<pg8::EpiWo, pg8::StaticOrder, true, true>(F.lds, g, S, E);
#endif
    }
    SEAM(3); STAMP(4);
    if (IN(4)) {
        pg8::Gemm g{X1B, (const bf16*)(F.ws + WS_WUP), MTOT, FF, DMOD, DMOD}; pg8::StaticOrder S; S.init(MTOT, FF, F.G, (int)blockIdx.x);
        pg8::EpiUp E{HB, (const float*)(F.ws + WS_SSQ)};
        pg8::gemm_phase<pg8::EpiUp, pg8::StaticOrder, true, true>(F.lds, g, S, E);
#if defined(DOUBLE_P4)
        cg::this_grid().sync();
        pg8::gemm_phase<pg8::EpiUp, pg8::StaticOrder, true, true>(F.lds, g, S, E);
#endif
    }
    SEAM(4); STAMP(5);
    if (IN(5)) {
#pragma nounroll
        for (int pass = 0; pass < 2; ++pass) {
            pg8::Gemm g{HB, (const bf16*)(F.ws + WS_WDN), MTOT, DMOD, pass ? FF : FF / pg8::OrderDown::KSPLIT, FF};
            pg8::OrderDown S; S.mode = pass; S.so.init(MP, DMOD, F.G, (int)blockIdx.x);
            pg8::EpiDown E{F.out + O_YP, F.out + O_YS, X1B, pass ? 0 : 1};
            pg8::gemm_phase<pg8::EpiDown, pg8::OrderDown, true, true>(F.lds, g, S, E);
        }
    }
    STAMP(6);
#if defined(PROBE_A)
    cg::this_grid().sync();
    if (stamper_) {
        unsigned long long da = ts_[PROBE_A + 1] - ts_[PROBE_A], db = ts_[PROBE_B + 1] - ts_[PROBE_B];
        unsigned qa = (unsigned)((da + 1250) / 2500), qb = (unsigned)((db + 1250) / 2500); if (qa > 63) qa = 63; if (qb > 63) qb = 63;
#if defined(PROBE_CAL)
        qa = 1000; qb = 0;
#endif
        const unsigned long long t0 = __builtin_amdgcn_s_memrealtime(), wait = 2000ull * (qa + 64 * qb);
        while (__builtin_amdgcn_s_memrealtime() - t0 < wait) __builtin_amdgcn_s_sleep(16);
    }
#endif
#undef IN
#undef SEAM
}

extern "C" void kernel_launch(void* const* d_in, const int* in_sizes, int n_in, void* d_out, int out_size, void* d_ws, size_t ws_size, hipStream_t stream) {
    static int grid = 0;
    if (grid == 0) {
        if (n_in != 17 || (size_t)out_size != O_END || ws_size < WS_END) { fprintf(stderr, "kernel_launch: unexpected shapes (n_in %d out %d ws %zu)\n", n_in, out_size, ws_size); grid = -1; return; }
        int dev = 0, cus = 0, per_cu = 0;
        if (hipGetDevice(&dev) != hipSuccess || hipDeviceGetAttribute(&cus, hipDeviceAttributeMultiprocessorCount, dev) != hipSuccess) { grid = -1; return; }
        if (hipFuncSetAttribute((const void*)skel_fwd, hipFuncAttributeMaxDynamicSharedMemorySize, LDS_BYTES) != hipSuccess) { fprintf(stderr, "kernel_launch: hipFuncSetAttribute failed\n"); grid = -1; return; }
        if (hipOccupancyMaxActiveBlocksPerMultiprocessor(&per_cu, (const void*)skel_fwd, NTHR, LDS_BYTES) != hipSuccess || per_cu < 1) { fprintf(stderr, "kernel_launch: occupancy query says %d\n", per_cu); per_cu = 1; }
        (void)hipGetLastError();
        grid = cus;
    }
    if (grid < 0) return;
    if (hipMemsetAsync((char*)d_ws + WS_CTL, 0, CTL_ZERO_BYTES, stream) != hipSuccess) { fprintf(stderr, "kernel_launch: memset failed\n"); return; }
    Args a{};
    for (int i = 0; i < 17; ++i) a.in[i] = (const float*)d_in[i];
    a.out = (float*)d_out; a.ws = (unsigned char*)d_ws;
#if MK_N_LAUNCHES == 1
    a.ph_lo = 0; a.ph_hi = 6;
    void* kargs[] = {&a};
    hipError_t e = hipLaunchCooperativeKernel((const void*)skel_fwd, dim3(grid), dim3(NTHR), kargs, LDS_BYTES, stream);
    if (e != hipSuccess) fprintf(stderr, "kernel_launch: cooperative launch failed: %s (grid %d)\n", hipGetErrorString(e), grid);
#else
    for (int li = 0; li < 6; ++li) { a.ph_lo = li; a.ph_hi = li + 1; hipLaunchKernelGGL(skel_fwd, dim3(grid), dim3(NTHR), LDS_BYTES, stream, a); }
#endif
}
```

```cpp
#include <hip/hip_runtime.h>
#include <cstdio>
#include <cstdint>
namespace pg8 {
#define PG8_LAS __attribute__((address_space(3)))
typedef unsigned short bf16_t;
typedef short bf16x8 __attribute__((ext_vector_type(8)));
typedef float f32x4 __attribute__((ext_vector_type(4)));
typedef unsigned u32x4 __attribute__((ext_vector_type(4)));
constexpr int BM = 256, BK = 64, HALF = 128, HTB = HALF * BK * 2  , STAGE_BYTES = 8 * HTB, NXCD = 8, WGM = 8;

__host__ __device__ __forceinline__ int lds_byte(int r, int c) { const int st = (r >> 4) * 2 + (c >> 5), rr = r & 15, cc = c & 31, ob = rr * 64 + cc * 2; return st * 1024 + (ob ^ (((ob >> 9) & 1) << 5)); }
__host__ __device__ __forceinline__ void stage_rc(int b, int& R, int& C) { const int st = b / 1024, sb = b % 1024, swz = sb ^ (((sb >> 9) & 1) << 5); R = (st >> 1) * 16 + swz / 64; C = (st & 1) * 32 + (swz % 64) / 2; }
__host__ __device__ __forceinline__ int perm32(int rho) { const int n = rho >> 4, i = rho & 15; return 8 * (i >> 2) + 4 * n + (i & 3); }

struct Unit { int pm, pn, kofs; };
struct Gemm { const bf16_t* A; const bf16_t* Bt; int M, N, K, ld; };

struct StaticOrder {
    int nM, nN, nwg, G, c;
    __host__ __device__ void init(int M, int N, int G_, int c_) { nM = M / BM; nN = N / BM; nwg = nM * nN; G = G_; c = c_; }
    __host__ __device__ bool next(int i, Unit& u) const {
        const long L = (long)i * G + c; if (L >= nwg) return false;
        int wgid = (int)L; { const int q = nwg / NXCD, r = nwg % NXCD, xcd = wgid % NXCD, off = wgid / NXCD; wgid = (xcd < r ? xcd * (q + 1) : r * (q + 1) + (xcd - r) * q) + off; }
        const int nig = WGM * nN, gid = wgid / nig, fm = gid * WGM, gsz = (nM - fm) < WGM ? (nM - fm) : WGM;
        u.pm = fm + ((wgid % nig) % gsz); u.pn = (wgid % nig) / gsz; u.kofs = 0; return true;
    }
    __device__ __forceinline__ void a_ready(const Unit&) const {}
    __device__ __forceinline__ void done(const Unit&) const {}
};

__device__ __forceinline__ unsigned cvt_pk_bf16(float lo, float hi) { unsigned r; asm volatile("v_cvt_pk_bf16_f32 %0, %1, %2" : "=v"(r) : "v"(lo), "v"(hi)); return r; }
typedef float f32x2 __attribute__((ext_vector_type(2)));
template <class Epi, class Sched, bool ALIGN_EPI = false, bool SP2 = false>
__device__ __forceinline__ void gemm_phase(PG8_LAS unsigned char* lds, const Gemm g, const Sched& S, const Epi& E) {
    const int tid = threadIdx.x, wid = __builtin_amdgcn_readfirstlane(tid >> 6), lane = tid & 63, wr = wid >> 2, wc = wid & 3, fr = lane & 15, fq = lane >> 4;
    const int K = g.ld, nt = g.K / BK;
    unsigned voffA[2], voffB[2];
#pragma unroll
    for (int i = 0; i < 2; ++i) { int R, C; stage_rc(tid * 16 + i * 8192, R, C); const int Rb = Epi::PERM ? ((R & ~31) + perm32(R & 31)) : R;
        voffA[i] = (unsigned)(R * K + C) * 2u; voffB[i] = (unsigned)(Rb * K + C) * 2u; }
    const size_t kstep = (size_t)(BK * 2);
    const size_t hstep = (size_t)HALF * K * 2;
    const size_t tstep = 2 * hstep;
    const unsigned ldsw = (unsigned)wid * 1024u;
    const int aoff = lds_byte(wr * 64 + fr, fq * 8), boff = lds_byte(wc * 32 + fr, fq * 8);
#define PG8_SA(b, h) (((b) * 2 + (h)) * HTB)
#define PG8_SB(b, h) ((4 + (b) * 2 + (h)) * HTB)
#define PG8_STAGE(bufoff, gbase, voff) do { _Pragma("unroll") for (int _i = 0; _i < 2; ++_i) \
        __builtin_amdgcn_global_load_lds((const unsigned*)((const char*)(gbase) + (voff)[_i]), (PG8_LAS unsigned*)(lds + (bufoff) + ldsw + _i * 8192), 16, 0, 0); } while (0)
#define PG8_LDA(dst, b, h) do { _Pragma("unroll") for (int m = 0; m < 4; ++m) _Pragma("unroll") for (int k = 0; k < 2; ++k) dst[m][k] = *(const PG8_LAS bf16x8*)(lds + PG8_SA(b, h) + aoff + m * 2048 + k * 1024); } while (0)
#define PG8_LDB(dst, b, h) do { _Pragma("unroll") for (int n = 0; n < 2; ++n) _Pragma("unroll") for (int k = 0; k < 2; ++k) dst[n][k] = *(const PG8_LAS bf16x8*)(lds + PG8_SB(b, h) + boff + n * 2048 + k * 1024); } while (0)
#define PG8_MMA(ai, bj, At, Bt) do { __builtin_amdgcn_s_setprio(1); _Pragma("unroll") for (int m = 0; m < 4; ++m) _Pragma("unroll") for (int n = 0; n < 2; ++n) _Pragma("unroll") for (int k = 0; k < 2; ++k) \
        acc[ai][bj][m][n] = __builtin_amdgcn_mfma_f32_16x16x32_bf16(Bt[n][k], At[m][k], acc[ai][bj][m][n], 0, 0, 0); __builtin_amdgcn_s_setprio(0); } while (0)
#define PG8_WAIT_V(n) asm volatile("s_waitcnt vmcnt(" #n ")" ::: "memory")
#define PG8_WAIT_L(n) asm volatile("s_waitcnt lgkmcnt(" #n ")" ::: "memory")
#define PG8_BAR __builtin_amdgcn_s_barrier()
#define PG8_SCHED __builtin_amdgcn_sched_barrier(0)
    Unit cur, nxt; int ui = 0;
    if (!S.next(0, cur)) return;
    f32x4 acc[2][2][4][2];
#pragma unroll
    for (int a = 0; a < 2; ++a)
#pragma unroll
        for (int b = 0; b < 2; ++b)
#pragma unroll
            for (int m = 0; m < 4; ++m)
#pragma unroll
                for (int n = 0; n < 2; ++n) acc[a][b][m][n] = (f32x4){0.f, 0.f, 0.f, 0.f};
    bf16x8 At[4][2], B0[2][2], B1[2][2];
    const char* cA = (const char*)g.A + (size_t)cur.pm * tstep + (size_t)cur.kofs * 2; const char* cB = (const char*)g.Bt + (size_t)cur.pn * tstep + (size_t)cur.kofs * 2;
    S.a_ready(cur);
    if constexpr (SP2) {
        PG8_STAGE(PG8_SB(0, 0), cB, voffB); PG8_STAGE(PG8_SB(0, 1), cB + hstep, voffB); PG8_STAGE(PG8_SA(0, 0), cA, voffA); PG8_STAGE(PG8_SA(0, 1), cA + hstep, voffA);
        if (wr == 1) PG8_BAR;
        PG8_WAIT_V(2); PG8_BAR;
        PG8_STAGE(PG8_SB(1, 0), cB + kstep, voffB); PG8_STAGE(PG8_SA(1, 0), cA + kstep, voffA); PG8_STAGE(PG8_SB(1, 1), cB + hstep + kstep, voffB);
        PG8_WAIT_V(6); PG8_BAR;
    } else {
        PG8_STAGE(PG8_SB(0, 0), cB, voffB); PG8_STAGE(PG8_SA(0, 0), cA, voffA); PG8_STAGE(PG8_SB(0, 1), cB + hstep, voffB); PG8_STAGE(PG8_SA(0, 1), cA + hstep, voffA);
        if (wr == 1) PG8_BAR;
        PG8_WAIT_V(4); PG8_BAR;
        PG8_STAGE(PG8_SB(1, 0), cB + kstep, voffB); PG8_STAGE(PG8_SA(1, 0), cA + kstep, voffA); PG8_STAGE(PG8_SB(1, 1), cB + hstep + kstep, voffB);
        PG8_WAIT_V(6); PG8_BAR;
    }
    for (;;) {
        const bool has_next = S.next(ui + 1, nxt);
        const char* nA = has_next ? (const char*)g.A + (size_t)nxt.pm * tstep + (size_t)nxt.kofs * 2 : cA; const char* nB = has_next ? (const char*)g.Bt + (size_t)nxt.pn * tstep + (size_t)nxt.kofs * 2 : cB;
        for (int t = 0; t < nt; t += 2) {
            const bool last = (t == nt - 2);
            const char* a1 = cA + (size_t)(t + 1) * kstep;
            const char* a2 = last ? nA : cA + (size_t)(t + 2) * kstep; const char* b2 = last ? nB : cB + (size_t)(t + 2) * kstep;
            const char* a3 = a2 + kstep; const char* b3 = b2 + kstep;
            if (last && has_next) S.a_ready(nxt);
            if constexpr (SP2) {
            PG8_LDB(B0, 0, 0); PG8_LDB(B1, 0, 1); PG8_SCHED; PG8_LDA(At, 0, 0); PG8_STAGE(PG8_SA(1, 1), a1 + hstep, voffA);
            PG8_WAIT_V(8); PG8_WAIT_L(0); PG8_BAR; PG8_MMA(0, 0, At, B0); PG8_MMA(0, 1, At, B1); PG8_BAR; PG8_SCHED;
            PG8_LDA(At, 0, 1); PG8_STAGE(PG8_SB(0, 0), b2, voffB); PG8_STAGE(PG8_SB(0, 1), b2 + hstep, voffB); PG8_STAGE(PG8_SA(0, 0), a2, voffA);
            PG8_WAIT_V(8); PG8_WAIT_L(0); PG8_BAR; PG8_MMA(1, 0, At, B0); PG8_MMA(1, 1, At, B1); PG8_BAR; PG8_SCHED;
            PG8_LDB(B0, 1, 0); PG8_LDB(B1, 1, 1); PG8_SCHED; PG8_LDA(At, 1, 0); PG8_STAGE(PG8_SA(0, 1), a2 + hstep, voffA);
            PG8_WAIT_V(8); PG8_WAIT_L(0); PG8_BAR; PG8_MMA(0, 0, At, B0); PG8_MMA(0, 1, At, B1); PG8_BAR; PG8_SCHED;
            PG8_LDA(At, 1, 1); PG8_STAGE(PG8_SB(1, 0), b3, voffB); PG8_STAGE(PG8_SB(1, 1), b3 + hstep, voffB); PG8_STAGE(PG8_SA(1, 0), a3, voffA);
            PG8_WAIT_V(8); PG8_WAIT_L(0); PG8_BAR; PG8_MMA(1, 0, At, B0); PG8_MMA(1, 1, At, B1); PG8_BAR; PG8_SCHED;
            } else {
            PG8_LDB(B0, 0, 0); PG8_SCHED; PG8_LDA(At, 0, 0); PG8_STAGE(PG8_SA(1, 1), a1 + hstep, voffA);
            PG8_WAIT_L(8); PG8_BAR; PG8_WAIT_L(0); PG8_MMA(0, 0, At, B0); PG8_BAR; PG8_SCHED;
            PG8_LDB(B1, 0, 1); PG8_STAGE(PG8_SB(0, 0), b2, voffB);
            PG8_BAR; PG8_WAIT_L(0); PG8_MMA(0, 1, At, B1); PG8_BAR;
            PG8_LDA(At, 0, 1); PG8_STAGE(PG8_SA(0, 0), a2, voffA);
            PG8_BAR; PG8_WAIT_L(0); PG8_MMA(1, 0, At, B0); PG8_BAR; PG8_SCHED;
            PG8_STAGE(PG8_SB(0, 1), b2 + hstep, voffB);
            PG8_WAIT_V(6); PG8_BAR; PG8_MMA(1, 1, At, B1); PG8_BAR;
            PG8_LDB(B0, 1, 0); PG8_SCHED; PG8_LDA(At, 1, 0); PG8_STAGE(PG8_SA(0, 1), a2 + hstep, voffA);
            PG8_WAIT_L(8); PG8_BAR; PG8_WAIT_L(0); PG8_MMA(0, 0, At, B0); PG8_BAR; PG8_SCHED;
            PG8_LDB(B1, 1, 1); PG8_STAGE(PG8_SB(1, 0), b3, voffB);
            PG8_BAR; PG8_WAIT_L(0); PG8_MMA(0, 1, At, B1); PG8_BAR;
            PG8_LDA(At, 1, 1); PG8_STAGE(PG8_SA(1, 0), a3, voffA);
            PG8_BAR; PG8_WAIT_L(0); PG8_MMA(1, 0, At, B0); PG8_BAR; PG8_SCHED;
            PG8_STAGE(PG8_SB(1, 1), b3 + hstep, voffB);
            PG8_WAIT_V(6); PG8_BAR; PG8_MMA(1, 1, At, B1); PG8_BAR;
            }
        }
        if constexpr (ALIGN_EPI) { if (wr == 0) PG8_BAR; }
        if constexpr (!Epi::AFTER_DRAIN) { E(acc, cur, wr, wc, fr, fq); S.done(cur); }
        if (!has_next) break;
#pragma unroll
        for (int a = 0; a < 2; ++a)
#pragma unroll
            for (int b = 0; b < 2; ++b)
#pragma unroll
                for (int m = 0; m < 4; ++m)
#pragma unroll
                    for (int n = 0; n < 2; ++n) acc[a][b][m][n] = (f32x4){0.f, 0.f, 0.f, 0.f};
        cur = nxt; cA = nA; cB = nB; ++ui;
        if constexpr (ALIGN_EPI) { if (wr == 1) PG8_BAR; }
    }
    PG8_WAIT_V(0);
    if constexpr (!ALIGN_EPI) { if (wr == 0) PG8_BAR; }
    PG8_BAR;
    if constexpr (Epi::AFTER_DRAIN) { E.fused(acc, cur, wr, wc, fr, fq, lds, wid, lane); S.done(cur); }
#undef PG8_SA
#undef PG8_SB
#undef PG8_STAGE
#undef PG8_LDA
#undef PG8_LDB
#undef PG8_MMA
#undef PG8_WAIT_V
#undef PG8_WAIT_L
#undef PG8_BAR
#undef PG8_SCHED
}
}
#include <hip/hip_bf16.h>
#include <cmath>
namespace attn_body {
using bf16=__hip_bfloat16;
using bf16x8=__attribute__((ext_vector_type(8)))short;
using s16x4=__attribute__((ext_vector_type(4)))short;
using f32x16=__attribute__((ext_vector_type(16)))float;
using u32x4=__attribute__((ext_vector_type(4)))unsigned;
constexpr int NHEAD=8,D=64,DM=NHEAD*D,OPITCH=1024;
constexpr int NW=8,QBLK=32,QB=QBLK*NW,KVBLK=64;
constexpr int ATTN_PITCH=DM, ATTN_UNIT_ROWS=QB;
__device__ __forceinline__ int crow(int r,int hi){return (r&3)+8*(r>>2)+4*hi;}
#define SBAR() __builtin_amdgcn_sched_barrier(0)
__device__ __forceinline__ void cmask(f32x16&p0,f32x16&p1,int jb,int qrel,int hi){
  const float NEG=-INFINITY; int kb=64*jb+4*hi;
  #pragma unroll
  for(int r=0;r<16;++r){int kv=kb+(r&3)+8*(r>>2); if(kv>qrel)p0[r]=NEG; if(kv+32>qrel)p1[r]=NEG;}
}

constexpr int NSLOT=3, SLOTB=8192;
constexpr int LDS_K=0, LDS_V=NSLOT*SLOTB, LDS_WS=2*NSLOT*SLOTB, LDS_OST=LDS_WS+NW*64*4, LDS_CB=LDS_OST+NW*4096, LDS_BYTES=LDS_CB+32768;
constexpr float C2=0.125f*1.4426950408889634f;
__device__ __forceinline__ void glds16(const void*gsrc,unsigned lds_dst){unsigned keep;
  asm volatile("s_mov_b32 %0, m0\n\ts_mov_b32 m0, %2\n\ts_nop 0\n\tglobal_load_lds_dwordx4 %1, off\n\ts_mov_b32 m0, %0":"=&s"(keep):"v"(gsrc),"s"(lds_dst):"memory");}
__device__ __forceinline__ float max3f(float a,float b,float c){float r;asm("v_max3_f32 %0, %1, %2, %3":"=v"(r):"v"(a),"v"(b),"v"(c));return r;}
__device__ __forceinline__ float max2f(float a,float b){float r;asm("v_max_f32_e32 %0, %1, %2":"=v"(r):"v"(a),"v"(b));return r;}
__device__ __forceinline__ float fadd_s(float a,float b){float r;asm("v_add_f32_e32 %0, %1, %2":"=v"(r):"v"(a),"v"(b));return r;}
__device__ __forceinline__ float fsub_s(float a,float b){float r;asm("v_sub_f32_e32 %0, %1, %2":"=v"(r):"v"(a),"v"(b));return r;}
typedef float f32x2_t __attribute__((ext_vector_type(2))); typedef float f32x4_t __attribute__((ext_vector_type(4))); typedef __bf16 bf16x2_t __attribute__((ext_vector_type(2)));
__device__ __forceinline__ unsigned cvtpk_s(float lo,float hi){f32x2_t v={lo,hi};bf16x2_t b=__builtin_convertvector(v,bf16x2_t);return __builtin_bit_cast(unsigned,b);}
#define WAIT_BAR(N) asm volatile("s_waitcnt vmcnt(" #N ") lgkmcnt(0)\n\ts_barrier":::"memory")

__device__ __forceinline__ void qkt(f32x16&p0,f32x16&p1,const char*Kslot,const bf16x8*qr,int r32,int hi){
  const char*kb=Kslot+hi*1024+r32*16;
  #pragma unroll
  for(int d0=0;d0<4;++d0){
    const bf16x8 b0=*reinterpret_cast<const bf16x8*>(kb+d0*2048);
    const bf16x8 b1=*reinterpret_cast<const bf16x8*>(kb+d0*2048+512);
    p0=__builtin_amdgcn_mfma_f32_32x32x16_bf16(b0,qr[d0],p0,0,0,0);p1=__builtin_amdgcn_mfma_f32_32x32x16_bf16(b1,qr[d0],p1,0,0,0);}
}
typedef __attribute__((address_space(3))) const char* lds_cptr;
typedef short v4i16_t __attribute__((ext_vector_type(4)));
__device__ __forceinline__ void kload8(bf16x8*kf,lds_cptr kp){
  kf[0]=*(const __attribute__((address_space(3))) bf16x8*)(kp);      kf[1]=*(const __attribute__((address_space(3))) bf16x8*)(kp+512);
  kf[2]=*(const __attribute__((address_space(3))) bf16x8*)(kp+2048); kf[3]=*(const __attribute__((address_space(3))) bf16x8*)(kp+2560);
  kf[4]=*(const __attribute__((address_space(3))) bf16x8*)(kp+4096); kf[5]=*(const __attribute__((address_space(3))) bf16x8*)(kp+4608);
  kf[6]=*(const __attribute__((address_space(3))) bf16x8*)(kp+6144); kf[7]=*(const __attribute__((address_space(3))) bf16x8*)(kp+6656);
}
__device__ __forceinline__ void kload2(bf16x8*kf,lds_cptr kp,int j){ kf[2*j]=*(const __attribute__((address_space(3))) bf16x8*)(kp+j*2048); kf[2*j+1]=*(const __attribute__((address_space(3))) bf16x8*)(kp+j*2048+512); }
__device__ __forceinline__ s16x4 vtr(lds_cptr p){ return __builtin_bit_cast(s16x4,__builtin_amdgcn_ds_read_tr16_b64_v4i16((__attribute__((address_space(3))) v4i16_t*)p)); }
__device__ __forceinline__ float rowmax(const f32x16&p0,const f32x16&p1){
  float a=max3f(p0[0],p0[1],p1[0]),b=max3f(p0[2],p0[3],p1[1]);a=max3f(a,p1[2],p1[3]);
  #pragma unroll
  for(int r=4;r<16;r+=4){a=max3f(a,p0[r],p0[r+1]);b=max3f(b,p0[r+2],p0[r+3]);a=max3f(a,p1[r],p1[r+1]);b=max3f(b,p1[r+2],p1[r+3]);}
  const float m=max2f(a,b);
  auto rr=__builtin_amdgcn_permlane32_swap(__float_as_uint(m),__float_as_uint(m),false,false);
  return max2f(__uint_as_float(rr[0]),__uint_as_float(rr[1]));
}
__device__ __forceinline__ void pv(f32x16*o,int vb,bf16x8 pa0,bf16x8 pa1,bf16x8 pa2,bf16x8 pa3){
  #pragma unroll
  for(int d0=0;d0<2;++d0){s16x4 lo[4],hi[4];
    #pragma unroll
    for(int ks=0;ks<4;++ks){
      asm volatile("ds_read_b64_tr_b16 %0,%1 offset:%c2":"=&v"(lo[ks]):"v"(vb),"i"(d0*4096+ks*1024):"memory");
      asm volatile("ds_read_b64_tr_b16 %0,%1 offset:%c2":"=&v"(hi[ks]):"v"(vb),"i"(d0*4096+ks*1024+512):"memory");}
    asm volatile("s_waitcnt lgkmcnt(0)":::"memory");SBAR();
    #define PK(k) (bf16x8){lo[k][0],lo[k][1],lo[k][2],lo[k][3],hi[k][0],hi[k][1],hi[k][2],hi[k][3]}
    o[d0]=__builtin_amdgcn_mfma_f32_32x32x16_bf16(pa0,PK(0),o[d0],0,0,0);
    o[d0]=__builtin_amdgcn_mfma_f32_32x32x16_bf16(pa1,PK(1),o[d0],0,0,0);
    o[d0]=__builtin_amdgcn_mfma_f32_32x32x16_bf16(pa2,PK(2),o[d0],0,0,0);
    o[d0]=__builtin_amdgcn_mfma_f32_32x32x16_bf16(pa3,PK(3),o[d0],0,0,0);
    #undef PK
  }
}

#ifndef ATTN_STORE16
#define ATTN_STORE16(p,v) (*(u32x4*)(p)=(v))
#endif
template<int THRL> __device__ __forceinline__ void attn_unit(const bf16*Qb,const bf16*__restrict__ Kh,const bf16*__restrict__ Vh,bf16*Ob,int NT,int NTE,const float*cgp,int q0,int wlo,int whi,char*shm){
  int tid_=threadIdx.x; asm volatile("":"+v"(tid_)); const int tid=tid_,lane=tid&63,r32=lane&31,hi=lane>>5; const int wid=__builtin_amdgcn_readfirstlane(tid>>6);
  const bf16*Qw=Qb+(long)(wid*QBLK)*DM;
  const unsigned lds0=(unsigned)(uintptr_t)shm;
  float*wsf=(float*)(shm+LDS_WS)+wid*64;
  const bf16*ksrc=Kh+(long)((NT-1)*KVBLK+lane)*DM+wid*8;
  const bf16*vsrc=Vh+(long)((NT-1)*KVBLK+16*(wid&3)+(lane>>2))*DM+(wid>>2)*32+(lane&3)*8;
  const unsigned kdst=lds0+LDS_K+wid*1024, vdst=lds0+LDS_V+wid*1024;
  #define DMA_K(t,slot) glds16(ksrc-(long)(t)*KVBLK*DM,(unsigned)__builtin_amdgcn_readfirstlane(kdst+(slot)))
  #define DMA_V(t,slot) glds16(vsrc-(long)(t)*KVBLK*DM,(unsigned)__builtin_amdgcn_readfirstlane(vdst+(slot)))
  const int vb0=(int)(lds0+LDS_V)+((lane>>4)&1)*32+(lane&3)*8+(4*hi+((lane&15)>>2))*64;
  const char*Kbase=shm+LDS_K; bf16x8 kf[8];
  const lds_cptr shm3=(lds_cptr)shm; const lds_cptr kp0=shm3+LDS_K+hi*1024+r32*16; const lds_cptr vp0=shm3+LDS_V+((lane>>4)&1)*32+(lane&3)*8+(4*hi+((lane&15)>>2))*64;
  { typedef __attribute__((address_space(3))) float lf_t; lf_t* cbw=(lf_t*)((lds_cptr)shm+LDS_CB); const float c0=cgp[q0]; const int jlo=(NT-NTE)*KVBLK, jhi=NT*KVBLK;
    for(int j=jlo+tid;j<jhi;j+=NW*64) cbw[j]=c0-cgp[j]; }
  const __attribute__((address_space(3))) float* cbL=(const __attribute__((address_space(3))) float*)((lds_cptr)shm+LDS_CB)+4*hi;
  #define CBLOAD(C0,C1,t,MH) do{ const __attribute__((address_space(3))) float* cbp_=cbL+(NT-1-(t))*KVBLK; \
    _Pragma("unroll") for(int g_=0;g_<4;++g_){ const f32x4_t v0_=*(const __attribute__((address_space(3))) f32x4_t*)(cbp_+8*g_); const f32x4_t v1_=*(const __attribute__((address_space(3))) f32x4_t*)(cbp_+32+8*g_); \
      C0[4*g_]=v0_[0]-(MH);C0[4*g_+1]=v0_[1]-(MH);C0[4*g_+2]=v0_[2]-(MH);C0[4*g_+3]=v0_[3]-(MH); C1[4*g_]=v1_[0]-(MH);C1[4*g_+1]=v1_[1]-(MH);C1[4*g_+2]=v1_[2]-(MH);C1[4*g_+3]=v1_[3]-(MH);} }while(0)
  DMA_K(0,0);DMA_V(0,0);DMA_K(1,SLOTB);
  bf16x8 qr[4];
  #pragma unroll
  for(int d0=0;d0<4;++d0)qr[d0]=*reinterpret_cast<const bf16x8*>(&Qw[(long)r32*DM+d0*16+hi*8]);
  float mhat=0.f,l_reg=0.f;f32x16 o[2];o[0]=f32x16{};o[1]=f32x16{};
  const int qrel=wid*QBLK+r32;
  #define CMASK(P0,P1,t) do{int jb_=3-(t); if(jb_>=0)cmask(P0,P1,jb_,qrel,hi);}while(0)
  bool resc=false;
  #define START(P0,P1) do{ const float rm=rowmax(P0,P1); resc=false; \
    { const float dl=(rm>-1e30f)?rm:0.f; mhat=fadd_s(mhat,dl); \
      _Pragma("unroll") for(int r=0;r<16;++r){P0[r]=fsub_s(P0[r],dl);P1[r]=fsub_s(P1[r],dl);} } \
    _Pragma("unroll") for(int r=0;r<16;++r)P0[r]=__builtin_amdgcn_exp2f(P0[r]); }while(0)
  #define RESC() do{ if(resc){ asm volatile("s_waitcnt lgkmcnt(0)":::"memory"); \
      _Pragma("unroll") for(int d_=0;d_<2;++d_) _Pragma("unroll") for(int r=0;r<16;++r)o[d_][r]*=wsf[crow(r,hi)]; } }while(0)
  f32x16 pA0,pA1,pB0,pB1;
  int sl_prev=0,sl_cur=0,sl_next=SLOTB;
  #define ROT() do{sl_prev=sl_cur;sl_cur=sl_next;sl_next=(sl_next==(NSLOT-1)*SLOTB)?0:sl_next+SLOTB;}while(0)
  DMA_K(2,2*SLOTB);
  WAIT_BAR(3);
  CBLOAD(pA0,pA1,0,0.f); qkt(pA0,pA1,Kbase,qr,r32,hi);asm volatile("s_nop 15\n\ts_nop 7":"+v"(pA0),"+v"(pA1));CMASK(pA0,pA1,0);
  START(pA0,pA1);
  _Pragma("unroll") for(int r=0;r<16;++r)pA1[r]=__builtin_amdgcn_exp2f(pA1[r]);
  WAIT_BAR(0);
  DMA_K(3,0);DMA_V(1,SLOTB);
  ROT();
  kload8(kf,kp0+sl_cur);
  WAIT_BAR(2);
  s16x4 vlo[8],vhi[8]; u32x4 pw0,pw1,pw2,pw3;
  #define PKW(P,B) cvtpk_s(P[B],P[B+1])
  #define PAF(k) __builtin_bit_cast(bf16x8,pw##k)
  #define VFR(i) (bf16x8){vlo[i][0],vlo[i][1],vlo[i][2],vlo[i][3],vhi[i][0],vhi[i][1],vhi[i][2],vhi[i][3]}
  #define PIN(x) asm volatile("":"+v"(x))
  #define MX3(a,b,c) __builtin_fmaxf(__builtin_fmaxf((a),(b)),(c))
  #define GAPA(MF,A0,A1,A2,A3,W0,W1,PW) do{ MF; sacc+=A0; sacc+=A1; sacc+=A2; sacc+=A3; PIN(sacc); W0; W1; PIN(PW); SBAR(); }while(0)
  #define EX(v) __builtin_amdgcn_exp2f(v)
  #define GAPB(MF,X,B) do{ MF; X[B]=EX(X[B]); X[B+1]=EX(X[B+1]); X[B+2]=EX(X[B+2]); X[B+3]=EX(X[B+3]); PIN(X); SBAR(); }while(0)
  #define VRD(i) do{ vlo[i]=vtr(vp_+(((i)>>2)*4096+((i)&3)*1024)); vhi[i]=vtr(vp_+(((i)>>2)*4096+((i)&3)*1024+512)); }while(0)
  #define KRD(G,j) do{ if(G){ kload2(kf,kp0+sl_next,j); SBAR(); } }while(0)
  #define STEP(C0,C1,P0,P1,t,GK,GV,GL) do{ SBAR(); \
    const lds_cptr vp_=vp0+sl_prev; CBLOAD(C0,C1,t,mhat); SBAR(); \
    VRD(0); SBAR(); float sacc=(P0[0]+P0[1]); \
    GAPA(C0=__builtin_amdgcn_mfma_f32_32x32x16_bf16(kf[0],qr[0],C0,0,0,0), P0[2],P0[3],P0[4],P0[5],     pw0[0]=PKW(P0,0), pw0[1]=PKW(P0,2), pw0); \
    VRD(4); SBAR(); GAPA(C1=__builtin_amdgcn_mfma_f32_32x32x16_bf16(kf[1],qr[0],C1,0,0,0), P0[6],P0[7],P0[8],P0[9],     pw0[2]=PKW(P0,4), pw0[3]=PKW(P0,6), pw0); \
    VRD(1); SBAR(); GAPA(C0=__builtin_amdgcn_mfma_f32_32x32x16_bf16(kf[2],qr[1],C0,0,0,0),   P0[10],P0[11],P0[12],P0[13], pw1[0]=PKW(P0,8), pw1[1]=PKW(P0,10), pw1); \
    VRD(5); SBAR(); GAPA(C1=__builtin_amdgcn_mfma_f32_32x32x16_bf16(kf[3],qr[1],C1,0,0,0),   P0[14],P0[15],P1[0],P1[1],   pw1[2]=PKW(P0,12),pw1[3]=PKW(P0,14), pw1); \
    VRD(2); SBAR(); GAPA(C0=__builtin_amdgcn_mfma_f32_32x32x16_bf16(kf[4],qr[2],C0,0,0,0),   P1[2],P1[3],P1[4],P1[5],     pw2[0]=PKW(P1,0), pw2[1]=PKW(P1,2), pw2); \
    VRD(6); SBAR(); GAPA(C1=__builtin_amdgcn_mfma_f32_32x32x16_bf16(kf[5],qr[2],C1,0,0,0),   P1[6],P1[7],P1[8],P1[9],     pw2[2]=PKW(P1,4), pw2[3]=PKW(P1,6), pw2); \
    VRD(3); SBAR(); GAPA(C0=__builtin_amdgcn_mfma_f32_32x32x16_bf16(kf[6],qr[3],C0,0,0,0),   P1[10],P1[11],P1[12],P1[13], pw3[0]=PKW(P1,8), pw3[1]=PKW(P1,10), pw3); \
    VRD(7); SBAR(); GAPA(C1=__builtin_amdgcn_mfma_f32_32x32x16_bf16(kf[7],qr[3],C1,0,0,0),   P1[14],P1[15],0.f,0.f,       pw3[2]=PKW(P1,12),pw3[3]=PKW(P1,14), pw3); \
    l_reg+=sacc; \
    if(GK){DMA_K((t)+3,sl_cur);} if(GV){DMA_V((t)+1,sl_next);} \
    CMASK(C0,C1,t); \
    { float a=MX3(C0[0],C0[1],C1[0]),b=MX3(C0[2],C0[3],C1[1]); a=MX3(a,C1[2],C1[3]); \
      _Pragma("unroll") for(int r=4;r<16;r+=4){a=MX3(a,C0[r],C0[r+1]);b=MX3(b,C0[r+2],C0[r+3]);a=MX3(a,C1[r],C1[r+1]);b=MX3(b,C1[r+2],C1[r+3]);} \
      float rm=__builtin_fmaxf(a,b); { auto rr=__builtin_amdgcn_permlane32_swap(__float_as_uint(rm),__float_as_uint(rm),false,false); rm=__builtin_fmaxf(__uint_as_float(rr[0]),__uint_as_float(rr[1])); } \
      resc=false; \
      if(__builtin_expect(__any(rm>(float)THRL),0)){ const float dl=__builtin_fmaxf(rm,0.f); mhat+=dl; \
        _Pragma("unroll") for(int r=0;r<16;++r){C0[r]-=dl;C1[r]-=dl;} \
        const float f=__builtin_amdgcn_exp2f(-dl); l_reg*=f; if(hi==0)wsf[r32]=f; resc=true; } } \
    SBAR(); \
    GAPB(o[0]=__builtin_amdgcn_mfma_f32_32x32x16_bf16(PAF(0),VFR(0),o[0],0,0,0), C0,0); \
    GAPB(o[1]=__builtin_amdgcn_mfma_f32_32x32x16_bf16(PAF(0),VFR(4),o[1],0,0,0), C0,4); \
    KRD(GL,0); GAPB(o[0]=__builtin_amdgcn_mfma_f32_32x32x16_bf16(PAF(1),VFR(1),o[0],0,0,0), C0,8); \
    KRD(GL,1); GAPB(o[1]=__builtin_amdgcn_mfma_f32_32x32x16_bf16(PAF(1),VFR(5),o[1],0,0,0), C0,12); \
    KRD(GL,2); GAPB(o[0]=__builtin_amdgcn_mfma_f32_32x32x16_bf16(PAF(2),VFR(2),o[0],0,0,0), C1,0); \
    KRD(GL,3); GAPB(o[1]=__builtin_amdgcn_mfma_f32_32x32x16_bf16(PAF(2),VFR(6),o[1],0,0,0), C1,4); \
    GAPB(o[0]=__builtin_amdgcn_mfma_f32_32x32x16_bf16(PAF(3),VFR(3),o[0],0,0,0), C1,8); \
    GAPB(o[1]=__builtin_amdgcn_mfma_f32_32x32x16_bf16(PAF(3),VFR(7),o[1],0,0,0), C1,12); \
    }while(0)
  int t=1;
  for(;t<5&&t+5<NTE;t+=2){
    STEP(pB0,pB1,pA0,pA1,t,true,true,true);     WAIT_BAR(2); RESC(); ROT();
    STEP(pA0,pA1,pB0,pB1,t+1,true,true,true);   WAIT_BAR(2); RESC(); ROT();
  }
  #undef CMASK
  #define CMASK(P0,P1,t) do{}while(0)
  for(;t+5<NTE;t+=2){
    STEP(pB0,pB1,pA0,pA1,t,true,true,true);     WAIT_BAR(2); RESC(); ROT();
    STEP(pA0,pA1,pB0,pB1,t+1,true,true,true);   WAIT_BAR(2); RESC(); ROT();
  }
  #undef CMASK
  #define CMASK(P0,P1,t) do{int jb_=3-(t); if(jb_>=0)cmask(P0,P1,jb_,qrel,hi);}while(0)
  #define ENDW(tt) do{ if((tt)+3<NTE){WAIT_BAR(2);} else if((tt)+2<NTE){WAIT_BAR(1);} else {WAIT_BAR(0);} }while(0)
  for(;t+1<NTE;t+=2){
    STEP(pB0,pB1,pA0,pA1,t,(t+3<NTE),(t+1<NTE),(t+1<NTE));       ENDW(t);   RESC(); ROT();
    STEP(pA0,pA1,pB0,pB1,t+1,(t+4<NTE),(t+2<NTE),(t+2<NTE));     ENDW(t+1); RESC(); ROT();
  }
  STEP(pB0,pB1,pA0,pA1,NTE-1,false,false,false); RESC();
  { float sacc=pB0[0]+pB0[1]; _Pragma("unroll") for(int r=2;r<16;++r)sacc+=pB0[r]; _Pragma("unroll") for(int r=0;r<16;++r)sacc+=pB1[r]; l_reg+=sacc;
    pw0=(u32x4){PKW(pB0,0),PKW(pB0,2),PKW(pB0,4),PKW(pB0,6)};pw1=(u32x4){PKW(pB0,8),PKW(pB0,10),PKW(pB0,12),PKW(pB0,14)};pw2=(u32x4){PKW(pB1,0),PKW(pB1,2),PKW(pB1,4),PKW(pB1,6)};pw3=(u32x4){PKW(pB1,8),PKW(pB1,10),PKW(pB1,12),PKW(pB1,14)};
    SBAR(); pv(o,vb0+sl_cur,PAF(0),PAF(1),PAF(2),PAF(3)); }
  #undef PKW
  #undef PAF
  #undef VFR
  #undef PIN
  #undef MX3
  #undef GAPA
  #undef GAPB
  #undef EX
  #undef VRD
  #undef KRD
  #undef STEP
  #undef ENDW
  {auto rr=__builtin_amdgcn_permlane32_swap(__float_as_uint(l_reg),__float_as_uint(l_reg),false,false);l_reg=__uint_as_float(rr[0])+__uint_as_float(rr[1]);}
  if(hi==0)wsf[32+r32]=l_reg;asm volatile("s_waitcnt lgkmcnt(0)":::"memory");
  float rli[16];
  #pragma unroll
  for(int r=0;r<16;++r)rli[r]=__builtin_amdgcn_rcpf(wsf[32+crow(r,hi)]);
  bf16*Ow=Ob+(long)(wid*QBLK)*OPITCH;
  { bf16*stg=(bf16*)(shm+LDS_OST)+wid*2048;
    #pragma unroll
    for(int r=0;r<16;++r){const int orow=crow(r,hi);
      #pragma unroll
      for(int d0=0;d0<2;++d0)stg[orow*64+d0*32+r32]=__float2bfloat16(o[d0][r]*rli[r]);}
    asm volatile("s_waitcnt lgkmcnt(0)":::"memory");
    #pragma unroll
    for(int i=0;i<4;++i){const int row=i*8+(lane>>3),ch=lane&7; const u32x4 v=*(const u32x4*)(stg+row*64+ch*8); if(wid>=wlo&&wid<whi)ATTN_STORE16(Ow+(long)row*OPITCH+ch*8,v);} }
  asm volatile("s_waitcnt lgkmcnt(0)\n\ts_barrier":::"memory");
  #undef DMA_K
  #undef DMA_V
  #undef CMASK
  #undef START
  #undef RESC
  #undef ROT
  #undef CBLOAD
}
constexpr int ATTN_LDS_BYTES=LDS_BYTES;
#undef SBAR
#undef WAIT_BAR
}
#include <hip/hip_cooperative_groups.h>
namespace cg = cooperative_groups;
#ifndef MK_N_LAUNCHES
#define MK_N_LAUNCHES 1
#endif
#ifndef FOX_PRUNE
#define FOX_PRUNE 1
#endif
constexpr int NWAVES = 8, NTHR = 512;
constexpr int DMOD = 1024, TSEQ = 8192, NBATCH = 8, MP = NBATCH * TSEQ, MS = 512, MTOT = MP + MS;
constexpr int NIN = 3584, INC = 3592, FF = 4096, SSEQ = 1152, PAST = 1024, DSEQ = 32;
constexpr int NCHUNK = MTOT / 64;
constexpr float EPSN = 1e-6f, LOG2E = 1.4426950408889634f;
constexpr size_t MiB = 1u << 20;
constexpr size_t WS_CTL = 0, CTL_ZERO_BYTES = 65536;
constexpr size_t WS_WIN = 2 * MiB, WS_WO = 9 * MiB, WS_WUP = 11 * MiB, WS_WDN = 19 * MiB;
constexpr size_t WS_RSTD = 27 * MiB, WS_CGP = 28 * MiB, WS_CGS = 30 * MiB, WS_VEC = 31 * MiB, WS_SSQ = 38 * MiB;
constexpr size_t WS_X1B = 44 * MiB, WS_MIX = 174 * MiB, WS_H = 304 * MiB;
constexpr size_t WS_XB = 304 * MiB, WS_Q = 434 * MiB, WS_K = 498 * MiB, WS_V = 562 * MiB, WS_QS = 626 * MiB, WS_KS = 635 * MiB, WS_VS = 644 * MiB;
constexpr size_t WS_QR = 654 * MiB, WS_KR = 719 * MiB, WS_VH = 784 * MiB, WS_SG = 849 * MiB, WS_END = 914 * MiB;
constexpr size_t VECN = (size_t)NCHUNK * 512;
static_assert(WS_VEC + 3 * VECN * 4 <= WS_SSQ && WS_SSQ + (size_t)MTOT * 16 * 4 <= WS_X1B && WS_X1B + (size_t)MTOT * DMOD * 2 <= WS_MIX && WS_MIX + (size_t)MTOT * DMOD * 2 <= WS_H, "ws map");
static_assert(WS_H + (size_t)MTOT * FF * 2 <= WS_END && WS_XB + (size_t)MTOT * DMOD * 2 <= WS_Q && WS_SG + (size_t)MTOT * 512 * 2 <= WS_END, "ws map 2");
constexpr int CW_QUEUE = 64, CW_SUB = 128, CW_BAR = 1024, NCHAINWG = 32;
constexpr size_t O_YP = 0, O_YS = O_YP + (size_t)MP * DMOD, O_KP = O_YS + (size_t)256 * DMOD, O_VP = O_KP + (size_t)MP * 512, O_LP = O_VP + (size_t)MP * 512,
                 O_HP = O_LP + (size_t)MP * 8, O_KS = O_HP + 524288, O_VS = O_KS + 131072, O_LS = O_VS + 131072, O_HS = O_LS + 2048, O_END = O_HS + 524288;
constexpr int RING_BYTES = 131072, MISC_OFF = RING_BYTES, LDS_BYTES = 135168;
static_assert(attn_body::ATTN_LDS_BYTES <= RING_BYTES, "attention LDS");

#define LAS __attribute__((address_space(3)))
typedef unsigned short bf16;
typedef unsigned v4u __attribute__((ext_vector_type(4)));
typedef unsigned v2u __attribute__((ext_vector_type(2)));
typedef float f32x4 __attribute__((ext_vector_type(4)));
typedef short bf16x8 __attribute__((ext_vector_type(8)));
#define LDS_WAIT() asm volatile("s_waitcnt lgkmcnt(0)" ::: "memory")
__device__ __forceinline__ unsigned pk2(float lo, float hi) { return pg8::cvt_pk_bf16(lo, hi); }
__device__ __forceinline__ float bf2f(unsigned short b) { return __uint_as_float(((unsigned)b) << 16); }
#define DPPF(v, ctrl) __int_as_float(__builtin_amdgcn_update_dpp(0, __float_as_int(v), (ctrl), 0xf, 0xf, false))
__device__ __forceinline__ float sum8(float v) { v += DPPF(v, 0xB1); v += DPPF(v, 0x4E); v += DPPF(v, 0x141); return v; }
__device__ __forceinline__ float swap16_sum(float a, float b) { auto r = __builtin_amdgcn_permlane16_swap(__float_as_uint(a), __float_as_uint(b), false, false); return __uint_as_float(r[0]) + __uint_as_float(r[1]); }
__device__ __forceinline__ float swap32_sum(float a, float b) { auto r = __builtin_amdgcn_permlane32_swap(__float_as_uint(a), __float_as_uint(b), false, false); return __uint_as_float(r[0]) + __uint_as_float(r[1]); }
__device__ __forceinline__ float wave_sum(float v) { v = sum8(v); v += DPPF(v, 0x140); v = swap16_sum(v, v); v = swap32_sum(v, v); return v; }
__device__ __forceinline__ bool row_map(int row, int& idx) { if (row < MP) { idx = row; return true; } const int rs = row - MP; idx = (rs >> 6) * 32 + (rs & 63); return (rs & 63) < 32; }

namespace pg8 {
struct OrderIn {
    StaticOrder so; int pn_off, extra, extra_pm0;
    __device__ bool next(int i, Unit& u) const {
        const long L = (long)i * so.G + so.c;
        if (L < so.nwg) { so.next(i, u); u.pn += pn_off; return true; }
        const long e = L - so.nwg; if (e >= extra) return false;
        u.pm = extra_pm0 + (int)(e >> 3); u.pn = (int)(e & 7); u.kofs = 0; return true;
    }
    __device__ __forceinline__ void a_ready(const Unit&) const {}
    __device__ __forceinline__ void done(const Unit&) const {}
};
#define DPP_SHR(v, n) __int_as_float(__builtin_amdgcn_update_dpp(0, __float_as_int(v), 0x110 + (n), 0xf, 0xf, false))
#define PERMA(lane) ((((lane) >> 2) + 16 * ((lane) & 3)) << 2)
__device__ __forceinline__ f32x4 lperm(const f32x4 v, int pa) { f32x4 r;
    r[0] = __int_as_float(__builtin_amdgcn_ds_bpermute(pa, __float_as_int(v[0]))); r[1] = __int_as_float(__builtin_amdgcn_ds_bpermute(pa, __float_as_int(v[1])));
    r[2] = __int_as_float(__builtin_amdgcn_ds_bpermute(pa, __float_as_int(v[2]))); r[3] = __int_as_float(__builtin_amdgcn_ds_bpermute(pa, __float_as_int(v[3]))); return r; }
struct EpiIn {
    static constexpr bool PERM = false, AFTER_DRAIN = false;
    const float* rstd1; const float* lbl; const float* qg; const float* kg; unsigned char* ws; float* out;
    __device__ __forceinline__ void operator()(const f32x4 (&acc)[2][2][4][2], const Unit& u, int wr, int wc, int fr, int fq) const {
        const int pn = u.pn, rowb = u.pm * BM + wr * 64 + fr; const bool samp = u.pm >= (MP / BM);
        bf16_t* const QR = (bf16_t*)(ws + WS_QR); bf16_t* const KR = (bf16_t*)(ws + WS_KR); bf16_t* const VH = (bf16_t*)(ws + WS_VH); bf16_t* const SG = (bf16_t*)(ws + WS_SG); float* const vec = (float*)(ws + WS_VEC);
        float rs[2][4];
#pragma unroll
        for (int ai = 0; ai < 2; ++ai)
#pragma unroll
            for (int m = 0; m < 4; ++m) rs[ai][m] = rstd1[rowb + ai * HALF + m * 16];
        if (pn < 4) {
            const int h = pn, ch0 = 128 * h + 32 * wc + 4 * fq; const int lane = threadIdx.x & 63; const int a15 = ((lane & 48) | 15) << 2;
#pragma unroll
            for (int n = 0; n < 2; ++n) {
                const f32x4 l0 = *(const f32x4*)(lbl + ch0 + 16 * n), l1 = *(const f32x4*)(lbl + 512 + ch0 + 16 * n);
                f32x4 lb, omlb;
#pragma unroll
                for (int j = 0; j < 4; ++j) { lb[j] = 1.f / (1.f + __expf(l1[j] - l0[j])); omlb[j] = 1.f - lb[j]; }
#pragma unroll
                for (int ai = 0; ai < 2; ++ai) {
                    f32x4 bq[4], kk[4], bb[4]; f32x4 carry = {0.f, 0.f, 0.f, 0.f};
#pragma unroll
                    for (int m = 0; m < 4; ++m) {
#pragma unroll
                        for (int j = 0; j < 4; ++j) {
                            const float zq = acc[ai][0][m][n][j] * rs[ai][m], zf = acc[ai][1][m][n][j] * rs[ai][m];
                            const float sig = 1.f / (1.f + __expf(-zf)); const float f = lb[j] + omlb[j] * sig; float k = omlb[j] * (1.f - sig); float s = __logf(f);
                            if (samp && m >= 2) { s = 0.f; k = 0.f; }
                            s += DPP_SHR(s, 1); s += DPP_SHR(s, 2); s += DPP_SHR(s, 4); s += DPP_SHR(s, 8);
                            s += carry[j]; carry[j] = __int_as_float(__builtin_amdgcn_ds_bpermute(a15, __float_as_int(s)));
                            bq[m][j] = zq; kk[m][j] = k; bb[m][j] = s;
                        }
                    }
#pragma unroll
                    for (int m = 0; m < 4; ++m) {
                        float qv[4], kv[4];
#pragma unroll
                        for (int j = 0; j < 4; ++j) { qv[j] = bq[m][j] * __expf(bb[m][j]); kv[j] = kk[m][j] * __expf(-bb[m][j]); }
                        const size_t off = (size_t)(rowb + ai * HALF + m * 16) * 512 + ch0 + 16 * n;
                        v2u wq; wq.x = cvt_pk_bf16(qv[0], qv[1]); wq.y = cvt_pk_bf16(qv[2], qv[3]); *(v2u*)(QR + off) = wq;
                        v2u wk; wk.x = cvt_pk_bf16(kv[0], kv[1]); wk.y = cvt_pk_bf16(kv[2], kv[3]); *(v2u*)(KR + off) = wk;
                    }
                    if (fr == 0) {
                        const size_t voff = (size_t)((u.pm * BM + ai * HALF + wr * 64) >> 6) * 512 + ch0 + 16 * n;
                        f32x4 d;
#pragma unroll
                        for (int j = 0; j < 4; ++j) d[j] = __expf(carry[j]);
                        *(f32x4*)(vec + voff) = d;
                    }
                }
            }
        } else if (pn < 8) {
            const int h = pn - 4, c0 = 128 * h + 32 * wc + 4 * fq;
#pragma unroll
            for (int ai = 0; ai < 2; ++ai)
#pragma unroll
                for (int m = 0; m < 4; ++m) { const size_t off = (size_t)(rowb + ai * HALF + m * 16) * 512 + c0; const float r = rs[ai][m];
#pragma unroll
                    for (int n = 0; n < 2; ++n) { const f32x4 v = acc[ai][0][m][n] * r; f32x4 g = acc[ai][1][m][n] * r;
#pragma unroll
                        for (int j = 0; j < 4; ++j) g[j] = g[j] / (1.f + __expf(-g[j]));
                        v2u wv; wv.x = cvt_pk_bf16(v[0], v[1]); wv.y = cvt_pk_bf16(v[2], v[3]); *(v2u*)(VH + off + 16 * n) = wv;
                        v2u wg; wg.x = cvt_pk_bf16(g[0], g[1]); wg.y = cvt_pk_bf16(g[2], g[3]); *(v2u*)(SG + off + 16 * n) = wg; } }
        } else if (pn < 12) {
            const bool isK = pn >= 10; const int head = 4 * ((pn - 8) & 1) + wc; const float* gain = isK ? kg : qg; const float osc = isK ? 1.f : attn_body::C2;
            f32x4 gv[2][2];
#pragma unroll
            for (int bj = 0; bj < 2; ++bj)
#pragma unroll
                for (int n = 0; n < 2; ++n) gv[bj][n] = *(const f32x4*)(gain + 32 * bj + 16 * n + 4 * fq) * osc;
#pragma unroll
            for (int ai = 0; ai < 2; ++ai)
#pragma unroll
                for (int m = 0; m < 4; ++m) { const int row = rowb + ai * HALF + m * 16; const float r = rs[ai][m]; float ssq = 0.f;
#pragma unroll
                    for (int bj = 0; bj < 2; ++bj)
#pragma unroll
                        for (int n = 0; n < 2; ++n) { const f32x4 z = acc[ai][bj][m][n] * r; ssq += (z[0] * z[0] + z[1] * z[1]) + (z[2] * z[2] + z[3] * z[3]); }
                    ssq += __shfl_xor(ssq, 16); ssq += __shfl_xor(ssq, 32);
                    const float r2 = r / sqrtf(ssq * (1.f / 64.f) + EPSN);
                    int idx; const bool valid = row_map(row, idx);
                    float* ofp = out + (samp ? O_KS : O_KP) + (size_t)idx * 512;
                    const size_t boff = samp ? (isK ? WS_KS : WS_QS) : (isK ? WS_K : WS_Q); const size_t brow = samp ? (size_t)((idx >> 5) * SSEQ + PAST + (idx & 31)) : (size_t)row;
                    bf16_t* bfp = (bf16_t*)(ws + boff) + brow * 512;
                    if (valid) {
#pragma unroll
                        for (int bj = 0; bj < 2; ++bj)
#pragma unroll
                            for (int n = 0; n < 2; ++n) { const f32x4 v = acc[ai][bj][m][n] * r2 * gv[bj][n]; const int col = 64 * head + 32 * bj + 16 * n + 4 * fq;
                                if (isK) *(f32x4*)(ofp + col) = v;
                                v2u w; w.x = cvt_pk_bf16(v[0], v[1]); w.y = cvt_pk_bf16(v[2], v[3]); *(v2u*)(bfp + col) = w; } } }
        } else {
            const int c0 = 256 * (pn - 12) + 32 * wc + 4 * fq;
#pragma unroll
            for (int ai = 0; ai < 2; ++ai)
#pragma unroll
                for (int m = 0; m < 4; ++m) { const int row = rowb + ai * HALF + m * 16; const float r = rs[ai][m];
                    int idx; const bool valid = row_map(row, idx);
                    float* ofp = out + (samp ? O_VS : O_VP) + (size_t)idx * 512;
                    const size_t brow = samp ? (size_t)((idx >> 5) * SSEQ + PAST + (idx & 31)) : (size_t)row;
                    bf16_t* bfp = (bf16_t*)(ws + (samp ? WS_VS : WS_V)) + brow * 512;
                    if (valid) {
#pragma unroll
                        for (int bj = 0; bj < 2; ++bj)
#pragma unroll
                            for (int n = 0; n < 2; ++n) { const f32x4 v = acc[ai][bj][m][n] * r; const int col = c0 + 128 * bj + 16 * n;
                                *(f32x4*)(ofp + col) = v;
                                v2u w; w.x = cvt_pk_bf16(v[0], v[1]); w.y = cvt_pk_bf16(v[2], v[3]); *(v2u*)(bfp + col) = w; } } }
        }
    }
};
struct EpiWo {
    static constexpr bool PERM = false, AFTER_DRAIN = false;
    const bf16_t* XBp; const float* xs; float* yp; float* ys; bf16_t* X1B; float* ssq;
    __device__ __forceinline__ void operator()(const f32x4 (&acc)[2][2][4][2], const Unit& u, int wr, int wc, int fr, int fq) const {
        const int lane = threadIdx.x & 63, pa = PERMA(lane); fr = lane >> 2; fq = lane & 3;
        const int rowb = u.pm * BM + wr * 64 + fr, c0 = u.pn * BM + wc * 32 + 4 * fq; const bool samp = u.pm >= (MP / BM);
#pragma unroll
        for (int ai = 0; ai < 2; ++ai) {
            f32x4 xv[4][2][2];
            if (samp) {
#pragma unroll
                for (int m = 0; m < 4; ++m) { const int row = rowb + ai * HALF + m * 16; int idx; const bool valid = row_map(row, idx); const float* xr = xs + (size_t)idx * DMOD;
#pragma unroll
                    for (int bj = 0; bj < 2; ++bj)
#pragma unroll
                        for (int n = 0; n < 2; ++n) xv[m][bj][n] = valid ? *(const f32x4*)(xr + c0 + 128 * bj + 16 * n) : (f32x4){0.f, 0.f, 0.f, 0.f}; }
            } else {
                v2u xb[4][2][2];
#pragma unroll
                for (int m = 0; m < 4; ++m) { const bf16_t* xr = XBp + (size_t)(rowb + ai * HALF + m * 16) * DMOD;
#pragma unroll
                    for (int bj = 0; bj < 2; ++bj)
#pragma unroll
                        for (int n = 0; n < 2; ++n) xb[m][bj][n] = *(const v2u*)(xr + c0 + 128 * bj + 16 * n); }
                __builtin_amdgcn_sched_barrier(0);
#pragma unroll
                for (int m = 0; m < 4; ++m)
#pragma unroll
                    for (int bj = 0; bj < 2; ++bj)
#pragma unroll
                        for (int n = 0; n < 2; ++n) { const v2u w = xb[m][bj][n]; xv[m][bj][n] = (f32x4){__uint_as_float(w.x << 16), __uint_as_float(w.x & 0xffff0000u), __uint_as_float(w.y << 16), __uint_as_float(w.y & 0xffff0000u)}; }
            }
            __builtin_amdgcn_sched_barrier(0);
#pragma unroll
            for (int m = 0; m < 4; ++m) { const int row = rowb + ai * HALF + m * 16; int idx; const bool valid = row_map(row, idx);
                float* yr = yp + (samp ? (size_t)MP * DMOD : (size_t)0) + (size_t)idx * DMOD; float s = 0.f;
#pragma unroll
                for (int bj = 0; bj < 2; ++bj)
#pragma unroll
                    for (int n = 0; n < 2; ++n) { const int col = c0 + 128 * bj + 16 * n; f32x4 v = lperm(acc[ai][bj][m][n], pa) + xv[m][bj][n];
                        if (samp && valid) *(f32x4*)(yr + col) = v;
                        s += (v[0] * v[0] + v[1] * v[1]) + (v[2] * v[2] + v[3] * v[3]);
                        v2u w; w.x = cvt_pk_bf16(v[0], v[1]); w.y = cvt_pk_bf16(v[2], v[3]); *(v2u*)(X1B + (size_t)row * DMOD + col) = w; }
                s += __shfl_xor(s, 1); s += __shfl_xor(s, 2);
                if (fq == 0) ssq[(size_t)row * 16 + 4 * u.pn + wc] = s; }
            __builtin_amdgcn_sched_barrier(0);
        }
    }
};
struct EpiUp {
    static constexpr bool PERM = true, AFTER_DRAIN = false;
    bf16_t* O; const float* ssq;
    __device__ __forceinline__ void operator()(const f32x4 (&acc)[2][2][4][2], const Unit& u, int wr, int wc, int fr, int fq) const {
        const int row0 = u.pm * BM + wr * 64 + fr, col0 = u.pn * BM + wc * 32 + 8 * fq;
        float rr[2][4];
#pragma unroll
        for (int ai = 0; ai < 2; ++ai) { f32x4 sv[4][4];
#pragma unroll
            for (int m = 0; m < 4; ++m) { const f32x4* sp = (const f32x4*)(ssq + (size_t)(row0 + ai * HALF + m * 16) * 16); sv[m][0] = sp[0]; sv[m][1] = sp[1]; sv[m][2] = sp[2]; sv[m][3] = sp[3]; }
            __builtin_amdgcn_sched_barrier(0);
#pragma unroll
            for (int m = 0; m < 4; ++m) { const f32x4 st = (sv[m][0] + sv[m][1]) + (sv[m][2] + sv[m][3]); rr[ai][m] = __builtin_amdgcn_rsqf(((st[0] + st[1]) + (st[2] + st[3])) * (1.f / DMOD) + EPSN); } }
#pragma unroll
        for (int ai = 0; ai < 2; ++ai)
#pragma unroll
            for (int m = 0; m < 4; ++m) { const int row = row0 + ai * HALF + m * 16;
                const float r = rr[ai][m];
                bf16_t* rowp = O + (size_t)row * FF + col0;
#pragma unroll
                for (int bj = 0; bj < 2; ++bj) { f32x4 v0 = acc[ai][bj][m][0] * r, v1 = acc[ai][bj][m][1] * r;
#pragma unroll
                    for (int j = 0; j < 4; ++j) { v0[j] = fmaxf(v0[j], 0.f); v0[j] *= v0[j]; v1[j] = fmaxf(v1[j], 0.f); v1[j] *= v1[j]; }
                    u32x4 w; w.x = cvt_pk_bf16(v0[0], v0[1]); w.y = cvt_pk_bf16(v0[2], v0[3]); w.z = cvt_pk_bf16(v1[0], v1[1]); w.w = cvt_pk_bf16(v1[2], v1[3]);
                    *(u32x4*)(rowp + bj * HALF) = w; } }
    }
};
struct OrderDown {
    StaticOrder so; int mode;
    static constexpr int KSPLIT = 4;
    __device__ bool next(int i, Unit& u) const {
        if (mode) return so.next(i, u);
        const long L = (long)i * so.G + so.c; if (L >= 8 * KSPLIT) return false;
        const int t = (int)L / KSPLIT, ks = (int)L % KSPLIT; u.pm = MP / BM + (t >> 2); u.pn = t & 3; u.kofs = ks * (FF / KSPLIT); return true;
    }
    __device__ __forceinline__ void a_ready(const Unit&) const {}
    __device__ __forceinline__ void done(const Unit&) const {}
};
struct EpiDown {
    static constexpr bool PERM = false, AFTER_DRAIN = false;
    float* yp; float* ys; const bf16_t* X1B; int atomic;
    __device__ __forceinline__ void operator()(const f32x4 (&acc)[2][2][4][2], const Unit& u, int wr, int wc, int fr, int fq) const {
        const int lane = threadIdx.x & 63, pa = PERMA(lane); fr = lane >> 2; fq = lane & 3;
        const int rowb = u.pm * BM + wr * 64 + fr, c0 = u.pn * BM + wc * 32 + 4 * fq; const bool samp = u.pm >= (MP / BM);
#pragma unroll
        for (int ai = 0; ai < 2; ++ai) {
            f32x4 xv[4][2][2];
            if (!atomic) {
                v2u xb[4][2][2];
#pragma unroll
                for (int m = 0; m < 4; ++m) { const bf16_t* xr = X1B + (size_t)(rowb + ai * HALF + m * 16) * DMOD;
#pragma unroll
                    for (int bj = 0; bj < 2; ++bj)
#pragma unroll
                        for (int n = 0; n < 2; ++n) xb[m][bj][n] = *(const v2u*)(xr + c0 + 128 * bj + 16 * n); }
                __builtin_amdgcn_sched_barrier(0);
#pragma unroll
                for (int m = 0; m < 4; ++m)
#pragma unroll
                    for (int bj = 0; bj < 2; ++bj)
#pragma unroll
                        for (int n = 0; n < 2; ++n) { const v2u w = xb[m][bj][n]; xv[m][bj][n] = (f32x4){__uint_as_float(w.x << 16), __uint_as_float(w.x & 0xffff0000u), __uint_as_float(w.y << 16), __uint_as_float(w.y & 0xffff0000u)}; }
            }
            __builtin_amdgcn_sched_barrier(0);
#pragma unroll
            for (int m = 0; m < 4; ++m) { const int row = rowb + ai * HALF + m * 16; int idx; const bool valid = row_map(row, idx);
                float* yr = yp + (samp ? (size_t)MP * DMOD : (size_t)0) + (size_t)idx * DMOD;
                if (valid) {
#pragma unroll
                    for (int bj = 0; bj < 2; ++bj)
#pragma unroll
                        for (int n = 0; n < 2; ++n) { const int col = c0 + 128 * bj + 16 * n; const f32x4 v = lperm(acc[ai][bj][m][n], pa);
                            if (atomic) {
#pragma unroll
                                for (int j = 0; j < 4; ++j) __hip_atomic_fetch_add(yr + col + j, v[j], __ATOMIC_RELAXED, __HIP_MEMORY_SCOPE_AGENT);
                            } else *(f32x4*)(yr + col) = xv[m][bj][n] + v; } } }
            __builtin_amdgcn_sched_barrier(0);
        }
    }
};
}

#define XB_TMO      128
#define XB_XCNT(j)  (256  + 64 * (j))
#define XB_XSUB(j)  (1280 + 64 * (j))
#define XB_XGEN(j)  (2304 + 64 * (j))
#define XB_TOP      3328
#define XB_TOPGEN   3392
#define XCD_BAR_WORDS 3456
#define XB_SPIN_CAP (1u << 18)

__device__ __forceinline__ unsigned xb_ld(unsigned* p)              { return __hip_atomic_load(p, __ATOMIC_RELAXED, __HIP_MEMORY_SCOPE_AGENT); }
__device__ __forceinline__ unsigned xb_add(unsigned* p, unsigned v) { return __hip_atomic_fetch_add(p, v, __ATOMIC_RELAXED, __HIP_MEMORY_SCOPE_AGENT); }
__device__ __forceinline__ unsigned xb_xcc_id() { return (unsigned)__builtin_amdgcn_s_getreg((3 << 11) | 20) & 0xFu; }
#define XB_SPIN(cond, bar) do { unsigned _sp = 0; while (cond) { __builtin_amdgcn_s_sleep(1); \
    if ((++_sp & 255u) == 0u) { if (xb_ld(&(bar)[XB_TMO])) break; if (_sp > XB_SPIN_CAP) { atomicAdd(&(bar)[XB_TMO], 1u); break; } } } } while (0)

struct XcdBarrier {
    unsigned* bar; unsigned x;
    volatile LAS unsigned* st;
};

__device__ __forceinline__ XcdBarrier xcd_barrier_post(unsigned* bar, volatile LAS unsigned* st) {
    XcdBarrier b; b.bar = bar; b.x = xb_xcc_id(); b.st = st;
    if (threadIdx.x == 0) (void)xb_add(&bar[XB_XCNT(b.x)], 1u);
    return b;
}
__device__ __forceinline__ void xcd_barrier_complete(unsigned* bar, unsigned x, unsigned& nloc, unsigned& nx) {
    const unsigned G = gridDim.x * gridDim.y * gridDim.z;
    unsigned sum, cnt, mine, sp = 0u;
    for (;;) {
        sum = 0u; cnt = 0u; mine = 0u;
#pragma unroll
        for (unsigned j = 0; j < 16; ++j) { const unsigned c = xb_ld(&bar[XB_XCNT(j)]); sum += c; cnt += (c > 0u) ? 1u : 0u; mine = (j == x) ? c : mine; }
        if (sum == G) break;
        __builtin_amdgcn_s_sleep(1);
        if ((++sp & 255u) == 0u) { if (xb_ld(&bar[XB_TMO])) break; if (sp > XB_SPIN_CAP) { atomicAdd(&bar[XB_TMO], 1u); break; } }
    }
    nloc = mine > 0u ? mine : 1u; nx = cnt > 0u ? cnt : 1u;
}

__device__ __forceinline__ void xcd_barrier(const XcdBarrier& b) {
    asm volatile("s_waitcnt vmcnt(0)" ::: "memory");
    __syncthreads();
    if (threadIdx.x == 0) {
        unsigned* bar = b.bar;
        __builtin_amdgcn_s_waitcnt(0);
        unsigned nloc = b.st[0], nx = b.st[1];
        if (nloc == 0u) { xcd_barrier_complete(bar, b.x, nloc, nx); b.st[0] = nloc; b.st[1] = nx; }
        const unsigned old = xb_add(&bar[XB_XSUB(b.x)], 1u);
        const unsigned gen = old / nloc;
        if (old + 1u == (gen + 1u) * nloc) {
            __builtin_amdgcn_fence(__ATOMIC_RELEASE, "agent");
            asm volatile("s_waitcnt vmcnt(0)" ::: "memory");
            const unsigned og = xb_add(&bar[XB_TOP], 1u);
            const unsigned tg = og / nx;
            if (og + 1u == (tg + 1u) * nx) xb_add(&bar[XB_TOPGEN], 1u);
            else XB_SPIN(xb_ld(&bar[XB_TOPGEN]) == tg, bar);
            __builtin_amdgcn_fence(__ATOMIC_ACQUIRE, "agent");
            xb_add(&bar[XB_XGEN(b.x)], 1u);
            asm volatile("s_waitcnt vmcnt(0)" ::: "memory");
        } else {
            XB_SPIN(xb_ld(&bar[XB_XGEN(b.x)]) == gen, bar);
            __builtin_amdgcn_fence(__ATOMIC_ACQUIRE, "agent");
            asm volatile("s_waitcnt vmcnt(0)" ::: "memory");
        }
    }
    __syncthreads();
}

struct Args { const float* in[17]; float* out; unsigned char* ws; int ph_lo, ph_hi; };
struct Frame {
    LAS unsigned char* lds; volatile LAS unsigned* MISC; unsigned* ctl; unsigned char* ws; float* out;
    int tid, lane, wave, vcu, G;
    const float *xp, *xs, *ck, *cv, *clf, *sh, *n1, *win, *bff, *qg, *kg, *lbl, *hon, *wout, *n2, *wup, *wdn;
};

__device__ __forceinline__ int win_src_col(int g) {
    const int j0 = 32 * g, tile = j0 >> 8, jl = j0 & 255;
    if (tile < 4) return (jl < 128) ? (128 * tile + jl) : (512 + 128 * tile + (jl - 128));
    if (tile < 8) { const int h = tile - 4; return (jl < 128) ? (1024 + 128 * h + jl) : (1536 + 128 * h + (jl - 128)); }
    if (tile < 12) { const int base = tile < 10 ? 2048 : 2560, tl = (tile - 8) & 1, bj = jl >> 7, wc = (jl >> 5) & 3; return base + 64 * (4 * tl + wc) + 32 * bj; }
    return 3072 + (j0 - 12 * 256);
}
__device__ __forceinline__ void p0_transpose_item(const float* W, int ldw, int K, const float* nrm, bf16* WT, int n0, int src0, int k0, LAS float* scr, int lane) {
    float vals[32]; const float* wp = W + (size_t)(k0 + (lane >> 5)) * ldw + src0 + (lane & 31);
#pragma unroll
    for (int i = 0; i < 32; ++i) vals[i] = wp[(size_t)(2 * i) * ldw];
    const int c = lane & 7;
    f32x4 n0v = {1.f, 1.f, 1.f, 1.f}, n1v = {1.f, 1.f, 1.f, 1.f};
    if (nrm) { n0v = *(const f32x4*)(nrm + k0 + 8 * c); n1v = *(const f32x4*)(nrm + k0 + 8 * c + 4); }
#pragma unroll
    for (int i = 0; i < 32; ++i) scr[(2 * i + (lane >> 5)) * 33 + (lane & 31)] = vals[i];
    LDS_WAIT(); asm volatile("" ::: "memory");
#pragma unroll
    for (int j = 0; j < 4; ++j) { const int n = (lane >> 3) + 8 * j; const LAS float* s = scr + (8 * c) * 33 + n;
        v4u o; o.x = pk2(s[0 * 33] * n0v[0], s[1 * 33] * n0v[1]); o.y = pk2(s[2 * 33] * n0v[2], s[3 * 33] * n0v[3]); o.z = pk2(s[4 * 33] * n1v[0], s[5 * 33] * n1v[1]); o.w = pk2(s[6 * 33] * n1v[2], s[7 * 33] * n1v[3]);
        *(v4u*)(WT + (size_t)(n0 + n) * K + k0 + 8 * c) = o; }
    LDS_WAIT(); asm volatile("" ::: "memory");
}
__device__ __forceinline__ void p0_prologue(Frame& F) {
    LAS float* scr = (LAS float*)(F.lds + F.wave * 16384);
    const int gw = F.vcu * NWAVES + F.wave, NGW = F.G * NWAVES, lane = F.lane;
    bf16* Win_t = (bf16*)(F.ws + WS_WIN); bf16* Wo_t = (bf16*)(F.ws + WS_WO); bf16* Wup_t = (bf16*)(F.ws + WS_WUP); bf16* Wdn_t = (bf16*)(F.ws + WS_WDN);
    constexpr int I_IN = 16 * (NIN / 32), I_O = 16 * 32, I_UP = 16 * (FF / 32), I_DN = 64 * 32, NITEMS = I_IN + I_O + I_UP + I_DN;
    for (int it = gw; it < NITEMS; it += NGW) {
        int r = it;
        if (r < I_IN) { const int kb = r / (NIN / 32), g = r % (NIN / 32); p0_transpose_item(F.win, INC, DMOD, F.n1, Win_t, 32 * g, win_src_col(g), 64 * kb, scr, lane); continue; } r -= I_IN;
        if (r < I_O) { const int kb = r / 32, g = r % 32; p0_transpose_item(F.wout, DMOD, DMOD, nullptr, Wo_t, 32 * g, 32 * g, 64 * kb, scr, lane); continue; } r -= I_O;
        if (r < I_UP) { const int kb = r / (FF / 32), g = r % (FF / 32); p0_transpose_item(F.wup, FF, DMOD, F.n2, Wup_t, 32 * g, 32 * g, 64 * kb, scr, lane); continue; } r -= I_UP;
        { const int kb = r / 32, g = r % 32; p0_transpose_item(F.wdn, DMOD, FF, nullptr, Wdn_t, 32 * g, 32 * g, 64 * kb, scr, lane); }
    }
    { const int gt = F.vcu * NTHR + F.tid, NGT = F.G * NTHR;
      bf16* Qs = (bf16*)(F.ws + WS_QS); bf16* Ks = (bf16*)(F.ws + WS_KS); bf16* Vs = (bf16*)(F.ws + WS_VS);
      for (int i = gt; i < NBATCH * PAST * 64; i += NGT) { const int b = i / (PAST * 64), rem = i % (PAST * 64); const size_t so = (size_t)i * 8, dof = ((size_t)b * SSEQ * 64 + rem) * 8;
          const f32x4 a0 = *(const f32x4*)(F.ck + so), a1 = *(const f32x4*)(F.ck + so + 4), b0 = *(const f32x4*)(F.cv + so), b1 = *(const f32x4*)(F.cv + so + 4);
          v4u o; o.x = pk2(a0[0], a0[1]); o.y = pk2(a0[2], a0[3]); o.z = pk2(a1[0], a1[1]); o.w = pk2(a1[2], a1[3]); *(v4u*)(Ks + dof) = o;
          o.x = pk2(b0[0], b0[1]); o.y = pk2(b0[2], b0[3]); o.z = pk2(b1[0], b1[1]); o.w = pk2(b1[2], b1[3]); *(v4u*)(Vs + dof) = o; }
      const v4u z = {0u, 0u, 0u, 0u};
      for (int i = gt; i < NBATCH * SSEQ * 64; i += NGT) *(v4u*)(Qs + (size_t)i * 8) = z;
      for (int i = gt; i < NBATCH * (SSEQ - PAST) * 64; i += NGT) { const int b = i / ((SSEQ - PAST) * 64), rem = i % ((SSEQ - PAST) * 64); const size_t dof = ((size_t)(b * SSEQ + PAST) * 64 + rem) * 8; *(v4u*)(Ks + dof) = z; *(v4u*)(Vs + dof) = z; }
    }
    float wf[4][4][8];
#pragma unroll
    for (int j = 0; j < 4; ++j)
#pragma unroll
        for (int i = 0; i < 4; ++i) { const int k = 256 * j + 4 * lane + i; const float nk = F.n1[k]; const f32x4 a = *(const f32x4*)(F.win + (size_t)k * INC + NIN), b = *(const f32x4*)(F.win + (size_t)k * INC + NIN + 4);
            wf[j][i][0] = a[0] * nk; wf[j][i][1] = a[1] * nk; wf[j][i][2] = a[2] * nk; wf[j][i][3] = a[3] * nk; wf[j][i][4] = b[0] * nk; wf[j][i][5] = b[1] * nk; wf[j][i][6] = b[2] * nk; wf[j][i][7] = b[3] * nk; }
    float* rstd1 = (float*)(F.ws + WS_RSTD); bf16* XB = (bf16*)(F.ws + WS_XB);
    f32x4 vn[4];
#define P0_LOADROW(mm) do { int idx_; const bool val_ = (mm) < MTOT && row_map((mm), idx_); const float* xr_ = ((mm) < MP ? F.xp : F.xs) + (size_t)idx_ * DMOD; \
        _Pragma("unroll") for (int j = 0; j < 4; ++j) vn[j] = val_ ? *((const f32x4*)xr_ + 64 * j + lane) : (f32x4){0.f, 0.f, 0.f, 0.f}; } while (0)
    P0_LOADROW(gw);
    for (int m = gw; m < MTOT; m += NGW) {
        int idx; const bool valid = row_map(m, idx);
        f32x4 v[4]; float s = 0.f;
#pragma unroll
        for (int j = 0; j < 4; ++j) v[j] = vn[j];
        P0_LOADROW(m + NGW);
#pragma unroll
        for (int j = 0; j < 4; ++j) s += (v[j][0] * v[j][0] + v[j][1] * v[j][1]) + (v[j][2] * v[j][2] + v[j][3] * v[j][3]);
        const float rstd = 1.f / sqrtf(wave_sum(s) * (1.f / DMOD) + EPSN);
        if (lane == 0) rstd1[m] = rstd;
        unsigned long long* o8 = (unsigned long long*)(XB + (size_t)m * DMOD) + lane;
#pragma unroll
        for (int j = 0; j < 4; ++j) o8[64 * j] = (unsigned long long)pk2(v[j][0], v[j][1]) | ((unsigned long long)pk2(v[j][2], v[j][3]) << 32);
        float a8[8];
#pragma unroll
        for (int h = 0; h < 8; ++h) { float a = 0.f;
#pragma unroll
            for (int j = 0; j < 4; ++j)
#pragma unroll
                for (int i = 0; i < 4; ++i) a += v[j][i] * wf[j][i][h];
            a8[h] = a; }
        float b4[4], c2[2], dsum;
#pragma unroll
        for (int i = 0; i < 4; ++i) b4[i] = swap32_sum(a8[i], a8[4 + i]);
#pragma unroll
        for (int i = 0; i < 2; ++i) c2[i] = swap16_sum(b4[i], b4[2 + i]);
        { const bool hi_ = (lane & 8) != 0; const float send = hi_ ? c2[0] : c2[1], keep = hi_ ? c2[1] : c2[0]; dsum = keep + DPPF(send, 0x128); }
        dsum = sum8(dsum);
        { const int hh = (lane >> 3) & 7; const float xx = dsum * rstd + F.bff[hh]; const float ls = fminf(xx, 0.f) - log1pf(expf(-fabsf(xx)));
          if (valid && (lane & 7) == 0) { float* lp = (m < MP ? F.out + O_LP : F.out + O_LS) + (size_t)idx * 8; lp[hh] = ls; } }
    }
}
__device__ __forceinline__ void scan_chain(Frame& F, int ch) {
    LAS float* wsum = (LAS float*)F.lds;
    const bool samp = ch >= 64; const int c2 = samp ? ch - 64 : ch, b = c2 >> 3, h = c2 & 7; const int L = samp ? SSEQ : TSEQ, EPT = samp ? 3 : 16;
    float* dst = samp ? (float*)(F.ws + WS_CGS) + (size_t)c2 * SSEQ : (float*)(F.ws + WS_CGP) + (size_t)c2 * TSEQ;
    float vals[16]; float sum = 0.f;
#pragma unroll
    for (int i = 0; i < 16; ++i) { const int p = F.tid * EPT + i; float v = 0.f;
        if (i < EPT && p < L) { if (!samp) v = F.out[O_LP + ((size_t)b * TSEQ + p) * 8 + h]; else if (p < PAST) v = F.clf[((size_t)b * PAST + p) * 8 + h]; else if (p < PAST + DSEQ) v = F.out[O_LS + ((size_t)b * DSEQ + (p - PAST)) * 8 + h]; }
        sum += v; vals[i] = sum; }
    float incl = sum;
#pragma unroll
    for (int o = 1; o < 64; o <<= 1) { const float t = __shfl_up(incl, o); if (F.lane >= o) incl += t; }
    if (F.lane == 63) wsum[F.wave] = incl;
    __syncthreads();
    float base = 0.f;
    for (int w = 0; w < F.wave; ++w) base += wsum[w];
    const float excl = base + incl - sum;
#pragma unroll
    for (int i = 0; i < 16; ++i) { const int p = F.tid * EPT + i; if (i < EPT && p < L) dst[p] = (excl + vals[i]) * LOG2E; }
    __syncthreads();
}
constexpr int KP = 320  , H_QR = 0, H_KR = 17408, H_KT = 37888, H_VT = 58368, H_VEC = 71680, H_AL = 73216, H_OL = 82432, H_END = 116224;
static_assert(H_END <= RING_BYTES, "hgrn LDS");
typedef short v4i16_t __attribute__((ext_vector_type(4)));
__device__ __forceinline__ bf16x8 tr_frag(LAS unsigned char* p) {
    const v4i16_t lo = __builtin_amdgcn_ds_read_tr16_b64_v4i16((LAS v4i16_t*)p), hi = __builtin_amdgcn_ds_read_tr16_b64_v4i16((LAS v4i16_t*)(p + 4 * KP));
    return (bf16x8){lo[0], lo[1], lo[2], lo[3], hi[0], hi[1], hi[2], hi[3]};
}
__device__ __forceinline__ f32x4 mfma16(bf16x8 a, bf16x8 b, f32x4 c) { return __builtin_amdgcn_mfma_f32_16x16x32_bf16(a, b, c, 0, 0, 0); }
#define LAUNDER(x) asm volatile("" : "+v"(x))
#ifndef PR_A
#define PR_A 1
#endif
#ifndef PR_O
#define PR_O 1
#endif
#ifndef PR_OUT
#define PR_OUT 1
#endif
#ifndef PR_U
#define PR_U 0
#endif
#ifndef PR_ST
#define PR_ST 1
#endif
#ifndef PR_BAR
#define PR_BAR 1
#endif
#define HG_BAR() do { for (int rb_ = 0; rb_ < PR_BAR; ++rb_) { asm volatile("s_waitcnt lgkmcnt(0)" ::: "memory"); __builtin_amdgcn_s_barrier(); asm volatile("" ::: "memory"); } } while (0)
__device__ __forceinline__ void hgrn_chain(Frame& F, int row0, int chunk0, int nsteps, int h, const float* S0, float* Sout) {
    LAS unsigned char* L = F.lds; int tid_ = F.tid; LAUNDER(tid_); const int tid = tid_, lane = tid & 63, w = F.wave, l15 = lane & 15, fq = lane >> 4;
    const char* qb = (const char*)(F.ws + WS_QR) + ((size_t)row0 * 512 + 128 * h) * 2; const char* kb_ = (const char*)(F.ws + WS_KR) + ((size_t)row0 * 512 + 128 * h) * 2;
    const char* vb = (const char*)(F.ws + WS_VH) + ((size_t)row0 * 512 + 128 * h) * 2; const char* gb = (const char*)(F.ws + WS_SG) + ((size_t)row0 * 512 + 128 * h) * 2;
    const char* eb = (const char*)(F.ws + WS_VEC) + ((size_t)chunk0 * 512 + 128 * h) * 4; char* mb = (char*)(F.ws + WS_MIX) + ((size_t)row0 * DMOD + 128 * h) * 2;
    const int oc = tid >> 3, oseg = tid & 7;
    unsigned vo_rm = (unsigned)((tid >> 4) * 1024 + (tid & 15) * 16), vo_sg = (unsigned)(oc * 1024 + oseg * 32), vo_mix = (unsigned)(oc * 2048 + oseg * 32);
    unsigned vo_vec = (unsigned)((tid & 31) * 16);
    unsigned l_rm = (unsigned)(H_QR + (tid >> 4) * 272 + (tid & 15) * 16), l_rk = (unsigned)(H_KR + (tid >> 4) * KP + (tid & 15) * 16);
    unsigned l_vw = (unsigned)(H_VEC + (tid & 31) * 16);
    unsigned l_aq = (unsigned)(H_QR + (16 * (w >> 1) + l15) * 272 + fq * 16);
    unsigned l_ak = (unsigned)(H_KR + (32 * (w & 1) + l15) * KP + fq * 16);
    unsigned l_aw = (unsigned)(H_AL + (16 * (w >> 1) + 4 * fq) * 144 + (32 * (w & 1) + l15) * 2);
    unsigned l_vt = (unsigned)(H_KT + (8 * fq + (l15 >> 2)) * KP + (16 * w + 4 * (l15 & 3)) * 2);
    unsigned l_q2 = (unsigned)(H_QR + l15 * 272 + fq * 16);
    unsigned l_al = (unsigned)(H_AL + l15 * 144 + fq * 16);
    unsigned l_kt = (unsigned)(H_KR + (8 * fq + (l15 >> 2)) * KP + (8 * (l15 & 3)) * 2);
    unsigned l_ve = (unsigned)(H_VEC + fq * 32);
    unsigned l_ow = (unsigned)(H_OL + (4 * fq) * 528 + (16 * w + l15) * 4);
    unsigned l_or = (unsigned)(H_OL + oc * 528 + oseg * 64);
    f32x4 S[8];
#pragma unroll
    for (int kb = 0; kb < 8; ++kb) S[kb] = (f32x4){0.f, 0.f, 0.f, 0.f};
    if (S0) { const float* sp = S0 + (8 * fq) * 128 + 16 * w + l15;
#pragma unroll
        for (int kb = 0; kb < 8; ++kb) { LAUNDER(sp);
#pragma unroll
            for (int r = 0; r < 4; ++r) S[kb][r] = sp[r * 128];
            sp += (kb & 1) ? 28 * 128 : 4 * 128; } }
    f32x4 gn[4];
#pragma unroll
    for (int i = 0; i < 4; ++i) gn[i] = *(const f32x4*)(F.hon + 128 * h + 16 * oseg + 4 * i);
    v4u pq[2][2], pk[2][2], pv[2][2], psg[2][2], pvec[2]; int cl = 0, gl = 0;
#define HG_LOADS(SET) do { \
        _Pragma("unroll") for (int it = 0; it < 2; ++it) { pq[SET][it] = *(const v4u*)(qb + vo_rm + it * 32768); pk[SET][it] = *(const v4u*)(kb_ + vo_rm + it * 32768); pv[SET][it] = *(const v4u*)(vb + vo_rm + it * 32768); } \
        pvec[SET] = *(const v4u*)(eb + vo_vec); } while (0)
#define HG_STORE(SET) do { \
        _Pragma("unroll") for (int it = 0; it < 2; ++it) { *(LAS v4u*)(L + l_rm + it * 8704) = pq[SET][it]; *(LAS v4u*)(L + l_rk + it * 32 * KP) = pk[SET][it]; *(LAS v4u*)(L + l_rk + (H_KT - H_KR) + it * 32 * KP) = pv[SET][it]; } \
        if (tid < 32) *(LAS v4u*)(L + l_vw) = pvec[SET]; } while (0)
#define HG_ADV() do { const int a_ = (cl + 1 < nsteps) ? 1 : 0; qb += a_ * 65536; kb_ += a_ * 65536; vb += a_ * 65536; eb += a_ * 2048; cl += a_; } while (0)
    HG_LOADS(0); HG_ADV(); HG_STORE(0); HG_LOADS(1); HG_ADV();
    psg[0][0] = *(const v4u*)(gb + vo_sg); psg[0][1] = *(const v4u*)(gb + vo_sg + 16); { const int a_ = (gl + 1 < nsteps) ? 1 : 0; gb += a_ * 65536; gl += a_; }
    HG_BAR();
#define HG_BODY(CUR, NXT, CC) do { \
        LAUNDER(vo_rm); LAUNDER(vo_sg); LAUNDER(vo_mix); LAUNDER(vo_vec); LAUNDER(l_rm); LAUNDER(l_rk); LAUNDER(l_vw); LAUNDER(l_aq); LAUNDER(l_ak); LAUNDER(l_aw); \
        LAUNDER(l_vt); LAUNDER(l_q2); LAUNDER(l_al); LAUNDER(l_kt); LAUNDER(l_ve); LAUNDER(l_ow); LAUNDER(l_or); \
        psg[NXT][0] = *(const v4u*)(gb + vo_sg); psg[NXT][1] = *(const v4u*)(gb + vo_sg + 16); { const int a_ = (gl + 1 < nsteps) ? 1 : 0; gb += a_ * 65536; gl += a_; } \
        HG_LOADS(CUR); HG_ADV(); \
        for (int ra_ = 0; ra_ < PR_A; ++ra_) { const int cblk = w >> 1; \
        _Pragma("unroll") \
          for (int jj = 0; jj < 2; ++jj) { const int sblk = 2 * (w & 1) + jj; f32x4 a = {0.f, 0.f, 0.f, 0.f}; \
              if (sblk <= cblk) { \
                  bf16x8 af[4], bf[4]; \
        _Pragma("unroll") \
                  for (int ks = 0; ks < 4; ++ks) { af[ks] = *(const LAS bf16x8*)(L + l_aq + ks * 64); bf[ks] = *(const LAS bf16x8*)(L + l_ak + jj * 16 * KP + ks * 64); } \
                  asm volatile("" : "+v"(af[0]), "+v"(af[1]), "+v"(af[2]), "+v"(af[3]), "+v"(bf[0]), "+v"(bf[1]), "+v"(bf[2]), "+v"(bf[3])); \
        _Pragma("unroll") \
                  for (int ks = 0; ks < 4; ++ks) a = mfma16(af[ks], bf[ks], a); \
        _Pragma("unroll") \
                  for (int r = 0; r < 4; ++r) if (16 * sblk + l15 > 16 * cblk + 4 * fq + r) a[r] = 0.f; \
              } \
        _Pragma("unroll") \
              for (int r = 0; r < 4; ++r) *(LAS unsigned short*)(L + l_aw + r * 144 + jj * 32) = (unsigned short)(pk2(a[r], 0.f) & 0xffffu); \
          } HG_BAR(); } \
        { bf16x8 bvt[2]; \
        _Pragma("unroll") \
          for (int ks = 0; ks < 2; ++ks) bvt[ks] = tr_frag(L + l_vt + ks * 32 * KP); \
          bf16x8 sb[4]; \
        _Pragma("unroll") \
          for (int kb2 = 0; kb2 < 4; ++kb2) { v4u t; t.x = pk2(S[2 * kb2][0], S[2 * kb2][1]); t.y = pk2(S[2 * kb2][2], S[2 * kb2][3]); t.z = pk2(S[2 * kb2 + 1][0], S[2 * kb2 + 1][1]); t.w = pk2(S[2 * kb2 + 1][2], S[2 * kb2 + 1][3]); sb[kb2] = __builtin_bit_cast(bf16x8, t); } \
          for (int ro_ = 0; ro_ < PR_O; ++ro_) \
          _Pragma("unroll") \
          for (int cb = 0; cb < 4; ++cb) { f32x4 o = {0.f, 0.f, 0.f, 0.f}; bf16x8 fa[2], fq_[4]; \
        _Pragma("unroll") \
              for (int ks = 0; ks < 2; ++ks) fa[ks] = *(const LAS bf16x8*)(L + l_al + cb * 16 * 144 + ks * 64); \
        _Pragma("unroll") \
              for (int kb2 = 0; kb2 < 4; ++kb2) fq_[kb2] = *(const LAS bf16x8*)(L + l_q2 + cb * 16 * 272 + kb2 * 64); \
              asm volatile("" : "+v"(fa[0]), "+v"(fa[1]), "+v"(fq_[0]), "+v"(fq_[1]), "+v"(fq_[2]), "+v"(fq_[3])); \
        _Pragma("unroll") \
              for (int ks = 0; ks < 2; ++ks) if (32 * ks <= 16 * cb + 15) o = mfma16(fa[ks], bvt[ks], o); \
        _Pragma("unroll") \
              for (int kb2 = 0; kb2 < 4; ++kb2) o = mfma16(fq_[kb2], sb[kb2], o); \
        _Pragma("unroll") \
              for (int r = 0; r < 4; ++r) *(LAS float*)(L + l_ow + (16 * cb + r) * 528) = o[r]; \
              __builtin_amdgcn_sched_barrier(0); } \
        _Pragma("unroll") \
          for (int kp = 0; kp < 4; ++kp) { bf16x8 fk[2][2]; f32x4 dv[2]; \
        _Pragma("unroll") \
              for (int e = 0; e < 2; ++e) { const int kb = 2 * kp + e; \
        _Pragma("unroll") \
                  for (int ks = 0; ks < 2; ++ks) fk[e][ks] = tr_frag(L + l_kt + (32 * (kb >> 1) + 4 * (kb & 1)) * 2 + ks * 32 * KP); \
                  dv[e] = *(const LAS f32x4*)(L + l_ve + (32 * (kb >> 1) + 4 * (kb & 1)) * 4); } \
              asm volatile("" : "+v"(fk[0][0]), "+v"(fk[0][1]), "+v"(fk[1][0]), "+v"(fk[1][1]), "+v"(dv[0]), "+v"(dv[1])); \
        _Pragma("unroll") \
              for (int e = 0; e < 2; ++e) { const int kb = 2 * kp + e; \
        _Pragma("unroll") \
                  for (int ks = 0; ks < 2; ++ks) S[kb] = mfma16(fk[e][ks], bvt[ks], S[kb]); \
                  S[kb] = S[kb] * dv[e]; } \
              __builtin_amdgcn_sched_barrier(0); } \
          for (int ru_ = 0; ru_ < PR_U; ++ru_) { f32x4 S2[8]; \
          _Pragma("unroll") for (int kb = 0; kb < 8; ++kb) S2[kb] = S[kb]; \
          _Pragma("unroll") \
          for (int kp = 0; kp < 4; ++kp) { bf16x8 fk[2][2]; f32x4 dv[2]; \
          _Pragma("unroll") \
              for (int e = 0; e < 2; ++e) { const int kb = 2 * kp + e; \
          _Pragma("unroll") \
                  for (int ks = 0; ks < 2; ++ks) fk[e][ks] = tr_frag(L + l_kt + (32 * (kb >> 1) + 4 * (kb & 1)) * 2 + ks * 32 * KP); \
                  dv[e] = *(const LAS f32x4*)(L + l_ve + (32 * (kb >> 1) + 4 * (kb & 1)) * 4); } \
              asm volatile("" : "+v"(fk[0][0]), "+v"(fk[0][1]), "+v"(fk[1][0]), "+v"(fk[1][1]), "+v"(dv[0]), "+v"(dv[1])); \
          _Pragma("unroll") \
              for (int e = 0; e < 2; ++e) { const int kb = 2 * kp + e; \
          _Pragma("unroll") \
                  for (int ks = 0; ks < 2; ++ks) S2[kb] = mfma16(fk[e][ks], bvt[ks], S2[kb]); \
                  S2[kb] = S2[kb] * dv[e]; } \
              __builtin_amdgcn_sched_barrier(0); } \
          asm volatile("" :: "v"(S2[0]), "v"(S2[1]), "v"(S2[2]), "v"(S2[3]), "v"(S2[4]), "v"(S2[5]), "v"(S2[6]), "v"(S2[7])); } } \
        HG_BAR(); \
        for (int rt_ = 0; rt_ < PR_OUT; ++rt_) { f32x4 ov[4]; float ss = 0.f; \
        _Pragma("unroll") \
          for (int i = 0; i < 4; ++i) { ov[i] = *(const LAS f32x4*)(L + l_or + 16 * i); ss += (ov[i][0] * ov[i][0] + ov[i][1] * ov[i][1]) + (ov[i][2] * ov[i][2] + ov[i][3] * ov[i][3]); } \
          ss = sum8(ss); \
          const float rn = __builtin_amdgcn_rsqf(ss * (1.f / 128.f) + EPSN); \
          float res[16]; \
        _Pragma("unroll") \
          for (int i = 0; i < 4; ++i) \
        _Pragma("unroll") \
              for (int j = 0; j < 4; ++j) { const int e = 4 * i + j; const unsigned wd = psg[CUR][e >> 3][(e & 7) >> 1]; const float sg = bf2f((unsigned short)((e & 1) ? (wd >> 16) : (wd & 0xffffu))); res[e] = ov[i][j] * rn * gn[i][j] * sg; } \
          v4u o0, o1; o0.x = pk2(res[0], res[1]); o0.y = pk2(res[2], res[3]); o0.z = pk2(res[4], res[5]); o0.w = pk2(res[6], res[7]); o1.x = pk2(res[8], res[9]); o1.y = pk2(res[10], res[11]); o1.z = pk2(res[12], res[13]); o1.w = pk2(res[14], res[15]); \
          *(v4u*)(mb + vo_mix) = o0; *(v4u*)(mb + vo_mix + 16) = o1; } mb += 131072; \
        if ((CC) + 1 < nsteps) { for (int rs_ = 0; rs_ < PR_ST; ++rs_) { HG_STORE(NXT); } } \
        HG_BAR(); \
    } while (0)
    for (int c = 0; c < nsteps; c += 2) { HG_BODY(0, 1, c); if (c + 1 < nsteps) HG_BODY(1, 0, c + 1); }
    { int ln2 = lane; LAUNDER(ln2); float* sp = Sout + (8 * (ln2 >> 4)) * 128 + 16 * w + (ln2 & 15);
#pragma unroll
      for (int kb = 0; kb < 8; ++kb) { LAUNDER(sp);
#pragma unroll
          for (int r = 0; r < 4; ++r) sp[r * 128] = S[kb][r];
          sp += (kb & 1) ? 28 * 128 : 4 * 128; } }
#undef HG_LOADS
#undef HG_STORE
#undef HG_ADV
#undef HG_BODY
}

__global__ void __launch_bounds__(NTHR, 2) skel_fwd(Args args) {
    extern __shared__ __attribute__((aligned(16))) unsigned char lds[];
    Frame F;
    F.lds = (LAS unsigned char*)lds; F.MISC = (volatile LAS unsigned*)(F.lds + MISC_OFF);
    F.tid = threadIdx.x; F.lane = F.tid & 63; F.wave = __builtin_amdgcn_readfirstlane(F.tid >> 6);
    F.G = gridDim.x; { const int bx = blockIdx.x; F.vcu = (F.G % 8 == 0) ? (bx % 8) * (F.G / 8) + bx / 8 : bx; }
    F.ws = args.ws; F.ctl = (unsigned*)(args.ws + WS_CTL); F.out = args.out;
    F.xp = args.in[0]; F.xs = args.in[1]; F.ck = args.in[2]; F.cv = args.in[3]; F.clf = args.in[4]; F.sh = args.in[5]; F.n1 = args.in[6]; F.win = args.in[7]; F.bff = args.in[8];
    F.qg = args.in[9]; F.kg = args.in[10]; F.lbl = args.in[11]; F.hon = args.in[12]; F.wout = args.in[13]; F.n2 = args.in[14]; F.wup = args.in[15]; F.wdn = args.in[16];
    const int lo = args.ph_lo, hi = args.ph_hi;
    if (F.tid < 64) F.MISC[F.tid] = 0u;
    __syncthreads();
    const XcdBarrier xbar = xcd_barrier_post((unsigned*)(F.ctl + CW_BAR), F.MISC + 8);
#if defined(PROBE_A)
    unsigned long long ts_[9]; const bool stamper_ = (blockIdx.x == 0 && F.tid == 0);
#define STAMP(k) do { if (stamper_) ts_[k] = __builtin_amdgcn_s_memrealtime(); } while (0)
    STAMP(0);
#else
#define STAMP(k) do {} while (0)
#endif
#ifndef PH_MASK
#define PH_MASK 63
#endif
#define IN(k) (((PH_MASK >> (k)) & 1) && lo <= (k) && (k) < hi)
#ifndef SYNC_REP
#define SYNC_REP 1
#endif
#define SEAM(k) do { if (IN(k) && IN((k) + 1)) { for (int sr_ = 0; sr_ < SYNC_REP; ++sr_) cg::this_grid().sync(); } } while (0)
    bf16* XB = (bf16*)(F.ws + WS_XB); bf16* X1B = (bf16*)(F.ws + WS_X1B); bf16* MIX = (bf16*)(F.ws + WS_MIX); bf16* HB = (bf16*)(F.ws + WS_H);
    if (IN(0)) { p0_prologue(F);
#if defined(DOUBLE_P0)
        cg::this_grid().sync(); p0_prologue(F);
#endif
    }
    SEAM(0); STAMP(1);
    const int bx = (int)blockIdx.x; const bool chainwg = bx < NCHAINWG; const int NWORK = F.G - NCHAINWG;
    if (IN(1)) {
#ifndef NO_SCAN
        for (int ch = F.vcu; ch < 128; ch += F.G) scan_chain(F, ch);
#endif
        pg8::Gemm g{XB, (const bf16*)(F.ws + WS_WIN), MTOT, NIN, DMOD, DMOD};
        pg8::EpiIn E{(const float*)(F.ws + WS_RSTD), F.lbl, F.qg, F.kg, F.ws, F.out};
#pragma nounroll
        for (int sub = 0; sub < 2; ++sub) {
            pg8::OrderIn S;
            if (sub == 0) { S.so.init(MP, 2048, F.G, bx); S.pn_off = 0; S.extra = 0; S.extra_pm0 = 0; }
            else { S.so.init(MTOT, NIN - 2048, NWORK, bx - NCHAINWG); S.pn_off = 8; S.extra = 8 * (MS / 256); S.extra_pm0 = MP / 256; }
            if (sub == 0 || !chainwg) pg8::gemm_phase<pg8::EpiIn, pg8::OrderIn, true, true>(F.lds, g, S, E);
            if (sub == 0) {
                xcd_barrier(xbar); STAMP(2);
                if (chainwg)
#if defined(DOUBLE_HGRN)
                for (int rep_ = 0; rep_ < 2; ++rep_)
#endif
                { const int bb = bx >> 2; hgrn_chain(F, bb * TSEQ, bb * (TSEQ / 64), TSEQ / 64, bx & 3, nullptr, F.out + O_HP + (size_t)bx * 16384); }
            }
        }
        asm volatile("s_waitcnt vmcnt(0)" ::: "memory"); __syncthreads();
        if (F.tid == 0) { unsigned* sc = F.ctl + CW_SUB;
            if (!chainwg) { __threadfence(); __hip_atomic_fetch_add(sc, 1u, __ATOMIC_RELAXED, __HIP_MEMORY_SCOPE_AGENT); }
            while (__hip_atomic_load(sc, __ATOMIC_RELAXED, __HIP_MEMORY_SCOPE_AGENT) < (unsigned)NWORK) __builtin_amdgcn_s_sleep(8);
            __threadfence(); }
        __syncthreads();
        if (chainwg) { const int bb = bx >> 2; hgrn_chain(F, MP + 64 * bb, MP / 64 + bb, 1, bx & 3, F.sh + (size_t)bx * 16384, F.out + O_HS + (size_t)bx * 16384); __syncthreads(); }
    }
    if (IN(2)) {
#ifndef NO_ATTN
        float prune_thr;
        { float mq = fabsf(F.qg[F.lane]), mk = fabsf(F.kg[F.lane]);
#pragma unroll
          for (int o = 1; o < 64; o <<= 1) { mq = fmaxf(mq, __shfl_xor(mq, o)); mk = fmaxf(mk, __shfl_xor(mk, o)); }
          prune_thr = 2.f * (8.f * mq * mk * LOG2E) + 150.f; }
        for (;;) {
            if (F.tid == 0) F.MISC[0] = atomicAdd(F.ctl + CW_QUEUE, 1u);
            __syncthreads();
            const int i = (int)F.MISC[0];
            __syncthreads();
            if (i >= 2048 + 64) break;
            typedef attn_body::bf16 abf;
            const bool smp = i >= 2048; const int j = smp ? i - 2048 : i;
            const int bh = j & 63, qb = 31 - (j >> 6), b = bh >> 3, h = bh & 7;
            const int q0 = smp ? SSEQ - 256 : 256 * qb, NT = (q0 + 256) / 64; int NTE = NT;
            const size_t rb = (size_t)b * (smp ? SSEQ : TSEQ);
            const float* cgp = (const float*)(F.ws + (smp ? WS_CGS : WS_CGP)) + (size_t)bh * (smp ? SSEQ : TSEQ);
#if FOX_PRUNE
            { const bool need = F.tid < NT && (cgp[q0] - cgp[64 * F.tid + 63] >= -prune_thr); const int needed = __syncthreads_count(need ? 1 : 0);
              NTE = (needed + 1) & ~1; NTE = NTE < 4 ? 4 : (NTE > NT ? NT : NTE); }
#endif
            const size_t orow = smp ? (size_t)(MP + 64 * b) - (size_t)(PAST - q0) : rb + q0;
            attn_body::attn_unit<8>((const abf*)(F.ws + (smp ? WS_QS : WS_Q)) + (rb + q0) * 512 + 64 * h, (const abf*)(F.ws + (smp ? WS_KS : WS_K)) + rb * 512 + 64 * h, (const abf*)(F.ws + (smp ? WS_VS : WS_V)) + rb * 512 + 64 * h,
                                    (abf*)MIX + orow * DMOD + 512 + 64 * h, NT, NTE, cgp, q0, smp ? (PAST - q0) / 32 : 0, smp ? (PAST - q0) / 32 + 1 : 8, (char*)lds);
        }
#endif
    }
    xcd_barrier(xbar); STAMP(3);
    if (IN(3)) {
        pg8::Gemm g{MIX, (const bf16*)(F.ws + WS_WO), MTOT, DMOD, DMOD, DMOD}; pg8::StaticOrder S; S.init(MTOT, DMOD, F.G, (int)blockIdx.x);
        pg8::EpiWo E{XB, F.xs, F.out + O_YP, F.out + O_YS, X1B, (float*)(F.ws + WS_SSQ)};
#ifndef P3_STAGGER
#define P3_STAGGER 0
#endif
        if (P3_STAGGER) {
            const unsigned long long t0 = __builtin_amdgcn_s_memrealtime(), wait = (unsigned long long)(blockIdx.x & 15) * P3_STAGGER;
            while (__builtin_amdgcn_s_memrealtime() - t0 < wait) __builtin_amdgcn_s_sleep(4);
        }
        pg8::gemm_phase<pg8::EpiWo, pg8::StaticOrder, true, true>(F.lds, g, S, E);
#if defined(DOUBLE_P3)
        cg::this_grid().sync();
        pg8::gemm_phase<pg8::EpiWo, pg8::StaticOrder, true, true>(F.lds, g, S, E);
#endif
    }
    xcd_barrier(xbar); STAMP(4);
    if (IN(4)) {
        pg8::Gemm g{X1B, (const bf16*)(F.ws + WS_WUP), MTOT, FF, DMOD, DMOD}; pg8::StaticOrder S; S.init(MTOT, FF, F.G, (int)blockIdx.x);
        pg8::EpiUp E{HB, (const float*)(F.ws + WS_SSQ)};
        pg8::gemm_phase<pg8::EpiUp, pg8::StaticOrder, true, true>(F.lds, g, S, E);
#if defined(DOUBLE_P4)
        cg::this_grid().sync();
        pg8::gemm_phase<pg8::EpiUp, pg8::StaticOrder, true, true>(F.lds, g, S, E);
#endif
    }
    xcd_barrier(xbar); STAMP(5);
    if (IN(5)) {
#pragma nounroll
        for (int pass = 0; pass < 2; ++pass) {
            pg8::Gemm g{HB, (const bf16*)(F.ws + WS_WDN), MTOT, DMOD, pass ? FF : FF / pg8::OrderDown::KSPLIT, FF};
            pg8::OrderDown S; S.mode = pass; S.so.init(MP, DMOD, F.G, (int)blockIdx.x);
            pg8::EpiDown E{F.out + O_YP, F.out + O_YS, X1B, pass ? 0 : 1};
            pg8::gemm_phase<pg8::EpiDown, pg8::OrderDown, true, true>(F.lds, g, S, E);
        }
    }
    STAMP(6);
#if defined(PROBE_A)
    cg::this_grid().sync();
    if (stamper_) {
        unsigned long long da = ts_[PROBE_A + 1] - ts_[PROBE_A], db = ts_[PROBE_B + 1] - ts_[PROBE_B];
        unsigned qa = (unsigned)((da + 1250) / 2500), qb = (unsigned)((db + 1250) / 2500); if (qa > 63) qa = 63; if (qb > 63) qb = 63;
#if defined(PROBE_CAL)
        qa = 1000; qb = 0;
#endif
        const unsigned long long t0 = __builtin_amdgcn_s_memrealtime(), wait = 2000ull * (qa + 64 * qb);
        while (__builtin_amdgcn_s_memrealtime() - t0 < wait) __builtin_amdgcn_s_sleep(16);
    }
#endif
#undef IN
#undef SEAM
}

extern "C" void kernel_launch(void* const* d_in, const int* in_sizes, int n_in, void* d_out, int out_size, void* d_ws, size_t ws_size, hipStream_t stream) {
    static int grid = 0;
    if (grid == 0) {
        if (n_in != 17 || (size_t)out_size != O_END || ws_size < WS_END) { fprintf(stderr, "kernel_launch: unexpected shapes (n_in %d out %d ws %zu)\n", n_in, out_size, ws_size); grid = -1; return; }
        int dev = 0, cus = 0, per_cu = 0;
        if (hipGetDevice(&dev) != hipSuccess || hipDeviceGetAttribute(&cus, hipDeviceAttributeMultiprocessorCount, dev) != hipSuccess) { grid = -1; return; }
        if (hipFuncSetAttribute((const void*)skel_fwd, hipFuncAttributeMaxDynamicSharedMemorySize, LDS_BYTES) != hipSuccess) { fprintf(stderr, "kernel_launch: hipFuncSetAttribute failed\n"); grid = -1; return; }
        if (hipOccupancyMaxActiveBlocksPerMultiprocessor(&per_cu, (const void*)skel_fwd, NTHR, LDS_BYTES) != hipSuccess || per_cu < 1) { fprintf(stderr, "kernel_launch: occupancy query says %d\n", per_cu); per_cu = 1; }
        (void)hipGetLastError();
        grid = cus;
    }
    if (grid < 0) return;
    if (hipMemsetAsync((char*)d_ws + WS_CTL, 0, CTL_ZERO_BYTES, stream) != hipSuccess) { fprintf(stderr, "kernel_launch: memset failed\n"); return; }
    Args a{};
    for (int i = 0; i < 17; ++i) a.in[i] = (const float*)d_in[i];
    a.out = (float*)d_out; a.ws = (unsigned char*)d_ws;
#if MK_N_LAUNCHES == 1
    a.ph_lo = 0; a.ph_hi = 6;
    void* kargs[] = {&a};
    hipError_t e = hipLaunchCooperativeKernel((const void*)skel_fwd, dim3(grid), dim3(NTHR), kargs, LDS_BYTES, stream);
    if (e != hipSuccess) fprintf(stderr, "kernel_launch: cooperative launch failed: %s (grid %d)\n", hipGetErrorString(e), grid);
#else
    for (int li = 0; li < 6; ++li) { a.ph_lo = li; a.ph_hi = li + 1; hipLaunchKernelGGL(skel_fwd, dim3(grid), dim3(NTHR), LDS_BYTES, stream, a); }
#endif
}
```

```cpp
#include <hip/hip_runtime.h>
#include <cstdio>
#include <cstdint>
namespace pg8 {
#define PG8_LAS __attribute__((address_space(3)))
typedef unsigned short bf16_t;
typedef short bf16x8 __attribute__((ext_vector_type(8)));
typedef float f32x4 __attribute__((ext_vector_type(4)));
typedef unsigned u32x4 __attribute__((ext_vector_type(4)));
constexpr int BM = 256, BK = 64, HALF = 128, HTB = HALF * BK * 2  , STAGE_BYTES = 8 * HTB, NXCD = 8, WGM = 8;

__host__ __device__ __forceinline__ int lds_byte(int r, int c) { const int st = (r >> 4) * 2 + (c >> 5), rr = r & 15, cc = c & 31, ob = rr * 64 + cc * 2; return st * 1024 + (ob ^ (((ob >> 9) & 1) << 5)); }
__host__ __device__ __forceinline__ void stage_rc(int b, int& R, int& C) { const int st = b / 1024, sb = b % 1024, swz = sb ^ (((sb >> 9) & 1) << 5); R = (st >> 1) * 16 + swz / 64; C = (st & 1) * 32 + (swz % 64) / 2; }
__host__ __device__ __forceinline__ int perm32(int rho) { const int n = rho >> 4, i = rho & 15; return 8 * (i >> 2) + 4 * n + (i & 3); }

struct Unit { int pm, pn, kofs; };
struct Gemm { const bf16_t* A; const bf16_t* Bt; int M, N, K, ld; };

struct StaticOrder {
    int nM, nN, nwg, G, c;
    __host__ __device__ void init(int M, int N, int G_, int c_) { nM = M / BM; nN = N / BM; nwg = nM * nN; G = G_; c = c_; }
    __host__ __device__ bool next(int i, Unit& u) const {
        const long L = (long)i * G + c; if (L >= nwg) return false;
        int wgid = (int)L; { const int q = nwg / NXCD, r = nwg % NXCD, xcd = wgid % NXCD, off = wgid / NXCD; wgid = (xcd < r ? xcd * (q + 1) : r * (q + 1) + (xcd - r) * q) + off; }
        const int nig = WGM * nN, gid = wgid / nig, fm = gid * WGM, gsz = (nM - fm) < WGM ? (nM - fm) : WGM;
        u.pm = fm + ((wgid % nig) % gsz); u.pn = (wgid % nig) / gsz; u.kofs = 0; return true;
    }
    __device__ __forceinline__ void a_ready(const Unit&) const {}
    __device__ __forceinline__ void done(const Unit&) const {}
};

__device__ __forceinline__ unsigned cvt_pk_bf16(float lo, float hi) { unsigned r; asm volatile("v_cvt_pk_bf16_f32 %0, %1, %2" : "=v"(r) : "v"(lo), "v"(hi)); return r; }
typedef float f32x2 __attribute__((ext_vector_type(2)));
template <class Epi, class Sched, bool ALIGN_EPI = false, bool SP2 = false>
__device__ __forceinline__ void gemm_phase(PG8_LAS unsigned char* lds, const Gemm g, const Sched& S, const Epi& E) {
    const int tid = threadIdx.x, wid = __builtin_amdgcn_readfirstlane(tid >> 6), lane = tid & 63, wr = wid >> 2, wc = wid & 3, fr = lane & 15, fq = lane >> 4;
    const int K = g.ld, nt = g.K / BK;
    unsigned voffA[2], voffB[2];
#pragma unroll
    for (int i = 0; i < 2; ++i) { int R, C; stage_rc(tid * 16 + i * 8192, R, C); const int Rb = Epi::PERM ? ((R & ~31) + perm32(R & 31)) : R;
        voffA[i] = (unsigned)(R * K + C) * 2u; voffB[i] = (unsigned)(Rb * K + C) * 2u; }
    const size_t kstep = (size_t)(BK * 2);
    const size_t hstep = (size_t)HALF * K * 2;
    const size_t tstep = 2 * hstep;
    const unsigned ldsw = (unsigned)wid * 1024u;
    const int aoff = lds_byte(wr * 64 + fr, fq * 8), boff = lds_byte(wc * 32 + fr, fq * 8);
#define PG8_SA(b, h) (((b) * 2 + (h)) * HTB)
#define PG8_SB(b, h) ((4 + (b) * 2 + (h)) * HTB)
#define PG8_STAGE(bufoff, gbase, voff) do { _Pragma("unroll") for (int _i = 0; _i < 2; ++_i) \
        __builtin_amdgcn_global_load_lds((const unsigned*)((const char*)(gbase) + (voff)[_i]), (PG8_LAS unsigned*)(lds + (bufoff) + ldsw + _i * 8192), 16, 0, 0); } while (0)
#define PG8_LDA(dst, b, h) do { _Pragma("unroll") for (int m = 0; m < 4; ++m) _Pragma("unroll") for (int k = 0; k < 2; ++k) dst[m][k] = *(const PG8_LAS bf16x8*)(lds + PG8_SA(b, h) + aoff + m * 2048 + k * 1024); } while (0)
#define PG8_LDB(dst, b, h) do { _Pragma("unroll") for (int n = 0; n < 2; ++n) _Pragma("unroll") for (int k = 0; k < 2; ++k) dst[n][k] = *(const PG8_LAS bf16x8*)(lds + PG8_SB(b, h) + boff + n * 2048 + k * 1024); } while (0)
#define PG8_MMA(ai, bj, At, Bt) do { __builtin_amdgcn_s_setprio(1); _Pragma("unroll") for (int m = 0; m < 4; ++m) _Pragma("unroll") for (int n = 0; n < 2; ++n) _Pragma("unroll") for (int k = 0; k < 2; ++k) \
        acc[ai][bj][m][n] = __builtin_amdgcn_mfma_f32_16x16x32_bf16(Bt[n][k], At[m][k], acc[ai][bj][m][n], 0, 0, 0); __builtin_amdgcn_s_setprio(0); } while (0)
#define PG8_WAIT_V(n) asm volatile("s_waitcnt vmcnt(" #n ")" ::: "memory")
#define PG8_WAIT_L(n) asm volatile("s_waitcnt lgkmcnt(" #n ")" ::: "memory")
#define PG8_BAR __builtin_amdgcn_s_barrier()
#define PG8_SCHED __builtin_amdgcn_sched_barrier(0)
    Unit cur, nxt; int ui = 0;
    if (!S.next(0, cur)) return;
    f32x4 acc[2][2][4][2];
#pragma unroll
    for (int a = 0; a < 2; ++a)
#pragma unroll
        for (int b = 0; b < 2; ++b)
#pragma unroll
            for (int m = 0; m < 4; ++m)
#pragma unroll
                for (int n = 0; n < 2; ++n) acc[a][b][m][n] = (f32x4){0.f, 0.f, 0.f, 0.f};
    bf16x8 At[4][2], B0[2][2], B1[2][2];
    const char* cA = (const char*)g.A + (size_t)cur.pm * tstep + (size_t)cur.kofs * 2; const char* cB = (const char*)g.Bt + (size_t)cur.pn * tstep + (size_t)cur.kofs * 2;
    S.a_ready(cur);
    if constexpr (SP2) {
        PG8_STAGE(PG8_SB(0, 0), cB, voffB); PG8_STAGE(PG8_SB(0, 1), cB + hstep, voffB); PG8_STAGE(PG8_SA(0, 0), cA, voffA); PG8_STAGE(PG8_SA(0, 1), cA + hstep, voffA);
        if (wr == 1) PG8_BAR;
        PG8_WAIT_V(2); PG8_BAR;
        PG8_STAGE(PG8_SB(1, 0), cB + kstep, voffB); PG8_STAGE(PG8_SA(1, 0), cA + kstep, voffA); PG8_STAGE(PG8_SB(1, 1), cB + hstep + kstep, voffB);
        PG8_WAIT_V(6); PG8_BAR;
    } else {
        PG8_STAGE(PG8_SB(0, 0), cB, voffB); PG8_STAGE(PG8_SA(0, 0), cA, voffA); PG8_STAGE(PG8_SB(0, 1), cB + hstep, voffB); PG8_STAGE(PG8_SA(0, 1), cA + hstep, voffA);
        if (wr == 1) PG8_BAR;
        PG8_WAIT_V(4); PG8_BAR;
        PG8_STAGE(PG8_SB(1, 0), cB + kstep, voffB); PG8_STAGE(PG8_SA(1, 0), cA + kstep, voffA); PG8_STAGE(PG8_SB(1, 1), cB + hstep + kstep, voffB);
        PG8_WAIT_V(6); PG8_BAR;
    }
    for (;;) {
        const bool has_next = S.next(ui + 1, nxt);
        const char* nA = has_next ? (const char*)g.A + (size_t)nxt.pm * tstep + (size_t)nxt.kofs * 2 : cA; const char* nB = has_next ? (const char*)g.Bt + (size_t)nxt.pn * tstep + (size_t)nxt.kofs * 2 : cB;
        for (int t = 0; t < nt; t += 2) {
            const bool last = (t == nt - 2);
            const char* a1 = cA + (size_t)(t + 1) * kstep;
            const char* a2 = last ? nA : cA + (size_t)(t + 2) * kstep; const char* b2 = last ? nB : cB + (size_t)(t + 2) * kstep;
            const char* a3 = a2 + kstep; const char* b3 = b2 + kstep;
            if (last && has_next) S.a_ready(nxt);
            if constexpr (SP2) {
            PG8_LDB(B0, 0, 0); PG8_LDB(B1, 0, 1); PG8_SCHED; PG8_LDA(At, 0, 0); PG8_STAGE(PG8_SA(1, 1), a1 + hstep, voffA);
            PG8_WAIT_V(8); PG8_WAIT_L(0); PG8_BAR; PG8_MMA(0, 0, At, B0); PG8_MMA(0, 1, At, B1); PG8_BAR; PG8_SCHED;
            PG8_LDA(At, 0, 1); PG8_STAGE(PG8_SB(0, 0), b2, voffB); PG8_STAGE(PG8_SB(0, 1), b2 + hstep, voffB); PG8_STAGE(PG8_SA(0, 0), a2, voffA);
            PG8_WAIT_V(8); PG8_WAIT_L(0); PG8_BAR; PG8_MMA(1, 0, At, B0); PG8_MMA(1, 1, At, B1); PG8_BAR; PG8_SCHED;
            PG8_LDB(B0, 1, 0); PG8_LDB(B1, 1, 1); PG8_SCHED; PG8_LDA(At, 1, 0); PG8_STAGE(PG8_SA(0, 1), a2 + hstep, voffA);
            PG8_WAIT_V(8); PG8_WAIT_L(0); PG8_BAR; PG8_MMA(0, 0, At, B0); PG8_MMA(0, 1, At, B1); PG8_BAR; PG8_SCHED;
            PG8_LDA(At, 1, 1); PG8_STAGE(PG8_SB(1, 0), b3, voffB); PG8_STAGE(PG8_SB(1, 1), b3 + hstep, voffB); PG8_STAGE(PG8_SA(1, 0), a3, voffA);
            PG8_WAIT_V(8); PG8_WAIT_L(0); PG8_BAR; PG8_MMA(1, 0, At, B0); PG8_MMA(1, 1, At, B1); PG8_BAR; PG8_SCHED;
            } else {
            PG8_LDB(B0, 0, 0); PG8_SCHED; PG8_LDA(At, 0, 0); PG8_STAGE(PG8_SA(1, 1), a1 + hstep, voffA);
            PG8_WAIT_L(8); PG8_BAR; PG8_WAIT_L(0); PG8_MMA(0, 0, At, B0); PG8_BAR; PG8_SCHED;
            PG8_LDB(B1, 0, 1); PG8_STAGE(PG8_SB(0, 0), b2, voffB);
            PG8_BAR; PG8_WAIT_L(0); PG8_MMA(0, 1, At, B1); PG8_BAR;
            PG8_LDA(At, 0, 1); PG8_STAGE(PG8_SA(0, 0), a2, voffA);
            PG8_BAR; PG8_WAIT_L(0); PG8_MMA(1, 0, At, B0); PG8_BAR; PG8_SCHED;
            PG8_STAGE(PG8_SB(0, 1), b2 + hstep, voffB);
            PG8_WAIT_V(6); PG8_BAR; PG8_MMA(1, 1, At, B1); PG8_BAR;
            PG8_LDB(B0, 1, 0); PG8_SCHED; PG8_LDA(At, 1, 0); PG8_STAGE(PG8_SA(0, 1), a2 + hstep, voffA);
            PG8_WAIT_L(8); PG8_BAR; PG8_WAIT_L(0); PG8_MMA(0, 0, At, B0); PG8_BAR; PG8_SCHED;
            PG8_LDB(B1, 1, 1); PG8_STAGE(PG8_SB(1, 0), b3, voffB);
            PG8_BAR; PG8_WAIT_L(0); PG8_MMA(0, 1, At, B1); PG8_BAR;
            PG8_LDA(At, 1, 1); PG8_STAGE(PG8_SA(1, 0), a3, voffA);
            PG8_BAR; PG8_WAIT_L(0); PG8_MMA(1, 0, At, B0); PG8_BAR; PG8_SCHED;
            PG8_STAGE(PG8_SB(1, 1), b3 + hstep, voffB);
            PG8_WAIT_V(6); PG8_BAR; PG8_MMA(1, 1, At, B1); PG8_BAR;
            }
        }
        if constexpr (ALIGN_EPI) { if (wr == 0) PG8_BAR; }
        if constexpr (!Epi::AFTER_DRAIN) { E(acc, cur, wr, wc, fr, fq); S.done(cur); }
        if (!has_next) break;
#pragma unroll
        for (int a = 0; a < 2; ++a)
#pragma unroll
            for (int b = 0; b < 2; ++b)
#pragma unroll
                for (int m = 0; m < 4; ++m)
#pragma unroll
                    for (int n = 0; n < 2; ++n) acc[a][b][m][n] = (f32x4){0.f, 0.f, 0.f, 0.f};
        cur = nxt; cA = nA; cB = nB; ++ui;
        if constexpr (ALIGN_EPI) { if (wr == 1) PG8_BAR; }
    }
    PG8_WAIT_V(0);
    if constexpr (!ALIGN_EPI) { if (wr == 0) PG8_BAR; }
    PG8_BAR;
    if constexpr (Epi::AFTER_DRAIN) { E.fused(acc, cur, wr, wc, fr, fq, lds, wid, lane); S.done(cur); }
#undef PG8_SA
#undef PG8_SB
#undef PG8_STAGE
#undef PG8_LDA
#undef PG8_LDB
#undef PG8_MMA
#undef PG8_WAIT_V
#undef PG8_WAIT_L
#undef PG8_BAR
#undef PG8_SCHED
}
}
#include <hip/hip_bf16.h>
#include <cmath>
namespace attn_body {
using bf16=__hip_bfloat16;
using bf16x8=__attribute__((ext_vector_type(8)))short;
using s16x4=__attribute__((ext_vector_type(4)))short;
using f32x16=__attribute__((ext_vector_type(16)))float;
using u32x4=__attribute__((ext_vector_type(4)))unsigned;
constexpr int NHEAD=8,D=64,DM=NHEAD*D,OPITCH=1024;
constexpr int NW=8,QBLK=32,QB=QBLK*NW,KVBLK=64;
constexpr int ATTN_PITCH=DM, ATTN_UNIT_ROWS=QB;
__device__ __forceinline__ int crow(int r,int hi){return (r&3)+8*(r>>2)+4*hi;}
#define SBAR() __builtin_amdgcn_sched_barrier(0)
__device__ __forceinline__ void cmask(f32x16&p0,f32x16&p1,int jb,int qrel,int hi){
  const float NEG=-INFINITY; int kb=64*jb+4*hi;
  #pragma unroll
  for(int r=0;r<16;++r){int kv=kb+(r&3)+8*(r>>2); if(kv>qrel)p0[r]=NEG; if(kv+32>qrel)p1[r]=NEG;}
}

constexpr int NSLOT=3, SLOTB=8192;
constexpr int LDS_K=0, LDS_V=NSLOT*SLOTB, LDS_WS=2*NSLOT*SLOTB, LDS_OST=LDS_WS+NW*64*4, LDS_CB=LDS_OST+NW*4096, LDS_BYTES=LDS_CB+32768;
constexpr float C2=0.125f*1.4426950408889634f;
__device__ __forceinline__ void glds16(const void*gsrc,unsigned lds_dst){unsigned keep;
  asm volatile("s_mov_b32 %0, m0\n\ts_mov_b32 m0, %2\n\ts_nop 0\n\tglobal_load_lds_dwordx4 %1, off\n\ts_mov_b32 m0, %0":"=&s"(keep):"v"(gsrc),"s"(lds_dst):"memory");}
__device__ __forceinline__ float max3f(float a,float b,float c){float r;asm("v_max3_f32 %0, %1, %2, %3":"=v"(r):"v"(a),"v"(b),"v"(c));return r;}
__device__ __forceinline__ float max2f(float a,float b){float r;asm("v_max_f32_e32 %0, %1, %2":"=v"(r):"v"(a),"v"(b));return r;}
__device__ __forceinline__ float fadd_s(float a,float b){float r;asm("v_add_f32_e32 %0, %1, %2":"=v"(r):"v"(a),"v"(b));return r;}
__device__ __forceinline__ float fsub_s(float a,float b){float r;asm("v_sub_f32_e32 %0, %1, %2":"=v"(r):"v"(a),"v"(b));return r;}
typedef float f32x2_t __attribute__((ext_vector_type(2))); typedef float f32x4_t __attribute__((ext_vector_type(4))); typedef __bf16 bf16x2_t __attribute__((ext_vector_type(2)));
__device__ __forceinline__ unsigned cvtpk_s(float lo,float hi){f32x2_t v={lo,hi};bf16x2_t b=__builtin_convertvector(v,bf16x2_t);return __builtin_bit_cast(unsigned,b);}
#define WAIT_BAR(N) asm volatile("s_waitcnt vmcnt(" #N ") lgkmcnt(0)\n\ts_barrier":::"memory")

__device__ __forceinline__ void qkt(f32x16&p0,f32x16&p1,const char*Kslot,const bf16x8*qr,int r32,int hi){
  const char*kb=Kslot+hi*1024+r32*16;
  #pragma unroll
  for(int d0=0;d0<4;++d0){
    const bf16x8 b0=*reinterpret_cast<const bf16x8*>(kb+d0*2048);
    const bf16x8 b1=*reinterpret_cast<const bf16x8*>(kb+d0*2048+512);
    p0=__builtin_amdgcn_mfma_f32_32x32x16_bf16(b0,qr[d0],p0,0,0,0);p1=__builtin_amdgcn_mfma_f32_32x32x16_bf16(b1,qr[d0],p1,0,0,0);}
}
typedef __attribute__((address_space(3))) const char* lds_cptr;
typedef short v4i16_t __attribute__((ext_vector_type(4)));
__device__ __forceinline__ void kload8(bf16x8*kf,lds_cptr kp){
  kf[0]=*(const __attribute__((address_space(3))) bf16x8*)(kp);      kf[1]=*(const __attribute__((address_space(3))) bf16x8*)(kp+512);
  kf[2]=*(const __attribute__((address_space(3))) bf16x8*)(kp+2048); kf[3]=*(const __attribute__((address_space(3))) bf16x8*)(kp+2560);
  kf[4]=*(const __attribute__((address_space(3))) bf16x8*)(kp+4096); kf[5]=*(const __attribute__((address_space(3))) bf16x8*)(kp+4608);
  kf[6]=*(const __attribute__((address_space(3))) bf16x8*)(kp+6144); kf[7]=*(const __attribute__((address_space(3))) bf16x8*)(kp+6656);
}
__device__ __forceinline__ void kload2(bf16x8*kf,lds_cptr kp,int j){ kf[2*j]=*(const __attribute__((address_space(3))) bf16x8*)(kp+j*2048); kf[2*j+1]=*(const __attribute__((address_space(3))) bf16x8*)(kp+j*2048+512); }
__device__ __forceinline__ s16x4 vtr(lds_cptr p){ return __builtin_bit_cast(s16x4,__builtin_amdgcn_ds_read_tr16_b64_v4i16((__attribute__((address_space(3))) v4i16_t*)p)); }
__device__ __forceinline__ float rowmax(const f32x16&p0,const f32x16&p1){
  float a=max3f(p0[0],p0[1],p1[0]),b=max3f(p0[2],p0[3],p1[1]);a=max3f(a,p1[2],p1[3]);
  #pragma unroll
  for(int r=4;r<16;r+=4){a=max3f(a,p0[r],p0[r+1]);b=max3f(b,p0[r+2],p0[r+3]);a=max3f(a,p1[r],p1[r+1]);b=max3f(b,p1[r+2],p1[r+3]);}
  const float m=max2f(a,b);
  auto rr=__builtin_amdgcn_permlane32_swap(__float_as_uint(m),__float_as_uint(m),false,false);
  return max2f(__uint_as_float(rr[0]),__uint_as_float(rr[1]));
}
__device__ __forceinline__ void pv(f32x16*o,int vb,bf16x8 pa0,bf16x8 pa1,bf16x8 pa2,bf16x8 pa3){
  #pragma unroll
  for(int d0=0;d0<2;++d0){s16x4 lo[4],hi[4];
    #pragma unroll
    for(int ks=0;ks<4;++ks){
      asm volatile("ds_read_b64_tr_b16 %0,%1 offset:%c2":"=&v"(lo[ks]):"v"(vb),"i"(d0*4096+ks*1024):"memory");
      asm volatile("ds_read_b64_tr_b16 %0,%1 offset:%c2":"=&v"(hi[ks]):"v"(vb),"i"(d0*4096+ks*1024+512):"memory");}
    asm volatile("s_waitcnt lgkmcnt(0)":::"memory");SBAR();
    #define PK(k) (bf16x8){lo[k][0],lo[k][1],lo[k][2],lo[k][3],hi[k][0],hi[k][1],hi[k][2],hi[k][3]}
    o[d0]=__builtin_amdgcn_mfma_f32_32x32x16_bf16(pa0,PK(0),o[d0],0,0,0);
    o[d0]=__builtin_amdgcn_mfma_f32_32x32x16_bf16(pa1,PK(1),o[d0],0,0,0);
    o[d0]=__builtin_amdgcn_mfma_f32_32x32x16_bf16(pa2,PK(2),o[d0],0,0,0);
    o[d0]=__builtin_amdgcn_mfma_f32_32x32x16_bf16(pa3,PK(3),o[d0],0,0,0);
    #undef PK
  }
}

#ifndef ATTN_STORE16
#define ATTN_STORE16(p,v) (*(u32x4*)(p)=(v))
#endif
template<int THRL> __device__ __forceinline__ void attn_unit(const bf16*Qb,const bf16*__restrict__ Kh,const bf16*__restrict__ Vh,bf16*Ob,int NT,int NTE,const float*cgp,int q0,int wlo,int whi,char*shm){
  int tid_=threadIdx.x; asm volatile("":"+v"(tid_)); const int tid=tid_,lane=tid&63,r32=lane&31,hi=lane>>5; const int wid=__builtin_amdgcn_readfirstlane(tid>>6);
  const bf16*Qw=Qb+(long)(wid*QBLK)*DM;
  const unsigned lds0=(unsigned)(uintptr_t)shm;
  float*wsf=(float*)(shm+LDS_WS)+wid*64;
  const bf16*ksrc=Kh+(long)((NT-1)*KVBLK+lane)*DM+wid*8;
  const bf16*vsrc=Vh+(long)((NT-1)*KVBLK+16*(wid&3)+(lane>>2))*DM+(wid>>2)*32+(lane&3)*8;
  const unsigned kdst=lds0+LDS_K+wid*1024, vdst=lds0+LDS_V+wid*1024;
  #define DMA_K(t,slot) glds16(ksrc-(long)(t)*KVBLK*DM,(unsigned)__builtin_amdgcn_readfirstlane(kdst+(slot)))
  #define DMA_V(t,slot) glds16(vsrc-(long)(t)*KVBLK*DM,(unsigned)__builtin_amdgcn_readfirstlane(vdst+(slot)))
  const int vb0=(int)(lds0+LDS_V)+((lane>>4)&1)*32+(lane&3)*8+(4*hi+((lane&15)>>2))*64;
  const char*Kbase=shm+LDS_K; bf16x8 kf[8];
  const lds_cptr shm3=(lds_cptr)shm; const lds_cptr kp0=shm3+LDS_K+hi*1024+r32*16; const lds_cptr vp0=shm3+LDS_V+((lane>>4)&1)*32+(lane&3)*8+(4*hi+((lane&15)>>2))*64;
  { typedef __attribute__((address_space(3))) float lf_t; lf_t* cbw=(lf_t*)((lds_cptr)shm+LDS_CB); const float c0=cgp[q0]; const int jlo=(NT-NTE)*KVBLK, jhi=NT*KVBLK;
    for(int j=jlo+tid;j<jhi;j+=NW*64) cbw[j]=c0-cgp[j]; }
  const __attribute__((address_space(3))) float* cbL=(const __attribute__((address_space(3))) float*)((lds_cptr)shm+LDS_CB)+4*hi;
  #define CBLOAD(C0,C1,t,MH) do{ const __attribute__((address_space(3))) float* cbp_=cbL+(NT-1-(t))*KVBLK; \
    _Pragma("unroll") for(int g_=0;g_<4;++g_){ const f32x4_t v0_=*(const __attribute__((address_space(3))) f32x4_t*)(cbp_+8*g_); const f32x4_t v1_=*(const __attribute__((address_space(3))) f32x4_t*)(cbp_+32+8*g_); \
      C0[4*g_]=v0_[0]-(MH);C0[4*g_+1]=v0_[1]-(MH);C0[4*g_+2]=v0_[2]-(MH);C0[4*g_+3]=v0_[3]-(MH); C1[4*g_]=v1_[0]-(MH);C1[4*g_+1]=v1_[1]-(MH);C1[4*g_+2]=v1_[2]-(MH);C1[4*g_+3]=v1_[3]-(MH);} }while(0)
  DMA_K(0,0);DMA_V(0,0);DMA_K(1,SLOTB);
  bf16x8 qr[4];
  #pragma unroll
  for(int d0=0;d0<4;++d0)qr[d0]=*reinterpret_cast<const bf16x8*>(&Qw[(long)r32*DM+d0*16+hi*8]);
  float mhat=0.f,l_reg=0.f;f32x16 o[2];o[0]=f32x16{};o[1]=f32x16{};
  const int qrel=wid*QBLK+r32;
  #define CMASK(P0,P1,t) do{int jb_=3-(t); if(jb_>=0)cmask(P0,P1,jb_,qrel,hi);}while(0)
  bool resc=false;
  #define START(P0,P1) do{ const float rm=rowmax(P0,P1); resc=false; \
    { const float dl=(rm>-1e30f)?rm:0.f; mhat=fadd_s(mhat,dl); \
      _Pragma("unroll") for(int r=0;r<16;++r){P0[r]=fsub_s(P0[r],dl);P1[r]=fsub_s(P1[r],dl);} } \
    _Pragma("unroll") for(int r=0;r<16;++r)P0[r]=__builtin_amdgcn_exp2f(P0[r]); }while(0)
  #define RESC() do{ if(resc){ asm volatile("s_waitcnt lgkmcnt(0)":::"memory"); \
      _Pragma("unroll") for(int d_=0;d_<2;++d_) _Pragma("unroll") for(int r=0;r<16;++r)o[d_][r]*=wsf[crow(r,hi)]; } }while(0)
  f32x16 pA0,pA1,pB0,pB1;
  int sl_prev=0,sl_cur=0,sl_next=SLOTB;
  #define ROT() do{sl_prev=sl_cur;sl_cur=sl_next;sl_next=(sl_next==(NSLOT-1)*SLOTB)?0:sl_next+SLOTB;}while(0)
  DMA_K(2,2*SLOTB);
  WAIT_BAR(3);
  CBLOAD(pA0,pA1,0,0.f); qkt(pA0,pA1,Kbase,qr,r32,hi);asm volatile("s_nop 15\n\ts_nop 7":"+v"(pA0),"+v"(pA1));CMASK(pA0,pA1,0);
  START(pA0,pA1);
  _Pragma("unroll") for(int r=0;r<16;++r)pA1[r]=__builtin_amdgcn_exp2f(pA1[r]);
  WAIT_BAR(0);
  DMA_K(3,0);DMA_V(1,SLOTB);
  ROT();
  kload8(kf,kp0+sl_cur);
  WAIT_BAR(2);
  s16x4 vlo[8],vhi[8]; u32x4 pw0,pw1,pw2,pw3;
  #define PKW(P,B) cvtpk_s(P[B],P[B+1])
  #define PAF(k) __builtin_bit_cast(bf16x8,pw##k)
  #define VFR(i) (bf16x8){vlo[i][0],vlo[i][1],vlo[i][2],vlo[i][3],vhi[i][0],vhi[i][1],vhi[i][2],vhi[i][3]}
  #define PIN(x) asm volatile("":"+v"(x))
  #define MX3(a,b,c) __builtin_fmaxf(__builtin_fmaxf((a),(b)),(c))
  #define GAPA(MF,A0,A1,A2,A3,W0,W1,PW) do{ MF; sacc+=A0; sacc+=A1; sacc+=A2; sacc+=A3; PIN(sacc); W0; W1; PIN(PW); SBAR(); }while(0)
  #define EX(v) __builtin_amdgcn_exp2f(v)
  #define GAPB(MF,X,B) do{ MF; X[B]=EX(X[B]); X[B+1]=EX(X[B+1]); X[B+2]=EX(X[B+2]); X[B+3]=EX(X[B+3]); PIN(X); SBAR(); }while(0)
  #define VRD(i) do{ vlo[i]=vtr(vp_+(((i)>>2)*4096+((i)&3)*1024)); vhi[i]=vtr(vp_+(((i)>>2)*4096+((i)&3)*1024+512)); }while(0)
  #define KRD(G,j) do{ if(G){ kload2(kf,kp0+sl_next,j); SBAR(); } }while(0)
  #define STEP(C0,C1,P0,P1,t,GK,GV,GL) do{ SBAR(); \
    const lds_cptr vp_=vp0+sl_prev; CBLOAD(C0,C1,t,mhat); SBAR(); \
    VRD(0); SBAR(); float sacc=(P0[0]+P0[1]); \
    GAPA(C0=__builtin_amdgcn_mfma_f32_32x32x16_bf16(kf[0],qr[0],C0,0,0,0), P0[2],P0[3],P0[4],P0[5],     pw0[0]=PKW(P0,0), pw0[1]=PKW(P0,2), pw0); \
    VRD(4); SBAR(); GAPA(C1=__builtin_amdgcn_mfma_f32_32x32x16_bf16(kf[1],qr[0],C1,0,0,0), P0[6],P0[7],P0[8],P0[9],     pw0[2]=PKW(P0,4), pw0[3]=PKW(P0,6), pw0); \
    VRD(1); SBAR(); GAPA(C0=__builtin_amdgcn_mfma_f32_32x32x16_bf16(kf[2],qr[1],C0,0,0,0),   P0[10],P0[11],P0[12],P0[13], pw1[0]=PKW(P0,8), pw1[1]=PKW(P0,10), pw1); \
    VRD(5); SBAR(); GAPA(C1=__builtin_amdgcn_mfma_f32_32x32x16_bf16(kf[3],qr[1],C1,0,0,0),   P0[14],P0[15],P1[0],P1[1],   pw1[2]=PKW(P0,12),pw1[3]=PKW(P0,14), pw1); \
    VRD(2); SBAR(); GAPA(C0=__builtin_amdgcn_mfma_f32_32x32x16_bf16(kf[4],qr[2],C0,0,0,0),   P1[2],P1[3],P1[4],P1[5],     pw2[0]=PKW(P1,0), pw2[1]=PKW(P1,2), pw2); \
    VRD(6); SBAR(); GAPA(C1=__builtin_amdgcn_mfma_f32_32x32x16_bf16(kf[5],qr[2],C1,0,0,0),   P1[6],P1[7],P1[8],P1[9],     pw2[2]=PKW(P1,4), pw2[3]=PKW(P1,6), pw2); \
    VRD(3); SBAR(); GAPA(C0=__builtin_amdgcn_mfma_f32_32x32x16_bf16(kf[6],qr[3],C0,0,0,0),   P1[10],P1[11],P1[12],P1[13], pw3[0]=PKW(P1,8), pw3[1]=PKW(P1,10), pw3); \
    VRD(7); SBAR(); GAPA(C1=__builtin_amdgcn_mfma_f32_32x32x16_bf16(kf[7],qr[3],C1,0,0,0),   P1[14],P1[15],0.f,0.f,       pw3[2]=PKW(P1,12),pw3[3]=PKW(P1,14), pw3); \
    l_reg+=sacc; \
    if(GK){DMA_K((t)+3,sl_cur);} if(GV){DMA_V((t)+1,sl_next);} \
    CMASK(C0,C1,t); \
    { float a=MX3(C0[0],C0[1],C1[0]),b=MX3(C0[2],C0[3],C1[1]); a=MX3(a,C1[2],C1[3]); \
      _Pragma("unroll") for(int r=4;r<16;r+=4){a=MX3(a,C0[r],C0[r+1]);b=MX3(b,C0[r+2],C0[r+3]);a=MX3(a,C1[r],C1[r+1]);b=MX3(b,C1[r+2],C1[r+3]);} \
      float rm=__builtin_fmaxf(a,b); { auto rr=__builtin_amdgcn_permlane32_swap(__float_as_uint(rm),__float_as_uint(rm),false,false); rm=__builtin_fmaxf(__uint_as_float(rr[0]),__uint_as_float(rr[1])); } \
      resc=false; \
      if(__builtin_expect(__any(rm>(float)THRL),0)){ const float dl=__builtin_fmaxf(rm,0.f); mhat+=dl; \
        _Pragma("unroll") for(int r=0;r<16;++r){C0[r]-=dl;C1[r]-=dl;} \
        const float f=__builtin_amdgcn_exp2f(-dl); l_reg*=f; if(hi==0)wsf[r32]=f; resc=true; } } \
    SBAR(); \
    GAPB(o[0]=__builtin_amdgcn_mfma_f32_32x32x16_bf16(PAF(0),VFR(0),o[0],0,0,0), C0,0); \
    GAPB(o[1]=__builtin_amdgcn_mfma_f32_32x32x16_bf16(PAF(0),VFR(4),o[1],0,0,0), C0,4); \
    KRD(GL,0); GAPB(o[0]=__builtin_amdgcn_mfma_f32_32x32x16_bf16(PAF(1),VFR(1),o[0],0,0,0), C0,8); \
    KRD(GL,1); GAPB(o[1]=__builtin_amdgcn_mfma_f32_32x32x16_bf16(PAF(1),VFR(5),o[1],0,0,0), C0,12); \
    KRD(GL,2); GAPB(o[0]=__builtin_amdgcn_mfma_f32_32x32x16_bf16(PAF(2),VFR(2),o[0],0,0,0), C1,0); \
    KRD(GL,3); GAPB(o[1]=__builtin_amdgcn_mfma_f32_32x32x16_bf16(PAF(2),VFR(6),o[1],0,0,0), C1,4); \
    GAPB(o[0]=__builtin_amdgcn_mfma_f32_32x32x16_bf16(PAF(3),VFR(3),o[0],0,0,0), C1,8); \
    GAPB(o[1]=__builtin_amdgcn_mfma_f32_32x32x16_bf16(PAF(3),VFR(7),o[1],0,0,0), C1,12); \
    }while(0)
  int t=1;
  for(;t<5&&t+5<NTE;t+=2){
    STEP(pB0,pB1,pA0,pA1,t,true,true,true);     WAIT_BAR(2); RESC(); ROT();
    STEP(pA0,pA1,pB0,pB1,t+1,true,true,true);   WAIT_BAR(2); RESC(); ROT();
  }
  #undef CMASK
  #define CMASK(P0,P1,t) do{}while(0)
  for(;t+5<NTE;t+=2){
    STEP(pB0,pB1,pA0,pA1,t,true,true,true);     WAIT_BAR(2); RESC(); ROT();
    STEP(pA0,pA1,pB0,pB1,t+1,true,true,true);   WAIT_BAR(2); RESC(); ROT();
  }
  #undef CMASK
  #define CMASK(P0,P1,t) do{int jb_=3-(t); if(jb_>=0)cmask(P0,P1,jb_,qrel,hi);}while(0)
  #define ENDW(tt) do{ if((tt)+3<NTE){WAIT_BAR(2);} else if((tt)+2<NTE){WAIT_BAR(1);} else {WAIT_BAR(0);} }while(0)
  for(;t+1<NTE;t+=2){
    STEP(pB0,pB1,pA0,pA1,t,(t+3<NTE),(t+1<NTE),(t+1<NTE));       ENDW(t);   RESC(); ROT();
    STEP(pA0,pA1,pB0,pB1,t+1,(t+4<NTE),(t+2<NTE),(t+2<NTE));     ENDW(t+1); RESC(); ROT();
  }
  STEP(pB0,pB1,pA0,pA1,NTE-1,false,false,false); RESC();
  { float sacc=pB0[0]+pB0[1]; _Pragma("unroll") for(int r=2;r<16;++r)sacc+=pB0[r]; _Pragma("unroll") for(int r=0;r<16;++r)sacc+=pB1[r]; l_reg+=sacc;
    pw0=(u32x4){PKW(pB0,0),PKW(pB0,2),PKW(pB0,4),PKW(pB0,6)};pw1=(u32x4){PKW(pB0,8),PKW(pB0,10),PKW(pB0,12),PKW(pB0,14)};pw2=(u32x4){PKW(pB1,0),PKW(pB1,2),PKW(pB1,4),PKW(pB1,6)};pw3=(u32x4){PKW(pB1,8),PKW(pB1,10),PKW(pB1,12),PKW(pB1,14)};
    SBAR(); pv(o,vb0+sl_cur,PAF(0),PAF(1),PAF(2),PAF(3)); }
  #undef PKW
  #undef PAF
  #undef VFR
  #undef PIN
  #undef MX3
  #undef GAPA
  #undef GAPB
  #undef EX
  #undef VRD
  #undef KRD
  #undef STEP
  #undef ENDW
  {auto rr=__builtin_amdgcn_permlane32_swap(__float_as_uint(l_reg),__float_as_uint(l_reg),false,false);l_reg=__uint_as_float(rr[0])+__uint_as_float(rr[1]);}
  if(hi==0)wsf[32+r32]=l_reg;asm volatile("s_waitcnt lgkmcnt(0)":::"memory");
  float rli[16];
  #pragma unroll
  for(int r=0;r<16;++r)rli[r]=__builtin_amdgcn_rcpf(wsf[32+crow(r,hi)]);
  bf16*Ow=Ob+(long)(wid*QBLK)*OPITCH;
  { bf16*stg=(bf16*)(shm+LDS_OST)+wid*2048;
    #pragma unroll
    for(int r=0;r<16;++r){const int orow=crow(r,hi);
      #pragma unroll
      for(int d0=0;d0<2;++d0)stg[orow*64+d0*32+r32]=__float2bfloat16(o[d0][r]*rli[r]);}
    asm volatile("s_waitcnt lgkmcnt(0)":::"memory");
    #pragma unroll
    for(int i=0;i<4;++i){const int row=i*8+(lane>>3),ch=lane&7; const u32x4 v=*(const u32x4*)(stg+row*64+ch*8); if(wid>=wlo&&wid<whi)ATTN_STORE16(Ow+(long)row*OPITCH+ch*8,v);} }
  asm volatile("s_waitcnt lgkmcnt(0)\n\ts_barrier":::"memory");
  #undef DMA_K
  #undef DMA_V
  #undef CMASK
  #undef START
  #undef RESC
  #undef ROT
  #undef CBLOAD
}
constexpr int ATTN_LDS_BYTES=LDS_BYTES;
#undef SBAR
#undef WAIT_BAR
}
#include <hip/hip_cooperative_groups.h>
namespace cg = cooperative_groups;
#ifndef MK_N_LAUNCHES
#define MK_N_LAUNCHES 1
#endif
#ifndef FOX_PRUNE
#define FOX_PRUNE 1
#endif
constexpr int NWAVES = 8, NTHR = 512;
constexpr int DMOD = 1024, TSEQ = 8192, NBATCH = 8, MP = NBATCH * TSEQ, MS = 512, MTOT = MP + MS;
constexpr int NIN = 3584, INC = 3592, FF = 4096, SSEQ = 1152, PAST = 1024, DSEQ = 32;
constexpr int NCHUNK = MTOT / 64;
constexpr float EPSN = 1e-6f, LOG2E = 1.4426950408889634f;
constexpr size_t MiB = 1u << 20;
constexpr size_t WS_CTL = 0, CTL_ZERO_BYTES = 65536;
constexpr size_t WS_WIN = 2 * MiB, WS_WO = 9 * MiB, WS_WUP = 11 * MiB, WS_WDN = 19 * MiB;
constexpr size_t WS_RSTD = 27 * MiB, WS_CGP = 28 * MiB, WS_CGS = 30 * MiB, WS_VEC = 31 * MiB, WS_SSQ = 38 * MiB;
constexpr size_t WS_X1B = 44 * MiB, WS_MIX = 174 * MiB, WS_H = 304 * MiB;
constexpr size_t WS_XB = 304 * MiB, WS_Q = 434 * MiB, WS_K = 498 * MiB, WS_V = 562 * MiB, WS_QS = 626 * MiB, WS_KS = 635 * MiB, WS_VS = 644 * MiB;
constexpr size_t WS_QR = 654 * MiB, WS_KR = 719 * MiB, WS_VH = 784 * MiB, WS_SG = 849 * MiB, WS_END = 914 * MiB;
constexpr size_t VECN = (size_t)NCHUNK * 512;
static_assert(WS_VEC + 3 * VECN * 4 <= WS_SSQ && WS_SSQ + (size_t)MTOT * 16 * 4 <= WS_X1B && WS_X1B + (size_t)MTOT * DMOD * 2 <= WS_MIX && WS_MIX + (size_t)MTOT * DMOD * 2 <= WS_H, "ws map");
static_assert(WS_H + (size_t)MTOT * FF * 2 <= WS_END && WS_XB + (size_t)MTOT * DMOD * 2 <= WS_Q && WS_SG + (size_t)MTOT * 512 * 2 <= WS_END, "ws map 2");
constexpr int CW_QUEUE = 64, CW_SUB = 128, CW_BAR = 1024, NCHAINWG = 32;
constexpr size_t O_YP = 0, O_YS = O_YP + (size_t)MP * DMOD, O_KP = O_YS + (size_t)256 * DMOD, O_VP = O_KP + (size_t)MP * 512, O_LP = O_VP + (size_t)MP * 512,
                 O_HP = O_LP + (size_t)MP * 8, O_KS = O_HP + 524288, O_VS = O_KS + 131072, O_LS = O_VS + 131072, O_HS = O_LS + 2048, O_END = O_HS + 524288;
constexpr int RING_BYTES = 131072, MISC_OFF = RING_BYTES, LDS_BYTES = 135168;
static_assert(attn_body::ATTN_LDS_BYTES <= RING_BYTES, "attention LDS");

#define LAS __attribute__((address_space(3)))
typedef unsigned short bf16;
typedef unsigned v4u __attribute__((ext_vector_type(4)));
typedef unsigned v2u __attribute__((ext_vector_type(2)));
typedef float f32x4 __attribute__((ext_vector_type(4)));
typedef short bf16x8 __attribute__((ext_vector_type(8)));
#define LDS_WAIT() asm volatile("s_waitcnt lgkmcnt(0)" ::: "memory")
__device__ __forceinline__ unsigned pk2(float lo, float hi) { return pg8::cvt_pk_bf16(lo, hi); }
__device__ __forceinline__ float bf2f(unsigned short b) { return __uint_as_float(((unsigned)b) << 16); }
#define DPPF(v, ctrl) __int_as_float(__builtin_amdgcn_update_dpp(0, __float_as_int(v), (ctrl), 0xf, 0xf, false))
__device__ __forceinline__ float sum8(float v) { v += DPPF(v, 0xB1); v += DPPF(v, 0x4E); v += DPPF(v, 0x141); return v; }
__device__ __forceinline__ float swap16_sum(float a, float b) { auto r = __builtin_amdgcn_permlane16_swap(__float_as_uint(a), __float_as_uint(b), false, false); return __uint_as_float(r[0]) + __uint_as_float(r[1]); }
__device__ __forceinline__ float swap32_sum(float a, float b) { auto r = __builtin_amdgcn_permlane32_swap(__float_as_uint(a), __float_as_uint(b), false, false); return __uint_as_float(r[0]) + __uint_as_float(r[1]); }
__device__ __forceinline__ float wave_sum(float v) { v = sum8(v); v += DPPF(v, 0x140); v = swap16_sum(v, v); v = swap32_sum(v, v); return v; }
__device__ __forceinline__ bool row_map(int row, int& idx) { if (row < MP) { idx = row; return true; } const int rs = row - MP; idx = (rs >> 6) * 32 + (rs & 63); return (rs & 63) < 32; }

namespace pg8 {
struct OrderIn {
    StaticOrder so; int pn_off, extra, extra_pm0, extra_shift;
    __device__ bool next(int i, Unit& u) const {
        const long L = (long)i * so.G + so.c;
        if (L < so.nwg) { so.next(i, u); u.pn += pn_off; return true; }
        const long e = L - so.nwg; if (e >= extra) return false;
        u.pm = extra_pm0 + (int)(e >> extra_shift); u.pn = (int)(e & ((1 << extra_shift) - 1)); u.kofs = 0; return true;
    }
    __device__ __forceinline__ void a_ready(const Unit&) const {}
    __device__ __forceinline__ void done(const Unit&) const {}
};
#define DPP_SHR(v, n) __int_as_float(__builtin_amdgcn_update_dpp(0, __float_as_int(v), 0x110 + (n), 0xf, 0xf, false))
#define PERMA(lane) ((((lane) >> 2) + 16 * ((lane) & 3)) << 2)
__device__ __forceinline__ f32x4 lperm(const f32x4 v, int pa) { f32x4 r;
    r[0] = __int_as_float(__builtin_amdgcn_ds_bpermute(pa, __float_as_int(v[0]))); r[1] = __int_as_float(__builtin_amdgcn_ds_bpermute(pa, __float_as_int(v[1])));
    r[2] = __int_as_float(__builtin_amdgcn_ds_bpermute(pa, __float_as_int(v[2]))); r[3] = __int_as_float(__builtin_amdgcn_ds_bpermute(pa, __float_as_int(v[3]))); return r; }
struct EpiIn {
    static constexpr bool PERM = false, AFTER_DRAIN = false;
    const float* rstd1; const float* lbl; const float* qg; const float* kg; unsigned char* ws; float* out;
    __device__ __forceinline__ void operator()(const f32x4 (&acc)[2][2][4][2], const Unit& u, int wr, int wc, int fr, int fq) const {
        const int pn = u.pn, rowb = u.pm * BM + wr * 64 + fr; const bool samp = u.pm >= (MP / BM);
        bf16_t* const QR = (bf16_t*)(ws + WS_QR); bf16_t* const KR = (bf16_t*)(ws + WS_KR); bf16_t* const VH = (bf16_t*)(ws + WS_VH); bf16_t* const SG = (bf16_t*)(ws + WS_SG); float* const vec = (float*)(ws + WS_VEC);
        float rs[2][4];
#pragma unroll
        for (int ai = 0; ai < 2; ++ai)
#pragma unroll
            for (int m = 0; m < 4; ++m) rs[ai][m] = rstd1[rowb + ai * HALF + m * 16];
        if (pn < 4) {
            const int h = pn, ch0 = 128 * h + 32 * wc + 4 * fq; const int lane = threadIdx.x & 63; const int a15 = ((lane & 48) | 15) << 2;
#pragma unroll
            for (int n = 0; n < 2; ++n) {
                const f32x4 l0 = *(const f32x4*)(lbl + ch0 + 16 * n), l1 = *(const f32x4*)(lbl + 512 + ch0 + 16 * n);
                f32x4 lb, omlb;
#pragma unroll
                for (int j = 0; j < 4; ++j) { lb[j] = __builtin_amdgcn_rcpf(1.f + __expf(l1[j] - l0[j])); omlb[j] = 1.f - lb[j]; }
#pragma unroll
                for (int ai = 0; ai < 2; ++ai) {
                    f32x4 bq[4], kk[4], bb[4]; f32x4 carry = {0.f, 0.f, 0.f, 0.f};
#pragma unroll
                    for (int m = 0; m < 4; ++m) {
#pragma unroll
                        for (int j = 0; j < 4; ++j) {
                            const float zq = acc[ai][0][m][n][j] * rs[ai][m], zf = acc[ai][1][m][n][j] * rs[ai][m];
                            const float sig = __builtin_amdgcn_rcpf(1.f + __expf(-zf)); const float f = lb[j] + omlb[j] * sig; float k = omlb[j] * (1.f - sig); float s = __logf(f);
                            if (samp && m >= 2) { s = 0.f; k = 0.f; }
                            s += DPP_SHR(s, 1); s += DPP_SHR(s, 2); s += DPP_SHR(s, 4); s += DPP_SHR(s, 8);
                            s += carry[j]; carry[j] = __int_as_float(__builtin_amdgcn_ds_bpermute(a15, __float_as_int(s)));
                            bq[m][j] = zq; kk[m][j] = k; bb[m][j] = s;
                        }
                    }
#pragma unroll
                    for (int m = 0; m < 4; ++m) {
                        float qv[4], kv[4];
#pragma unroll
                        for (int j = 0; j < 4; ++j) { qv[j] = bq[m][j] * __expf(bb[m][j]); kv[j] = kk[m][j] * __expf(-bb[m][j]); }
                        const size_t off = (size_t)(rowb + ai * HALF + m * 16) * 512 + ch0 + 16 * n;
                        v2u wq; wq.x = cvt_pk_bf16(qv[0], qv[1]); wq.y = cvt_pk_bf16(qv[2], qv[3]); *(v2u*)(QR + off) = wq;
                        v2u wk; wk.x = cvt_pk_bf16(kv[0], kv[1]); wk.y = cvt_pk_bf16(kv[2], kv[3]); *(v2u*)(KR + off) = wk;
                    }
                    if (fr == 0) {
                        const size_t voff = (size_t)((u.pm * BM + ai * HALF + wr * 64) >> 6) * 512 + ch0 + 16 * n;
                        f32x4 d;
#pragma unroll
                        for (int j = 0; j < 4; ++j) d[j] = __expf(carry[j]);
                        *(f32x4*)(vec + voff) = d;
                    }
                }
            }
        } else if (pn < 8) {
            const int h = pn - 4, c0 = 128 * h + 32 * wc + 4 * fq;
#pragma unroll
            for (int ai = 0; ai < 2; ++ai)
#pragma unroll
                for (int m = 0; m < 4; ++m) { const size_t off = (size_t)(rowb + ai * HALF + m * 16) * 512 + c0; const float r = rs[ai][m];
#pragma unroll
                    for (int n = 0; n < 2; ++n) { const f32x4 v = acc[ai][0][m][n] * r; f32x4 g = acc[ai][1][m][n] * r;
#pragma unroll
                        for (int j = 0; j < 4; ++j) g[j] = g[j] * __builtin_amdgcn_rcpf(1.f + __expf(-g[j]));
                        v2u wv; wv.x = cvt_pk_bf16(v[0], v[1]); wv.y = cvt_pk_bf16(v[2], v[3]); *(v2u*)(VH + off + 16 * n) = wv;
                        v2u wg; wg.x = cvt_pk_bf16(g[0], g[1]); wg.y = cvt_pk_bf16(g[2], g[3]); *(v2u*)(SG + off + 16 * n) = wg; } }
        } else if (pn < 12) {
            const bool isK = pn >= 10; const int head = 4 * ((pn - 8) & 1) + wc; const float* gain = isK ? kg : qg; const float osc = isK ? 1.f : attn_body::C2;
            f32x4 gv[2][2];
#pragma unroll
            for (int bj = 0; bj < 2; ++bj)
#pragma unroll
                for (int n = 0; n < 2; ++n) gv[bj][n] = *(const f32x4*)(gain + 32 * bj + 16 * n + 4 * fq) * osc;
#pragma unroll
            for (int ai = 0; ai < 2; ++ai)
#pragma unroll
                for (int m = 0; m < 4; ++m) { const int row = rowb + ai * HALF + m * 16; const float r = rs[ai][m]; float ssq = 0.f;
#pragma unroll
                    for (int bj = 0; bj < 2; ++bj)
#pragma unroll
                        for (int n = 0; n < 2; ++n) { const f32x4 z = acc[ai][bj][m][n] * r; ssq += (z[0] * z[0] + z[1] * z[1]) + (z[2] * z[2] + z[3] * z[3]); }
                    ssq += __shfl_xor(ssq, 16); ssq += __shfl_xor(ssq, 32);
                    const float r2 = r * __builtin_amdgcn_rsqf(ssq * (1.f / 64.f) + EPSN);
                    int idx; const bool valid = row_map(row, idx);
                    float* ofp = out + (samp ? O_KS : O_KP) + (size_t)idx * 512;
                    const size_t boff = samp ? (isK ? WS_KS : WS_QS) : (isK ? WS_K : WS_Q); const size_t brow = samp ? (size_t)((idx >> 5) * SSEQ + PAST + (idx & 31)) : (size_t)row;
                    bf16_t* bfp = (bf16_t*)(ws + boff) + brow * 512;
                    if (valid) {
#pragma unroll
                        for (int bj = 0; bj < 2; ++bj)
#pragma unroll
                            for (int n = 0; n < 2; ++n) { const f32x4 v = acc[ai][bj][m][n] * r2 * gv[bj][n]; const int col = 64 * head + 32 * bj + 16 * n + 4 * fq;
                                if (isK) *(f32x4*)(ofp + col) = v;
                                v2u w; w.x = cvt_pk_bf16(v[0], v[1]); w.y = cvt_pk_bf16(v[2], v[3]); *(v2u*)(bfp + col) = w; } } }
        } else {
            const int c0 = 256 * (pn - 12) + 32 * wc + 4 * fq;
#pragma unroll
            for (int ai = 0; ai < 2; ++ai)
#pragma unroll
                for (int m = 0; m < 4; ++m) { const int row = rowb + ai * HALF + m * 16; const float r = rs[ai][m];
                    int idx; const bool valid = row_map(row, idx);
                    float* ofp = out + (samp ? O_VS : O_VP) + (size_t)idx * 512;
                    const size_t brow = samp ? (size_t)((idx >> 5) * SSEQ + PAST + (idx & 31)) : (size_t)row;
                    bf16_t* bfp = (bf16_t*)(ws + (samp ? WS_VS : WS_V)) + brow * 512;
                    if (valid) {
#pragma unroll
                        for (int bj = 0; bj < 2; ++bj)
#pragma unroll
                            for (int n = 0; n < 2; ++n) { const f32x4 v = acc[ai][bj][m][n] * r; const int col = c0 + 128 * bj + 16 * n;
                                *(f32x4*)(ofp + col) = v;
                                v2u w; w.x = cvt_pk_bf16(v[0], v[1]); w.y = cvt_pk_bf16(v[2], v[3]); *(v2u*)(bfp + col) = w; } } }
        }
    }
};
struct EpiWo {
    static constexpr bool PERM = false, AFTER_DRAIN = false;
    const bf16_t* XBp; const float* xs; float* yp; float* ys; bf16_t* X1B; float* ssq;
    __device__ __forceinline__ void operator()(const f32x4 (&acc)[2][2][4][2], const Unit& u, int wr, int wc, int fr, int fq) const {
        const int lane = threadIdx.x & 63, pa = PERMA(lane); fr = lane >> 2; fq = lane & 3;
        const int rowb = u.pm * BM + wr * 64 + fr, c0 = u.pn * BM + wc * 32 + 4 * fq; const bool samp = u.pm >= (MP / BM);
#pragma unroll
        for (int ai = 0; ai < 2; ++ai) {
            f32x4 xv[4][2][2];
            if (samp) {
#pragma unroll
                for (int m = 0; m < 4; ++m) { const int row = rowb + ai * HALF + m * 16; int idx; const bool valid = row_map(row, idx); const float* xr = xs + (size_t)idx * DMOD;
#pragma unroll
                    for (int bj = 0; bj < 2; ++bj)
#pragma unroll
                        for (int n = 0; n < 2; ++n) xv[m][bj][n] = valid ? *(const f32x4*)(xr + c0 + 128 * bj + 16 * n) : (f32x4){0.f, 0.f, 0.f, 0.f}; }
            } else {
                v2u xb[4][2][2];
#pragma unroll
                for (int m = 0; m < 4; ++m) { const bf16_t* xr = XBp + (size_t)(rowb + ai * HALF + m * 16) * DMOD;
#pragma unroll
                    for (int bj = 0; bj < 2; ++bj)
#pragma unroll
                        for (int n = 0; n < 2; ++n) xb[m][bj][n] = *(const v2u*)(xr + c0 + 128 * bj + 16 * n); }
                __builtin_amdgcn_sched_barrier(0);
#pragma unroll
                for (int m = 0; m < 4; ++m)
#pragma unroll
                    for (int bj = 0; bj < 2; ++bj)
#pragma unroll
                        for (int n = 0; n < 2; ++n) { const v2u w = xb[m][bj][n]; xv[m][bj][n] = (f32x4){__uint_as_float(w.x << 16), __uint_as_float(w.x & 0xffff0000u), __uint_as_float(w.y << 16), __uint_as_float(w.y & 0xffff0000u)}; }
            }
            __builtin_amdgcn_sched_barrier(0);
#pragma unroll
            for (int m = 0; m < 4; ++m) { const int row = rowb + ai * HALF + m * 16; int idx; const bool valid = row_map(row, idx);
                float* yr = yp + (samp ? (size_t)MP * DMOD : (size_t)0) + (size_t)idx * DMOD; float s = 0.f;
#pragma unroll
                for (int bj = 0; bj < 2; ++bj)
#pragma unroll
                    for (int n = 0; n < 2; ++n) { const int col = c0 + 128 * bj + 16 * n; f32x4 v = lperm(acc[ai][bj][m][n], pa) + xv[m][bj][n];
                        if (samp && valid) *(f32x4*)(yr + col) = v;
                        s += (v[0] * v[0] + v[1] * v[1]) + (v[2] * v[2] + v[3] * v[3]);
                        v2u w; w.x = cvt_pk_bf16(v[0], v[1]); w.y = cvt_pk_bf16(v[2], v[3]); *(v2u*)(X1B + (size_t)row * DMOD + col) = w; }
                s += __shfl_xor(s, 1); s += __shfl_xor(s, 2);
                if (fq == 0) ssq[(size_t)row * 16 + 4 * u.pn + wc] = s; }
            __builtin_amdgcn_sched_barrier(0);
        }
    }
};
struct EpiUp {
    static constexpr bool PERM = true, AFTER_DRAIN = false;
    bf16_t* O; const float* ssq;
    __device__ __forceinline__ void operator()(const f32x4 (&acc)[2][2][4][2], const Unit& u, int wr, int wc, int fr, int fq) const {
        const int row0 = u.pm * BM + wr * 64 + fr, col0 = u.pn * BM + wc * 32 + 8 * fq;
        float rr[2][4];
#pragma unroll
        for (int ai = 0; ai < 2; ++ai) { f32x4 sv[4][4];
#pragma unroll
            for (int m = 0; m < 4; ++m) { const f32x4* sp = (const f32x4*)(ssq + (size_t)(row0 + ai * HALF + m * 16) * 16); sv[m][0] = sp[0]; sv[m][1] = sp[1]; sv[m][2] = sp[2]; sv[m][3] = sp[3]; }
            __builtin_amdgcn_sched_barrier(0);
#pragma unroll
            for (int m = 0; m < 4; ++m) { const f32x4 st = (sv[m][0] + sv[m][1]) + (sv[m][2] + sv[m][3]); rr[ai][m] = __builtin_amdgcn_rsqf(((st[0] + st[1]) + (st[2] + st[3])) * (1.f / DMOD) + EPSN); } }
#pragma unroll
        for (int ai = 0; ai < 2; ++ai)
#pragma unroll
            for (int m = 0; m < 4; ++m) { const int row = row0 + ai * HALF + m * 16;
                const float r = rr[ai][m];
                bf16_t* rowp = O + (size_t)row * FF + col0;
#pragma unroll
                for (int bj = 0; bj < 2; ++bj) { f32x4 v0 = acc[ai][bj][m][0] * r, v1 = acc[ai][bj][m][1] * r;
#pragma unroll
                    for (int j = 0; j < 4; ++j) { v0[j] = fmaxf(v0[j], 0.f); v0[j] *= v0[j]; v1[j] = fmaxf(v1[j], 0.f); v1[j] *= v1[j]; }
                    u32x4 w; w.x = cvt_pk_bf16(v0[0], v0[1]); w.y = cvt_pk_bf16(v0[2], v0[3]); w.z = cvt_pk_bf16(v1[0], v1[1]); w.w = cvt_pk_bf16(v1[2], v1[3]);
                    *(u32x4*)(rowp + bj * HALF) = w; } }
    }
};
struct OrderDown {
    StaticOrder so; int mode;
    static constexpr int KSPLIT = 4;
    __device__ bool next(int i, Unit& u) const {
        if (mode) return so.next(i, u);
        const long L = (long)i * so.G + so.c; if (L >= 8 * KSPLIT) return false;
        const int t = (int)L / KSPLIT, ks = (int)L % KSPLIT; u.pm = MP / BM + (t >> 2); u.pn = t & 3; u.kofs = ks * (FF / KSPLIT); return true;
    }
    __device__ __forceinline__ void a_ready(const Unit&) const {}
    __device__ __forceinline__ void done(const Unit&) const {}
};
struct EpiDown {
    static constexpr bool PERM = false, AFTER_DRAIN = false;
    float* yp; float* ys; const bf16_t* X1B; int atomic;
    __device__ __forceinline__ void operator()(const f32x4 (&acc)[2][2][4][2], const Unit& u, int wr, int wc, int fr, int fq) const {
        const int lane = threadIdx.x & 63, pa = PERMA(lane); fr = lane >> 2; fq = lane & 3;
        const int rowb = u.pm * BM + wr * 64 + fr, c0 = u.pn * BM + wc * 32 + 4 * fq; const bool samp = u.pm >= (MP / BM);
#pragma unroll
        for (int ai = 0; ai < 2; ++ai) {
            f32x4 xv[4][2][2];
            if (!atomic) {
                v2u xb[4][2][2];
#pragma unroll
                for (int m = 0; m < 4; ++m) { const bf16_t* xr = X1B + (size_t)(rowb + ai * HALF + m * 16) * DMOD;
#pragma unroll
                    for (int bj = 0; bj < 2; ++bj)
#pragma unroll
                        for (int n = 0; n < 2; ++n) xb[m][bj][n] = *(const v2u*)(xr + c0 + 128 * bj + 16 * n); }
                __builtin_amdgcn_sched_barrier(0);
#pragma unroll
                for (int m = 0; m < 4; ++m)
#pragma unroll
                    for (int bj = 0; bj < 2; ++bj)
#pragma unroll
                        for (int n = 0; n < 2; ++n) { const v2u w = xb[m][bj][n]; xv[m][bj][n] = (f32x4){__uint_as_float(w.x << 16), __uint_as_float(w.x & 0xffff0000u), __uint_as_float(w.y << 16), __uint_as_float(w.y & 0xffff0000u)}; }
            }
            __builtin_amdgcn_sched_barrier(0);
#pragma unroll
            for (int m = 0; m < 4; ++m) { const int row = rowb + ai * HALF + m * 16; int idx; const bool valid = row_map(row, idx);
                float* yr = yp + (samp ? (size_t)MP * DMOD : (size_t)0) + (size_t)idx * DMOD;
                if (valid) {
#pragma unroll
                    for (int bj = 0; bj < 2; ++bj)
#pragma unroll
                        for (int n = 0; n < 2; ++n) { const int col = c0 + 128 * bj + 16 * n; const f32x4 v = lperm(acc[ai][bj][m][n], pa);
                            if (atomic) {
#pragma unroll
                                for (int j = 0; j < 4; ++j) __hip_atomic_fetch_add(yr + col + j, v[j], __ATOMIC_RELAXED, __HIP_MEMORY_SCOPE_AGENT);
                            } else *(f32x4*)(yr + col) = xv[m][bj][n] + v; } } }
            __builtin_amdgcn_sched_barrier(0);
        }
    }
};
}

#define XB_TMO      128
#define XB_XCNT(j)  (256  + 64 * (j))
#define XB_XSUB(j)  (1280 + 64 * (j))
#define XB_XGEN(j)  (2304 + 64 * (j))
#define XB_TOP      3328
#define XB_TOPGEN   3392
#define XCD_BAR_WORDS 3456
#define XB_SPIN_CAP (1u << 18)

__device__ __forceinline__ unsigned xb_ld(unsigned* p)              { return __hip_atomic_load(p, __ATOMIC_RELAXED, __HIP_MEMORY_SCOPE_AGENT); }
__device__ __forceinline__ unsigned xb_add(unsigned* p, unsigned v) { return __hip_atomic_fetch_add(p, v, __ATOMIC_RELAXED, __HIP_MEMORY_SCOPE_AGENT); }
__device__ __forceinline__ unsigned xb_xcc_id() { return (unsigned)__builtin_amdgcn_s_getreg((3 << 11) | 20) & 0xFu; }
#define XB_SPIN(cond, bar) do { unsigned _sp = 0; while (cond) { __builtin_amdgcn_s_sleep(1); \
    if ((++_sp & 255u) == 0u) { if (xb_ld(&(bar)[XB_TMO])) break; if (_sp > XB_SPIN_CAP) { atomicAdd(&(bar)[XB_TMO], 1u); break; } } } } while (0)

struct XcdBarrier {
    unsigned* bar; unsigned x;
    volatile LAS unsigned* st;
};

__device__ __forceinline__ XcdBarrier xcd_barrier_post(unsigned* bar, volatile LAS unsigned* st) {
    XcdBarrier b; b.bar = bar; b.x = xb_xcc_id(); b.st = st;
    if (threadIdx.x == 0) (void)xb_add(&bar[XB_XCNT(b.x)], 1u);
    return b;
}
__device__ __forceinline__ void xcd_barrier_complete(unsigned* bar, unsigned x, unsigned& nloc, unsigned& nx) {
    const unsigned G = gridDim.x * gridDim.y * gridDim.z;
    unsigned sum, cnt, mine, sp = 0u;
    for (;;) {
        sum = 0u; cnt = 0u; mine = 0u;
#pragma unroll
        for (unsigned j = 0; j < 16; ++j) { const unsigned c = xb_ld(&bar[XB_XCNT(j)]); sum += c; cnt += (c > 0u) ? 1u : 0u; mine = (j == x) ? c : mine; }
        if (sum == G) break;
        __builtin_amdgcn_s_sleep(1);
        if ((++sp & 255u) == 0u) { if (xb_ld(&bar[XB_TMO])) break; if (sp > XB_SPIN_CAP) { atomicAdd(&bar[XB_TMO], 1u); break; } }
    }
    nloc = mine > 0u ? mine : 1u; nx = cnt > 0u ? cnt : 1u;
}

__device__ __forceinline__ void xcd_barrier(const XcdBarrier& b) {
    asm volatile("s_waitcnt vmcnt(0)" ::: "memory");
    __syncthreads();
    if (threadIdx.x == 0) {
        unsigned* bar = b.bar;
        __builtin_amdgcn_s_waitcnt(0);
        unsigned nloc = b.st[0], nx = b.st[1];
        if (nloc == 0u) { xcd_barrier_complete(bar, b.x, nloc, nx); b.st[0] = nloc; b.st[1] = nx; }
        const unsigned old = xb_add(&bar[XB_XSUB(b.x)], 1u);
        const unsigned gen = old / nloc;
        if (old + 1u == (gen + 1u) * nloc) {
            __builtin_amdgcn_fence(__ATOMIC_RELEASE, "agent");
            asm volatile("s_waitcnt vmcnt(0)" ::: "memory");
            const unsigned og = xb_add(&bar[XB_TOP], 1u);
            const unsigned tg = og / nx;
            if (og + 1u == (tg + 1u) * nx) xb_add(&bar[XB_TOPGEN], 1u);
            else XB_SPIN(xb_ld(&bar[XB_TOPGEN]) == tg, bar);
            __builtin_amdgcn_fence(__ATOMIC_ACQUIRE, "agent");
            xb_add(&bar[XB_XGEN(b.x)], 1u);
            asm volatile("s_waitcnt vmcnt(0)" ::: "memory");
        } else {
            XB_SPIN(xb_ld(&bar[XB_XGEN(b.x)]) == gen, bar);
            __builtin_amdgcn_fence(__ATOMIC_ACQUIRE, "agent");
            asm volatile("s_waitcnt vmcnt(0)" ::: "memory");
        }
    }
    __syncthreads();
}

struct Args { const float* in[17]; float* out; unsigned char* ws; int ph_lo, ph_hi; };
struct Frame {
    LAS unsigned char* lds; volatile LAS unsigned* MISC; unsigned* ctl; unsigned char* ws; float* out;
    int tid, lane, wave, vcu, G;
    const float *xp, *xs, *ck, *cv, *clf, *sh, *n1, *win, *bff, *qg, *kg, *lbl, *hon, *wout, *n2, *wup, *wdn;
};

__device__ __forceinline__ int win_src_col(int g) {
    const int j0 = 32 * g, tile = j0 >> 8, jl = j0 & 255;
    if (tile < 4) return (jl < 128) ? (128 * tile + jl) : (512 + 128 * tile + (jl - 128));
    if (tile < 8) { const int h = tile - 4; return (jl < 128) ? (1024 + 128 * h + jl) : (1536 + 128 * h + (jl - 128)); }
    if (tile < 12) { const int base = tile < 10 ? 2048 : 2560, tl = (tile - 8) & 1, bj = jl >> 7, wc = (jl >> 5) & 3; return base + 64 * (4 * tl + wc) + 32 * bj; }
    return 3072 + (j0 - 12 * 256);
}
__device__ __forceinline__ void p0_transpose_item(const float* W, int ldw, int K, const float* nrm, bf16* WT, int n0, int src0, int k0, LAS float* scr, int lane) {
    float vals[32]; const float* wp = W + (size_t)(k0 + (lane >> 5)) * ldw + src0 + (lane & 31);
#pragma unroll
    for (int i = 0; i < 32; ++i) vals[i] = wp[(size_t)(2 * i) * ldw];
    const int c = lane & 7;
    f32x4 n0v = {1.f, 1.f, 1.f, 1.f}, n1v = {1.f, 1.f, 1.f, 1.f};
    if (nrm) { n0v = *(const f32x4*)(nrm + k0 + 8 * c); n1v = *(const f32x4*)(nrm + k0 + 8 * c + 4); }
#pragma unroll
    for (int i = 0; i < 32; ++i) scr[(2 * i + (lane >> 5)) * 33 + (lane & 31)] = vals[i];
    LDS_WAIT(); asm volatile("" ::: "memory");
#pragma unroll
    for (int j = 0; j < 4; ++j) { const int n = (lane >> 3) + 8 * j; const LAS float* s = scr + (8 * c) * 33 + n;
        v4u o; o.x = pk2(s[0 * 33] * n0v[0], s[1 * 33] * n0v[1]); o.y = pk2(s[2 * 33] * n0v[2], s[3 * 33] * n0v[3]); o.z = pk2(s[4 * 33] * n1v[0], s[5 * 33] * n1v[1]); o.w = pk2(s[6 * 33] * n1v[2], s[7 * 33] * n1v[3]);
        *(v4u*)(WT + (size_t)(n0 + n) * K + k0 + 8 * c) = o; }
    LDS_WAIT(); asm volatile("" ::: "memory");
}
__device__ __forceinline__ void p0_prologue(Frame& F) {
    LAS float* scr = (LAS float*)(F.lds + F.wave * 16384);
    const int gw = F.vcu * NWAVES + F.wave, NGW = F.G * NWAVES, lane = F.lane;
    bf16* Win_t = (bf16*)(F.ws + WS_WIN); bf16* Wo_t = (bf16*)(F.ws + WS_WO); bf16* Wup_t = (bf16*)(F.ws + WS_WUP); bf16* Wdn_t = (bf16*)(F.ws + WS_WDN);
    constexpr int I_IN = 16 * (NIN / 32), I_O = 16 * 32, I_UP = 16 * (FF / 32), I_DN = 64 * 32, NITEMS = I_IN + I_O + I_UP + I_DN;
    for (int it = gw; it < NITEMS; it += NGW) {
        int r = it;
        if (r < I_IN) { const int kb = r / (NIN / 32), g = r % (NIN / 32); p0_transpose_item(F.win, INC, DMOD, F.n1, Win_t, 32 * g, win_src_col(g), 64 * kb, scr, lane); continue; } r -= I_IN;
        if (r < I_O) { const int kb = r / 32, g = r % 32; p0_transpose_item(F.wout, DMOD, DMOD, nullptr, Wo_t, 32 * g, 32 * g, 64 * kb, scr, lane); continue; } r -= I_O;
        if (r < I_UP) { const int kb = r / (FF / 32), g = r % (FF / 32); p0_transpose_item(F.wup, FF, DMOD, F.n2, Wup_t, 32 * g, 32 * g, 64 * kb, scr, lane); continue; } r -= I_UP;
        { const int kb = r / 32, g = r % 32; p0_transpose_item(F.wdn, DMOD, FF, nullptr, Wdn_t, 32 * g, 32 * g, 64 * kb, scr, lane); }
    }
    { const int gt = F.vcu * NTHR + F.tid, NGT = F.G * NTHR;
      bf16* Qs = (bf16*)(F.ws + WS_QS); bf16* Ks = (bf16*)(F.ws + WS_KS); bf16* Vs = (bf16*)(F.ws + WS_VS);
      for (int i = gt; i < NBATCH * PAST * 64; i += NGT) { const int b = i / (PAST * 64), rem = i % (PAST * 64); const size_t so = (size_t)i * 8, dof = ((size_t)b * SSEQ * 64 + rem) * 8;
          const f32x4 a0 = *(const f32x4*)(F.ck + so), a1 = *(const f32x4*)(F.ck + so + 4), b0 = *(const f32x4*)(F.cv + so), b1 = *(const f32x4*)(F.cv + so + 4);
          v4u o; o.x = pk2(a0[0], a0[1]); o.y = pk2(a0[2], a0[3]); o.z = pk2(a1[0], a1[1]); o.w = pk2(a1[2], a1[3]); *(v4u*)(Ks + dof) = o;
          o.x = pk2(b0[0], b0[1]); o.y = pk2(b0[2], b0[3]); o.z = pk2(b1[0], b1[1]); o.w = pk2(b1[2], b1[3]); *(v4u*)(Vs + dof) = o; }
      const v4u z = {0u, 0u, 0u, 0u};
      for (int i = gt; i < NBATCH * SSEQ * 64; i += NGT) *(v4u*)(Qs + (size_t)i * 8) = z;
      for (int i = gt; i < NBATCH * (SSEQ - PAST) * 64; i += NGT) { const int b = i / ((SSEQ - PAST) * 64), rem = i % ((SSEQ - PAST) * 64); const size_t dof = ((size_t)(b * SSEQ + PAST) * 64 + rem) * 8; *(v4u*)(Ks + dof) = z; *(v4u*)(Vs + dof) = z; }
    }
    float wf[4][4][8];
#pragma unroll
    for (int j = 0; j < 4; ++j)
#pragma unroll
        for (int i = 0; i < 4; ++i) { const int k = 256 * j + 4 * lane + i; const float nk = F.n1[k]; const f32x4 a = *(const f32x4*)(F.win + (size_t)k * INC + NIN), b = *(const f32x4*)(F.win + (size_t)k * INC + NIN + 4);
            wf[j][i][0] = a[0] * nk; wf[j][i][1] = a[1] * nk; wf[j][i][2] = a[2] * nk; wf[j][i][3] = a[3] * nk; wf[j][i][4] = b[0] * nk; wf[j][i][5] = b[1] * nk; wf[j][i][6] = b[2] * nk; wf[j][i][7] = b[3] * nk; }
    float* rstd1 = (float*)(F.ws + WS_RSTD); bf16* XB = (bf16*)(F.ws + WS_XB);
    f32x4 vn[4];
#define P0_LOADROW(mm) do { int idx_; const bool val_ = (mm) < MTOT && row_map((mm), idx_); const float* xr_ = ((mm) < MP ? F.xp : F.xs) + (size_t)idx_ * DMOD; \
        _Pragma("unroll") for (int j = 0; j < 4; ++j) vn[j] = val_ ? *((const f32x4*)xr_ + 64 * j + lane) : (f32x4){0.f, 0.f, 0.f, 0.f}; } while (0)
    P0_LOADROW(gw);
    for (int m = gw; m < MTOT; m += NGW) {
        int idx; const bool valid = row_map(m, idx);
        f32x4 v[4]; float s = 0.f;
#pragma unroll
        for (int j = 0; j < 4; ++j) v[j] = vn[j];
        P0_LOADROW(m + NGW);
#pragma unroll
        for (int j = 0; j < 4; ++j) s += (v[j][0] * v[j][0] + v[j][1] * v[j][1]) + (v[j][2] * v[j][2] + v[j][3] * v[j][3]);
        const float rstd = 1.f / sqrtf(wave_sum(s) * (1.f / DMOD) + EPSN);
        if (lane == 0) rstd1[m] = rstd;
        unsigned long long* o8 = (unsigned long long*)(XB + (size_t)m * DMOD) + lane;
#pragma unroll
        for (int j = 0; j < 4; ++j) o8[64 * j] = (unsigned long long)pk2(v[j][0], v[j][1]) | ((unsigned long long)pk2(v[j][2], v[j][3]) << 32);
        float a8[8];
#pragma unroll
        for (int h = 0; h < 8; ++h) { float a = 0.f;
#pragma unroll
            for (int j = 0; j < 4; ++j)
#pragma unroll
                for (int i = 0; i < 4; ++i) a += v[j][i] * wf[j][i][h];
            a8[h] = a; }
        float b4[4], c2[2], dsum;
#pragma unroll
        for (int i = 0; i < 4; ++i) b4[i] = swap32_sum(a8[i], a8[4 + i]);
#pragma unroll
        for (int i = 0; i < 2; ++i) c2[i] = swap16_sum(b4[i], b4[2 + i]);
        { const bool hi_ = (lane & 8) != 0; const float send = hi_ ? c2[0] : c2[1], keep = hi_ ? c2[1] : c2[0]; dsum = keep + DPPF(send, 0x128); }
        dsum = sum8(dsum);
        { const int hh = (lane >> 3) & 7; const float xx = dsum * rstd + F.bff[hh]; const float ls = fminf(xx, 0.f) - log1pf(expf(-fabsf(xx)));
          if (valid && (lane & 7) == 0) { float* lp = (m < MP ? F.out + O_LP : F.out + O_LS) + (size_t)idx * 8; lp[hh] = ls; } }
    }
}
__device__ __forceinline__ void scan_chain(Frame& F, int ch) {
    LAS float* wsum = (LAS float*)F.lds;
    const bool samp = ch >= 64; const int c2 = samp ? ch - 64 : ch, b = c2 >> 3, h = c2 & 7; const int L = samp ? SSEQ : TSEQ, EPT = samp ? 3 : 16;
    float* dst = samp ? (float*)(F.ws + WS_CGS) + (size_t)c2 * SSEQ : (float*)(F.ws + WS_CGP) + (size_t)c2 * TSEQ;
    float vals[16]; float sum = 0.f;
#pragma unroll
    for (int i = 0; i < 16; ++i) { const int p = F.tid * EPT + i; float v = 0.f;
        if (i < EPT && p < L) { if (!samp) v = F.out[O_LP + ((size_t)b * TSEQ + p) * 8 + h]; else if (p < PAST) v = F.clf[((size_t)b * PAST + p) * 8 + h]; else if (p < PAST + DSEQ) v = F.out[O_LS + ((size_t)b * DSEQ + (p - PAST)) * 8 + h]; }
        sum += v; vals[i] = sum; }
    float incl = sum;
#pragma unroll
    for (int o = 1; o < 64; o <<= 1) { const float t = __shfl_up(incl, o); if (F.lane >= o) incl += t; }
    if (F.lane == 63) wsum[F.wave] = incl;
    __syncthreads();
    float base = 0.f;
    for (int w = 0; w < F.wave; ++w) base += wsum[w];
    const float excl = base + incl - sum;
#pragma unroll
    for (int i = 0; i < 16; ++i) { const int p = F.tid * EPT + i; if (i < EPT && p < L) dst[p] = (excl + vals[i]) * LOG2E; }
    __syncthreads();
}
constexpr int KP = 320  , H_QR = 0, H_KR = 17408, H_KT = 37888, H_VT = 58368, H_VEC = 71680, H_AL = 73216, H_OL = 82432, H_END = 116224;
static_assert(H_END <= RING_BYTES, "hgrn LDS");
typedef short v4i16_t __attribute__((ext_vector_type(4)));
__device__ __forceinline__ bf16x8 tr_frag(LAS unsigned char* p) {
    const v4i16_t lo = __builtin_amdgcn_ds_read_tr16_b64_v4i16((LAS v4i16_t*)p), hi = __builtin_amdgcn_ds_read_tr16_b64_v4i16((LAS v4i16_t*)(p + 4 * KP));
    return (bf16x8){lo[0], lo[1], lo[2], lo[3], hi[0], hi[1], hi[2], hi[3]};
}
__device__ __forceinline__ f32x4 mfma16(bf16x8 a, bf16x8 b, f32x4 c) { return __builtin_amdgcn_mfma_f32_16x16x32_bf16(a, b, c, 0, 0, 0); }
#define LAUNDER(x) asm volatile("" : "+v"(x))
#ifndef PR_A
#define PR_A 1
#endif
#ifndef PR_O
#define PR_O 1
#endif
#ifndef PR_OUT
#define PR_OUT 1
#endif
#ifndef PR_U
#define PR_U 0
#endif
#ifndef PR_ST
#define PR_ST 1
#endif
#ifndef PR_BAR
#define PR_BAR 1
#endif
#define HG_BAR() do { for (int rb_ = 0; rb_ < PR_BAR; ++rb_) { asm volatile("s_waitcnt lgkmcnt(0)" ::: "memory"); __builtin_amdgcn_s_barrier(); asm volatile("" ::: "memory"); } } while (0)
__device__ __forceinline__ void hgrn_chain(Frame& F, int row0, int chunk0, int nsteps, int h, const float* S0, float* Sout) {
    LAS unsigned char* L = F.lds; int tid_ = F.tid; LAUNDER(tid_); const int tid = tid_, lane = tid & 63, w = F.wave, l15 = lane & 15, fq = lane >> 4;
    const char* qb = (const char*)(F.ws + WS_QR) + ((size_t)row0 * 512 + 128 * h) * 2; const char* kb_ = (const char*)(F.ws + WS_KR) + ((size_t)row0 * 512 + 128 * h) * 2;
    const char* vb = (const char*)(F.ws + WS_VH) + ((size_t)row0 * 512 + 128 * h) * 2; const char* gb = (const char*)(F.ws + WS_SG) + ((size_t)row0 * 512 + 128 * h) * 2;
    const char* eb = (const char*)(F.ws + WS_VEC) + ((size_t)chunk0 * 512 + 128 * h) * 4; char* mb = (char*)(F.ws + WS_MIX) + ((size_t)row0 * DMOD + 128 * h) * 2;
    const int oc = tid >> 3, oseg = tid & 7;
    unsigned vo_rm = (unsigned)((tid >> 4) * 1024 + (tid & 15) * 16), vo_sg = (unsigned)(oc * 1024 + oseg * 32), vo_mix = (unsigned)(oc * 2048 + oseg * 32);
    unsigned vo_vec = (unsigned)((tid & 31) * 16);
    unsigned l_rm = (unsigned)(H_QR + (tid >> 4) * 272 + (tid & 15) * 16), l_rk = (unsigned)(H_KR + (tid >> 4) * KP + (tid & 15) * 16);
    unsigned l_vw = (unsigned)(H_VEC + (tid & 31) * 16);
    unsigned l_aq = (unsigned)(H_QR + (16 * (w >> 1) + l15) * 272 + fq * 16);
    unsigned l_ak = (unsigned)(H_KR + (32 * (w & 1) + l15) * KP + fq * 16);
    unsigned l_aw = (unsigned)(H_AL + (16 * (w >> 1) + 4 * fq) * 144 + (32 * (w & 1) + l15) * 2);
    unsigned l_vt = (unsigned)(H_KT + (8 * fq + (l15 >> 2)) * KP + (16 * w + 4 * (l15 & 3)) * 2);
    unsigned l_q2 = (unsigned)(H_QR + l15 * 272 + fq * 16);
    unsigned l_al = (unsigned)(H_AL + l15 * 144 + fq * 16);
    unsigned l_kt = (unsigned)(H_KR + (8 * fq + (l15 >> 2)) * KP + (8 * (l15 & 3)) * 2);
    unsigned l_ve = (unsigned)(H_VEC + fq * 32);
    unsigned l_ow = (unsigned)(H_OL + (4 * fq) * 528 + (16 * w + l15) * 4);
    unsigned l_or = (unsigned)(H_OL + oc * 528 + oseg * 64);
    f32x4 S[8];
#pragma unroll
    for (int kb = 0; kb < 8; ++kb) S[kb] = (f32x4){0.f, 0.f, 0.f, 0.f};
    if (S0) { const float* sp = S0 + (8 * fq) * 128 + 16 * w + l15;
#pragma unroll
        for (int kb = 0; kb < 8; ++kb) { LAUNDER(sp);
#pragma unroll
            for (int r = 0; r < 4; ++r) S[kb][r] = sp[r * 128];
            sp += (kb & 1) ? 28 * 128 : 4 * 128; } }
    f32x4 gn[4];
#pragma unroll
    for (int i = 0; i < 4; ++i) gn[i] = *(const f32x4*)(F.hon + 128 * h + 16 * oseg + 4 * i);
    v4u pq[2][2], pk[2][2], pv[2][2], psg[2][2], pvec[2]; int cl = 0, gl = 0;
#define HG_LOADS(SET) do { \
        _Pragma("unroll") for (int it = 0; it < 2; ++it) { pq[SET][it] = *(const v4u*)(qb + vo_rm + it * 32768); pk[SET][it] = *(const v4u*)(kb_ + vo_rm + it * 32768); pv[SET][it] = *(const v4u*)(vb + vo_rm + it * 32768); } \
        pvec[SET] = *(const v4u*)(eb + vo_vec); } while (0)
#define HG_STORE(SET) do { \
        _Pragma("unroll") for (int it = 0; it < 2; ++it) { *(LAS v4u*)(L + l_rm + it * 8704) = pq[SET][it]; *(LAS v4u*)(L + l_rk + it * 32 * KP) = pk[SET][it]; *(LAS v4u*)(L + l_rk + (H_KT - H_KR) + it * 32 * KP) = pv[SET][it]; } \
        if (tid < 32) *(LAS v4u*)(L + l_vw) = pvec[SET]; } while (0)
#define HG_ADV() do { const int a_ = (cl + 1 < nsteps) ? 1 : 0; qb += a_ * 65536; kb_ += a_ * 65536; vb += a_ * 65536; eb += a_ * 2048; cl += a_; } while (0)
    HG_LOADS(0); HG_ADV(); HG_STORE(0); HG_LOADS(1); HG_ADV();
    psg[0][0] = *(const v4u*)(gb + vo_sg); psg[0][1] = *(const v4u*)(gb + vo_sg + 16); { const int a_ = (gl + 1 < nsteps) ? 1 : 0; gb += a_ * 65536; gl += a_; }
    HG_BAR();
#define HG_BODY(CUR, NXT, CC) do { \
        LAUNDER(vo_rm); LAUNDER(vo_sg); LAUNDER(vo_mix); LAUNDER(vo_vec); LAUNDER(l_rm); LAUNDER(l_rk); LAUNDER(l_vw); LAUNDER(l_aq); LAUNDER(l_ak); LAUNDER(l_aw); \
        LAUNDER(l_vt); LAUNDER(l_q2); LAUNDER(l_al); LAUNDER(l_kt); LAUNDER(l_ve); LAUNDER(l_ow); LAUNDER(l_or); \
        psg[NXT][0] = *(const v4u*)(gb + vo_sg); psg[NXT][1] = *(const v4u*)(gb + vo_sg + 16); { const int a_ = (gl + 1 < nsteps) ? 1 : 0; gb += a_ * 65536; gl += a_; } \
        HG_LOADS(CUR); HG_ADV(); \
        for (int ra_ = 0; ra_ < PR_A; ++ra_) { const int cblk = w >> 1; \
        _Pragma("unroll") \
          for (int jj = 0; jj < 2; ++jj) { const int sblk = 2 * (w & 1) + jj; f32x4 a = {0.f, 0.f, 0.f, 0.f}; \
              if (sblk <= cblk) { \
                  bf16x8 af[4], bf[4]; \
        _Pragma("unroll") \
                  for (int ks = 0; ks < 4; ++ks) { af[ks] = *(const LAS bf16x8*)(L + l_aq + ks * 64); bf[ks] = *(const LAS bf16x8*)(L + l_ak + jj * 16 * KP + ks * 64); } \
                  asm volatile("" : "+v"(af[0]), "+v"(af[1]), "+v"(af[2]), "+v"(af[3]), "+v"(bf[0]), "+v"(bf[1]), "+v"(bf[2]), "+v"(bf[3])); \
        _Pragma("unroll") \
                  for (int ks = 0; ks < 4; ++ks) a = mfma16(af[ks], bf[ks], a); \
        _Pragma("unroll") \
                  for (int r = 0; r < 4; ++r) if (16 * sblk + l15 > 16 * cblk + 4 * fq + r) a[r] = 0.f; \
              } \
        _Pragma("unroll") \
              for (int r = 0; r < 4; ++r) *(LAS unsigned short*)(L + l_aw + r * 144 + jj * 32) = (unsigned short)(pk2(a[r], 0.f) & 0xffffu); \
          } HG_BAR(); } \
        { bf16x8 bvt[2]; \
        _Pragma("unroll") \
          for (int ks = 0; ks < 2; ++ks) bvt[ks] = tr_frag(L + l_vt + ks * 32 * KP); \
          bf16x8 sb[4]; \
        _Pragma("unroll") \
          for (int kb2 = 0; kb2 < 4; ++kb2) { v4u t; t.x = pk2(S[2 * kb2][0], S[2 * kb2][1]); t.y = pk2(S[2 * kb2][2], S[2 * kb2][3]); t.z = pk2(S[2 * kb2 + 1][0], S[2 * kb2 + 1][1]); t.w = pk2(S[2 * kb2 + 1][2], S[2 * kb2 + 1][3]); sb[kb2] = __builtin_bit_cast(bf16x8, t); } \
          for (int ro_ = 0; ro_ < PR_O; ++ro_) \
          _Pragma("unroll") \
          for (int cb = 0; cb < 4; ++cb) { f32x4 o = {0.f, 0.f, 0.f, 0.f}; bf16x8 fa[2], fq_[4]; \
        _Pragma("unroll") \
              for (int ks = 0; ks < 2; ++ks) fa[ks] = *(const LAS bf16x8*)(L + l_al + cb * 16 * 144 + ks * 64); \
        _Pragma("unroll") \
              for (int kb2 = 0; kb2 < 4; ++kb2) fq_[kb2] = *(const LAS bf16x8*)(L + l_q2 + cb * 16 * 272 + kb2 * 64); \
              asm volatile("" : "+v"(fa[0]), "+v"(fa[1]), "+v"(fq_[0]), "+v"(fq_[1]), "+v"(fq_[2]), "+v"(fq_[3])); \
        _Pragma("unroll") \
              for (int ks = 0; ks < 2; ++ks) if (32 * ks <= 16 * cb + 15) o = mfma16(fa[ks], bvt[ks], o); \
        _Pragma("unroll") \
              for (int kb2 = 0; kb2 < 4; ++kb2) o = mfma16(fq_[kb2], sb[kb2], o); \
        _Pragma("unroll") \
              for (int r = 0; r < 4; ++r) *(LAS float*)(L + l_ow + (16 * cb + r) * 528) = o[r]; \
              __builtin_amdgcn_sched_barrier(0); } \
        _Pragma("unroll") \
          for (int kp = 0; kp < 4; ++kp) { bf16x8 fk[2][2]; f32x4 dv[2]; \
        _Pragma("unroll") \
              for (int e = 0; e < 2; ++e) { const int kb = 2 * kp + e; \
        _Pragma("unroll") \
                  for (int ks = 0; ks < 2; ++ks) fk[e][ks] = tr_frag(L + l_kt + (32 * (kb >> 1) + 4 * (kb & 1)) * 2 + ks * 32 * KP); \
                  dv[e] = *(const LAS f32x4*)(L + l_ve + (32 * (kb >> 1) + 4 * (kb & 1)) * 4); } \
              asm volatile("" : "+v"(fk[0][0]), "+v"(fk[0][1]), "+v"(fk[1][0]), "+v"(fk[1][1]), "+v"(dv[0]), "+v"(dv[1])); \
        _Pragma("unroll") \
              for (int e = 0; e < 2; ++e) { const int kb = 2 * kp + e; \
        _Pragma("unroll") \
                  for (int ks = 0; ks < 2; ++ks) S[kb] = mfma16(fk[e][ks], bvt[ks], S[kb]); \
                  S[kb] = S[kb] * dv[e]; } \
              __builtin_amdgcn_sched_barrier(0); } \
          for (int ru_ = 0; ru_ < PR_U; ++ru_) { f32x4 S2[8]; \
          _Pragma("unroll") for (int kb = 0; kb < 8; ++kb) S2[kb] = S[kb]; \
          _Pragma("unroll") \
          for (int kp = 0; kp < 4; ++kp) { bf16x8 fk[2][2]; f32x4 dv[2]; \
          _Pragma("unroll") \
              for (int e = 0; e < 2; ++e) { const int kb = 2 * kp + e; \
          _Pragma("unroll") \
                  for (int ks = 0; ks < 2; ++ks) fk[e][ks] = tr_frag(L + l_kt + (32 * (kb >> 1) + 4 * (kb & 1)) * 2 + ks * 32 * KP); \
                  dv[e] = *(const LAS f32x4*)(L + l_ve + (32 * (kb >> 1) + 4 * (kb & 1)) * 4); } \
              asm volatile("" : "+v"(fk[0][0]), "+v"(fk[0][1]), "+v"(fk[1][0]), "+v"(fk[1][1]), "+v"(dv[0]), "+v"(dv[1])); \
          _Pragma("unroll") \
              for (int e = 0; e < 2; ++e) { const int kb = 2 * kp + e; \
          _Pragma("unroll") \
                  for (int ks = 0; ks < 2; ++ks) S2[kb] = mfma16(fk[e][ks], bvt[ks], S2[kb]); \
                  S2[kb] = S2[kb] * dv[e]; } \
              __builtin_amdgcn_sched_barrier(0); } \
          asm volatile("" :: "v"(S2[0]), "v"(S2[1]), "v"(S2[2]), "v"(S2[3]), "v"(S2[4]), "v"(S2[5]), "v"(S2[6]), "v"(S2[7])); } } \
        HG_BAR(); \
        for (int rt_ = 0; rt_ < PR_OUT; ++rt_) { f32x4 ov[4]; float ss = 0.f; \
        _Pragma("unroll") \
          for (int i = 0; i < 4; ++i) { ov[i] = *(const LAS f32x4*)(L + l_or + 16 * i); ss += (ov[i][0] * ov[i][0] + ov[i][1] * ov[i][1]) + (ov[i][2] * ov[i][2] + ov[i][3] * ov[i][3]); } \
          ss = sum8(ss); \
          const float rn = __builtin_amdgcn_rsqf(ss * (1.f / 128.f) + EPSN); \
          float res[16]; \
        _Pragma("unroll") \
          for (int i = 0; i < 4; ++i) \
        _Pragma("unroll") \
              for (int j = 0; j < 4; ++j) { const int e = 4 * i + j; const unsigned wd = psg[CUR][e >> 3][(e & 7) >> 1]; const float sg = bf2f((unsigned short)((e & 1) ? (wd >> 16) : (wd & 0xffffu))); res[e] = ov[i][j] * rn * gn[i][j] * sg; } \
          v4u o0, o1; o0.x = pk2(res[0], res[1]); o0.y = pk2(res[2], res[3]); o0.z = pk2(res[4], res[5]); o0.w = pk2(res[6], res[7]); o1.x = pk2(res[8], res[9]); o1.y = pk2(res[10], res[11]); o1.z = pk2(res[12], res[13]); o1.w = pk2(res[14], res[15]); \
          *(v4u*)(mb + vo_mix) = o0; *(v4u*)(mb + vo_mix + 16) = o1; } mb += 131072; \
        if ((CC) + 1 < nsteps) { for (int rs_ = 0; rs_ < PR_ST; ++rs_) { HG_STORE(NXT); } } \
        HG_BAR(); \
    } while (0)
    for (int c = 0; c < nsteps; c += 2) { HG_BODY(0, 1, c); if (c + 1 < nsteps) HG_BODY(1, 0, c + 1); }
    { int ln2 = lane; LAUNDER(ln2); float* sp = Sout + (8 * (ln2 >> 4)) * 128 + 16 * w + (ln2 & 15);
#pragma unroll
      for (int kb = 0; kb < 8; ++kb) { LAUNDER(sp);
#pragma unroll
          for (int r = 0; r < 4; ++r) sp[r * 128] = S[kb][r];
          sp += (kb & 1) ? 28 * 128 : 4 * 128; } }
#undef HG_LOADS
#undef HG_STORE
#undef HG_ADV
#undef HG_BODY
}

__global__ void __launch_bounds__(NTHR, 2) skel_fwd(Args args) {
    extern __shared__ __attribute__((aligned(16))) unsigned char lds[];
    Frame F;
    F.lds = (LAS unsigned char*)lds; F.MISC = (volatile LAS unsigned*)(F.lds + MISC_OFF);
    F.tid = threadIdx.x; F.lane = F.tid & 63; F.wave = __builtin_amdgcn_readfirstlane(F.tid >> 6);
    F.G = gridDim.x; { const int bx = blockIdx.x; F.vcu = (F.G % 8 == 0) ? (bx % 8) * (F.G / 8) + bx / 8 : bx; }
    F.ws = args.ws; F.ctl = (unsigned*)(args.ws + WS_CTL); F.out = args.out;
    F.xp = args.in[0]; F.xs = args.in[1]; F.ck = args.in[2]; F.cv = args.in[3]; F.clf = args.in[4]; F.sh = args.in[5]; F.n1 = args.in[6]; F.win = args.in[7]; F.bff = args.in[8];
    F.qg = args.in[9]; F.kg = args.in[10]; F.lbl = args.in[11]; F.hon = args.in[12]; F.wout = args.in[13]; F.n2 = args.in[14]; F.wup = args.in[15]; F.wdn = args.in[16];
    const int lo = args.ph_lo, hi = args.ph_hi;
    if (F.tid < 64) F.MISC[F.tid] = 0u;
    __syncthreads();
    const XcdBarrier xbar = xcd_barrier_post((unsigned*)(F.ctl + CW_BAR), F.MISC + 8);
#if defined(PROBE_A)
    unsigned long long ts_[9]; const bool stamper_ = (blockIdx.x == 0 && F.tid == 0);
#define STAMP(k) do { if (stamper_) ts_[k] = __builtin_amdgcn_s_memrealtime(); } while (0)
    STAMP(0);
#else
#define STAMP(k) do {} while (0)
#endif
#ifndef PH_MASK
#define PH_MASK 63
#endif
#define IN(k) (((PH_MASK >> (k)) & 1) && lo <= (k) && (k) < hi)
#ifndef SYNC_REP
#define SYNC_REP 1
#endif
#define SEAM(k) do { if (IN(k) && IN((k) + 1)) { for (int sr_ = 0; sr_ < SYNC_REP; ++sr_) cg::this_grid().sync(); } } while (0)
    bf16* XB = (bf16*)(F.ws + WS_XB); bf16* X1B = (bf16*)(F.ws + WS_X1B); bf16* MIX = (bf16*)(F.ws + WS_MIX); bf16* HB = (bf16*)(F.ws + WS_H);
    if (IN(0)) { p0_prologue(F);
#if defined(DOUBLE_P0)
        cg::this_grid().sync(); p0_prologue(F);
#endif
    }
    SEAM(0); STAMP(1);
    const int bx = (int)blockIdx.x; const bool chainwg = bx < NCHAINWG; const int NWORK = F.G - NCHAINWG;
    if (IN(1)) {
#ifndef NO_SCAN
        for (int ch = F.vcu; ch < 128; ch += F.G) scan_chain(F, ch);
#endif
        pg8::Gemm g{XB, (const bf16*)(F.ws + WS_WIN), MTOT, NIN, DMOD, DMOD};
        pg8::EpiIn E{(const float*)(F.ws + WS_RSTD), F.lbl, F.qg, F.kg, F.ws, F.out};
#pragma nounroll
        for (int sub = 0; sub < 2; ++sub) {
            pg8::OrderIn S;
            if (sub == 0) { S.so.init(MP, 2048, F.G, bx); S.pn_off = 0; S.extra = 0; S.extra_pm0 = 0; S.extra_shift = 3; }
            else { S.so.init(MTOT, NIN - 2048, NWORK, bx - NCHAINWG); S.pn_off = 8; S.extra = 8 * (MS / 256); S.extra_pm0 = MP / 256; S.extra_shift = 3; }
            if (sub == 0 || !chainwg) pg8::gemm_phase<pg8::EpiIn, pg8::OrderIn, true, true>(F.lds, g, S, E);
            if (sub == 0) {
                xcd_barrier(xbar); STAMP(2);
                if (chainwg)
#if defined(DOUBLE_HGRN)
                for (int rep_ = 0; rep_ < 2; ++rep_)
#endif
                { const int bb = bx >> 2; hgrn_chain(F, bb * TSEQ, bb * (TSEQ / 64), TSEQ / 64, bx & 3, nullptr, F.out + O_HP + (size_t)bx * 16384); }
            }
        }
#define SUBSET_BARRIER(word) do { asm volatile("s_waitcnt vmcnt(0)" ::: "memory"); __syncthreads(); \
            if (F.tid == 0) { unsigned* sc_ = F.ctl + (word); __threadfence(); __hip_atomic_fetch_add(sc_, 1u, __ATOMIC_RELAXED, __HIP_MEMORY_SCOPE_AGENT); \
                while (__hip_atomic_load(sc_, __ATOMIC_RELAXED, __HIP_MEMORY_SCOPE_AGENT) < (unsigned)NWORK) __builtin_amdgcn_s_sleep(8); \
                __threadfence(); } \
            __syncthreads(); } while (0)
        if (!chainwg) SUBSET_BARRIER(CW_SUB);
    }
    if (IN(2)) {
#ifndef NO_ATTN
        float prune_thr;
        { float mq = fabsf(F.qg[F.lane]), mk = fabsf(F.kg[F.lane]);
#pragma unroll
          for (int o = 1; o < 64; o <<= 1) { mq = fmaxf(mq, __shfl_xor(mq, o)); mk = fmaxf(mk, __shfl_xor(mk, o)); }
          prune_thr = 2.f * (8.f * mq * mk * LOG2E) + 150.f; }
        if (!chainwg) for (;;) {
            if (F.tid == 0) F.MISC[0] = atomicAdd(F.ctl + CW_QUEUE, 1u);
            __syncthreads();
            const int i = (int)F.MISC[0];
            __syncthreads();
            if (i >= 32 + 64 + 2048) break;
            if (i < 32) { const int bb = i >> 2; hgrn_chain(F, MP + 64 * bb, MP / 64 + bb, 1, i & 3, F.sh + (size_t)i * 16384, F.out + O_HS + (size_t)i * 16384); __syncthreads(); continue; }
            typedef attn_body::bf16 abf;
            const bool smp = i < 96; const int j = smp ? i - 32 : i - 96;
            const int bh = j & 63, qb = 31 - (j >> 6), b = bh >> 3, h = bh & 7;
            const int q0 = smp ? SSEQ - 256 : 256 * qb, NT = (q0 + 256) / 64; int NTE = NT;
            const size_t rb = (size_t)b * (smp ? SSEQ : TSEQ);
            const float* cgp = (const float*)(F.ws + (smp ? WS_CGS : WS_CGP)) + (size_t)bh * (smp ? SSEQ : TSEQ);
#if FOX_PRUNE
            { const bool need = F.tid < NT && (cgp[q0] - cgp[64 * F.tid + 63] >= -prune_thr); const int needed = __syncthreads_count(need ? 1 : 0);
              NTE = (needed + 1) & ~1; NTE = NTE < 4 ? 4 : (NTE > NT ? NT : NTE); }
#endif
            const size_t orow = smp ? (size_t)(MP + 64 * b) - (size_t)(PAST - q0) : rb + q0;
            attn_body::attn_unit<8>((const abf*)(F.ws + (smp ? WS_QS : WS_Q)) + (rb + q0) * 512 + 64 * h, (const abf*)(F.ws + (smp ? WS_KS : WS_K)) + rb * 512 + 64 * h, (const abf*)(F.ws + (smp ? WS_VS : WS_V)) + rb * 512 + 64 * h,
                                    (abf*)MIX + orow * DMOD + 512 + 64 * h, NT, NTE, cgp, q0, smp ? (PAST - q0) / 32 : 0, smp ? (PAST - q0) / 32 + 1 : 8, (char*)lds);
        }
#endif
    }
    if (IN(3)) {
        if (!chainwg) SUBSET_BARRIER(CW_SUB + 64);
        pg8::Gemm g{MIX, (const bf16*)(F.ws + WS_WO), MTOT, DMOD, DMOD, DMOD};
        pg8::EpiWo E{XB, F.xs, F.out + O_YP, F.out + O_YS, X1B, (float*)(F.ws + WS_SSQ)};
#pragma nounroll
        for (int pass = 0; pass < 2; ++pass) {
            pg8::OrderIn S;
            if (pass == 0) { S.so.init(0, DMOD, NWORK, bx - NCHAINWG); S.pn_off = 0; S.extra = 8; S.extra_pm0 = MP / 256; S.extra_shift = 2; }
            else { xcd_barrier(xbar); STAMP(3); S.so.init(MP, DMOD, F.G, bx); S.pn_off = 0; S.extra = 0; S.extra_pm0 = 0; S.extra_shift = 2; }
            if (pass == 1 || !chainwg) pg8::gemm_phase<pg8::EpiWo, pg8::OrderIn, true, true>(F.lds, g, S, E);
        }
    }
    xcd_barrier(xbar); STAMP(4);
    if (IN(4)) {
        pg8::Gemm g{X1B, (const bf16*)(F.ws + WS_WUP), MTOT, FF, DMOD, DMOD}; pg8::StaticOrder S; S.init(MTOT, FF, F.G, (int)blockIdx.x);
        pg8::EpiUp E{HB, (const float*)(F.ws + WS_SSQ)};
        pg8::gemm_phase<pg8::EpiUp, pg8::StaticOrder, true, true>(F.lds, g, S, E);
#if defined(DOUBLE_P4)
        cg::this_grid().sync();
        pg8::gemm_phase<pg8::EpiUp, pg8::StaticOrder, true, true>(F.lds, g, S, E);
#endif
    }
    xcd_barrier(xbar); STAMP(5);
    if (IN(5)) {
#pragma nounroll
        for (int pass = 0; pass < 2; ++pass) {
            pg8::Gemm g{HB, (const bf16*)(F.ws + WS_WDN), MTOT, DMOD, pass ? FF : FF / pg8::OrderDown::KSPLIT, FF};
            pg8::OrderDown S; S.mode = pass; S.so.init(MP, DMOD, F.G, (int)blockIdx.x);
            pg8::EpiDown E{F.out + O_YP, F.out + O_YS, X1B, pass ? 0 : 1};
            pg8::gemm_phase<pg8::EpiDown, pg8::OrderDown, true, true>(F.lds, g, S, E);
        }
    }
    STAMP(6);
#if defined(PROBE_A)
    cg::this_grid().sync();
    if (stamper_) {
        unsigned long long da = ts_[PROBE_A + 1] - ts_[PROBE_A], db = ts_[PROBE_B + 1] - ts_[PROBE_B];
        unsigned qa = (unsigned)((da + 1250) / 2500), qb = (unsigned)((db + 1250) / 2500); if (qa > 63) qa = 63; if (qb > 63) qb = 63;
#if defined(PROBE_CAL)
        qa = 1000; qb = 0;
#endif
        const unsigned long long t0 = __builtin_amdgcn_s_memrealtime(), wait = 2000ull * (qa + 64 * qb);
        while (__builtin_amdgcn_s_memrealtime() - t0 < wait) __builtin_amdgcn_s_sleep(16);
    }
#endif
#undef IN
#undef SEAM
}

extern "C" void kernel_launch(void* const* d_in, const int* in_sizes, int n_in, void* d_out, int out_size, void* d_ws, size_t ws_size, hipStream_t stream) {
    static int grid = 0;
    if (grid == 0) {
        if (n_in != 17 || (size_t)out_size != O_END || ws_size < WS_END) { fprintf(stderr, "kernel_launch: unexpected shapes (n_in %d out %d ws %zu)\n", n_in, out_size, ws_size); grid = -1; return; }
        int dev = 0, cus = 0, per_cu = 0;
        if (hipGetDevice(&dev) != hipSuccess || hipDeviceGetAttribute(&cus, hipDeviceAttributeMultiprocessorCount, dev) != hipSuccess) { grid = -1; return; }
        if (hipFuncSetAttribute((const void*)skel_fwd, hipFuncAttributeMaxDynamicSharedMemorySize, LDS_BYTES) != hipSuccess) { fprintf(stderr, "kernel_launch: hipFuncSetAttribute failed\n"); grid = -1; return; }
        if (hipOccupancyMaxActiveBlocksPerMultiprocessor(&per_cu, (const void*)skel_fwd, NTHR, LDS_BYTES) != hipSuccess || per_cu < 1) { fprintf(stderr, "kernel_launch: occupancy query says %d\n", per_cu); per_cu = 1; }
        (void)hipGetLastError();
        grid = cus;
    }
    if (grid < 0) return;
    if (hipMemsetAsync((char*)d_ws + WS_CTL, 0, CTL_ZERO_BYTES, stream) != hipSuccess) { fprintf(stderr, "kernel_launch: memset failed\n"); return; }
    Args a{};
    for (int i = 0; i < 17; ++i) a.in[i] = (const float*)d_in[i];
    a.out = (float*)d_out; a.ws = (unsigned char*)d_ws;
#if MK_N_LAUNCHES == 1
    a.ph_lo = 0; a.ph_hi = 6;
    void* kargs[] = {&a};
    hipError_t e = hipLaunchCooperativeKernel((const void*)skel_fwd, dim3(grid), dim3(NTHR), kargs, LDS_BYTES, stream);
    if (e != hipSuccess) fprintf(stderr, "kernel_launch: cooperative launch failed: %s (grid %d)\n", hipGetErrorString(e), grid);
#else
    for (int li = 0; li < 6; ++li) { a.ph_lo = li; a.ph_hi = li + 1; hipLaunchKernelGGL(skel_fwd, dim3(grid), dim3(NTHR), LDS_BYTES, stream, a); }
#endif
}
```

```cpp
#include <hip/hip_runtime.h>
#include <cstdio>
#include <cstdint>
namespace pg8 {
#define PG8_LAS __attribute__((address_space(3)))
typedef unsigned short bf16_t;
typedef short bf16x8 __attribute__((ext_vector_type(8)));
typedef float f32x4 __attribute__((ext_vector_type(4)));
typedef unsigned u32x4 __attribute__((ext_vector_type(4)));
constexpr int BM = 256, BK = 64, HALF = 128, HTB = HALF * BK * 2  , STAGE_BYTES = 8 * HTB, NXCD = 8, WGM = 8;

__host__ __device__ __forceinline__ int lds_byte(int r, int c) { const int st = (r >> 4) * 2 + (c >> 5), rr = r & 15, cc = c & 31, ob = rr * 64 + cc * 2; return st * 1024 + (ob ^ (((ob >> 9) & 1) << 5)); }
__host__ __device__ __forceinline__ void stage_rc(int b, int& R, int& C) { const int st = b / 1024, sb = b % 1024, swz = sb ^ (((sb >> 9) & 1) << 5); R = (st >> 1) * 16 + swz / 64; C = (st & 1) * 32 + (swz % 64) / 2; }
__host__ __device__ __forceinline__ int perm32(int rho) { const int n = rho >> 4, i = rho & 15; return 8 * (i >> 2) + 4 * n + (i & 3); }

struct Unit { int pm, pn, kofs; };
struct Gemm { const bf16_t* A; const bf16_t* Bt; int M, N, K, ld; };

struct StaticOrder {
    int nM, nN, nwg, G, c;
    __host__ __device__ void init(int M, int N, int G_, int c_) { nM = M / BM; nN = N / BM; nwg = nM * nN; G = G_; c = c_; }
    __host__ __device__ bool next(int i, Unit& u) const {
        const long L = (long)i * G + c; if (L >= nwg) return false;
        int wgid = (int)L; { const int q = nwg / NXCD, r = nwg % NXCD, xcd = wgid % NXCD, off = wgid / NXCD; wgid = (xcd < r ? xcd * (q + 1) : r * (q + 1) + (xcd - r) * q) + off; }
        const int nig = WGM * nN, gid = wgid / nig, fm = gid * WGM, gsz = (nM - fm) < WGM ? (nM - fm) : WGM;
        u.pm = fm + ((wgid % nig) % gsz); u.pn = (wgid % nig) / gsz; u.kofs = 0; return true;
    }
    __device__ __forceinline__ void a_ready(const Unit&) const {}
    __device__ __forceinline__ void done(const Unit&) const {}
};

__device__ __forceinline__ unsigned cvt_pk_bf16(float lo, float hi) { unsigned r; asm volatile("v_cvt_pk_bf16_f32 %0, %1, %2" : "=v"(r) : "v"(lo), "v"(hi)); return r; }
typedef float f32x2 __attribute__((ext_vector_type(2)));
template <class Epi, class Sched, bool ALIGN_EPI = false, bool SP2 = false>
__device__ __forceinline__ void gemm_phase(PG8_LAS unsigned char* lds, const Gemm g, const Sched& S, const Epi& E) {
    const int tid = threadIdx.x, wid = __builtin_amdgcn_readfirstlane(tid >> 6), lane = tid & 63, wr = wid >> 2, wc = wid & 3, fr = lane & 15, fq = lane >> 4;
    const int K = g.ld, nt = g.K / BK;
    unsigned voffA[2], voffB[2];
#pragma unroll
    for (int i = 0; i < 2; ++i) { int R, C; stage_rc(tid * 16 + i * 8192, R, C); const int Rb = Epi::PERM ? ((R & ~31) + perm32(R & 31)) : R;
        voffA[i] = (unsigned)(R * K + C) * 2u; voffB[i] = (unsigned)(Rb * K + C) * 2u; }
    const size_t kstep = (size_t)(BK * 2);
    const size_t hstep = (size_t)HALF * K * 2;
    const size_t tstep = 2 * hstep;
    const unsigned ldsw = (unsigned)wid * 1024u;
    const int aoff = lds_byte(wr * 64 + fr, fq * 8), boff = lds_byte(wc * 32 + fr, fq * 8);
#define PG8_SA(b, h) (((b) * 2 + (h)) * HTB)
#define PG8_SB(b, h) ((4 + (b) * 2 + (h)) * HTB)
#define PG8_STAGE(bufoff, gbase, voff) do { _Pragma("unroll") for (int _i = 0; _i < 2; ++_i) \
        __builtin_amdgcn_global_load_lds((const unsigned*)((const char*)(gbase) + (voff)[_i]), (PG8_LAS unsigned*)(lds + (bufoff) + ldsw + _i * 8192), 16, 0, 0); } while (0)
#define PG8_LDA(dst, b, h) do { _Pragma("unroll") for (int m = 0; m < 4; ++m) _Pragma("unroll") for (int k = 0; k < 2; ++k) dst[m][k] = *(const PG8_LAS bf16x8*)(lds + PG8_SA(b, h) + aoff + m * 2048 + k * 1024); } while (0)
#define PG8_LDB(dst, b, h) do { _Pragma("unroll") for (int n = 0; n < 2; ++n) _Pragma("unroll") for (int k = 0; k < 2; ++k) dst[n][k] = *(const PG8_LAS bf16x8*)(lds + PG8_SB(b, h) + boff + n * 2048 + k * 1024); } while (0)
#define PG8_MMA(ai, bj, At, Bt) do { __builtin_amdgcn_s_setprio(1); _Pragma("unroll") for (int m = 0; m < 4; ++m) _Pragma("unroll") for (int n = 0; n < 2; ++n) _Pragma("unroll") for (int k = 0; k < 2; ++k) \
        acc[ai][bj][m][n] = __builtin_amdgcn_mfma_f32_16x16x32_bf16(Bt[n][k], At[m][k], acc[ai][bj][m][n], 0, 0, 0); __builtin_amdgcn_s_setprio(0); } while (0)
#define PG8_WAIT_V(n) asm volatile("s_waitcnt vmcnt(" #n ")" ::: "memory")
#define PG8_WAIT_L(n) asm volatile("s_waitcnt lgkmcnt(" #n ")" ::: "memory")
#define PG8_BAR __builtin_amdgcn_s_barrier()
#define PG8_SCHED __builtin_amdgcn_sched_barrier(0)
    Unit cur, nxt; int ui = 0;
    if (!S.next(0, cur)) return;
    f32x4 acc[2][2][4][2];
#pragma unroll
    for (int a = 0; a < 2; ++a)
#pragma unroll
        for (int b = 0; b < 2; ++b)
#pragma unroll
            for (int m = 0; m < 4; ++m)
#pragma unroll
                for (int n = 0; n < 2; ++n) acc[a][b][m][n] = (f32x4){0.f, 0.f, 0.f, 0.f};
    bf16x8 At[4][2], B0[2][2], B1[2][2];
    const char* cA = (const char*)g.A + (size_t)cur.pm * tstep + (size_t)cur.kofs * 2; const char* cB = (const char*)g.Bt + (size_t)cur.pn * tstep + (size_t)cur.kofs * 2;
    S.a_ready(cur);
    if constexpr (SP2) {
        PG8_STAGE(PG8_SB(0, 0), cB, voffB); PG8_STAGE(PG8_SB(0, 1), cB + hstep, voffB); PG8_STAGE(PG8_SA(0, 0), cA, voffA); PG8_STAGE(PG8_SA(0, 1), cA + hstep, voffA);
        if (wr == 1) PG8_BAR;
        PG8_WAIT_V(2); PG8_BAR;
        PG8_STAGE(PG8_SB(1, 0), cB + kstep, voffB); PG8_STAGE(PG8_SA(1, 0), cA + kstep, voffA); PG8_STAGE(PG8_SB(1, 1), cB + hstep + kstep, voffB);
        PG8_WAIT_V(6); PG8_BAR;
    } else {
        PG8_STAGE(PG8_SB(0, 0), cB, voffB); PG8_STAGE(PG8_SA(0, 0), cA, voffA); PG8_STAGE(PG8_SB(0, 1), cB + hstep, voffB); PG8_STAGE(PG8_SA(0, 1), cA + hstep, voffA);
        if (wr == 1) PG8_BAR;
        PG8_WAIT_V(4); PG8_BAR;
        PG8_STAGE(PG8_SB(1, 0), cB + kstep, voffB); PG8_STAGE(PG8_SA(1, 0), cA + kstep, voffA); PG8_STAGE(PG8_SB(1, 1), cB + hstep + kstep, voffB);
        PG8_WAIT_V(6); PG8_BAR;
    }
    for (;;) {
        const bool has_next = S.next(ui + 1, nxt);
        const char* nA = has_next ? (const char*)g.A + (size_t)nxt.pm * tstep + (size_t)nxt.kofs * 2 : cA; const char* nB = has_next ? (const char*)g.Bt + (size_t)nxt.pn * tstep + (size_t)nxt.kofs * 2 : cB;
        for (int t = 0; t < nt; t += 2) {
            const bool last = (t == nt - 2);
            const char* a1 = cA + (size_t)(t + 1) * kstep;
            const char* a2 = last ? nA : cA + (size_t)(t + 2) * kstep; const char* b2 = last ? nB : cB + (size_t)(t + 2) * kstep;
            const char* a3 = a2 + kstep; const char* b3 = b2 + kstep;
            if (last && has_next) S.a_ready(nxt);
            if constexpr (SP2) {
            PG8_LDB(B0, 0, 0); PG8_LDB(B1, 0, 1); PG8_SCHED; PG8_LDA(At, 0, 0); PG8_STAGE(PG8_SA(1, 1), a1 + hstep, voffA);
            PG8_WAIT_V(8); PG8_WAIT_L(0); PG8_BAR; PG8_MMA(0, 0, At, B0); PG8_MMA(0, 1, At, B1); PG8_BAR; PG8_SCHED;
            PG8_LDA(At, 0, 1); PG8_STAGE(PG8_SB(0, 0), b2, voffB); PG8_STAGE(PG8_SB(0, 1), b2 + hstep, voffB); PG8_STAGE(PG8_SA(0, 0), a2, voffA);
            PG8_WAIT_V(8); PG8_WAIT_L(0); PG8_BAR; PG8_MMA(1, 0, At, B0); PG8_MMA(1, 1, At, B1); PG8_BAR; PG8_SCHED;
            PG8_LDB(B0, 1, 0); PG8_LDB(B1, 1, 1); PG8_SCHED; PG8_LDA(At, 1, 0); PG8_STAGE(PG8_SA(0, 1), a2 + hstep, voffA);
            PG8_WAIT_V(8); PG8_WAIT_L(0); PG8_BAR; PG8_MMA(0, 0, At, B0); PG8_MMA(0, 1, At, B1); PG8_BAR; PG8_SCHED;
            PG8_LDA(At, 1, 1); PG8_STAGE(PG8_SB(1, 0), b3, voffB); PG8_STAGE(PG8_SB(1, 1), b3 + hstep, voffB); PG8_STAGE(PG8_SA(1, 0), a3, voffA);
            PG8_WAIT_V(8); PG8_WAIT_L(0); PG8_BAR; PG8_MMA(1, 0, At, B0); PG8_MMA(1, 1, At, B1); PG8_BAR; PG8_SCHED;
            } else {
            PG8_LDB(B0, 0, 0); PG8_SCHED; PG8_LDA(At, 0, 0); PG8_STAGE(PG8_SA(1, 1), a1 + hstep, voffA);
            PG8_WAIT_L(8); PG8_BAR; PG8_WAIT_L(0); PG8_MMA(0, 0, At, B0); PG8_BAR; PG8_SCHED;
            PG8_LDB(B1, 0, 1); PG8_STAGE(PG8_SB(0, 0), b2, voffB);
            PG8_BAR; PG8_WAIT_L(0); PG8_MMA(0, 1, At, B1); PG8_BAR;
            PG8_LDA(At, 0, 1); PG8_STAGE(PG8_SA(0, 0), a2, voffA);
            PG8_BAR; PG8_WAIT_L(0); PG8_MMA(1, 0, At, B0); PG8_BAR; PG8_SCHED;
            PG8_STAGE(PG8_SB(0, 1), b2 + hstep, voffB);
            PG8_WAIT_V(6); PG8_BAR; PG8_MMA(1, 1, At, B1); PG8_BAR;
            PG8_LDB(B0, 1, 0); PG8_SCHED; PG8_LDA(At, 1, 0); PG8_STAGE(PG8_SA(0, 1), a2 + hstep, voffA);
            PG8_WAIT_L(8); PG8_BAR; PG8_WAIT_L(0); PG8_MMA(0, 0, At, B0); PG8_BAR; PG8_SCHED;
            PG8_LDB(B1, 1, 1); PG8_STAGE(PG8_SB(1, 0), b3, voffB);
            PG8_BAR; PG8_WAIT_L(0); PG8_MMA(0, 1, At, B1); PG8_BAR;
            PG8_LDA(At, 1, 1); PG8_STAGE(PG8_SA(1, 0), a3, voffA);
            PG8_BAR; PG8_WAIT_L(0); PG8_MMA(1, 0, At, B0); PG8_BAR; PG8_SCHED;
            PG8_STAGE(PG8_SB(1, 1), b3 + hstep, voffB);
            PG8_WAIT_V(6); PG8_BAR; PG8_MMA(1, 1, At, B1); PG8_BAR;
            }
        }
        if constexpr (ALIGN_EPI) { if (wr == 0) PG8_BAR; }
        if constexpr (!Epi::AFTER_DRAIN) { E(acc, cur, wr, wc, fr, fq); S.done(cur); }
        if (!has_next) break;
#pragma unroll
        for (int a = 0; a < 2; ++a)
#pragma unroll
            for (int b = 0; b < 2; ++b)
#pragma unroll
                for (int m = 0; m < 4; ++m)
#pragma unroll
                    for (int n = 0; n < 2; ++n) acc[a][b][m][n] = (f32x4){0.f, 0.f, 0.f, 0.f};
        cur = nxt; cA = nA; cB = nB; ++ui;
        if constexpr (ALIGN_EPI) { if (wr == 1) PG8_BAR; }
    }
    PG8_WAIT_V(0);
    if constexpr (!ALIGN_EPI) { if (wr == 0) PG8_BAR; }
    PG8_BAR;
    if constexpr (Epi::AFTER_DRAIN) { E.fused(acc, cur, wr, wc, fr, fq, lds, wid, lane); S.done(cur); }
#undef PG8_SA
#undef PG8_SB
#undef PG8_STAGE
#undef PG8_LDA
#undef PG8_LDB
#undef PG8_MMA
#undef PG8_WAIT_V
#undef PG8_WAIT_L
#undef PG8_BAR
#undef PG8_SCHED
}
}
#include <hip/hip_bf16.h>
#include <cmath>
namespace attn_body {
using bf16=__hip_bfloat16;
using bf16x8=__attribute__((ext_vector_type(8)))short;
using s16x4=__attribute__((ext_vector_type(4)))short;
using f32x16=__attribute__((ext_vector_type(16)))float;
using u32x4=__attribute__((ext_vector_type(4)))unsigned;
constexpr int NHEAD=8,D=64,DM=NHEAD*D,OPITCH=1024;
constexpr int NW=8,QBLK=32,QB=QBLK*NW,KVBLK=64;
constexpr int ATTN_PITCH=DM, ATTN_UNIT_ROWS=QB;
__device__ __forceinline__ int crow(int r,int hi){return (r&3)+8*(r>>2)+4*hi;}
#define SBAR() __builtin_amdgcn_sched_barrier(0)
__device__ __forceinline__ void cmask(f32x16&p0,f32x16&p1,int jb,int qrel,int hi){
  const float NEG=-INFINITY; int kb=64*jb+4*hi;
  #pragma unroll
  for(int r=0;r<16;++r){int kv=kb+(r&3)+8*(r>>2); if(kv>qrel)p0[r]=NEG; if(kv+32>qrel)p1[r]=NEG;}
}

constexpr int NSLOT=3, SLOTB=8192;
constexpr int LDS_K=0, LDS_V=NSLOT*SLOTB, LDS_WS=2*NSLOT*SLOTB, LDS_OST=LDS_WS+NW*64*4, LDS_CB=LDS_OST+NW*4096, LDS_BYTES=LDS_CB+32768;
constexpr float C2=0.125f*1.4426950408889634f;
__device__ __forceinline__ void glds16(const void*gsrc,unsigned lds_dst){unsigned keep;
  asm volatile("s_mov_b32 %0, m0\n\ts_mov_b32 m0, %2\n\ts_nop 0\n\tglobal_load_lds_dwordx4 %1, off\n\ts_mov_b32 m0, %0":"=&s"(keep):"v"(gsrc),"s"(lds_dst):"memory");}
__device__ __forceinline__ float max3f(float a,float b,float c){float r;asm("v_max3_f32 %0, %1, %2, %3":"=v"(r):"v"(a),"v"(b),"v"(c));return r;}
__device__ __forceinline__ float max2f(float a,float b){float r;asm("v_max_f32_e32 %0, %1, %2":"=v"(r):"v"(a),"v"(b));return r;}
__device__ __forceinline__ float fadd_s(float a,float b){float r;asm("v_add_f32_e32 %0, %1, %2":"=v"(r):"v"(a),"v"(b));return r;}
__device__ __forceinline__ float fsub_s(float a,float b){float r;asm("v_sub_f32_e32 %0, %1, %2":"=v"(r):"v"(a),"v"(b));return r;}
typedef float f32x2_t __attribute__((ext_vector_type(2))); typedef float f32x4_t __attribute__((ext_vector_type(4))); typedef __bf16 bf16x2_t __attribute__((ext_vector_type(2)));
__device__ __forceinline__ unsigned cvtpk_s(float lo,float hi){f32x2_t v={lo,hi};bf16x2_t b=__builtin_convertvector(v,bf16x2_t);return __builtin_bit_cast(unsigned,b);}
#define WAIT_BAR(N) asm volatile("s_waitcnt vmcnt(" #N ") lgkmcnt(0)\n\ts_barrier":::"memory")

__device__ __forceinline__ void qkt(f32x16&p0,f32x16&p1,const char*Kslot,const bf16x8*qr,int r32,int hi){
  const char*kb=Kslot+hi*1024+r32*16;
  #pragma unroll
  for(int d0=0;d0<4;++d0){
    const bf16x8 b0=*reinterpret_cast<const bf16x8*>(kb+d0*2048);
    const bf16x8 b1=*reinterpret_cast<const bf16x8*>(kb+d0*2048+512);
    p0=__builtin_amdgcn_mfma_f32_32x32x16_bf16(b0,qr[d0],p0,0,0,0);p1=__builtin_amdgcn_mfma_f32_32x32x16_bf16(b1,qr[d0],p1,0,0,0);}
}
typedef __attribute__((address_space(3))) const char* lds_cptr;
typedef short v4i16_t __attribute__((ext_vector_type(4)));
__device__ __forceinline__ void kload8(bf16x8*kf,lds_cptr kp){
  kf[0]=*(const __attribute__((address_space(3))) bf16x8*)(kp);      kf[1]=*(const __attribute__((address_space(3))) bf16x8*)(kp+512);
  kf[2]=*(const __attribute__((address_space(3))) bf16x8*)(kp+2048); kf[3]=*(const __attribute__((address_space(3))) bf16x8*)(kp+2560);
  kf[4]=*(const __attribute__((address_space(3))) bf16x8*)(kp+4096); kf[5]=*(const __attribute__((address_space(3))) bf16x8*)(kp+4608);
  kf[6]=*(const __attribute__((address_space(3))) bf16x8*)(kp+6144); kf[7]=*(const __attribute__((address_space(3))) bf16x8*)(kp+6656);
}
__device__ __forceinline__ void kload2(bf16x8*kf,lds_cptr kp,int j){ kf[2*j]=*(const __attribute__((address_space(3))) bf16x8*)(kp+j*2048); kf[2*j+1]=*(const __attribute__((address_space(3))) bf16x8*)(kp+j*2048+512); }
__device__ __forceinline__ s16x4 vtr(lds_cptr p){ return __builtin_bit_cast(s16x4,__builtin_amdgcn_ds_read_tr16_b64_v4i16((__attribute__((address_space(3))) v4i16_t*)p)); }
__device__ __forceinline__ float rowmax(const f32x16&p0,const f32x16&p1){
  float a=max3f(p0[0],p0[1],p1[0]),b=max3f(p0[2],p0[3],p1[1]);a=max3f(a,p1[2],p1[3]);
  #pragma unroll
  for(int r=4;r<16;r+=4){a=max3f(a,p0[r],p0[r+1]);b=max3f(b,p0[r+2],p0[r+3]);a=max3f(a,p1[r],p1[r+1]);b=max3f(b,p1[r+2],p1[r+3]);}
  const float m=max2f(a,b);
  auto rr=__builtin_amdgcn_permlane32_swap(__float_as_uint(m),__float_as_uint(m),false,false);
  return max2f(__uint_as_float(rr[0]),__uint_as_float(rr[1]));
}
__device__ __forceinline__ void pv(f32x16*o,int vb,bf16x8 pa0,bf16x8 pa1,bf16x8 pa2,bf16x8 pa3){
  #pragma unroll
  for(int d0=0;d0<2;++d0){s16x4 lo[4],hi[4];
    #pragma unroll
    for(int ks=0;ks<4;++ks){
      asm volatile("ds_read_b64_tr_b16 %0,%1 offset:%c2":"=&v"(lo[ks]):"v"(vb),"i"(d0*4096+ks*1024):"memory");
      asm volatile("ds_read_b64_tr_b16 %0,%1 offset:%c2":"=&v"(hi[ks]):"v"(vb),"i"(d0*4096+ks*1024+512):"memory");}
    asm volatile("s_waitcnt lgkmcnt(0)":::"memory");SBAR();
    #define PK(k) (bf16x8){lo[k][0],lo[k][1],lo[k][2],lo[k][3],hi[k][0],hi[k][1],hi[k][2],hi[k][3]}
    o[d0]=__builtin_amdgcn_mfma_f32_32x32x16_bf16(pa0,PK(0),o[d0],0,0,0);
    o[d0]=__builtin_amdgcn_mfma_f32_32x32x16_bf16(pa1,PK(1),o[d0],0,0,0);
    o[d0]=__builtin_amdgcn_mfma_f32_32x32x16_bf16(pa2,PK(2),o[d0],0,0,0);
    o[d0]=__builtin_amdgcn_mfma_f32_32x32x16_bf16(pa3,PK(3),o[d0],0,0,0);
    #undef PK
  }
}

#ifndef ATTN_STORE16
#define ATTN_STORE16(p,v) (*(u32x4*)(p)=(v))
#endif
template<int THRL> __device__ __forceinline__ void attn_unit(const bf16*Qb,const bf16*__restrict__ Kh,const bf16*__restrict__ Vh,bf16*Ob,int NT,int NTE,const float*cgp,int q0,int wlo,int whi,char*shm){
  int tid_=threadIdx.x; asm volatile("":"+v"(tid_)); const int tid=tid_,lane=tid&63,r32=lane&31,hi=lane>>5; const int wid=__builtin_amdgcn_readfirstlane(tid>>6);
  const bf16*Qw=Qb+(long)(wid*QBLK)*DM;
  const unsigned lds0=(unsigned)(uintptr_t)shm;
  float*wsf=(float*)(shm+LDS_WS)+wid*64;
  const bf16*ksrc=Kh+(long)((NT-1)*KVBLK+lane)*DM+wid*8;
  const bf16*vsrc=Vh+(long)((NT-1)*KVBLK+16*(wid&3)+(lane>>2))*DM+(wid>>2)*32+(lane&3)*8;
  const unsigned kdst=lds0+LDS_K+wid*1024, vdst=lds0+LDS_V+wid*1024;
  #define DMA_K(t,slot) glds16(ksrc-(long)(t)*KVBLK*DM,(unsigned)__builtin_amdgcn_readfirstlane(kdst+(slot)))
  #define DMA_V(t,slot) glds16(vsrc-(long)(t)*KVBLK*DM,(unsigned)__builtin_amdgcn_readfirstlane(vdst+(slot)))
  const int vb0=(int)(lds0+LDS_V)+((lane>>4)&1)*32+(lane&3)*8+(4*hi+((lane&15)>>2))*64;
  const char*Kbase=shm+LDS_K; bf16x8 kf[8];
  const lds_cptr shm3=(lds_cptr)shm; const lds_cptr kp0=shm3+LDS_K+hi*1024+r32*16; const lds_cptr vp0=shm3+LDS_V+((lane>>4)&1)*32+(lane&3)*8+(4*hi+((lane&15)>>2))*64;
  { typedef __attribute__((address_space(3))) float lf_t; lf_t* cbw=(lf_t*)((lds_cptr)shm+LDS_CB); const float c0=cgp[q0]; const int jlo=(NT-NTE)*KVBLK, jhi=NT*KVBLK;
    for(int j=jlo+tid;j<jhi;j+=NW*64) cbw[j]=c0-cgp[j]; }
  const __attribute__((address_space(3))) float* cbL=(const __attribute__((address_space(3))) float*)((lds_cptr)shm+LDS_CB)+4*hi;
  #define CBLOAD(C0,C1,t,MH) do{ const __attribute__((address_space(3))) float* cbp_=cbL+(NT-1-(t))*KVBLK; \
    _Pragma("unroll") for(int g_=0;g_<4;++g_){ const f32x4_t v0_=*(const __attribute__((address_space(3))) f32x4_t*)(cbp_+8*g_); const f32x4_t v1_=*(const __attribute__((address_space(3))) f32x4_t*)(cbp_+32+8*g_); \
      C0[4*g_]=v0_[0]-(MH);C0[4*g_+1]=v0_[1]-(MH);C0[4*g_+2]=v0_[2]-(MH);C0[4*g_+3]=v0_[3]-(MH); C1[4*g_]=v1_[0]-(MH);C1[4*g_+1]=v1_[1]-(MH);C1[4*g_+2]=v1_[2]-(MH);C1[4*g_+3]=v1_[3]-(MH);} }while(0)
  DMA_K(0,0);DMA_V(0,0);DMA_K(1,SLOTB);
  bf16x8 qr[4];
  #pragma unroll
  for(int d0=0;d0<4;++d0)qr[d0]=*reinterpret_cast<const bf16x8*>(&Qw[(long)r32*DM+d0*16+hi*8]);
  float mhat=0.f,l_reg=0.f;f32x16 o[2];o[0]=f32x16{};o[1]=f32x16{};
  const int qrel=wid*QBLK+r32;
  #define CMASK(P0,P1,t) do{int jb_=3-(t); if(jb_>=0)cmask(P0,P1,jb_,qrel,hi);}while(0)
  bool resc=false;
  #define START(P0,P1) do{ const float rm=rowmax(P0,P1); resc=false; \
    { const float dl=(rm>-1e30f)?rm:0.f; mhat=fadd_s(mhat,dl); \
      _Pragma("unroll") for(int r=0;r<16;++r){P0[r]=fsub_s(P0[r],dl);P1[r]=fsub_s(P1[r],dl);} } \
    _Pragma("unroll") for(int r=0;r<16;++r)P0[r]=__builtin_amdgcn_exp2f(P0[r]); }while(0)
  #define RESC() do{ if(resc){ asm volatile("s_waitcnt lgkmcnt(0)":::"memory"); \
      _Pragma("unroll") for(int d_=0;d_<2;++d_) _Pragma("unroll") for(int r=0;r<16;++r)o[d_][r]*=wsf[crow(r,hi)]; } }while(0)
  f32x16 pA0,pA1,pB0,pB1;
  int sl_prev=0,sl_cur=0,sl_next=SLOTB;
  #define ROT() do{sl_prev=sl_cur;sl_cur=sl_next;sl_next=(sl_next==(NSLOT-1)*SLOTB)?0:sl_next+SLOTB;}while(0)
  DMA_K(2,2*SLOTB);
  WAIT_BAR(3);
  CBLOAD(pA0,pA1,0,0.f); qkt(pA0,pA1,Kbase,qr,r32,hi);asm volatile("s_nop 15\n\ts_nop 7":"+v"(pA0),"+v"(pA1));CMASK(pA0,pA1,0);
  START(pA0,pA1);
  _Pragma("unroll") for(int r=0;r<16;++r)pA1[r]=__builtin_amdgcn_exp2f(pA1[r]);
  WAIT_BAR(0);
  DMA_K(3,0);DMA_V(1,SLOTB);
  ROT();
  kload8(kf,kp0+sl_cur);
  WAIT_BAR(2);
  s16x4 vlo[8],vhi[8]; u32x4 pw0,pw1,pw2,pw3;
  #define PKW(P,B) cvtpk_s(P[B],P[B+1])
  #define PAF(k) __builtin_bit_cast(bf16x8,pw##k)
  #define VFR(i) (bf16x8){vlo[i][0],vlo[i][1],vlo[i][2],vlo[i][3],vhi[i][0],vhi[i][1],vhi[i][2],vhi[i][3]}
  #define PIN(x) asm volatile("":"+v"(x))
  #define MX3(a,b,c) __builtin_fmaxf(__builtin_fmaxf((a),(b)),(c))
  #define GAPA(MF,A0,A1,A2,A3,W0,W1,PW) do{ MF; sacc+=A0; sacc+=A1; sacc+=A2; sacc+=A3; PIN(sacc); W0; W1; PIN(PW); SBAR(); }while(0)
  #define EX(v) __builtin_amdgcn_exp2f(v)
  #define GAPB(MF,X,B) do{ MF; X[B]=EX(X[B]); X[B+1]=EX(X[B+1]); X[B+2]=EX(X[B+2]); X[B+3]=EX(X[B+3]); PIN(X); SBAR(); }while(0)
  #define VRD(i) do{ vlo[i]=vtr(vp_+(((i)>>2)*4096+((i)&3)*1024)); vhi[i]=vtr(vp_+(((i)>>2)*4096+((i)&3)*1024+512)); }while(0)
  #define KRD(G,j) do{ if(G){ kload2(kf,kp0+sl_next,j); SBAR(); } }while(0)
  #define STEP(C0,C1,P0,P1,t,GK,GV,GL) do{ SBAR(); \
    const lds_cptr vp_=vp0+sl_prev; CBLOAD(C0,C1,t,mhat); SBAR(); \
    VRD(0); SBAR(); float sacc=(P0[0]+P0[1]); \
    GAPA(C0=__builtin_amdgcn_mfma_f32_32x32x16_bf16(kf[0],qr[0],C0,0,0,0), P0[2],P0[3],P0[4],P0[5],     pw0[0]=PKW(P0,0), pw0[1]=PKW(P0,2), pw0); \
    VRD(4); SBAR(); GAPA(C1=__builtin_amdgcn_mfma_f32_32x32x16_bf16(kf[1],qr[0],C1,0,0,0), P0[6],P0[7],P0[8],P0[9],     pw0[2]=PKW(P0,4), pw0[3]=PKW(P0,6), pw0); \
    VRD(1); SBAR(); GAPA(C0=__builtin_amdgcn_mfma_f32_32x32x16_bf16(kf[2],qr[1],C0,0,0,0),   P0[10],P0[11],P0[12],P0[13], pw1[0]=PKW(P0,8), pw1[1]=PKW(P0,10), pw1); \
    VRD(5); SBAR(); GAPA(C1=__builtin_amdgcn_mfma_f32_32x32x16_bf16(kf[3],qr[1],C1,0,0,0),   P0[14],P0[15],P1[0],P1[1],   pw1[2]=PKW(P0,12),pw1[3]=PKW(P0,14), pw1); \
    VRD(2); SBAR(); GAPA(C0=__builtin_amdgcn_mfma_f32_32x32x16_bf16(kf[4],qr[2],C0,0,0,0),   P1[2],P1[3],P1[4],P1[5],     pw2[0]=PKW(P1,0), pw2[1]=PKW(P1,2), pw2); \
    VRD(6); SBAR(); GAPA(C1=__builtin_amdgcn_mfma_f32_32x32x16_bf16(kf[5],qr[2],C1,0,0,0),   P1[6],P1[7],P1[8],P1[9],     pw2[2]=PKW(P1,4), pw2[3]=PKW(P1,6), pw2); \
    VRD(3); SBAR(); GAPA(C0=__builtin_amdgcn_mfma_f32_32x32x16_bf16(kf[6],qr[3],C0,0,0,0),   P1[10],P1[11],P1[12],P1[13], pw3[0]=PKW(P1,8), pw3[1]=PKW(P1,10), pw3); \
    VRD(7); SBAR(); GAPA(C1=__builtin_amdgcn_mfma_f32_32x32x16_bf16(kf[7],qr[3],C1,0,0,0),   P1[14],P1[15],0.f,0.f,       pw3[2]=PKW(P1,12),pw3[3]=PKW(P1,14), pw3); \
    l_reg+=sacc; \
    if(GK){DMA_K((t)+3,sl_cur);} if(GV){DMA_V((t)+1,sl_next);} \
    CMASK(C0,C1,t); \
    { float a=MX3(C0[0],C0[1],C1[0]),b=MX3(C0[2],C0[3],C1[1]); a=MX3(a,C1[2],C1[3]); \
      _Pragma("unroll") for(int r=4;r<16;r+=4){a=MX3(a,C0[r],C0[r+1]);b=MX3(b,C0[r+2],C0[r+3]);a=MX3(a,C1[r],C1[r+1]);b=MX3(b,C1[r+2],C1[r+3]);} \
      float rm=__builtin_fmaxf(a,b); { auto rr=__builtin_amdgcn_permlane32_swap(__float_as_uint(rm),__float_as_uint(rm),false,false); rm=__builtin_fmaxf(__uint_as_float(rr[0]),__uint_as_float(rr[1])); } \
      resc=false; \
      if(__builtin_expect(__any(rm>(float)THRL),0)){ const float dl=__builtin_fmaxf(rm,0.f); mhat+=dl; \
        _Pragma("unroll") for(int r=0;r<16;++r){C0[r]-=dl;C1[r]-=dl;} \
        const float f=__builtin_amdgcn_exp2f(-dl); l_reg*=f; if(hi==0)wsf[r32]=f; resc=true; } } \
    SBAR(); \
    GAPB(o[0]=__builtin_amdgcn_mfma_f32_32x32x16_bf16(PAF(0),VFR(0),o[0],0,0,0), C0,0); \
    GAPB(o[1]=__builtin_amdgcn_mfma_f32_32x32x16_bf16(PAF(0),VFR(4),o[1],0,0,0), C0,4); \
    KRD(GL,0); GAPB(o[0]=__builtin_amdgcn_mfma_f32_32x32x16_bf16(PAF(1),VFR(1),o[0],0,0,0), C0,8); \
    KRD(GL,1); GAPB(o[1]=__builtin_amdgcn_mfma_f32_32x32x16_bf16(PAF(1),VFR(5),o[1],0,0,0), C0,12); \
    KRD(GL,2); GAPB(o[0]=__builtin_amdgcn_mfma_f32_32x32x16_bf16(PAF(2),VFR(2),o[0],0,0,0), C1,0); \
    KRD(GL,3); GAPB(o[1]=__builtin_amdgcn_mfma_f32_32x32x16_bf16(PAF(2),VFR(6),o[1],0,0,0), C1,4); \
    GAPB(o[0]=__builtin_amdgcn_mfma_f32_32x32x16_bf16(PAF(3),VFR(3),o[0],0,0,0), C1,8); \
    GAPB(o[1]=__builtin_amdgcn_mfma_f32_32x32x16_bf16(PAF(3),VFR(7),o[1],0,0,0), C1,12); \
    }while(0)
  int t=1;
  for(;t<5&&t+5<NTE;t+=2){
    STEP(pB0,pB1,pA0,pA1,t,true,true,true);     WAIT_BAR(2); RESC(); ROT();
    STEP(pA0,pA1,pB0,pB1,t+1,true,true,true);   WAIT_BAR(2); RESC(); ROT();
  }
  #undef CMASK
  #define CMASK(P0,P1,t) do{}while(0)
  for(;t+5<NTE;t+=2){
    STEP(pB0,pB1,pA0,pA1,t,true,true,true);     WAIT_BAR(2); RESC(); ROT();
    STEP(pA0,pA1,pB0,pB1,t+1,true,true,true);   WAIT_BAR(2); RESC(); ROT();
  }
  #undef CMASK
  #define CMASK(P0,P1,t) do{int jb_=3-(t); if(jb_>=0)cmask(P0,P1,jb_,qrel,hi);}while(0)
  #define ENDW(tt) do{ if((tt)+3<NTE){WAIT_BAR(2);} else if((tt)+2<NTE){WAIT_BAR(1);} else {WAIT_BAR(0);} }while(0)
  for(;t+1<NTE;t+=2){
    STEP(pB0,pB1,pA0,pA1,t,(t+3<NTE),(t+1<NTE),(t+1<NTE));       ENDW(t);   RESC(); ROT();
    STEP(pA0,pA1,pB0,pB1,t+1,(t+4<NTE),(t+2<NTE),(t+2<NTE));     ENDW(t+1); RESC(); ROT();
  }
  STEP(pB0,pB1,pA0,pA1,NTE-1,false,false,false); RESC();
  { float sacc=pB0[0]+pB0[1]; _Pragma("unroll") for(int r=2;r<16;++r)sacc+=pB0[r]; _Pragma("unroll") for(int r=0;r<16;++r)sacc+=pB1[r]; l_reg+=sacc;
    pw0=(u32x4){PKW(pB0,0),PKW(pB0,2),PKW(pB0,4),PKW(pB0,6)};pw1=(u32x4){PKW(pB0,8),PKW(pB0,10),PKW(pB0,12),PKW(pB0,14)};pw2=(u32x4){PKW(pB1,0),PKW(pB1,2),PKW(pB1,4),PKW(pB1,6)};pw3=(u32x4){PKW(pB1,8),PKW(pB1,10),PKW(pB1,12),PKW(pB1,14)};
    SBAR(); pv(o,vb0+sl_cur,PAF(0),PAF(1),PAF(2),PAF(3)); }
  #undef PKW
  #undef PAF
  #undef VFR
  #undef PIN
  #undef MX3
  #undef GAPA
  #undef GAPB
  #undef EX
  #undef VRD
  #undef KRD
  #undef STEP
  #undef ENDW
  {auto rr=__builtin_amdgcn_permlane32_swap(__float_as_uint(l_reg),__float_as_uint(l_reg),false,false);l_reg=__uint_as_float(rr[0])+__uint_as_float(rr[1]);}
  if(hi==0)wsf[32+r32]=l_reg;asm volatile("s_waitcnt lgkmcnt(0)":::"memory");
  float rli[16];
  #pragma unroll
  for(int r=0;r<16;++r)rli[r]=__builtin_amdgcn_rcpf(wsf[32+crow(r,hi)]);
  bf16*Ow=Ob+(long)(wid*QBLK)*OPITCH;
  { bf16*stg=(bf16*)(shm+LDS_OST)+wid*2048;
    #pragma unroll
    for(int r=0;r<16;++r){const int orow=crow(r,hi);
      #pragma unroll
      for(int d0=0;d0<2;++d0)stg[orow*64+d0*32+r32]=__float2bfloat16(o[d0][r]*rli[r]);}
    asm volatile("s_waitcnt lgkmcnt(0)":::"memory");
    #pragma unroll
    for(int i=0;i<4;++i){const int row=i*8+(lane>>3),ch=lane&7; const u32x4 v=*(const u32x4*)(stg+row*64+ch*8); if(wid>=wlo&&wid<whi)ATTN_STORE16(Ow+(long)row*OPITCH+ch*8,v);} }
  asm volatile("s_waitcnt lgkmcnt(0)\n\ts_barrier":::"memory");
  #undef DMA_K
  #undef DMA_V
  #undef CMASK
  #undef START
  #undef RESC
  #undef ROT
  #undef CBLOAD
}
constexpr int ATTN_LDS_BYTES=LDS_BYTES;
#undef SBAR
#undef WAIT_BAR
}
#include <hip/hip_cooperative_groups.h>
namespace cg = cooperative_groups;
#ifndef MK_N_LAUNCHES
#define MK_N_LAUNCHES 1
#endif
#ifndef FOX_PRUNE
#define FOX_PRUNE 1
#endif
constexpr int NWAVES = 8, NTHR = 512;
constexpr int DMOD = 1024, TSEQ = 8192, NBATCH = 8, MP = NBATCH * TSEQ, MS = 512, MTOT = MP + MS;
constexpr int NIN = 3584, INC = 3592, FF = 4096, SSEQ = 1152, PAST = 1024, DSEQ = 32;
constexpr int NCHUNK = MTOT / 64;
constexpr float EPSN = 1e-6f, LOG2E = 1.4426950408889634f;
constexpr size_t MiB = 1u << 20;
constexpr size_t WS_CTL = 0, CTL_ZERO_BYTES = 65536;
constexpr size_t WS_WIN = 2 * MiB, WS_WO = 9 * MiB, WS_WUP = 11 * MiB, WS_WDN = 19 * MiB;
constexpr size_t WS_RSTD = 27 * MiB, WS_CGP = 28 * MiB, WS_CGS = 30 * MiB, WS_VEC = 31 * MiB, WS_SSQ = 38 * MiB;
constexpr size_t WS_X1B = 44 * MiB, WS_MIX = 174 * MiB, WS_H = 304 * MiB;
constexpr size_t WS_XB = 304 * MiB, WS_Q = 434 * MiB, WS_K = 498 * MiB, WS_V = 562 * MiB, WS_QS = 626 * MiB, WS_KS = 635 * MiB, WS_VS = 644 * MiB;
constexpr size_t WS_QR = 654 * MiB, WS_KR = 719 * MiB, WS_VH = 784 * MiB, WS_SG = 849 * MiB, WS_END = 914 * MiB;
constexpr size_t VECN = (size_t)NCHUNK * 512;
static_assert(WS_VEC + 3 * VECN * 4 <= WS_SSQ && WS_SSQ + (size_t)MTOT * 16 * 4 <= WS_X1B && WS_X1B + (size_t)MTOT * DMOD * 2 <= WS_MIX && WS_MIX + (size_t)MTOT * DMOD * 2 <= WS_H, "ws map");
static_assert(WS_H + (size_t)MTOT * FF * 2 <= WS_END && WS_XB + (size_t)MTOT * DMOD * 2 <= WS_Q && WS_SG + (size_t)MTOT * 512 * 2 <= WS_END, "ws map 2");
constexpr int CW_QUEUE = 64, CW_SUB = 128, CW_BAR = 1024, NCHAINWG = 32;
constexpr size_t O_YP = 0, O_YS = O_YP + (size_t)MP * DMOD, O_KP = O_YS + (size_t)256 * DMOD, O_VP = O_KP + (size_t)MP * 512, O_LP = O_VP + (size_t)MP * 512,
                 O_HP = O_LP + (size_t)MP * 8, O_KS = O_HP + 524288, O_VS = O_KS + 131072, O_LS = O_VS + 131072, O_HS = O_LS + 2048, O_END = O_HS + 524288;
constexpr int RING_BYTES = 131072, MISC_OFF = RING_BYTES, LDS_BYTES = 135168;
static_assert(attn_body::ATTN_LDS_BYTES <= RING_BYTES, "attention LDS");

#define LAS __attribute__((address_space(3)))
typedef unsigned short bf16;
typedef unsigned v4u __attribute__((ext_vector_type(4)));
typedef unsigned v2u __attribute__((ext_vector_type(2)));
typedef float f32x4 __attribute__((ext_vector_type(4)));
typedef short bf16x8 __attribute__((ext_vector_type(8)));
#define LDS_WAIT() asm volatile("s_waitcnt lgkmcnt(0)" ::: "memory")
__device__ __forceinline__ unsigned pk2(float lo, float hi) { return pg8::cvt_pk_bf16(lo, hi); }
__device__ __forceinline__ float bf2f(unsigned short b) { return __uint_as_float(((unsigned)b) << 16); }
#define DPPF(v, ctrl) __int_as_float(__builtin_amdgcn_update_dpp(0, __float_as_int(v), (ctrl), 0xf, 0xf, false))
__device__ __forceinline__ float sum8(float v) { v += DPPF(v, 0xB1); v += DPPF(v, 0x4E); v += DPPF(v, 0x141); return v; }
__device__ __forceinline__ float swap16_sum(float a, float b) { auto r = __builtin_amdgcn_permlane16_swap(__float_as_uint(a), __float_as_uint(b), false, false); return __uint_as_float(r[0]) + __uint_as_float(r[1]); }
__device__ __forceinline__ float swap32_sum(float a, float b) { auto r = __builtin_amdgcn_permlane32_swap(__float_as_uint(a), __float_as_uint(b), false, false); return __uint_as_float(r[0]) + __uint_as_float(r[1]); }
__device__ __forceinline__ float wave_sum(float v) { v = sum8(v); v += DPPF(v, 0x140); v = swap16_sum(v, v); v = swap32_sum(v, v); return v; }
__device__ __forceinline__ bool row_map(int row, int& idx) { if (row < MP) { idx = row; return true; } const int rs = row - MP; idx = (rs >> 6) * 32 + (rs & 63); return (rs & 63) < 32; }

namespace pg8 {
struct OrderIn {
    StaticOrder so; int pn_off, extra, extra_pm0, extra_shift;
    __device__ bool next(int i, Unit& u) const {
        const long L = (long)i * so.G + so.c;
        if (L < so.nwg) { so.next(i, u); u.pn += pn_off; return true; }
        const long e = L - so.nwg; if (e >= extra) return false;
        u.pm = extra_pm0 + (int)(e >> extra_shift); u.pn = (int)(e & ((1 << extra_shift) - 1)); u.kofs = 0; return true;
    }
    __device__ __forceinline__ void a_ready(const Unit&) const {}
    __device__ __forceinline__ void done(const Unit&) const {}
};
#define DPP_SHR(v, n) __int_as_float(__builtin_amdgcn_update_dpp(0, __float_as_int(v), 0x110 + (n), 0xf, 0xf, false))
#define PERMA(lane) ((((lane) >> 2) + 16 * ((lane) & 3)) << 2)
__device__ __forceinline__ f32x4 lperm(const f32x4 v, int pa) { f32x4 r;
    r[0] = __int_as_float(__builtin_amdgcn_ds_bpermute(pa, __float_as_int(v[0]))); r[1] = __int_as_float(__builtin_amdgcn_ds_bpermute(pa, __float_as_int(v[1])));
    r[2] = __int_as_float(__builtin_amdgcn_ds_bpermute(pa, __float_as_int(v[2]))); r[3] = __int_as_float(__builtin_amdgcn_ds_bpermute(pa, __float_as_int(v[3]))); return r; }
struct EpiIn {
    static constexpr bool PERM = false, AFTER_DRAIN = false;
    const float* rstd1; const float* lbl; const float* qg; const float* kg; unsigned char* ws; float* out;
    __device__ __forceinline__ void operator()(const f32x4 (&acc)[2][2][4][2], const Unit& u, int wr, int wc, int fr, int fq) const {
        const int pn = u.pn, rowb = u.pm * BM + wr * 64 + fr; const bool samp = u.pm >= (MP / BM);
        const int lane_ = threadIdx.x & 63, pa = PERMA(lane_), fr2 = lane_ >> 2, fq2 = lane_ & 3, rowb2 = u.pm * BM + wr * 64 + fr2;
        bf16_t* const QR = (bf16_t*)(ws + WS_QR); bf16_t* const KR = (bf16_t*)(ws + WS_KR); bf16_t* const VH = (bf16_t*)(ws + WS_VH); bf16_t* const SG = (bf16_t*)(ws + WS_SG); float* const vec = (float*)(ws + WS_VEC);
        float rs[2][4];
#pragma unroll
        for (int ai = 0; ai < 2; ++ai)
#pragma unroll
            for (int m = 0; m < 4; ++m) rs[ai][m] = rstd1[rowb + ai * HALF + m * 16];
        if (pn < 4) {
            const int h = pn, ch0 = 128 * h + 32 * wc + 4 * fq; const int lane = threadIdx.x & 63; const int a15 = ((lane & 48) | 15) << 2;
#pragma unroll
            for (int n = 0; n < 2; ++n) {
                const f32x4 l0 = *(const f32x4*)(lbl + ch0 + 16 * n), l1 = *(const f32x4*)(lbl + 512 + ch0 + 16 * n);
                f32x4 lb, omlb;
#pragma unroll
                for (int j = 0; j < 4; ++j) { lb[j] = __builtin_amdgcn_rcpf(1.f + __expf(l1[j] - l0[j])); omlb[j] = 1.f - lb[j]; }
#pragma unroll
                for (int ai = 0; ai < 2; ++ai) {
                    f32x4 bq[4], kk[4], bb[4]; f32x4 carry = {0.f, 0.f, 0.f, 0.f};
#pragma unroll
                    for (int m = 0; m < 4; ++m) {
#pragma unroll
                        for (int j = 0; j < 4; ++j) {
                            const float zq = acc[ai][0][m][n][j] * rs[ai][m], zf = acc[ai][1][m][n][j] * rs[ai][m];
                            const float sig = __builtin_amdgcn_rcpf(1.f + __expf(-zf)); const float f = lb[j] + omlb[j] * sig; float k = omlb[j] * (1.f - sig); float s = __logf(f);
                            if (samp && m >= 2) { s = 0.f; k = 0.f; }
                            s += DPP_SHR(s, 1); s += DPP_SHR(s, 2); s += DPP_SHR(s, 4); s += DPP_SHR(s, 8);
                            s += carry[j]; carry[j] = __int_as_float(__builtin_amdgcn_ds_bpermute(a15, __float_as_int(s)));
                            bq[m][j] = zq; kk[m][j] = k; bb[m][j] = s;
                        }
                    }
#pragma unroll
                    for (int m = 0; m < 4; ++m) {
                        float qv[4], kv[4];
#pragma unroll
                        for (int j = 0; j < 4; ++j) { qv[j] = bq[m][j] * __expf(bb[m][j]); kv[j] = kk[m][j] * __expf(-bb[m][j]); }
                        const size_t off = (size_t)(rowb2 + ai * HALF + m * 16) * 512 + 128 * h + 32 * wc + 4 * fq2 + 16 * n;
                        const f32x4 qp = lperm((f32x4){qv[0], qv[1], qv[2], qv[3]}, pa), kp = lperm((f32x4){kv[0], kv[1], kv[2], kv[3]}, pa);
                        v2u wq; wq.x = cvt_pk_bf16(qp[0], qp[1]); wq.y = cvt_pk_bf16(qp[2], qp[3]); *(v2u*)(QR + off) = wq;
                        v2u wk; wk.x = cvt_pk_bf16(kp[0], kp[1]); wk.y = cvt_pk_bf16(kp[2], kp[3]); *(v2u*)(KR + off) = wk;
                    }
                    if (fr == 0) {
                        const size_t voff = (size_t)((u.pm * BM + ai * HALF + wr * 64) >> 6) * 512 + ch0 + 16 * n;
                        f32x4 d;
#pragma unroll
                        for (int j = 0; j < 4; ++j) d[j] = __expf(carry[j]);
                        *(f32x4*)(vec + voff) = d;
                    }
                }
            }
        } else if (pn < 8) {
            const int h = pn - 4, c0 = 128 * h + 32 * wc + 4 * fq2;
#pragma unroll
            for (int ai = 0; ai < 2; ++ai)
#pragma unroll
                for (int m = 0; m < 4; ++m) { const size_t off = (size_t)(rowb2 + ai * HALF + m * 16) * 512 + c0; const float r = rs[ai][m];
#pragma unroll
                    for (int n = 0; n < 2; ++n) { const f32x4 v = lperm(acc[ai][0][m][n] * r, pa); f32x4 g = acc[ai][1][m][n] * r;
#pragma unroll
                        for (int j = 0; j < 4; ++j) g[j] = g[j] * __builtin_amdgcn_rcpf(1.f + __expf(-g[j]));
                        g = lperm(g, pa);
                        v2u wv; wv.x = cvt_pk_bf16(v[0], v[1]); wv.y = cvt_pk_bf16(v[2], v[3]); *(v2u*)(VH + off + 16 * n) = wv;
                        v2u wg; wg.x = cvt_pk_bf16(g[0], g[1]); wg.y = cvt_pk_bf16(g[2], g[3]); *(v2u*)(SG + off + 16 * n) = wg; } }
        } else if (pn < 12) {
            const bool isK = pn >= 10; const int head = 4 * ((pn - 8) & 1) + wc; const float* gain = isK ? kg : qg; const float osc = isK ? 1.f : attn_body::C2;
            f32x4 gv[2][2];
#pragma unroll
            for (int bj = 0; bj < 2; ++bj)
#pragma unroll
                for (int n = 0; n < 2; ++n) gv[bj][n] = *(const f32x4*)(gain + 32 * bj + 16 * n + 4 * fq) * osc;
#pragma unroll
            for (int ai = 0; ai < 2; ++ai)
#pragma unroll
                for (int m = 0; m < 4; ++m) { const int row = rowb2 + ai * HALF + m * 16; const float r = rs[ai][m]; float ssq = 0.f;
#pragma unroll
                    for (int bj = 0; bj < 2; ++bj)
#pragma unroll
                        for (int n = 0; n < 2; ++n) { const f32x4 z = acc[ai][bj][m][n] * r; ssq += (z[0] * z[0] + z[1] * z[1]) + (z[2] * z[2] + z[3] * z[3]); }
                    ssq = swap16_sum(ssq, ssq); ssq = swap32_sum(ssq, ssq);
                    const float r2 = r * __builtin_amdgcn_rsqf(ssq * (1.f / 64.f) + EPSN);
                    int idx; const bool valid = row_map(row, idx);
                    float* ofp = out + (samp ? O_KS : O_KP) + (size_t)idx * 512;
                    const size_t boff = samp ? (isK ? WS_KS : WS_QS) : (isK ? WS_K : WS_Q); const size_t brow = samp ? (size_t)((idx >> 5) * SSEQ + PAST + (idx & 31)) : (size_t)row;
                    bf16_t* bfp = (bf16_t*)(ws + boff) + brow * 512;
                    if (valid) {
#pragma unroll
                        for (int bj = 0; bj < 2; ++bj)
#pragma unroll
                            for (int n = 0; n < 2; ++n) { const f32x4 v = lperm(acc[ai][bj][m][n] * r2 * gv[bj][n], pa); const int col = 64 * head + 32 * bj + 16 * n + 4 * fq2;
                                if (isK) *(f32x4*)(ofp + col) = v;
                                v2u w; w.x = cvt_pk_bf16(v[0], v[1]); w.y = cvt_pk_bf16(v[2], v[3]); *(v2u*)(bfp + col) = w; } } }
        } else {
            const int c0 = 256 * (pn - 12) + 32 * wc + 4 * fq2;
#pragma unroll
            for (int ai = 0; ai < 2; ++ai)
#pragma unroll
                for (int m = 0; m < 4; ++m) { const int row = rowb2 + ai * HALF + m * 16; const float r = rs[ai][m];
                    int idx; const bool valid = row_map(row, idx);
                    float* ofp = out + (samp ? O_VS : O_VP) + (size_t)idx * 512;
                    const size_t brow = samp ? (size_t)((idx >> 5) * SSEQ + PAST + (idx & 31)) : (size_t)row;
                    bf16_t* bfp = (bf16_t*)(ws + (samp ? WS_VS : WS_V)) + brow * 512;
                    if (valid) {
#pragma unroll
                        for (int bj = 0; bj < 2; ++bj)
#pragma unroll
                            for (int n = 0; n < 2; ++n) { const f32x4 v = lperm(acc[ai][bj][m][n] * r, pa); const int col = c0 + 128 * bj + 16 * n;
                                *(f32x4*)(ofp + col) = v;
                                v2u w; w.x = cvt_pk_bf16(v[0], v[1]); w.y = cvt_pk_bf16(v[2], v[3]); *(v2u*)(bfp + col) = w; } } }
        }
    }
};
struct EpiWo {
    static constexpr bool PERM = false, AFTER_DRAIN = false;
    const bf16_t* XBp; const float* xs; float* yp; float* ys; bf16_t* X1B; float* ssq;
    __device__ __forceinline__ void operator()(const f32x4 (&acc)[2][2][4][2], const Unit& u, int wr, int wc, int fr, int fq) const {
        const int lane = threadIdx.x & 63, pa = PERMA(lane); fr = lane >> 2; fq = lane & 3;
        const int rowb = u.pm * BM + wr * 64 + fr, c0 = u.pn * BM + wc * 32 + 4 * fq; const bool samp = u.pm >= (MP / BM);
#pragma unroll
        for (int ai = 0; ai < 2; ++ai) {
            f32x4 xv[4][2][2];
            if (samp) {
#pragma unroll
                for (int m = 0; m < 4; ++m) { const int row = rowb + ai * HALF + m * 16; int idx; const bool valid = row_map(row, idx); const float* xr = xs + (size_t)idx * DMOD;
#pragma unroll
                    for (int bj = 0; bj < 2; ++bj)
#pragma unroll
                        for (int n = 0; n < 2; ++n) xv[m][bj][n] = valid ? *(const f32x4*)(xr + c0 + 128 * bj + 16 * n) : (f32x4){0.f, 0.f, 0.f, 0.f}; }
            } else {
                v2u xb[4][2][2];
#pragma unroll
                for (int m = 0; m < 4; ++m) { const bf16_t* xr = XBp + (size_t)(rowb + ai * HALF + m * 16) * DMOD;
#pragma unroll
                    for (int bj = 0; bj < 2; ++bj)
#pragma unroll
                        for (int n = 0; n < 2; ++n) xb[m][bj][n] = *(const v2u*)(xr + c0 + 128 * bj + 16 * n); }
                __builtin_amdgcn_sched_barrier(0);
#pragma unroll
                for (int m = 0; m < 4; ++m)
#pragma unroll
                    for (int bj = 0; bj < 2; ++bj)
#pragma unroll
                        for (int n = 0; n < 2; ++n) { const v2u w = xb[m][bj][n]; xv[m][bj][n] = (f32x4){__uint_as_float(w.x << 16), __uint_as_float(w.x & 0xffff0000u), __uint_as_float(w.y << 16), __uint_as_float(w.y & 0xffff0000u)}; }
            }
            __builtin_amdgcn_sched_barrier(0);
#pragma unroll
            for (int m = 0; m < 4; ++m) { const int row = rowb + ai * HALF + m * 16; int idx; const bool valid = row_map(row, idx);
                float* yr = yp + (samp ? (size_t)MP * DMOD : (size_t)0) + (size_t)idx * DMOD; float s = 0.f;
#pragma unroll
                for (int bj = 0; bj < 2; ++bj)
#pragma unroll
                    for (int n = 0; n < 2; ++n) { const int col = c0 + 128 * bj + 16 * n; f32x4 v = lperm(acc[ai][bj][m][n], pa) + xv[m][bj][n];
                        if (samp && valid) *(f32x4*)(yr + col) = v;
                        s += (v[0] * v[0] + v[1] * v[1]) + (v[2] * v[2] + v[3] * v[3]);
                        v2u w; w.x = cvt_pk_bf16(v[0], v[1]); w.y = cvt_pk_bf16(v[2], v[3]); *(v2u*)(X1B + (size_t)row * DMOD + col) = w; }
                s += __shfl_xor(s, 1); s += __shfl_xor(s, 2);
                if (fq == 0) ssq[(size_t)row * 16 + 4 * u.pn + wc] = s; }
            __builtin_amdgcn_sched_barrier(0);
        }
    }
};
struct EpiUp {
    static constexpr bool PERM = true, AFTER_DRAIN = false;
    bf16_t* O; const float* ssq;
    __device__ __forceinline__ void operator()(const f32x4 (&acc)[2][2][4][2], const Unit& u, int wr, int wc, int fr, int fq) const {
        const int lane = threadIdx.x & 63, pa = PERMA(lane); fr = lane >> 2; fq = lane & 3;
        const int row0 = u.pm * BM + wr * 64 + fr, col0 = u.pn * BM + wc * 32 + 8 * fq;
        float rr[2][4];
#pragma unroll
        for (int ai = 0; ai < 2; ++ai) { f32x4 sv[4][4];
#pragma unroll
            for (int m = 0; m < 4; ++m) { const f32x4* sp = (const f32x4*)(ssq + (size_t)(row0 + ai * HALF + m * 16) * 16); sv[m][0] = sp[0]; sv[m][1] = sp[1]; sv[m][2] = sp[2]; sv[m][3] = sp[3]; }
            __builtin_amdgcn_sched_barrier(0);
#pragma unroll
            for (int m = 0; m < 4; ++m) { const f32x4 st = (sv[m][0] + sv[m][1]) + (sv[m][2] + sv[m][3]); rr[ai][m] = __builtin_amdgcn_rsqf(((st[0] + st[1]) + (st[2] + st[3])) * (1.f / DMOD) + EPSN); } }
#pragma unroll
        for (int ai = 0; ai < 2; ++ai)
#pragma unroll
            for (int m = 0; m < 4; ++m) { const int row = row0 + ai * HALF + m * 16;
                const float r = rr[ai][m];
                bf16_t* rowp = O + (size_t)row * FF + col0;
#pragma unroll
                for (int bj = 0; bj < 2; ++bj) { f32x4 v0 = lperm(acc[ai][bj][m][0], pa) * r, v1 = lperm(acc[ai][bj][m][1], pa) * r;
#pragma unroll
                    for (int j = 0; j < 4; ++j) { v0[j] = fmaxf(v0[j], 0.f); v0[j] *= v0[j]; v1[j] = fmaxf(v1[j], 0.f); v1[j] *= v1[j]; }
                    u32x4 w; w.x = cvt_pk_bf16(v0[0], v0[1]); w.y = cvt_pk_bf16(v0[2], v0[3]); w.z = cvt_pk_bf16(v1[0], v1[1]); w.w = cvt_pk_bf16(v1[2], v1[3]);
                    *(u32x4*)(rowp + bj * HALF) = w; } }
    }
};
struct OrderDown {
    StaticOrder so; int mode;
    static constexpr int KSPLIT = 4;
    __device__ bool next(int i, Unit& u) const {
        if (mode) return so.next(i, u);
        const long L = (long)i * so.G + so.c; if (L >= 8 * KSPLIT) return false;
        const int t = (int)L / KSPLIT, ks = (int)L % KSPLIT; u.pm = MP / BM + (t >> 2); u.pn = t & 3; u.kofs = ks * (FF / KSPLIT); return true;
    }
    __device__ __forceinline__ void a_ready(const Unit&) const {}
    __device__ __forceinline__ void done(const Unit&) const {}
};
struct EpiDown {
    static constexpr bool PERM = false, AFTER_DRAIN = false;
    float* yp; float* ys; const bf16_t* X1B; int atomic;
    __device__ __forceinline__ void operator()(const f32x4 (&acc)[2][2][4][2], const Unit& u, int wr, int wc, int fr, int fq) const {
        const int lane = threadIdx.x & 63, pa = PERMA(lane); fr = lane >> 2; fq = lane & 3;
        const int rowb = u.pm * BM + wr * 64 + fr, c0 = u.pn * BM + wc * 32 + 4 * fq; const bool samp = u.pm >= (MP / BM);
#pragma unroll
        for (int ai = 0; ai < 2; ++ai) {
            f32x4 xv[4][2][2];
            if (!atomic) {
                v2u xb[4][2][2];
#pragma unroll
                for (int m = 0; m < 4; ++m) { const bf16_t* xr = X1B + (size_t)(rowb + ai * HALF + m * 16) * DMOD;
#pragma unroll
                    for (int bj = 0; bj < 2; ++bj)
#pragma unroll
                        for (int n = 0; n < 2; ++n) xb[m][bj][n] = *(const v2u*)(xr + c0 + 128 * bj + 16 * n); }
                __builtin_amdgcn_sched_barrier(0);
#pragma unroll
                for (int m = 0; m < 4; ++m)
#pragma unroll
                    for (int bj = 0; bj < 2; ++bj)
#pragma unroll
                        for (int n = 0; n < 2; ++n) { const v2u w = xb[m][bj][n]; xv[m][bj][n] = (f32x4){__uint_as_float(w.x << 16), __uint_as_float(w.x & 0xffff0000u), __uint_as_float(w.y << 16), __uint_as_float(w.y & 0xffff0000u)}; }
            }
            __builtin_amdgcn_sched_barrier(0);
#pragma unroll
            for (int m = 0; m < 4; ++m) { const int row = rowb + ai * HALF + m * 16; int idx; const bool valid = row_map(row, idx);
                float* yr = yp + (samp ? (size_t)MP * DMOD : (size_t)0) + (size_t)idx * DMOD;
                if (valid) {
#pragma unroll
                    for (int bj = 0; bj < 2; ++bj)
#pragma unroll
                        for (int n = 0; n < 2; ++n) { const int col = c0 + 128 * bj + 16 * n; const f32x4 v = lperm(acc[ai][bj][m][n], pa);
                            if (atomic) {
#pragma unroll
                                for (int j = 0; j < 4; ++j) __hip_atomic_fetch_add(yr + col + j, v[j], __ATOMIC_RELAXED, __HIP_MEMORY_SCOPE_AGENT);
                            } else *(f32x4*)(yr + col) = xv[m][bj][n] + v; } } }
            __builtin_amdgcn_sched_barrier(0);
        }
    }
};
}

#define XB_TMO      128
#define XB_XCNT(j)  (256  + 64 * (j))
#define XB_XSUB(j)  (1280 + 64 * (j))
#define XB_XGEN(j)  (2304 + 64 * (j))
#define XB_TOP      3328
#define XB_TOPGEN   3392
#define XCD_BAR_WORDS 3456
#define XB_SPIN_CAP (1u << 18)

__device__ __forceinline__ unsigned xb_ld(unsigned* p)              { return __hip_atomic_load(p, __ATOMIC_RELAXED, __HIP_MEMORY_SCOPE_AGENT); }
__device__ __forceinline__ unsigned xb_add(unsigned* p, unsigned v) { return __hip_atomic_fetch_add(p, v, __ATOMIC_RELAXED, __HIP_MEMORY_SCOPE_AGENT); }
__device__ __forceinline__ unsigned xb_xcc_id() { return (unsigned)__builtin_amdgcn_s_getreg((3 << 11) | 20) & 0xFu; }
#define XB_SPIN(cond, bar) do { unsigned _sp = 0; while (cond) { __builtin_amdgcn_s_sleep(1); \
    if ((++_sp & 255u) == 0u) { if (xb_ld(&(bar)[XB_TMO])) break; if (_sp > XB_SPIN_CAP) { atomicAdd(&(bar)[XB_TMO], 1u); break; } } } } while (0)

struct XcdBarrier {
    unsigned* bar; unsigned x;
    volatile LAS unsigned* st;
};

__device__ __forceinline__ XcdBarrier xcd_barrier_post(unsigned* bar, volatile LAS unsigned* st) {
    XcdBarrier b; b.bar = bar; b.x = xb_xcc_id(); b.st = st;
    if (threadIdx.x == 0) (void)xb_add(&bar[XB_XCNT(b.x)], 1u);
    return b;
}
__device__ __forceinline__ void xcd_barrier_complete(unsigned* bar, unsigned x, unsigned& nloc, unsigned& nx) {
    const unsigned G = gridDim.x * gridDim.y * gridDim.z;
    unsigned sum, cnt, mine, sp = 0u;
    for (;;) {
        sum = 0u; cnt = 0u; mine = 0u;
#pragma unroll
        for (unsigned j = 0; j < 16; ++j) { const unsigned c = xb_ld(&bar[XB_XCNT(j)]); sum += c; cnt += (c > 0u) ? 1u : 0u; mine = (j == x) ? c : mine; }
        if (sum == G) break;
        __builtin_amdgcn_s_sleep(1);
        if ((++sp & 255u) == 0u) { if (xb_ld(&bar[XB_TMO])) break; if (sp > XB_SPIN_CAP) { atomicAdd(&bar[XB_TMO], 1u); break; } }
    }
    nloc = mine > 0u ? mine : 1u; nx = cnt > 0u ? cnt : 1u;
}

__device__ __forceinline__ void xcd_barrier(const XcdBarrier& b) {
    asm volatile("s_waitcnt vmcnt(0)" ::: "memory");
    __syncthreads();
    if (threadIdx.x == 0) {
        unsigned* bar = b.bar;
        __builtin_amdgcn_s_waitcnt(0);
        unsigned nloc = b.st[0], nx = b.st[1];
        if (nloc == 0u) { xcd_barrier_complete(bar, b.x, nloc, nx); b.st[0] = nloc; b.st[1] = nx; }
        const unsigned old = xb_add(&bar[XB_XSUB(b.x)], 1u);
        const unsigned gen = old / nloc;
        if (old + 1u == (gen + 1u) * nloc) {
            __builtin_amdgcn_fence(__ATOMIC_RELEASE, "agent");
            asm volatile("s_waitcnt vmcnt(0)" ::: "memory");
            const unsigned og = xb_add(&bar[XB_TOP], 1u);
            const unsigned tg = og / nx;
            if (og + 1u == (tg + 1u) * nx) xb_add(&bar[XB_TOPGEN], 1u);
            else XB_SPIN(xb_ld(&bar[XB_TOPGEN]) == tg, bar);
            __builtin_amdgcn_fence(__ATOMIC_ACQUIRE, "agent");
            xb_add(&bar[XB_XGEN(b.x)], 1u);
            asm volatile("s_waitcnt vmcnt(0)" ::: "memory");
        } else {
            XB_SPIN(xb_ld(&bar[XB_XGEN(b.x)]) == gen, bar);
            __builtin_amdgcn_fence(__ATOMIC_ACQUIRE, "agent");
            asm volatile("s_waitcnt vmcnt(0)" ::: "memory");
        }
    }
    __syncthreads();
}

struct Args { const float* in[17]; float* out; unsigned char* ws; int ph_lo, ph_hi; };
struct Frame {
    LAS unsigned char* lds; volatile LAS unsigned* MISC; unsigned* ctl; unsigned char* ws; float* out;
    int tid, lane, wave, vcu, G;
    const float *xp, *xs, *ck, *cv, *clf, *sh, *n1, *win, *bff, *qg, *kg, *lbl, *hon, *wout, *n2, *wup, *wdn;
};

__device__ __forceinline__ int win_src_col(int g) {
    const int j0 = 32 * g, tile = j0 >> 8, jl = j0 & 255;
    if (tile < 4) return (jl < 128) ? (128 * tile + jl) : (512 + 128 * tile + (jl - 128));
    if (tile < 8) { const int h = tile - 4; return (jl < 128) ? (1024 + 128 * h + jl) : (1536 + 128 * h + (jl - 128)); }
    if (tile < 12) { const int base = tile < 10 ? 2048 : 2560, tl = (tile - 8) & 1, bj = jl >> 7, wc = (jl >> 5) & 3; return base + 64 * (4 * tl + wc) + 32 * bj; }
    return 3072 + (j0 - 12 * 256);
}
__device__ __forceinline__ void p0_transpose_item(const float* W, int ldw, int K, const float* nrm, bf16* WT, int n0, int src0, int k0, LAS float* scr, int lane) {
    float vals[32]; const float* wp = W + (size_t)(k0 + (lane >> 5)) * ldw + src0 + (lane & 31);
#pragma unroll
    for (int i = 0; i < 32; ++i) vals[i] = wp[(size_t)(2 * i) * ldw];
    const int c = lane & 7;
    f32x4 n0v = {1.f, 1.f, 1.f, 1.f}, n1v = {1.f, 1.f, 1.f, 1.f};
    if (nrm) { n0v = *(const f32x4*)(nrm + k0 + 8 * c); n1v = *(const f32x4*)(nrm + k0 + 8 * c + 4); }
#pragma unroll
    for (int i = 0; i < 32; ++i) scr[(2 * i + (lane >> 5)) * 33 + (lane & 31)] = vals[i];
    LDS_WAIT(); asm volatile("" ::: "memory");
#pragma unroll
    for (int j = 0; j < 4; ++j) { const int n = (lane >> 3) + 8 * j; const LAS float* s = scr + (8 * c) * 33 + n;
        v4u o; o.x = pk2(s[0 * 33] * n0v[0], s[1 * 33] * n0v[1]); o.y = pk2(s[2 * 33] * n0v[2], s[3 * 33] * n0v[3]); o.z = pk2(s[4 * 33] * n1v[0], s[5 * 33] * n1v[1]); o.w = pk2(s[6 * 33] * n1v[2], s[7 * 33] * n1v[3]);
        *(v4u*)(WT + (size_t)(n0 + n) * K + k0 + 8 * c) = o; }
    LDS_WAIT(); asm volatile("" ::: "memory");
}
__device__ __forceinline__ void p0_prologue(Frame& F) {
    LAS float* scr = (LAS float*)(F.lds + F.wave * 16384);
    const int gw = F.vcu * NWAVES + F.wave, NGW = F.G * NWAVES, lane = F.lane;
    bf16* Win_t = (bf16*)(F.ws + WS_WIN); bf16* Wo_t = (bf16*)(F.ws + WS_WO); bf16* Wup_t = (bf16*)(F.ws + WS_WUP); bf16* Wdn_t = (bf16*)(F.ws + WS_WDN);
    constexpr int I_IN = 16 * (NIN / 32), I_O = 16 * 32, I_UP = 16 * (FF / 32), I_DN = 64 * 32, NITEMS = I_IN + I_O + I_UP + I_DN;
    for (int it = gw; it < NITEMS; it += NGW) {
        int r = it;
        if (r < I_IN) { const int kb = r / (NIN / 32), g = r % (NIN / 32); p0_transpose_item(F.win, INC, DMOD, F.n1, Win_t, 32 * g, win_src_col(g), 64 * kb, scr, lane); continue; } r -= I_IN;
        if (r < I_O) { const int kb = r / 32, g = r % 32; p0_transpose_item(F.wout, DMOD, DMOD, nullptr, Wo_t, 32 * g, 32 * g, 64 * kb, scr, lane); continue; } r -= I_O;
        if (r < I_UP) { const int kb = r / (FF / 32), g = r % (FF / 32); p0_transpose_item(F.wup, FF, DMOD, F.n2, Wup_t, 32 * g, 32 * g, 64 * kb, scr, lane); continue; } r -= I_UP;
        { const int kb = r / 32, g = r % 32; p0_transpose_item(F.wdn, DMOD, FF, nullptr, Wdn_t, 32 * g, 32 * g, 64 * kb, scr, lane); }
    }
    { const int gt = F.vcu * NTHR + F.tid, NGT = F.G * NTHR;
      bf16* Qs = (bf16*)(F.ws + WS_QS); bf16* Ks = (bf16*)(F.ws + WS_KS); bf16* Vs = (bf16*)(F.ws + WS_VS);
      for (int i = gt; i < NBATCH * PAST * 64; i += NGT) { const int b = i / (PAST * 64), rem = i % (PAST * 64); const size_t so = (size_t)i * 8, dof = ((size_t)b * SSEQ * 64 + rem) * 8;
          const f32x4 a0 = *(const f32x4*)(F.ck + so), a1 = *(const f32x4*)(F.ck + so + 4), b0 = *(const f32x4*)(F.cv + so), b1 = *(const f32x4*)(F.cv + so + 4);
          v4u o; o.x = pk2(a0[0], a0[1]); o.y = pk2(a0[2], a0[3]); o.z = pk2(a1[0], a1[1]); o.w = pk2(a1[2], a1[3]); *(v4u*)(Ks + dof) = o;
          o.x = pk2(b0[0], b0[1]); o.y = pk2(b0[2], b0[3]); o.z = pk2(b1[0], b1[1]); o.w = pk2(b1[2], b1[3]); *(v4u*)(Vs + dof) = o; }
      const v4u z = {0u, 0u, 0u, 0u};
      for (int i = gt; i < NBATCH * SSEQ * 64; i += NGT) *(v4u*)(Qs + (size_t)i * 8) = z;
      for (int i = gt; i < NBATCH * (SSEQ - PAST) * 64; i += NGT) { const int b = i / ((SSEQ - PAST) * 64), rem = i % ((SSEQ - PAST) * 64); const size_t dof = ((size_t)(b * SSEQ + PAST) * 64 + rem) * 8; *(v4u*)(Ks + dof) = z; *(v4u*)(Vs + dof) = z; }
    }
    float wf[4][4][8];
#pragma unroll
    for (int j = 0; j < 4; ++j)
#pragma unroll
        for (int i = 0; i < 4; ++i) { const int k = 256 * j + 4 * lane + i; const float nk = F.n1[k]; const f32x4 a = *(const f32x4*)(F.win + (size_t)k * INC + NIN), b = *(const f32x4*)(F.win + (size_t)k * INC + NIN + 4);
            wf[j][i][0] = a[0] * nk; wf[j][i][1] = a[1] * nk; wf[j][i][2] = a[2] * nk; wf[j][i][3] = a[3] * nk; wf[j][i][4] = b[0] * nk; wf[j][i][5] = b[1] * nk; wf[j][i][6] = b[2] * nk; wf[j][i][7] = b[3] * nk; }
    float* rstd1 = (float*)(F.ws + WS_RSTD); bf16* XB = (bf16*)(F.ws + WS_XB);
    f32x4 vn[4];
#define P0_LOADROW(mm) do { int idx_; const bool val_ = (mm) < MTOT && row_map((mm), idx_); const float* xr_ = ((mm) < MP ? F.xp : F.xs) + (size_t)idx_ * DMOD; \
        _Pragma("unroll") for (int j = 0; j < 4; ++j) vn[j] = val_ ? *((const f32x4*)xr_ + 64 * j + lane) : (f32x4){0.f, 0.f, 0.f, 0.f}; } while (0)
    P0_LOADROW(gw);
    for (int m = gw; m < MTOT; m += NGW) {
        int idx; const bool valid = row_map(m, idx);
        f32x4 v[4]; float s = 0.f;
#pragma unroll
        for (int j = 0; j < 4; ++j) v[j] = vn[j];
        P0_LOADROW(m + NGW);
#pragma unroll
        for (int j = 0; j < 4; ++j) s += (v[j][0] * v[j][0] + v[j][1] * v[j][1]) + (v[j][2] * v[j][2] + v[j][3] * v[j][3]);
        const float rstd = 1.f / sqrtf(wave_sum(s) * (1.f / DMOD) + EPSN);
        if (lane == 0) rstd1[m] = rstd;
        unsigned long long* o8 = (unsigned long long*)(XB + (size_t)m * DMOD) + lane;
#pragma unroll
        for (int j = 0; j < 4; ++j) o8[64 * j] = (unsigned long long)pk2(v[j][0], v[j][1]) | ((unsigned long long)pk2(v[j][2], v[j][3]) << 32);
        float a8[8];
#pragma unroll
        for (int h = 0; h < 8; ++h) { float a = 0.f;
#pragma unroll
            for (int j = 0; j < 4; ++j)
#pragma unroll
                for (int i = 0; i < 4; ++i) a += v[j][i] * wf[j][i][h];
            a8[h] = a; }
        float b4[4], c2[2], dsum;
#pragma unroll
        for (int i = 0; i < 4; ++i) b4[i] = swap32_sum(a8[i], a8[4 + i]);
#pragma unroll
        for (int i = 0; i < 2; ++i) c2[i] = swap16_sum(b4[i], b4[2 + i]);
        { const bool hi_ = (lane & 8) != 0; const float send = hi_ ? c2[0] : c2[1], keep = hi_ ? c2[1] : c2[0]; dsum = keep + DPPF(send, 0x128); }
        dsum = sum8(dsum);
        { const int hh = (lane >> 3) & 7; const float xx = dsum * rstd + F.bff[hh]; const float ls = fminf(xx, 0.f) - log1pf(expf(-fabsf(xx)));
          if (valid && (lane & 7) == 0) { float* lp = (m < MP ? F.out + O_LP : F.out + O_LS) + (size_t)idx * 8; lp[hh] = ls; } }
    }
}
__device__ __forceinline__ void scan_chain(Frame& F, int ch) {
    LAS float* wsum = (LAS float*)F.lds;
    const bool samp = ch >= 64; const int c2 = samp ? ch - 64 : ch, b = c2 >> 3, h = c2 & 7; const int L = samp ? SSEQ : TSEQ, EPT = samp ? 3 : 16;
    float* dst = samp ? (float*)(F.ws + WS_CGS) + (size_t)c2 * SSEQ : (float*)(F.ws + WS_CGP) + (size_t)c2 * TSEQ;
    float vals[16]; float sum = 0.f;
#pragma unroll
    for (int i = 0; i < 16; ++i) { const int p = F.tid * EPT + i; float v = 0.f;
        if (i < EPT && p < L) { if (!samp) v = F.out[O_LP + ((size_t)b * TSEQ + p) * 8 + h]; else if (p < PAST) v = F.clf[((size_t)b * PAST + p) * 8 + h]; else if (p < PAST + DSEQ) v = F.out[O_LS + ((size_t)b * DSEQ + (p - PAST)) * 8 + h]; }
        sum += v; vals[i] = sum; }
    float incl = sum;
#pragma unroll
    for (int o = 1; o < 64; o <<= 1) { const float t = __shfl_up(incl, o); if (F.lane >= o) incl += t; }
    if (F.lane == 63) wsum[F.wave] = incl;
    __syncthreads();
    float base = 0.f;
    for (int w = 0; w < F.wave; ++w) base += wsum[w];
    const float excl = base + incl - sum;
#pragma unroll
    for (int i = 0; i < 16; ++i) { const int p = F.tid * EPT + i; if (i < EPT && p < L) dst[p] = (excl + vals[i]) * LOG2E; }
    __syncthreads();
}
constexpr int KP = 320  , H_QR = 0, H_KR = 17408, H_KT = 37888, H_VT = 58368, H_VEC = 71680, H_AL = 73216, H_OL = 82432, H_END = 116224;
static_assert(H_END <= RING_BYTES, "hgrn LDS");
typedef short v4i16_t __attribute__((ext_vector_type(4)));
__device__ __forceinline__ bf16x8 tr_frag(LAS unsigned char* p) {
    const v4i16_t lo = __builtin_amdgcn_ds_read_tr16_b64_v4i16((LAS v4i16_t*)p), hi = __builtin_amdgcn_ds_read_tr16_b64_v4i16((LAS v4i16_t*)(p + 4 * KP));
    return (bf16x8){lo[0], lo[1], lo[2], lo[3], hi[0], hi[1], hi[2], hi[3]};
}
__device__ __forceinline__ f32x4 mfma16(bf16x8 a, bf16x8 b, f32x4 c) { return __builtin_amdgcn_mfma_f32_16x16x32_bf16(a, b, c, 0, 0, 0); }
#define LAUNDER(x) asm volatile("" : "+v"(x))
#ifndef PR_A
#define PR_A 1
#endif
#ifndef PR_O
#define PR_O 1
#endif
#ifndef PR_OUT
#define PR_OUT 1
#endif
#ifndef PR_U
#define PR_U 0
#endif
#ifndef PR_ST
#define PR_ST 1
#endif
#ifndef PR_BAR
#define PR_BAR 1
#endif
#define HG_BAR() do { for (int rb_ = 0; rb_ < PR_BAR; ++rb_) { asm volatile("s_waitcnt lgkmcnt(0)" ::: "memory"); __builtin_amdgcn_s_barrier(); asm volatile("" ::: "memory"); } } while (0)
__device__ __forceinline__ void hgrn_chain(Frame& F, int row0, int chunk0, int nsteps, int h, const float* S0, float* Sout) {
    LAS unsigned char* L = F.lds; int tid_ = F.tid; LAUNDER(tid_); const int tid = tid_, lane = tid & 63, w = F.wave, l15 = lane & 15, fq = lane >> 4;
    const char* qb = (const char*)(F.ws + WS_QR) + ((size_t)row0 * 512 + 128 * h) * 2; const char* kb_ = (const char*)(F.ws + WS_KR) + ((size_t)row0 * 512 + 128 * h) * 2;
    const char* vb = (const char*)(F.ws + WS_VH) + ((size_t)row0 * 512 + 128 * h) * 2; const char* gb = (const char*)(F.ws + WS_SG) + ((size_t)row0 * 512 + 128 * h) * 2;
    const char* eb = (const char*)(F.ws + WS_VEC) + ((size_t)chunk0 * 512 + 128 * h) * 4; char* mb = (char*)(F.ws + WS_MIX) + ((size_t)row0 * DMOD + 128 * h) * 2;
    const int oc = tid >> 3, oseg = tid & 7;
    unsigned vo_rm = (unsigned)((tid >> 4) * 1024 + (tid & 15) * 16), vo_sg = (unsigned)(oc * 1024 + oseg * 32), vo_mix = (unsigned)(oc * 2048 + oseg * 32);
    unsigned vo_vec = (unsigned)((tid & 31) * 16);
    unsigned l_rm = (unsigned)(H_QR + (tid >> 4) * 272 + (tid & 15) * 16), l_rk = (unsigned)(H_KR + (tid >> 4) * KP + (tid & 15) * 16);
    unsigned l_vw = (unsigned)(H_VEC + (tid & 31) * 16);
    unsigned l_aq = (unsigned)(H_QR + (16 * (w >> 1) + l15) * 272 + fq * 16);
    unsigned l_ak = (unsigned)(H_KR + (32 * (w & 1) + l15) * KP + fq * 16);
    unsigned l_aw = (unsigned)(H_AL + (16 * (w >> 1) + 4 * fq) * 144 + (32 * (w & 1) + l15) * 2);
    unsigned l_vt = (unsigned)(H_KT + (8 * fq + (l15 >> 2)) * KP + (16 * w + 4 * (l15 & 3)) * 2);
    unsigned l_q2 = (unsigned)(H_QR + l15 * 272 + fq * 16);
    unsigned l_al = (unsigned)(H_AL + l15 * 144 + fq * 16);
    unsigned l_kt = (unsigned)(H_KR + (8 * fq + (l15 >> 2)) * KP + (8 * (l15 & 3)) * 2);
    unsigned l_ve = (unsigned)(H_VEC + fq * 32);
    unsigned l_ow = (unsigned)(H_OL + (4 * fq) * 528 + (16 * w + l15) * 4);
    unsigned l_or = (unsigned)(H_OL + oc * 528 + oseg * 64);
    f32x4 S[8];
#pragma unroll
    for (int kb = 0; kb < 8; ++kb) S[kb] = (f32x4){0.f, 0.f, 0.f, 0.f};
    if (S0) { const float* sp = S0 + (8 * fq) * 128 + 16 * w + l15;
#pragma unroll
        for (int kb = 0; kb < 8; ++kb) { LAUNDER(sp);
#pragma unroll
            for (int r = 0; r < 4; ++r) S[kb][r] = sp[r * 128];
            sp += (kb & 1) ? 28 * 128 : 4 * 128; } }
    f32x4 gn[4];
#pragma unroll
    for (int i = 0; i < 4; ++i) gn[i] = *(const f32x4*)(F.hon + 128 * h + 16 * oseg + 4 * i);
    v4u pq[2][2], pk[2][2], pv[2][2], psg[2][2], pvec[2]; int cl = 0, gl = 0;
#define HG_LOADS(SET) do { \
        _Pragma("unroll") for (int it = 0; it < 2; ++it) { pq[SET][it] = *(const v4u*)(qb + vo_rm + it * 32768); pk[SET][it] = *(const v4u*)(kb_ + vo_rm + it * 32768); pv[SET][it] = *(const v4u*)(vb + vo_rm + it * 32768); } \
        pvec[SET] = *(const v4u*)(eb + vo_vec); } while (0)
#define HG_STORE(SET) do { \
        _Pragma("unroll") for (int it = 0; it < 2; ++it) { *(LAS v4u*)(L + l_rm + it * 8704) = pq[SET][it]; *(LAS v4u*)(L + l_rk + it * 32 * KP) = pk[SET][it]; *(LAS v4u*)(L + l_rk + (H_KT - H_KR) + it * 32 * KP) = pv[SET][it]; } \
        if (tid < 32) *(LAS v4u*)(L + l_vw) = pvec[SET]; } while (0)
#define HG_ADV() do { const int a_ = (cl + 1 < nsteps) ? 1 : 0; qb += a_ * 65536; kb_ += a_ * 65536; vb += a_ * 65536; eb += a_ * 2048; cl += a_; } while (0)
    HG_LOADS(0); HG_ADV(); HG_STORE(0); HG_LOADS(1); HG_ADV();
    psg[0][0] = *(const v4u*)(gb + vo_sg); psg[0][1] = *(const v4u*)(gb + vo_sg + 16); { const int a_ = (gl + 1 < nsteps) ? 1 : 0; gb += a_ * 65536; gl += a_; }
    HG_BAR();
#define HG_BODY(CUR, NXT, CC) do { \
        LAUNDER(vo_rm); LAUNDER(vo_sg); LAUNDER(vo_mix); LAUNDER(vo_vec); LAUNDER(l_rm); LAUNDER(l_rk); LAUNDER(l_vw); LAUNDER(l_aq); LAUNDER(l_ak); LAUNDER(l_aw); \
        LAUNDER(l_vt); LAUNDER(l_q2); LAUNDER(l_al); LAUNDER(l_kt); LAUNDER(l_ve); LAUNDER(l_ow); LAUNDER(l_or); \
        psg[NXT][0] = *(const v4u*)(gb + vo_sg); psg[NXT][1] = *(const v4u*)(gb + vo_sg + 16); { const int a_ = (gl + 1 < nsteps) ? 1 : 0; gb += a_ * 65536; gl += a_; } \
        HG_LOADS(CUR); HG_ADV(); \
        for (int ra_ = 0; ra_ < PR_A; ++ra_) { const int cblk = w >> 1; \
        _Pragma("unroll") \
          for (int jj = 0; jj < 2; ++jj) { const int sblk = 2 * (w & 1) + jj; f32x4 a = {0.f, 0.f, 0.f, 0.f}; \
              if (sblk <= cblk) { \
                  bf16x8 af[4], bf[4]; \
        _Pragma("unroll") \
                  for (int ks = 0; ks < 4; ++ks) { af[ks] = *(const LAS bf16x8*)(L + l_aq + ks * 64); bf[ks] = *(const LAS bf16x8*)(L + l_ak + jj * 16 * KP + ks * 64); } \
                  asm volatile("" : "+v"(af[0]), "+v"(af[1]), "+v"(af[2]), "+v"(af[3]), "+v"(bf[0]), "+v"(bf[1]), "+v"(bf[2]), "+v"(bf[3])); \
        _Pragma("unroll") \
                  for (int ks = 0; ks < 4; ++ks) a = mfma16(af[ks], bf[ks], a); \
        _Pragma("unroll") \
                  for (int r = 0; r < 4; ++r) if (16 * sblk + l15 > 16 * cblk + 4 * fq + r) a[r] = 0.f; \
              } \
        _Pragma("unroll") \
              for (int r = 0; r < 4; ++r) *(LAS unsigned short*)(L + l_aw + r * 144 + jj * 32) = (unsigned short)(pk2(a[r], 0.f) & 0xffffu); \
          } HG_BAR(); } \
        { bf16x8 bvt[2]; \
        _Pragma("unroll") \
          for (int ks = 0; ks < 2; ++ks) bvt[ks] = tr_frag(L + l_vt + ks * 32 * KP); \
          bf16x8 sb[4]; \
        _Pragma("unroll") \
          for (int kb2 = 0; kb2 < 4; ++kb2) { v4u t; t.x = pk2(S[2 * kb2][0], S[2 * kb2][1]); t.y = pk2(S[2 * kb2][2], S[2 * kb2][3]); t.z = pk2(S[2 * kb2 + 1][0], S[2 * kb2 + 1][1]); t.w = pk2(S[2 * kb2 + 1][2], S[2 * kb2 + 1][3]); sb[kb2] = __builtin_bit_cast(bf16x8, t); } \
          for (int ro_ = 0; ro_ < PR_O; ++ro_) \
          _Pragma("unroll") \
          for (int cb = 0; cb < 4; ++cb) { f32x4 o = {0.f, 0.f, 0.f, 0.f}; bf16x8 fa[2], fq_[4]; \
        _Pragma("unroll") \
              for (int ks = 0; ks < 2; ++ks) fa[ks] = *(const LAS bf16x8*)(L + l_al + cb * 16 * 144 + ks * 64); \
        _Pragma("unroll") \
              for (int kb2 = 0; kb2 < 4; ++kb2) fq_[kb2] = *(const LAS bf16x8*)(L + l_q2 + cb * 16 * 272 + kb2 * 64); \
              asm volatile("" : "+v"(fa[0]), "+v"(fa[1]), "+v"(fq_[0]), "+v"(fq_[1]), "+v"(fq_[2]), "+v"(fq_[3])); \
        _Pragma("unroll") \
              for (int ks = 0; ks < 2; ++ks) if (32 * ks <= 16 * cb + 15) o = mfma16(fa[ks], bvt[ks], o); \
        _Pragma("unroll") \
              for (int kb2 = 0; kb2 < 4; ++kb2) o = mfma16(fq_[kb2], sb[kb2], o); \
        _Pragma("unroll") \
              for (int r = 0; r < 4; ++r) *(LAS float*)(L + l_ow + (16 * cb + r) * 528) = o[r]; \
              __builtin_amdgcn_sched_barrier(0); } \
        _Pragma("unroll") \
          for (int kp = 0; kp < 4; ++kp) { bf16x8 fk[2][2]; f32x4 dv[2]; \
        _Pragma("unroll") \
              for (int e = 0; e < 2; ++e) { const int kb = 2 * kp + e; \
        _Pragma("unroll") \
                  for (int ks = 0; ks < 2; ++ks) fk[e][ks] = tr_frag(L + l_kt + (32 * (kb >> 1) + 4 * (kb & 1)) * 2 + ks * 32 * KP); \
                  dv[e] = *(const LAS f32x4*)(L + l_ve + (32 * (kb >> 1) + 4 * (kb & 1)) * 4); } \
              asm volatile("" : "+v"(fk[0][0]), "+v"(fk[0][1]), "+v"(fk[1][0]), "+v"(fk[1][1]), "+v"(dv[0]), "+v"(dv[1])); \
        _Pragma("unroll") \
              for (int e = 0; e < 2; ++e) { const int kb = 2 * kp + e; \
        _Pragma("unroll") \
                  for (int ks = 0; ks < 2; ++ks) S[kb] = mfma16(fk[e][ks], bvt[ks], S[kb]); \
                  S[kb] = S[kb] * dv[e]; } \
              __builtin_amdgcn_sched_barrier(0); } \
          for (int ru_ = 0; ru_ < PR_U; ++ru_) { f32x4 S2[8]; \
          _Pragma("unroll") for (int kb = 0; kb < 8; ++kb) S2[kb] = S[kb]; \
          _Pragma("unroll") \
          for (int kp = 0; kp < 4; ++kp) { bf16x8 fk[2][2]; f32x4 dv[2]; \
          _Pragma("unroll") \
              for (int e = 0; e < 2; ++e) { const int kb = 2 * kp + e; \
          _Pragma("unroll") \
                  for (int ks = 0; ks < 2; ++ks) fk[e][ks] = tr_frag(L + l_kt + (32 * (kb >> 1) + 4 * (kb & 1)) * 2 + ks * 32 * KP); \
                  dv[e] = *(const LAS f32x4*)(L + l_ve + (32 * (kb >> 1) + 4 * (kb & 1)) * 4); } \
              asm volatile("" : "+v"(fk[0][0]), "+v"(fk[0][1]), "+v"(fk[1][0]), "+v"(fk[1][1]), "+v"(dv[0]), "+v"(dv[1])); \
          _Pragma("unroll") \
              for (int e = 0; e < 2; ++e) { const int kb = 2 * kp + e; \
          _Pragma("unroll") \
                  for (int ks = 0; ks < 2; ++ks) S2[kb] = mfma16(fk[e][ks], bvt[ks], S2[kb]); \
                  S2[kb] = S2[kb] * dv[e]; } \
              __builtin_amdgcn_sched_barrier(0); } \
          asm volatile("" :: "v"(S2[0]), "v"(S2[1]), "v"(S2[2]), "v"(S2[3]), "v"(S2[4]), "v"(S2[5]), "v"(S2[6]), "v"(S2[7])); } } \
        HG_BAR(); \
        for (int rt_ = 0; rt_ < PR_OUT; ++rt_) { f32x4 ov[4]; float ss = 0.f; \
        _Pragma("unroll") \
          for (int i = 0; i < 4; ++i) { ov[i] = *(const LAS f32x4*)(L + l_or + 16 * i); ss += (ov[i][0] * ov[i][0] + ov[i][1] * ov[i][1]) + (ov[i][2] * ov[i][2] + ov[i][3] * ov[i][3]); } \
          ss = sum8(ss); \
          const float rn = __builtin_amdgcn_rsqf(ss * (1.f / 128.f) + EPSN); \
          float res[16]; \
        _Pragma("unroll") \
          for (int i = 0; i < 4; ++i) \
        _Pragma("unroll") \
              for (int j = 0; j < 4; ++j) { const int e = 4 * i + j; const unsigned wd = psg[CUR][e >> 3][(e & 7) >> 1]; const float sg = bf2f((unsigned short)((e & 1) ? (wd >> 16) : (wd & 0xffffu))); res[e] = ov[i][j] * rn * gn[i][j] * sg; } \
          v4u o0, o1; o0.x = pk2(res[0], res[1]); o0.y = pk2(res[2], res[3]); o0.z = pk2(res[4], res[5]); o0.w = pk2(res[6], res[7]); o1.x = pk2(res[8], res[9]); o1.y = pk2(res[10], res[11]); o1.z = pk2(res[12], res[13]); o1.w = pk2(res[14], res[15]); \
          *(v4u*)(mb + vo_mix) = o0; *(v4u*)(mb + vo_mix + 16) = o1; } mb += 131072; \
        if ((CC) + 1 < nsteps) { for (int rs_ = 0; rs_ < PR_ST; ++rs_) { HG_STORE(NXT); } } \
        HG_BAR(); \
    } while (0)
    for (int c = 0; c < nsteps; c += 2) { HG_BODY(0, 1, c); if (c + 1 < nsteps) HG_BODY(1, 0, c + 1); }
    { int ln2 = lane; LAUNDER(ln2); float* sp = Sout + (8 * (ln2 >> 4)) * 128 + 16 * w + (ln2 & 15);
#pragma unroll
      for (int kb = 0; kb < 8; ++kb) { LAUNDER(sp);
#pragma unroll
          for (int r = 0; r < 4; ++r) sp[r * 128] = S[kb][r];
          sp += (kb & 1) ? 28 * 128 : 4 * 128; } }
#undef HG_LOADS
#undef HG_STORE
#undef HG_ADV
#undef HG_BODY
}

__global__ void __launch_bounds__(NTHR, 2) skel_fwd(Args args) {
    extern __shared__ __attribute__((aligned(16))) unsigned char lds[];
    Frame F;
    F.lds = (LAS unsigned char*)lds; F.MISC = (volatile LAS unsigned*)(F.lds + MISC_OFF);
    F.tid = threadIdx.x; F.lane = F.tid & 63; F.wave = __builtin_amdgcn_readfirstlane(F.tid >> 6);
    F.G = gridDim.x; { const int bx = blockIdx.x; F.vcu = (F.G % 8 == 0) ? (bx % 8) * (F.G / 8) + bx / 8 : bx; }
    F.ws = args.ws; F.ctl = (unsigned*)(args.ws + WS_CTL); F.out = args.out;
    F.xp = args.in[0]; F.xs = args.in[1]; F.ck = args.in[2]; F.cv = args.in[3]; F.clf = args.in[4]; F.sh = args.in[5]; F.n1 = args.in[6]; F.win = args.in[7]; F.bff = args.in[8];
    F.qg = args.in[9]; F.kg = args.in[10]; F.lbl = args.in[11]; F.hon = args.in[12]; F.wout = args.in[13]; F.n2 = args.in[14]; F.wup = args.in[15]; F.wdn = args.in[16];
    const int lo = args.ph_lo, hi = args.ph_hi;
    if (F.tid < 64) F.MISC[F.tid] = 0u;
    __syncthreads();
    const XcdBarrier xbar = xcd_barrier_post((unsigned*)(F.ctl + CW_BAR), F.MISC + 8);
#if defined(PROBE_A)
    unsigned long long ts_[9]; const bool stamper_ = (blockIdx.x == 0 && F.tid == 0);
#define STAMP(k) do { if (stamper_) ts_[k] = __builtin_amdgcn_s_memrealtime(); } while (0)
    STAMP(0);
#else
#define STAMP(k) do {} while (0)
#endif
#ifndef PH_MASK
#define PH_MASK 63
#endif
#define IN(k) (((PH_MASK >> (k)) & 1) && lo <= (k) && (k) < hi)
#ifndef SYNC_REP
#define SYNC_REP 1
#endif
#define SEAM(k) do { if (IN(k) && IN((k) + 1)) { for (int sr_ = 0; sr_ < SYNC_REP; ++sr_) cg::this_grid().sync(); } } while (0)
    bf16* XB = (bf16*)(F.ws + WS_XB); bf16* X1B = (bf16*)(F.ws + WS_X1B); bf16* MIX = (bf16*)(F.ws + WS_MIX); bf16* HB = (bf16*)(F.ws + WS_H);
    if (IN(0)) { p0_prologue(F);
#if defined(DOUBLE_P0)
        cg::this_grid().sync(); p0_prologue(F);
#endif
    }
    SEAM(0); STAMP(1);
    const int bx = (int)blockIdx.x; const bool chainwg = bx < NCHAINWG; const int NWORK = F.G - NCHAINWG;
    if (IN(1)) {
#ifndef NO_SCAN
        for (int ch = F.vcu; ch < 128; ch += F.G) scan_chain(F, ch);
#endif
        pg8::Gemm g{XB, (const bf16*)(F.ws + WS_WIN), MTOT, NIN, DMOD, DMOD};
        pg8::EpiIn E{(const float*)(F.ws + WS_RSTD), F.lbl, F.qg, F.kg, F.ws, F.out};
#pragma nounroll
        for (int sub = 0; sub < 2; ++sub) {
            pg8::OrderIn S;
            if (sub == 0) { S.so.init(MP, 2048, F.G, bx); S.pn_off = 0; S.extra = 0; S.extra_pm0 = 0; S.extra_shift = 3; }
            else { S.so.init(MTOT, NIN - 2048, NWORK, bx - NCHAINWG); S.pn_off = 8; S.extra = 8 * (MS / 256); S.extra_pm0 = MP / 256; S.extra_shift = 3; }
            if (sub == 0 || !chainwg) pg8::gemm_phase<pg8::EpiIn, pg8::OrderIn, true, true>(F.lds, g, S, E);
            if (sub == 0) {
                xcd_barrier(xbar); STAMP(2);
                if (chainwg)
#if defined(DOUBLE_HGRN)
                for (int rep_ = 0; rep_ < 2; ++rep_)
#endif
                { const int bb = bx >> 2; hgrn_chain(F, bb * TSEQ, bb * (TSEQ / 64), TSEQ / 64, bx & 3, nullptr, F.out + O_HP + (size_t)bx * 16384); }
            }
        }
#define SUBSET_BARRIER(word) do { asm volatile("s_waitcnt vmcnt(0)" ::: "memory"); __syncthreads(); \
            if (F.tid == 0) { unsigned* sc_ = F.ctl + (word); __threadfence(); __hip_atomic_fetch_add(sc_, 1u, __ATOMIC_RELAXED, __HIP_MEMORY_SCOPE_AGENT); \
                while (__hip_atomic_load(sc_, __ATOMIC_RELAXED, __HIP_MEMORY_SCOPE_AGENT) < (unsigned)NWORK) __builtin_amdgcn_s_sleep(8); \
                __threadfence(); } \
            __syncthreads(); } while (0)
        if (!chainwg) SUBSET_BARRIER(CW_SUB);
    }
    if (IN(2)) {
#ifndef NO_ATTN
        float prune_thr;
        { float mq = fabsf(F.qg[F.lane]), mk = fabsf(F.kg[F.lane]);
#pragma unroll
          for (int o = 1; o < 64; o <<= 1) { mq = fmaxf(mq, __shfl_xor(mq, o)); mk = fmaxf(mk, __shfl_xor(mk, o)); }
          prune_thr = 2.f * (8.f * mq * mk * LOG2E) + 150.f; }
        if (!chainwg) for (;;) {
            if (F.tid == 0) F.MISC[0] = atomicAdd(F.ctl + CW_QUEUE, 1u);
            __syncthreads();
            const int i = (int)F.MISC[0];
            __syncthreads();
            if (i >= 32 + 64 + 2048) break;
            if (i < 32) { const int bb = i >> 2; hgrn_chain(F, MP + 64 * bb, MP / 64 + bb, 1, i & 3, F.sh + (size_t)i * 16384, F.out + O_HS + (size_t)i * 16384); __syncthreads(); continue; }
            typedef attn_body::bf16 abf;
            const bool smp = i < 96; const int j = smp ? i - 32 : i - 96;
            const int bh = j & 63, qb = 31 - (j >> 6), b = bh >> 3, h = bh & 7;
            const int q0 = smp ? SSEQ - 256 : 256 * qb, NT = (q0 + 256) / 64; int NTE = NT;
            const size_t rb = (size_t)b * (smp ? SSEQ : TSEQ);
            const float* cgp = (const float*)(F.ws + (smp ? WS_CGS : WS_CGP)) + (size_t)bh * (smp ? SSEQ : TSEQ);
#if FOX_PRUNE
            { const bool need = F.tid < NT && (cgp[q0] - cgp[64 * F.tid + 63] >= -prune_thr); const int needed = __syncthreads_count(need ? 1 : 0);
              NTE = (needed + 1) & ~1; NTE = NTE < 4 ? 4 : (NTE > NT ? NT : NTE); }
#endif
            const size_t orow = smp ? (size_t)(MP + 64 * b) - (size_t)(PAST - q0) : rb + q0;
            attn_body::attn_unit<8>((const abf*)(F.ws + (smp ? WS_QS : WS_Q)) + (rb + q0) * 512 + 64 * h, (const abf*)(F.ws + (smp ? WS_KS : WS_K)) + rb * 512 + 64 * h, (const abf*)(F.ws + (smp ? WS_VS : WS_V)) + rb * 512 + 64 * h,
                                    (abf*)MIX + orow * DMOD + 512 + 64 * h, NT, NTE, cgp, q0, smp ? (PAST - q0) / 32 : 0, smp ? (PAST - q0) / 32 + 1 : 8, (char*)lds);
        }
#endif
    }
    if (IN(3)) {
        if (!chainwg) SUBSET_BARRIER(CW_SUB + 64);
        pg8::Gemm g{MIX, (const bf16*)(F.ws + WS_WO), MTOT, DMOD, DMOD, DMOD};
        pg8::EpiWo E{XB, F.xs, F.out + O_YP, F.out + O_YS, X1B, (float*)(F.ws + WS_SSQ)};
#pragma nounroll
        for (int pass = 0; pass < 2; ++pass) {
            pg8::OrderIn S;
            if (pass == 0) { S.so.init(0, DMOD, NWORK, bx - NCHAINWG); S.pn_off = 0; S.extra = 8; S.extra_pm0 = MP / 256; S.extra_shift = 2; }
            else { xcd_barrier(xbar); STAMP(3); S.so.init(MP, DMOD, F.G, bx); S.pn_off = 0; S.extra = 0; S.extra_pm0 = 0; S.extra_shift = 2; }
            if (pass == 1 || !chainwg) pg8::gemm_phase<pg8::EpiWo, pg8::OrderIn, true, true>(F.lds, g, S, E);
        }
    }
    xcd_barrier(xbar); STAMP(4);
    if (IN(4)) {
        pg8::Gemm g{X1B, (const bf16*)(F.ws + WS_WUP), MTOT, FF, DMOD, DMOD}; pg8::StaticOrder S; S.init(MTOT, FF, F.G, (int)blockIdx.x);
        pg8::EpiUp E{HB, (const float*)(F.ws + WS_SSQ)};
        pg8::gemm_phase<pg8::EpiUp, pg8::StaticOrder, true, true>(F.lds, g, S, E);
#if defined(DOUBLE_P4)
        cg::this_grid().sync();
        pg8::gemm_phase<pg8::EpiUp, pg8::StaticOrder, true, true>(F.lds, g, S, E);
#endif
    }
    xcd_barrier(xbar); STAMP(5);
    if (IN(5)) {
#pragma nounroll
        for (int pass = 0; pass < 2; ++pass) {
            pg8::Gemm g{HB, (const bf16*)(F.ws + WS_WDN), MTOT, DMOD, pass ? FF : FF / pg8::OrderDown::KSPLIT, FF};
            pg8::OrderDown S; S.mode = pass; S.so.init(MP, DMOD, F.G, (int)blockIdx.x);
            pg8::EpiDown E{F.out + O_YP, F.out + O_YS, X1B, pass ? 0 : 1};
            pg8::gemm_phase<pg8::EpiDown, pg8::OrderDown, true, true>(F.lds, g, S, E);
        }
    }
    STAMP(6);
#if defined(PROBE_A)
    cg::this_grid().sync();
    if (stamper_) {
        unsigned long long da = ts_[PROBE_A + 1] - ts_[PROBE_A], db = ts_[PROBE_B + 1] - ts_[PROBE_B];
        unsigned qa = (unsigned)((da + 1250) / 2500), qb = (unsigned)((db + 1250) / 2500); if (qa > 63) qa = 63; if (qb > 63) qb = 63;
#if defined(PROBE_CAL)
        qa = 1000; qb = 0;
#endif
        const unsigned long long t0 = __builtin_amdgcn_s_memrealtime(), wait = 2000ull * (qa + 64 * qb);
        while (__builtin_amdgcn_s_memrealtime() - t0 < wait) __builtin_amdgcn_s_sleep(16);
    }
#endif
#undef IN
#undef SEAM
}

extern "C" void kernel_launch(void* const* d_in, const int* in_sizes, int n_in, void* d_out, int out_size, void* d_ws, size_t ws_size, hipStream_t stream) {
    static int grid = 0;
    if (grid == 0) {
        if (n_in != 17 || (size_t)out_size != O_END || ws_size < WS_END) { fprintf(stderr, "kernel_launch: unexpected shapes (n_in %d out %d ws %zu)\n", n_in, out_size, ws_size); grid = -1; return; }
        int dev = 0, cus = 0, per_cu = 0;
        if (hipGetDevice(&dev) != hipSuccess || hipDeviceGetAttribute(&cus, hipDeviceAttributeMultiprocessorCount, dev) != hipSuccess) { grid = -1; return; }
        if (hipFuncSetAttribute((const void*)skel_fwd, hipFuncAttributeMaxDynamicSharedMemorySize, LDS_BYTES) != hipSuccess) { fprintf(stderr, "kernel_launch: hipFuncSetAttribute failed\n"); grid = -1; return; }
        if (hipOccupancyMaxActiveBlocksPerMultiprocessor(&per_cu, (const void*)skel_fwd, NTHR, LDS_BYTES) != hipSuccess || per_cu < 1) { fprintf(stderr, "kernel_launch: occupancy query says %d\n", per_cu); per_cu = 1; }
        (void)hipGetLastError();
        grid = cus;
    }
    if (grid < 0) return;
    if (hipMemsetAsync((char*)d_ws + WS_CTL, 0, CTL_ZERO_BYTES, stream) != hipSuccess) { fprintf(stderr, "kernel_launch: memset failed\n"); return; }
    Args a{};
    for (int i = 0; i < 17; ++i) a.in[i] = (const float*)d_in[i];
    a.out = (float*)d_out; a.ws = (unsigned char*)d_ws;
#if MK_N_LAUNCHES == 1
    a.ph_lo = 0; a.ph_hi = 6;
    void* kargs[] = {&a};
    hipError_t e = hipLaunchCooperativeKernel((const void*)skel_fwd, dim3(grid), dim3(NTHR), kargs, LDS_BYTES, stream);
    if (e != hipSuccess) fprintf(stderr, "kernel_launch: cooperative launch failed: %s (grid %d)\n", hipGetErrorString(e), grid);
#else
    for (int li = 0; li < 6; ++li) { a.ph_lo = li; a.ph_hi = li + 1; hipLaunchKernelGGL(skel_fwd, dim3(grid), dim3(NTHR), LDS_BYTES, stream, a); }
#endif
}
```
